# Optimizing an MI355X kernel written in HIP

```python
import math
import jax
import jax.numpy as jnp
from jax import lax
import numpy as np

D_MODEL = 1024
BATCH = 8
SEQ = 8192
DEPTH = 2

N_MIXERS = 4
N_HEADS = 4
HEAD_DIM = 64
MIX_WIDTH = N_HEADS * HEAD_DIM
D_FF = 2816
PLE_DIM = 256
NORM_EPS = 1e-6
NEG_BIG = -1e30
POS_BIG = 1e30
GATE_FLOOR = 1e-20

NSA_CMP_BLOCK = 32
NSA_CMP_STRIDE = 16
NSA_SEL_BLOCK = 64
NSA_TOP_N = 16
NSA_WINDOW = 512
NSA_Q_CHUNK = 64
NSA_CMP_HIDDEN = 128
NSA_WIDTHS = (MIX_WIDTH, HEAD_DIM, HEAD_DIM, HEAD_DIM, HEAD_DIM, HEAD_DIM, HEAD_DIM, 3 * N_HEADS)

HGRN_CHUNK = 32
HGRN_WIDTHS = (MIX_WIDTH, MIX_WIDTH, MIX_WIDTH, MIX_WIDTH)

RET_CHUNK = 64
RET_ROPE_BASE = 10000.0
RET_GN_EPS = 1e-5
RET_WIDTHS = (MIX_WIDTH, MIX_WIDTH, MIX_WIDTH, MIX_WIDTH)

RWKV_W_RANK = 64
RWKV_A_RANK = 64
RWKV_G_RANK = 128
RWKV_GN_EPS = 64e-5
RWKV_WIDTHS = (MIX_WIDTH, MIX_WIDTH, MIX_WIDTH, RWKV_W_RANK, RWKV_A_RANK, RWKV_G_RANK)
RWKV_IN = sum(RWKV_WIDTHS)

GROUP_WIDTHS = (sum(NSA_WIDTHS), sum(HGRN_WIDTHS), sum(RET_WIDTHS), RWKV_IN)
D_IN = sum(GROUP_WIDTHS)

kernel_name = 'hybrid_nsa_hgrn2_retnet_rwkv7_block'


def _split(a, widths):
    out = []
    off = 0
    for w in widths:
        out.append(a[..., off:off + w])
        off += w
    return out


def _rmsnorm(x, g):
    xf = x.astype(jnp.float32)
    y = xf * lax.rsqrt(jnp.mean(xf * xf, axis=-1, keepdims=True) + NORM_EPS)
    return (y * g.astype(jnp.float32)).astype(x.dtype)


def _head_rmsnorm(o, g):
    b, s, h, d = o.shape
    y = o * lax.rsqrt(jnp.mean(o * o, axis=-1, keepdims=True) + NORM_EPS)
    return y.reshape(b, s, h * d) * g.astype(jnp.float32)


def _head_layernorm(o, g, beta, eps):
    b, s, h, d = o.shape
    mu = jnp.mean(o, axis=-1, keepdims=True)
    var = jnp.mean(jnp.square(o - mu), axis=-1, keepdims=True)
    y = ((o - mu) * lax.rsqrt(var + eps)).reshape(b, s, h * d)
    return y * g.astype(jnp.float32) + beta.astype(jnp.float32)


def _nsa_mixer(u, pos_k, pos_v, cmp_k1, cmp_k2, cmp_v1, cmp_v2):
    u = u.astype(jnp.float32)
    bsz, seq, _ = u.shape
    q, k_c, v_c, k_s, v_s, k_w, v_w, g_logit = _split(u, NSA_WIDTHS)
    q = q.reshape(bsz, seq, N_HEADS, HEAD_DIM) * (HEAD_DIM ** -0.5)
    gates = jax.nn.sigmoid(g_logit).reshape(bsz, seq, 3, N_HEADS)

    n_cmp = (seq - NSA_CMP_BLOCK) // NSA_CMP_STRIDE + 1
    cmp_start = jnp.arange(n_cmp) * NSA_CMP_STRIDE
    blk_idx = cmp_start[:, None] + jnp.arange(NSA_CMP_BLOCK)[None, :]

    def compress(kv, pos, w1, w2):
        blk = kv[:, blk_idx] + pos.astype(jnp.float32)
        hid = jax.nn.silu(blk.reshape(bsz, n_cmp, NSA_CMP_BLOCK * HEAD_DIM) @ w1)
        return hid @ w2

    k_cmp = compress(k_c, pos_k, cmp_k1, cmp_k2)
    v_cmp = compress(v_c, pos_v, cmp_v1, cmp_v2)
    cmp_end = cmp_start + NSA_CMP_BLOCK - 1

    n_sel = seq // NSA_SEL_BLOCK
    n_top = min(NSA_TOP_N, n_sel)
    sel_start = jnp.arange(n_sel) * NSA_SEL_BLOCK
    overlap = ((cmp_start[:, None] < sel_start[None, :] + NSA_SEL_BLOCK)
               & (cmp_start[:, None] + NSA_CMP_BLOCK > sel_start[None, :])).astype(jnp.float32)
    k_blocks = k_s.reshape(bsz, n_sel, NSA_SEL_BLOCK, HEAD_DIM)
    v_blocks = v_s.reshape(bsz, n_sel, NSA_SEL_BLOCK, HEAD_DIM)
    blk_ids = jnp.arange(n_sel)
    gather = jax.vmap(lambda blocks, ix: blocks[ix])

    k_win = jnp.pad(k_w, ((0, 0), (NSA_WINDOW, 0), (0, 0)))
    v_win = jnp.pad(v_w, ((0, 0), (NSA_WINDOW, 0), (0, 0)))

    def query_chunk(c):
        t0 = c * NSA_Q_CHUNK
        qc = lax.dynamic_slice_in_dim(q, t0, NSA_Q_CHUNK, axis=1)
        gc = lax.dynamic_slice_in_dim(gates, t0, NSA_Q_CHUNK, axis=1)
        t = t0 + jnp.arange(NSA_Q_CHUNK)
        m_cmp = cmp_end[None, :] <= t[:, None]
        s_cmp = jnp.einsum('bqhd,bnd->bhqn', qc, k_cmp)
        p_cmp = jax.nn.softmax(jnp.where(m_cmp, s_cmp, NEG_BIG), axis=-1) * m_cmp
        o_cmp = jnp.einsum('bhqn,bnd->bqhd', p_cmp, v_cmp)
        importance = jnp.einsum('bhqn,ns->bqs', p_cmp, overlap)
        cur = t // NSA_SEL_BLOCK
        allowed = blk_ids[None, :] <= cur[:, None]
        forced = ((blk_ids[None, :] == 0) | (blk_ids[None, :] == cur[:, None])
                  | (blk_ids[None, :] == cur[:, None] - 1))
        score = jnp.where(forced, POS_BIG, jnp.where(allowed, importance, NEG_BIG))
        _, sel = lax.top_k(score, n_top)
        k_sel = gather(k_blocks, sel)
        v_sel = gather(v_blocks, sel)
        key_pos = sel[..., None] * NSA_SEL_BLOCK + jnp.arange(NSA_SEL_BLOCK)
        m_sel = (key_pos <= t[None, :, None, None])[:, :, None]
        s_sel = jnp.where(m_sel, jnp.einsum('bqhd,bqnkd->bqhnk', qc, k_sel), NEG_BIG)
        p_sel = jax.nn.softmax(s_sel.reshape(bsz, NSA_Q_CHUNK, N_HEADS, n_top * NSA_SEL_BLOCK), axis=-1)
        p_sel = p_sel.reshape(bsz, NSA_Q_CHUNK, N_HEADS, n_top, NSA_SEL_BLOCK)
        o_sel = jnp.einsum('bqhnk,bqnkd->bqhd', p_sel, v_sel)
        kw = lax.dynamic_slice_in_dim(k_win, t0, NSA_Q_CHUNK + NSA_WINDOW, axis=1)
        vw = lax.dynamic_slice_in_dim(v_win, t0, NSA_Q_CHUNK + NSA_WINDOW, axis=1)
        s_pos = t0 - NSA_WINDOW + jnp.arange(NSA_Q_CHUNK + NSA_WINDOW)
        dist = t[:, None] - s_pos[None, :]
        m_win = (dist >= 0) & (dist < NSA_WINDOW) & (s_pos[None, :] >= 0)
        s_win = jnp.einsum('bqhd,bkd->bhqk', qc, kw)
        p_win = jax.nn.softmax(jnp.where(m_win, s_win, NEG_BIG), axis=-1)
        o_win = jnp.einsum('bhqk,bkd->bqhd', p_win, vw)
        return (gc[:, :, 0, :, None] * o_cmp + gc[:, :, 1, :, None] * o_sel
                + gc[:, :, 2, :, None] * o_win)

    out = lax.map(query_chunk, jnp.arange(seq // NSA_Q_CHUNK))
    return out.transpose(1, 0, 2, 3, 4).reshape(bsz, seq, MIX_WIDTH)


def _chunk_gated_linear(q, k, v, log_f, chunk):
    bsz, seq, nh, dk = q.shape
    dv = v.shape[-1]
    n = seq // chunk

    def to_chunks(a):
        return a.reshape(bsz, n, chunk, nh, a.shape[-1]).transpose(1, 0, 3, 2, 4)

    causal = jnp.tril(jnp.ones((chunk, chunk), bool))[:, :, None]

    def step(state, inp):
        qc, kc, vc, gc = inp
        b = jnp.cumsum(gc, axis=2)
        o_inter = jnp.einsum('bhtd,bhde->bhte', qc * jnp.exp(b), state)
        diff = b[:, :, :, None, :] - b[:, :, None, :, :]
        decay = jnp.where(causal, jnp.exp(jnp.where(causal, diff, 0.0)), 0.0)
        attn = jnp.einsum('bhtd,bhsd,bhtsd->bhts', qc, kc, decay)
        o = o_inter + jnp.einsum('bhts,bhse->bhte', attn, vc)
        b_last = b[:, :, -1:, :]
        state = (jnp.exp(b_last[:, :, 0, :])[..., None] * state
                 + jnp.einsum('bhsd,bhse->bhde', kc * jnp.exp(b_last - b), vc))
        return state, o

    init = jnp.zeros((bsz, nh, dk, dv), jnp.float32)
    _, o = lax.scan(step, init, (to_chunks(q), to_chunks(k), to_chunks(v), to_chunks(log_f)))
    return o.transpose(1, 0, 3, 2, 4).reshape(bsz, seq, nh, dv)


def _hgrn2_mixer(u, lower_bound, norm_g):
    u = u.astype(jnp.float32)
    bsz, seq, _ = u.shape
    q, f_logit, i_in, o_gate = _split(u, HGRN_WIDTHS)
    lb = lower_bound.astype(jnp.float32)
    f = lb + (1.0 - lb) * jax.nn.sigmoid(f_logit)
    log_f = jnp.log(jnp.maximum(f, GATE_FLOOR))
    k = 1.0 - f
    q = jax.nn.silu(q)

    def heads(a):
        return a.reshape(bsz, seq, N_HEADS, HEAD_DIM)

    o = _chunk_gated_linear(heads(q), heads(k), heads(i_in), heads(log_f), HGRN_CHUNK)
    return _head_rmsnorm(o, norm_g) * jax.nn.silu(o_gate)


def _rope(a, cos, sin):
    half = a.shape[-1] // 2
    a1, a2 = a[..., :half], a[..., half:]
    return jnp.concatenate([a1 * cos - a2 * sin, a1 * sin + a2 * cos], axis=-1)


def _retention_mixer(u, norm_g, norm_b):
    u = u.astype(jnp.float32)
    bsz, seq, _ = u.shape
    q, k, v, g = _split(u, RET_WIDTHS)
    q = q.reshape(bsz, seq, N_HEADS, HEAD_DIM)
    k = k.reshape(bsz, seq, N_HEADS, HEAD_DIM)
    v = v.reshape(bsz, seq, N_HEADS, HEAD_DIM)
    pos = jnp.arange(seq, dtype=jnp.float32)
    inv_freq = RET_ROPE_BASE ** (-jnp.arange(0, HEAD_DIM, 2, dtype=jnp.float32) / HEAD_DIM)
    ang = pos[:, None] * inv_freq[None, :]
    cos, sin = jnp.cos(ang)[:, None, :], jnp.sin(ang)[:, None, :]
    q = _rope(q, cos, sin)
    k = _rope(k, cos, sin) * (HEAD_DIM ** -0.5)
    log_gamma = jnp.log(1.0 - jnp.exp2(-5.0 - jnp.arange(N_HEADS, dtype=jnp.float32)))

    n = seq // RET_CHUNK
    qc = q.reshape(bsz, n, RET_CHUNK, N_HEADS, HEAD_DIM)
    kc = k.reshape(bsz, n, RET_CHUNK, N_HEADS, HEAD_DIM)
    vc = v.reshape(bsz, n, RET_CHUNK, N_HEADS, HEAD_DIM)
    i = jnp.arange(RET_CHUNK, dtype=jnp.float32)
    dpos = i[:, None] - i[None, :]
    decay_mask = jnp.where(dpos >= 0, jnp.exp(jnp.maximum(dpos, 0.0)[None] * log_gamma[:, None, None]), 0.0)
    s = jnp.einsum('bnthd,bnshd->bnhts', qc, kc) * decay_mask
    o_intra = jnp.einsum('bnhts,bnshe->bnthe', s, vc)

    k_decay = jnp.exp((RET_CHUNK - 1.0 - i)[:, None] * log_gamma[None, :])
    kv = jnp.einsum('bnshd,sh,bnshe->nbhde', kc, k_decay, vc)
    chunk_decay = jnp.exp(RET_CHUNK * log_gamma)

    def carry_state(state, kv_c):
        return chunk_decay[None, :, None, None] * state + kv_c, state

    _, states = lax.scan(carry_state, jnp.zeros((bsz, N_HEADS, HEAD_DIM, HEAD_DIM), jnp.float32), kv)
    q_decay = jnp.exp((i + 1.0)[:, None] * log_gamma[None, :])
    o_inter = jnp.einsum('bnthd,th,nbhde->bnthe', qc, q_decay, states)
    o = (o_intra + o_inter).reshape(bsz, seq, N_HEADS, HEAD_DIM)
    return _head_layernorm(o, norm_g, norm_b, RET_GN_EPS) * jax.nn.silu(g)


def _rwkv7_mixer(u, mu, w0, w_up, a0, a_up, g_up, k_k, k_a, r_k, norm_g, norm_b):
    u = u.astype(jnp.float32)
    bsz, seq, _ = u.shape
    u_prev = jnp.pad(u[:, :-1], ((0, 0), (1, 0), (0, 0)))
    u = u + mu * (u_prev - u)
    r, k, v, w_lo, a_lo, g_lo = _split(u, RWKV_WIDTHS)
    decay = jnp.exp(-math.exp(-0.5) * jax.nn.sigmoid(w0 + jnp.tanh(w_lo) @ w_up))
    a = jax.nn.sigmoid(a0 + a_lo @ a_up)
    g = jax.nn.sigmoid(g_lo) @ g_up

    def heads(t):
        return t.reshape(bsz, seq, N_HEADS, HEAD_DIM)

    kk = heads(k * k_k)
    kk = kk * lax.rsqrt(jnp.maximum(jnp.sum(kk * kk, axis=-1, keepdims=True), 1e-24))
    k = k * (1.0 + (a - 1.0) * k_a)
    r_h, k_h, v_h, w_h, a_h = heads(r), heads(k), heads(v), heads(decay), heads(a)

    def step(state, inp):
        r_t, w_t, k_t, v_t, kk_t, a_t = inp
        sa = jnp.einsum('bhvk,bhk->bhv', state, -kk_t)
        state = (state * w_t[:, :, None, :] + sa[..., None] * (kk_t * a_t)[:, :, None, :]
                 + v_t[..., None] * k_t[:, :, None, :])
        return state, jnp.einsum('bhvk,bhk->bhv', state, r_t)

    def time_major(t):
        return t.transpose(1, 0, 2, 3)

    init = jnp.zeros((bsz, N_HEADS, HEAD_DIM, HEAD_DIM), jnp.float32)
    _, y = lax.scan(step, init, (time_major(r_h), time_major(w_h), time_major(k_h),
                                 time_major(v_h), time_major(kk), time_major(a_h)))
    y = _head_layernorm(time_major(y), norm_g, norm_b, RWKV_GN_EPS)
    bonus = jnp.sum(r_h * k_h * r_k.reshape(N_HEADS, HEAD_DIM), axis=-1, keepdims=True) * v_h
    return (y + bonus.reshape(bsz, seq, MIX_WIDTH)) * g


def setup_inputs(seed: int = 0) -> dict:
    key = jax.random.key(seed)
    keys = iter(jax.random.split(key, 48))

    def normal(shape, scale):
        return scale * jax.random.normal(next(keys), shape, jnp.float32)

    def gain(shape):
        return 1.0 + normal(shape, 0.02)

    L = DEPTH
    cmp_in = NSA_CMP_BLOCK * HEAD_DIM
    return {
        'x': normal((BATCH, SEQ, D_MODEL), 1.0),
        'p': normal((DEPTH, BATCH, SEQ, PLE_DIM), 1.0),
        'norm_mix': gain((L, D_MODEL)),
        'w_in': normal((L, D_MODEL, D_IN), D_MODEL ** -0.5),
        'nsa_pos_k': normal((L, NSA_CMP_BLOCK, HEAD_DIM), 0.02),
        'nsa_pos_v': normal((L, NSA_CMP_BLOCK, HEAD_DIM), 0.02),
        'nsa_cmp_k1': normal((L, cmp_in, NSA_CMP_HIDDEN), cmp_in ** -0.5),
        'nsa_cmp_k2': normal((L, NSA_CMP_HIDDEN, HEAD_DIM), NSA_CMP_HIDDEN ** -0.5),
        'nsa_cmp_v1': normal((L, cmp_in, NSA_CMP_HIDDEN), cmp_in ** -0.5),
        'nsa_cmp_v2': normal((L, NSA_CMP_HIDDEN, HEAD_DIM), NSA_CMP_HIDDEN ** -0.5),
        'hgrn_lb_logits': normal((L, MIX_WIDTH), 0.5),
        'hgrn_norm': gain((L, MIX_WIDTH)),
        'ret_norm_g': gain((L, MIX_WIDTH)),
        'ret_norm_b': normal((L, MIX_WIDTH), 0.02),
        'rwkv_mu': jax.random.uniform(next(keys), (L, RWKV_IN), jnp.float32, minval=0.2, maxval=0.8),
        'rwkv_w0': normal((L, MIX_WIDTH), 0.5),
        'rwkv_w_up': normal((L, RWKV_W_RANK, MIX_WIDTH), 0.5 * RWKV_W_RANK ** -0.5),
        'rwkv_a0': normal((L, MIX_WIDTH), 0.1),
        'rwkv_a_up': normal((L, RWKV_A_RANK, MIX_WIDTH), 0.5 * RWKV_A_RANK ** -0.5),
        'rwkv_g_up': normal((L, RWKV_G_RANK, MIX_WIDTH), RWKV_G_RANK ** -0.5),
        'rwkv_k_k': 0.85 + normal((L, MIX_WIDTH), 0.02),
        'rwkv_k_a': 1.0 + normal((L, MIX_WIDTH), 0.02),
        'rwkv_r_k': normal((L, MIX_WIDTH), 0.1),
        'rwkv_norm_g': gain((L, MIX_WIDTH)),
        'rwkv_norm_b': normal((L, MIX_WIDTH), 0.02),
        'w_branch': normal((L, N_MIXERS, MIX_WIDTH, D_MODEL), MIX_WIDTH ** -0.5),
        'w_gate': normal((L, N_MIXERS, D_MODEL, D_MODEL), D_MODEL ** -0.5),
        'b_gate': normal((L, N_MIXERS, D_MODEL), 0.01),
        'w_out': normal((L, D_MODEL, D_MODEL), D_MODEL ** -0.5),
        'norm_ffn': gain((L, D_MODEL)),
        'w_ffn_gate': normal((L, D_MODEL, D_FF), D_MODEL ** -0.5),
        'w_ffn_up': normal((L, D_MODEL, D_FF), D_MODEL ** -0.5),
        'w_ffn_down': normal((L, D_FF, D_MODEL), D_FF ** -0.5),
        'norm_ple': gain((L, D_MODEL)),
        'w_ple_gate': normal((L, D_MODEL, D_MODEL), D_MODEL ** -0.5),
        'w_ple_proj': normal((L, PLE_DIM, D_MODEL), PLE_DIM ** -0.5),
        'norm_final': gain((D_MODEL,)),
    }


def reference(x, p, norm_mix, w_in, nsa_pos_k, nsa_pos_v, nsa_cmp_k1, nsa_cmp_k2, nsa_cmp_v1,
              nsa_cmp_v2, hgrn_lb_logits, hgrn_norm, ret_norm_g, ret_norm_b, rwkv_mu, rwkv_w0,
              rwkv_w_up, rwkv_a0, rwkv_a_up, rwkv_g_up, rwkv_k_k, rwkv_k_a, rwkv_r_k, rwkv_norm_g,
              rwkv_norm_b, w_branch, w_gate, b_gate, w_out, norm_ffn, w_ffn_gate, w_ffn_up,
              w_ffn_down, norm_ple, w_ple_gate, w_ple_proj, norm_final):
    lb_soft = jax.nn.softmax(hgrn_lb_logits.astype(jnp.float32), axis=0)
    lower_bounds = jnp.cumsum(lb_soft, axis=0) - lb_soft[0]

    h = x
    for i in range(DEPTH):
        xn = _rmsnorm(h, norm_mix[i])
        u = xn @ w_in[i]
        u_nsa, u_hgrn, u_ret, u_rwkv = _split(u, GROUP_WIDTHS)
        branch_outs = (
            _nsa_mixer(u_nsa, nsa_pos_k[i], nsa_pos_v[i], nsa_cmp_k1[i], nsa_cmp_k2[i],
                       nsa_cmp_v1[i], nsa_cmp_v2[i]),
            _hgrn2_mixer(u_hgrn, lower_bounds[i], hgrn_norm[i]),
            _retention_mixer(u_ret, ret_norm_g[i], ret_norm_b[i]),
            _rwkv7_mixer(u_rwkv, rwkv_mu[i], rwkv_w0[i], rwkv_w_up[i], rwkv_a0[i], rwkv_a_up[i],
                         rwkv_g_up[i], rwkv_k_k[i], rwkv_k_a[i], rwkv_r_k[i], rwkv_norm_g[i],
                         rwkv_norm_b[i]),
        )
        merged = None
        for m in range(N_MIXERS):
            gate = jax.nn.sigmoid(xn @ w_gate[i, m] + b_gate[i, m])
            term = gate * (branch_outs[m] @ w_branch[i, m])
            merged = term if merged is None else merged + term
        h = h + (merged @ w_out[i]).astype(h.dtype)

        hn = _rmsnorm(h, norm_ffn[i])
        ff = (jax.nn.silu(hn @ w_ffn_gate[i]) * (hn @ w_ffn_up[i])) @ w_ffn_down[i]
        h = h + ff.astype(h.dtype)

        hp = _rmsnorm(h, norm_ple[i])
        ple = jax.nn.sigmoid(hp @ w_ple_gate[i]) * (p[i] @ w_ple_proj[i])
        h = h + ple.astype(h.dtype)
    return _rmsnorm(h, norm_final)
```

```cpp
#include <hip/hip_runtime.h>
#include <cstdio>
#include <cstdint>

#ifndef MK_N_LAUNCHES
#define MK_N_LAUNCHES 1
#endif

#define LAS __attribute__((address_space(3)))
#define GAS __attribute__((address_space(1)))
typedef unsigned short bf16;
typedef short bf16x8 __attribute__((ext_vector_type(8)));
typedef float f32x4 __attribute__((ext_vector_type(4)));
typedef float f32x16 __attribute__((ext_vector_type(16)));
typedef unsigned u32x4 __attribute__((ext_vector_type(4)));
typedef unsigned u32x2 __attribute__((ext_vector_type(2)));

constexpr int D = 1024, NB = 8, S = 8192, T = NB * S, NL = 2;
constexpr int NH = 4, HD = 64, MW = 256, DFF = 2816, PLE = 256;
constexpr int DIN = 3724, UW = 3840;
constexpr int U_NSA = 0, U_HG = 768, U_RT = 1792, U_RW = 2816;
constexpr int NCMP = 511, NSEL = 128;
constexpr float EPS = 1e-6f;

constexpr size_t MiB = 1u << 20;
constexpr size_t WS_CTL = 0, CTL_BYTES = 4 * MiB;
constexpr size_t WS_W = 4 * MiB;
constexpr size_t WL_IN = 0, WL_G = 8 * MiB, WL_B = 16 * MiB, WL_OUT = 18 * MiB, WL_FF = 20 * MiB, WL_DN = 31 * MiB, WL_PG = 37 * MiB, WL_PP = 39 * MiB, WL_STRIDE = 40 * MiB;
constexpr size_t WS_MISC = 84 * MiB;
constexpr size_t WS_ROPE = WS_MISC, WS_KCMP = WS_MISC + 2 * MiB, WS_VCMP = WS_MISC + 3 * MiB;
constexpr size_t WS_HBA = 88 * MiB, WS_HBB = 216 * MiB;
constexpr size_t WS_BO = 344 * MiB;
constexpr size_t WS_U = 472 * MiB;
constexpr size_t WS_MERGED = WS_U, WS_SCR = WS_U + 416 * MiB;
constexpr size_t WS_FFH = WS_U;
constexpr size_t WS_PB = 952 * MiB;
constexpr size_t WS_END = 1024 * MiB;
constexpr int CW_BAR = 4096;
constexpr int CW_SS = 65536;
constexpr int NSS = 7;
static_assert((size_t)(CW_SS + NSS * T) * 4 <= CTL_BYTES, "ctl");

#define LDS_WAIT() asm volatile("s_waitcnt lgkmcnt(0)" ::: "memory")
#define VM_WAIT() asm volatile("s_waitcnt vmcnt(0)" ::: "memory")
__device__ __forceinline__ unsigned cvt_pk_bf16(float lo, float hi) { unsigned r; asm volatile("v_cvt_pk_bf16_f32 %0, %1, %2" : "=v"(r) : "v"(lo), "v"(hi)); return r; }
__device__ __forceinline__ float bf2f(unsigned short b) { return __builtin_bit_cast(float, ((unsigned)b) << 16); }
__device__ __forceinline__ float bflo(unsigned w) { return __builtin_bit_cast(float, w << 16); }
__device__ __forceinline__ float bfhi(unsigned w) { return __builtin_bit_cast(float, w & 0xffff0000u); }
__device__ __forceinline__ float fsigmoid(float z) { return __builtin_amdgcn_rcpf(1.0f + __builtin_amdgcn_exp2f(-1.44269504f * z)); }
__device__ __forceinline__ float fsilu(float z) { return z * fsigmoid(z); }
__device__ __forceinline__ float wave_sum(float v) {
#pragma unroll
    for (int o = 1; o < 64; o <<= 1) v += __shfl_xor(v, o);
    return v;
}
__device__ __forceinline__ float wave_max(float v) {
#pragma unroll
    for (int o = 1; o < 64; o <<= 1) v = fmaxf(v, __shfl_xor(v, o));
    return v;
}

#define XB_TMO      128
#define XB_XCNT(j)  (256  + 64 * (j))
#define XB_XSUB(j)  (1280 + 64 * (j))
#define XB_XGEN(j)  (2304 + 64 * (j))
#define XB_TOP      3328
#define XB_TOPGEN   3392
#define XCD_BAR_WORDS 3456
#define XB_SPIN_CAP (1u << 24)
__device__ __forceinline__ unsigned xb_ld(unsigned* p)              { return __hip_atomic_load(p, __ATOMIC_RELAXED, __HIP_MEMORY_SCOPE_AGENT); }
__device__ __forceinline__ unsigned xb_add(unsigned* p, unsigned v) { return __hip_atomic_fetch_add(p, v, __ATOMIC_RELAXED, __HIP_MEMORY_SCOPE_AGENT); }
__device__ __forceinline__ unsigned xb_xcc_id() { return (unsigned)__builtin_amdgcn_s_getreg((3 << 11) | 20) & 0xFu; }
#define XB_SPIN(cond, bar) do { unsigned _sp = 0; while (cond) { __builtin_amdgcn_s_sleep(1); \
    if ((++_sp & 255u) == 0u) { if (xb_ld(&(bar)[XB_TMO])) break; if (_sp > XB_SPIN_CAP) { atomicAdd(&(bar)[XB_TMO], 1u); break; } } } } while (0)
struct XcdBarrier { unsigned* bar; unsigned x; volatile LAS unsigned* st; };
__device__ __forceinline__ XcdBarrier xcd_barrier_post(unsigned* bar, volatile LAS unsigned* st) {
    XcdBarrier b; b.bar = bar; b.x = xb_xcc_id(); b.st = st;
    if (threadIdx.x == 0) (void)xb_add(&bar[XB_XCNT(b.x)], 1u);
    return b;
}
__device__ __forceinline__ void xcd_barrier_complete(unsigned* bar, unsigned x, unsigned& nloc, unsigned& nx) {
    const unsigned G = gridDim.x * gridDim.y * gridDim.z;
    unsigned sum, cnt, mine, sp = 0u;
    for (;;) {
        sum = 0u; cnt = 0u; mine = 0u;
#pragma unroll
        for (unsigned j = 0; j < 16; ++j) { const unsigned c = xb_ld(&bar[XB_XCNT(j)]); sum += c; cnt += (c > 0u) ? 1u : 0u; mine = (j == x) ? c : mine; }
        if (sum == G) break;
        __builtin_amdgcn_s_sleep(1);
        if ((++sp & 255u) == 0u) { if (xb_ld(&bar[XB_TMO])) break; if (sp > XB_SPIN_CAP) { atomicAdd(&bar[XB_TMO], 1u); break; } }
    }
    nloc = mine > 0u ? mine : 1u; nx = cnt > 0u ? cnt : 1u;
}
__device__ __forceinline__ void xcd_barrier(const XcdBarrier& b) {
    asm volatile("s_waitcnt vmcnt(0)" ::: "memory");
    __syncthreads();
    if (threadIdx.x == 0) {
        unsigned* bar = b.bar;
        __builtin_amdgcn_s_waitcnt(0);
        unsigned nloc = b.st[0], nx = b.st[1];
        if (nloc == 0u) { xcd_barrier_complete(bar, b.x, nloc, nx); b.st[0] = nloc; b.st[1] = nx; }
        const unsigned old = xb_add(&bar[XB_XSUB(b.x)], 1u);
        const unsigned gen = old / nloc;
        if (old + 1u == (gen + 1u) * nloc) {
            __builtin_amdgcn_fence(__ATOMIC_RELEASE, "agent");
            asm volatile("s_waitcnt vmcnt(0)" ::: "memory");
            const unsigned og = xb_add(&bar[XB_TOP], 1u);
            const unsigned tg = og / nx;
            if (og + 1u == (tg + 1u) * nx) xb_add(&bar[XB_TOPGEN], 1u);
            else XB_SPIN(xb_ld(&bar[XB_TOPGEN]) == tg, bar);
            __builtin_amdgcn_fence(__ATOMIC_ACQUIRE, "agent");
            xb_add(&bar[XB_XGEN(b.x)], 1u);
            asm volatile("s_waitcnt vmcnt(0)" ::: "memory");
        } else {
            XB_SPIN(xb_ld(&bar[XB_XGEN(b.x)]) == gen, bar);
            __builtin_amdgcn_fence(__ATOMIC_ACQUIRE, "agent");
            asm volatile("s_waitcnt vmcnt(0)" ::: "memory");
        }
    }
    __syncthreads();
}

namespace pg8 {
constexpr int BM = 256, BK = 64, HALF = 128, HTB = HALF * BK * 2, STAGE_BYTES = 8 * HTB, NXCD = 8, WGM = 8;
__host__ __device__ __forceinline__ int lds_byte(int r, int c) { const int st = (r >> 4) * 2 + (c >> 5), rr = r & 15, cc = c & 31, ob = rr * 64 + cc * 2; return st * 1024 + (ob ^ (((ob >> 9) & 1) << 5)); }
__host__ __device__ __forceinline__ void stage_rc(int b, int& R, int& C) { const int st = b / 1024, sb = b % 1024, swz = sb ^ (((sb >> 9) & 1) << 5); R = (st >> 1) * 16 + swz / 64; C = (st & 1) * 32 + (swz % 64) / 2; }
__host__ __device__ __forceinline__ int perm32(int rho) { const int n = rho >> 4, i = rho & 15; return 8 * (i >> 2) + 4 * n + (i & 3); }

struct GU { const char* A; const char* B; unsigned lda, ldb; int nt; int pm, pn, kind, mi; };

__device__ __forceinline__ bool tile_of(int L, int nM, int nN, int& pm, int& pn) {
    const int nwg = nM * nN; if (L >= nwg) return false;
    int wgid = L; { const int q = nwg / NXCD, r = nwg % NXCD, xcd = wgid % NXCD, off = wgid / NXCD; wgid = (xcd < r ? xcd * (q + 1) : r * (q + 1) + (xcd - r) * q) + off; }
    const int nig = WGM * nN, gid = wgid / nig, fm = gid * WGM, gsz = (nM - fm) < WGM ? (nM - fm) : WGM;
    pm = fm + ((wgid % nig) % gsz); pn = (wgid % nig) / gsz; return true;
}

template <class Epi, class Sched>
__device__ __forceinline__ void gemm_phase(LAS unsigned char* lds, const Sched& S, const Epi& E) {
    int tid = threadIdx.x; asm volatile("" : "+v"(tid));
    const int wid = __builtin_amdgcn_readfirstlane(tid >> 6), lane = tid & 63, wr = wid >> 2, wc = wid & 3, fr = lane & 15, fq = lane >> 4;
    unsigned RA[2], RB[2], C2[2];
#pragma unroll
    for (int i = 0; i < 2; ++i) { int R, C; stage_rc(tid * 16 + i * 8192, R, C); RA[i] = (unsigned)R; RB[i] = (unsigned)((R & ~31) + perm32(R & 31)); C2[i] = (unsigned)C * 2u; }
    const size_t kstep = (size_t)(BK * 2);
    const unsigned ldsw = (unsigned)wid * 1024u;
    const int aoff = lds_byte(wr * 64 + fr, fq * 8), boff = lds_byte(wc * 32 + fr, fq * 8);
#define PG8_SA(b, h) (((b) * 2 + (h)) * HTB)
#define PG8_SB(b, h) ((4 + (b) * 2 + (h)) * HTB)
#define PG8_STAGE(bufoff, gbase, ld, RR) do { _Pragma("unroll") for (int _i = 0; _i < 2; ++_i) \
        __builtin_amdgcn_global_load_lds((const unsigned*)((const char*)(gbase) + (RR[_i] * (ld) + C2[_i])), (LAS unsigned*)(lds + (bufoff) + ldsw + _i * 8192), 16, 0, 0); } while (0)
#define PG8_LDA(dst, b, h) do { _Pragma("unroll") for (int m = 0; m < 4; ++m) _Pragma("unroll") for (int k = 0; k < 2; ++k) dst[m][k] = *(const LAS bf16x8*)(lds + PG8_SA(b, h) + aoff + m * 2048 + k * 1024); } while (0)
#define PG8_LDB(dst, b, h) do { _Pragma("unroll") for (int n = 0; n < 2; ++n) _Pragma("unroll") for (int k = 0; k < 2; ++k) dst[n][k] = *(const LAS bf16x8*)(lds + PG8_SB(b, h) + boff + n * 2048 + k * 1024); } while (0)
#define PG8_MMA(ai, bj, At, Bt) do { __builtin_amdgcn_s_setprio(1); _Pragma("unroll") for (int m = 0; m < 4; ++m) _Pragma("unroll") for (int n = 0; n < 2; ++n) _Pragma("unroll") for (int k = 0; k < 2; ++k) \
        acc[ai][bj][m][n] = __builtin_amdgcn_mfma_f32_16x16x32_bf16(Bt[n][k], At[m][k], acc[ai][bj][m][n], 0, 0, 0); __builtin_amdgcn_s_setprio(0); } while (0)
#define PG8_WAIT_V(n) asm volatile("s_waitcnt vmcnt(" #n ")" ::: "memory")
#define PG8_WAIT_L(n) asm volatile("s_waitcnt lgkmcnt(" #n ")" ::: "memory")
#define PG8_BAR __builtin_amdgcn_s_barrier()
#define PG8_SCHED __builtin_amdgcn_sched_barrier(0)
    GU cur, nxt; int ui = 0;
    if (!S.next(0, cur)) return;
    f32x4 acc[2][2][4][2];
#pragma unroll
    for (int a = 0; a < 2; ++a)
#pragma unroll
        for (int b = 0; b < 2; ++b)
#pragma unroll
            for (int m = 0; m < 4; ++m)
#pragma unroll
                for (int n = 0; n < 2; ++n) acc[a][b][m][n] = (f32x4){0.f, 0.f, 0.f, 0.f};
    bf16x8 At[4][2], B0[2][2], B1[2][2];
    const char* cA = cur.A; const char* cB = cur.B; unsigned clda = cur.lda, cldb = cur.ldb;
    PG8_STAGE(PG8_SB(0, 0), cB, cldb, RB); PG8_STAGE(PG8_SB(0, 1), cB + (size_t)HALF * cldb, cldb, RB); PG8_STAGE(PG8_SA(0, 0), cA, clda, RA); PG8_STAGE(PG8_SA(0, 1), cA + (size_t)HALF * clda, clda, RA);
    if (wr == 1) PG8_BAR;
    PG8_WAIT_V(2); PG8_BAR;
    PG8_STAGE(PG8_SB(1, 0), cB + kstep, cldb, RB); PG8_STAGE(PG8_SA(1, 0), cA + kstep, clda, RA); PG8_STAGE(PG8_SB(1, 1), cB + (size_t)HALF * cldb + kstep, cldb, RB);
    PG8_WAIT_V(6); PG8_BAR;
    for (;;) {
        const bool has_next = S.next(ui + 1, nxt);
        const char* nA = has_next ? nxt.A : cA; const char* nB = has_next ? nxt.B : cB;
        const unsigned nlda = has_next ? nxt.lda : clda, nldb = has_next ? nxt.ldb : cldb;
        const int nt = cur.nt;
        for (int t = 0; t < nt; t += 2) {
            const bool last = (t == nt - 2);
            const char* a1 = cA + (size_t)(t + 1) * kstep;
            const char* a2 = last ? nA : cA + (size_t)(t + 2) * kstep; const char* b2 = last ? nB : cB + (size_t)(t + 2) * kstep;
            const unsigned lda2 = last ? nlda : clda, ldb2 = last ? nldb : cldb;
            const char* a3 = a2 + kstep; const char* b3 = b2 + kstep;
            PG8_LDB(B0, 0, 0); PG8_LDB(B1, 0, 1); PG8_SCHED; PG8_LDA(At, 0, 0); PG8_STAGE(PG8_SA(1, 1), a1 + (size_t)HALF * clda, clda, RA);
            PG8_WAIT_V(8); PG8_WAIT_L(0); PG8_BAR; PG8_MMA(0, 0, At, B0); PG8_MMA(0, 1, At, B1); PG8_BAR; PG8_SCHED;
            PG8_LDA(At, 0, 1); PG8_STAGE(PG8_SB(0, 0), b2, ldb2, RB); PG8_STAGE(PG8_SB(0, 1), b2 + (size_t)HALF * ldb2, ldb2, RB); PG8_STAGE(PG8_SA(0, 0), a2, lda2, RA);
            PG8_WAIT_V(8); PG8_WAIT_L(0); PG8_BAR; PG8_MMA(1, 0, At, B0); PG8_MMA(1, 1, At, B1); PG8_BAR; PG8_SCHED;
            PG8_LDB(B0, 1, 0); PG8_LDB(B1, 1, 1); PG8_SCHED; PG8_LDA(At, 1, 0); PG8_STAGE(PG8_SA(0, 1), a2 + (size_t)HALF * lda2, lda2, RA);
            PG8_WAIT_V(8); PG8_WAIT_L(0); PG8_BAR; PG8_MMA(0, 0, At, B0); PG8_MMA(0, 1, At, B1); PG8_BAR; PG8_SCHED;
            PG8_LDA(At, 1, 1); PG8_STAGE(PG8_SB(1, 0), b3, ldb2, RB); PG8_STAGE(PG8_SB(1, 1), b3 + (size_t)HALF * ldb2, ldb2, RB); PG8_STAGE(PG8_SA(1, 0), a3, lda2, RA);
            PG8_WAIT_V(8); PG8_WAIT_L(0); PG8_BAR; PG8_MMA(1, 0, At, B0); PG8_MMA(1, 1, At, B1); PG8_BAR; PG8_SCHED;
        }
        if (wr == 0) PG8_BAR;
        E(acc, cur, wr, wc, fr, fq);
        if (!has_next) break;
#pragma unroll
        for (int a = 0; a < 2; ++a)
#pragma unroll
            for (int b = 0; b < 2; ++b)
#pragma unroll
                for (int m = 0; m < 4; ++m)
#pragma unroll
                    for (int n = 0; n < 2; ++n) acc[a][b][m][n] = (f32x4){0.f, 0.f, 0.f, 0.f};
        cur = nxt; cA = nA; cB = nB; clda = nlda; cldb = nldb; ++ui;
        if (wr == 1) PG8_BAR;
    }
    PG8_WAIT_V(0);
    PG8_BAR;
#undef PG8_SA
#undef PG8_SB
#undef PG8_STAGE
#undef PG8_LDA
#undef PG8_LDB
#undef PG8_MMA
#undef PG8_WAIT_V
#undef PG8_WAIT_L
#undef PG8_BAR
#undef PG8_SCHED
}
}
using pg8::GU;

struct PlainSched {
    const char* A; const char* B; unsigned lda, ldb; int nt, nM, nN, G, c;
    __device__ __forceinline__ bool next(int i, GU& u) const {
        int pm, pn; if (!pg8::tile_of(i * G + c, nM, nN, pm, pn)) return false;
        u.A = A + (size_t)pm * 256 * lda; u.B = B + (size_t)pn * 256 * ldb; u.lda = lda; u.ldb = ldb; u.nt = nt; u.pm = pm; u.pn = pn; u.kind = 0; u.mi = 0; return true;
    }
};
struct PairSched {
    const char* A1; const char* B1; unsigned lda1, ldb1; int nt1; size_t b1_mstride;
    const char* A2; const char* B2; unsigned lda2, ldb2; int nt2; size_t a2_mstride, b2_mstride;
    int nm, nM, nN, G, c;
    __device__ __forceinline__ bool next(int i, GU& u) const {
        const int per = 2 * nm, ti = i / per, sub = i - ti * per, m = sub >> 1, kind = sub & 1;
        int pm, pn; if (!pg8::tile_of(ti * G + c, nM, nN, pm, pn)) return false;
        u.pm = pm; u.pn = pn; u.kind = kind; u.mi = m;
        if (kind == 0) { u.A = A2 + (size_t)m * a2_mstride + (size_t)pm * 256 * lda2; u.B = B2 + (size_t)m * b2_mstride + (size_t)pn * 256 * ldb2; u.lda = lda2; u.ldb = ldb2; u.nt = nt2; }
        else { u.A = A1 + (size_t)pm * 256 * lda1; u.B = B1 + (size_t)m * b1_mstride + (size_t)pn * 256 * ldb1; u.lda = lda1; u.ldb = ldb1; u.nt = nt1; }
        return true;
    }
};

__device__ __forceinline__ float rstd_of(const float* ss, int row) { return __builtin_amdgcn_rsqf(ss[row] * (1.0f / D) + EPS); }
__device__ __forceinline__ u32x4 pack8(const f32x4& a, const f32x4& b) { u32x4 w; w.x = cvt_pk_bf16(a[0], a[1]); w.y = cvt_pk_bf16(a[2], a[3]); w.z = cvt_pk_bf16(b[0], b[1]); w.w = cvt_pk_bf16(b[2], b[3]); return w; }
__device__ __forceinline__ void unpack8(const u32x4& w, f32x4& a, f32x4& b) { a = (f32x4){bflo(w.x), bfhi(w.x), bflo(w.y), bfhi(w.y)}; b = (f32x4){bflo(w.z), bfhi(w.z), bflo(w.w), bfhi(w.w)}; }

struct EpiScaleBf16 {
    bf16* O; int ldo; const float* ss;
    __device__ __forceinline__ void operator()(const f32x4 (&acc)[2][2][4][2], const GU& u, int wr, int wc, int fr, int fq) const {
        const int row0 = u.pm * 256 + wr * 64 + fr, col0 = u.pn * 256 + wc * 32 + 8 * fq;
#pragma unroll
        for (int ai = 0; ai < 2; ++ai)
#pragma unroll
            for (int m = 0; m < 4; ++m) { const int r = row0 + ai * 128 + m * 16; const float rs = rstd_of(ss, r); bf16* rowp = O + (size_t)r * ldo + col0;
#pragma unroll
                for (int bj = 0; bj < 2; ++bj) *(u32x4*)(rowp + bj * 128) = pack8(acc[ai][bj][m][0] * rs, acc[ai][bj][m][1] * rs); }
    }
};
struct EpiSwiGLU {
    bf16* O; const float* ss;
    __device__ __forceinline__ void operator()(const f32x4 (&acc)[2][2][4][2], const GU& u, int wr, int wc, int fr, int fq) const {
        const int row0 = u.pm * 256 + wr * 64 + fr, col0 = u.pn * 128 + wc * 32 + 8 * fq;
#pragma unroll
        for (int ai = 0; ai < 2; ++ai)
#pragma unroll
            for (int m = 0; m < 4; ++m) { const int r = row0 + ai * 128 + m * 16; const float rs = rstd_of(ss, r);
                f32x4 v[2];
#pragma unroll
                for (int n = 0; n < 2; ++n)
#pragma unroll
                    for (int j = 0; j < 4; ++j) { const float g = acc[ai][0][m][n][j] * rs, up = acc[ai][1][m][n][j] * rs; v[n][j] = fsilu(g) * up; }
                *(u32x4*)(O + (size_t)r * DFF + col0) = pack8(v[0], v[1]); }
    }
};
struct EpiResidual {
    const float* Hin; float* Hout; bf16* HB; float* ss_out;
    __device__ __forceinline__ void operator()(const f32x4 (&acc)[2][2][4][2], const GU& u, int wr, int wc, int fr, int fq) const {
        const int row0 = u.pm * 256 + wr * 64 + fr, col0 = u.pn * 256 + wc * 32 + 8 * fq;
#pragma unroll
        for (int ai = 0; ai < 2; ++ai)
#pragma unroll
            for (int m = 0; m < 4; ++m) { const int r = row0 + ai * 128 + m * 16; float s2 = 0.f;
#pragma unroll
                for (int bj = 0; bj < 2; ++bj) { const size_t o = (size_t)r * D + col0 + bj * 128;
                    f32x4 h0 = *(const f32x4*)(Hin + o), h1 = *(const f32x4*)(Hin + o + 4);
                    h0 += acc[ai][bj][m][0]; h1 += acc[ai][bj][m][1];
                    *(f32x4*)(Hout + o) = h0; *(f32x4*)(Hout + o + 4) = h1; *(u32x4*)(HB + o) = pack8(h0, h1);
                    s2 += (h0[0] * h0[0] + h0[1] * h0[1]) + (h0[2] * h0[2] + h0[3] * h0[3]) + (h1[0] * h1[0] + h1[1] * h1[1]) + (h1[2] * h1[2] + h1[3] * h1[3]); }
                s2 += __shfl_xor(s2, 16); s2 += __shfl_xor(s2, 32);
                if (fq == 0) atomicAdd(ss_out + r, s2);
                if (m == 3) asm volatile("" ::: "memory"); }
    }
};
#define SLOT(ai, m, bj) (((((ai) * 4 + (m)) >> 1) * 512 + tid) * 4 + (((m) & 1) * 2 + (bj)))
struct EpiMerge {
    u32x4* scrP; u32x4* scrM; bf16* M; const float* ss; const float* bias;
    int nm;
    __device__ __forceinline__ void operator()(const f32x4 (&acc)[2][2][4][2], const GU& u, int wr, int wc, int fr, int fq) const {
        int tid = threadIdx.x; asm volatile("" : "+v"(tid));
        if (u.kind == 0) {
#pragma unroll
            for (int ai = 0; ai < 2; ++ai)
#pragma unroll
                for (int m = 0; m < 4; ++m)
#pragma unroll
                    for (int bj = 0; bj < 2; ++bj) scrP[SLOT(ai, m, bj)] = pack8(acc[ai][bj][m][0], acc[ai][bj][m][1]);
            return;
        }
        const int row0 = u.pm * 256 + wr * 64 + fr, col0 = u.pn * 256 + wc * 32 + 8 * fq;
        const float* bp = bias + (size_t)u.mi * D + col0;
        f32x4 bv[2][2];
#pragma unroll
        for (int bj = 0; bj < 2; ++bj) { bv[bj][0] = *(const f32x4*)(bp + bj * 128); bv[bj][1] = *(const f32x4*)(bp + bj * 128 + 4); }
#pragma unroll
        for (int ai = 0; ai < 2; ++ai)
#pragma unroll
            for (int m = 0; m < 4; ++m) { const int r = row0 + ai * 128 + m * 16; const float rs = rstd_of(ss, r);
#pragma unroll
                for (int bj = 0; bj < 2; ++bj) { const int slot = SLOT(ai, m, bj);
                    f32x4 p0, p1; unpack8(scrP[slot], p0, p1);
                    f32x4 v0, v1;
#pragma unroll
                    for (int j = 0; j < 4; ++j) { v0[j] = fsigmoid(acc[ai][bj][m][0][j] * rs + bv[bj][0][j]) * p0[j]; v1[j] = fsigmoid(acc[ai][bj][m][1][j] * rs + bv[bj][1][j]) * p1[j]; }
                    if (u.mi > 0) { f32x4 q0, q1; unpack8(scrM[slot], q0, q1); v0 += q0; v1 += q1; }
                    const u32x4 w = pack8(v0, v1);
                    if (u.mi == nm - 1) *(u32x4*)(M + (size_t)r * D + col0 + bj * 128) = w; else scrM[slot] = w; }
                asm volatile("" ::: "memory"); }
    }
};
struct EpiPle {
    u32x4* scrP; float* H; bf16* HB; const float* ss; float* ss_out;
    __device__ __forceinline__ void operator()(const f32x4 (&acc)[2][2][4][2], const GU& u, int wr, int wc, int fr, int fq) const {
        int tid = threadIdx.x; asm volatile("" : "+v"(tid));
        if (u.kind == 0) {
#pragma unroll
            for (int ai = 0; ai < 2; ++ai)
#pragma unroll
                for (int m = 0; m < 4; ++m)
#pragma unroll
                    for (int bj = 0; bj < 2; ++bj) scrP[SLOT(ai, m, bj)] = pack8(acc[ai][bj][m][0], acc[ai][bj][m][1]);
            return;
        }
        const int row0 = u.pm * 256 + wr * 64 + fr, col0 = u.pn * 256 + wc * 32 + 8 * fq;
#pragma unroll
        for (int ai = 0; ai < 2; ++ai)
#pragma unroll
            for (int m = 0; m < 4; ++m) { const int r = row0 + ai * 128 + m * 16; const float rs = rstd_of(ss, r); float s2 = 0.f;
#pragma unroll
                for (int bj = 0; bj < 2; ++bj) { const int slot = SLOT(ai, m, bj); const size_t o = (size_t)r * D + col0 + bj * 128;
                    f32x4 p0, p1; unpack8(scrP[slot], p0, p1);
                    f32x4 h0 = *(const f32x4*)(H + o), h1 = *(const f32x4*)(H + o + 4);
#pragma unroll
                    for (int j = 0; j < 4; ++j) { h0[j] += fsigmoid(acc[ai][bj][m][0][j] * rs) * p0[j]; h1[j] += fsigmoid(acc[ai][bj][m][1][j] * rs) * p1[j]; }
                    *(f32x4*)(H + o) = h0; *(f32x4*)(H + o + 4) = h1; *(u32x4*)(HB + o) = pack8(h0, h1);
                    s2 += (h0[0] * h0[0] + h0[1] * h0[1]) + (h0[2] * h0[2] + h0[3] * h0[3]) + (h1[0] * h1[0] + h1[1] * h1[1]) + (h1[2] * h1[2] + h1[3] * h1[3]); }
                s2 += __shfl_xor(s2, 16); s2 += __shfl_xor(s2, 32);
                if (fq == 0) atomicAdd(ss_out + r, s2);
                asm volatile("" ::: "memory"); }
    }
};

constexpr int NWAVES = 8, NTHR = 512;
constexpr int LDS_BYTES = 147456;
constexpr int RING_OFF = 0, RING_BYTES = 131072, MISC_OFF = RING_BYTES + 320;
struct Args { const float* in[37]; float* out; unsigned char* ws; int ph_lo, ph_hi; };
struct Frame {
    LAS unsigned char* lds; int tid, lane, wave, G, bx;
    const float* const* in; float* out; unsigned char* ws;
};
enum { I_X = 0, I_P, I_NORM_MIX, I_W_IN, I_POS_K, I_POS_V, I_CK1, I_CK2, I_CV1, I_CV2, I_LB, I_HG_NORM, I_RT_G, I_RT_B, I_MU, I_W0, I_WUP, I_A0, I_AUP, I_GUP, I_KK, I_KA, I_RK,
       I_RW_G, I_RW_B, I_WBR, I_WGATE, I_BGATE, I_WOUT, I_NORM_FFN, I_FFG, I_FFU, I_FFD, I_NORM_PLE, I_PLEG, I_PLEP, I_NORM_FINAL };

template <class ColMap>
__device__ __forceinline__ void transpose_item(const float* W, int ldw, int K, const float* scale, bf16* WT, LAS float* scr, int item, int nblk, int lane, const ColMap& cm) {
    const int kb = item / nblk, nb = item % nblk, k0 = 64 * kb, n0 = 32 * nb;
    const int sc = cm(n0 + (lane & 31));
#pragma unroll 8
    for (int i = 0; i < 32; ++i) { const int kk = 2 * i + (lane >> 5); float v = 0.f; if (sc >= 0) { v = W[(size_t)(k0 + kk) * ldw + sc]; if (scale) v *= scale[k0 + kk]; } scr[kk * 33 + (lane & 31)] = v; }
    LDS_WAIT();
    const int c = lane & 7;
#pragma unroll
    for (int j = 0; j < 4; ++j) { const int n = (lane >> 3) + 8 * j; const LAS float* s = scr + (8 * c) * 33 + n;
        u32x4 o; o.x = cvt_pk_bf16(s[0 * 33], s[1 * 33]); o.y = cvt_pk_bf16(s[2 * 33], s[3 * 33]); o.z = cvt_pk_bf16(s[4 * 33], s[5 * 33]); o.w = cvt_pk_bf16(s[6 * 33], s[7 * 33]);
        *(u32x4*)(WT + (size_t)(n0 + n) * K + k0 + 8 * c) = o; }
    LDS_WAIT();
}
struct CmIdent { __device__ __forceinline__ int operator()(int n) const { return n; } };
struct CmWin { __device__ __forceinline__ int operator()(int n) const { return n < 652 ? n : (n < 768 ? -1 : n - 116); } };
struct CmFF { __device__ __forceinline__ int operator()(int n) const { return (n >> 8) * 128 + (n & 127); } };

__device__ __forceinline__ void phase_prologue(Frame& F0) {
    Frame F = F0; asm volatile("" : "+v"(F.tid)); F.lane = F.tid & 63;
    LAS float* scr = (LAS float*)(F.lds + F.wave * 16384);
    const int gw = F.bx * NWAVES + F.wave, NGW = F.G * NWAVES;
    for (int L = 0; L < NL; ++L) {
        unsigned char* wl = F.ws + WS_W + (size_t)L * WL_STRIDE;
        const float* g_mix = F.in[I_NORM_MIX] + L * D; const float* g_ffn = F.in[I_NORM_FFN] + L * D; const float* g_ple = F.in[I_NORM_PLE] + L * D;
        { const int nblk = UW / 32, items = (D / 64) * nblk; const float* W = F.in[I_W_IN] + (size_t)L * D * DIN;
          for (int it = gw; it < items; it += NGW) transpose_item(W, DIN, D, g_mix, (bf16*)(wl + WL_IN), scr, it, nblk, F.lane, CmWin()); }
        for (int m = 0; m < 4; ++m) { const int nblk = D / 32, items = (D / 64) * nblk; const float* W = F.in[I_WGATE] + ((size_t)L * 4 + m) * D * D;
          for (int it = gw; it < items; it += NGW) transpose_item(W, D, D, g_mix, (bf16*)(wl + WL_G) + (size_t)m * D * D, scr, it, nblk, F.lane, CmIdent()); }
        for (int m = 0; m < 4; ++m) { const int nblk = D / 32, items = (MW / 64) * nblk; const float* W = F.in[I_WBR] + ((size_t)L * 4 + m) * MW * D;
          for (int it = gw; it < items; it += NGW) transpose_item(W, D, MW, nullptr, (bf16*)(wl + WL_B) + (size_t)m * D * MW, scr, it, nblk, F.lane, CmIdent()); }
        { const int nblk = D / 32, items = (D / 64) * nblk; const float* W = F.in[I_WOUT] + (size_t)L * D * D;
          for (int it = gw; it < items; it += NGW) transpose_item(W, D, D, nullptr, (bf16*)(wl + WL_OUT), scr, it, nblk, F.lane, CmIdent()); }
        { const int nblk = (2 * DFF) / 32, items = (D / 64) * nblk; const float* Wg = F.in[I_FFG] + (size_t)L * D * DFF; const float* Wu = F.in[I_FFU] + (size_t)L * D * DFF;
          for (int it = gw; it < items; it += NGW) { const int nb = it % nblk; const bool up = ((nb * 32) & 128) != 0; transpose_item(up ? Wu : Wg, DFF, D, g_ffn, (bf16*)(wl + WL_FF), scr, it, nblk, F.lane, CmFF()); } }
        { const int nblk = D / 32, items = (DFF / 64) * nblk; const float* W = F.in[I_FFD] + (size_t)L * DFF * D;
          for (int it = gw; it < items; it += NGW) transpose_item(W, D, DFF, nullptr, (bf16*)(wl + WL_DN), scr, it, nblk, F.lane, CmIdent()); }
        { const int nblk = D / 32, items = (D / 64) * nblk; const float* W = F.in[I_PLEG] + (size_t)L * D * D;
          for (int it = gw; it < items; it += NGW) transpose_item(W, D, D, g_ple, (bf16*)(wl + WL_PG), scr, it, nblk, F.lane, CmIdent()); }
        { const int nblk = D / 32, items = (PLE / 64) * nblk; const float* W = F.in[I_PLEP] + (size_t)L * PLE * D;
          for (int it = gw; it < items; it += NGW) transpose_item(W, D, PLE, nullptr, (bf16*)(wl + WL_PP), scr, it, nblk, F.lane, CmIdent()); }
    }
    { const float* x = F.in[I_X]; bf16* hb = (bf16*)(F.ws + WS_HBA); float* ss0 = (float*)(F.ws + WS_CTL) + CW_SS;
      for (int r = gw; r < T; r += NGW) { const f32x4* xr = (const f32x4*)(x + (size_t)r * D) + F.lane; float s = 0.f;
#pragma unroll
        for (int j = 0; j < 4; ++j) { const f32x4 v = xr[64 * j]; s += (v[0] * v[0] + v[1] * v[1]) + (v[2] * v[2] + v[3] * v[3]);
            u32x2 w; w.x = cvt_pk_bf16(v[0], v[1]); w.y = cvt_pk_bf16(v[2], v[3]); *((u32x2*)(hb + (size_t)r * D) + F.lane + 64 * j) = w; }
        s = wave_sum(s); if (F.lane == 0) ss0[r] = s; } }
    { const float* p = F.in[I_P]; bf16* pb = (bf16*)(F.ws + WS_PB);
      for (int r = gw; r < 2 * T; r += NGW) { const f32x4 v = *((const f32x4*)(p + (size_t)r * PLE) + F.lane); u32x2 w; w.x = cvt_pk_bf16(v[0], v[1]); w.y = cvt_pk_bf16(v[2], v[3]); *((u32x2*)(pb + (size_t)r * PLE) + F.lane) = w; } }
    { float* rope = (float*)(F.ws + WS_ROPE); const int gt = F.bx * NTHR + F.tid, NT_ = F.G * NTHR;
      for (int i = gt; i < S * 32; i += NT_) { const int pos = i >> 5, j = i & 31; const double inv = pow(10000.0, -(double)(2 * j) / 64.0); const double a = (double)pos * (double)(float)inv;
        rope[2 * i] = (float)cos(a); rope[2 * i + 1] = (float)sin(a); } }
}

__device__ __forceinline__ float ldu(const bf16* u, size_t row, int col) { return bf2f(u[row * UW + col]); }

__device__ __forceinline__ void phase_cmp(Frame& F0, int L) {
    Frame F = F0; asm volatile("" : "+v"(F.tid)); F.lane = F.tid & 63;
    const bf16* u = (const bf16*)(F.ws + WS_U);
    LAS float* xs = (LAS float*)(F.lds + F.wave * 16384);
    const int gw = F.bx * NWAVES + F.wave, NGW = F.G * NWAVES;
    for (int it = gw; it < NB * 512 * 2; it += NGW) {
        const int kv = it & 1, i = (it >> 1) & 511, b = it >> 10;
        float* outp = (float*)(F.ws + (kv ? WS_VCMP : WS_KCMP)) + ((size_t)b * 512 + i) * 64;
        if (i >= NCMP) { outp[F.lane] = 0.f; continue; }
        const float* pos = F.in[kv ? I_POS_V : I_POS_K] + (size_t)L * 2048;
        const float* w1 = F.in[kv ? I_CV1 : I_CK1] + (size_t)L * 2048 * 128;
        const float* w2 = F.in[kv ? I_CV2 : I_CK2] + (size_t)L * 128 * 64;
        const int col = U_NSA + (kv ? 320 : 256);
        for (int e = F.lane; e < 2048; e += 64) { const int tok = e >> 6, d = e & 63; xs[e] = ldu(u, (size_t)b * S + 16 * i + tok, col + d) + pos[e]; }
        LDS_WAIT();
        float h0 = 0.f, h1 = 0.f;
        for (int j = 0; j < 2048; ++j) { const float xv = xs[j]; h0 += xv * w1[(size_t)j * 128 + F.lane]; h1 += xv * w1[(size_t)j * 128 + 64 + F.lane]; }
        xs[2048 + F.lane] = fsilu(h0); xs[2048 + 64 + F.lane] = fsilu(h1);
        LDS_WAIT();
        float o = 0.f;
        for (int j = 0; j < 128; ++j) o += xs[2048 + j] * w2[j * 64 + F.lane];
        outp[F.lane] = o;
        LDS_WAIT();
    }
}

__device__ __forceinline__ void rwkv_seq(Frame& F, int L, int b, int h) {
    const bf16* u = (const bf16*)(F.ws + WS_U); bf16* bo = (bf16*)(F.ws + WS_BO);
    LAS float* Lw = (LAS float*)F.lds;
    LAS float* La = Lw + 2048; LAS float* Lb = La + 2048; LAS float* Lk = Lb + 2048; LAS float* Lr = Lk + 2048; LAS float* Lv = Lr + 2048; LAS float* Lg = Lv + 2048;
    LAS float* Ltw = Lg + 2048; LAS float* Lal = Ltw + 2048; LAS float* Lgl = Lal + 2048;
    LAS float* Lbon = Lgl + 4096;
    const float* mu = F.in[I_MU] + L * 1024; const float* w0 = F.in[I_W0] + L * 256 + h * 64; const float* a0 = F.in[I_A0] + L * 256 + h * 64;
    const float* wup = F.in[I_WUP] + (size_t)L * 64 * 256 + h * 64; const float* aup = F.in[I_AUP] + (size_t)L * 64 * 256 + h * 64; const float* gup = F.in[I_GUP] + (size_t)L * 128 * 256 + h * 64;
    const float* kkw = F.in[I_KK] + L * 256 + h * 64; const float* kaw = F.in[I_KA] + L * 256 + h * 64; const float* rkw = F.in[I_RK] + L * 256 + h * 64;
    const float* ng = F.in[I_RW_G] + L * 256 + h * 64; const float* nb = F.in[I_RW_B] + L * 256 + h * 64;
    float St[64];
#pragma unroll
    for (int k = 0; k < 64; ++k) St[k] = 0.f;
    const int lane = F.lane, wave = F.wave;
    for (int t0 = 0; t0 < S; t0 += 32) {
        for (int e = F.tid; e < 32 * 448; e += NTHR) {
            const int tok = e / 448, c = e % 448;
            int col; if (c < 64) col = h * 64 + c; else if (c < 128) col = 256 + h * 64 + (c - 64); else if (c < 192) col = 512 + h * 64 + (c - 128); else col = 768 + (c - 192);
            const int t = t0 + tok; const size_t row = (size_t)b * S + t;
            const float x1 = ldu(u, row, U_RW + col); const float x0 = t > 0 ? ldu(u, row - 1, U_RW + col) : 0.f;
            const float xv = x1 + mu[col] * (x0 - x1);
            if (c < 64) Lr[tok * 64 + c] = xv; else if (c < 128) Lk[tok * 64 + c - 64] = xv; else if (c < 192) Lv[tok * 64 + c - 128] = xv;
            else if (c < 256) Ltw[tok * 64 + c - 192] = tanhf(xv); else if (c < 320) Lal[tok * 64 + c - 256] = xv; else Lgl[tok * 128 + c - 320] = fsigmoid(xv);
        }
        __syncthreads();
        for (int q = 0; q < 4; ++q) { const int tok = wave * 4 + q;
            float zw = w0[lane], za = a0[lane], zg = 0.f;
            for (int j = 0; j < 64; ++j) { zw += Ltw[tok * 64 + j] * wup[j * 256 + lane]; za += Lal[tok * 64 + j] * aup[j * 256 + lane]; }
            for (int j = 0; j < 128; ++j) zg += Lgl[tok * 128 + j] * gup[j * 256 + lane];
            const float dec = __expf(-0.6065306597126334f * fsigmoid(zw)); const float ag = fsigmoid(za);
            const float kx = Lk[tok * 64 + lane], rx = Lr[tok * 64 + lane];
            float kk = kx * kkw[lane]; const float n2 = wave_sum(kk * kk); kk *= __builtin_amdgcn_rsqf(fmaxf(n2, 1e-24f));
            const float kp = kx * (1.0f + (ag - 1.0f) * kaw[lane]);
            const float bon = wave_sum(rx * kp * rkw[lane]);
            Lw[tok * 64 + lane] = dec; La[tok * 64 + lane] = -kk; Lb[tok * 64 + lane] = kk * ag; Lk[tok * 64 + lane] = kp; Lg[tok * 64 + lane] = zg;
            if (lane == 0) Lbon[tok] = bon;
        }
        __syncthreads();
        if (wave == 0) {
            for (int tok = 0; tok < 32; ++tok) {
                const float vl = Lv[tok * 64 + lane];
                float sa = 0.f;
#pragma unroll
                for (int k4 = 0; k4 < 16; ++k4) { const f32x4 a = *(const LAS f32x4*)(La + tok * 64 + 4 * k4);
                    sa += St[4 * k4] * a[0]; sa += St[4 * k4 + 1] * a[1]; sa += St[4 * k4 + 2] * a[2]; sa += St[4 * k4 + 3] * a[3];
                    if ((k4 & 7) == 7) asm volatile("" ::: "memory"); }
                float y = 0.f;
#pragma unroll
                for (int k4 = 0; k4 < 16; ++k4) { const f32x4 w = *(const LAS f32x4*)(Lw + tok * 64 + 4 * k4), bb = *(const LAS f32x4*)(Lb + tok * 64 + 4 * k4),
                                                      kp = *(const LAS f32x4*)(Lk + tok * 64 + 4 * k4), r = *(const LAS f32x4*)(Lr + tok * 64 + 4 * k4);
#pragma unroll
                    for (int j = 0; j < 4; ++j) { float s = St[4 * k4 + j] * w[j] + sa * bb[j] + vl * kp[j]; St[4 * k4 + j] = s; y += s * r[j]; }
                    if ((k4 & 1) == 1) asm volatile("" ::: "memory"); }
                const float mean = wave_sum(y) * (1.0f / 64.0f); const float dlt = y - mean; const float var = wave_sum(dlt * dlt) * (1.0f / 64.0f);
                const float yn = dlt * __builtin_amdgcn_rsqf(var + 64e-5f) * ng[lane] + nb[lane];
                const float o = (yn + Lbon[tok] * vl) * Lg[tok * 64 + lane];
                bo[((size_t)b * S + t0 + tok) * 1024 + 768 + h * 64 + lane] = (bf16)(cvt_pk_bf16(o, 0.f) & 0xffffu);
            }
        }
        __syncthreads();
    }
}

__device__ __forceinline__ void hgrn_seq(Frame& F, int L, int b, int h) {
    const bf16* u = (const bf16*)(F.ws + WS_U); bf16* bo = (bf16*)(F.ws + WS_BO);
    LAS float* Lq = (LAS float*)F.lds; LAS float* Lf = Lq + 2048; LAS float* Lk = Lf + 2048; LAS float* Lv = Lk + 2048; LAS float* Lo = Lv + 2048;
    const float* lbl = F.in[I_LB]; const float* ng = F.in[I_HG_NORM] + L * 256 + h * 64;
    float St[64];
#pragma unroll
    for (int k = 0; k < 64; ++k) St[k] = 0.f;
    const int lane = F.lane;
    for (int t0 = 0; t0 < S; t0 += 32) {
        for (int e = F.tid; e < 32 * 256; e += NTHR) {
            const int tok = e >> 8, c = e & 255, part = c >> 6, d = c & 63, ch = h * 64 + d;
            const float xv = ldu(u, (size_t)b * S + t0 + tok, U_HG + part * 256 + ch);
            if (part == 0) Lq[tok * 64 + d] = fsilu(xv);
            else if (part == 1) {
                const float l0 = lbl[ch], l1 = lbl[256 + ch]; const float mx = fmaxf(l0, l1); const float e0 = __expf(l0 - mx), e1 = __expf(l1 - mx);
                const float lb = (L == 0) ? 0.f : e1 / (e0 + e1);
                float f = lb + (1.0f - lb) * fsigmoid(xv); Lk[tok * 64 + d] = 1.0f - f; Lf[tok * 64 + d] = fmaxf(f, 1e-20f); }
            else if (part == 2) Lv[tok * 64 + d] = xv;
            else Lo[tok * 64 + d] = fsilu(xv);
        }
        __syncthreads();
        if (F.wave == 0) {
            for (int tok = 0; tok < 32; ++tok) {
                const float vl = Lv[tok * 64 + lane]; float o = 0.f;
#pragma unroll
                for (int k4 = 0; k4 < 16; ++k4) { const f32x4 f = *(const LAS f32x4*)(Lf + tok * 64 + 4 * k4), kk = *(const LAS f32x4*)(Lk + tok * 64 + 4 * k4), q = *(const LAS f32x4*)(Lq + tok * 64 + 4 * k4);
#pragma unroll
                    for (int j = 0; j < 4; ++j) { const float s = St[4 * k4 + j] * f[j] + kk[j] * vl; St[4 * k4 + j] = s; o += q[j] * s; }
                    if ((k4 & 3) == 3) asm volatile("" ::: "memory"); }
                const float ms = wave_sum(o * o) * (1.0f / 64.0f);
                const float y = o * __builtin_amdgcn_rsqf(ms + EPS) * ng[lane] * Lo[tok * 64 + lane];
                bo[((size_t)b * S + t0 + tok) * 1024 + 256 + h * 64 + lane] = (bf16)(cvt_pk_bf16(y, 0.f) & 0xffffu);
            }
        }
        __syncthreads();
    }
}

__device__ __forceinline__ void ret_seq(Frame& F, int L, int b, int h) {
    const bf16* u = (const bf16*)(F.ws + WS_U); bf16* bo = (bf16*)(F.ws + WS_BO); const float* rope = (const float*)(F.ws + WS_ROPE);
    LAS float* Lq = (LAS float*)F.lds; LAS float* Lk = Lq + 2048; LAS float* Lv = Lk + 2048; LAS float* Lg = Lv + 2048;
    const float* ng = F.in[I_RT_G] + L * 256 + h * 64; const float* nbv = F.in[I_RT_B] + L * 256 + h * 64;
    const float gamma = 1.0f - exp2f(-5.0f - (float)h);
    float St[64];
#pragma unroll
    for (int k = 0; k < 64; ++k) St[k] = 0.f;
    const int lane = F.lane;
    for (int t0 = 0; t0 < S; t0 += 32) {
        for (int e = F.tid; e < 32 * 128; e += NTHR) {
            const int tok = e >> 7, c = e & 127, part = c >> 5, j = c & 31; const int t = t0 + tok; const size_t row = (size_t)b * S + t;
            if (part < 2) { const int base = U_RT + part * 256 + h * 64; const float a1 = ldu(u, row, base + j), a2 = ldu(u, row, base + 32 + j);
                const float cs = rope[(t * 32 + j) * 2], sn = rope[(t * 32 + j) * 2 + 1]; const float sc = part == 1 ? 0.125f : 1.0f;
                LAS float* dst = part == 0 ? Lq : Lk; dst[tok * 64 + j] = (a1 * cs - a2 * sn) * sc; dst[tok * 64 + 32 + j] = (a1 * sn + a2 * cs) * sc; }
            else { const int d = (part - 2) * 32 + j; Lv[tok * 64 + d] = ldu(u, row, U_RT + 512 + h * 64 + d); Lg[tok * 64 + d] = fsilu(ldu(u, row, U_RT + 768 + h * 64 + d)); }
        }
        __syncthreads();
        if (F.wave == 0) {
            for (int tok = 0; tok < 32; ++tok) {
                const float vl = Lv[tok * 64 + lane]; float o = 0.f;
#pragma unroll
                for (int k4 = 0; k4 < 16; ++k4) { const f32x4 kk = *(const LAS f32x4*)(Lk + tok * 64 + 4 * k4), q = *(const LAS f32x4*)(Lq + tok * 64 + 4 * k4);
#pragma unroll
                    for (int j = 0; j < 4; ++j) { const float s = St[4 * k4 + j] * gamma + kk[j] * vl; St[4 * k4 + j] = s; o += q[j] * s; }
                    if ((k4 & 3) == 3) asm volatile("" ::: "memory"); }
                const float mean = wave_sum(o) * (1.0f / 64.0f); const float dlt = o - mean; const float var = wave_sum(dlt * dlt) * (1.0f / 64.0f);
                const float y = (dlt * __builtin_amdgcn_rsqf(var + 1e-5f) * ng[lane] + nbv[lane]) * Lg[tok * 64 + lane];
                bo[((size_t)b * S + t0 + tok) * 1024 + 512 + h * 64 + lane] = (bf16)(cvt_pk_bf16(y, 0.f) & 0xffffu);
            }
        }
        __syncthreads();
    }
}

struct OnlineSM { float m[4], l[4], o[4]; };
__device__ __forceinline__ void nsa_batch(const bf16* kbase, const bf16* vbase, bool valid, int nkeys, LAS float* Lq, LAS float* Lp, OnlineSM& sm, int lane) {
    float s[4] = {0.f, 0.f, 0.f, 0.f};
    if (valid) { const u32x4* kr = (const u32x4*)(kbase + (size_t)lane * UW);
#pragma unroll 1
        for (int c8 = 0; c8 < 8; ++c8) { const u32x4 w = kr[c8]; f32x4 a, bb; unpack8(w, a, bb);
#pragma unroll
            for (int hh = 0; hh < 4; ++hh) { const f32x4 q0 = *(const LAS f32x4*)(Lq + hh * 64 + c8 * 8), q1 = *(const LAS f32x4*)(Lq + hh * 64 + c8 * 8 + 4);
                s[hh] += (a[0] * q0[0] + a[1] * q0[1]) + (a[2] * q0[2] + a[3] * q0[3]) + (bb[0] * q1[0] + bb[1] * q1[1]) + (bb[2] * q1[2] + bb[3] * q1[3]); }
            asm volatile("" ::: "memory"); } }
    float scale[4];
#pragma unroll
    for (int hh = 0; hh < 4; ++hh) { const float sv = valid ? s[hh] : -1e30f; const float mx = fmaxf(sm.m[hh], wave_max(sv));
        const float p = valid ? __expf(sv - mx) : 0.f; scale[hh] = __expf(sm.m[hh] - mx); sm.m[hh] = mx; sm.l[hh] = sm.l[hh] * scale[hh] + wave_sum(p); Lp[hh * 64 + lane] = p; }
    LDS_WAIT();
#pragma unroll
    for (int hh = 0; hh < 4; ++hh) sm.o[hh] *= scale[hh];
    for (int k = 0; k < nkeys; ++k) { const float vv = bf2f(vbase[(size_t)k * UW + lane]);
#pragma unroll
        for (int hh = 0; hh < 4; ++hh) sm.o[hh] += Lp[hh * 64 + k] * vv; }
    LDS_WAIT();
}
__device__ __forceinline__ void nsa_query(Frame& F, int b, int t, LAS float* Lq, LAS float* Lc, LAS float* Lp) {
    const bf16* u = (const bf16*)(F.ws + WS_U); bf16* bo = (bf16*)(F.ws + WS_BO);
    const float* kcmp = (const float*)(F.ws + WS_KCMP) + (size_t)b * 512 * 64; const float* vcmp = (const float*)(F.ws + WS_VCMP) + (size_t)b * 512 * 64;
    const int lane = F.lane; const size_t row = (size_t)b * S + t;
#pragma unroll
    for (int hh = 0; hh < 4; ++hh) Lq[hh * 64 + lane] = ldu(u, row, U_NSA + hh * 64 + lane) * 0.125f;
    LDS_WAIT();
    const int nvis = t >= 31 ? ((t - 31) >> 4) + 1 : 0;
    float ocmp[4] = {0.f, 0.f, 0.f, 0.f};
    if (nvis > 0) {
        float mx[4] = {-1e30f, -1e30f, -1e30f, -1e30f};
        for (int i0 = 0; i0 < nvis; i0 += 64) { const int i = i0 + lane; float s[4] = {0.f, 0.f, 0.f, 0.f};
            if (i < nvis) { const f32x4* kr = (const f32x4*)(kcmp + (size_t)i * 64);
#pragma unroll 1
                for (int c4 = 0; c4 < 16; ++c4) { const f32x4 kk = kr[c4];
#pragma unroll
                    for (int hh = 0; hh < 4; ++hh) { const f32x4 q = *(const LAS f32x4*)(Lq + hh * 64 + c4 * 4); s[hh] += (kk[0] * q[0] + kk[1] * q[1]) + (kk[2] * q[2] + kk[3] * q[3]); }
                    if ((c4 & 3) == 3) asm volatile("" ::: "memory"); } }
#pragma unroll
            for (int hh = 0; hh < 4; ++hh) { if (i < nvis) { Lc[hh * 512 + i] = s[hh]; mx[hh] = fmaxf(mx[hh], s[hh]); } } }
        float lsum[4];
#pragma unroll
        for (int hh = 0; hh < 4; ++hh) { mx[hh] = wave_max(mx[hh]); lsum[hh] = 0.f; }
        LDS_WAIT();
        for (int i0 = 0; i0 < nvis; i0 += 64) { const int i = i0 + lane;
#pragma unroll
            for (int hh = 0; hh < 4; ++hh) if (i < nvis) { const float p = __expf(Lc[hh * 512 + i] - mx[hh]); Lc[hh * 512 + i] = p; lsum[hh] += p; } }
#pragma unroll
        for (int hh = 0; hh < 4; ++hh) lsum[hh] = 1.0f / wave_sum(lsum[hh]);
        LDS_WAIT();
        for (int i0 = 0; i0 < nvis; i0 += 64) { const int i = i0 + lane;
#pragma unroll
            for (int hh = 0; hh < 4; ++hh) if (i < nvis) Lc[hh * 512 + i] *= lsum[hh]; }
        LDS_WAIT();
        for (int i = 0; i < nvis; ++i) { const float vv = vcmp[(size_t)i * 64 + lane];
#pragma unroll
            for (int hh = 0; hh < 4; ++hh) ocmp[hh] += Lc[hh * 512 + i] * vv; }
    }
    const int cur = t >> 6;
    float sc0, sc1;
    { float imp[2];
#pragma unroll
      for (int q = 0; q < 2; ++q) { const int j = lane + 64 * q; float a = 0.f;
          for (int i = 4 * j - 1; i <= 4 * j + 3; ++i) if (i >= 0 && i < nvis) a += (Lc[i] + Lc[512 + i]) + (Lc[1024 + i] + Lc[1536 + i]);
          const bool forced = (j == 0) || (j == cur) || (j == cur - 1); const bool allowed = j <= cur;
          imp[q] = forced ? 1e30f : (allowed ? a : -1e30f); }
      sc0 = imp[0]; sc1 = imp[1]; }
    unsigned long long sel_lo = 0ull, sel_hi = 0ull;
    for (int it = 0; it < 16; ++it) {
        const float best = wave_max(fmaxf(sc0, sc1));
        const unsigned long long m0 = __ballot(sc0 == best), m1 = __ballot(sc1 == best);
        int idx; if (m0) idx = __builtin_ctzll(m0); else idx = 64 + __builtin_ctzll(m1);
        if (idx < 64) { sel_lo |= 1ull << idx; if (lane == idx) sc0 = -3e38f; } else { sel_hi |= 1ull << (idx - 64); if (lane == idx - 64) sc1 = -3e38f; }
    }
    OnlineSM sm;
#pragma unroll
    for (int hh = 0; hh < 4; ++hh) { sm.m[hh] = -1e30f; sm.l[hh] = 0.f; sm.o[hh] = 0.f; }
    for (int j = 0; j <= cur; ++j) { const bool on = j < 64 ? ((sel_lo >> j) & 1ull) : ((sel_hi >> (j - 64)) & 1ull); if (!on) continue;
        const int kp0 = j * 64; const bool valid = kp0 + lane <= t; const int nk = (t - kp0 + 1) < 64 ? (t - kp0 + 1) : 64;
        nsa_batch(u + ((size_t)b * S + kp0) * UW + U_NSA + 384, u + ((size_t)b * S + kp0) * UW + U_NSA + 448, valid, nk, Lq, Lp, sm, lane); }
    float osel[4];
#pragma unroll
    for (int hh = 0; hh < 4; ++hh) osel[hh] = sm.o[hh] / sm.l[hh];
#pragma unroll
    for (int hh = 0; hh < 4; ++hh) { sm.m[hh] = -1e30f; sm.l[hh] = 0.f; sm.o[hh] = 0.f; }
    { const int lo = t - 511 > 0 ? t - 511 : 0;
      for (int kp0 = lo; kp0 <= t; kp0 += 64) { const bool valid = kp0 + lane <= t; const int nk = (t - kp0 + 1) < 64 ? (t - kp0 + 1) : 64;
        nsa_batch(u + ((size_t)b * S + kp0) * UW + U_NSA + 512, u + ((size_t)b * S + kp0) * UW + U_NSA + 576, valid, nk, Lq, Lp, sm, lane); } }
#pragma unroll
    for (int hh = 0; hh < 4; ++hh) {
        const float g0 = fsigmoid(ldu(u, row, U_NSA + 640 + hh)), g1 = fsigmoid(ldu(u, row, U_NSA + 644 + hh)), g2 = fsigmoid(ldu(u, row, U_NSA + 648 + hh));
        const float o = g0 * ocmp[hh] + g1 * osel[hh] + g2 * (sm.o[hh] / sm.l[hh]);
        bo[row * 1024 + hh * 64 + lane] = (bf16)(cvt_pk_bf16(o, 0.f) & 0xffffu);
    }
    LDS_WAIT();
}

__device__ __forceinline__ void phase_mix(Frame& F0, int L) {
    Frame F = F0; asm volatile("" : "+v"(F.tid)); F.lane = F.tid & 63;
    if (F.bx < 32) {
#ifndef SK_RWKV
        rwkv_seq(F, L, F.bx >> 2, F.bx & 3);
#endif
    } else if (F.bx < 64) {
#ifndef SK_HGRN
        hgrn_seq(F, L, (F.bx - 32) >> 2, (F.bx - 32) & 3);
#endif
    } else if (F.bx < 96) {
#ifndef SK_RET
        ret_seq(F, L, (F.bx - 64) >> 2, (F.bx - 64) & 3);
#endif
    } else {
#ifndef SK_NSA
        LAS float* Lq = (LAS float*)(F.lds + F.wave * 16384); LAS float* Lc = Lq + 256; LAS float* Lp = Lc + 2048;
        const int nw = (F.G - 96) * NWAVES, w = (F.bx - 96) * NWAVES + F.wave;
        for (int q = w; q < T; q += nw) nsa_query(F, q >> 13, q & (S - 1), Lq, Lc, Lp);
#endif
    }
}

__device__ __forceinline__ void phase_final(Frame& F0, const float* ss) {
    Frame F = F0; asm volatile("" : "+v"(F.tid)); F.lane = F.tid & 63;
    const float* g = F.in[I_NORM_FINAL]; const int gw = F.bx * NWAVES + F.wave, NGW = F.G * NWAVES;
    for (int r = gw; r < T; r += NGW) { const float rs = rstd_of(ss, r); f32x4* hr = (f32x4*)(F.out + (size_t)r * D) + F.lane;
#pragma unroll
        for (int j = 0; j < 4; ++j) { f32x4 v = hr[64 * j]; const f32x4 gg = *((const f32x4*)g + F.lane + 64 * j); v = v * rs * gg; hr[64 * j] = v; } }
}

constexpr int PH_PER_LAYER = 8, N_PHASES = 1 + NL * PH_PER_LAYER + 1;
__global__ void __launch_bounds__(NTHR, 2) mega_fwd(Args args) {
    extern __shared__ __attribute__((aligned(16))) unsigned char lds_raw[];
    Frame F; F.lds = (LAS unsigned char*)lds_raw; F.tid = threadIdx.x; F.lane = F.tid & 63; F.wave = __builtin_amdgcn_readfirstlane(F.tid >> 6); F.G = gridDim.x; F.bx = blockIdx.x;
    F.in = args.in; F.out = args.out; F.ws = args.ws;
    volatile LAS unsigned* MISC = (volatile LAS unsigned*)(F.lds + MISC_OFF);
    if (F.tid < 32) MISC[F.tid] = 0u;
    __syncthreads();
    unsigned* ctl = (unsigned*)(F.ws + WS_CTL);
    XcdBarrier bar; bar.bar = ctl + CW_BAR; bar.x = 0; bar.st = nullptr;
    if (MK_N_LAUNCHES == 1) bar = xcd_barrier_post(ctl + CW_BAR, MISC + 8);
    const int lo = args.ph_lo, hi = args.ph_hi;
#define IN(k) (lo <= (k) && (k) < hi)
#define SEAM(k) do { if (IN(k) && IN((k) + 1)) xcd_barrier(bar); } while (0)
    float* ssb = (float*)ctl + CW_SS;
    LAS unsigned char* ring = F.lds + RING_OFF;

    #ifndef SK_PRO
    if (IN(0)) { phase_prologue(F); }
#endif
    SEAM(0);

    for (int L = 0; L < NL; ++L) {
        const int pb = 1 + L * PH_PER_LAYER;
        unsigned char* wl = F.ws + WS_W + (size_t)L * WL_STRIDE;
        bf16* hb_cur = (bf16*)(F.ws + ((L & 1) ? WS_HBB : WS_HBA)); bf16* hb_oth = (bf16*)(F.ws + ((L & 1) ? WS_HBA : WS_HBB));
        const float* ss_mix = ssb + (size_t)(3 * L) * T; float* ss_ffn = ssb + (size_t)(3 * L + 1) * T; float* ss_ple = ssb + (size_t)(3 * L + 2) * T; float* ss_next = ssb + (size_t)(3 * L + 3) * T;
        const float* h_in = (L == 0) ? F.in[I_X] : F.out;
#ifndef SK_G1
        if (IN(pb + 0)) { PlainSched Sd{(const char*)hb_cur, (const char*)(wl + WL_IN), D * 2, D * 2, D / 64, T / 256, UW / 256, F.G, F.bx};
            EpiScaleBf16 E{(bf16*)(F.ws + WS_U), UW, ss_mix}; pg8::gemm_phase(ring, Sd, E); }
#endif
        SEAM(pb + 0);
#ifndef SK_CMP
        if (IN(pb + 1)) phase_cmp(F, L);
#endif
        SEAM(pb + 1);
#ifndef SK_MIX
        if (IN(pb + 2)) phase_mix(F, L);
#endif
        SEAM(pb + 2);
#ifndef SK_G2
        if (IN(pb + 3)) { PairSched Sd{(const char*)hb_cur, (const char*)(wl + WL_G), D * 2, D * 2, D / 64, (size_t)D * D * 2,
                                        (const char*)(F.ws + WS_BO), (const char*)(wl + WL_B), 1024 * 2, MW * 2, MW / 64, (size_t)MW * 2, (size_t)D * MW * 2, 4, T / 256, D / 256, F.G, F.bx};
            u32x4* scr = (u32x4*)(F.ws + WS_SCR + (size_t)F.bx * 262144);
            EpiMerge E{scr, scr + 8192, (bf16*)(F.ws + WS_MERGED), ss_mix, F.in[I_BGATE] + (size_t)L * 4 * D, 4}; pg8::gemm_phase(ring, Sd, E); }
#endif
        SEAM(pb + 3);
#ifndef SK_G3
        if (IN(pb + 4)) { PlainSched Sd{(const char*)(F.ws + WS_MERGED), (const char*)(wl + WL_OUT), D * 2, D * 2, D / 64, T / 256, D / 256, F.G, F.bx};
            EpiResidual E{h_in, F.out, hb_cur, ss_ffn}; pg8::gemm_phase(ring, Sd, E); }
#endif
        SEAM(pb + 4);
#ifndef SK_G4
        if (IN(pb + 5)) { PlainSched Sd{(const char*)hb_cur, (const char*)(wl + WL_FF), D * 2, D * 2, D / 64, T / 256, (2 * DFF) / 256, F.G, F.bx};
            EpiSwiGLU E{(bf16*)(F.ws + WS_FFH), ss_ffn}; pg8::gemm_phase(ring, Sd, E); }
#endif
        SEAM(pb + 5);
#ifndef SK_G5
        if (IN(pb + 6)) { PlainSched Sd{(const char*)(F.ws + WS_FFH), (const char*)(wl + WL_DN), DFF * 2, DFF * 2, DFF / 64, T / 256, D / 256, F.G, F.bx};
            EpiResidual E{F.out, F.out, hb_cur, ss_ple}; pg8::gemm_phase(ring, Sd, E); }
#endif
        SEAM(pb + 6);
#ifndef SK_G6
        if (IN(pb + 7)) { PairSched Sd{(const char*)hb_cur, (const char*)(wl + WL_PG), D * 2, D * 2, D / 64, 0,
                                        (const char*)(F.ws + WS_PB) + (size_t)L * T * PLE * 2, (const char*)(wl + WL_PP), PLE * 2, PLE * 2, PLE / 64, 0, 0, 1, T / 256, D / 256, F.G, F.bx};
            u32x4* scr = (u32x4*)(F.ws + WS_SCR + (size_t)F.bx * 262144);
            EpiPle E{scr, F.out, hb_oth, ss_ple, ss_next}; pg8::gemm_phase(ring, Sd, E); }
#endif
        SEAM(pb + 7);
    }
#ifndef SK_FIN
    if (IN(N_PHASES - 1)) phase_final(F, ssb + (size_t)(3 * NL) * T);
#endif
#undef IN
#undef SEAM
}

extern "C" void kernel_launch(void* const* d_in, const int* in_sizes, int n_in, void* d_out, int out_size, void* d_ws, size_t ws_size, hipStream_t stream) {
    static int grid = 0;
    if (grid == 0) {
        if (n_in != 37 || in_sizes[0] != T * D || out_size != T * D || ws_size < WS_END) { fprintf(stderr, "kernel_launch: unexpected shapes (n_in %d, ws %zu)\n", n_in, ws_size); grid = -1; return; }
        int dev = 0, cus = 0, per_cu = 0;
        if (hipGetDevice(&dev) != hipSuccess || hipDeviceGetAttribute(&cus, hipDeviceAttributeMultiprocessorCount, dev) != hipSuccess) { grid = -1; return; }
        if (hipFuncSetAttribute((const void*)mega_fwd, hipFuncAttributeMaxDynamicSharedMemorySize, LDS_BYTES) != hipSuccess) { fprintf(stderr, "kernel_launch: hipFuncSetAttribute failed\n"); grid = -1; return; }
        if (hipOccupancyMaxActiveBlocksPerMultiprocessor(&per_cu, (const void*)mega_fwd, NTHR, LDS_BYTES) != hipSuccess || per_cu < 1) { fprintf(stderr, "kernel_launch: occupancy query says %d\n", per_cu); }
        (void)hipGetLastError();
        grid = cus;
    }
    if (grid < 0) return;
    hipMemsetAsync((char*)d_ws + WS_CTL, 0, CTL_BYTES, stream);
    Args a{};
    for (int i = 0; i < 37; ++i) a.in[i] = (const float*)d_in[i];
    a.out = (float*)d_out; a.ws = (unsigned char*)d_ws;
    if (MK_N_LAUNCHES == 1) { a.ph_lo = 0; a.ph_hi = N_PHASES; hipLaunchKernelGGL(mega_fwd, dim3(grid), dim3(NTHR), LDS_BYTES, stream, a); }
    else for (int p = 0; p < N_PHASES; ++p) { a.ph_lo = p; a.ph_hi = p + 1; hipLaunchKernelGGL(mega_fwd, dim3(grid), dim3(NTHR), LDS_BYTES, stream, a); }
}
```

```cpp
#include <hip/hip_runtime.h>
#include <cstdio>
#include <cstdint>

#ifndef MK_N_LAUNCHES
#define MK_N_LAUNCHES 1
#endif

#define LAS __attribute__((address_space(3)))
#define GAS __attribute__((address_space(1)))
typedef unsigned short bf16;
typedef short bf16x8 __attribute__((ext_vector_type(8)));
typedef float f32x4 __attribute__((ext_vector_type(4)));
typedef float f32x16 __attribute__((ext_vector_type(16)));
typedef unsigned u32x4 __attribute__((ext_vector_type(4)));
typedef unsigned u32x2 __attribute__((ext_vector_type(2)));

constexpr int D = 1024, NB = 8, S = 8192, T = NB * S, NL = 2;
constexpr int NH = 4, HD = 64, MW = 256, DFF = 2816, PLE = 256;
constexpr int DIN = 3724, UW = 3840;
constexpr int U_NSA = 0, U_HG = 768, U_RT = 1792, U_RW = 2816;
constexpr int NCMP = 511, NSEL = 128;
constexpr float EPS = 1e-6f;

constexpr size_t MiB = 1u << 20;
constexpr size_t WS_CTL = 0, CTL_BYTES = 4 * MiB;
constexpr size_t WS_W = 4 * MiB;
constexpr size_t WL_IN = 0, WL_G = 8 * MiB, WL_B = 16 * MiB, WL_OUT = 18 * MiB, WL_FF = 20 * MiB, WL_DN = 31 * MiB, WL_PG = 37 * MiB, WL_PP = 39 * MiB, WL_STRIDE = 40 * MiB;
constexpr size_t WS_MISC = 84 * MiB;
constexpr size_t WS_ROPE = WS_MISC, WS_KCMP = WS_MISC + 2 * MiB, WS_VCMP = WS_MISC + 3 * MiB;
constexpr size_t WS_HBA = 88 * MiB, WS_HBB = 216 * MiB;
constexpr size_t WS_BO = 344 * MiB;
constexpr size_t WS_U = 472 * MiB;
constexpr size_t WS_MERGED = WS_U, WS_SCR = WS_U + 416 * MiB;
constexpr size_t WS_FFH = WS_U;
constexpr size_t WS_PB = 952 * MiB;
constexpr size_t WS_END = 1024 * MiB;
constexpr int CW_BAR = 4096;
constexpr int CW_SS = 65536;
constexpr int NSS = 7;
static_assert((size_t)(CW_SS + NSS * T) * 4 <= CTL_BYTES, "ctl");

#define LDS_WAIT() asm volatile("s_waitcnt lgkmcnt(0)" ::: "memory")
#define VM_WAIT() asm volatile("s_waitcnt vmcnt(0)" ::: "memory")
__device__ __forceinline__ unsigned cvt_pk_bf16(float lo, float hi) { unsigned r; asm volatile("v_cvt_pk_bf16_f32 %0, %1, %2" : "=v"(r) : "v"(lo), "v"(hi)); return r; }
__device__ __forceinline__ float bf2f(unsigned short b) { return __builtin_bit_cast(float, ((unsigned)b) << 16); }
__device__ __forceinline__ float bflo(unsigned w) { return __builtin_bit_cast(float, w << 16); }
__device__ __forceinline__ float bfhi(unsigned w) { return __builtin_bit_cast(float, w & 0xffff0000u); }
__device__ __forceinline__ float fsigmoid(float z) { return __builtin_amdgcn_rcpf(1.0f + __builtin_amdgcn_exp2f(-1.44269504f * z)); }
__device__ __forceinline__ float fsilu(float z) { return z * fsigmoid(z); }
__device__ __forceinline__ float wave_sum(float v) {
#pragma unroll
    for (int o = 1; o < 64; o <<= 1) v += __shfl_xor(v, o);
    return v;
}
__device__ __forceinline__ float wave_max(float v) {
#pragma unroll
    for (int o = 1; o < 64; o <<= 1) v = fmaxf(v, __shfl_xor(v, o));
    return v;
}

#define XB_TMO      128
#define XB_XCNT(j)  (256  + 64 * (j))
#define XB_XSUB(j)  (1280 + 64 * (j))
#define XB_XGEN(j)  (2304 + 64 * (j))
#define XB_TOP      3328
#define XB_TOPGEN   3392
#define XCD_BAR_WORDS 3456
#define XB_SPIN_CAP (1u << 24)
__device__ __forceinline__ unsigned xb_ld(unsigned* p)              { return __hip_atomic_load(p, __ATOMIC_RELAXED, __HIP_MEMORY_SCOPE_AGENT); }
__device__ __forceinline__ unsigned xb_add(unsigned* p, unsigned v) { return __hip_atomic_fetch_add(p, v, __ATOMIC_RELAXED, __HIP_MEMORY_SCOPE_AGENT); }
__device__ __forceinline__ unsigned xb_xcc_id() { return (unsigned)__builtin_amdgcn_s_getreg((3 << 11) | 20) & 0xFu; }
#define XB_SPIN(cond, bar) do { unsigned _sp = 0; while (cond) { __builtin_amdgcn_s_sleep(1); \
    if ((++_sp & 255u) == 0u) { if (xb_ld(&(bar)[XB_TMO])) break; if (_sp > XB_SPIN_CAP) { atomicAdd(&(bar)[XB_TMO], 1u); break; } } } } while (0)
struct XcdBarrier { unsigned* bar; unsigned x; volatile LAS unsigned* st; };
__device__ __forceinline__ XcdBarrier xcd_barrier_post(unsigned* bar, volatile LAS unsigned* st) {
    XcdBarrier b; b.bar = bar; b.x = xb_xcc_id(); b.st = st;
    if (threadIdx.x == 0) (void)xb_add(&bar[XB_XCNT(b.x)], 1u);
    return b;
}
__device__ __forceinline__ void xcd_barrier_complete(unsigned* bar, unsigned x, unsigned& nloc, unsigned& nx) {
    const unsigned G = gridDim.x * gridDim.y * gridDim.z;
    unsigned sum, cnt, mine, sp = 0u;
    for (;;) {
        sum = 0u; cnt = 0u; mine = 0u;
#pragma unroll
        for (unsigned j = 0; j < 16; ++j) { const unsigned c = xb_ld(&bar[XB_XCNT(j)]); sum += c; cnt += (c > 0u) ? 1u : 0u; mine = (j == x) ? c : mine; }
        if (sum == G) break;
        __builtin_amdgcn_s_sleep(1);
        if ((++sp & 255u) == 0u) { if (xb_ld(&bar[XB_TMO])) break; if (sp > XB_SPIN_CAP) { atomicAdd(&bar[XB_TMO], 1u); break; } }
    }
    nloc = mine > 0u ? mine : 1u; nx = cnt > 0u ? cnt : 1u;
}
__device__ __forceinline__ void xcd_barrier(const XcdBarrier& b) {
    asm volatile("s_waitcnt vmcnt(0)" ::: "memory");
    __syncthreads();
    if (threadIdx.x == 0) {
        unsigned* bar = b.bar;
        __builtin_amdgcn_s_waitcnt(0);
        unsigned nloc = b.st[0], nx = b.st[1];
        if (nloc == 0u) { xcd_barrier_complete(bar, b.x, nloc, nx); b.st[0] = nloc; b.st[1] = nx; }
        const unsigned old = xb_add(&bar[XB_XSUB(b.x)], 1u);
        const unsigned gen = old / nloc;
        if (old + 1u == (gen + 1u) * nloc) {
            __builtin_amdgcn_fence(__ATOMIC_RELEASE, "agent");
            asm volatile("s_waitcnt vmcnt(0)" ::: "memory");
            const unsigned og = xb_add(&bar[XB_TOP], 1u);
            const unsigned tg = og / nx;
            if (og + 1u == (tg + 1u) * nx) xb_add(&bar[XB_TOPGEN], 1u);
            else XB_SPIN(xb_ld(&bar[XB_TOPGEN]) == tg, bar);
            __builtin_amdgcn_fence(__ATOMIC_ACQUIRE, "agent");
            xb_add(&bar[XB_XGEN(b.x)], 1u);
            asm volatile("s_waitcnt vmcnt(0)" ::: "memory");
        } else {
            XB_SPIN(xb_ld(&bar[XB_XGEN(b.x)]) == gen, bar);
            __builtin_amdgcn_fence(__ATOMIC_ACQUIRE, "agent");
            asm volatile("s_waitcnt vmcnt(0)" ::: "memory");
        }
    }
    __syncthreads();
}

namespace pg8 {
constexpr int BM = 256, BK = 64, HALF = 128, HTB = HALF * BK * 2, STAGE_BYTES = 8 * HTB, NXCD = 8, WGM = 8;
__host__ __device__ __forceinline__ int lds_byte(int r, int c) { const int st = (r >> 4) * 2 + (c >> 5), rr = r & 15, cc = c & 31, ob = rr * 64 + cc * 2; return st * 1024 + (ob ^ (((ob >> 9) & 1) << 5)); }
__host__ __device__ __forceinline__ void stage_rc(int b, int& R, int& C) { const int st = b / 1024, sb = b % 1024, swz = sb ^ (((sb >> 9) & 1) << 5); R = (st >> 1) * 16 + swz / 64; C = (st & 1) * 32 + (swz % 64) / 2; }
__host__ __device__ __forceinline__ int perm32(int rho) { const int n = rho >> 4, i = rho & 15; return 8 * (i >> 2) + 4 * n + (i & 3); }

struct GU { const char* A; const char* B; unsigned lda, ldb; int nt; int pm, pn, kind, mi; };

__device__ __forceinline__ bool tile_of(int L, int nM, int nN, int& pm, int& pn) {
    const int nwg = nM * nN; if (L >= nwg) return false;
    int wgid = L; { const int q = nwg / NXCD, r = nwg % NXCD, xcd = wgid % NXCD, off = wgid / NXCD; wgid = (xcd < r ? xcd * (q + 1) : r * (q + 1) + (xcd - r) * q) + off; }
    const int nig = WGM * nN, gid = wgid / nig, fm = gid * WGM, gsz = (nM - fm) < WGM ? (nM - fm) : WGM;
    pm = fm + ((wgid % nig) % gsz); pn = (wgid % nig) / gsz; return true;
}

template <class Epi, class Sched>
__device__ __forceinline__ void gemm_phase(LAS unsigned char* lds, const Sched& S, const Epi& E) {
    int tid = threadIdx.x; asm volatile("" : "+v"(tid));
    const int wid = __builtin_amdgcn_readfirstlane(tid >> 6), lane = tid & 63, wr = wid >> 2, wc = wid & 3, fr = lane & 15, fq = lane >> 4;
    unsigned RA[2], RB[2], C2[2];
#pragma unroll
    for (int i = 0; i < 2; ++i) { int R, C; stage_rc(tid * 16 + i * 8192, R, C); RA[i] = (unsigned)R; RB[i] = (unsigned)((R & ~31) + perm32(R & 31)); C2[i] = (unsigned)C * 2u; }
    const size_t kstep = (size_t)(BK * 2);
    const unsigned ldsw = (unsigned)wid * 1024u;
    const int aoff = lds_byte(wr * 64 + fr, fq * 8), boff = lds_byte(wc * 32 + fr, fq * 8);
#define PG8_SA(b, h) (((b) * 2 + (h)) * HTB)
#define PG8_SB(b, h) ((4 + (b) * 2 + (h)) * HTB)
#define PG8_STAGE(bufoff, gbase, ld, RR) do { _Pragma("unroll") for (int _i = 0; _i < 2; ++_i) \
        __builtin_amdgcn_global_load_lds((const unsigned*)((const char*)(gbase) + (RR[_i] * (ld) + C2[_i])), (LAS unsigned*)(lds + (bufoff) + ldsw + _i * 8192), 16, 0, 0); } while (0)
#define PG8_LDA(dst, b, h) do { _Pragma("unroll") for (int m = 0; m < 4; ++m) _Pragma("unroll") for (int k = 0; k < 2; ++k) dst[m][k] = *(const LAS bf16x8*)(lds + PG8_SA(b, h) + aoff + m * 2048 + k * 1024); } while (0)
#define PG8_LDB(dst, b, h) do { _Pragma("unroll") for (int n = 0; n < 2; ++n) _Pragma("unroll") for (int k = 0; k < 2; ++k) dst[n][k] = *(const LAS bf16x8*)(lds + PG8_SB(b, h) + boff + n * 2048 + k * 1024); } while (0)
#define PG8_MMA(ai, bj, At, Bt) do { __builtin_amdgcn_s_setprio(1); _Pragma("unroll") for (int m = 0; m < 4; ++m) _Pragma("unroll") for (int n = 0; n < 2; ++n) _Pragma("unroll") for (int k = 0; k < 2; ++k) \
        acc[ai][bj][m][n] = __builtin_amdgcn_mfma_f32_16x16x32_bf16(Bt[n][k], At[m][k], acc[ai][bj][m][n], 0, 0, 0); __builtin_amdgcn_s_setprio(0); } while (0)
#define PG8_WAIT_V(n) asm volatile("s_waitcnt vmcnt(" #n ")" ::: "memory")
#define PG8_WAIT_L(n) asm volatile("s_waitcnt lgkmcnt(" #n ")" ::: "memory")
#define PG8_BAR __builtin_amdgcn_s_barrier()
#define PG8_SCHED __builtin_amdgcn_sched_barrier(0)
    GU cur, nxt; int ui = 0;
    if (!S.next(0, cur)) return;
    f32x4 acc[2][2][4][2];
#pragma unroll
    for (int a = 0; a < 2; ++a)
#pragma unroll
        for (int b = 0; b < 2; ++b)
#pragma unroll
            for (int m = 0; m < 4; ++m)
#pragma unroll
                for (int n = 0; n < 2; ++n) acc[a][b][m][n] = (f32x4){0.f, 0.f, 0.f, 0.f};
    bf16x8 At[4][2], B0[2][2], B1[2][2];
    const char* cA = cur.A; const char* cB = cur.B; unsigned clda = cur.lda, cldb = cur.ldb;
    PG8_STAGE(PG8_SB(0, 0), cB, cldb, RB); PG8_STAGE(PG8_SB(0, 1), cB + (size_t)HALF * cldb, cldb, RB); PG8_STAGE(PG8_SA(0, 0), cA, clda, RA); PG8_STAGE(PG8_SA(0, 1), cA + (size_t)HALF * clda, clda, RA);
    if (wr == 1) PG8_BAR;
    PG8_WAIT_V(2); PG8_BAR;
    PG8_STAGE(PG8_SB(1, 0), cB + kstep, cldb, RB); PG8_STAGE(PG8_SA(1, 0), cA + kstep, clda, RA); PG8_STAGE(PG8_SB(1, 1), cB + (size_t)HALF * cldb + kstep, cldb, RB);
    PG8_WAIT_V(6); PG8_BAR;
    for (;;) {
        const bool has_next = S.next(ui + 1, nxt);
        const char* nA = has_next ? nxt.A : cA; const char* nB = has_next ? nxt.B : cB;
        const unsigned nlda = has_next ? nxt.lda : clda, nldb = has_next ? nxt.ldb : cldb;
        const int nt = cur.nt;
        for (int t = 0; t < nt; t += 2) {
            const bool last = (t == nt - 2);
            const char* a1 = cA + (size_t)(t + 1) * kstep;
            const char* a2 = last ? nA : cA + (size_t)(t + 2) * kstep; const char* b2 = last ? nB : cB + (size_t)(t + 2) * kstep;
            const unsigned lda2 = last ? nlda : clda, ldb2 = last ? nldb : cldb;
            const char* a3 = a2 + kstep; const char* b3 = b2 + kstep;
            PG8_LDB(B0, 0, 0); PG8_LDB(B1, 0, 1); PG8_SCHED; PG8_LDA(At, 0, 0); PG8_STAGE(PG8_SA(1, 1), a1 + (size_t)HALF * clda, clda, RA);
            PG8_WAIT_V(8); PG8_WAIT_L(0); PG8_BAR; PG8_MMA(0, 0, At, B0); PG8_MMA(0, 1, At, B1); PG8_BAR; PG8_SCHED;
            PG8_LDA(At, 0, 1); PG8_STAGE(PG8_SB(0, 0), b2, ldb2, RB); PG8_STAGE(PG8_SB(0, 1), b2 + (size_t)HALF * ldb2, ldb2, RB); PG8_STAGE(PG8_SA(0, 0), a2, lda2, RA);
            PG8_WAIT_V(8); PG8_WAIT_L(0); PG8_BAR; PG8_MMA(1, 0, At, B0); PG8_MMA(1, 1, At, B1); PG8_BAR; PG8_SCHED;
            PG8_LDB(B0, 1, 0); PG8_LDB(B1, 1, 1); PG8_SCHED; PG8_LDA(At, 1, 0); PG8_STAGE(PG8_SA(0, 1), a2 + (size_t)HALF * lda2, lda2, RA);
            PG8_WAIT_V(8); PG8_WAIT_L(0); PG8_BAR; PG8_MMA(0, 0, At, B0); PG8_MMA(0, 1, At, B1); PG8_BAR; PG8_SCHED;
            PG8_LDA(At, 1, 1); PG8_STAGE(PG8_SB(1, 0), b3, ldb2, RB); PG8_STAGE(PG8_SB(1, 1), b3 + (size_t)HALF * ldb2, ldb2, RB); PG8_STAGE(PG8_SA(1, 0), a3, lda2, RA);
            PG8_WAIT_V(8); PG8_WAIT_L(0); PG8_BAR; PG8_MMA(1, 0, At, B0); PG8_MMA(1, 1, At, B1); PG8_BAR; PG8_SCHED;
        }
        if (wr == 0) PG8_BAR;
        E(acc, cur, wr, wc, fr, fq);
        if (!has_next) break;
#pragma unroll
        for (int a = 0; a < 2; ++a)
#pragma unroll
            for (int b = 0; b < 2; ++b)
#pragma unroll
                for (int m = 0; m < 4; ++m)
#pragma unroll
                    for (int n = 0; n < 2; ++n) acc[a][b][m][n] = (f32x4){0.f, 0.f, 0.f, 0.f};
        cur = nxt; cA = nA; cB = nB; clda = nlda; cldb = nldb; ++ui;
        if (wr == 1) PG8_BAR;
    }
    PG8_WAIT_V(0);
    PG8_BAR;
#undef PG8_SA
#undef PG8_SB
#undef PG8_STAGE
#undef PG8_LDA
#undef PG8_LDB
#undef PG8_MMA
#undef PG8_WAIT_V
#undef PG8_WAIT_L
#undef PG8_BAR
#undef PG8_SCHED
}
}
using pg8::GU;

struct PlainSched {
    const char* A; const char* B; unsigned lda, ldb; int nt, nM, nN, G, c;
    __device__ __forceinline__ bool next(int i, GU& u) const {
        int pm, pn; if (!pg8::tile_of(i * G + c, nM, nN, pm, pn)) return false;
        u.A = A + (size_t)pm * 256 * lda; u.B = B + (size_t)pn * 256 * ldb; u.lda = lda; u.ldb = ldb; u.nt = nt; u.pm = pm; u.pn = pn; u.kind = 0; u.mi = 0; return true;
    }
};
struct PairSched {
    const char* A1; const char* B1; unsigned lda1, ldb1; int nt1; size_t b1_mstride;
    const char* A2; const char* B2; unsigned lda2, ldb2; int nt2; size_t a2_mstride, b2_mstride;
    int nm, nM, nN, G, c;
    __device__ __forceinline__ bool next(int i, GU& u) const {
        const int per = 2 * nm, ti = i / per, sub = i - ti * per, m = sub >> 1, kind = sub & 1;
        int pm, pn; if (!pg8::tile_of(ti * G + c, nM, nN, pm, pn)) return false;
        u.pm = pm; u.pn = pn; u.kind = kind; u.mi = m;
        if (kind == 0) { u.A = A2 + (size_t)m * a2_mstride + (size_t)pm * 256 * lda2; u.B = B2 + (size_t)m * b2_mstride + (size_t)pn * 256 * ldb2; u.lda = lda2; u.ldb = ldb2; u.nt = nt2; }
        else { u.A = A1 + (size_t)pm * 256 * lda1; u.B = B1 + (size_t)m * b1_mstride + (size_t)pn * 256 * ldb1; u.lda = lda1; u.ldb = ldb1; u.nt = nt1; }
        return true;
    }
};

__device__ __forceinline__ float rstd_of(const float* ss, int row) { return __builtin_amdgcn_rsqf(ss[row] * (1.0f / D) + EPS); }
__device__ __forceinline__ u32x4 pack8(const f32x4& a, const f32x4& b) { u32x4 w; w.x = cvt_pk_bf16(a[0], a[1]); w.y = cvt_pk_bf16(a[2], a[3]); w.z = cvt_pk_bf16(b[0], b[1]); w.w = cvt_pk_bf16(b[2], b[3]); return w; }
__device__ __forceinline__ void unpack8(const u32x4& w, f32x4& a, f32x4& b) { a = (f32x4){bflo(w.x), bfhi(w.x), bflo(w.y), bfhi(w.y)}; b = (f32x4){bflo(w.z), bfhi(w.z), bflo(w.w), bfhi(w.w)}; }

struct EpiScaleBf16 {
    bf16* O; int ldo; const float* ss;
    __device__ __forceinline__ void operator()(const f32x4 (&acc)[2][2][4][2], const GU& u, int wr, int wc, int fr, int fq) const {
        const int row0 = u.pm * 256 + wr * 64 + fr, col0 = u.pn * 256 + wc * 32 + 8 * fq;
#pragma unroll
        for (int ai = 0; ai < 2; ++ai)
#pragma unroll
            for (int m = 0; m < 4; ++m) { const int r = row0 + ai * 128 + m * 16; const float rs = rstd_of(ss, r); bf16* rowp = O + (size_t)r * ldo + col0;
#pragma unroll
                for (int bj = 0; bj < 2; ++bj) *(u32x4*)(rowp + bj * 128) = pack8(acc[ai][bj][m][0] * rs, acc[ai][bj][m][1] * rs); }
    }
};
struct EpiSwiGLU {
    bf16* O; const float* ss;
    __device__ __forceinline__ void operator()(const f32x4 (&acc)[2][2][4][2], const GU& u, int wr, int wc, int fr, int fq) const {
        const int row0 = u.pm * 256 + wr * 64 + fr, col0 = u.pn * 128 + wc * 32 + 8 * fq;
#pragma unroll
        for (int ai = 0; ai < 2; ++ai)
#pragma unroll
            for (int m = 0; m < 4; ++m) { const int r = row0 + ai * 128 + m * 16; const float rs = rstd_of(ss, r);
                f32x4 v[2];
#pragma unroll
                for (int n = 0; n < 2; ++n)
#pragma unroll
                    for (int j = 0; j < 4; ++j) { const float g = acc[ai][0][m][n][j] * rs, up = acc[ai][1][m][n][j] * rs; v[n][j] = fsilu(g) * up; }
                *(u32x4*)(O + (size_t)r * DFF + col0) = pack8(v[0], v[1]); }
    }
};
struct EpiResidual {
    const float* Hin; float* Hout; bf16* HB; float* ss_out;
    __device__ __forceinline__ void operator()(const f32x4 (&acc)[2][2][4][2], const GU& u, int wr, int wc, int fr, int fq) const {
        const int row0 = u.pm * 256 + wr * 64 + fr, col0 = u.pn * 256 + wc * 32 + 8 * fq;
#pragma unroll
        for (int ai = 0; ai < 2; ++ai)
#pragma unroll
            for (int m = 0; m < 4; ++m) { const int r = row0 + ai * 128 + m * 16; float s2 = 0.f;
#pragma unroll
                for (int bj = 0; bj < 2; ++bj) { const size_t o = (size_t)r * D + col0 + bj * 128;
                    f32x4 h0 = *(const f32x4*)(Hin + o), h1 = *(const f32x4*)(Hin + o + 4);
                    h0 += acc[ai][bj][m][0]; h1 += acc[ai][bj][m][1];
                    *(f32x4*)(Hout + o) = h0; *(f32x4*)(Hout + o + 4) = h1; *(u32x4*)(HB + o) = pack8(h0, h1);
                    s2 += (h0[0] * h0[0] + h0[1] * h0[1]) + (h0[2] * h0[2] + h0[3] * h0[3]) + (h1[0] * h1[0] + h1[1] * h1[1]) + (h1[2] * h1[2] + h1[3] * h1[3]); }
                s2 += __shfl_xor(s2, 16); s2 += __shfl_xor(s2, 32);
                if (fq == 0) atomicAdd(ss_out + r, s2);
                if (m == 3) asm volatile("" ::: "memory"); }
    }
};
#define SLOT(ai, m, bj) (((((ai) * 4 + (m)) >> 1) * 512 + tid) * 4 + (((m) & 1) * 2 + (bj)))
struct EpiMerge {
    u32x4* scrP; u32x4* scrM; bf16* M; const float* ss; const float* bias;
    int nm;
    __device__ __forceinline__ void operator()(const f32x4 (&acc)[2][2][4][2], const GU& u, int wr, int wc, int fr, int fq) const {
        int tid = threadIdx.x; asm volatile("" : "+v"(tid));
        if (u.kind == 0) {
#pragma unroll
            for (int ai = 0; ai < 2; ++ai)
#pragma unroll
                for (int m = 0; m < 4; ++m)
#pragma unroll
                    for (int bj = 0; bj < 2; ++bj) scrP[SLOT(ai, m, bj)] = pack8(acc[ai][bj][m][0], acc[ai][bj][m][1]);
            return;
        }
        const int row0 = u.pm * 256 + wr * 64 + fr, col0 = u.pn * 256 + wc * 32 + 8 * fq;
        const float* bp = bias + (size_t)u.mi * D + col0;
        f32x4 bv[2][2];
#pragma unroll
        for (int bj = 0; bj < 2; ++bj) { bv[bj][0] = *(const f32x4*)(bp + bj * 128); bv[bj][1] = *(const f32x4*)(bp + bj * 128 + 4); }
#pragma unroll
        for (int ai = 0; ai < 2; ++ai)
#pragma unroll
            for (int m = 0; m < 4; ++m) { const int r = row0 + ai * 128 + m * 16; const float rs = rstd_of(ss, r);
#pragma unroll
                for (int bj = 0; bj < 2; ++bj) { const int slot = SLOT(ai, m, bj);
                    f32x4 p0, p1; unpack8(scrP[slot], p0, p1);
                    f32x4 v0, v1;
#pragma unroll
                    for (int j = 0; j < 4; ++j) { v0[j] = fsigmoid(acc[ai][bj][m][0][j] * rs + bv[bj][0][j]) * p0[j]; v1[j] = fsigmoid(acc[ai][bj][m][1][j] * rs + bv[bj][1][j]) * p1[j]; }
                    if (u.mi > 0) { f32x4 q0, q1; unpack8(scrM[slot], q0, q1); v0 += q0; v1 += q1; }
                    const u32x4 w = pack8(v0, v1);
                    if (u.mi == nm - 1) *(u32x4*)(M + (size_t)r * D + col0 + bj * 128) = w; else scrM[slot] = w; }
                asm volatile("" ::: "memory"); }
    }
};
struct EpiPle {
    u32x4* scrP; float* H; bf16* HB; const float* ss; float* ss_out;
    __device__ __forceinline__ void operator()(const f32x4 (&acc)[2][2][4][2], const GU& u, int wr, int wc, int fr, int fq) const {
        int tid = threadIdx.x; asm volatile("" : "+v"(tid));
        if (u.kind == 0) {
#pragma unroll
            for (int ai = 0; ai < 2; ++ai)
#pragma unroll
                for (int m = 0; m < 4; ++m)
#pragma unroll
                    for (int bj = 0; bj < 2; ++bj) scrP[SLOT(ai, m, bj)] = pack8(acc[ai][bj][m][0], acc[ai][bj][m][1]);
            return;
        }
        const int row0 = u.pm * 256 + wr * 64 + fr, col0 = u.pn * 256 + wc * 32 + 8 * fq;
#pragma unroll
        for (int ai = 0; ai < 2; ++ai)
#pragma unroll
            for (int m = 0; m < 4; ++m) { const int r = row0 + ai * 128 + m * 16; const float rs = rstd_of(ss, r); float s2 = 0.f;
#pragma unroll
                for (int bj = 0; bj < 2; ++bj) { const int slot = SLOT(ai, m, bj); const size_t o = (size_t)r * D + col0 + bj * 128;
                    f32x4 p0, p1; unpack8(scrP[slot], p0, p1);
                    f32x4 h0 = *(const f32x4*)(H + o), h1 = *(const f32x4*)(H + o + 4);
#pragma unroll
                    for (int j = 0; j < 4; ++j) { h0[j] += fsigmoid(acc[ai][bj][m][0][j] * rs) * p0[j]; h1[j] += fsigmoid(acc[ai][bj][m][1][j] * rs) * p1[j]; }
                    *(f32x4*)(H + o) = h0; *(f32x4*)(H + o + 4) = h1; *(u32x4*)(HB + o) = pack8(h0, h1);
                    s2 += (h0[0] * h0[0] + h0[1] * h0[1]) + (h0[2] * h0[2] + h0[3] * h0[3]) + (h1[0] * h1[0] + h1[1] * h1[1]) + (h1[2] * h1[2] + h1[3] * h1[3]); }
                s2 += __shfl_xor(s2, 16); s2 += __shfl_xor(s2, 32);
                if (fq == 0) atomicAdd(ss_out + r, s2);
                asm volatile("" ::: "memory"); }
    }
};

constexpr int NWAVES = 8, NTHR = 512;
constexpr int LDS_BYTES = 147456;
constexpr int RING_OFF = 0, RING_BYTES = 131072, MISC_OFF = RING_BYTES + 320;
struct Args { const float* in[37]; float* out; unsigned char* ws; int ph_lo, ph_hi; };
struct Frame {
    LAS unsigned char* lds; int tid, lane, wave, G, bx;
    const float* const* in; float* out; unsigned char* ws;
};
enum { I_X = 0, I_P, I_NORM_MIX, I_W_IN, I_POS_K, I_POS_V, I_CK1, I_CK2, I_CV1, I_CV2, I_LB, I_HG_NORM, I_RT_G, I_RT_B, I_MU, I_W0, I_WUP, I_A0, I_AUP, I_GUP, I_KK, I_KA, I_RK,
       I_RW_G, I_RW_B, I_WBR, I_WGATE, I_BGATE, I_WOUT, I_NORM_FFN, I_FFG, I_FFU, I_FFD, I_NORM_PLE, I_PLEG, I_PLEP, I_NORM_FINAL };

template <class ColMap>
__device__ __forceinline__ void transpose_item(const float* W, int ldw, int K, const float* scale, bf16* WT, LAS float* scr, int item, int nblk, int lane, const ColMap& cm) {
    const int kb = item / nblk, nb = item % nblk, k0 = 64 * kb, n0 = 32 * nb;
    const int sc = cm(n0 + (lane & 31));
#pragma unroll 8
    for (int i = 0; i < 32; ++i) { const int kk = 2 * i + (lane >> 5); float v = 0.f; if (sc >= 0) { v = W[(size_t)(k0 + kk) * ldw + sc]; if (scale) v *= scale[k0 + kk]; } scr[kk * 33 + (lane & 31)] = v; }
    LDS_WAIT();
    const int c = lane & 7;
#pragma unroll
    for (int j = 0; j < 4; ++j) { const int n = (lane >> 3) + 8 * j; const LAS float* s = scr + (8 * c) * 33 + n;
        u32x4 o; o.x = cvt_pk_bf16(s[0 * 33], s[1 * 33]); o.y = cvt_pk_bf16(s[2 * 33], s[3 * 33]); o.z = cvt_pk_bf16(s[4 * 33], s[5 * 33]); o.w = cvt_pk_bf16(s[6 * 33], s[7 * 33]);
        *(u32x4*)(WT + (size_t)(n0 + n) * K + k0 + 8 * c) = o; }
    LDS_WAIT();
}
struct CmIdent { __device__ __forceinline__ int operator()(int n) const { return n; } };
struct CmWin { __device__ __forceinline__ int operator()(int n) const { return n < 652 ? n : (n < 768 ? -1 : n - 116); } };
struct CmFF { __device__ __forceinline__ int operator()(int n) const { return (n >> 8) * 128 + (n & 127); } };

__device__ __forceinline__ void phase_prologue(Frame& F0) {
    Frame F = F0; asm volatile("" : "+v"(F.tid)); F.lane = F.tid & 63;
    LAS float* scr = (LAS float*)(F.lds + F.wave * 16384);
    const int gw = F.bx * NWAVES + F.wave, NGW = F.G * NWAVES;
    for (int L = 0; L < NL; ++L) {
        unsigned char* wl = F.ws + WS_W + (size_t)L * WL_STRIDE;
        const float* g_mix = F.in[I_NORM_MIX] + L * D; const float* g_ffn = F.in[I_NORM_FFN] + L * D; const float* g_ple = F.in[I_NORM_PLE] + L * D;
        { const int nblk = UW / 32, items = (D / 64) * nblk; const float* W = F.in[I_W_IN] + (size_t)L * D * DIN;
          for (int it = gw; it < items; it += NGW) transpose_item(W, DIN, D, g_mix, (bf16*)(wl + WL_IN), scr, it, nblk, F.lane, CmWin()); }
        for (int m = 0; m < 4; ++m) { const int nblk = D / 32, items = (D / 64) * nblk; const float* W = F.in[I_WGATE] + ((size_t)L * 4 + m) * D * D;
          for (int it = gw; it < items; it += NGW) transpose_item(W, D, D, g_mix, (bf16*)(wl + WL_G) + (size_t)m * D * D, scr, it, nblk, F.lane, CmIdent()); }
        for (int m = 0; m < 4; ++m) { const int nblk = D / 32, items = (MW / 64) * nblk; const float* W = F.in[I_WBR] + ((size_t)L * 4 + m) * MW * D;
          for (int it = gw; it < items; it += NGW) transpose_item(W, D, MW, nullptr, (bf16*)(wl + WL_B) + (size_t)m * D * MW, scr, it, nblk, F.lane, CmIdent()); }
        { const int nblk = D / 32, items = (D / 64) * nblk; const float* W = F.in[I_WOUT] + (size_t)L * D * D;
          for (int it = gw; it < items; it += NGW) transpose_item(W, D, D, nullptr, (bf16*)(wl + WL_OUT), scr, it, nblk, F.lane, CmIdent()); }
        { const int nblk = (2 * DFF) / 32, items = (D / 64) * nblk; const float* Wg = F.in[I_FFG] + (size_t)L * D * DFF; const float* Wu = F.in[I_FFU] + (size_t)L * D * DFF;
          for (int it = gw; it < items; it += NGW) { const int nb = it % nblk; const bool up = ((nb * 32) & 128) != 0; transpose_item(up ? Wu : Wg, DFF, D, g_ffn, (bf16*)(wl + WL_FF), scr, it, nblk, F.lane, CmFF()); } }
        { const int nblk = D / 32, items = (DFF / 64) * nblk; const float* W = F.in[I_FFD] + (size_t)L * DFF * D;
          for (int it = gw; it < items; it += NGW) transpose_item(W, D, DFF, nullptr, (bf16*)(wl + WL_DN), scr, it, nblk, F.lane, CmIdent()); }
        { const int nblk = D / 32, items = (D / 64) * nblk; const float* W = F.in[I_PLEG] + (size_t)L * D * D;
          for (int it = gw; it < items; it += NGW) transpose_item(W, D, D, g_ple, (bf16*)(wl + WL_PG), scr, it, nblk, F.lane, CmIdent()); }
        { const int nblk = D / 32, items = (PLE / 64) * nblk; const float* W = F.in[I_PLEP] + (size_t)L * PLE * D;
          for (int it = gw; it < items; it += NGW) transpose_item(W, D, PLE, nullptr, (bf16*)(wl + WL_PP), scr, it, nblk, F.lane, CmIdent()); }
    }
    { const float* x = F.in[I_X]; bf16* hb = (bf16*)(F.ws + WS_HBA); float* ss0 = (float*)(F.ws + WS_CTL) + CW_SS;
      for (int r = gw; r < T; r += NGW) { const f32x4* xr = (const f32x4*)(x + (size_t)r * D) + F.lane; float s = 0.f;
#pragma unroll
        for (int j = 0; j < 4; ++j) { const f32x4 v = xr[64 * j]; s += (v[0] * v[0] + v[1] * v[1]) + (v[2] * v[2] + v[3] * v[3]);
            u32x2 w; w.x = cvt_pk_bf16(v[0], v[1]); w.y = cvt_pk_bf16(v[2], v[3]); *((u32x2*)(hb + (size_t)r * D) + F.lane + 64 * j) = w; }
        s = wave_sum(s); if (F.lane == 0) ss0[r] = s; } }
    { const float* p = F.in[I_P]; bf16* pb = (bf16*)(F.ws + WS_PB);
      for (int r = gw; r < 2 * T; r += NGW) { const f32x4 v = *((const f32x4*)(p + (size_t)r * PLE) + F.lane); u32x2 w; w.x = cvt_pk_bf16(v[0], v[1]); w.y = cvt_pk_bf16(v[2], v[3]); *((u32x2*)(pb + (size_t)r * PLE) + F.lane) = w; } }
    { float* rope = (float*)(F.ws + WS_ROPE); const int gt = F.bx * NTHR + F.tid, NT_ = F.G * NTHR;
      for (int i = gt; i < S * 32; i += NT_) { const int pos = i >> 5, j = i & 31; const double inv = pow(10000.0, -(double)(2 * j) / 64.0); const double a = (double)pos * (double)(float)inv;
        rope[2 * i] = (float)cos(a); rope[2 * i + 1] = (float)sin(a); } }
}

__device__ __forceinline__ float ldu(const bf16* u, size_t row, int col) { return bf2f(u[row * UW + col]); }

__device__ __forceinline__ void phase_cmp(Frame& F0, int L) {
    Frame F = F0; asm volatile("" : "+v"(F.tid)); F.lane = F.tid & 63;
    const bf16* u = (const bf16*)(F.ws + WS_U);
    LAS float* xs = (LAS float*)(F.lds + F.wave * 16384);
    const int gw = F.bx * NWAVES + F.wave, NGW = F.G * NWAVES;
    for (int it = gw; it < NB * 512 * 2; it += NGW) {
        const int kv = it & 1, i = (it >> 1) & 511, b = it >> 10;
        bf16* outp = (bf16*)(F.ws + (kv ? WS_VCMP : WS_KCMP)) + ((size_t)b * 512 + i) * 64;
        if (i >= NCMP) { outp[F.lane] = 0; continue; }
        const float* pos = F.in[kv ? I_POS_V : I_POS_K] + (size_t)L * 2048;
        const float* w1 = F.in[kv ? I_CV1 : I_CK1] + (size_t)L * 2048 * 128;
        const float* w2 = F.in[kv ? I_CV2 : I_CK2] + (size_t)L * 128 * 64;
        const int col = U_NSA + (kv ? 320 : 256);
        for (int e = F.lane; e < 2048; e += 64) { const int tok = e >> 6, d = e & 63; xs[e] = ldu(u, (size_t)b * S + 16 * i + tok, col + d) + pos[e]; }
        LDS_WAIT();
        float h0 = 0.f, h1 = 0.f;
        for (int j = 0; j < 2048; ++j) { const float xv = xs[j]; h0 += xv * w1[(size_t)j * 128 + F.lane]; h1 += xv * w1[(size_t)j * 128 + 64 + F.lane]; }
        xs[2048 + F.lane] = fsilu(h0); xs[2048 + 64 + F.lane] = fsilu(h1);
        LDS_WAIT();
        float o = 0.f;
        for (int j = 0; j < 128; ++j) o += xs[2048 + j] * w2[j * 64 + F.lane];
        outp[F.lane] = (bf16)(cvt_pk_bf16(o, 0.f) & 0xffffu);
        LDS_WAIT();
    }
}

__device__ __forceinline__ void rwkv_seq(Frame& F, int L, int b, int h) {
    const bf16* u = (const bf16*)(F.ws + WS_U); bf16* bo = (bf16*)(F.ws + WS_BO);
    LAS float* Lw = (LAS float*)F.lds;
    LAS float* La = Lw + 2048; LAS float* Lb = La + 2048; LAS float* Lk = Lb + 2048; LAS float* Lr = Lk + 2048; LAS float* Lv = Lr + 2048; LAS float* Lg = Lv + 2048;
    LAS float* Ltw = Lg + 2048; LAS float* Lal = Ltw + 2048; LAS float* Lgl = Lal + 2048;
    LAS float* Lbon = Lgl + 4096;
    const float* mu = F.in[I_MU] + L * 1024; const float* w0 = F.in[I_W0] + L * 256 + h * 64; const float* a0 = F.in[I_A0] + L * 256 + h * 64;
    const float* wup = F.in[I_WUP] + (size_t)L * 64 * 256 + h * 64; const float* aup = F.in[I_AUP] + (size_t)L * 64 * 256 + h * 64; const float* gup = F.in[I_GUP] + (size_t)L * 128 * 256 + h * 64;
    const float* kkw = F.in[I_KK] + L * 256 + h * 64; const float* kaw = F.in[I_KA] + L * 256 + h * 64; const float* rkw = F.in[I_RK] + L * 256 + h * 64;
    const float* ng = F.in[I_RW_G] + L * 256 + h * 64; const float* nb = F.in[I_RW_B] + L * 256 + h * 64;
    float St[64];
#pragma unroll
    for (int k = 0; k < 64; ++k) St[k] = 0.f;
    const int lane = F.lane, wave = F.wave;
    for (int t0 = 0; t0 < S; t0 += 32) {
        for (int e = F.tid; e < 32 * 448; e += NTHR) {
            const int tok = e / 448, c = e % 448;
            int col; if (c < 64) col = h * 64 + c; else if (c < 128) col = 256 + h * 64 + (c - 64); else if (c < 192) col = 512 + h * 64 + (c - 128); else col = 768 + (c - 192);
            const int t = t0 + tok; const size_t row = (size_t)b * S + t;
            const float x1 = ldu(u, row, U_RW + col); const float x0 = t > 0 ? ldu(u, row - 1, U_RW + col) : 0.f;
            const float xv = x1 + mu[col] * (x0 - x1);
            if (c < 64) Lr[tok * 64 + c] = xv; else if (c < 128) Lk[tok * 64 + c - 64] = xv; else if (c < 192) Lv[tok * 64 + c - 128] = xv;
            else if (c < 256) Ltw[tok * 64 + c - 192] = tanhf(xv); else if (c < 320) Lal[tok * 64 + c - 256] = xv; else Lgl[tok * 128 + c - 320] = fsigmoid(xv);
        }
        __syncthreads();
        for (int q = 0; q < 4; ++q) { const int tok = wave * 4 + q;
            float zw = w0[lane], za = a0[lane], zg = 0.f;
            for (int j = 0; j < 64; ++j) { zw += Ltw[tok * 64 + j] * wup[j * 256 + lane]; za += Lal[tok * 64 + j] * aup[j * 256 + lane]; }
            for (int j = 0; j < 128; ++j) zg += Lgl[tok * 128 + j] * gup[j * 256 + lane];
            const float dec = __expf(-0.6065306597126334f * fsigmoid(zw)); const float ag = fsigmoid(za);
            const float kx = Lk[tok * 64 + lane], rx = Lr[tok * 64 + lane];
            float kk = kx * kkw[lane]; const float n2 = wave_sum(kk * kk); kk *= __builtin_amdgcn_rsqf(fmaxf(n2, 1e-24f));
            const float kp = kx * (1.0f + (ag - 1.0f) * kaw[lane]);
            const float bon = wave_sum(rx * kp * rkw[lane]);
            Lw[tok * 64 + lane] = dec; La[tok * 64 + lane] = -kk; Lb[tok * 64 + lane] = kk * ag; Lk[tok * 64 + lane] = kp; Lg[tok * 64 + lane] = zg;
            if (lane == 0) Lbon[tok] = bon;
        }
        __syncthreads();
        if (wave == 0) {
            for (int tok = 0; tok < 32; ++tok) {
                const float vl = Lv[tok * 64 + lane];
                float sa = 0.f;
#pragma unroll
                for (int k4 = 0; k4 < 16; ++k4) { const f32x4 a = *(const LAS f32x4*)(La + tok * 64 + 4 * k4);
                    sa += St[4 * k4] * a[0]; sa += St[4 * k4 + 1] * a[1]; sa += St[4 * k4 + 2] * a[2]; sa += St[4 * k4 + 3] * a[3];
                    if ((k4 & 7) == 7) asm volatile("" ::: "memory"); }
                float y = 0.f;
#pragma unroll
                for (int k4 = 0; k4 < 16; ++k4) { const f32x4 w = *(const LAS f32x4*)(Lw + tok * 64 + 4 * k4), bb = *(const LAS f32x4*)(Lb + tok * 64 + 4 * k4),
                                                      kp = *(const LAS f32x4*)(Lk + tok * 64 + 4 * k4), r = *(const LAS f32x4*)(Lr + tok * 64 + 4 * k4);
#pragma unroll
                    for (int j = 0; j < 4; ++j) { float s = St[4 * k4 + j] * w[j] + sa * bb[j] + vl * kp[j]; St[4 * k4 + j] = s; y += s * r[j]; }
                    if ((k4 & 1) == 1) asm volatile("" ::: "memory"); }
                const float mean = wave_sum(y) * (1.0f / 64.0f); const float dlt = y - mean; const float var = wave_sum(dlt * dlt) * (1.0f / 64.0f);
                const float yn = dlt * __builtin_amdgcn_rsqf(var + 64e-5f) * ng[lane] + nb[lane];
                const float o = (yn + Lbon[tok] * vl) * Lg[tok * 64 + lane];
                bo[((size_t)b * S + t0 + tok) * 1024 + 768 + h * 64 + lane] = (bf16)(cvt_pk_bf16(o, 0.f) & 0xffffu);
            }
        }
        __syncthreads();
    }
}

__device__ __forceinline__ void hgrn_seq(Frame& F, int L, int b, int h) {
    const bf16* u = (const bf16*)(F.ws + WS_U); bf16* bo = (bf16*)(F.ws + WS_BO);
    LAS float* Lq = (LAS float*)F.lds; LAS float* Lf = Lq + 2048; LAS float* Lk = Lf + 2048; LAS float* Lv = Lk + 2048; LAS float* Lo = Lv + 2048;
    const float* lbl = F.in[I_LB]; const float* ng = F.in[I_HG_NORM] + L * 256 + h * 64;
    float St[64];
#pragma unroll
    for (int k = 0; k < 64; ++k) St[k] = 0.f;
    const int lane = F.lane;
    for (int t0 = 0; t0 < S; t0 += 32) {
        for (int e = F.tid; e < 32 * 256; e += NTHR) {
            const int tok = e >> 8, c = e & 255, part = c >> 6, d = c & 63, ch = h * 64 + d;
            const float xv = ldu(u, (size_t)b * S + t0 + tok, U_HG + part * 256 + ch);
            if (part == 0) Lq[tok * 64 + d] = fsilu(xv);
            else if (part == 1) {
                const float l0 = lbl[ch], l1 = lbl[256 + ch]; const float mx = fmaxf(l0, l1); const float e0 = __expf(l0 - mx), e1 = __expf(l1 - mx);
                const float lb = (L == 0) ? 0.f : e1 / (e0 + e1);
                float f = lb + (1.0f - lb) * fsigmoid(xv); Lk[tok * 64 + d] = 1.0f - f; Lf[tok * 64 + d] = fmaxf(f, 1e-20f); }
            else if (part == 2) Lv[tok * 64 + d] = xv;
            else Lo[tok * 64 + d] = fsilu(xv);
        }
        __syncthreads();
        if (F.wave == 0) {
            for (int tok = 0; tok < 32; ++tok) {
                const float vl = Lv[tok * 64 + lane]; float o = 0.f;
#pragma unroll
                for (int k4 = 0; k4 < 16; ++k4) { const f32x4 f = *(const LAS f32x4*)(Lf + tok * 64 + 4 * k4), kk = *(const LAS f32x4*)(Lk + tok * 64 + 4 * k4), q = *(const LAS f32x4*)(Lq + tok * 64 + 4 * k4);
#pragma unroll
                    for (int j = 0; j < 4; ++j) { const float s = St[4 * k4 + j] * f[j] + kk[j] * vl; St[4 * k4 + j] = s; o += q[j] * s; }
                    if ((k4 & 3) == 3) asm volatile("" ::: "memory"); }
                const float ms = wave_sum(o * o) * (1.0f / 64.0f);
                const float y = o * __builtin_amdgcn_rsqf(ms + EPS) * ng[lane] * Lo[tok * 64 + lane];
                bo[((size_t)b * S + t0 + tok) * 1024 + 256 + h * 64 + lane] = (bf16)(cvt_pk_bf16(y, 0.f) & 0xffffu);
            }
        }
        __syncthreads();
    }
}

__device__ __forceinline__ void ret_seq(Frame& F, int L, int b, int h) {
    const bf16* u = (const bf16*)(F.ws + WS_U); bf16* bo = (bf16*)(F.ws + WS_BO); const float* rope = (const float*)(F.ws + WS_ROPE);
    LAS float* Lq = (LAS float*)F.lds; LAS float* Lk = Lq + 2048; LAS float* Lv = Lk + 2048; LAS float* Lg = Lv + 2048;
    const float* ng = F.in[I_RT_G] + L * 256 + h * 64; const float* nbv = F.in[I_RT_B] + L * 256 + h * 64;
    const float gamma = 1.0f - exp2f(-5.0f - (float)h);
    float St[64];
#pragma unroll
    for (int k = 0; k < 64; ++k) St[k] = 0.f;
    const int lane = F.lane;
    for (int t0 = 0; t0 < S; t0 += 32) {
        for (int e = F.tid; e < 32 * 128; e += NTHR) {
            const int tok = e >> 7, c = e & 127, part = c >> 5, j = c & 31; const int t = t0 + tok; const size_t row = (size_t)b * S + t;
            if (part < 2) { const int base = U_RT + part * 256 + h * 64; const float a1 = ldu(u, row, base + j), a2 = ldu(u, row, base + 32 + j);
                const float cs = rope[(t * 32 + j) * 2], sn = rope[(t * 32 + j) * 2 + 1]; const float sc = part == 1 ? 0.125f : 1.0f;
                LAS float* dst = part == 0 ? Lq : Lk; dst[tok * 64 + j] = (a1 * cs - a2 * sn) * sc; dst[tok * 64 + 32 + j] = (a1 * sn + a2 * cs) * sc; }
            else { const int d = (part - 2) * 32 + j; Lv[tok * 64 + d] = ldu(u, row, U_RT + 512 + h * 64 + d); Lg[tok * 64 + d] = fsilu(ldu(u, row, U_RT + 768 + h * 64 + d)); }
        }
        __syncthreads();
        if (F.wave == 0) {
            for (int tok = 0; tok < 32; ++tok) {
                const float vl = Lv[tok * 64 + lane]; float o = 0.f;
#pragma unroll
                for (int k4 = 0; k4 < 16; ++k4) { const f32x4 kk = *(const LAS f32x4*)(Lk + tok * 64 + 4 * k4), q = *(const LAS f32x4*)(Lq + tok * 64 + 4 * k4);
#pragma unroll
                    for (int j = 0; j < 4; ++j) { const float s = St[4 * k4 + j] * gamma + kk[j] * vl; St[4 * k4 + j] = s; o += q[j] * s; }
                    if ((k4 & 3) == 3) asm volatile("" ::: "memory"); }
                const float mean = wave_sum(o) * (1.0f / 64.0f); const float dlt = o - mean; const float var = wave_sum(dlt * dlt) * (1.0f / 64.0f);
                const float y = (dlt * __builtin_amdgcn_rsqf(var + 1e-5f) * ng[lane] + nbv[lane]) * Lg[tok * 64 + lane];
                bo[((size_t)b * S + t0 + tok) * 1024 + 512 + h * 64 + lane] = (bf16)(cvt_pk_bf16(y, 0.f) & 0xffffu);
            }
        }
        __syncthreads();
    }
}

constexpr int NS_KROW = 144, NS_VROW = 136;
constexpr int NS_KB = 64 * NS_KROW, NS_VB = 64 * NS_VROW;
constexpr int NS_K0 = 0, NS_V0 = 2 * NS_KB, NS_IMP = NS_V0 + 2 * NS_VB, NS_SEL = NS_IMP + 64 * 128 * 4, NS_END = NS_SEL + 64 * 4 * 4;
static_assert(NS_END <= RING_BYTES, "nsa lds");
struct NsaRow { float m, l; f32x16 o[2]; };
__device__ __forceinline__ void ns_load(const bf16* kb, const bf16* vb, size_t stride, int tid, u32x4& kr, u32x4& vr) {
    const int key = tid >> 3, ch = tid & 7; kr = *(const u32x4*)(kb + (size_t)key * stride + ch * 8); vr = *(const u32x4*)(vb + (size_t)key * stride + ch * 8);
}
__device__ __forceinline__ void ns_store(LAS unsigned char* Kb, LAS unsigned char* Vb, int tid, const u32x4& kr, const u32x4& vr) {
    const int key = tid >> 3, ch = tid & 7;
    *(LAS u32x4*)(Kb + key * NS_KROW + ch * 16) = kr;
    LAS unsigned short* vt = (LAS unsigned short*)(Vb + (8 * ch) * NS_VROW + key * 2);
    vt[0 * (NS_VROW / 2)] = (unsigned short)(vr.x & 0xffffu); vt[1 * (NS_VROW / 2)] = (unsigned short)(vr.x >> 16);
    vt[2 * (NS_VROW / 2)] = (unsigned short)(vr.y & 0xffffu); vt[3 * (NS_VROW / 2)] = (unsigned short)(vr.y >> 16);
    vt[4 * (NS_VROW / 2)] = (unsigned short)(vr.z & 0xffffu); vt[5 * (NS_VROW / 2)] = (unsigned short)(vr.z >> 16);
    vt[6 * (NS_VROW / 2)] = (unsigned short)(vr.w & 0xffffu); vt[7 * (NS_VROW / 2)] = (unsigned short)(vr.w >> 16);
}
__device__ __forceinline__ void ns_qk(LAS unsigned char* Kb, const bf16x8 (&qf)[4], int r, int h2, f32x16 (&sacc)[2]) {
#pragma unroll
    for (int sub = 0; sub < 2; ++sub) { f32x16 a;
#pragma unroll
        for (int i = 0; i < 16; ++i) a[i] = 0.f;
#pragma unroll
        for (int kk = 0; kk < 4; ++kk) { const bf16x8 kf = *(const LAS bf16x8*)(Kb + (32 * sub + r) * NS_KROW + (8 * h2 + 16 * kk) * 2); a = __builtin_amdgcn_mfma_f32_32x32x16_bf16(kf, qf[kk], a, 0, 0, 0); }
        sacc[sub] = a; }
}
enum { NS_CMP = 0, NS_SEL_ = 1, NS_WIN = 2 };
template <int MODE> __device__ __forceinline__ bool ns_valid(int key, int t, bool blk_on) {
    if (MODE == NS_CMP) return 16 * key + 31 <= t;
    if (MODE == NS_SEL_) return blk_on && key <= t;
    return key <= t && key + 511 >= t;
}
template <int MODE>
__device__ __forceinline__ void ns_branch(Frame& F, const bf16* kbase, const bf16* vbase, size_t stride, int tile_lo, int tile_hi, const bf16x8 (&qf)[4], int t, int r, int h2,
                                          const unsigned (&selw)[4], NsaRow& R) {
    LAS unsigned char* L = F.lds;
    R.m = -1e30f; R.l = 0.f;
#pragma unroll
    for (int e = 0; e < 2; ++e)
#pragma unroll
        for (int i = 0; i < 16; ++i) R.o[e][i] = 0.f;
    if (tile_hi <= tile_lo) return;
    u32x4 kr, vr;
    ns_load(kbase + (size_t)tile_lo * 64 * stride, vbase + (size_t)tile_lo * 64 * stride, stride, F.tid, kr, vr);
    __syncthreads();
    ns_store(L + NS_K0, L + NS_V0, F.tid, kr, vr);
    __syncthreads();
    for (int ti = tile_lo; ti < tile_hi; ++ti) {
        const int buf = (ti - tile_lo) & 1;
        if (ti + 1 < tile_hi) ns_load(kbase + (size_t)(ti + 1) * 64 * stride, vbase + (size_t)(ti + 1) * 64 * stride, stride, F.tid, kr, vr);
        LAS unsigned char* Kb = L + NS_K0 + buf * NS_KB; LAS unsigned char* Vb = L + NS_V0 + buf * NS_VB;
        bool blk_on = true;
        if (MODE == NS_SEL_) blk_on = (selw[ti >> 5] >> (ti & 31)) & 1u;
        bool any;
        if (MODE == NS_CMP) any = 16 * (ti * 64) + 31 <= t; else if (MODE == NS_SEL_) any = blk_on && ti * 64 <= t; else any = (ti * 64 <= t) && (ti * 64 + 63 + 511 >= t);
        if (__ballot(any) != 0ull) {
            f32x16 sacc[2];
            ns_qk(Kb, qf, r, h2, sacc);
            float mt = -1e30f;
#pragma unroll
            for (int sub = 0; sub < 2; ++sub)
#pragma unroll
                for (int i = 0; i < 16; ++i) { const int key = ti * 64 + 32 * sub + (i & 3) + 8 * (i >> 2) + 4 * h2; const float sv = ns_valid<MODE>(key, t, blk_on) ? sacc[sub][i] : -1e30f; sacc[sub][i] = sv; mt = fmaxf(mt, sv); }
            mt = fmaxf(mt, __shfl_xor(mt, 32));
            const float mn = fmaxf(R.m, mt), sc = __expf(R.m - mn); float rs = 0.f;
#pragma unroll
            for (int sub = 0; sub < 2; ++sub)
#pragma unroll
                for (int i = 0; i < 16; ++i) { const float sv = sacc[sub][i]; const float p = sv > -1e29f ? __expf(sv - mn) : 0.f; sacc[sub][i] = p; rs += p; }
            rs += __shfl_xor(rs, 32);
            R.l = R.l * sc + rs; R.m = mn;
#pragma unroll
            for (int e = 0; e < 2; ++e)
#pragma unroll
                for (int i = 0; i < 16; ++i) R.o[e][i] *= sc;
#pragma unroll
            for (int sub = 0; sub < 2; ++sub)
#pragma unroll
                for (int s2 = 0; s2 < 2; ++s2) {
                    union { bf16x8 v; unsigned w[4]; } pf;
#pragma unroll
                    for (int j = 0; j < 4; ++j) pf.w[j] = cvt_pk_bf16(sacc[sub][8 * s2 + 2 * j], sacc[sub][8 * s2 + 2 * j + 1]);
#pragma unroll
                    for (int e = 0; e < 2; ++e) {
                        union { bf16x8 v; u32x2 d[2]; } vf;
                        const LAS unsigned char* vp = Vb + (32 * e + r) * NS_VROW + (32 * sub + 16 * s2 + 4 * h2) * 2;
                        vf.d[0] = *(const LAS u32x2*)vp; vf.d[1] = *(const LAS u32x2*)(vp + 16);
                        R.o[e] = __builtin_amdgcn_mfma_f32_32x32x16_bf16(vf.v, pf.v, R.o[e], 0, 0, 0);
                    }
                }
        }
        if (ti + 1 < tile_hi) ns_store(L + NS_K0 + (buf ^ 1) * NS_KB, L + NS_V0 + (buf ^ 1) * NS_VB, F.tid, kr, vr);
        __syncthreads();
    }
}
__device__ __forceinline__ void ns_importance(Frame& F, const bf16* kbase, int ntiles, const bf16x8 (&qf)[4], int t, int r, int h2, float m, float inv_l) {
    LAS unsigned char* L = F.lds; LAS float* imp = (LAS float*)(L + NS_IMP);
    const int qrow = F.wave * 8 + (r & 7);
    u32x4 kr, vr;
    ns_load(kbase, kbase, 64, F.tid, kr, vr);
    __syncthreads();
    ns_store(L + NS_K0, L + NS_V0, F.tid, kr, vr);
    __syncthreads();
    for (int ti = 0; ti < ntiles; ++ti) {
        const int buf = ti & 1;
        if (ti + 1 < ntiles) ns_load(kbase + (size_t)(ti + 1) * 64 * 64, kbase + (size_t)(ti + 1) * 64 * 64, 64, F.tid, kr, vr);
        LAS unsigned char* Kb = L + NS_K0 + buf * NS_KB;
        f32x16 sacc[2];
        ns_qk(Kb, qf, r, h2, sacc);
#pragma unroll
        for (int sub = 0; sub < 2; ++sub)
#pragma unroll
            for (int g = 0; g < 4; ++g) {
                float p[4];
#pragma unroll
                for (int x = 0; x < 4; ++x) { const int key = ti * 64 + 32 * sub + x + 8 * g + 4 * h2; p[x] = (16 * key + 31 <= t) ? __expf(sacc[sub][4 * g + x] - m) * inv_l : 0.f; }
                float G = (p[0] + p[1]) + (p[2] + p[3]), E = p[3];
                G += __shfl_xor(G, 8); G += __shfl_xor(G, 16); E += __shfl_xor(E, 8); E += __shfl_xor(E, 16);
                const int jj = ti * 16 + 8 * sub + 2 * g + h2;
                if (r < 8) { atomicAdd((float*)(imp + qrow * 128 + jj), G); if (jj + 1 < 128) atomicAdd((float*)(imp + qrow * 128 + jj + 1), E); }
            }
        if (ti + 1 < ntiles) ns_store(L + NS_K0 + (buf ^ 1) * NS_KB, L + NS_V0 + (buf ^ 1) * NS_VB, F.tid, kr, vr);
        __syncthreads();
    }
}
__device__ __forceinline__ void nsa_unit(Frame& F, int b, int c) {
    const bf16* u = (const bf16*)(F.ws + WS_U); bf16* bo = (bf16*)(F.ws + WS_BO);
    const bf16* kcmp = (const bf16*)(F.ws + WS_KCMP) + (size_t)b * 512 * 64; const bf16* vcmp = (const bf16*)(F.ws + WS_VCMP) + (size_t)b * 512 * 64;
    LAS unsigned char* L = F.lds; LAS float* imp = (LAS float*)(L + NS_IMP); LAS unsigned* selL = (LAS unsigned*)(L + NS_SEL);
    const int lane = F.lane, r = lane & 31, h2 = lane >> 5, head = r >> 3, ql = r & 7;
    const int t = 64 * c + 8 * F.wave + ql; const size_t row = (size_t)b * S + t;
    const bf16* ub = u + (size_t)b * S * UW;
    bf16x8 qf[4];
#pragma unroll
    for (int kk = 0; kk < 4; ++kk) { const u32x4 w = *(const u32x4*)(u + row * UW + U_NSA + head * 64 + 8 * h2 + 16 * kk); f32x4 a, bb; unpack8(w, a, bb);
        union { bf16x8 v; u32x4 q; } cv; cv.q = pack8(a * 0.125f, bb * 0.125f); qf[kk] = cv.v; }
    const float g_cmp = fsigmoid(ldu(u, row, U_NSA + 640 + head)), g_sel = fsigmoid(ldu(u, row, U_NSA + 644 + head)), g_win = fsigmoid(ldu(u, row, U_NSA + 648 + head));
    unsigned selw[4] = {0xffffffffu, 0xffffffffu, 0xffffffffu, 0xffffffffu};
    f32x16 out[2];
    NsaRow R;
    const int ncmp_tiles = (4 * c + 3 + 63) >> 6;
    ns_branch<NS_CMP>(F, kcmp, vcmp, 64, 0, ncmp_tiles, qf, t, r, h2, selw, R);
    { const float inv = R.l > 0.f ? 1.0f / R.l : 0.f; const float gs = g_cmp * inv;
#pragma unroll
      for (int e = 0; e < 2; ++e)
#pragma unroll
        for (int i = 0; i < 16; ++i) out[e][i] = R.o[e][i] * gs;
      if (c >= 15) {
        for (int i = F.tid; i < 64 * 128; i += NTHR) imp[i] = 0.f;
        __syncthreads();
        ns_importance(F, kcmp, ncmp_tiles, qf, t, r, h2, R.m, inv);
        for (int q8 = 0; q8 < 8; ++q8) { const int qrow = F.wave * 8 + q8;
            float sc0, sc1;
            { const int j0 = lane, j1 = lane + 64;
              const bool f0 = (j0 == 0) || (j0 == c) || (j0 == c - 1), f1 = (j1 == c) || (j1 == c - 1);
              sc0 = f0 ? 1e30f : (j0 <= c ? imp[qrow * 128 + j0] : -1e30f); sc1 = f1 ? 1e30f : (j1 <= c ? imp[qrow * 128 + j1] : -1e30f); }
            unsigned long long lo = 0ull, hi = 0ull;
            for (int it = 0; it < 16; ++it) {
                const float best = wave_max(fmaxf(sc0, sc1));
                const unsigned long long m0 = __ballot(sc0 == best), m1 = __ballot(sc1 == best);
                int idx; if (m0) idx = __builtin_ctzll(m0); else idx = 64 + __builtin_ctzll(m1);
                if (idx < 64) { lo |= 1ull << idx; if (lane == idx) sc0 = -3e38f; } else { hi |= 1ull << (idx - 64); if (lane == idx - 64) sc1 = -3e38f; }
            }
            if (lane == 0) { selL[qrow * 4 + 0] = (unsigned)lo; selL[qrow * 4 + 1] = (unsigned)(lo >> 32); selL[qrow * 4 + 2] = (unsigned)hi; selL[qrow * 4 + 3] = (unsigned)(hi >> 32); }
        }
        LDS_WAIT();
#pragma unroll
        for (int j = 0; j < 4; ++j) selw[j] = selL[(F.wave * 8 + ql) * 4 + j];
      }
    }
    ns_branch<NS_SEL_>(F, ub + U_NSA + 384, ub + U_NSA + 448, UW, 0, c + 1, qf, t, r, h2, selw, R);
    { const float gs = g_sel / R.l;
#pragma unroll
      for (int e = 0; e < 2; ++e)
#pragma unroll
        for (int i = 0; i < 16; ++i) out[e][i] += R.o[e][i] * gs; }
    ns_branch<NS_WIN>(F, ub + U_NSA + 512, ub + U_NSA + 576, UW, c >= 8 ? c - 8 : 0, c + 1, qf, t, r, h2, selw, R);
    { const float gs = g_win / R.l;
#pragma unroll
      for (int e = 0; e < 2; ++e)
#pragma unroll
        for (int i = 0; i < 16; ++i) out[e][i] += R.o[e][i] * gs; }
#pragma unroll
    for (int e = 0; e < 2; ++e)
#pragma unroll
        for (int g = 0; g < 4; ++g) { u32x2 w; w.x = cvt_pk_bf16(out[e][4 * g], out[e][4 * g + 1]); w.y = cvt_pk_bf16(out[e][4 * g + 2], out[e][4 * g + 3]);
            *(u32x2*)(bo + row * 1024 + head * 64 + 32 * e + 8 * g + 4 * h2) = w; }
}

__device__ __forceinline__ void phase_mix(Frame& F0, int L) {
    Frame F = F0; asm volatile("" : "+v"(F.tid)); F.lane = F.tid & 63;
    if (F.bx < 32) {
#ifndef SK_RWKV
        rwkv_seq(F, L, F.bx >> 2, F.bx & 3);
#endif
    } else if (F.bx < 64) {
#ifndef SK_HGRN
        hgrn_seq(F, L, (F.bx - 32) >> 2, (F.bx - 32) & 3);
#endif
    } else if (F.bx < 96) {
#ifndef SK_RET
        ret_seq(F, L, (F.bx - 64) >> 2, (F.bx - 64) & 3);
#endif
    } else {
#ifndef SK_NSA
        for (int p = F.bx - 96; p < 512; p += F.G - 96) { const int b = p >> 6, cc = p & 63; nsa_unit(F, b, 127 - cc); nsa_unit(F, b, cc); }
#endif
    }
}

__device__ __forceinline__ void phase_final(Frame& F0, const float* ss) {
    Frame F = F0; asm volatile("" : "+v"(F.tid)); F.lane = F.tid & 63;
    const float* g = F.in[I_NORM_FINAL]; const int gw = F.bx * NWAVES + F.wave, NGW = F.G * NWAVES;
    for (int r = gw; r < T; r += NGW) { const float rs = rstd_of(ss, r); f32x4* hr = (f32x4*)(F.out + (size_t)r * D) + F.lane;
#pragma unroll
        for (int j = 0; j < 4; ++j) { f32x4 v = hr[64 * j]; const f32x4 gg = *((const f32x4*)g + F.lane + 64 * j); v = v * rs * gg; hr[64 * j] = v; } }
}

constexpr int PH_PER_LAYER = 8, N_PHASES = 1 + NL * PH_PER_LAYER + 1;
__global__ void __launch_bounds__(NTHR, 2) mega_fwd(Args args) {
    extern __shared__ __attribute__((aligned(16))) unsigned char lds_raw[];
    Frame F; F.lds = (LAS unsigned char*)lds_raw; F.tid = threadIdx.x; F.lane = F.tid & 63; F.wave = __builtin_amdgcn_readfirstlane(F.tid >> 6); F.G = gridDim.x; F.bx = blockIdx.x;
    F.in = args.in; F.out = args.out; F.ws = args.ws;
    volatile LAS unsigned* MISC = (volatile LAS unsigned*)(F.lds + MISC_OFF);
    if (F.tid < 32) MISC[F.tid] = 0u;
    __syncthreads();
    unsigned* ctl = (unsigned*)(F.ws + WS_CTL);
    XcdBarrier bar; bar.bar = ctl + CW_BAR; bar.x = 0; bar.st = nullptr;
    if (MK_N_LAUNCHES == 1) bar = xcd_barrier_post(ctl + CW_BAR, MISC + 8);
    const int lo = args.ph_lo, hi = args.ph_hi;
#define IN(k) (lo <= (k) && (k) < hi)
#define SEAM(k) do { if (IN(k) && IN((k) + 1)) xcd_barrier(bar); } while (0)
    float* ssb = (float*)ctl + CW_SS;
    LAS unsigned char* ring = F.lds + RING_OFF;

    #ifndef SK_PRO
    if (IN(0)) { phase_prologue(F); }
#endif
    SEAM(0);

    for (int L = 0; L < NL; ++L) {
        const int pb = 1 + L * PH_PER_LAYER;
        unsigned char* wl = F.ws + WS_W + (size_t)L * WL_STRIDE;
        bf16* hb_cur = (bf16*)(F.ws + ((L & 1) ? WS_HBB : WS_HBA)); bf16* hb_oth = (bf16*)(F.ws + ((L & 1) ? WS_HBA : WS_HBB));
        const float* ss_mix = ssb + (size_t)(3 * L) * T; float* ss_ffn = ssb + (size_t)(3 * L + 1) * T; float* ss_ple = ssb + (size_t)(3 * L + 2) * T; float* ss_next = ssb + (size_t)(3 * L + 3) * T;
        const float* h_in = (L == 0) ? F.in[I_X] : F.out;
#ifndef SK_G1
        if (IN(pb + 0)) { PlainSched Sd{(const char*)hb_cur, (const char*)(wl + WL_IN), D * 2, D * 2, D / 64, T / 256, UW / 256, F.G, F.bx};
            EpiScaleBf16 E{(bf16*)(F.ws + WS_U), UW, ss_mix}; pg8::gemm_phase(ring, Sd, E); }
#endif
        SEAM(pb + 0);
#ifndef SK_CMP
        if (IN(pb + 1)) phase_cmp(F, L);
#endif
        SEAM(pb + 1);
#ifndef SK_MIX
        if (IN(pb + 2)) phase_mix(F, L);
#endif
        SEAM(pb + 2);
#ifndef SK_G2
        if (IN(pb + 3)) { PairSched Sd{(const char*)hb_cur, (const char*)(wl + WL_G), D * 2, D * 2, D / 64, (size_t)D * D * 2,
                                        (const char*)(F.ws + WS_BO), (const char*)(wl + WL_B), 1024 * 2, MW * 2, MW / 64, (size_t)MW * 2, (size_t)D * MW * 2, 4, T / 256, D / 256, F.G, F.bx};
            u32x4* scr = (u32x4*)(F.ws + WS_SCR + (size_t)F.bx * 262144);
            EpiMerge E{scr, scr + 8192, (bf16*)(F.ws + WS_MERGED), ss_mix, F.in[I_BGATE] + (size_t)L * 4 * D, 4}; pg8::gemm_phase(ring, Sd, E); }
#endif
        SEAM(pb + 3);
#ifndef SK_G3
        if (IN(pb + 4)) { PlainSched Sd{(const char*)(F.ws + WS_MERGED), (const char*)(wl + WL_OUT), D * 2, D * 2, D / 64, T / 256, D / 256, F.G, F.bx};
            EpiResidual E{h_in, F.out, hb_cur, ss_ffn}; pg8::gemm_phase(ring, Sd, E); }
#endif
        SEAM(pb + 4);
#ifndef SK_G4
        if (IN(pb + 5)) { PlainSched Sd{(const char*)hb_cur, (const char*)(wl + WL_FF), D * 2, D * 2, D / 64, T / 256, (2 * DFF) / 256, F.G, F.bx};
            EpiSwiGLU E{(bf16*)(F.ws + WS_FFH), ss_ffn}; pg8::gemm_phase(ring, Sd, E); }
#endif
        SEAM(pb + 5);
#ifndef SK_G5
        if (IN(pb + 6)) { PlainSched Sd{(const char*)(F.ws + WS_FFH), (const char*)(wl + WL_DN), DFF * 2, DFF * 2, DFF / 64, T / 256, D / 256, F.G, F.bx};
            EpiResidual E{F.out, F.out, hb_cur, ss_ple}; pg8::gemm_phase(ring, Sd, E); }
#endif
        SEAM(pb + 6);
#ifndef SK_G6
        if (IN(pb + 7)) { PairSched Sd{(const char*)hb_cur, (const char*)(wl + WL_PG), D * 2, D * 2, D / 64, 0,
                                        (const char*)(F.ws + WS_PB) + (size_t)L * T * PLE * 2, (const char*)(wl + WL_PP), PLE * 2, PLE * 2, PLE / 64, 0, 0, 1, T / 256, D / 256, F.G, F.bx};
            u32x4* scr = (u32x4*)(F.ws + WS_SCR + (size_t)F.bx * 262144);
            EpiPle E{scr, F.out, hb_oth, ss_ple, ss_next}; pg8::gemm_phase(ring, Sd, E); }
#endif
        SEAM(pb + 7);
    }
#ifndef SK_FIN
    if (IN(N_PHASES - 1)) phase_final(F, ssb + (size_t)(3 * NL) * T);
#endif
#undef IN
#undef SEAM
}

extern "C" void kernel_launch(void* const* d_in, const int* in_sizes, int n_in, void* d_out, int out_size, void* d_ws, size_t ws_size, hipStream_t stream) {
    static int grid = 0;
    if (grid == 0) {
        if (n_in != 37 || in_sizes[0] != T * D || out_size != T * D || ws_size < WS_END) { fprintf(stderr, "kernel_launch: unexpected shapes (n_in %d, ws %zu)\n", n_in, ws_size); grid = -1; return; }
        int dev = 0, cus = 0, per_cu = 0;
        if (hipGetDevice(&dev) != hipSuccess || hipDeviceGetAttribute(&cus, hipDeviceAttributeMultiprocessorCount, dev) != hipSuccess) { grid = -1; return; }
        if (hipFuncSetAttribute((const void*)mega_fwd, hipFuncAttributeMaxDynamicSharedMemorySize, LDS_BYTES) != hipSuccess) { fprintf(stderr, "kernel_launch: hipFuncSetAttribute failed\n"); grid = -1; return; }
        if (hipOccupancyMaxActiveBlocksPerMultiprocessor(&per_cu, (const void*)mega_fwd, NTHR, LDS_BYTES) != hipSuccess || per_cu < 1) { fprintf(stderr, "kernel_launch: occupancy query says %d\n", per_cu); }
        (void)hipGetLastError();
        grid = cus;
    }
    if (grid < 0) return;
    hipMemsetAsync((char*)d_ws + WS_CTL, 0, CTL_BYTES, stream);
    Args a{};
    for (int i = 0; i < 37; ++i) a.in[i] = (const float*)d_in[i];
    a.out = (float*)d_out; a.ws = (unsigned char*)d_ws;
    if (MK_N_LAUNCHES == 1) { a.ph_lo = 0; a.ph_hi = N_PHASES; hipLaunchKernelGGL(mega_fwd, dim3(grid), dim3(NTHR), LDS_BYTES, stream, a); }
    else for (int p = 0; p < N_PHASES; ++p) { a.ph_lo = p; a.ph_hi = p + 1; hipLaunchKernelGGL(mega_fwd, dim3(grid), dim3(NTHR), LDS_BYTES, stream, a); }
}
```

```cpp
#include <hip/hip_runtime.h>
#include <cstdio>
#include <cstdint>

#ifndef MK_N_LAUNCHES
#define MK_N_LAUNCHES 1
#endif

#define LAS __attribute__((address_space(3)))
#define GAS __attribute__((address_space(1)))
typedef unsigned short bf16;
typedef short bf16x8 __attribute__((ext_vector_type(8)));
typedef float f32x4 __attribute__((ext_vector_type(4)));
typedef float f32x16 __attribute__((ext_vector_type(16)));
typedef unsigned u32x4 __attribute__((ext_vector_type(4)));
typedef unsigned u32x2 __attribute__((ext_vector_type(2)));

constexpr int D = 1024, NB = 8, S = 8192, T = NB * S, NL = 2;
constexpr int NH = 4, HD = 64, MW = 256, DFF = 2816, PLE = 256;
constexpr int DIN = 3724, UW = 3840;
constexpr int U_NSA = 0, U_HG = 768, U_RT = 1792, U_RW = 2816;
constexpr int NCMP = 511, NSEL = 128;
constexpr float EPS = 1e-6f;

constexpr size_t MiB = 1u << 20;
constexpr size_t WS_CTL = 0, CTL_BYTES = 4 * MiB;
constexpr size_t WS_W = 4 * MiB;
constexpr size_t WL_IN = 0, WL_G = 8 * MiB, WL_B = 16 * MiB, WL_OUT = 18 * MiB, WL_FF = 20 * MiB, WL_DN = 31 * MiB, WL_PG = 37 * MiB, WL_PP = 39 * MiB, WL_STRIDE = 40 * MiB;
constexpr size_t WS_MISC = 84 * MiB;
constexpr size_t WS_ROPE = WS_MISC, WS_KCMP = WS_MISC + 2 * MiB, WS_VCMP = WS_MISC + 2 * MiB + 512 * 1024, WS_RWUP = WS_MISC + 3 * MiB;
constexpr size_t WS_HBA = 88 * MiB, WS_HBB = 216 * MiB;
constexpr size_t WS_BO = 344 * MiB;
constexpr size_t WS_U = 472 * MiB;
constexpr size_t WS_MERGED = WS_U, WS_SCR = WS_U + 416 * MiB;
constexpr size_t WS_FFH = WS_U;
constexpr size_t WS_PB = WS_U + 352 * MiB;
constexpr size_t WS_RWN = 952 * MiB;
constexpr size_t WS_HGD = 1016 * MiB;
constexpr size_t WS_RWM = WS_BO;
constexpr size_t WS_END = 1024 * MiB;
constexpr int CH = 32, NCH = S / CH;
constexpr int CW_BAR = 4096;
constexpr int CW_SS = 65536;
constexpr int NSS = 7;
static_assert((size_t)(CW_SS + NSS * T) * 4 <= CTL_BYTES, "ctl");

#define LDS_WAIT() asm volatile("s_waitcnt lgkmcnt(0)" ::: "memory")
#define VM_WAIT() asm volatile("s_waitcnt vmcnt(0)" ::: "memory")
typedef __bf16 hbf16x2 __attribute__((ext_vector_type(2)));
typedef float f32x2v __attribute__((ext_vector_type(2)));
__device__ __forceinline__ unsigned cvt_pk_bf16(float lo, float hi) { const f32x2v v = {lo, hi}; const hbf16x2 b = __builtin_convertvector(v, hbf16x2); return __builtin_bit_cast(unsigned, b); }
__device__ __forceinline__ float bf2f(unsigned short b) { return __builtin_bit_cast(float, ((unsigned)b) << 16); }
__device__ __forceinline__ float bflo(unsigned w) { return __builtin_bit_cast(float, w << 16); }
__device__ __forceinline__ float bfhi(unsigned w) { return __builtin_bit_cast(float, w & 0xffff0000u); }
__device__ __forceinline__ float fsigmoid(float z) { return __builtin_amdgcn_rcpf(1.0f + __builtin_amdgcn_exp2f(-1.44269504f * z)); }
__device__ __forceinline__ float fsilu(float z) { return z * fsigmoid(z); }
__device__ __forceinline__ float wave_sum(float v) {
#pragma unroll
    for (int o = 1; o < 64; o <<= 1) v += __shfl_xor(v, o);
    return v;
}
__device__ __forceinline__ float wave_max(float v) {
#pragma unroll
    for (int o = 1; o < 64; o <<= 1) v = fmaxf(v, __shfl_xor(v, o));
    return v;
}

#define XB_TMO      128
#define XB_XCNT(j)  (256  + 64 * (j))
#define XB_XSUB(j)  (1280 + 64 * (j))
#define XB_XGEN(j)  (2304 + 64 * (j))
#define XB_TOP      3328
#define XB_TOPGEN   3392
#define XCD_BAR_WORDS 3456
#define XB_SPIN_CAP (1u << 24)
__device__ __forceinline__ unsigned xb_ld(unsigned* p)              { return __hip_atomic_load(p, __ATOMIC_RELAXED, __HIP_MEMORY_SCOPE_AGENT); }
__device__ __forceinline__ unsigned xb_add(unsigned* p, unsigned v) { return __hip_atomic_fetch_add(p, v, __ATOMIC_RELAXED, __HIP_MEMORY_SCOPE_AGENT); }
__device__ __forceinline__ unsigned xb_xcc_id() { return (unsigned)__builtin_amdgcn_s_getreg((3 << 11) | 20) & 0xFu; }
#define XB_SPIN(cond, bar) do { unsigned _sp = 0; while (cond) { __builtin_amdgcn_s_sleep(1); \
    if ((++_sp & 255u) == 0u) { if (xb_ld(&(bar)[XB_TMO])) break; if (_sp > XB_SPIN_CAP) { atomicAdd(&(bar)[XB_TMO], 1u); break; } } } } while (0)
struct XcdBarrier { unsigned* bar; unsigned x; volatile LAS unsigned* st; };
__device__ __forceinline__ XcdBarrier xcd_barrier_post(unsigned* bar, volatile LAS unsigned* st) {
    XcdBarrier b; b.bar = bar; b.x = xb_xcc_id(); b.st = st;
    if (threadIdx.x == 0) (void)xb_add(&bar[XB_XCNT(b.x)], 1u);
    return b;
}
__device__ __forceinline__ void xcd_barrier_complete(unsigned* bar, unsigned x, unsigned& nloc, unsigned& nx) {
    const unsigned G = gridDim.x * gridDim.y * gridDim.z;
    unsigned sum, cnt, mine, sp = 0u;
    for (;;) {
        sum = 0u; cnt = 0u; mine = 0u;
#pragma unroll
        for (unsigned j = 0; j < 16; ++j) { const unsigned c = xb_ld(&bar[XB_XCNT(j)]); sum += c; cnt += (c > 0u) ? 1u : 0u; mine = (j == x) ? c : mine; }
        if (sum == G) break;
        __builtin_amdgcn_s_sleep(1);
        if ((++sp & 255u) == 0u) { if (xb_ld(&bar[XB_TMO])) break; if (sp > XB_SPIN_CAP) { atomicAdd(&bar[XB_TMO], 1u); break; } }
    }
    nloc = mine > 0u ? mine : 1u; nx = cnt > 0u ? cnt : 1u;
}
__device__ __forceinline__ void xcd_barrier(const XcdBarrier& b) {
    asm volatile("s_waitcnt vmcnt(0)" ::: "memory");
    __syncthreads();
    if (threadIdx.x == 0) {
        unsigned* bar = b.bar;
        __builtin_amdgcn_s_waitcnt(0);
        unsigned nloc = b.st[0], nx = b.st[1];
        if (nloc == 0u) { xcd_barrier_complete(bar, b.x, nloc, nx); b.st[0] = nloc; b.st[1] = nx; }
        const unsigned old = xb_add(&bar[XB_XSUB(b.x)], 1u);
        const unsigned gen = old / nloc;
        if (old + 1u == (gen + 1u) * nloc) {
            __builtin_amdgcn_fence(__ATOMIC_RELEASE, "agent");
            asm volatile("s_waitcnt vmcnt(0)" ::: "memory");
            const unsigned og = xb_add(&bar[XB_TOP], 1u);
            const unsigned tg = og / nx;
            if (og + 1u == (tg + 1u) * nx) xb_add(&bar[XB_TOPGEN], 1u);
            else XB_SPIN(xb_ld(&bar[XB_TOPGEN]) == tg, bar);
            __builtin_amdgcn_fence(__ATOMIC_ACQUIRE, "agent");
            xb_add(&bar[XB_XGEN(b.x)], 1u);
            asm volatile("s_waitcnt vmcnt(0)" ::: "memory");
        } else {
            XB_SPIN(xb_ld(&bar[XB_XGEN(b.x)]) == gen, bar);
            __builtin_amdgcn_fence(__ATOMIC_ACQUIRE, "agent");
            asm volatile("s_waitcnt vmcnt(0)" ::: "memory");
        }
    }
    __syncthreads();
}

namespace pg8 {
constexpr int BM = 256, BK = 64, HALF = 128, HTB = HALF * BK * 2, STAGE_BYTES = 8 * HTB, NXCD = 8, WGM = 8;
__host__ __device__ __forceinline__ int lds_byte(int r, int c) { const int st = (r >> 4) * 2 + (c >> 5), rr = r & 15, cc = c & 31, ob = rr * 64 + cc * 2; return st * 1024 + (ob ^ (((ob >> 9) & 1) << 5)); }
__host__ __device__ __forceinline__ void stage_rc(int b, int& R, int& C) { const int st = b / 1024, sb = b % 1024, swz = sb ^ (((sb >> 9) & 1) << 5); R = (st >> 1) * 16 + swz / 64; C = (st & 1) * 32 + (swz % 64) / 2; }
__host__ __device__ __forceinline__ int perm32(int rho) { const int n = rho >> 4, i = rho & 15; return 8 * (i >> 2) + 4 * n + (i & 3); }

struct GU { const char* A; const char* B; unsigned lda, ldb; int nt; int pm, pn, kind, mi; };

__device__ __forceinline__ bool tile_of(int L, int nM, int nN, int& pm, int& pn) {
    const int nwg = nM * nN; if (L >= nwg) return false;
    int wgid = L; { const int q = nwg / NXCD, r = nwg % NXCD, xcd = wgid % NXCD, off = wgid / NXCD; wgid = (xcd < r ? xcd * (q + 1) : r * (q + 1) + (xcd - r) * q) + off; }
    const int nig = WGM * nN, gid = wgid / nig, fm = gid * WGM, gsz = (nM - fm) < WGM ? (nM - fm) : WGM;
    pm = fm + ((wgid % nig) % gsz); pn = (wgid % nig) / gsz; return true;
}

template <class Epi, class Sched>
__device__ __forceinline__ void gemm_phase(LAS unsigned char* lds, const Sched& S, const Epi& E) {
    int tid = threadIdx.x; asm volatile("" : "+v"(tid));
    const int wid = __builtin_amdgcn_readfirstlane(tid >> 6), lane = tid & 63, wr = wid >> 2, wc = wid & 3, fr = lane & 15, fq = lane >> 4;
    unsigned RA[2], RB[2], C2[2];
#pragma unroll
    for (int i = 0; i < 2; ++i) { int R, C; stage_rc(tid * 16 + i * 8192, R, C); RA[i] = (unsigned)R; RB[i] = (unsigned)((R & ~31) + perm32(R & 31)); C2[i] = (unsigned)C * 2u; }
    const size_t kstep = (size_t)(BK * 2);
    const unsigned ldsw = (unsigned)wid * 1024u;
    const int aoff = lds_byte(wr * 64 + fr, fq * 8), boff = lds_byte(wc * 32 + fr, fq * 8);
#define PG8_SA(b, h) (((b) * 2 + (h)) * HTB)
#define PG8_SB(b, h) ((4 + (b) * 2 + (h)) * HTB)
#define PG8_STAGE(bufoff, gbase, ld, RR) do { _Pragma("unroll") for (int _i = 0; _i < 2; ++_i) \
        __builtin_amdgcn_global_load_lds((const unsigned*)((const char*)(gbase) + (RR[_i] * (ld) + C2[_i])), (LAS unsigned*)(lds + (bufoff) + ldsw + _i * 8192), 16, 0, 0); } while (0)
#define PG8_LDA(dst, b, h) do { _Pragma("unroll") for (int m = 0; m < 4; ++m) _Pragma("unroll") for (int k = 0; k < 2; ++k) dst[m][k] = *(const LAS bf16x8*)(lds + PG8_SA(b, h) + aoff + m * 2048 + k * 1024); } while (0)
#define PG8_LDB(dst, b, h) do { _Pragma("unroll") for (int n = 0; n < 2; ++n) _Pragma("unroll") for (int k = 0; k < 2; ++k) dst[n][k] = *(const LAS bf16x8*)(lds + PG8_SB(b, h) + boff + n * 2048 + k * 1024); } while (0)
#define PG8_MMA(ai, bj, At, Bt) do { __builtin_amdgcn_s_setprio(1); _Pragma("unroll") for (int m = 0; m < 4; ++m) _Pragma("unroll") for (int n = 0; n < 2; ++n) _Pragma("unroll") for (int k = 0; k < 2; ++k) \
        acc[ai][bj][m][n] = __builtin_amdgcn_mfma_f32_16x16x32_bf16(Bt[n][k], At[m][k], acc[ai][bj][m][n], 0, 0, 0); __builtin_amdgcn_s_setprio(0); } while (0)
#define PG8_WAIT_V(n) asm volatile("s_waitcnt vmcnt(" #n ")" ::: "memory")
#define PG8_WAIT_L(n) asm volatile("s_waitcnt lgkmcnt(" #n ")" ::: "memory")
#define PG8_BAR __builtin_amdgcn_s_barrier()
#define PG8_SCHED __builtin_amdgcn_sched_barrier(0)
    GU cur, nxt; int ui = 0;
    if (!S.next(0, cur)) return;
    f32x4 acc[2][2][4][2];
#pragma unroll
    for (int a = 0; a < 2; ++a)
#pragma unroll
        for (int b = 0; b < 2; ++b)
#pragma unroll
            for (int m = 0; m < 4; ++m)
#pragma unroll
                for (int n = 0; n < 2; ++n) acc[a][b][m][n] = (f32x4){0.f, 0.f, 0.f, 0.f};
    bf16x8 At[4][2], B0[2][2], B1[2][2];
    const char* cA = cur.A; const char* cB = cur.B; unsigned clda = cur.lda, cldb = cur.ldb;
    PG8_STAGE(PG8_SB(0, 0), cB, cldb, RB); PG8_STAGE(PG8_SB(0, 1), cB + (size_t)HALF * cldb, cldb, RB); PG8_STAGE(PG8_SA(0, 0), cA, clda, RA); PG8_STAGE(PG8_SA(0, 1), cA + (size_t)HALF * clda, clda, RA);
    if (wr == 1) PG8_BAR;
    PG8_WAIT_V(2); PG8_BAR;
    PG8_STAGE(PG8_SB(1, 0), cB + kstep, cldb, RB); PG8_STAGE(PG8_SA(1, 0), cA + kstep, clda, RA); PG8_STAGE(PG8_SB(1, 1), cB + (size_t)HALF * cldb + kstep, cldb, RB);
    PG8_WAIT_V(6); PG8_BAR;
    for (;;) {
        const bool has_next = S.next(ui + 1, nxt);
        const char* nA = has_next ? nxt.A : cA; const char* nB = has_next ? nxt.B : cB;
        const unsigned nlda = has_next ? nxt.lda : clda, nldb = has_next ? nxt.ldb : cldb;
        const int nt = cur.nt;
        for (int t = 0; t < nt; t += 2) {
            const bool last = (t == nt - 2);
            const char* a1 = cA + (size_t)(t + 1) * kstep;
            const char* a2 = last ? nA : cA + (size_t)(t + 2) * kstep; const char* b2 = last ? nB : cB + (size_t)(t + 2) * kstep;
            const unsigned lda2 = last ? nlda : clda, ldb2 = last ? nldb : cldb;
            const char* a3 = a2 + kstep; const char* b3 = b2 + kstep;
            PG8_LDB(B0, 0, 0); PG8_LDB(B1, 0, 1); PG8_SCHED; PG8_LDA(At, 0, 0); PG8_STAGE(PG8_SA(1, 1), a1 + (size_t)HALF * clda, clda, RA);
            PG8_WAIT_V(8); PG8_WAIT_L(0); PG8_BAR; PG8_MMA(0, 0, At, B0); PG8_MMA(0, 1, At, B1); PG8_BAR; PG8_SCHED;
            PG8_LDA(At, 0, 1); PG8_STAGE(PG8_SB(0, 0), b2, ldb2, RB); PG8_STAGE(PG8_SB(0, 1), b2 + (size_t)HALF * ldb2, ldb2, RB); PG8_STAGE(PG8_SA(0, 0), a2, lda2, RA);
            PG8_WAIT_V(8); PG8_WAIT_L(0); PG8_BAR; PG8_MMA(1, 0, At, B0); PG8_MMA(1, 1, At, B1); PG8_BAR; PG8_SCHED;
            PG8_LDB(B0, 1, 0); PG8_LDB(B1, 1, 1); PG8_SCHED; PG8_LDA(At, 1, 0); PG8_STAGE(PG8_SA(0, 1), a2 + (size_t)HALF * lda2, lda2, RA);
            PG8_WAIT_V(8); PG8_WAIT_L(0); PG8_BAR; PG8_MMA(0, 0, At, B0); PG8_MMA(0, 1, At, B1); PG8_BAR; PG8_SCHED;
            PG8_LDA(At, 1, 1); PG8_STAGE(PG8_SB(1, 0), b3, ldb2, RB); PG8_STAGE(PG8_SB(1, 1), b3 + (size_t)HALF * ldb2, ldb2, RB); PG8_STAGE(PG8_SA(1, 0), a3, lda2, RA);
            PG8_WAIT_V(8); PG8_WAIT_L(0); PG8_BAR; PG8_MMA(1, 0, At, B0); PG8_MMA(1, 1, At, B1); PG8_BAR; PG8_SCHED;
        }
        if (wr == 0) PG8_BAR;
        E(acc, cur, wr, wc, fr, fq);
        if (!has_next) break;
#pragma unroll
        for (int a = 0; a < 2; ++a)
#pragma unroll
            for (int b = 0; b < 2; ++b)
#pragma unroll
                for (int m = 0; m < 4; ++m)
#pragma unroll
                    for (int n = 0; n < 2; ++n) acc[a][b][m][n] = (f32x4){0.f, 0.f, 0.f, 0.f};
        cur = nxt; cA = nA; cB = nB; clda = nlda; cldb = nldb; ++ui;
        if (wr == 1) PG8_BAR;
    }
    PG8_WAIT_V(0);
    PG8_BAR;
#undef PG8_SA
#undef PG8_SB
#undef PG8_STAGE
#undef PG8_LDA
#undef PG8_LDB
#undef PG8_MMA
#undef PG8_WAIT_V
#undef PG8_WAIT_L
#undef PG8_BAR
#undef PG8_SCHED
}
}
using pg8::GU;

struct PlainSched {
    const char* A; const char* B; unsigned lda, ldb; int nt, nM, nN, G, c;
    __device__ __forceinline__ bool next(int i, GU& u) const {
        int pm, pn; if (!pg8::tile_of(i * G + c, nM, nN, pm, pn)) return false;
        u.A = A + (size_t)pm * 256 * lda; u.B = B + (size_t)pn * 256 * ldb; u.lda = lda; u.ldb = ldb; u.nt = nt; u.pm = pm; u.pn = pn; u.kind = 0; u.mi = 0; return true;
    }
};
struct PairSched {
    const char* A1; const char* B1; unsigned lda1, ldb1; int nt1; size_t b1_mstride;
    const char* A2; const char* B2; unsigned lda2, ldb2; int nt2; size_t a2_mstride, b2_mstride;
    int nm, nM, nN, G, c;
    __device__ __forceinline__ bool next(int i, GU& u) const {
        const int per = 2 * nm, ti = i / per, sub = i - ti * per, m = sub >> 1, kind = sub & 1;
        int pm, pn; if (!pg8::tile_of(ti * G + c, nM, nN, pm, pn)) return false;
        u.pm = pm; u.pn = pn; u.kind = kind; u.mi = m;
        if (kind == 0) { u.A = A2 + (size_t)m * a2_mstride + (size_t)pm * 256 * lda2; u.B = B2 + (size_t)m * b2_mstride + (size_t)pn * 256 * ldb2; u.lda = lda2; u.ldb = ldb2; u.nt = nt2; }
        else { u.A = A1 + (size_t)pm * 256 * lda1; u.B = B1 + (size_t)m * b1_mstride + (size_t)pn * 256 * ldb1; u.lda = lda1; u.ldb = ldb1; u.nt = nt1; }
        return true;
    }
};

__device__ __forceinline__ float rstd_of(const float* ss, int row) { return __builtin_amdgcn_rsqf(ss[row] * (1.0f / D) + EPS); }
__device__ __forceinline__ u32x4 pack8(const f32x4& a, const f32x4& b) { u32x4 w; w.x = cvt_pk_bf16(a[0], a[1]); w.y = cvt_pk_bf16(a[2], a[3]); w.z = cvt_pk_bf16(b[0], b[1]); w.w = cvt_pk_bf16(b[2], b[3]); return w; }
__device__ __forceinline__ void unpack8(const u32x4& w, f32x4& a, f32x4& b) { a = (f32x4){bflo(w.x), bfhi(w.x), bflo(w.y), bfhi(w.y)}; b = (f32x4){bflo(w.z), bfhi(w.z), bflo(w.w), bfhi(w.w)}; }

struct EpiScaleBf16 {
    bf16* O; int ldo; const float* ss;
    __device__ __forceinline__ void operator()(const f32x4 (&acc)[2][2][4][2], const GU& u, int wr, int wc, int fr, int fq) const {
        const int row0 = u.pm * 256 + wr * 64 + fr, col0 = u.pn * 256 + wc * 32 + 8 * fq;
#pragma unroll
        for (int ai = 0; ai < 2; ++ai)
#pragma unroll
            for (int m = 0; m < 4; ++m) { const int r = row0 + ai * 128 + m * 16; const float rs = rstd_of(ss, r); bf16* rowp = O + (size_t)r * ldo + col0;
#pragma unroll
                for (int bj = 0; bj < 2; ++bj) *(u32x4*)(rowp + bj * 128) = pack8(acc[ai][bj][m][0] * rs, acc[ai][bj][m][1] * rs); }
    }
};
struct EpiSwiGLU {
    bf16* O; const float* ss;
    __device__ __forceinline__ void operator()(const f32x4 (&acc)[2][2][4][2], const GU& u, int wr, int wc, int fr, int fq) const {
        const int row0 = u.pm * 256 + wr * 64 + fr, col0 = u.pn * 128 + wc * 32 + 8 * fq;
#pragma unroll
        for (int ai = 0; ai < 2; ++ai)
#pragma unroll
            for (int m = 0; m < 4; ++m) { const int r = row0 + ai * 128 + m * 16; const float rs = rstd_of(ss, r);
                f32x4 v[2];
#pragma unroll
                for (int n = 0; n < 2; ++n)
#pragma unroll
                    for (int j = 0; j < 4; ++j) { const float g = acc[ai][0][m][n][j] * rs, up = acc[ai][1][m][n][j] * rs; v[n][j] = fsilu(g) * up; }
                *(u32x4*)(O + (size_t)r * DFF + col0) = pack8(v[0], v[1]); }
    }
};
struct EpiResidual {
    const float* Hin; float* Hout; bf16* HB; float* ss_out;
    __device__ __forceinline__ void operator()(const f32x4 (&acc)[2][2][4][2], const GU& u, int wr, int wc, int fr, int fq) const {
        const int row0 = u.pm * 256 + wr * 64 + fr, col0 = u.pn * 256 + wc * 32 + 8 * fq;
#pragma unroll
        for (int ai = 0; ai < 2; ++ai)
#pragma unroll
            for (int m = 0; m < 4; ++m) { const int r = row0 + ai * 128 + m * 16; float s2 = 0.f;
#pragma unroll
                for (int bj = 0; bj < 2; ++bj) { const size_t o = (size_t)r * D + col0 + bj * 128;
                    f32x4 h0 = *(const f32x4*)(Hin + o), h1 = *(const f32x4*)(Hin + o + 4);
                    h0 += acc[ai][bj][m][0]; h1 += acc[ai][bj][m][1];
                    *(f32x4*)(Hout + o) = h0; *(f32x4*)(Hout + o + 4) = h1; *(u32x4*)(HB + o) = pack8(h0, h1);
                    s2 += (h0[0] * h0[0] + h0[1] * h0[1]) + (h0[2] * h0[2] + h0[3] * h0[3]) + (h1[0] * h1[0] + h1[1] * h1[1]) + (h1[2] * h1[2] + h1[3] * h1[3]); }
                s2 += __shfl_xor(s2, 16); s2 += __shfl_xor(s2, 32);
                if (fq == 0) atomicAdd(ss_out + r, s2);
                if (m == 3) asm volatile("" ::: "memory"); }
    }
};
#define SLOT(ai, m, bj) (((((ai) * 4 + (m)) >> 1) * 512 + tid) * 4 + (((m) & 1) * 2 + (bj)))
struct EpiMerge {
    u32x4* scrP; u32x4* scrM; bf16* M; const float* ss; const float* bias;
    int nm;
    __device__ __forceinline__ void operator()(const f32x4 (&acc)[2][2][4][2], const GU& u, int wr, int wc, int fr, int fq) const {
        int tid = threadIdx.x; asm volatile("" : "+v"(tid));
        if (u.kind == 0) {
#pragma unroll
            for (int ai = 0; ai < 2; ++ai)
#pragma unroll
                for (int m = 0; m < 4; ++m)
#pragma unroll
                    for (int bj = 0; bj < 2; ++bj) scrP[SLOT(ai, m, bj)] = pack8(acc[ai][bj][m][0], acc[ai][bj][m][1]);
            return;
        }
        const int row0 = u.pm * 256 + wr * 64 + fr, col0 = u.pn * 256 + wc * 32 + 8 * fq;
        const float* bp = bias + (size_t)u.mi * D + col0;
        f32x4 bv[2][2];
#pragma unroll
        for (int bj = 0; bj < 2; ++bj) { bv[bj][0] = *(const f32x4*)(bp + bj * 128); bv[bj][1] = *(const f32x4*)(bp + bj * 128 + 4); }
#pragma unroll
        for (int ai = 0; ai < 2; ++ai)
#pragma unroll
            for (int m = 0; m < 4; ++m) { const int r = row0 + ai * 128 + m * 16; const float rs = rstd_of(ss, r);
#pragma unroll
                for (int bj = 0; bj < 2; ++bj) { const int slot = SLOT(ai, m, bj);
                    f32x4 p0, p1; unpack8(scrP[slot], p0, p1);
                    f32x4 v0, v1;
#pragma unroll
                    for (int j = 0; j < 4; ++j) { v0[j] = fsigmoid(acc[ai][bj][m][0][j] * rs + bv[bj][0][j]) * p0[j]; v1[j] = fsigmoid(acc[ai][bj][m][1][j] * rs + bv[bj][1][j]) * p1[j]; }
                    if (u.mi > 0) { f32x4 q0, q1; unpack8(scrM[slot], q0, q1); v0 += q0; v1 += q1; }
                    const u32x4 w = pack8(v0, v1);
                    if (u.mi == nm - 1) *(u32x4*)(M + (size_t)r * D + col0 + bj * 128) = w; else scrM[slot] = w; }
                asm volatile("" ::: "memory"); }
    }
};
struct EpiPle {
    u32x4* scrP; float* H; bf16* HB; const float* ss; float* ss_out;
    __device__ __forceinline__ void operator()(const f32x4 (&acc)[2][2][4][2], const GU& u, int wr, int wc, int fr, int fq) const {
        int tid = threadIdx.x; asm volatile("" : "+v"(tid));
        if (u.kind == 0) {
#pragma unroll
            for (int ai = 0; ai < 2; ++ai)
#pragma unroll
                for (int m = 0; m < 4; ++m)
#pragma unroll
                    for (int bj = 0; bj < 2; ++bj) scrP[SLOT(ai, m, bj)] = pack8(acc[ai][bj][m][0], acc[ai][bj][m][1]);
            return;
        }
        const int row0 = u.pm * 256 + wr * 64 + fr, col0 = u.pn * 256 + wc * 32 + 8 * fq;
#pragma unroll
        for (int ai = 0; ai < 2; ++ai)
#pragma unroll
            for (int m = 0; m < 4; ++m) { const int r = row0 + ai * 128 + m * 16; const float rs = rstd_of(ss, r); float s2 = 0.f;
#pragma unroll
                for (int bj = 0; bj < 2; ++bj) { const int slot = SLOT(ai, m, bj); const size_t o = (size_t)r * D + col0 + bj * 128;
                    f32x4 p0, p1; unpack8(scrP[slot], p0, p1);
                    f32x4 h0 = *(const f32x4*)(H + o), h1 = *(const f32x4*)(H + o + 4);
#pragma unroll
                    for (int j = 0; j < 4; ++j) { h0[j] += fsigmoid(acc[ai][bj][m][0][j] * rs) * p0[j]; h1[j] += fsigmoid(acc[ai][bj][m][1][j] * rs) * p1[j]; }
                    *(f32x4*)(H + o) = h0; *(f32x4*)(H + o + 4) = h1; *(u32x4*)(HB + o) = pack8(h0, h1);
                    s2 += (h0[0] * h0[0] + h0[1] * h0[1]) + (h0[2] * h0[2] + h0[3] * h0[3]) + (h1[0] * h1[0] + h1[1] * h1[1]) + (h1[2] * h1[2] + h1[3] * h1[3]); }
                s2 += __shfl_xor(s2, 16); s2 += __shfl_xor(s2, 32);
                if (fq == 0) atomicAdd(ss_out + r, s2);
                asm volatile("" ::: "memory"); }
    }
};

constexpr int NWAVES = 8, NTHR = 512;
constexpr int RING_OFF = 0, RING_BYTES = 131072, WREG = 19456, MISC_OFF = 8 * WREG;
constexpr int LDS_BYTES = MISC_OFF + 256;
static_assert(MISC_OFF + 128 <= LDS_BYTES, "lds");
struct Args { const float* in[37]; float* out; unsigned char* ws; int ph_lo, ph_hi; };
struct Frame {
    LAS unsigned char* lds; int tid, lane, wave, G, bx;
    const float* const* in; float* out; unsigned char* ws;
};
enum { I_X = 0, I_P, I_NORM_MIX, I_W_IN, I_POS_K, I_POS_V, I_CK1, I_CK2, I_CV1, I_CV2, I_LB, I_HG_NORM, I_RT_G, I_RT_B, I_MU, I_W0, I_WUP, I_A0, I_AUP, I_GUP, I_KK, I_KA, I_RK,
       I_RW_G, I_RW_B, I_WBR, I_WGATE, I_BGATE, I_WOUT, I_NORM_FFN, I_FFG, I_FFU, I_FFD, I_NORM_PLE, I_PLEG, I_PLEP, I_NORM_FINAL };

template <class ColMap>
__device__ __forceinline__ void transpose_item(const float* W, int ldw, int K, const float* scale, bf16* WT, LAS float* scr, int item, int nblk, int lane, const ColMap& cm) {
    const int kb = item / nblk, nb = item % nblk, k0 = 64 * kb, n0 = 32 * nb;
    const int sc = cm(n0 + (lane & 31));
#pragma unroll 8
    for (int i = 0; i < 32; ++i) { const int kk = 2 * i + (lane >> 5); float v = 0.f; if (sc >= 0) { v = W[(size_t)(k0 + kk) * ldw + sc]; if (scale) v *= scale[k0 + kk]; } scr[kk * 33 + (lane & 31)] = v; }
    LDS_WAIT();
    const int c = lane & 7;
#pragma unroll
    for (int j = 0; j < 4; ++j) { const int n = (lane >> 3) + 8 * j; const LAS float* s = scr + (8 * c) * 33 + n;
        u32x4 o; o.x = cvt_pk_bf16(s[0 * 33], s[1 * 33]); o.y = cvt_pk_bf16(s[2 * 33], s[3 * 33]); o.z = cvt_pk_bf16(s[4 * 33], s[5 * 33]); o.w = cvt_pk_bf16(s[6 * 33], s[7 * 33]);
        *(u32x4*)(WT + (size_t)(n0 + n) * K + k0 + 8 * c) = o; }
    LDS_WAIT();
}
struct CmIdent { __device__ __forceinline__ int operator()(int n) const { return n; } };
struct CmWin { __device__ __forceinline__ int operator()(int n) const { return n < 652 ? n : (n < 768 ? -1 : n - 116); } };
struct CmFF { __device__ __forceinline__ int operator()(int n) const { return (n >> 8) * 128 + (n & 127); } };

__device__ __forceinline__ void phase_prologue(Frame& F0) {
    Frame F = F0; asm volatile("" : "+v"(F.tid)); F.lane = F.tid & 63;
    LAS float* scr = (LAS float*)(F.lds + F.wave * WREG);
    const int gw = F.bx * NWAVES + F.wave, NGW = F.G * NWAVES;
    for (int L = 0; L < NL; ++L) {
        unsigned char* wl = F.ws + WS_W + (size_t)L * WL_STRIDE;
        const float* g_mix = F.in[I_NORM_MIX] + L * D; const float* g_ffn = F.in[I_NORM_FFN] + L * D; const float* g_ple = F.in[I_NORM_PLE] + L * D;
        { const int nblk = UW / 32, items = (D / 64) * nblk; const float* W = F.in[I_W_IN] + (size_t)L * D * DIN;
          for (int it = gw; it < items; it += NGW) transpose_item(W, DIN, D, g_mix, (bf16*)(wl + WL_IN), scr, it, nblk, F.lane, CmWin()); }
        for (int m = 0; m < 4; ++m) { const int nblk = D / 32, items = (D / 64) * nblk; const float* W = F.in[I_WGATE] + ((size_t)L * 4 + m) * D * D;
          for (int it = gw; it < items; it += NGW) transpose_item(W, D, D, g_mix, (bf16*)(wl + WL_G) + (size_t)m * D * D, scr, it, nblk, F.lane, CmIdent()); }
        for (int m = 0; m < 4; ++m) { const int nblk = D / 32, items = (MW / 64) * nblk; const float* W = F.in[I_WBR] + ((size_t)L * 4 + m) * MW * D;
          for (int it = gw; it < items; it += NGW) transpose_item(W, D, MW, nullptr, (bf16*)(wl + WL_B) + (size_t)m * D * MW, scr, it, nblk, F.lane, CmIdent()); }
        { const int nblk = D / 32, items = (D / 64) * nblk; const float* W = F.in[I_WOUT] + (size_t)L * D * D;
          for (int it = gw; it < items; it += NGW) transpose_item(W, D, D, nullptr, (bf16*)(wl + WL_OUT), scr, it, nblk, F.lane, CmIdent()); }
        { const int nblk = (2 * DFF) / 32, items = (D / 64) * nblk; const float* Wg = F.in[I_FFG] + (size_t)L * D * DFF; const float* Wu = F.in[I_FFU] + (size_t)L * D * DFF;
          for (int it = gw; it < items; it += NGW) { const int nb = it % nblk; const bool up = ((nb * 32) & 128) != 0; transpose_item(up ? Wu : Wg, DFF, D, g_ffn, (bf16*)(wl + WL_FF), scr, it, nblk, F.lane, CmFF()); } }
        { const int nblk = D / 32, items = (DFF / 64) * nblk; const float* W = F.in[I_FFD] + (size_t)L * DFF * D;
          for (int it = gw; it < items; it += NGW) transpose_item(W, D, DFF, nullptr, (bf16*)(wl + WL_DN), scr, it, nblk, F.lane, CmIdent()); }
        { const int nblk = D / 32, items = (D / 64) * nblk; const float* W = F.in[I_PLEG] + (size_t)L * D * D;
          for (int it = gw; it < items; it += NGW) transpose_item(W, D, D, g_ple, (bf16*)(wl + WL_PG), scr, it, nblk, F.lane, CmIdent()); }
        { const int nblk = D / 32, items = (PLE / 64) * nblk; const float* W = F.in[I_PLEP] + (size_t)L * PLE * D;
          for (int it = gw; it < items; it += NGW) transpose_item(W, D, PLE, nullptr, (bf16*)(wl + WL_PP), scr, it, nblk, F.lane, CmIdent()); }
    }
    { const float* x = F.in[I_X]; bf16* hb = (bf16*)(F.ws + WS_HBA); float* ss0 = (float*)(F.ws + WS_CTL) + CW_SS;
      for (int r = gw; r < T; r += NGW) { const f32x4* xr = (const f32x4*)(x + (size_t)r * D) + F.lane; float s = 0.f;
#pragma unroll
        for (int j = 0; j < 4; ++j) { const f32x4 v = xr[64 * j]; s += (v[0] * v[0] + v[1] * v[1]) + (v[2] * v[2] + v[3] * v[3]);
            u32x2 w; w.x = cvt_pk_bf16(v[0], v[1]); w.y = cvt_pk_bf16(v[2], v[3]); *((u32x2*)(hb + (size_t)r * D) + F.lane + 64 * j) = w; }
        s = wave_sum(s); if (F.lane == 0) ss0[r] = s; } }
    for (int L = 0; L < NL; ++L) { bf16* base = (bf16*)(F.ws + WS_RWUP + (size_t)L * 131072);
        for (int it = gw; it < 8; it += NGW) transpose_item(F.in[I_WUP] + (size_t)L * 64 * 256, 256, 64, nullptr, base, scr, it, 8, F.lane, CmIdent());
        for (int it = gw; it < 8; it += NGW) transpose_item(F.in[I_AUP] + (size_t)L * 64 * 256, 256, 64, nullptr, base + 256 * 64, scr, it, 8, F.lane, CmIdent());
        for (int it = gw; it < 16; it += NGW) transpose_item(F.in[I_GUP] + (size_t)L * 128 * 256, 256, 128, nullptr, base + 2 * 256 * 64, scr, it, 8, F.lane, CmIdent()); }
    { float* rope = (float*)(F.ws + WS_ROPE); const int gt = F.bx * NTHR + F.tid, NT_ = F.G * NTHR;
      for (int i = gt; i < S * 32; i += NT_) { const int pos = i >> 5, j = i & 31; const double inv = pow(10000.0, -(double)(2 * j) / 64.0); const double a = (double)pos * (double)(float)inv;
        rope[2 * i] = (float)cos(a); rope[2 * i + 1] = (float)sin(a); } }
}

__device__ __forceinline__ float ldu(const bf16* u, size_t row, int col) { return bf2f(u[row * UW + col]); }

__device__ __forceinline__ void phase_cmp(Frame& F0, int L) {
    Frame F = F0; asm volatile("" : "+v"(F.tid)); F.lane = F.tid & 63;
    const bf16* u = (const bf16*)(F.ws + WS_U);
    LAS float* xs = (LAS float*)(F.lds + F.wave * WREG);
    const int gw = F.bx * NWAVES + F.wave, NGW = F.G * NWAVES;
    for (int it = gw; it < NB * 512 * 2; it += NGW) {
        const int kv = it & 1, i = (it >> 1) & 511, b = it >> 10;
        bf16* outp = (bf16*)(F.ws + (kv ? WS_VCMP : WS_KCMP)) + ((size_t)b * 512 + i) * 64;
        if (i >= NCMP) { outp[F.lane] = 0; continue; }
        const float* pos = F.in[kv ? I_POS_V : I_POS_K] + (size_t)L * 2048;
        const float* w1 = F.in[kv ? I_CV1 : I_CK1] + (size_t)L * 2048 * 128;
        const float* w2 = F.in[kv ? I_CV2 : I_CK2] + (size_t)L * 128 * 64;
        const int col = U_NSA + (kv ? 320 : 256);
        for (int e = F.lane; e < 2048; e += 64) { const int tok = e >> 6, d = e & 63; xs[e] = ldu(u, (size_t)b * S + 16 * i + tok, col + d) + pos[e]; }
        LDS_WAIT();
        float h0 = 0.f, h1 = 0.f;
        for (int j = 0; j < 2048; ++j) { const float xv = xs[j]; h0 += xv * w1[(size_t)j * 128 + F.lane]; h1 += xv * w1[(size_t)j * 128 + 64 + F.lane]; }
        xs[2048 + F.lane] = fsilu(h0); xs[2048 + 64 + F.lane] = fsilu(h1);
        LDS_WAIT();
        float o = 0.f;
        for (int j = 0; j < 128; ++j) o += xs[2048 + j] * w2[j * 64 + F.lane];
        outp[F.lane] = (bf16)(cvt_pk_bf16(o, 0.f) & 0xffffu);
        LDS_WAIT();
    }
}

typedef short s16x4 __attribute__((ext_vector_type(4)));
__device__ __forceinline__ bf16x8 frag_rm(const LAS unsigned char* X, int ld, int r0, int k0, int lane) { return *(const LAS bf16x8*)(X + (r0 + (lane & 31)) * ld + (k0 + 8 * (lane >> 5)) * 2); }
__device__ __forceinline__ bf16x8 frag_tr(const LAS unsigned char* X, int ld, int k0, int c0, int lane) {
    const LAS unsigned char* p = X + (k0 + 8 * (lane >> 5) + ((lane & 15) >> 2)) * ld + (c0 + 16 * ((lane >> 4) & 1) + 4 * (lane & 3)) * 2;
    const s16x4 a = __builtin_amdgcn_ds_read_tr16_b64_v4i16((LAS s16x4*)p), b = __builtin_amdgcn_ds_read_tr16_b64_v4i16((LAS s16x4*)(p + 4 * ld));
    return (bf16x8){a[0], a[1], a[2], a[3], b[0], b[1], b[2], b[3]};
}
__device__ __forceinline__ bf16x8 frag_g(const bf16* X, int ld, int r0, int k0, int lane) { return *(const bf16x8*)(X + (size_t)(r0 + (lane & 31)) * ld + k0 + 8 * (lane >> 5)); }
__device__ __forceinline__ f32x16 mma32(const bf16x8& a, const bf16x8& b, const f32x16& c) { return __builtin_amdgcn_mfma_f32_32x32x16_bf16(a, b, c, 0, 0, 0); }
__device__ __forceinline__ f32x16 zero16() { f32x16 z;
#pragma unroll
    for (int i = 0; i < 16; ++i) z[i] = 0.f;
    return z; }
__device__ __forceinline__ void st_T(LAS unsigned char* X, int ld, int j0, int i0, const f32x16& acc, int lane) {
#pragma unroll
    for (int g = 0; g < 4; ++g) { u32x2 w; w.x = cvt_pk_bf16(acc[4 * g], acc[4 * g + 1]); w.y = cvt_pk_bf16(acc[4 * g + 2], acc[4 * g + 3]);
        *(LAS u32x2*)(X + (j0 + (lane & 31)) * ld + (i0 + 8 * g + 4 * (lane >> 5)) * 2) = w; }
}
__device__ __forceinline__ void st_wt8(bf16* p, const u32x2& w) { __hip_atomic_store((unsigned long long*)p, ((unsigned long long)w.y << 32) | (unsigned long long)w.x, __ATOMIC_RELAXED, __HIP_MEMORY_SCOPE_AGENT); }
__device__ __forceinline__ void st_T_g(bf16* X, int ld, int j0, int i0, const f32x16& acc, int lane) {
#pragma unroll
    for (int g = 0; g < 4; ++g) { u32x2 w; w.x = cvt_pk_bf16(acc[4 * g], acc[4 * g + 1]); w.y = cvt_pk_bf16(acc[4 * g + 2], acc[4 * g + 3]);
        st_wt8(X + (size_t)(j0 + (lane & 31)) * ld + i0 + 8 * g + 4 * (lane >> 5), w); }
}
constexpr int LD64 = 144, LD32 = 80;
__device__ __forceinline__ float expc(float x) { return __expf(fminf(fmaxf(x, -80.f), 80.f)); }
__device__ __forceinline__ unsigned short f2b(float x) { return (unsigned short)(cvt_pk_bf16(x, 0.f) & 0xffffu); }
__device__ __forceinline__ void copy_tok64(LAS unsigned char* X, const bf16* src, int lane) {
#pragma unroll
    for (int p = 0; p < 4; ++p) { const int t = 8 * p + (lane >> 3), ch = lane & 7; *(LAS u32x4*)(X + t * LD64 + ch * 16) = *(const u32x4*)(src + (size_t)t * UW + ch * 8); }
}
__device__ __forceinline__ void glin_m1(const LAS unsigned char* Kh, const LAS unsigned char* Vv, bf16* Sg, int lane, bool cst = false) {
#pragma unroll
    for (int dt = 0; dt < 2; ++dt)
#pragma unroll
        for (int et = 0; et < 2; ++et) { f32x16 acc = zero16();
#pragma unroll
            for (int ks = 0; ks < 2; ++ks) acc = mma32(frag_tr(Kh, LD64, 16 * ks, 32 * dt, lane), frag_tr(Vv, LD64, 16 * ks, 32 * et, lane), acc);
            if (cst) {
#pragma unroll
            for (int i = 0; i < 16; ++i) acc[i] = 0.01f * (float)(1 + ((lane + i) & 7)); }
            st_T_g(Sg, 64, 32 * et, 32 * dt, acc, lane); }
}
__device__ __forceinline__ void glin_m3(const LAS unsigned char* Qt, const LAS unsigned char* Kt, const LAS unsigned char* Vv, LAS unsigned char* Xa, const bf16* S0, int lane, f32x16 (&o)[2]) {
    { f32x16 acc = zero16();
#pragma unroll
      for (int ks = 0; ks < 4; ++ks) acc = mma32(frag_rm(Kt, LD64, 0, 16 * ks, lane), frag_rm(Qt, LD64, 0, 16 * ks, lane), acc);
      const int t = lane & 31;
#pragma unroll
      for (int i = 0; i < 16; ++i) { const int sidx = (i & 3) + 8 * (i >> 2) + 4 * (lane >> 5); if (sidx > t) acc[i] = 0.f; }
      st_T(Xa, LD32, 0, 0, acc, lane); }
    LDS_WAIT();
#pragma unroll
    for (int et = 0; et < 2; ++et) { f32x16 acc = zero16();
        if (S0) {
#pragma unroll
            for (int ks = 0; ks < 4; ++ks) acc = mma32(frag_g(S0, 64, 32 * et, 16 * ks, lane), frag_rm(Qt, LD64, 0, 16 * ks, lane), acc); }
#pragma unroll
        for (int ks = 0; ks < 2; ++ks) acc = mma32(frag_tr(Vv, LD64, 16 * ks, 32 * et, lane), frag_rm(Xa, LD32, 0, 16 * ks, lane), acc);
        o[et] = acc; }
}
template <bool M3>
__device__ __forceinline__ void hgrn_chunk(Frame& F, int L, int bh, int n, LAS unsigned char* W, bf16* Sbase, float* Dbase) {
    const bf16* u = (const bf16*)(F.ws + WS_U); bf16* bo = (bf16*)(F.ws + WS_BO);
    int lane = F.lane; asm volatile("" : "+v"(lane));
    const int b = bh >> 2, h = bh & 3; const size_t row0 = (size_t)b * S + (size_t)n * CH;
    const bf16* ur = u + row0 * UW + U_HG + h * 64;
    bf16* Sg = Sbase + ((size_t)bh * NCH + n) * 4096;
    LAS unsigned char* Xq = W; LAS unsigned char* Xk = W + 4608; LAS unsigned char* Xv = W + 9216; LAS unsigned char* Xa = W + 13824;
    const float* lbl = F.in[I_LB]; const int ch = h * 64 + lane;
    float lb = 0.f; if (L > 0) { const float l0 = lbl[ch], l1 = lbl[256 + ch]; const float mx = fmaxf(l0, l1); const float e0 = __expf(l0 - mx), e1 = __expf(l1 - mx); lb = e1 / (e0 + e1); }
    float bcum[CH], kk[CH]; float run = 0.f;
#pragma unroll
    for (int t = 0; t < CH; ++t) { const float z = bf2f(ur[(size_t)t * UW + 256 + lane]); const float f = lb + (1.0f - lb) * fsigmoid(z); kk[t] = 1.0f - f; run += __logf(fmaxf(f, 1e-20f)); bcum[t] = run; }
    const float blast = bcum[CH - 1];
    copy_tok64(Xv, ur + 512, lane);
    if (!M3) {
#pragma unroll
        for (int t = 0; t < CH; ++t) *(LAS unsigned short*)(Xq + t * LD64 + lane * 2) = f2b(kk[t] * expc(blast - bcum[t]));
        Dbase[((size_t)bh * NCH + n) * 64 + lane] = expc(blast);
        LDS_WAIT();
        glin_m1(Xq, Xv, Sg, lane);
    } else {
#pragma unroll
        for (int t = 0; t < CH; ++t) { const float q = fsilu(bf2f(ur[(size_t)t * UW + lane]));
            *(LAS unsigned short*)(Xq + t * LD64 + lane * 2) = f2b(q * expc(bcum[t]));
            *(LAS unsigned short*)(Xk + t * LD64 + lane * 2) = f2b(kk[t] * expc(-bcum[t])); }
        LDS_WAIT();
        f32x16 o[2];
        glin_m3(Xq, Xk, Xv, Xa, n > 0 ? Sg - 4096 : nullptr, lane, o);
        const int t = lane & 31, hh = lane >> 5; float ss = 0.f;
#pragma unroll
        for (int et = 0; et < 2; ++et)
#pragma unroll
            for (int i = 0; i < 16; ++i) ss += o[et][i] * o[et][i];
        ss += __shfl_xor(ss, 32);
        const float rn = __builtin_amdgcn_rsqf(ss * (1.0f / 64.0f) + EPS);
        const float* ng = F.in[I_HG_NORM] + L * 256 + h * 64;
#pragma unroll
        for (int et = 0; et < 2; ++et)
#pragma unroll
            for (int g = 0; g < 4; ++g) { const int e0 = 32 * et + 8 * g + 4 * hh;
                const u32x2 og = *(const u32x2*)(ur + (size_t)t * UW + 768 + e0); const f32x4 gg = *(const f32x4*)(ng + e0);
                const float y0 = o[et][4 * g] * rn * gg[0] * fsilu(bflo(og.x)), y1 = o[et][4 * g + 1] * rn * gg[1] * fsilu(bfhi(og.x));
                const float y2 = o[et][4 * g + 2] * rn * gg[2] * fsilu(bflo(og.y)), y3 = o[et][4 * g + 3] * rn * gg[3] * fsilu(bfhi(og.y));
                u32x2 w; w.x = cvt_pk_bf16(y0, y1); w.y = cvt_pk_bf16(y2, y3);
                *(u32x2*)(bo + (row0 + t) * 1024 + 256 + h * 64 + e0) = w; }
    }
    LDS_WAIT();
}
template <bool M3>
__device__ __forceinline__ void ret_chunk(Frame& F, int L, int bh, int n, LAS unsigned char* W, bf16* Sbase) {
    const bf16* u = (const bf16*)(F.ws + WS_U); bf16* bo = (bf16*)(F.ws + WS_BO); const float* rope = (const float*)(F.ws + WS_ROPE);
    int lane = F.lane; asm volatile("" : "+v"(lane));
    const int b = bh >> 2, h = bh & 3; const int tpos0 = n * CH; const size_t row0 = (size_t)b * S + (size_t)tpos0;
    const bf16* ur = u + row0 * UW + U_RT + h * 64;
    bf16* Sg = Sbase + ((size_t)bh * NCH + n) * 4096;
    LAS unsigned char* Xq = W; LAS unsigned char* Xk = W + 4608; LAS unsigned char* Xv = W + 9216; LAS unsigned char* Xa = W + 13824;
    const float lg2 = __log2f(1.0f - exp2f(-5.0f - (float)h));
    copy_tok64(Xv, ur + 512, lane);
#pragma unroll
    for (int p = 0; p < 2; ++p) { const int idx = lane + 64 * p, t = idx >> 2, jc = idx & 3;
        f32x4 c0, c1, s0, s1;
        { const float* rp = rope + ((size_t)(tpos0 + t) * 32 + jc * 8) * 2; const f32x4 a = *(const f32x4*)rp, bq = *(const f32x4*)(rp + 4), c = *(const f32x4*)(rp + 8), d = *(const f32x4*)(rp + 12);
          c0 = (f32x4){a[0], a[2], bq[0], bq[2]}; s0 = (f32x4){a[1], a[3], bq[1], bq[3]}; c1 = (f32x4){c[0], c[2], d[0], d[2]}; s1 = (f32x4){c[1], c[3], d[1], d[3]}; }
        { const u32x4 w1 = *(const u32x4*)(ur + (size_t)t * UW + 256 + jc * 8), w2 = *(const u32x4*)(ur + (size_t)t * UW + 256 + 32 + jc * 8);
          f32x4 a0, a1, b0, b1; unpack8(w1, a0, a1); unpack8(w2, b0, b1);
          const float sc = 0.125f * exp2f(lg2 * (M3 ? -(float)(t + 1) : (float)(CH - 1 - t)));
          const f32x4 lo0 = (a0 * c0 - b0 * s0) * sc, lo1 = (a1 * c1 - b1 * s1) * sc, hi0 = (a0 * s0 + b0 * c0) * sc, hi1 = (a1 * s1 + b1 * c1) * sc;
          LAS unsigned char* dst = M3 ? Xk : Xq;
          *(LAS u32x4*)(dst + t * LD64 + jc * 16) = pack8(lo0, lo1); *(LAS u32x4*)(dst + t * LD64 + 64 + jc * 16) = pack8(hi0, hi1); }
        if (M3) { const u32x4 w1 = *(const u32x4*)(ur + (size_t)t * UW + jc * 8), w2 = *(const u32x4*)(ur + (size_t)t * UW + 32 + jc * 8);
          f32x4 a0, a1, b0, b1; unpack8(w1, a0, a1); unpack8(w2, b0, b1);
          const float sc = exp2f(lg2 * (float)(t + 1));
          const f32x4 lo0 = (a0 * c0 - b0 * s0) * sc, lo1 = (a1 * c1 - b1 * s1) * sc, hi0 = (a0 * s0 + b0 * c0) * sc, hi1 = (a1 * s1 + b1 * c1) * sc;
          *(LAS u32x4*)(Xq + t * LD64 + jc * 16) = pack8(lo0, lo1); *(LAS u32x4*)(Xq + t * LD64 + 64 + jc * 16) = pack8(hi0, hi1); }
    }
    LDS_WAIT();
    if (!M3) glin_m1(Xq, Xv, Sg, lane);
    else {
        f32x16 o[2];
        glin_m3(Xq, Xk, Xv, Xa, n > 0 ? Sg - 4096 : nullptr, lane, o);
        const int t = lane & 31, hh = lane >> 5; float sm = 0.f;
#pragma unroll
        for (int et = 0; et < 2; ++et)
#pragma unroll
            for (int i = 0; i < 16; ++i) sm += o[et][i];
        sm += __shfl_xor(sm, 32);
        const float mean = sm * (1.0f / 64.0f); float sv = 0.f;
#pragma unroll
        for (int et = 0; et < 2; ++et)
#pragma unroll
            for (int i = 0; i < 16; ++i) { const float dl = o[et][i] - mean; sv += dl * dl; }
        sv += __shfl_xor(sv, 32);
        const float rn = __builtin_amdgcn_rsqf(sv * (1.0f / 64.0f) + 1e-5f);
        const float* ng = F.in[I_RT_G] + L * 256 + h * 64; const float* nb = F.in[I_RT_B] + L * 256 + h * 64;
#pragma unroll
        for (int et = 0; et < 2; ++et)
#pragma unroll
            for (int g = 0; g < 4; ++g) { const int e0 = 32 * et + 8 * g + 4 * hh;
                const u32x2 og = *(const u32x2*)(ur + (size_t)t * UW + 768 + e0); const f32x4 gg = *(const f32x4*)(ng + e0), bb = *(const f32x4*)(nb + e0);
                const float y0 = ((o[et][4 * g] - mean) * rn * gg[0] + bb[0]) * fsilu(bflo(og.x)), y1 = ((o[et][4 * g + 1] - mean) * rn * gg[1] + bb[1]) * fsilu(bfhi(og.x));
                const float y2 = ((o[et][4 * g + 2] - mean) * rn * gg[2] + bb[2]) * fsilu(bflo(og.y)), y3 = ((o[et][4 * g + 3] - mean) * rn * gg[3] + bb[3]) * fsilu(bfhi(og.y));
                u32x2 w; w.x = cvt_pk_bf16(y0, y1); w.y = cvt_pk_bf16(y2, y3);
                *(u32x2*)(bo + (row0 + t) * 1024 + 512 + h * 64 + e0) = w; }
    }
    LDS_WAIT();
}
__device__ __forceinline__ void glin_scan_task(bf16* Sbase, const float* Dbase, float dscal, int bh, int quarter, int tl  ) {
    bf16* p = Sbase + (size_t)bh * NCH * 4096 + quarter * 1024 + tl * 4;
    const int d0 = (tl & 15) * 4;
    f32x4 st = {0.f, 0.f, 0.f, 0.f};
    for (int n0 = 0; n0 < NCH; n0 += 8) {
        u32x2 kv[8]; f32x4 dd[8];
#pragma unroll
        for (int j = 0; j < 8; ++j) { kv[j] = *(const u32x2*)(p + (size_t)(n0 + j) * 4096); if (Dbase) dd[j] = *(const f32x4*)(Dbase + ((size_t)bh * NCH + n0 + j) * 64 + d0); else dd[j] = (f32x4){dscal, dscal, dscal, dscal}; }
#pragma unroll
        for (int j = 0; j < 8; ++j) {
            st[0] = st[0] * dd[j][0] + bflo(kv[j].x); st[1] = st[1] * dd[j][1] + bfhi(kv[j].x); st[2] = st[2] * dd[j][2] + bflo(kv[j].y); st[3] = st[3] * dd[j][3] + bfhi(kv[j].y);
            u32x2 w; w.x = cvt_pk_bf16(st[0], st[1]); w.y = cvt_pk_bf16(st[2], st[3]); st_wt8(p + (size_t)(n0 + j) * 4096, w); }
    }
}

constexpr int RW_R0 = 0, RW_R1 = 4608, RW_R2 = 9216, RW_R3 = 13824, RW_R4 = 16384, RW_R5 = 18944, RW_LW = 0, RW_AG = 8704, LDLW = 272;
__device__ __forceinline__ void ld_shift8(const bf16* urow, bool has_prev, const float* mu8, f32x4& lo, f32x4& hi) {
    const u32x4 w1 = *(const u32x4*)urow; f32x4 a0, a1; unpack8(w1, a0, a1);
    f32x4 p0 = {0.f, 0.f, 0.f, 0.f}, p1 = {0.f, 0.f, 0.f, 0.f};
    if (has_prev) { const u32x4 w0 = *(const u32x4*)(urow - UW); unpack8(w0, p0, p1); }
    const f32x4 m0 = *(const f32x4*)mu8, m1 = *(const f32x4*)(mu8 + 4);
    lo = a0 + m0 * (p0 - a0); hi = a1 + m1 * (p1 - a1);
}
__device__ __forceinline__ float ftanh(float x) { return 1.0f - 2.0f * __builtin_amdgcn_rcpf(1.0f + __builtin_amdgcn_exp2f(2.8853900817779268f * x)); }
#ifndef RW_LIMIT
#define RW_LIMIT 100
#endif
#define RW_CUT(k) do { if (RW_LIMIT <= (k)) return; } while (0)
template <int SI> struct SubstStep {
    static __device__ __forceinline__ void run(float (&Tr)[CH], const LAS unsigned char* AT, int r32, int& ofs) {
        float a0 = (r32 == SI) ? 1.0f : 0.f, a1 = 0.f;
#pragma unroll
        for (int q = 0; q < 4; ++q) { if (8 * q + 7 > SI) { const u32x4 w = *(const LAS u32x4*)(AT + ofs + SI * LD32 + q * 16); f32x4 lo, hi; unpack8(w, lo, hi);
#pragma unroll
            for (int x = 0; x < 4; ++x) { if (8 * q + x > SI) a0 += Tr[8 * q + x] * lo[x]; if (8 * q + 4 + x > SI) a1 += Tr[8 * q + 4 + x] * hi[x]; } } }
        const float a = a0 + a1;
        Tr[SI] = a;
        asm volatile("" : "+v"(ofs) : "v"(a));
        SubstStep<SI - 1>::run(Tr, AT, r32, ofs);
    }
};
template <> struct SubstStep<-1> { static __device__ __forceinline__ void run(float (&)[CH], const LAS unsigned char*, int, int&) {} };
template <bool M3>
__device__ __forceinline__ void rwkv_chunk(Frame& F, int L, int bh, int n, LAS unsigned char* W) {
    const bf16* u = (const bf16*)(F.ws + WS_U); bf16* bo = (bf16*)(F.ws + WS_BO);
    int lane = F.lane; asm volatile("" : "+v"(lane));
    const int b = bh >> 2, h = bh & 3, r32 = lane & 31, hh = lane >> 5; const size_t row0 = (size_t)b * S + (size_t)n * CH;
    const bf16* ur = u + row0 * UW + U_RW;
    const float* mu = F.in[I_MU] + L * 1024;
    const bf16* upT = (const bf16*)(F.ws + WS_RWUP + (size_t)L * 131072);
    bf16* Mg = (bf16*)(F.ws + WS_RWM) + ((size_t)bh * NCH + n) * 4096;
    bf16* Ng = (bf16*)(F.ws + WS_RWN) + ((size_t)bh * NCH + n) * 4096;
    LAS unsigned char* R0 = W + RW_R0; LAS unsigned char* R1 = W + RW_R1; LAS unsigned char* R2 = W + RW_R2; LAS unsigned char* R3 = W + RW_R3; LAS unsigned char* R4 = W + RW_R4;
    LAS float* R5 = (LAS float*)(W + RW_R5);
#pragma unroll
    for (int i = 0; i < 8; ++i) { const int idx = lane + 64 * i, t = idx >> 4, part = (idx >> 3) & 1, ch = idx & 7, col = 768 + part * 64 + ch * 8;
        f32x4 lo, hi; ld_shift8(ur + (size_t)t * UW + col, (n * CH + t) > 0, mu + col, lo, hi);
        if (part == 0) {
#pragma unroll
            for (int j = 0; j < 4; ++j) { lo[j] = ftanh(lo[j]); hi[j] = ftanh(hi[j]); } }
        *(LAS u32x4*)(W + part * 4608 + t * LD64 + ch * 16) = pack8(lo, hi); }
    RW_CUT(0);
    LDS_WAIT();
    { f32x16 zw[2], za[2];
#pragma unroll
      for (int ct = 0; ct < 2; ++ct) { zw[ct] = zero16(); za[ct] = zero16();
#pragma unroll
        for (int ks = 0; ks < 4; ++ks) { zw[ct] = mma32(frag_g(upT + (size_t)(h * 64 + 32 * ct) * 64, 64, 0, 16 * ks, lane), frag_rm(W, LD64, 0, 16 * ks, lane), zw[ct]);
            za[ct] = mma32(frag_g(upT + 256 * 64 + (size_t)(h * 64 + 32 * ct) * 64, 64, 0, 16 * ks, lane), frag_rm(W + 4608, LD64, 0, 16 * ks, lane), za[ct]); } }
      const float* w0 = F.in[I_W0] + L * 256 + h * 64; const float* a0 = F.in[I_A0] + L * 256 + h * 64;
#pragma unroll
      for (int ct = 0; ct < 2; ++ct)
#pragma unroll
        for (int g = 0; g < 4; ++g) { const int c0 = 32 * ct + 8 * g + 4 * hh; const f32x4 wv = *(const f32x4*)(w0 + c0), av = *(const f32x4*)(a0 + c0);
            f32x4 lw, ag;
#pragma unroll
            for (int x = 0; x < 4; ++x) { lw[x] = -0.6065306597126334f * fsigmoid(zw[ct][4 * g + x] + wv[x]); ag[x] = fsigmoid(za[ct][4 * g + x] + av[x]); }
            *(LAS f32x4*)(W + RW_LW + r32 * LDLW + c0 * 4) = lw;
            u32x2 pk; pk.x = cvt_pk_bf16(ag[0], ag[1]); pk.y = cvt_pk_bf16(ag[2], ag[3]); *(LAS u32x2*)(W + RW_AG + r32 * LD64 + c0 * 2) = pk; } }
    RW_CUT(1);
    LDS_WAIT();
    { float run = 0.f;
#pragma unroll
      for (int t = 0; t < CH; ++t) { LAS float* p = (LAS float*)(W + RW_LW + t * LDLW) + lane; run += *p; *p = run; } }
    RW_CUT(2);
    LDS_WAIT();
    const int c0 = 8 * (lane & 7), tl = lane >> 3;
    u32x4 E1p[4], E2p[4], AGp[4];
#pragma unroll
    for (int p = 0; p < 4; ++p) { const int t = 8 * p + tl;
        const f32x4 ca = *(const LAS f32x4*)(W + RW_LW + t * LDLW + c0 * 4), cb = *(const LAS f32x4*)(W + RW_LW + t * LDLW + c0 * 4 + 16);
        f32x4 ea = {0.f, 0.f, 0.f, 0.f}, eb = {0.f, 0.f, 0.f, 0.f};
        if (t > 0) { ea = *(const LAS f32x4*)(W + RW_LW + (t - 1) * LDLW + c0 * 4); eb = *(const LAS f32x4*)(W + RW_LW + (t - 1) * LDLW + c0 * 4 + 16); }
        AGp[p] = *(const LAS u32x4*)(W + RW_AG + t * LD64 + c0 * 2);
        f32x4 x1a, x1b, x2a, x2b;
#pragma unroll
        for (int x = 0; x < 4; ++x) { x1a[x] = __expf(ea[x]); x1b[x] = __expf(eb[x]); x2a[x] = __expf(-ca[x]); x2b[x] = __expf(-cb[x]); }
        E1p[p] = pack8(x1a, x1b); E2p[p] = pack8(x2a, x2b); }
    float pcl[8];
    { const f32x4 la = *(const LAS f32x4*)(W + RW_LW + 31 * LDLW + c0 * 4), lb2 = *(const LAS f32x4*)(W + RW_LW + 31 * LDLW + c0 * 4 + 16);
#pragma unroll
      for (int x = 0; x < 4; ++x) { pcl[x] = __expf(la[x]); pcl[4 + x] = __expf(lb2[x]); } }
    RW_CUT(3);
    LDS_WAIT();
    const float* kkw = F.in[I_KK] + L * 256 + h * 64 + c0; const float* kaw = F.in[I_KA] + L * 256 + h * 64 + c0; const float* rkw = F.in[I_RK] + L * 256 + h * 64 + c0;
    u32x4 Ap[4];
    if (!M3 && tl == 0) { *(LAS f32x4*)(R5 + c0) = (f32x4){pcl[0], pcl[1], pcl[2], pcl[3]}; *(LAS f32x4*)(R5 + c0 + 4) = (f32x4){pcl[4], pcl[5], pcl[6], pcl[7]}; }
#pragma unroll
    for (int p = 0; p < 4; ++p) { const int t = 8 * p + tl; const bool hp = (n * CH + t) > 0; const bf16* ut = ur + (size_t)t * UW + h * 64 + c0;
        f32x4 k0, k1, r0 = {0.f, 0.f, 0.f, 0.f}, r1 = {0.f, 0.f, 0.f, 0.f};
        ld_shift8(ut + 256, hp, mu + 256 + h * 64 + c0, k0, k1);
        if (M3) ld_shift8(ut, hp, mu + h * 64 + c0, r0, r1);
        f32x4 ag0, ag1; unpack8(AGp[p], ag0, ag1);
        float E1[8], E2[8]; { f32x4 a, bq; unpack8(E1p[p], a, bq); f32x4 c, d; unpack8(E2p[p], c, d);
#pragma unroll
            for (int x = 0; x < 4; ++x) { E1[x] = a[x]; E1[4 + x] = bq[x]; E2[x] = c[x]; E2[4 + x] = d[x]; } }
        const f32x4 kw0 = *(const f32x4*)kkw, kw1 = *(const f32x4*)(kkw + 4), ka0 = *(const f32x4*)kaw, ka1 = *(const f32x4*)(kaw + 4);
        f32x4 q0 = k0 * kw0, q1 = k1 * kw1;
        float n2 = (q0[0] * q0[0] + q0[1] * q0[1]) + (q0[2] * q0[2] + q0[3] * q0[3]) + (q1[0] * q1[0] + q1[1] * q1[1]) + (q1[2] * q1[2] + q1[3] * q1[3]);
        n2 += __shfl_xor(n2, 1); n2 += __shfl_xor(n2, 2); n2 += __shfl_xor(n2, 4);
        const float rn = __builtin_amdgcn_rsqf(fmaxf(n2, 1e-24f)); q0 = q0 * rn; q1 = q1 * rn;
        f32x4 kp0, kp1, at0, at1, bt0, bt1, kt0, kt1;
#pragma unroll
        for (int x = 0; x < 4; ++x) { kp0[x] = k0[x] * (1.0f + (ag0[x] - 1.0f) * ka0[x]); kp1[x] = k1[x] * (1.0f + (ag1[x] - 1.0f) * ka1[x]);
            at0[x] = -q0[x] * E1[x]; at1[x] = -q1[x] * E1[4 + x]; bt0[x] = q0[x] * ag0[x] * E2[x]; bt1[x] = q1[x] * ag1[x] * E2[4 + x];
            kt0[x] = kp0[x] * E2[x]; kt1[x] = kp1[x] * E2[4 + x]; }
        *(LAS u32x4*)(R1 + t * LD64 + c0 * 2) = pack8(bt0, bt1); *(LAS u32x4*)(R2 + t * LD64 + c0 * 2) = pack8(kt0, kt1);
        if (!M3) *(LAS u32x4*)(R0 + t * LD64 + c0 * 2) = pack8(at0, at1);
        else { Ap[p] = pack8(at0, at1);
            const f32x4 rk0 = *(const f32x4*)rkw, rk1 = *(const f32x4*)(rkw + 4);
            f32x4 rt0, rt1; float bs = 0.f;
#pragma unroll
            for (int x = 0; x < 4; ++x) { rt0[x] = r0[x] * __builtin_amdgcn_rcpf(E2[x]); rt1[x] = r1[x] * __builtin_amdgcn_rcpf(E2[4 + x]); bs += r0[x] * kp0[x] * rk0[x] + r1[x] * kp1[x] * rk1[x]; }
            bs += __shfl_xor(bs, 1); bs += __shfl_xor(bs, 2); bs += __shfl_xor(bs, 4);
            if ((lane & 7) == 0) R5[t] = bs;
            *(LAS u32x4*)(R0 + t * LD64 + c0 * 2) = pack8(rt0, rt1); } }
    RW_CUT(4);
    LDS_WAIT();
    const bf16* S0 = n > 0 ? Ng - 4096 : nullptr;
    f32x16 yacc[2], g2acc;
    if (M3) {
#pragma unroll
        for (int vt = 0; vt < 2; ++vt) { yacc[vt] = zero16();
            if (S0) {
#pragma unroll
                for (int ks = 0; ks < 4; ++ks) yacc[vt] = mma32(frag_g(S0, 64, 32 * vt, 16 * ks, lane), frag_rm(R0, LD64, 0, 16 * ks, lane), yacc[vt]); } }
        f32x16 g1 = zero16(); g2acc = zero16();
#pragma unroll
        for (int ks = 0; ks < 4; ++ks) { const bf16x8 rf = frag_rm(R0, LD64, 0, 16 * ks, lane); g1 = mma32(frag_rm(R1, LD64, 0, 16 * ks, lane), rf, g1); g2acc = mma32(frag_rm(R2, LD64, 0, 16 * ks, lane), rf, g2acc); }
#pragma unroll
        for (int i = 0; i < 16; ++i) { const int sidx = (i & 3) + 8 * (i >> 2) + 4 * hh; if (sidx > r32) { g1[i] = 0.f; g2acc[i] = 0.f; } }
        st_T(R4, LD32, 0, 0, g1, lane);
        LDS_WAIT();
#pragma unroll
        for (int p = 0; p < 4; ++p) *(LAS u32x4*)(R0 + (8 * p + tl) * LD64 + c0 * 2) = Ap[p];
        LDS_WAIT();
    }
    RW_CUT(5);
    { f32x16 ab = zero16(), ak = zero16();
#pragma unroll
      for (int ks = 0; ks < 4; ++ks) { const bf16x8 af = frag_rm(R0, LD64, 0, 16 * ks, lane); ab = mma32(af, frag_rm(R1, LD64, 0, 16 * ks, lane), ab); ak = mma32(frag_rm(R2, LD64, 0, 16 * ks, lane), af, ak); }
#pragma unroll
      for (int i = 0; i < 16; ++i) { const int ridx = (i & 3) + 8 * (i >> 2) + 4 * hh;
          if (!(ridx > r32)) ab[i] = 0.f;
          if (!(ridx < r32)) ak[i] = 0.f; }
      st_T(R3, LD32, 0, 0, ab, lane);
      st_T(M3 ? R2 : R4, LD32, 0, 0, ak, lane); }
    LAS unsigned char* X1 = M3 ? R2 : R4;
    RW_CUT(6);
    LDS_WAIT();
    { float Tr[CH];
      int sofs = 0; asm volatile("" : "+v"(sofs)); SubstStep<CH - 1>::run(Tr, R3, r32, sofs);
      if (hh == 0) {
#pragma unroll
          for (int q = 0; q < 4; ++q) { f32x4 lo = {Tr[8 * q], Tr[8 * q + 1], Tr[8 * q + 2], Tr[8 * q + 3]}, hi = {Tr[8 * q + 4], Tr[8 * q + 5], Tr[8 * q + 6], Tr[8 * q + 7]};
              *(LAS u32x4*)(R3 + r32 * LD32 + q * 16) = pack8(lo, hi); } } }
    RW_CUT(7);
    LDS_WAIT();
    { f32x16 y = zero16(), ah[2];
#pragma unroll
      for (int ks = 0; ks < 2; ++ks) y = mma32(frag_tr(X1, LD32, 16 * ks, 0, lane), frag_rm(R3, LD32, 0, 16 * ks, lane), y);
#pragma unroll
      for (int ct = 0; ct < 2; ++ct) { ah[ct] = zero16();
#pragma unroll
        for (int ks = 0; ks < 2; ++ks) ah[ct] = mma32(frag_tr(R0, LD64, 16 * ks, 32 * ct, lane), frag_rm(R3, LD32, 0, 16 * ks, lane), ah[ct]); }
      st_T(X1, LD32, 0, 0, y, lane);
      st_T(R0, LD64, 0, 0, ah[0], lane); st_T(R0, LD64, 0, 32, ah[1], lane); }
    RW_CUT(8);
    LDS_WAIT();
    if (!M3) {
        { f32x16 z[2];
#pragma unroll
          for (int dt = 0; dt < 2; ++dt) {
#pragma unroll
            for (int g = 0; g < 4; ++g) { const u32x2 w = *(const LAS u32x2*)(R2 + r32 * LD64 + (32 * dt + 8 * g + 4 * hh) * 2); z[dt][4 * g] = bflo(w.x); z[dt][4 * g + 1] = bfhi(w.x); z[dt][4 * g + 2] = bflo(w.y); z[dt][4 * g + 3] = bfhi(w.y); }
#pragma unroll
            for (int ks = 0; ks < 2; ++ks) z[dt] = mma32(frag_tr(R1, LD64, 16 * ks, 32 * dt, lane), frag_tr(X1, LD32, 16 * ks, 0, lane), z[dt]); }
          st_T(R2, LD64, 0, 0, z[0], lane); st_T(R2, LD64, 0, 32, z[1], lane); }
#pragma unroll
        for (int d1t = 0; d1t < 2; ++d1t) { const float pc1 = R5[32 * d1t + r32];
#pragma unroll
            for (int d2t = 0; d2t < 2; ++d2t) { f32x16 m = zero16();
#pragma unroll
                for (int ks = 0; ks < 2; ++ks) m = mma32(frag_tr(R0, LD64, 16 * ks, 32 * d2t, lane), frag_tr(R1, LD64, 16 * ks, 32 * d1t, lane), m);
#pragma unroll
                for (int i = 0; i < 16; ++i) { const int d2 = 32 * d2t + (i & 3) + 8 * (i >> 2) + 4 * hh; m[i] = pc1 * (m[i] + ((d2 == 32 * d1t + r32) ? 1.0f : 0.f)); }
                st_T_g(Mg, 64, 32 * d1t, 32 * d2t, m, lane); } }
        LDS_WAIT();
#pragma unroll
        for (int p = 0; p < 4; ++p) { const int t = 8 * p + tl; f32x4 v0, v1; ld_shift8(ur + (size_t)t * UW + h * 64 + c0 + 512, (n * CH + t) > 0, mu + 512 + h * 64 + c0, v0, v1); *(LAS u32x4*)(R1 + t * LD64 + c0 * 2) = pack8(v0, v1); }
        LDS_WAIT();
#pragma unroll
        for (int dt = 0; dt < 2; ++dt)
#pragma unroll
            for (int vt = 0; vt < 2; ++vt) { f32x16 nn = zero16();
#pragma unroll
                for (int ks = 0; ks < 2; ++ks) nn = mma32(frag_tr(R2, LD64, 16 * ks, 32 * dt, lane), frag_tr(R1, LD64, 16 * ks, 32 * vt, lane), nn);
#pragma unroll
                for (int g = 0; g < 4; ++g) { const f32x4 pv = *(const LAS f32x4*)(R5 + 32 * dt + 8 * g + 4 * hh);
#pragma unroll
                    for (int x = 0; x < 4; ++x) nn[4 * g + x] *= pv[x]; }
                st_T_g(Ng, 64, 32 * vt, 32 * dt, nn, lane); }
    } else {
        { f32x16 rh[2];
#pragma unroll
          for (int dt = 0; dt < 2; ++dt) { rh[dt] = zero16();
#pragma unroll
            for (int ks = 0; ks < 2; ++ks) rh[dt] = mma32(frag_tr(R0, LD64, 16 * ks, 32 * dt, lane), frag_rm(R4, LD32, 0, 16 * ks, lane), rh[dt]); }
          st_T(R1, LD64, 0, 0, rh[0], lane); st_T(R1, LD64, 0, 32, rh[1], lane); }
        { f32x16 gh = g2acc;
#pragma unroll
          for (int ks = 0; ks < 2; ++ks) gh = mma32(frag_tr(X1, LD32, 16 * ks, 0, lane), frag_rm(R4, LD32, 0, 16 * ks, lane), gh);
          LDS_WAIT();
          st_T(R3, LD32, 0, 0, gh, lane); }
        LDS_WAIT();
        if (S0) {
#pragma unroll
            for (int vt = 0; vt < 2; ++vt)
#pragma unroll
                for (int ks = 0; ks < 4; ++ks) yacc[vt] = mma32(frag_g(S0, 64, 32 * vt, 16 * ks, lane), frag_rm(R1, LD64, 0, 16 * ks, lane), yacc[vt]); }
        LDS_WAIT();
#pragma unroll
        for (int p = 0; p < 4; ++p) { const int t = 8 * p + tl; f32x4 v0, v1; ld_shift8(ur + (size_t)t * UW + h * 64 + c0 + 512, (n * CH + t) > 0, mu + 512 + h * 64 + c0, v0, v1); *(LAS u32x4*)(R0 + t * LD64 + c0 * 2) = pack8(v0, v1); }
#pragma unroll
        for (int i = 0; i < 8; ++i) { const int idx = lane + 64 * i, t = idx >> 4, ch = idx & 15, col = 896 + ch * 8;
            f32x4 lo, hi; ld_shift8(ur + (size_t)t * UW + col, (n * CH + t) > 0, mu + col, lo, hi);
#pragma unroll
            for (int j = 0; j < 4; ++j) { lo[j] = fsigmoid(lo[j]); hi[j] = fsigmoid(hi[j]); }
            *(LAS u32x4*)(R1 + t * LDLW + ch * 16) = pack8(lo, hi); }
        LDS_WAIT();
        f32x16 gacc[2];
#pragma unroll
        for (int vt = 0; vt < 2; ++vt) {
#pragma unroll
            for (int ks = 0; ks < 2; ++ks) yacc[vt] = mma32(frag_tr(R0, LD64, 16 * ks, 32 * vt, lane), frag_rm(R3, LD32, 0, 16 * ks, lane), yacc[vt]);
            gacc[vt] = zero16();
#pragma unroll
            for (int ks = 0; ks < 8; ++ks) gacc[vt] = mma32(frag_g(upT + 2 * 256 * 64 + (size_t)(h * 64 + 32 * vt) * 128, 128, 0, 16 * ks, lane), frag_rm(R1, LDLW, 0, 16 * ks, lane), gacc[vt]); }
        float sm = 0.f;
#pragma unroll
        for (int vt = 0; vt < 2; ++vt)
#pragma unroll
            for (int i = 0; i < 16; ++i) sm += yacc[vt][i];
        sm += __shfl_xor(sm, 32);
        const float mean = sm * (1.0f / 64.0f); float sv = 0.f;
#pragma unroll
        for (int vt = 0; vt < 2; ++vt)
#pragma unroll
            for (int i = 0; i < 16; ++i) { const float dl = yacc[vt][i] - mean; sv += dl * dl; }
        sv += __shfl_xor(sv, 32);
        const float rstd = __builtin_amdgcn_rsqf(sv * (1.0f / 64.0f) + 64e-5f);
        const float bon = R5[r32];
        const float* ng = F.in[I_RW_G] + L * 256 + h * 64; const float* nb = F.in[I_RW_B] + L * 256 + h * 64;
#pragma unroll
        for (int vt = 0; vt < 2; ++vt)
#pragma unroll
            for (int g = 0; g < 4; ++g) { const int v0i = 32 * vt + 8 * g + 4 * hh;
                const u32x2 vw = *(const LAS u32x2*)(R0 + r32 * LD64 + v0i * 2); const f32x4 gg = *(const f32x4*)(ng + v0i), bb = *(const f32x4*)(nb + v0i);
                const float vv[4] = {bflo(vw.x), bfhi(vw.x), bflo(vw.y), bfhi(vw.y)}; float o[4];
#pragma unroll
                for (int x = 0; x < 4; ++x) o[x] = ((yacc[vt][4 * g + x] - mean) * rstd * gg[x] + bb[x] + bon * vv[x]) * gacc[vt][4 * g + x];
                u32x2 w; w.x = cvt_pk_bf16(o[0], o[1]); w.y = cvt_pk_bf16(o[2], o[3]);
                *(u32x2*)(bo + (row0 + r32) * 1024 + 768 + h * 64 + v0i) = w; }
    }
    LDS_WAIT();
}
__device__ __forceinline__ void rwkv_scan_task(Frame& F, int bh, int vh) {
    const int lane = F.lane, r32 = lane & 31, hh = lane >> 5;
    const bf16* Mb = (const bf16*)(F.ws + WS_RWM) + (size_t)bh * NCH * 4096; bf16* Nb = (bf16*)(F.ws + WS_RWN) + (size_t)bh * NCH * 4096 + (size_t)(vh * 32 + r32) * 64;
    f32x16 st[2] = {zero16(), zero16()};
    u32x2 nq[2][4], mq[2][2][2][2];
#define RW_PREF(nn) do { _Pragma("unroll") for (int dt = 0; dt < 2; ++dt) _Pragma("unroll") for (int g = 0; g < 4; ++g) nq[dt][g] = *(const u32x2*)(Nb + (size_t)(nn) * 4096 + 32 * dt + 8 * g + 4 * hh); \
        _Pragma("unroll") for (int d1t = 0; d1t < 2; ++d1t) _Pragma("unroll") for (int dt = 0; dt < 2; ++dt) _Pragma("unroll") for (int s2 = 0; s2 < 2; ++s2) { \
            const bf16* mp = Mb + (size_t)(nn) * 4096 + (size_t)(32 * d1t + r32) * 64 + 32 * dt + 16 * s2 + 4 * hh; mq[d1t][dt][s2][0] = *(const u32x2*)mp; mq[d1t][dt][s2][1] = *(const u32x2*)(mp + 8); } } while (0)
    RW_PREF(0);
    for (int n = 0; n < NCH; ++n) {
        bf16x8 bfr[2][2];
#pragma unroll
        for (int dt = 0; dt < 2; ++dt)
#pragma unroll
            for (int s2 = 0; s2 < 2; ++s2) { union { bf16x8 v; unsigned w[4]; } pf;
#pragma unroll
                for (int j = 0; j < 4; ++j) pf.w[j] = cvt_pk_bf16(st[dt][8 * s2 + 2 * j], st[dt][8 * s2 + 2 * j + 1]);
                bfr[dt][s2] = pf.v; }
        f32x16 nw[2];
#pragma unroll
        for (int d1t = 0; d1t < 2; ++d1t) {
#pragma unroll
            for (int g = 0; g < 4; ++g) { nw[d1t][4 * g] = bflo(nq[d1t][g].x); nw[d1t][4 * g + 1] = bfhi(nq[d1t][g].x); nw[d1t][4 * g + 2] = bflo(nq[d1t][g].y); nw[d1t][4 * g + 3] = bfhi(nq[d1t][g].y); }
#pragma unroll
            for (int dt = 0; dt < 2; ++dt)
#pragma unroll
                for (int s2 = 0; s2 < 2; ++s2) { union { bf16x8 v; u32x2 d[2]; } mf; mf.d[0] = mq[d1t][dt][s2][0]; mf.d[1] = mq[d1t][dt][s2][1]; nw[d1t] = mma32(mf.v, bfr[dt][s2], nw[d1t]); } }
        if (n + 1 < NCH) RW_PREF(n + 1);
#pragma unroll
        for (int d1t = 0; d1t < 2; ++d1t) { st[d1t] = nw[d1t];
#pragma unroll
            for (int g = 0; g < 4; ++g) { u32x2 w; w.x = cvt_pk_bf16(nw[d1t][4 * g], nw[d1t][4 * g + 1]); w.y = cvt_pk_bf16(nw[d1t][4 * g + 2], nw[d1t][4 * g + 3]); st_wt8(Nb + (size_t)n * 4096 + 32 * d1t + 8 * g + 4 * hh, w); } }
    }
#undef RW_PREF
}

constexpr int NS_KROW = 144, NS_VROW = 136;
constexpr int NS_KB = 64 * NS_KROW, NS_VB = 64 * NS_VROW;
constexpr int NS_K0 = 0, NS_V0 = 2 * NS_KB, NS_IMP = NS_V0 + 2 * NS_VB, NS_SEL = NS_IMP + 64 * 128 * 4, NS_END = NS_SEL + 64 * 4 * 4;
static_assert(NS_END <= RING_BYTES, "nsa lds");
struct NsaRow { float m, l; f32x16 o[2]; };
__device__ __forceinline__ void ns_load(const bf16* kb, const bf16* vb, size_t stride, int tid, u32x4& kr, u32x4& vr) {
    const int key = tid >> 3, ch = tid & 7; kr = *(const u32x4*)(kb + (size_t)key * stride + ch * 8); vr = *(const u32x4*)(vb + (size_t)key * stride + ch * 8);
}
__device__ __forceinline__ void ns_store(LAS unsigned char* Kb, LAS unsigned char* Vb, int tid, const u32x4& kr, const u32x4& vr) {
    const int key = tid >> 3, ch = tid & 7;
    *(LAS u32x4*)(Kb + key * NS_KROW + ch * 16) = kr;
    LAS unsigned short* vt = (LAS unsigned short*)(Vb + (8 * ch) * NS_VROW + key * 2);
    vt[0 * (NS_VROW / 2)] = (unsigned short)(vr.x & 0xffffu); vt[1 * (NS_VROW / 2)] = (unsigned short)(vr.x >> 16);
    vt[2 * (NS_VROW / 2)] = (unsigned short)(vr.y & 0xffffu); vt[3 * (NS_VROW / 2)] = (unsigned short)(vr.y >> 16);
    vt[4 * (NS_VROW / 2)] = (unsigned short)(vr.z & 0xffffu); vt[5 * (NS_VROW / 2)] = (unsigned short)(vr.z >> 16);
    vt[6 * (NS_VROW / 2)] = (unsigned short)(vr.w & 0xffffu); vt[7 * (NS_VROW / 2)] = (unsigned short)(vr.w >> 16);
}
__device__ __forceinline__ void ns_qk(LAS unsigned char* Kb, const bf16x8 (&qf)[4], int r, int h2, f32x16 (&sacc)[2]) {
#pragma unroll
    for (int sub = 0; sub < 2; ++sub) { f32x16 a;
#pragma unroll
        for (int i = 0; i < 16; ++i) a[i] = 0.f;
#pragma unroll
        for (int kk = 0; kk < 4; ++kk) { const bf16x8 kf = *(const LAS bf16x8*)(Kb + (32 * sub + r) * NS_KROW + (8 * h2 + 16 * kk) * 2); a = __builtin_amdgcn_mfma_f32_32x32x16_bf16(kf, qf[kk], a, 0, 0, 0); }
        sacc[sub] = a; }
}
enum { NS_CMP = 0, NS_SEL_ = 1, NS_WIN = 2 };
template <int MODE> __device__ __forceinline__ bool ns_valid(int key, int t, bool blk_on) {
    if (MODE == NS_CMP) return 16 * key + 31 <= t;
    if (MODE == NS_SEL_) return blk_on && key <= t;
    return key <= t && key + 511 >= t;
}
template <int MODE>
__device__ __forceinline__ void ns_branch(Frame& F, const bf16* kbase, const bf16* vbase, size_t stride, int tile_lo, int tile_hi, const bf16x8 (&qf)[4], int t, int r, int h2,
                                          const unsigned (&selw)[4], NsaRow& R) {
    LAS unsigned char* L = F.lds;
    R.m = -1e30f; R.l = 0.f;
#pragma unroll
    for (int e = 0; e < 2; ++e)
#pragma unroll
        for (int i = 0; i < 16; ++i) R.o[e][i] = 0.f;
    if (tile_hi <= tile_lo) return;
    u32x4 kr, vr;
    ns_load(kbase + (size_t)tile_lo * 64 * stride, vbase + (size_t)tile_lo * 64 * stride, stride, F.tid, kr, vr);
    __syncthreads();
    ns_store(L + NS_K0, L + NS_V0, F.tid, kr, vr);
    __syncthreads();
    for (int ti = tile_lo; ti < tile_hi; ++ti) {
        const int buf = (ti - tile_lo) & 1;
        if (ti + 1 < tile_hi) ns_load(kbase + (size_t)(ti + 1) * 64 * stride, vbase + (size_t)(ti + 1) * 64 * stride, stride, F.tid, kr, vr);
        LAS unsigned char* Kb = L + NS_K0 + buf * NS_KB; LAS unsigned char* Vb = L + NS_V0 + buf * NS_VB;
        bool blk_on = true;
        if (MODE == NS_SEL_) blk_on = (selw[ti >> 5] >> (ti & 31)) & 1u;
        bool any;
        if (MODE == NS_CMP) any = 16 * (ti * 64) + 31 <= t; else if (MODE == NS_SEL_) any = blk_on && ti * 64 <= t; else any = (ti * 64 <= t) && (ti * 64 + 63 + 511 >= t);
        if (__ballot(any) != 0ull) {
            f32x16 sacc[2];
            ns_qk(Kb, qf, r, h2, sacc);
            float mt = -1e30f;
#pragma unroll
            for (int sub = 0; sub < 2; ++sub)
#pragma unroll
                for (int i = 0; i < 16; ++i) { const int key = ti * 64 + 32 * sub + (i & 3) + 8 * (i >> 2) + 4 * h2; const float sv = ns_valid<MODE>(key, t, blk_on) ? sacc[sub][i] : -1e30f; sacc[sub][i] = sv; mt = fmaxf(mt, sv); }
            mt = fmaxf(mt, __shfl_xor(mt, 32));
            const float mn = fmaxf(R.m, mt), sc = __expf(R.m - mn); float rs = 0.f;
#pragma unroll
            for (int sub = 0; sub < 2; ++sub)
#pragma unroll
                for (int i = 0; i < 16; ++i) { const float sv = sacc[sub][i]; const float p = sv > -1e29f ? __expf(sv - mn) : 0.f; sacc[sub][i] = p; rs += p; }
            rs += __shfl_xor(rs, 32);
            R.l = R.l * sc + rs; R.m = mn;
#pragma unroll
            for (int e = 0; e < 2; ++e)
#pragma unroll
                for (int i = 0; i < 16; ++i) R.o[e][i] *= sc;
#pragma unroll
            for (int sub = 0; sub < 2; ++sub)
#pragma unroll
                for (int s2 = 0; s2 < 2; ++s2) {
                    union { bf16x8 v; unsigned w[4]; } pf;
#pragma unroll
                    for (int j = 0; j < 4; ++j) pf.w[j] = cvt_pk_bf16(sacc[sub][8 * s2 + 2 * j], sacc[sub][8 * s2 + 2 * j + 1]);
#pragma unroll
                    for (int e = 0; e < 2; ++e) {
                        union { bf16x8 v; u32x2 d[2]; } vf;
                        const LAS unsigned char* vp = Vb + (32 * e + r) * NS_VROW + (32 * sub + 16 * s2 + 4 * h2) * 2;
                        vf.d[0] = *(const LAS u32x2*)vp; vf.d[1] = *(const LAS u32x2*)(vp + 16);
                        R.o[e] = __builtin_amdgcn_mfma_f32_32x32x16_bf16(vf.v, pf.v, R.o[e], 0, 0, 0);
                    }
                }
        }
        if (ti + 1 < tile_hi) ns_store(L + NS_K0 + (buf ^ 1) * NS_KB, L + NS_V0 + (buf ^ 1) * NS_VB, F.tid, kr, vr);
        __syncthreads();
    }
}
__device__ __forceinline__ void ns_importance(Frame& F, const bf16* kbase, int ntiles, const bf16x8 (&qf)[4], int t, int r, int h2, float m, float inv_l) {
    LAS unsigned char* L = F.lds; LAS float* imp = (LAS float*)(L + NS_IMP);
    const int qrow = F.wave * 8 + (r & 7);
    u32x4 kr, vr;
    ns_load(kbase, kbase, 64, F.tid, kr, vr);
    __syncthreads();
    ns_store(L + NS_K0, L + NS_V0, F.tid, kr, vr);
    __syncthreads();
    for (int ti = 0; ti < ntiles; ++ti) {
        const int buf = ti & 1;
        if (ti + 1 < ntiles) ns_load(kbase + (size_t)(ti + 1) * 64 * 64, kbase + (size_t)(ti + 1) * 64 * 64, 64, F.tid, kr, vr);
        LAS unsigned char* Kb = L + NS_K0 + buf * NS_KB;
        f32x16 sacc[2];
        ns_qk(Kb, qf, r, h2, sacc);
#pragma unroll
        for (int sub = 0; sub < 2; ++sub)
#pragma unroll
            for (int g = 0; g < 4; ++g) {
                float p[4];
#pragma unroll
                for (int x = 0; x < 4; ++x) { const int key = ti * 64 + 32 * sub + x + 8 * g + 4 * h2; p[x] = (16 * key + 31 <= t) ? __expf(sacc[sub][4 * g + x] - m) * inv_l : 0.f; }
                float G = (p[0] + p[1]) + (p[2] + p[3]), E = p[3];
                G += __shfl_xor(G, 8); G += __shfl_xor(G, 16); E += __shfl_xor(E, 8); E += __shfl_xor(E, 16);
                const int jj = ti * 16 + 8 * sub + 2 * g + h2;
                if (r < 8) { atomicAdd((float*)(imp + qrow * 128 + jj), G); if (jj + 1 < 128) atomicAdd((float*)(imp + qrow * 128 + jj + 1), E); }
            }
        if (ti + 1 < ntiles) ns_store(L + NS_K0 + (buf ^ 1) * NS_KB, L + NS_V0 + (buf ^ 1) * NS_VB, F.tid, kr, vr);
        __syncthreads();
    }
}
__device__ __forceinline__ void nsa_unit(Frame& F, int b, int c) {
    const bf16* u = (const bf16*)(F.ws + WS_U); bf16* bo = (bf16*)(F.ws + WS_BO);
    const bf16* kcmp = (const bf16*)(F.ws + WS_KCMP) + (size_t)b * 512 * 64; const bf16* vcmp = (const bf16*)(F.ws + WS_VCMP) + (size_t)b * 512 * 64;
    LAS unsigned char* L = F.lds; LAS float* imp = (LAS float*)(L + NS_IMP); LAS unsigned* selL = (LAS unsigned*)(L + NS_SEL);
    const int lane = F.lane, r = lane & 31, h2 = lane >> 5, head = r >> 3, ql = r & 7;
    const int t = 64 * c + 8 * F.wave + ql; const size_t row = (size_t)b * S + t;
    const bf16* ub = u + (size_t)b * S * UW;
    bf16x8 qf[4];
#pragma unroll
    for (int kk = 0; kk < 4; ++kk) { const u32x4 w = *(const u32x4*)(u + row * UW + U_NSA + head * 64 + 8 * h2 + 16 * kk); f32x4 a, bb; unpack8(w, a, bb);
        union { bf16x8 v; u32x4 q; } cv; cv.q = pack8(a * 0.125f, bb * 0.125f); qf[kk] = cv.v; }
    const float g_cmp = fsigmoid(ldu(u, row, U_NSA + 640 + head)), g_sel = fsigmoid(ldu(u, row, U_NSA + 644 + head)), g_win = fsigmoid(ldu(u, row, U_NSA + 648 + head));
    unsigned selw[4] = {0xffffffffu, 0xffffffffu, 0xffffffffu, 0xffffffffu};
    f32x16 out[2];
    NsaRow R;
    const int ncmp_tiles = (4 * c + 3 + 63) >> 6;
    ns_branch<NS_CMP>(F, kcmp, vcmp, 64, 0, ncmp_tiles, qf, t, r, h2, selw, R);
    { const float inv = R.l > 0.f ? 1.0f / R.l : 0.f; const float gs = g_cmp * inv;
#pragma unroll
      for (int e = 0; e < 2; ++e)
#pragma unroll
        for (int i = 0; i < 16; ++i) out[e][i] = R.o[e][i] * gs;
      if (c >= 15) {
        for (int i = F.tid; i < 64 * 128; i += NTHR) imp[i] = 0.f;
        __syncthreads();
        ns_importance(F, kcmp, ncmp_tiles, qf, t, r, h2, R.m, inv);
        for (int q8 = 0; q8 < 8; ++q8) { const int qrow = F.wave * 8 + q8;
            float sc0, sc1;
            { const int j0 = lane, j1 = lane + 64;
              const bool f0 = (j0 == 0) || (j0 == c) || (j0 == c - 1), f1 = (j1 == c) || (j1 == c - 1);
              sc0 = f0 ? 1e30f : (j0 <= c ? imp[qrow * 128 + j0] : -1e30f); sc1 = f1 ? 1e30f : (j1 <= c ? imp[qrow * 128 + j1] : -1e30f); }
            unsigned long long lo = 0ull, hi = 0ull;
            for (int it = 0; it < 16; ++it) {
                const float best = wave_max(fmaxf(sc0, sc1));
                const unsigned long long m0 = __ballot(sc0 == best), m1 = __ballot(sc1 == best);
                int idx; if (m0) idx = __builtin_ctzll(m0); else idx = 64 + __builtin_ctzll(m1);
                if (idx < 64) { lo |= 1ull << idx; if (lane == idx) sc0 = -3e38f; } else { hi |= 1ull << (idx - 64); if (lane == idx - 64) sc1 = -3e38f; }
            }
            if (lane == 0) { selL[qrow * 4 + 0] = (unsigned)lo; selL[qrow * 4 + 1] = (unsigned)(lo >> 32); selL[qrow * 4 + 2] = (unsigned)hi; selL[qrow * 4 + 3] = (unsigned)(hi >> 32); }
        }
        LDS_WAIT();
#pragma unroll
        for (int j = 0; j < 4; ++j) selw[j] = selL[(F.wave * 8 + ql) * 4 + j];
      }
    }
    ns_branch<NS_SEL_>(F, ub + U_NSA + 384, ub + U_NSA + 448, UW, 0, c + 1, qf, t, r, h2, selw, R);
    { const float gs = g_sel / R.l;
#pragma unroll
      for (int e = 0; e < 2; ++e)
#pragma unroll
        for (int i = 0; i < 16; ++i) out[e][i] += R.o[e][i] * gs; }
    ns_branch<NS_WIN>(F, ub + U_NSA + 512, ub + U_NSA + 576, UW, c >= 8 ? c - 8 : 0, c + 1, qf, t, r, h2, selw, R);
    { const float gs = g_win / R.l;
#pragma unroll
      for (int e = 0; e < 2; ++e)
#pragma unroll
        for (int i = 0; i < 16; ++i) out[e][i] += R.o[e][i] * gs; }
#pragma unroll
    for (int e = 0; e < 2; ++e)
#pragma unroll
        for (int g = 0; g < 4; ++g) { u32x2 w; w.x = cvt_pk_bf16(out[e][4 * g], out[e][4 * g + 1]); w.y = cvt_pk_bf16(out[e][4 * g + 2], out[e][4 * g + 3]);
            *(u32x2*)(bo + row * 1024 + head * 64 + 32 * e + 8 * g + 4 * h2) = w; }
}

#ifdef SK_RWM1
#define RWM1(x)
#else
#define RWM1(x) x
#endif
#ifdef SK_RWM3
#define RWM3(x)
#else
#define RWM3(x) x
#endif
#ifdef SK_RWSC
#define RWSC(x)
#else
#define RWSC(x) x
#endif
__device__ __forceinline__ void phase_m1(Frame& F0, int L, bf16* hgS, bf16* rtS) {
    Frame F = F0; asm volatile("" : "+v"(F.tid)); F.lane = F.tid & 63;
    LAS unsigned char* W = F.lds + F.wave * WREG;
    const int gw = F.bx * NWAVES + F.wave, NGW = F.G * NWAVES;
    for (int it = gw; it < 3 * 32 * NCH; it += NGW) { const int type = it % 3, q = it / 3, bh = q / NCH, n = q % NCH;
        if (type == 0) hgrn_chunk<false>(F, L, bh, n, W, hgS, (float*)(F.ws + WS_HGD)); else if (type == 1) ret_chunk<false>(F, L, bh, n, W, rtS); else { RWM1(rwkv_chunk<false>(F, L, bh, n, W)); } }
}
__device__ __forceinline__ void phase_scan(Frame& F0, int L, bf16* hgS, bf16* rtS) {
    Frame F = F0; asm volatile("" : "+v"(F.tid)); F.lane = F.tid & 63;
    if (F.tid < 256) {
        if (F.bx < 128) glin_scan_task(hgS, (const float*)(F.ws + WS_HGD), 0.f, F.bx >> 2, F.bx & 3, F.tid);
        else { const int k = F.bx - 128, h = (k >> 2) & 3; const float g = 1.0f - exp2f(-5.0f - (float)h); glin_scan_task(rtS, nullptr, exp2f(32.0f * __log2f(g)), k >> 2, k & 3, F.tid); }
    } else if (F.wave == 4 && F.bx < 64) { RWSC(rwkv_scan_task(F, F.bx >> 1, F.bx & 1)); }
}
__device__ __forceinline__ void phase_m3(Frame& F0, int L, bf16* hgS, bf16* rtS) {
    Frame F = F0; asm volatile("" : "+v"(F.tid)); F.lane = F.tid & 63;
    LAS unsigned char* W = F.lds + F.wave * WREG;
    const int gw = F.bx * NWAVES + F.wave, NGW = F.G * NWAVES;
    for (int it = gw; it < 3 * 32 * NCH; it += NGW) { const int type = it % 3, q = it / 3, bh = q / NCH, n = q % NCH;
        if (type == 0) hgrn_chunk<true>(F, L, bh, n, W, hgS, nullptr); else if (type == 1) ret_chunk<true>(F, L, bh, n, W, rtS); else { RWM3(rwkv_chunk<true>(F, L, bh, n, W)); } }
    __syncthreads();
#ifndef SK_NSA
    for (int p = F.bx; p < 512; p += F.G) { const int b = p >> 6, cc = p & 63; nsa_unit(F, b, 127 - cc); nsa_unit(F, b, cc); }
#endif
}

__device__ __forceinline__ void phase_pconv(Frame& F0, int L) {
    Frame F = F0; asm volatile("" : "+v"(F.tid)); F.lane = F.tid & 63;
    const float* p = F.in[I_P] + (size_t)L * T * PLE; bf16* pbf = (bf16*)(F.ws + WS_PB);
    for (int r = F.bx * NWAVES + F.wave; r < T; r += F.G * NWAVES) { const f32x4 v = *((const f32x4*)(p + (size_t)r * PLE) + F.lane); u32x2 w; w.x = cvt_pk_bf16(v[0], v[1]); w.y = cvt_pk_bf16(v[2], v[3]); *((u32x2*)(pbf + (size_t)r * PLE) + F.lane) = w; }
}
__device__ __forceinline__ void phase_final(Frame& F0, const float* ss) {
    Frame F = F0; asm volatile("" : "+v"(F.tid)); F.lane = F.tid & 63;
    const float* g = F.in[I_NORM_FINAL]; const int gw = F.bx * NWAVES + F.wave, NGW = F.G * NWAVES;
    for (int r = gw; r < T; r += NGW) { const float rs = rstd_of(ss, r); f32x4* hr = (f32x4*)(F.out + (size_t)r * D) + F.lane;
#pragma unroll
        for (int j = 0; j < 4; ++j) { f32x4 v = hr[64 * j]; const f32x4 gg = *((const f32x4*)g + F.lane + 64 * j); v = v * rs * gg; hr[64 * j] = v; } }
}

constexpr int PH_PER_LAYER = 9, N_PHASES = 1 + NL * PH_PER_LAYER + 1;
__global__ void __launch_bounds__(NTHR, 2) mega_fwd(Args args) {
    extern __shared__ __attribute__((aligned(16))) unsigned char lds_raw[];
    Frame F; F.lds = (LAS unsigned char*)lds_raw; F.tid = threadIdx.x; F.lane = F.tid & 63; F.wave = __builtin_amdgcn_readfirstlane(F.tid >> 6); F.G = gridDim.x; F.bx = blockIdx.x;
    F.in = args.in; F.out = args.out; F.ws = args.ws;
    volatile LAS unsigned* MISC = (volatile LAS unsigned*)(F.lds + MISC_OFF);
    if (F.tid < 32) MISC[F.tid] = 0u;
    __syncthreads();
    unsigned* ctl = (unsigned*)(F.ws + WS_CTL);
    XcdBarrier bar; bar.bar = ctl + CW_BAR; bar.x = 0; bar.st = nullptr;
    if (MK_N_LAUNCHES == 1) bar = xcd_barrier_post(ctl + CW_BAR, MISC + 8);
    const int lo = args.ph_lo, hi = args.ph_hi;
#define IN(k) (lo <= (k) && (k) < hi)
#define SEAM(k) do { if (IN(k) && IN((k) + 1)) xcd_barrier(bar); } while (0)
    float* ssb = (float*)ctl + CW_SS;
    LAS unsigned char* ring = F.lds + RING_OFF;

    #ifndef SK_PRO
    if (IN(0)) { phase_prologue(F); }
#endif
    SEAM(0);

    for (int L = 0; L < NL; ++L) {
        const int pb = 1 + L * PH_PER_LAYER;
        unsigned char* wl = F.ws + WS_W + (size_t)L * WL_STRIDE;
        bf16* hb_cur = (bf16*)(F.ws + ((L & 1) ? WS_HBB : WS_HBA)); bf16* hb_oth = (bf16*)(F.ws + ((L & 1) ? WS_HBA : WS_HBB));
        const float* ss_mix = ssb + (size_t)(3 * L) * T; float* ss_ffn = ssb + (size_t)(3 * L + 1) * T; float* ss_ple = ssb + (size_t)(3 * L + 2) * T; float* ss_next = ssb + (size_t)(3 * L + 3) * T;
        const float* h_in = (L == 0) ? F.in[I_X] : F.out;
#ifndef SK_G1
        if (IN(pb + 0)) { PlainSched Sd{(const char*)hb_cur, (const char*)(wl + WL_IN), D * 2, D * 2, D / 64, T / 256, UW / 256, F.G, F.bx};
            EpiScaleBf16 E{(bf16*)(F.ws + WS_U), UW, ss_mix}; pg8::gemm_phase(ring, Sd, E); }
#endif
        SEAM(pb + 0);
        bf16* hgS = hb_oth; bf16* rtS = hb_oth + (size_t)32 * NCH * 4096;
        if (IN(pb + 1)) { phase_m1(F, L, hgS, rtS); phase_cmp(F, L); }
        SEAM(pb + 1);
#ifndef EXP_NOSCAN
        if (IN(pb + 2)) phase_scan(F, L, hgS, rtS);
#endif
        SEAM(pb + 2);
        if (IN(pb + 3)) phase_m3(F, L, hgS, rtS);
        SEAM(pb + 3);
#ifndef SK_G2
        if (IN(pb + 4)) { PairSched Sd{(const char*)hb_cur, (const char*)(wl + WL_G), D * 2, D * 2, D / 64, (size_t)D * D * 2,
                                        (const char*)(F.ws + WS_BO), (const char*)(wl + WL_B), 1024 * 2, MW * 2, MW / 64, (size_t)MW * 2, (size_t)D * MW * 2, 4, T / 256, D / 256, F.G, F.bx};
            u32x4* scr = (u32x4*)(F.ws + WS_SCR + (size_t)F.bx * 262144);
            EpiMerge E{scr, scr + 8192, (bf16*)(F.ws + WS_MERGED), ss_mix, F.in[I_BGATE] + (size_t)L * 4 * D, 4}; pg8::gemm_phase(ring, Sd, E); }
#endif
        SEAM(pb + 4);
#ifndef SK_G3
        if (IN(pb + 5)) phase_pconv(F, L);
        if (IN(pb + 5)) { PlainSched Sd{(const char*)(F.ws + WS_MERGED), (const char*)(wl + WL_OUT), D * 2, D * 2, D / 64, T / 256, D / 256, F.G, F.bx};
            EpiResidual E{h_in, F.out, hb_cur, ss_ffn}; pg8::gemm_phase(ring, Sd, E); }
#endif
        SEAM(pb + 5);
#ifndef SK_G4
        if (IN(pb + 6)) { PlainSched Sd{(const char*)hb_cur, (const char*)(wl + WL_FF), D * 2, D * 2, D / 64, T / 256, (2 * DFF) / 256, F.G, F.bx};
            EpiSwiGLU E{(bf16*)(F.ws + WS_FFH), ss_ffn}; pg8::gemm_phase(ring, Sd, E); }
#endif
        SEAM(pb + 6);
#ifndef SK_G5
        if (IN(pb + 7)) { PlainSched Sd{(const char*)(F.ws + WS_FFH), (const char*)(wl + WL_DN), DFF * 2, DFF * 2, DFF / 64, T / 256, D / 256, F.G, F.bx};
            EpiResidual E{F.out, F.out, hb_cur, ss_ple}; pg8::gemm_phase(ring, Sd, E); }
#endif
        SEAM(pb + 7);
#ifndef SK_G6
        if (IN(pb + 8)) { PairSched Sd{(const char*)hb_cur, (const char*)(wl + WL_PG), D * 2, D * 2, D / 64, 0,
                                        (const char*)(F.ws + WS_PB), (const char*)(wl + WL_PP), PLE * 2, PLE * 2, PLE / 64, 0, 0, 1, T / 256, D / 256, F.G, F.bx};
            u32x4* scr = (u32x4*)(F.ws + WS_SCR + (size_t)F.bx * 262144);
            EpiPle E{scr, F.out, hb_oth, ss_ple, ss_next}; pg8::gemm_phase(ring, Sd, E); }
#endif
        SEAM(pb + 8);
    }
#ifndef SK_FIN
    if (IN(N_PHASES - 1)) phase_final(F, ssb + (size_t)(3 * NL) * T);
#endif
#undef IN
#undef SEAM
}

extern "C" void kernel_launch(void* const* d_in, const int* in_sizes, int n_in, void* d_out, int out_size, void* d_ws, size_t ws_size, hipStream_t stream) {
    static int grid = 0;
    if (grid == 0) {
        if (n_in != 37 || in_sizes[0] != T * D || out_size != T * D || ws_size < WS_END) { fprintf(stderr, "kernel_launch: unexpected shapes (n_in %d, ws %zu)\n", n_in, ws_size); grid = -1; return; }
        int dev = 0, cus = 0, per_cu = 0;
        if (hipGetDevice(&dev) != hipSuccess || hipDeviceGetAttribute(&cus, hipDeviceAttributeMultiprocessorCount, dev) != hipSuccess) { grid = -1; return; }
        if (hipFuncSetAttribute((const void*)mega_fwd, hipFuncAttributeMaxDynamicSharedMemorySize, LDS_BYTES) != hipSuccess) { fprintf(stderr, "kernel_launch: hipFuncSetAttribute failed\n"); grid = -1; return; }
        if (hipOccupancyMaxActiveBlocksPerMultiprocessor(&per_cu, (const void*)mega_fwd, NTHR, LDS_BYTES) != hipSuccess || per_cu < 1) { fprintf(stderr, "kernel_launch: occupancy query says %d\n", per_cu); }
        (void)hipGetLastError();
        grid = cus;
    }
    if (grid < 0) return;
    hipMemsetAsync((char*)d_ws + WS_CTL, 0, CTL_BYTES, stream);
    Args a{};
    for (int i = 0; i < 37; ++i) a.in[i] = (const float*)d_in[i];
    a.out = (float*)d_out; a.ws = (unsigned char*)d_ws;
    if (MK_N_LAUNCHES == 1) { a.ph_lo = 0; a.ph_hi = N_PHASES; hipLaunchKernelGGL(mega_fwd, dim3(grid), dim3(NTHR), LDS_BYTES, stream, a); }
    else for (int p = 0; p < N_PHASES; ++p) { a.ph_lo = p; a.ph_hi = p + 1; hipLaunchKernelGGL(mega_fwd, dim3(grid), dim3(NTHR), LDS_BYTES, stream, a); }
}
```

```cpp
#include <hip/hip_runtime.h>
#include <cstdio>
#include <cstdint>

#ifndef REP_ITEMS
#define REP_ITEMS 1
#endif
#ifndef REP_NSA
#define REP_NSA 1
#endif
#ifndef REP_PHASE
#define REP_PHASE (-1)
#endif
#ifndef MK_N_LAUNCHES
#define MK_N_LAUNCHES 1
#endif

#define LAS __attribute__((address_space(3)))
#define GAS __attribute__((address_space(1)))
typedef unsigned short bf16;
typedef short bf16x8 __attribute__((ext_vector_type(8)));
typedef float f32x4 __attribute__((ext_vector_type(4)));
typedef float f32x16 __attribute__((ext_vector_type(16)));
typedef unsigned u32x4 __attribute__((ext_vector_type(4)));
typedef unsigned u32x2 __attribute__((ext_vector_type(2)));

constexpr int D = 1024, NB = 8, S = 8192, T = NB * S, NL = 2;
constexpr int NH = 4, HD = 64, MW = 256, DFF = 2816, PLE = 256;
constexpr int DIN = 3724, UW = 3840;
constexpr int U_NSA = 0, U_HG = 768, U_RT = 1792, U_RW = 2816;
constexpr int NCMP = 511, NSEL = 128;
constexpr float EPS = 1e-6f;

constexpr size_t MiB = 1u << 20;
constexpr size_t WS_CTL = 0, CTL_BYTES = 4 * MiB;
constexpr size_t WS_W = 4 * MiB;
constexpr size_t WL_IN = 0, WL_G = 8 * MiB, WL_B = 16 * MiB, WL_OUT = 18 * MiB, WL_FF = 20 * MiB, WL_DN = 31 * MiB, WL_PG = 37 * MiB, WL_PP = 39 * MiB, WL_STRIDE = 40 * MiB;
constexpr size_t WS_MISC = 84 * MiB;
constexpr size_t WS_ROPE = WS_MISC, WS_KCMP = WS_MISC + 2 * MiB, WS_VCMP = WS_MISC + 2 * MiB + 512 * 1024, WS_RWUP = WS_MISC + 3 * MiB;
constexpr size_t WS_HBA = 88 * MiB, WS_HBB = 216 * MiB;
constexpr size_t WS_BO = 344 * MiB;
constexpr size_t WS_U = 472 * MiB;
constexpr size_t WS_MERGED = WS_U, WS_SCR = WS_U + 416 * MiB;
constexpr size_t WS_FFH = WS_U;
constexpr size_t WS_PB = WS_U + 352 * MiB;
constexpr size_t WS_RWN = 952 * MiB;
constexpr size_t WS_HGD = 1016 * MiB;
constexpr size_t WS_RWM = WS_BO;
constexpr size_t WS_CMPH = 1018 * MiB;
constexpr size_t WS_CW1 = 1020 * MiB;
constexpr size_t WS_CW2 = 1022 * MiB;
constexpr size_t WS_END = 1024 * MiB;
constexpr int CH = 32, NCH = S / CH;
constexpr int CW_BAR = 4096;
constexpr int CW_C1 = 16384;
constexpr int CW_SS = 65536;
constexpr int NSS = 7;
static_assert((size_t)(CW_SS + NSS * T) * 4 <= CTL_BYTES, "ctl");

#define LDS_WAIT() asm volatile("s_waitcnt lgkmcnt(0)" ::: "memory")
#define VM_WAIT() asm volatile("s_waitcnt vmcnt(0)" ::: "memory")
typedef __bf16 hbf16x2 __attribute__((ext_vector_type(2)));
typedef float f32x2v __attribute__((ext_vector_type(2)));
__device__ __forceinline__ unsigned cvt_pk_bf16(float lo, float hi) { const f32x2v v = {lo, hi}; const hbf16x2 b = __builtin_convertvector(v, hbf16x2); return __builtin_bit_cast(unsigned, b); }
__device__ __forceinline__ float bf2f(unsigned short b) { return __builtin_bit_cast(float, ((unsigned)b) << 16); }
__device__ __forceinline__ float bflo(unsigned w) { return __builtin_bit_cast(float, w << 16); }
__device__ __forceinline__ float bfhi(unsigned w) { return __builtin_bit_cast(float, w & 0xffff0000u); }
__device__ __forceinline__ float fsigmoid(float z) { return __builtin_amdgcn_rcpf(1.0f + __builtin_amdgcn_exp2f(-1.44269504f * z)); }
__device__ __forceinline__ float fsilu(float z) { return z * fsigmoid(z); }
__device__ __forceinline__ float wave_sum(float v) {
#pragma unroll
    for (int o = 1; o < 64; o <<= 1) v += __shfl_xor(v, o);
    return v;
}
__device__ __forceinline__ float wave_max(float v) {
#pragma unroll
    for (int o = 1; o < 64; o <<= 1) v = fmaxf(v, __shfl_xor(v, o));
    return v;
}

#define XB_TMO      128
#define XB_XCNT(j)  (256  + 64 * (j))
#define XB_XSUB(j)  (1280 + 64 * (j))
#define XB_XGEN(j)  (2304 + 64 * (j))
#define XB_TOP      3328
#define XB_TOPGEN   3392
#define XCD_BAR_WORDS 3456
#define XB_SPIN_CAP (1u << 24)
__device__ __forceinline__ unsigned xb_ld(unsigned* p)              { return __hip_atomic_load(p, __ATOMIC_RELAXED, __HIP_MEMORY_SCOPE_AGENT); }
__device__ __forceinline__ unsigned xb_add(unsigned* p, unsigned v) { return __hip_atomic_fetch_add(p, v, __ATOMIC_RELAXED, __HIP_MEMORY_SCOPE_AGENT); }
__device__ __forceinline__ unsigned xb_xcc_id() { return (unsigned)__builtin_amdgcn_s_getreg((3 << 11) | 20) & 0xFu; }
#define XB_SPIN(cond, bar) do { unsigned _sp = 0; while (cond) { __builtin_amdgcn_s_sleep(1); \
    if ((++_sp & 255u) == 0u) { if (xb_ld(&(bar)[XB_TMO])) break; if (_sp > XB_SPIN_CAP) { atomicAdd(&(bar)[XB_TMO], 1u); break; } } } } while (0)
struct XcdBarrier { unsigned* bar; unsigned x; volatile LAS unsigned* st; };
__device__ __forceinline__ XcdBarrier xcd_barrier_post(unsigned* bar, volatile LAS unsigned* st) {
    XcdBarrier b; b.bar = bar; b.x = xb_xcc_id(); b.st = st;
    if (threadIdx.x == 0) (void)xb_add(&bar[XB_XCNT(b.x)], 1u);
    return b;
}
__device__ __forceinline__ void xcd_barrier_complete(unsigned* bar, unsigned x, unsigned& nloc, unsigned& nx) {
    const unsigned G = gridDim.x * gridDim.y * gridDim.z;
    unsigned sum, cnt, mine, sp = 0u;
    for (;;) {
        sum = 0u; cnt = 0u; mine = 0u;
#pragma unroll
        for (unsigned j = 0; j < 16; ++j) { const unsigned c = xb_ld(&bar[XB_XCNT(j)]); sum += c; cnt += (c > 0u) ? 1u : 0u; mine = (j == x) ? c : mine; }
        if (sum == G) break;
        __builtin_amdgcn_s_sleep(1);
        if ((++sp & 255u) == 0u) { if (xb_ld(&bar[XB_TMO])) break; if (sp > XB_SPIN_CAP) { atomicAdd(&bar[XB_TMO], 1u); break; } }
    }
    nloc = mine > 0u ? mine : 1u; nx = cnt > 0u ? cnt : 1u;
}
__device__ __forceinline__ void xcd_barrier(const XcdBarrier& b) {
    asm volatile("s_waitcnt vmcnt(0)" ::: "memory");
    __syncthreads();
    if (threadIdx.x == 0) {
        unsigned* bar = b.bar;
        __builtin_amdgcn_s_waitcnt(0);
        unsigned nloc = b.st[0], nx = b.st[1];
        if (nloc == 0u) { xcd_barrier_complete(bar, b.x, nloc, nx); b.st[0] = nloc; b.st[1] = nx; }
        const unsigned old = xb_add(&bar[XB_XSUB(b.x)], 1u);
        const unsigned gen = old / nloc;
        if (old + 1u == (gen + 1u) * nloc) {
            __builtin_amdgcn_fence(__ATOMIC_RELEASE, "agent");
            asm volatile("s_waitcnt vmcnt(0)" ::: "memory");
            const unsigned og = xb_add(&bar[XB_TOP], 1u);
            const unsigned tg = og / nx;
            if (og + 1u == (tg + 1u) * nx) xb_add(&bar[XB_TOPGEN], 1u);
            else XB_SPIN(xb_ld(&bar[XB_TOPGEN]) == tg, bar);
            __builtin_amdgcn_fence(__ATOMIC_ACQUIRE, "agent");
            xb_add(&bar[XB_XGEN(b.x)], 1u);
            asm volatile("s_waitcnt vmcnt(0)" ::: "memory");
        } else {
            XB_SPIN(xb_ld(&bar[XB_XGEN(b.x)]) == gen, bar);
            __builtin_amdgcn_fence(__ATOMIC_ACQUIRE, "agent");
            asm volatile("s_waitcnt vmcnt(0)" ::: "memory");
        }
    }
    __syncthreads();
}

namespace pg8 {
constexpr int BM = 256, BK = 64, HALF = 128, HTB = HALF * BK * 2, STAGE_BYTES = 8 * HTB, NXCD = 8, WGM = 8;
__host__ __device__ __forceinline__ int lds_byte(int r, int c) { const int st = (r >> 4) * 2 + (c >> 5), rr = r & 15, cc = c & 31, ob = rr * 64 + cc * 2; return st * 1024 + (ob ^ (((ob >> 9) & 1) << 5)); }
__host__ __device__ __forceinline__ void stage_rc(int b, int& R, int& C) { const int st = b / 1024, sb = b % 1024, swz = sb ^ (((sb >> 9) & 1) << 5); R = (st >> 1) * 16 + swz / 64; C = (st & 1) * 32 + (swz % 64) / 2; }
__host__ __device__ __forceinline__ int perm32(int rho) { const int n = rho >> 4, i = rho & 15; return 8 * (i >> 2) + 4 * n + (i & 3); }

struct GU { const char* A; const char* B; unsigned lda, ldb; int nt; int pm, pn, kind, mi; };

__device__ __forceinline__ bool tile_of(int L, int nM, int nN, int& pm, int& pn) {
    const int nwg = nM * nN; if (L >= nwg) return false;
    int wgid = L; { const int q = nwg / NXCD, r = nwg % NXCD, xcd = wgid % NXCD, off = wgid / NXCD; wgid = (xcd < r ? xcd * (q + 1) : r * (q + 1) + (xcd - r) * q) + off; }
    const int nig = WGM * nN, gid = wgid / nig, fm = gid * WGM, gsz = (nM - fm) < WGM ? (nM - fm) : WGM;
    pm = fm + ((wgid % nig) % gsz); pn = (wgid % nig) / gsz; return true;
}

template <class Epi, class Sched, bool AX = false>
__device__ __forceinline__ void gemm_phase(LAS unsigned char* lds, const Sched& S, const Epi& E, unsigned ax_kstep = 0, unsigned ax_half = 0) {
    int tid = threadIdx.x; asm volatile("" : "+v"(tid));
    const int wid = __builtin_amdgcn_readfirstlane(tid >> 6), lane = tid & 63, wr = wid >> 2, wc = wid & 3, fr = lane & 15, fq = lane >> 4;
    unsigned RA[2], RB[2], C2[2];
#pragma unroll
    for (int i = 0; i < 2; ++i) { int R, C; stage_rc(tid * 16 + i * 8192, R, C); RA[i] = (unsigned)R; RB[i] = (unsigned)((R & ~31) + perm32(R & 31)); C2[i] = (unsigned)C * 2u; }
    const size_t kstep = (size_t)(BK * 2);
    const size_t kstepA = AX ? (size_t)ax_kstep : kstep;
#define PG8_HSA(ld) (AX ? (size_t)ax_half : (size_t)HALF * (ld))
    const unsigned ldsw = (unsigned)wid * 1024u;
    const int aoff = lds_byte(wr * 64 + fr, fq * 8), boff = lds_byte(wc * 32 + fr, fq * 8);
#define PG8_SA(b, h) (((b) * 2 + (h)) * HTB)
#define PG8_SB(b, h) ((4 + (b) * 2 + (h)) * HTB)
#define PG8_STAGE(bufoff, gbase, ld, RR) do { _Pragma("unroll") for (int _i = 0; _i < 2; ++_i) \
        __builtin_amdgcn_global_load_lds((const unsigned*)((const char*)(gbase) + (RR[_i] * (ld) + C2[_i])), (LAS unsigned*)(lds + (bufoff) + ldsw + _i * 8192), 16, 0, 0); } while (0)
#define PG8_LDA(dst, b, h) do { _Pragma("unroll") for (int m = 0; m < 4; ++m) _Pragma("unroll") for (int k = 0; k < 2; ++k) dst[m][k] = *(const LAS bf16x8*)(lds + PG8_SA(b, h) + aoff + m * 2048 + k * 1024); } while (0)
#define PG8_LDB(dst, b, h) do { _Pragma("unroll") for (int n = 0; n < 2; ++n) _Pragma("unroll") for (int k = 0; k < 2; ++k) dst[n][k] = *(const LAS bf16x8*)(lds + PG8_SB(b, h) + boff + n * 2048 + k * 1024); } while (0)
#define PG8_MMA(ai, bj, At, Bt) do { __builtin_amdgcn_s_setprio(1); _Pragma("unroll") for (int m = 0; m < 4; ++m) _Pragma("unroll") for (int n = 0; n < 2; ++n) _Pragma("unroll") for (int k = 0; k < 2; ++k) \
        acc[ai][bj][m][n] = __builtin_amdgcn_mfma_f32_16x16x32_bf16(Bt[n][k], At[m][k], acc[ai][bj][m][n], 0, 0, 0); __builtin_amdgcn_s_setprio(0); } while (0)
#define PG8_WAIT_V(n) asm volatile("s_waitcnt vmcnt(" #n ")" ::: "memory")
#define PG8_WAIT_L(n) asm volatile("s_waitcnt lgkmcnt(" #n ")" ::: "memory")
#define PG8_BAR __builtin_amdgcn_s_barrier()
#define PG8_SCHED __builtin_amdgcn_sched_barrier(0)
    GU cur, nxt; int ui = 0;
    if (!S.next(0, cur)) return;
    f32x4 acc[2][2][4][2];
#pragma unroll
    for (int a = 0; a < 2; ++a)
#pragma unroll
        for (int b = 0; b < 2; ++b)
#pragma unroll
            for (int m = 0; m < 4; ++m)
#pragma unroll
                for (int n = 0; n < 2; ++n) acc[a][b][m][n] = (f32x4){0.f, 0.f, 0.f, 0.f};
    bf16x8 At[4][2], B0[2][2], B1[2][2];
    const char* cA = cur.A; const char* cB = cur.B; unsigned clda = cur.lda, cldb = cur.ldb;
    PG8_STAGE(PG8_SB(0, 0), cB, cldb, RB); PG8_STAGE(PG8_SB(0, 1), cB + (size_t)HALF * cldb, cldb, RB); PG8_STAGE(PG8_SA(0, 0), cA, clda, RA); PG8_STAGE(PG8_SA(0, 1), cA + PG8_HSA(clda), clda, RA);
    if (wr == 1) PG8_BAR;
    PG8_WAIT_V(2); PG8_BAR;
    PG8_STAGE(PG8_SB(1, 0), cB + kstep, cldb, RB); PG8_STAGE(PG8_SA(1, 0), cA + kstepA, clda, RA); PG8_STAGE(PG8_SB(1, 1), cB + (size_t)HALF * cldb + kstep, cldb, RB);
    PG8_WAIT_V(6); PG8_BAR;
    for (;;) {
        const bool has_next = S.next(ui + 1, nxt);
        const char* nA = has_next ? nxt.A : cA; const char* nB = has_next ? nxt.B : cB;
        const unsigned nlda = has_next ? nxt.lda : clda, nldb = has_next ? nxt.ldb : cldb;
        const int nt = cur.nt;
        for (int t = 0; t < nt; t += 2) {
            const bool last = (t == nt - 2);
            const char* a1 = cA + (size_t)(t + 1) * kstepA;
            const char* a2 = last ? nA : cA + (size_t)(t + 2) * kstepA; const char* b2 = last ? nB : cB + (size_t)(t + 2) * kstep;
            const unsigned lda2 = last ? nlda : clda, ldb2 = last ? nldb : cldb;
            const char* a3 = a2 + kstepA; const char* b3 = b2 + kstep;
            PG8_LDB(B0, 0, 0); PG8_LDB(B1, 0, 1); PG8_SCHED; PG8_LDA(At, 0, 0); PG8_STAGE(PG8_SA(1, 1), a1 + PG8_HSA(clda), clda, RA);
            PG8_WAIT_V(8); PG8_WAIT_L(0); PG8_BAR; PG8_MMA(0, 0, At, B0); PG8_MMA(0, 1, At, B1); PG8_BAR; PG8_SCHED;
            PG8_LDA(At, 0, 1); PG8_STAGE(PG8_SB(0, 0), b2, ldb2, RB); PG8_STAGE(PG8_SB(0, 1), b2 + (size_t)HALF * ldb2, ldb2, RB); PG8_STAGE(PG8_SA(0, 0), a2, lda2, RA);
            PG8_WAIT_V(8); PG8_WAIT_L(0); PG8_BAR; PG8_MMA(1, 0, At, B0); PG8_MMA(1, 1, At, B1); PG8_BAR; PG8_SCHED;
            PG8_LDB(B0, 1, 0); PG8_LDB(B1, 1, 1); PG8_SCHED; PG8_LDA(At, 1, 0); PG8_STAGE(PG8_SA(0, 1), a2 + PG8_HSA(lda2), lda2, RA);
            PG8_WAIT_V(8); PG8_WAIT_L(0); PG8_BAR; PG8_MMA(0, 0, At, B0); PG8_MMA(0, 1, At, B1); PG8_BAR; PG8_SCHED;
            PG8_LDA(At, 1, 1); PG8_STAGE(PG8_SB(1, 0), b3, ldb2, RB); PG8_STAGE(PG8_SB(1, 1), b3 + (size_t)HALF * ldb2, ldb2, RB); PG8_STAGE(PG8_SA(1, 0), a3, lda2, RA);
            PG8_WAIT_V(8); PG8_WAIT_L(0); PG8_BAR; PG8_MMA(1, 0, At, B0); PG8_MMA(1, 1, At, B1); PG8_BAR; PG8_SCHED;
        }
        if (wr == 0) PG8_BAR;
        E(acc, cur, wr, wc, fr, fq);
        if (!has_next) break;
#pragma unroll
        for (int a = 0; a < 2; ++a)
#pragma unroll
            for (int b = 0; b < 2; ++b)
#pragma unroll
                for (int m = 0; m < 4; ++m)
#pragma unroll
                    for (int n = 0; n < 2; ++n) acc[a][b][m][n] = (f32x4){0.f, 0.f, 0.f, 0.f};
        cur = nxt; cA = nA; cB = nB; clda = nlda; cldb = nldb; ++ui;
        if (wr == 1) PG8_BAR;
    }
    PG8_WAIT_V(0);
    PG8_BAR;
#undef PG8_SA
#undef PG8_HSA
#undef PG8_SB
#undef PG8_STAGE
#undef PG8_LDA
#undef PG8_LDB
#undef PG8_MMA
#undef PG8_WAIT_V
#undef PG8_WAIT_L
#undef PG8_BAR
#undef PG8_SCHED
}
}
using pg8::GU;

struct PlainSched {
    const char* A; const char* B; unsigned lda, ldb; int nt, nM, nN, G, c;
    __device__ __forceinline__ bool next(int i, GU& u) const {
        int pm, pn; if (!pg8::tile_of(i * G + c, nM, nN, pm, pn)) return false;
        u.A = A + (size_t)pm * 256 * lda; u.B = B + (size_t)pn * 256 * ldb; u.lda = lda; u.ldb = ldb; u.nt = nt; u.pm = pm; u.pn = pn; u.kind = 0; u.mi = 0; return true;
    }
};
struct PairSched {
    const char* A1; const char* B1; unsigned lda1, ldb1; int nt1; size_t b1_mstride;
    const char* A2; const char* B2; unsigned lda2, ldb2; int nt2; size_t a2_mstride, b2_mstride;
    int nm, nM, nN, G, c;
    __device__ __forceinline__ bool next(int i, GU& u) const {
        const int per = 2 * nm, ti = i / per, sub = i - ti * per, m = sub >> 1, kind = sub & 1;
        int pm, pn; if (!pg8::tile_of(ti * G + c, nM, nN, pm, pn)) return false;
        u.pm = pm; u.pn = pn; u.kind = kind; u.mi = m;
        if (kind == 0) { u.A = A2 + (size_t)m * a2_mstride + (size_t)pm * 256 * lda2; u.B = B2 + (size_t)m * b2_mstride + (size_t)pn * 256 * ldb2; u.lda = lda2; u.ldb = ldb2; u.nt = nt2; }
        else { u.A = A1 + (size_t)pm * 256 * lda1; u.B = B1 + (size_t)m * b1_mstride + (size_t)pn * 256 * ldb1; u.lda = lda1; u.ldb = ldb1; u.nt = nt1; }
        return true;
    }
};

__device__ __forceinline__ float rstd_of(const float* ss, int row) { return __builtin_amdgcn_rsqf(ss[row] * (1.0f / D) + EPS); }
__device__ __forceinline__ u32x4 pack8(const f32x4& a, const f32x4& b) { u32x4 w; w.x = cvt_pk_bf16(a[0], a[1]); w.y = cvt_pk_bf16(a[2], a[3]); w.z = cvt_pk_bf16(b[0], b[1]); w.w = cvt_pk_bf16(b[2], b[3]); return w; }
__device__ __forceinline__ void unpack8(const u32x4& w, f32x4& a, f32x4& b) { a = (f32x4){bflo(w.x), bfhi(w.x), bflo(w.y), bfhi(w.y)}; b = (f32x4){bflo(w.z), bfhi(w.z), bflo(w.w), bfhi(w.w)}; }

struct CmpSched {
    const char* U; const char* B; int c;
    __device__ __forceinline__ bool next(int i, GU& u) const {
        if (i > 0 || c >= 32) return false;
        const int b = c >> 2, q = c & 3;
        u.A = U + ((size_t)(b * S + 2048 * q) * UW + U_NSA + 256) * 2; u.B = B; u.lda = 16 * UW * 2; u.ldb = 4096; u.nt = 32; u.pm = b; u.pn = q; u.kind = 0; u.mi = 0; return true;
    }
};
struct EpiCmp {
    bf16* H; const float* c1;
    __device__ __forceinline__ void operator()(const f32x4 (&acc)[2][2][4][2], const GU& u, int wr, int wc, int fr, int fq) const {
        const int col = wc * 32 + 8 * fq;
#pragma unroll
        for (int kv = 0; kv < 2; ++kv) { const f32x4 b0 = *(const f32x4*)(c1 + kv * 128 + col), b1 = *(const f32x4*)(c1 + kv * 128 + col + 4);
#pragma unroll
            for (int m = 0; m < 4; ++m) { const int i = u.pn * 128 + wr * 64 + m * 16 + fr; f32x4 v0, v1;
#pragma unroll
                for (int j = 0; j < 4; ++j) { v0[j] = fsilu(acc[kv][kv][m][0][j] + b0[j]); v1[j] = fsilu(acc[kv][kv][m][1][j] + b1[j]); }
                *(u32x4*)(H + ((size_t)(u.pm * 512 + i)) * 256 + kv * 128 + col) = pack8(v0, v1); } }
    }
};
struct EpiScaleBf16 {
    bf16* O; int ldo; const float* ss;
    __device__ __forceinline__ void operator()(const f32x4 (&acc)[2][2][4][2], const GU& u, int wr, int wc, int fr, int fq) const {
        const int row0 = u.pm * 256 + wr * 64 + fr, col0 = u.pn * 256 + wc * 32 + 8 * fq;
#pragma unroll
        for (int ai = 0; ai < 2; ++ai)
#pragma unroll
            for (int m = 0; m < 4; ++m) { const int r = row0 + ai * 128 + m * 16; const float rs = rstd_of(ss, r); bf16* rowp = O + (size_t)r * ldo + col0;
#pragma unroll
                for (int bj = 0; bj < 2; ++bj) *(u32x4*)(rowp + bj * 128) = pack8(acc[ai][bj][m][0] * rs, acc[ai][bj][m][1] * rs); }
    }
};
struct EpiSwiGLU {
    bf16* O; const float* ss;
    __device__ __forceinline__ void operator()(const f32x4 (&acc)[2][2][4][2], const GU& u, int wr, int wc, int fr, int fq) const {
        const int row0 = u.pm * 256 + wr * 64 + fr, col0 = u.pn * 128 + wc * 32 + 8 * fq;
#pragma unroll
        for (int ai = 0; ai < 2; ++ai)
#pragma unroll
            for (int m = 0; m < 4; ++m) { const int r = row0 + ai * 128 + m * 16; const float rs = rstd_of(ss, r);
                f32x4 v[2];
#pragma unroll
                for (int n = 0; n < 2; ++n)
#pragma unroll
                    for (int j = 0; j < 4; ++j) { const float g = acc[ai][0][m][n][j] * rs, up = acc[ai][1][m][n][j] * rs; v[n][j] = fsilu(g) * up; }
                *(u32x4*)(O + (size_t)r * DFF + col0) = pack8(v[0], v[1]); }
    }
};
struct EpiResidual {
    const float* Hin; float* Hout; bf16* HB; float* ss_out;
    __device__ __forceinline__ void operator()(const f32x4 (&acc)[2][2][4][2], const GU& u, int wr, int wc, int fr, int fq) const {
        const int row0 = u.pm * 256 + wr * 64 + fr, col0 = u.pn * 256 + wc * 32 + 8 * fq;
#pragma unroll
        for (int ai = 0; ai < 2; ++ai)
#pragma unroll
            for (int m = 0; m < 4; ++m) { const int r = row0 + ai * 128 + m * 16; float s2 = 0.f;
#pragma unroll
                for (int bj = 0; bj < 2; ++bj) { const size_t o = (size_t)r * D + col0 + bj * 128;
                    f32x4 h0 = *(const f32x4*)(Hin + o), h1 = *(const f32x4*)(Hin + o + 4);
                    h0 += acc[ai][bj][m][0]; h1 += acc[ai][bj][m][1];
                    *(f32x4*)(Hout + o) = h0; *(f32x4*)(Hout + o + 4) = h1; *(u32x4*)(HB + o) = pack8(h0, h1);
                    s2 += (h0[0] * h0[0] + h0[1] * h0[1]) + (h0[2] * h0[2] + h0[3] * h0[3]) + (h1[0] * h1[0] + h1[1] * h1[1]) + (h1[2] * h1[2] + h1[3] * h1[3]); }
                s2 += __shfl_xor(s2, 16); s2 += __shfl_xor(s2, 32);
                if (fq == 0) atomicAdd(ss_out + r, s2);
                if (m == 3) asm volatile("" ::: "memory"); }
    }
};
#define SLOT(ai, m, bj) (((((ai) * 4 + (m)) >> 1) * 512 + tid) * 4 + (((m) & 1) * 2 + (bj)))
struct EpiMerge {
    u32x4* scrP; u32x4* scrM; bf16* M; const float* ss; const float* bias;
    int nm;
    __device__ __forceinline__ void operator()(const f32x4 (&acc)[2][2][4][2], const GU& u, int wr, int wc, int fr, int fq) const {
        int tid = threadIdx.x; asm volatile("" : "+v"(tid));
        if (u.kind == 0) {
#pragma unroll
            for (int ai = 0; ai < 2; ++ai)
#pragma unroll
                for (int m = 0; m < 4; ++m)
#pragma unroll
                    for (int bj = 0; bj < 2; ++bj) scrP[SLOT(ai, m, bj)] = pack8(acc[ai][bj][m][0], acc[ai][bj][m][1]);
            return;
        }
        const int row0 = u.pm * 256 + wr * 64 + fr, col0 = u.pn * 256 + wc * 32 + 8 * fq;
        const float* bp = bias + (size_t)u.mi * D + col0;
        f32x4 bv[2][2];
#pragma unroll
        for (int bj = 0; bj < 2; ++bj) { bv[bj][0] = *(const f32x4*)(bp + bj * 128); bv[bj][1] = *(const f32x4*)(bp + bj * 128 + 4); }
#pragma unroll
        for (int ai = 0; ai < 2; ++ai)
#pragma unroll
            for (int m = 0; m < 4; ++m) { const int r = row0 + ai * 128 + m * 16; const float rs = rstd_of(ss, r);
#pragma unroll
                for (int bj = 0; bj < 2; ++bj) { const int slot = SLOT(ai, m, bj);
                    f32x4 p0, p1; unpack8(scrP[slot], p0, p1);
                    f32x4 v0, v1;
#pragma unroll
                    for (int j = 0; j < 4; ++j) { v0[j] = fsigmoid(acc[ai][bj][m][0][j] * rs + bv[bj][0][j]) * p0[j]; v1[j] = fsigmoid(acc[ai][bj][m][1][j] * rs + bv[bj][1][j]) * p1[j]; }
                    if (u.mi > 0) { f32x4 q0, q1; unpack8(scrM[slot], q0, q1); v0 += q0; v1 += q1; }
                    const u32x4 w = pack8(v0, v1);
                    if (u.mi == nm - 1) *(u32x4*)(M + (size_t)r * D + col0 + bj * 128) = w; else scrM[slot] = w; }
                asm volatile("" ::: "memory"); }
    }
};
struct EpiPle {
    u32x4* scrP; float* H; bf16* HB; const float* ss; float* ss_out;
    __device__ __forceinline__ void operator()(const f32x4 (&acc)[2][2][4][2], const GU& u, int wr, int wc, int fr, int fq) const {
        int tid = threadIdx.x; asm volatile("" : "+v"(tid));
        if (u.kind == 0) {
#pragma unroll
            for (int ai = 0; ai < 2; ++ai)
#pragma unroll
                for (int m = 0; m < 4; ++m)
#pragma unroll
                    for (int bj = 0; bj < 2; ++bj) scrP[SLOT(ai, m, bj)] = pack8(acc[ai][bj][m][0], acc[ai][bj][m][1]);
            return;
        }
        const int row0 = u.pm * 256 + wr * 64 + fr, col0 = u.pn * 256 + wc * 32 + 8 * fq;
#pragma unroll
        for (int ai = 0; ai < 2; ++ai)
#pragma unroll
            for (int m = 0; m < 4; ++m) { const int r = row0 + ai * 128 + m * 16; const float rs = rstd_of(ss, r); float s2 = 0.f;
#pragma unroll
                for (int bj = 0; bj < 2; ++bj) { const int slot = SLOT(ai, m, bj); const size_t o = (size_t)r * D + col0 + bj * 128;
                    f32x4 p0, p1; unpack8(scrP[slot], p0, p1);
                    f32x4 h0 = *(const f32x4*)(H + o), h1 = *(const f32x4*)(H + o + 4);
#pragma unroll
                    for (int j = 0; j < 4; ++j) { h0[j] += fsigmoid(acc[ai][bj][m][0][j] * rs) * p0[j]; h1[j] += fsigmoid(acc[ai][bj][m][1][j] * rs) * p1[j]; }
                    *(f32x4*)(H + o) = h0; *(f32x4*)(H + o + 4) = h1; *(u32x4*)(HB + o) = pack8(h0, h1);
                    s2 += (h0[0] * h0[0] + h0[1] * h0[1]) + (h0[2] * h0[2] + h0[3] * h0[3]) + (h1[0] * h1[0] + h1[1] * h1[1]) + (h1[2] * h1[2] + h1[3] * h1[3]); }
                s2 += __shfl_xor(s2, 16); s2 += __shfl_xor(s2, 32);
                if (fq == 0) atomicAdd(ss_out + r, s2);
                asm volatile("" ::: "memory"); }
    }
};

constexpr int NWAVES = 8, NTHR = 512;
constexpr int RING_OFF = 0, RING_BYTES = 131072, WREG = 19456, MISC_OFF = 8 * WREG;
constexpr int LDS_BYTES = MISC_OFF + 256;
static_assert(MISC_OFF + 128 <= LDS_BYTES, "lds");
struct Args { const float* in[37]; float* out; unsigned char* ws; int ph_lo, ph_hi; };
struct Frame {
    LAS unsigned char* lds; int tid, lane, wave, G, bx;
    const float* const* in; float* out; unsigned char* ws;
};
enum { I_X = 0, I_P, I_NORM_MIX, I_W_IN, I_POS_K, I_POS_V, I_CK1, I_CK2, I_CV1, I_CV2, I_LB, I_HG_NORM, I_RT_G, I_RT_B, I_MU, I_W0, I_WUP, I_A0, I_AUP, I_GUP, I_KK, I_KA, I_RK,
       I_RW_G, I_RW_B, I_WBR, I_WGATE, I_BGATE, I_WOUT, I_NORM_FFN, I_FFG, I_FFU, I_FFD, I_NORM_PLE, I_PLEG, I_PLEP, I_NORM_FINAL };

template <class ColMap>
__device__ __forceinline__ void transpose_item(const float* W, int ldw, int K, const float* scale, bf16* WT, LAS float* scr, int item, int nblk, int lane, const ColMap& cm) {
    const int kb = item / nblk, nb = item % nblk, k0 = 64 * kb, n0 = 32 * nb;
    const int sc = cm(n0 + (lane & 31));
#pragma unroll 8
    for (int i = 0; i < 32; ++i) { const int kk = 2 * i + (lane >> 5); float v = 0.f; if (sc >= 0) { v = W[(size_t)(k0 + kk) * ldw + sc]; if (scale) v *= scale[k0 + kk]; } scr[kk * 33 + (lane & 31)] = v; }
    LDS_WAIT();
    const int c = lane & 7;
#pragma unroll
    for (int j = 0; j < 4; ++j) { const int n = (lane >> 3) + 8 * j; const LAS float* s = scr + (8 * c) * 33 + n;
        u32x4 o; o.x = cvt_pk_bf16(s[0 * 33], s[1 * 33]); o.y = cvt_pk_bf16(s[2 * 33], s[3 * 33]); o.z = cvt_pk_bf16(s[4 * 33], s[5 * 33]); o.w = cvt_pk_bf16(s[6 * 33], s[7 * 33]);
        *(u32x4*)(WT + (size_t)(n0 + n) * K + k0 + 8 * c) = o; }
    LDS_WAIT();
}
struct CmIdent { __device__ __forceinline__ int operator()(int n) const { return n; } };
struct CmWin { __device__ __forceinline__ int operator()(int n) const { return n < 652 ? n : (n < 768 ? -1 : n - 116); } };
struct CmFF { __device__ __forceinline__ int operator()(int n) const { return (n >> 8) * 128 + (n & 127); } };

__device__ __forceinline__ void phase_prologue(Frame& F0) {
    Frame F = F0; asm volatile("" : "+v"(F.tid)); F.lane = F.tid & 63;
    LAS float* scr = (LAS float*)(F.lds + F.wave * WREG);
    const int gw = F.bx * NWAVES + F.wave, NGW = F.G * NWAVES;
    for (int L = 0; L < NL; ++L) {
        unsigned char* wl = F.ws + WS_W + (size_t)L * WL_STRIDE;
        const float* g_mix = F.in[I_NORM_MIX] + L * D; const float* g_ffn = F.in[I_NORM_FFN] + L * D; const float* g_ple = F.in[I_NORM_PLE] + L * D;
        { const int nblk = UW / 32, items = (D / 64) * nblk; const float* W = F.in[I_W_IN] + (size_t)L * D * DIN;
          for (int it = gw; it < items; it += NGW) transpose_item(W, DIN, D, g_mix, (bf16*)(wl + WL_IN), scr, it, nblk, F.lane, CmWin()); }
        for (int m = 0; m < 4; ++m) { const int nblk = D / 32, items = (D / 64) * nblk; const float* W = F.in[I_WGATE] + ((size_t)L * 4 + m) * D * D;
          for (int it = gw; it < items; it += NGW) transpose_item(W, D, D, g_mix, (bf16*)(wl + WL_G) + (size_t)m * D * D, scr, it, nblk, F.lane, CmIdent()); }
        for (int m = 0; m < 4; ++m) { const int nblk = D / 32, items = (MW / 64) * nblk; const float* W = F.in[I_WBR] + ((size_t)L * 4 + m) * MW * D;
          for (int it = gw; it < items; it += NGW) transpose_item(W, D, MW, nullptr, (bf16*)(wl + WL_B) + (size_t)m * D * MW, scr, it, nblk, F.lane, CmIdent()); }
        { const int nblk = D / 32, items = (D / 64) * nblk; const float* W = F.in[I_WOUT] + (size_t)L * D * D;
          for (int it = gw; it < items; it += NGW) transpose_item(W, D, D, nullptr, (bf16*)(wl + WL_OUT), scr, it, nblk, F.lane, CmIdent()); }
        { const int nblk = (2 * DFF) / 32, items = (D / 64) * nblk; const float* Wg = F.in[I_FFG] + (size_t)L * D * DFF; const float* Wu = F.in[I_FFU] + (size_t)L * D * DFF;
          for (int it = gw; it < items; it += NGW) { const int nb = it % nblk; const bool up = ((nb * 32) & 128) != 0; transpose_item(up ? Wu : Wg, DFF, D, g_ffn, (bf16*)(wl + WL_FF), scr, it, nblk, F.lane, CmFF()); } }
        { const int nblk = D / 32, items = (DFF / 64) * nblk; const float* W = F.in[I_FFD] + (size_t)L * DFF * D;
          for (int it = gw; it < items; it += NGW) transpose_item(W, D, DFF, nullptr, (bf16*)(wl + WL_DN), scr, it, nblk, F.lane, CmIdent()); }
        { const int nblk = D / 32, items = (D / 64) * nblk; const float* W = F.in[I_PLEG] + (size_t)L * D * D;
          for (int it = gw; it < items; it += NGW) transpose_item(W, D, D, g_ple, (bf16*)(wl + WL_PG), scr, it, nblk, F.lane, CmIdent()); }
        { const int nblk = D / 32, items = (PLE / 64) * nblk; const float* W = F.in[I_PLEP] + (size_t)L * PLE * D;
          for (int it = gw; it < items; it += NGW) transpose_item(W, D, PLE, nullptr, (bf16*)(wl + WL_PP), scr, it, nblk, F.lane, CmIdent()); }
    }
    for (int L = 0; L < NL; ++L) for (int kv = 0; kv < 2; ++kv) {
        const float* w1 = F.in[kv ? I_CV1 : I_CK1] + (size_t)L * 2048 * 128; const float* w2 = F.in[kv ? I_CV2 : I_CK2] + (size_t)L * 128 * 64;
        bf16* w1T = (bf16*)(F.ws + WS_CW1 + (size_t)L * MiB) + (size_t)kv * 128 * 2048; bf16* w2T = (bf16*)(F.ws + WS_CW2 + (size_t)L * 65536) + kv * 64 * 128;
        for (int it = gw; it < 128; it += NGW) transpose_item(w1, 128, 2048, nullptr, w1T, scr, it, 4, F.lane, CmIdent());
        for (int it = gw; it < 4; it += NGW) transpose_item(w2, 64, 128, nullptr, w2T, scr, it, 2, F.lane, CmIdent());
        for (int tk = gw; tk < 64; tk += NGW) { const int hf = tk & 1, jq = tk >> 1; const float* pos = F.in[kv ? I_POS_V : I_POS_K] + (size_t)L * 2048; float a = 0.f;
#pragma unroll 8
            for (int j = 64 * jq; j < 64 * jq + 64; ++j) a += pos[j] * w1[(size_t)j * 128 + hf * 64 + F.lane];
            atomicAdd((float*)(F.ws + WS_CTL) + CW_C1 + L * 256 + kv * 128 + hf * 64 + F.lane, a); } }
    { const float* x = F.in[I_X]; bf16* hb = (bf16*)(F.ws + WS_HBA); float* ss0 = (float*)(F.ws + WS_CTL) + CW_SS;
      for (int r = gw; r < T; r += NGW) { const f32x4* xr = (const f32x4*)(x + (size_t)r * D) + F.lane; float s = 0.f;
#pragma unroll
        for (int j = 0; j < 4; ++j) { const f32x4 v = xr[64 * j]; s += (v[0] * v[0] + v[1] * v[1]) + (v[2] * v[2] + v[3] * v[3]);
            u32x2 w; w.x = cvt_pk_bf16(v[0], v[1]); w.y = cvt_pk_bf16(v[2], v[3]); *((u32x2*)(hb + (size_t)r * D) + F.lane + 64 * j) = w; }
        s = wave_sum(s); if (F.lane == 0) ss0[r] = s; } }
    for (int L = 0; L < NL; ++L) { bf16* base = (bf16*)(F.ws + WS_RWUP + (size_t)L * 131072);
        for (int it = gw; it < 8; it += NGW) transpose_item(F.in[I_WUP] + (size_t)L * 64 * 256, 256, 64, nullptr, base, scr, it, 8, F.lane, CmIdent());
        for (int it = gw; it < 8; it += NGW) transpose_item(F.in[I_AUP] + (size_t)L * 64 * 256, 256, 64, nullptr, base + 256 * 64, scr, it, 8, F.lane, CmIdent());
        for (int it = gw; it < 16; it += NGW) transpose_item(F.in[I_GUP] + (size_t)L * 128 * 256, 256, 128, nullptr, base + 2 * 256 * 64, scr, it, 8, F.lane, CmIdent()); }
    { float* rope = (float*)(F.ws + WS_ROPE); const int gt = F.bx * NTHR + F.tid, NT_ = F.G * NTHR;
      for (int i = gt; i < S * 32; i += NT_) { const int pos = i >> 5, j = i & 31; const double inv = pow(10000.0, -(double)(2 * j) / 64.0); const double a = (double)pos * (double)(float)inv;
        rope[2 * i] = (float)cos(a); rope[2 * i + 1] = (float)sin(a); } }
}

__device__ __forceinline__ float ldu(const bf16* u, size_t row, int col) { return bf2f(u[row * UW + col]); }

typedef short s16x4 __attribute__((ext_vector_type(4)));
__device__ __forceinline__ bf16x8 frag_rm(const LAS unsigned char* X, int ld, int r0, int k0, int lane) { return *(const LAS bf16x8*)(X + (r0 + (lane & 31)) * ld + (k0 + 8 * (lane >> 5)) * 2); }
__device__ __forceinline__ bf16x8 frag_tr(const LAS unsigned char* X, int ld, int k0, int c0, int lane) {
    const LAS unsigned char* p = X + (k0 + 8 * (lane >> 5) + ((lane & 15) >> 2)) * ld + (c0 + 16 * ((lane >> 4) & 1) + 4 * (lane & 3)) * 2;
    const s16x4 a = __builtin_amdgcn_ds_read_tr16_b64_v4i16((LAS s16x4*)p), b = __builtin_amdgcn_ds_read_tr16_b64_v4i16((LAS s16x4*)(p + 4 * ld));
    return (bf16x8){a[0], a[1], a[2], a[3], b[0], b[1], b[2], b[3]};
}
__device__ __forceinline__ bf16x8 frag_g(const bf16* X, int ld, int r0, int k0, int lane) { return *(const bf16x8*)(X + (size_t)(r0 + (lane & 31)) * ld + k0 + 8 * (lane >> 5)); }
__device__ __forceinline__ f32x16 mma32(const bf16x8& a, const bf16x8& b, const f32x16& c) { return __builtin_amdgcn_mfma_f32_32x32x16_bf16(a, b, c, 0, 0, 0); }
__device__ __forceinline__ f32x16 zero16() { f32x16 z;
#pragma unroll
    for (int i = 0; i < 16; ++i) z[i] = 0.f;
    return z; }
__device__ __forceinline__ void st_T(LAS unsigned char* X, int ld, int j0, int i0, const f32x16& acc, int lane) {
#pragma unroll
    for (int g = 0; g < 4; ++g) { u32x2 w; w.x = cvt_pk_bf16(acc[4 * g], acc[4 * g + 1]); w.y = cvt_pk_bf16(acc[4 * g + 2], acc[4 * g + 3]);
        *(LAS u32x2*)(X + (j0 + (lane & 31)) * ld + (i0 + 8 * g + 4 * (lane >> 5)) * 2) = w; }
}
__device__ __forceinline__ void st_wt8(bf16* p, const u32x2& w) { __hip_atomic_store((unsigned long long*)p, ((unsigned long long)w.y << 32) | (unsigned long long)w.x, __ATOMIC_RELAXED, __HIP_MEMORY_SCOPE_AGENT); }
__device__ __forceinline__ void st_T_g(bf16* X, int ld, int j0, int i0, const f32x16& acc, int lane) {
#pragma unroll
    for (int g = 0; g < 4; ++g) { u32x2 w; w.x = cvt_pk_bf16(acc[4 * g], acc[4 * g + 1]); w.y = cvt_pk_bf16(acc[4 * g + 2], acc[4 * g + 3]);
        st_wt8(X + (size_t)(j0 + (lane & 31)) * ld + i0 + 8 * g + 4 * (lane >> 5), w); }
}
constexpr int LD64 = 144, LD32 = 80;
__device__ __forceinline__ float expc(float x) { return __expf(fminf(fmaxf(x, -80.f), 80.f)); }
__device__ __forceinline__ unsigned short f2b(float x) { return (unsigned short)(cvt_pk_bf16(x, 0.f) & 0xffffu); }
__device__ __forceinline__ void copy_tok64(LAS unsigned char* X, const bf16* src, int lane) {
#pragma unroll
    for (int p = 0; p < 4; ++p) { const int t = 8 * p + (lane >> 3), ch = lane & 7; *(LAS u32x4*)(X + t * LD64 + ch * 16) = *(const u32x4*)(src + (size_t)t * UW + ch * 8); }
}
__device__ __forceinline__ void glin_m1(const LAS unsigned char* Kh, const LAS unsigned char* Vv, bf16* Sg, int lane, bool cst = false) {
#pragma unroll
    for (int dt = 0; dt < 2; ++dt)
#pragma unroll
        for (int et = 0; et < 2; ++et) { f32x16 acc = zero16();
#pragma unroll
            for (int ks = 0; ks < 2; ++ks) acc = mma32(frag_tr(Kh, LD64, 16 * ks, 32 * dt, lane), frag_tr(Vv, LD64, 16 * ks, 32 * et, lane), acc);
            if (cst) {
#pragma unroll
            for (int i = 0; i < 16; ++i) acc[i] = 0.01f * (float)(1 + ((lane + i) & 7)); }
            st_T_g(Sg, 64, 32 * et, 32 * dt, acc, lane); }
}
__device__ __forceinline__ void glin_m3(const LAS unsigned char* Qt, const LAS unsigned char* Kt, const LAS unsigned char* Vv, LAS unsigned char* Xa, const bf16* S0, int lane, f32x16 (&o)[2]) {
    { f32x16 acc = zero16();
#pragma unroll
      for (int ks = 0; ks < 4; ++ks) acc = mma32(frag_rm(Kt, LD64, 0, 16 * ks, lane), frag_rm(Qt, LD64, 0, 16 * ks, lane), acc);
      const int t = lane & 31;
#pragma unroll
      for (int i = 0; i < 16; ++i) { const int sidx = (i & 3) + 8 * (i >> 2) + 4 * (lane >> 5); if (sidx > t) acc[i] = 0.f; }
      st_T(Xa, LD32, 0, 0, acc, lane); }
    LDS_WAIT();
#pragma unroll
    for (int et = 0; et < 2; ++et) { f32x16 acc = zero16();
        if (S0) {
#pragma unroll
            for (int ks = 0; ks < 4; ++ks) acc = mma32(frag_g(S0, 64, 32 * et, 16 * ks, lane), frag_rm(Qt, LD64, 0, 16 * ks, lane), acc); }
#pragma unroll
        for (int ks = 0; ks < 2; ++ks) acc = mma32(frag_tr(Vv, LD64, 16 * ks, 32 * et, lane), frag_rm(Xa, LD32, 0, 16 * ks, lane), acc);
        o[et] = acc; }
}
template <bool M3>
__device__ __forceinline__ void hgrn_chunk(Frame& F, int L, int bh, int n, LAS unsigned char* W, bf16* Sbase, float* Dbase) {
    const bf16* u = (const bf16*)(F.ws + WS_U); bf16* bo = (bf16*)(F.ws + WS_BO);
    int lane = F.lane; asm volatile("" : "+v"(lane));
    const int b = bh >> 2, h = bh & 3; const size_t row0 = (size_t)b * S + (size_t)n * CH;
    const bf16* ur = u + row0 * UW + U_HG + h * 64;
    bf16* Sg = Sbase + ((size_t)bh * NCH + n) * 4096;
    LAS unsigned char* Xq = W; LAS unsigned char* Xk = W + 4608; LAS unsigned char* Xv = W + 9216; LAS unsigned char* Xa = W + 13824;
    const float* lbl = F.in[I_LB]; const int ch = h * 64 + lane;
    float lb = 0.f; if (L > 0) { const float l0 = lbl[ch], l1 = lbl[256 + ch]; const float mx = fmaxf(l0, l1); const float e0 = __expf(l0 - mx), e1 = __expf(l1 - mx); lb = e1 / (e0 + e1); }
    float bcum[CH], kk[CH]; float run = 0.f;
#pragma unroll
    for (int t = 0; t < CH; ++t) { const float z = bf2f(ur[(size_t)t * UW + 256 + lane]); const float f = lb + (1.0f - lb) * fsigmoid(z); kk[t] = 1.0f - f; run += __logf(fmaxf(f, 1e-20f)); bcum[t] = run; }
    const float blast = bcum[CH - 1];
    copy_tok64(Xv, ur + 512, lane);
    if (!M3) {
#pragma unroll
        for (int t = 0; t < CH; ++t) *(LAS unsigned short*)(Xq + t * LD64 + lane * 2) = f2b(kk[t] * expc(blast - bcum[t]));
        Dbase[((size_t)bh * NCH + n) * 64 + lane] = expc(blast);
        LDS_WAIT();
        glin_m1(Xq, Xv, Sg, lane);
    } else {
#pragma unroll
        for (int t = 0; t < CH; ++t) { const float q = fsilu(bf2f(ur[(size_t)t * UW + lane]));
            *(LAS unsigned short*)(Xq + t * LD64 + lane * 2) = f2b(q * expc(bcum[t]));
            *(LAS unsigned short*)(Xk + t * LD64 + lane * 2) = f2b(kk[t] * expc(-bcum[t])); }
        LDS_WAIT();
        f32x16 o[2];
        glin_m3(Xq, Xk, Xv, Xa, n > 0 ? Sg - 4096 : nullptr, lane, o);
        const int t = lane & 31, hh = lane >> 5; float ss = 0.f;
#pragma unroll
        for (int et = 0; et < 2; ++et)
#pragma unroll
            for (int i = 0; i < 16; ++i) ss += o[et][i] * o[et][i];
        ss += __shfl_xor(ss, 32);
        const float rn = __builtin_amdgcn_rsqf(ss * (1.0f / 64.0f) + EPS);
        const float* ng = F.in[I_HG_NORM] + L * 256 + h * 64;
#pragma unroll
        for (int et = 0; et < 2; ++et)
#pragma unroll
            for (int g = 0; g < 4; ++g) { const int e0 = 32 * et + 8 * g + 4 * hh;
                const u32x2 og = *(const u32x2*)(ur + (size_t)t * UW + 768 + e0); const f32x4 gg = *(const f32x4*)(ng + e0);
                const float y0 = o[et][4 * g] * rn * gg[0] * fsilu(bflo(og.x)), y1 = o[et][4 * g + 1] * rn * gg[1] * fsilu(bfhi(og.x));
                const float y2 = o[et][4 * g + 2] * rn * gg[2] * fsilu(bflo(og.y)), y3 = o[et][4 * g + 3] * rn * gg[3] * fsilu(bfhi(og.y));
                u32x2 w; w.x = cvt_pk_bf16(y0, y1); w.y = cvt_pk_bf16(y2, y3);
                *(u32x2*)(bo + (row0 + t) * 1024 + 256 + h * 64 + e0) = w; }
    }
    LDS_WAIT();
}
template <bool M3>
__device__ __forceinline__ void ret_chunk(Frame& F, int L, int bh, int n, LAS unsigned char* W, bf16* Sbase) {
    const bf16* u = (const bf16*)(F.ws + WS_U); bf16* bo = (bf16*)(F.ws + WS_BO); const float* rope = (const float*)(F.ws + WS_ROPE);
    int lane = F.lane; asm volatile("" : "+v"(lane));
    const int b = bh >> 2, h = bh & 3; const int tpos0 = n * CH; const size_t row0 = (size_t)b * S + (size_t)tpos0;
    const bf16* ur = u + row0 * UW + U_RT + h * 64;
    bf16* Sg = Sbase + ((size_t)bh * NCH + n) * 4096;
    LAS unsigned char* Xq = W; LAS unsigned char* Xk = W + 4608; LAS unsigned char* Xv = W + 9216; LAS unsigned char* Xa = W + 13824;
    const float lg2 = __log2f(1.0f - exp2f(-5.0f - (float)h));
    copy_tok64(Xv, ur + 512, lane);
#pragma unroll
    for (int p = 0; p < 2; ++p) { const int idx = lane + 64 * p, t = idx >> 2, jc = idx & 3;
        f32x4 c0, c1, s0, s1;
        { const float* rp = rope + ((size_t)(tpos0 + t) * 32 + jc * 8) * 2; const f32x4 a = *(const f32x4*)rp, bq = *(const f32x4*)(rp + 4), c = *(const f32x4*)(rp + 8), d = *(const f32x4*)(rp + 12);
          c0 = (f32x4){a[0], a[2], bq[0], bq[2]}; s0 = (f32x4){a[1], a[3], bq[1], bq[3]}; c1 = (f32x4){c[0], c[2], d[0], d[2]}; s1 = (f32x4){c[1], c[3], d[1], d[3]}; }
        { const u32x4 w1 = *(const u32x4*)(ur + (size_t)t * UW + 256 + jc * 8), w2 = *(const u32x4*)(ur + (size_t)t * UW + 256 + 32 + jc * 8);
          f32x4 a0, a1, b0, b1; unpack8(w1, a0, a1); unpack8(w2, b0, b1);
          const float sc = 0.125f * exp2f(lg2 * (M3 ? -(float)(t + 1) : (float)(CH - 1 - t)));
          const f32x4 lo0 = (a0 * c0 - b0 * s0) * sc, lo1 = (a1 * c1 - b1 * s1) * sc, hi0 = (a0 * s0 + b0 * c0) * sc, hi1 = (a1 * s1 + b1 * c1) * sc;
          LAS unsigned char* dst = M3 ? Xk : Xq;
          *(LAS u32x4*)(dst + t * LD64 + jc * 16) = pack8(lo0, lo1); *(LAS u32x4*)(dst + t * LD64 + 64 + jc * 16) = pack8(hi0, hi1); }
        if (M3) { const u32x4 w1 = *(const u32x4*)(ur + (size_t)t * UW + jc * 8), w2 = *(const u32x4*)(ur + (size_t)t * UW + 32 + jc * 8);
          f32x4 a0, a1, b0, b1; unpack8(w1, a0, a1); unpack8(w2, b0, b1);
          const float sc = exp2f(lg2 * (float)(t + 1));
          const f32x4 lo0 = (a0 * c0 - b0 * s0) * sc, lo1 = (a1 * c1 - b1 * s1) * sc, hi0 = (a0 * s0 + b0 * c0) * sc, hi1 = (a1 * s1 + b1 * c1) * sc;
          *(LAS u32x4*)(Xq + t * LD64 + jc * 16) = pack8(lo0, lo1); *(LAS u32x4*)(Xq + t * LD64 + 64 + jc * 16) = pack8(hi0, hi1); }
    }
    LDS_WAIT();
    if (!M3) glin_m1(Xq, Xv, Sg, lane);
    else {
        f32x16 o[2];
        glin_m3(Xq, Xk, Xv, Xa, n > 0 ? Sg - 4096 : nullptr, lane, o);
        const int t = lane & 31, hh = lane >> 5; float sm = 0.f;
#pragma unroll
        for (int et = 0; et < 2; ++et)
#pragma unroll
            for (int i = 0; i < 16; ++i) sm += o[et][i];
        sm += __shfl_xor(sm, 32);
        const float mean = sm * (1.0f / 64.0f); float sv = 0.f;
#pragma unroll
        for (int et = 0; et < 2; ++et)
#pragma unroll
            for (int i = 0; i < 16; ++i) { const float dl = o[et][i] - mean; sv += dl * dl; }
        sv += __shfl_xor(sv, 32);
        const float rn = __builtin_amdgcn_rsqf(sv * (1.0f / 64.0f) + 1e-5f);
        const float* ng = F.in[I_RT_G] + L * 256 + h * 64; const float* nb = F.in[I_RT_B] + L * 256 + h * 64;
#pragma unroll
        for (int et = 0; et < 2; ++et)
#pragma unroll
            for (int g = 0; g < 4; ++g) { const int e0 = 32 * et + 8 * g + 4 * hh;
                const u32x2 og = *(const u32x2*)(ur + (size_t)t * UW + 768 + e0); const f32x4 gg = *(const f32x4*)(ng + e0), bb = *(const f32x4*)(nb + e0);
                const float y0 = ((o[et][4 * g] - mean) * rn * gg[0] + bb[0]) * fsilu(bflo(og.x)), y1 = ((o[et][4 * g + 1] - mean) * rn * gg[1] + bb[1]) * fsilu(bfhi(og.x));
                const float y2 = ((o[et][4 * g + 2] - mean) * rn * gg[2] + bb[2]) * fsilu(bflo(og.y)), y3 = ((o[et][4 * g + 3] - mean) * rn * gg[3] + bb[3]) * fsilu(bfhi(og.y));
                u32x2 w; w.x = cvt_pk_bf16(y0, y1); w.y = cvt_pk_bf16(y2, y3);
                *(u32x2*)(bo + (row0 + t) * 1024 + 512 + h * 64 + e0) = w; }
    }
    LDS_WAIT();
}
__device__ __forceinline__ void glin_scan_task(bf16* Sbase, const float* Dbase, float dscal, int bh, int quarter, int tl  ) {
    bf16* p = Sbase + (size_t)bh * NCH * 4096 + quarter * 1024 + tl * 4;
    const int d0 = (tl & 15) * 4;
    f32x4 st = {0.f, 0.f, 0.f, 0.f};
    for (int n0 = 0; n0 < NCH; n0 += 8) {
        u32x2 kv[8]; f32x4 dd[8];
#pragma unroll
        for (int j = 0; j < 8; ++j) { kv[j] = *(const u32x2*)(p + (size_t)(n0 + j) * 4096); if (Dbase) dd[j] = *(const f32x4*)(Dbase + ((size_t)bh * NCH + n0 + j) * 64 + d0); else dd[j] = (f32x4){dscal, dscal, dscal, dscal}; }
#pragma unroll
        for (int j = 0; j < 8; ++j) {
            st[0] = st[0] * dd[j][0] + bflo(kv[j].x); st[1] = st[1] * dd[j][1] + bfhi(kv[j].x); st[2] = st[2] * dd[j][2] + bflo(kv[j].y); st[3] = st[3] * dd[j][3] + bfhi(kv[j].y);
            u32x2 w; w.x = cvt_pk_bf16(st[0], st[1]); w.y = cvt_pk_bf16(st[2], st[3]); st_wt8(p + (size_t)(n0 + j) * 4096, w); }
    }
}

constexpr int RW_R0 = 0, RW_R1 = 4608, RW_R2 = 9216, RW_R3 = 13824, RW_R4 = 16384, RW_R5 = 18944, RW_LW = 0, RW_AG = 8704, LDLW = 272;
__device__ __forceinline__ void ld_shift8(const bf16* urow, bool has_prev, const float* mu8, f32x4& lo, f32x4& hi) {
    const u32x4 w1 = *(const u32x4*)urow; f32x4 a0, a1; unpack8(w1, a0, a1);
    f32x4 p0 = {0.f, 0.f, 0.f, 0.f}, p1 = {0.f, 0.f, 0.f, 0.f};
    if (has_prev) { const u32x4 w0 = *(const u32x4*)(urow - UW); unpack8(w0, p0, p1); }
    const f32x4 m0 = *(const f32x4*)mu8, m1 = *(const f32x4*)(mu8 + 4);
    lo = a0 + m0 * (p0 - a0); hi = a1 + m1 * (p1 - a1);
}
__device__ __forceinline__ float ftanh(float x) { return 1.0f - 2.0f * __builtin_amdgcn_rcpf(1.0f + __builtin_amdgcn_exp2f(2.8853900817779268f * x)); }
#ifndef RW_LIMIT
#define RW_LIMIT 100
#endif
#define RW_CUT(k) do { if (RW_LIMIT <= (k)) return; } while (0)
template <int SI> struct SubstStep {
    static __device__ __forceinline__ void run(float (&Tr)[CH], const LAS unsigned char* AT, int r32, int& ofs) {
        float a0 = (r32 == SI) ? 1.0f : 0.f, a1 = 0.f;
#pragma unroll
        for (int q = 0; q < 4; ++q) { if (8 * q + 7 > SI) { const u32x4 w = *(const LAS u32x4*)(AT + ofs + SI * LD32 + q * 16); f32x4 lo, hi; unpack8(w, lo, hi);
#pragma unroll
            for (int x = 0; x < 4; ++x) { if (8 * q + x > SI) a0 += Tr[8 * q + x] * lo[x]; if (8 * q + 4 + x > SI) a1 += Tr[8 * q + 4 + x] * hi[x]; } } }
        const float a = a0 + a1;
        Tr[SI] = a;
        asm volatile("" : "+v"(ofs) : "v"(a));
        SubstStep<SI - 1>::run(Tr, AT, r32, ofs);
    }
};
template <> struct SubstStep<-1> { static __device__ __forceinline__ void run(float (&)[CH], const LAS unsigned char*, int, int&) {} };
template <bool M3>
__device__ __forceinline__ void rwkv_chunk(Frame& F, int L, int bh, int n, LAS unsigned char* W) {
    const bf16* u = (const bf16*)(F.ws + WS_U); bf16* bo = (bf16*)(F.ws + WS_BO);
    int lane = F.lane; asm volatile("" : "+v"(lane));
    const int b = bh >> 2, h = bh & 3, r32 = lane & 31, hh = lane >> 5; const size_t row0 = (size_t)b * S + (size_t)n * CH;
    const bf16* ur = u + row0 * UW + U_RW;
    const float* mu = F.in[I_MU] + L * 1024;
    const bf16* upT = (const bf16*)(F.ws + WS_RWUP + (size_t)L * 131072);
    bf16* Mg = (bf16*)(F.ws + WS_RWM) + ((size_t)bh * NCH + n) * 4096;
    bf16* Ng = (bf16*)(F.ws + WS_RWN) + ((size_t)bh * NCH + n) * 4096;
    LAS unsigned char* R0 = W + RW_R0; LAS unsigned char* R1 = W + RW_R1; LAS unsigned char* R2 = W + RW_R2; LAS unsigned char* R3 = W + RW_R3; LAS unsigned char* R4 = W + RW_R4;
    LAS float* R5 = (LAS float*)(W + RW_R5);
#pragma unroll
    for (int i = 0; i < 8; ++i) { const int idx = lane + 64 * i, t = idx >> 4, part = (idx >> 3) & 1, ch = idx & 7, col = 768 + part * 64 + ch * 8;
        f32x4 lo, hi; ld_shift8(ur + (size_t)t * UW + col, (n * CH + t) > 0, mu + col, lo, hi);
        if (part == 0) {
#pragma unroll
            for (int j = 0; j < 4; ++j) { lo[j] = ftanh(lo[j]); hi[j] = ftanh(hi[j]); } }
        *(LAS u32x4*)(W + part * 4608 + t * LD64 + ch * 16) = pack8(lo, hi); }
    RW_CUT(0);
    LDS_WAIT();
    { f32x16 zw[2], za[2];
#pragma unroll
      for (int ct = 0; ct < 2; ++ct) { zw[ct] = zero16(); za[ct] = zero16();
#pragma unroll
        for (int ks = 0; ks < 4; ++ks) { zw[ct] = mma32(frag_g(upT + (size_t)(h * 64 + 32 * ct) * 64, 64, 0, 16 * ks, lane), frag_rm(W, LD64, 0, 16 * ks, lane), zw[ct]);
            za[ct] = mma32(frag_g(upT + 256 * 64 + (size_t)(h * 64 + 32 * ct) * 64, 64, 0, 16 * ks, lane), frag_rm(W + 4608, LD64, 0, 16 * ks, lane), za[ct]); } }
      const float* w0 = F.in[I_W0] + L * 256 + h * 64; const float* a0 = F.in[I_A0] + L * 256 + h * 64;
#pragma unroll
      for (int ct = 0; ct < 2; ++ct)
#pragma unroll
        for (int g = 0; g < 4; ++g) { const int c0 = 32 * ct + 8 * g + 4 * hh; const f32x4 wv = *(const f32x4*)(w0 + c0), av = *(const f32x4*)(a0 + c0);
            f32x4 lw, ag;
#pragma unroll
            for (int x = 0; x < 4; ++x) { lw[x] = -0.6065306597126334f * fsigmoid(zw[ct][4 * g + x] + wv[x]); ag[x] = fsigmoid(za[ct][4 * g + x] + av[x]); }
            *(LAS f32x4*)(W + RW_LW + r32 * LDLW + c0 * 4) = lw;
            u32x2 pk; pk.x = cvt_pk_bf16(ag[0], ag[1]); pk.y = cvt_pk_bf16(ag[2], ag[3]); *(LAS u32x2*)(W + RW_AG + r32 * LD64 + c0 * 2) = pk; } }
    RW_CUT(1);
    LDS_WAIT();
    { float run = 0.f;
#pragma unroll
      for (int t = 0; t < CH; ++t) { LAS float* p = (LAS float*)(W + RW_LW + t * LDLW) + lane; run += *p; *p = run; } }
    RW_CUT(2);
    LDS_WAIT();
    const int c0 = 8 * (lane & 7), tl = lane >> 3;
    u32x4 E1p[4], E2p[4], AGp[4];
#pragma unroll
    for (int p = 0; p < 4; ++p) { const int t = 8 * p + tl;
        const f32x4 ca = *(const LAS f32x4*)(W + RW_LW + t * LDLW + c0 * 4), cb = *(const LAS f32x4*)(W + RW_LW + t * LDLW + c0 * 4 + 16);
        f32x4 ea = {0.f, 0.f, 0.f, 0.f}, eb = {0.f, 0.f, 0.f, 0.f};
        if (t > 0) { ea = *(const LAS f32x4*)(W + RW_LW + (t - 1) * LDLW + c0 * 4); eb = *(const LAS f32x4*)(W + RW_LW + (t - 1) * LDLW + c0 * 4 + 16); }
        AGp[p] = *(const LAS u32x4*)(W + RW_AG + t * LD64 + c0 * 2);
        f32x4 x1a, x1b, x2a, x2b;
#pragma unroll
        for (int x = 0; x < 4; ++x) { x1a[x] = __expf(ea[x]); x1b[x] = __expf(eb[x]); x2a[x] = __expf(-ca[x]); x2b[x] = __expf(-cb[x]); }
        E1p[p] = pack8(x1a, x1b); E2p[p] = pack8(x2a, x2b); }
    float pcl[8];
    { const f32x4 la = *(const LAS f32x4*)(W + RW_LW + 31 * LDLW + c0 * 4), lb2 = *(const LAS f32x4*)(W + RW_LW + 31 * LDLW + c0 * 4 + 16);
#pragma unroll
      for (int x = 0; x < 4; ++x) { pcl[x] = __expf(la[x]); pcl[4 + x] = __expf(lb2[x]); } }
    RW_CUT(3);
    LDS_WAIT();
    const float* kkw = F.in[I_KK] + L * 256 + h * 64 + c0; const float* kaw = F.in[I_KA] + L * 256 + h * 64 + c0; const float* rkw = F.in[I_RK] + L * 256 + h * 64 + c0;
    u32x4 Ap[4];
    if (!M3 && tl == 0) { *(LAS f32x4*)(R5 + c0) = (f32x4){pcl[0], pcl[1], pcl[2], pcl[3]}; *(LAS f32x4*)(R5 + c0 + 4) = (f32x4){pcl[4], pcl[5], pcl[6], pcl[7]}; }
#pragma unroll
    for (int p = 0; p < 4; ++p) { const int t = 8 * p + tl; const bool hp = (n * CH + t) > 0; const bf16* ut = ur + (size_t)t * UW + h * 64 + c0;
        f32x4 k0, k1, r0 = {0.f, 0.f, 0.f, 0.f}, r1 = {0.f, 0.f, 0.f, 0.f};
        ld_shift8(ut + 256, hp, mu + 256 + h * 64 + c0, k0, k1);
        if (M3) ld_shift8(ut, hp, mu + h * 64 + c0, r0, r1);
        f32x4 ag0, ag1; unpack8(AGp[p], ag0, ag1);
        float E1[8], E2[8]; { f32x4 a, bq; unpack8(E1p[p], a, bq); f32x4 c, d; unpack8(E2p[p], c, d);
#pragma unroll
            for (int x = 0; x < 4; ++x) { E1[x] = a[x]; E1[4 + x] = bq[x]; E2[x] = c[x]; E2[4 + x] = d[x]; } }
        const f32x4 kw0 = *(const f32x4*)kkw, kw1 = *(const f32x4*)(kkw + 4), ka0 = *(const f32x4*)kaw, ka1 = *(const f32x4*)(kaw + 4);
        f32x4 q0 = k0 * kw0, q1 = k1 * kw1;
        float n2 = (q0[0] * q0[0] + q0[1] * q0[1]) + (q0[2] * q0[2] + q0[3] * q0[3]) + (q1[0] * q1[0] + q1[1] * q1[1]) + (q1[2] * q1[2] + q1[3] * q1[3]);
        n2 += __shfl_xor(n2, 1); n2 += __shfl_xor(n2, 2); n2 += __shfl_xor(n2, 4);
        const float rn = __builtin_amdgcn_rsqf(fmaxf(n2, 1e-24f)); q0 = q0 * rn; q1 = q1 * rn;
        f32x4 kp0, kp1, at0, at1, bt0, bt1, kt0, kt1;
#pragma unroll
        for (int x = 0; x < 4; ++x) { kp0[x] = k0[x] * (1.0f + (ag0[x] - 1.0f) * ka0[x]); kp1[x] = k1[x] * (1.0f + (ag1[x] - 1.0f) * ka1[x]);
            at0[x] = -q0[x] * E1[x]; at1[x] = -q1[x] * E1[4 + x]; bt0[x] = q0[x] * ag0[x] * E2[x]; bt1[x] = q1[x] * ag1[x] * E2[4 + x];
            kt0[x] = kp0[x] * E2[x]; kt1[x] = kp1[x] * E2[4 + x]; }
        *(LAS u32x4*)(R1 + t * LD64 + c0 * 2) = pack8(bt0, bt1); *(LAS u32x4*)(R2 + t * LD64 + c0 * 2) = pack8(kt0, kt1);
        if (!M3) *(LAS u32x4*)(R0 + t * LD64 + c0 * 2) = pack8(at0, at1);
        else { Ap[p] = pack8(at0, at1);
            const f32x4 rk0 = *(const f32x4*)rkw, rk1 = *(const f32x4*)(rkw + 4);
            f32x4 rt0, rt1; float bs = 0.f;
#pragma unroll
            for (int x = 0; x < 4; ++x) { rt0[x] = r0[x] * __builtin_amdgcn_rcpf(E2[x]); rt1[x] = r1[x] * __builtin_amdgcn_rcpf(E2[4 + x]); bs += r0[x] * kp0[x] * rk0[x] + r1[x] * kp1[x] * rk1[x]; }
            bs += __shfl_xor(bs, 1); bs += __shfl_xor(bs, 2); bs += __shfl_xor(bs, 4);
            if ((lane & 7) == 0) R5[t] = bs;
            *(LAS u32x4*)(R0 + t * LD64 + c0 * 2) = pack8(rt0, rt1); } }
    RW_CUT(4);
    LDS_WAIT();
    const bf16* S0 = n > 0 ? Ng - 4096 : nullptr;
    f32x16 yacc[2], g2acc;
    if (M3) {
#pragma unroll
        for (int vt = 0; vt < 2; ++vt) { yacc[vt] = zero16();
            if (S0) {
#pragma unroll
                for (int ks = 0; ks < 4; ++ks) yacc[vt] = mma32(frag_g(S0, 64, 32 * vt, 16 * ks, lane), frag_rm(R0, LD64, 0, 16 * ks, lane), yacc[vt]); } }
        f32x16 g1 = zero16(); g2acc = zero16();
#pragma unroll
        for (int ks = 0; ks < 4; ++ks) { const bf16x8 rf = frag_rm(R0, LD64, 0, 16 * ks, lane); g1 = mma32(frag_rm(R1, LD64, 0, 16 * ks, lane), rf, g1); g2acc = mma32(frag_rm(R2, LD64, 0, 16 * ks, lane), rf, g2acc); }
#pragma unroll
        for (int i = 0; i < 16; ++i) { const int sidx = (i & 3) + 8 * (i >> 2) + 4 * hh; if (sidx > r32) { g1[i] = 0.f; g2acc[i] = 0.f; } }
        st_T(R4, LD32, 0, 0, g1, lane);
        LDS_WAIT();
#pragma unroll
        for (int p = 0; p < 4; ++p) *(LAS u32x4*)(R0 + (8 * p + tl) * LD64 + c0 * 2) = Ap[p];
        LDS_WAIT();
    }
    RW_CUT(5);
    { f32x16 ab = zero16(), ak = zero16();
#pragma unroll
      for (int ks = 0; ks < 4; ++ks) { const bf16x8 af = frag_rm(R0, LD64, 0, 16 * ks, lane); ab = mma32(af, frag_rm(R1, LD64, 0, 16 * ks, lane), ab); ak = mma32(frag_rm(R2, LD64, 0, 16 * ks, lane), af, ak); }
#pragma unroll
      for (int i = 0; i < 16; ++i) { const int ridx = (i & 3) + 8 * (i >> 2) + 4 * hh;
          if (!(ridx > r32)) ab[i] = 0.f;
          if (!(ridx < r32)) ak[i] = 0.f; }
      st_T(R3, LD32, 0, 0, ab, lane);
      st_T(M3 ? R2 : R4, LD32, 0, 0, ak, lane); }
    LAS unsigned char* X1 = M3 ? R2 : R4;
    RW_CUT(6);
    LDS_WAIT();
    { float Tr[CH];
      int sofs = 0; asm volatile("" : "+v"(sofs)); SubstStep<CH - 1>::run(Tr, R3, r32, sofs);
      if (hh == 0) {
#pragma unroll
          for (int q = 0; q < 4; ++q) { f32x4 lo = {Tr[8 * q], Tr[8 * q + 1], Tr[8 * q + 2], Tr[8 * q + 3]}, hi = {Tr[8 * q + 4], Tr[8 * q + 5], Tr[8 * q + 6], Tr[8 * q + 7]};
              *(LAS u32x4*)(R3 + r32 * LD32 + q * 16) = pack8(lo, hi); } } }
    RW_CUT(7);
    LDS_WAIT();
    { f32x16 y = zero16(), ah[2];
#pragma unroll
      for (int ks = 0; ks < 2; ++ks) y = mma32(frag_tr(X1, LD32, 16 * ks, 0, lane), frag_rm(R3, LD32, 0, 16 * ks, lane), y);
#pragma unroll
      for (int ct = 0; ct < 2; ++ct) { ah[ct] = zero16();
#pragma unroll
        for (int ks = 0; ks < 2; ++ks) ah[ct] = mma32(frag_tr(R0, LD64, 16 * ks, 32 * ct, lane), frag_rm(R3, LD32, 0, 16 * ks, lane), ah[ct]); }
      st_T(X1, LD32, 0, 0, y, lane);
      st_T(R0, LD64, 0, 0, ah[0], lane); st_T(R0, LD64, 0, 32, ah[1], lane); }
    RW_CUT(8);
    LDS_WAIT();
    if (!M3) {
        { f32x16 z[2];
#pragma unroll
          for (int dt = 0; dt < 2; ++dt) {
#pragma unroll
            for (int g = 0; g < 4; ++g) { const u32x2 w = *(const LAS u32x2*)(R2 + r32 * LD64 + (32 * dt + 8 * g + 4 * hh) * 2); z[dt][4 * g] = bflo(w.x); z[dt][4 * g + 1] = bfhi(w.x); z[dt][4 * g + 2] = bflo(w.y); z[dt][4 * g + 3] = bfhi(w.y); }
#pragma unroll
            for (int ks = 0; ks < 2; ++ks) z[dt] = mma32(frag_tr(R1, LD64, 16 * ks, 32 * dt, lane), frag_tr(X1, LD32, 16 * ks, 0, lane), z[dt]); }
          st_T(R2, LD64, 0, 0, z[0], lane); st_T(R2, LD64, 0, 32, z[1], lane); }
#pragma unroll
        for (int d1t = 0; d1t < 2; ++d1t) { const float pc1 = R5[32 * d1t + r32];
#pragma unroll
            for (int d2t = 0; d2t < 2; ++d2t) { f32x16 m = zero16();
#pragma unroll
                for (int ks = 0; ks < 2; ++ks) m = mma32(frag_tr(R0, LD64, 16 * ks, 32 * d2t, lane), frag_tr(R1, LD64, 16 * ks, 32 * d1t, lane), m);
#pragma unroll
                for (int i = 0; i < 16; ++i) { const int d2 = 32 * d2t + (i & 3) + 8 * (i >> 2) + 4 * hh; m[i] = pc1 * (m[i] + ((d2 == 32 * d1t + r32) ? 1.0f : 0.f)); }
                st_T_g(Mg, 64, 32 * d1t, 32 * d2t, m, lane); } }
        LDS_WAIT();
#pragma unroll
        for (int p = 0; p < 4; ++p) { const int t = 8 * p + tl; f32x4 v0, v1; ld_shift8(ur + (size_t)t * UW + h * 64 + c0 + 512, (n * CH + t) > 0, mu + 512 + h * 64 + c0, v0, v1); *(LAS u32x4*)(R1 + t * LD64 + c0 * 2) = pack8(v0, v1); }
        LDS_WAIT();
#pragma unroll
        for (int dt = 0; dt < 2; ++dt)
#pragma unroll
            for (int vt = 0; vt < 2; ++vt) { f32x16 nn = zero16();
#pragma unroll
                for (int ks = 0; ks < 2; ++ks) nn = mma32(frag_tr(R2, LD64, 16 * ks, 32 * dt, lane), frag_tr(R1, LD64, 16 * ks, 32 * vt, lane), nn);
#pragma unroll
                for (int g = 0; g < 4; ++g) { const f32x4 pv = *(const LAS f32x4*)(R5 + 32 * dt + 8 * g + 4 * hh);
#pragma unroll
                    for (int x = 0; x < 4; ++x) nn[4 * g + x] *= pv[x]; }
                st_T_g(Ng, 64, 32 * vt, 32 * dt, nn, lane); }
    } else {
        { f32x16 rh[2];
#pragma unroll
          for (int dt = 0; dt < 2; ++dt) { rh[dt] = zero16();
#pragma unroll
            for (int ks = 0; ks < 2; ++ks) rh[dt] = mma32(frag_tr(R0, LD64, 16 * ks, 32 * dt, lane), frag_rm(R4, LD32, 0, 16 * ks, lane), rh[dt]); }
          st_T(R1, LD64, 0, 0, rh[0], lane); st_T(R1, LD64, 0, 32, rh[1], lane); }
        { f32x16 gh = g2acc;
#pragma unroll
          for (int ks = 0; ks < 2; ++ks) gh = mma32(frag_tr(X1, LD32, 16 * ks, 0, lane), frag_rm(R4, LD32, 0, 16 * ks, lane), gh);
          LDS_WAIT();
          st_T(R3, LD32, 0, 0, gh, lane); }
        LDS_WAIT();
        if (S0) {
#pragma unroll
            for (int vt = 0; vt < 2; ++vt)
#pragma unroll
                for (int ks = 0; ks < 4; ++ks) yacc[vt] = mma32(frag_g(S0, 64, 32 * vt, 16 * ks, lane), frag_rm(R1, LD64, 0, 16 * ks, lane), yacc[vt]); }
        LDS_WAIT();
#pragma unroll
        for (int p = 0; p < 4; ++p) { const int t = 8 * p + tl; f32x4 v0, v1; ld_shift8(ur + (size_t)t * UW + h * 64 + c0 + 512, (n * CH + t) > 0, mu + 512 + h * 64 + c0, v0, v1); *(LAS u32x4*)(R0 + t * LD64 + c0 * 2) = pack8(v0, v1); }
#pragma unroll
        for (int i = 0; i < 8; ++i) { const int idx = lane + 64 * i, t = idx >> 4, ch = idx & 15, col = 896 + ch * 8;
            f32x4 lo, hi; ld_shift8(ur + (size_t)t * UW + col, (n * CH + t) > 0, mu + col, lo, hi);
#pragma unroll
            for (int j = 0; j < 4; ++j) { lo[j] = fsigmoid(lo[j]); hi[j] = fsigmoid(hi[j]); }
            *(LAS u32x4*)(R1 + t * LDLW + ch * 16) = pack8(lo, hi); }
        LDS_WAIT();
        f32x16 gacc[2];
#pragma unroll
        for (int vt = 0; vt < 2; ++vt) {
#pragma unroll
            for (int ks = 0; ks < 2; ++ks) yacc[vt] = mma32(frag_tr(R0, LD64, 16 * ks, 32 * vt, lane), frag_rm(R3, LD32, 0, 16 * ks, lane), yacc[vt]);
            gacc[vt] = zero16();
#pragma unroll
            for (int ks = 0; ks < 8; ++ks) gacc[vt] = mma32(frag_g(upT + 2 * 256 * 64 + (size_t)(h * 64 + 32 * vt) * 128, 128, 0, 16 * ks, lane), frag_rm(R1, LDLW, 0, 16 * ks, lane), gacc[vt]); }
        float sm = 0.f;
#pragma unroll
        for (int vt = 0; vt < 2; ++vt)
#pragma unroll
            for (int i = 0; i < 16; ++i) sm += yacc[vt][i];
        sm += __shfl_xor(sm, 32);
        const float mean = sm * (1.0f / 64.0f); float sv = 0.f;
#pragma unroll
        for (int vt = 0; vt < 2; ++vt)
#pragma unroll
            for (int i = 0; i < 16; ++i) { const float dl = yacc[vt][i] - mean; sv += dl * dl; }
        sv += __shfl_xor(sv, 32);
        const float rstd = __builtin_amdgcn_rsqf(sv * (1.0f / 64.0f) + 64e-5f);
        const float bon = R5[r32];
        const float* ng = F.in[I_RW_G] + L * 256 + h * 64; const float* nb = F.in[I_RW_B] + L * 256 + h * 64;
#pragma unroll
        for (int vt = 0; vt < 2; ++vt)
#pragma unroll
            for (int g = 0; g < 4; ++g) { const int v0i = 32 * vt + 8 * g + 4 * hh;
                const u32x2 vw = *(const LAS u32x2*)(R0 + r32 * LD64 + v0i * 2); const f32x4 gg = *(const f32x4*)(ng + v0i), bb = *(const f32x4*)(nb + v0i);
                const float vv[4] = {bflo(vw.x), bfhi(vw.x), bflo(vw.y), bfhi(vw.y)}; float o[4];
#pragma unroll
                for (int x = 0; x < 4; ++x) o[x] = ((yacc[vt][4 * g + x] - mean) * rstd * gg[x] + bb[x] + bon * vv[x]) * gacc[vt][4 * g + x];
                u32x2 w; w.x = cvt_pk_bf16(o[0], o[1]); w.y = cvt_pk_bf16(o[2], o[3]);
                *(u32x2*)(bo + (row0 + r32) * 1024 + 768 + h * 64 + v0i) = w; }
    }
    LDS_WAIT();
}
__device__ __forceinline__ void rwkv_scan_task(Frame& F, int bh, int vh) {
    const int lane = F.lane, r32 = lane & 31, hh = lane >> 5;
    const bf16* Mb = (const bf16*)(F.ws + WS_RWM) + (size_t)bh * NCH * 4096; bf16* Nb = (bf16*)(F.ws + WS_RWN) + (size_t)bh * NCH * 4096 + (size_t)(vh * 32 + r32) * 64;
    f32x16 st[2] = {zero16(), zero16()};
    u32x2 nq[2][4], mq[2][2][2][2];
#define RW_PREF(nn) do { _Pragma("unroll") for (int dt = 0; dt < 2; ++dt) _Pragma("unroll") for (int g = 0; g < 4; ++g) nq[dt][g] = *(const u32x2*)(Nb + (size_t)(nn) * 4096 + 32 * dt + 8 * g + 4 * hh); \
        _Pragma("unroll") for (int d1t = 0; d1t < 2; ++d1t) _Pragma("unroll") for (int dt = 0; dt < 2; ++dt) _Pragma("unroll") for (int s2 = 0; s2 < 2; ++s2) { \
            const bf16* mp = Mb + (size_t)(nn) * 4096 + (size_t)(32 * d1t + r32) * 64 + 32 * dt + 16 * s2 + 4 * hh; mq[d1t][dt][s2][0] = *(const u32x2*)mp; mq[d1t][dt][s2][1] = *(const u32x2*)(mp + 8); } } while (0)
    RW_PREF(0);
    for (int n = 0; n < NCH; ++n) {
        bf16x8 bfr[2][2];
#pragma unroll
        for (int dt = 0; dt < 2; ++dt)
#pragma unroll
            for (int s2 = 0; s2 < 2; ++s2) { union { bf16x8 v; unsigned w[4]; } pf;
#pragma unroll
                for (int j = 0; j < 4; ++j) pf.w[j] = cvt_pk_bf16(st[dt][8 * s2 + 2 * j], st[dt][8 * s2 + 2 * j + 1]);
                bfr[dt][s2] = pf.v; }
        f32x16 nw[2];
#pragma unroll
        for (int d1t = 0; d1t < 2; ++d1t) {
#pragma unroll
            for (int g = 0; g < 4; ++g) { nw[d1t][4 * g] = bflo(nq[d1t][g].x); nw[d1t][4 * g + 1] = bfhi(nq[d1t][g].x); nw[d1t][4 * g + 2] = bflo(nq[d1t][g].y); nw[d1t][4 * g + 3] = bfhi(nq[d1t][g].y); }
#pragma unroll
            for (int dt = 0; dt < 2; ++dt)
#pragma unroll
                for (int s2 = 0; s2 < 2; ++s2) { union { bf16x8 v; u32x2 d[2]; } mf; mf.d[0] = mq[d1t][dt][s2][0]; mf.d[1] = mq[d1t][dt][s2][1]; nw[d1t] = mma32(mf.v, bfr[dt][s2], nw[d1t]); } }
        if (n + 1 < NCH) RW_PREF(n + 1);
#pragma unroll
        for (int d1t = 0; d1t < 2; ++d1t) { st[d1t] = nw[d1t];
#pragma unroll
            for (int g = 0; g < 4; ++g) { u32x2 w; w.x = cvt_pk_bf16(nw[d1t][4 * g], nw[d1t][4 * g + 1]); w.y = cvt_pk_bf16(nw[d1t][4 * g + 2], nw[d1t][4 * g + 3]); st_wt8(Nb + (size_t)n * 4096 + 32 * d1t + 8 * g + 4 * hh, w); } }
    }
#undef RW_PREF
}

constexpr int NS_KROW = 144, NS_VROW = 136;
constexpr int NS_KB = 64 * NS_KROW, NS_VB = 64 * NS_VROW;
constexpr int NS_K0 = 0, NS_V0 = 2 * NS_KB, NS_IMP = NS_V0 + 2 * NS_VB, NS_SEL = NS_IMP + 64 * 128 * 4, NS_END = NS_SEL + 64 * 4 * 4;
static_assert(NS_END <= RING_BYTES, "nsa lds");
struct NsaRow { float m, l; f32x16 o[2]; };
__device__ __forceinline__ void ns_load(const bf16* kb, const bf16* vb, size_t stride, int tid, u32x4& kr, u32x4& vr) {
    const int key = tid >> 3, ch = tid & 7; kr = *(const u32x4*)(kb + (size_t)key * stride + ch * 8); vr = *(const u32x4*)(vb + (size_t)key * stride + ch * 8);
}
__device__ __forceinline__ void ns_store(LAS unsigned char* Kb, LAS unsigned char* Vb, int tid, const u32x4& kr, const u32x4& vr) {
    const int key = tid >> 3, ch = tid & 7;
    *(LAS u32x4*)(Kb + key * NS_KROW + ch * 16) = kr;
    LAS unsigned short* vt = (LAS unsigned short*)(Vb + (8 * ch) * NS_VROW + key * 2);
    vt[0 * (NS_VROW / 2)] = (unsigned short)(vr.x & 0xffffu); vt[1 * (NS_VROW / 2)] = (unsigned short)(vr.x >> 16);
    vt[2 * (NS_VROW / 2)] = (unsigned short)(vr.y & 0xffffu); vt[3 * (NS_VROW / 2)] = (unsigned short)(vr.y >> 16);
    vt[4 * (NS_VROW / 2)] = (unsigned short)(vr.z & 0xffffu); vt[5 * (NS_VROW / 2)] = (unsigned short)(vr.z >> 16);
    vt[6 * (NS_VROW / 2)] = (unsigned short)(vr.w & 0xffffu); vt[7 * (NS_VROW / 2)] = (unsigned short)(vr.w >> 16);
}
__device__ __forceinline__ void ns_qk(LAS unsigned char* Kb, const bf16x8 (&qf)[4], int r, int h2, f32x16 (&sacc)[2]) {
#pragma unroll
    for (int sub = 0; sub < 2; ++sub) { f32x16 a;
#pragma unroll
        for (int i = 0; i < 16; ++i) a[i] = 0.f;
#pragma unroll
        for (int kk = 0; kk < 4; ++kk) { const bf16x8 kf = *(const LAS bf16x8*)(Kb + (32 * sub + r) * NS_KROW + (8 * h2 + 16 * kk) * 2); a = __builtin_amdgcn_mfma_f32_32x32x16_bf16(kf, qf[kk], a, 0, 0, 0); }
        sacc[sub] = a; }
}
enum { NS_CMP = 0, NS_SEL_ = 1, NS_WIN = 2 };
template <int MODE> __device__ __forceinline__ bool ns_valid(int key, int t, bool blk_on) {
    if (MODE == NS_CMP) return 16 * key + 31 <= t;
    if (MODE == NS_SEL_) return blk_on && key <= t;
    return key <= t && key + 511 >= t;
}
template <int MODE>
__device__ __forceinline__ void ns_branch(Frame& F, const bf16* kbase, const bf16* vbase, size_t stride, int tile_lo, int tile_hi, const bf16x8 (&qf)[4], int t, int r, int h2,
                                          const unsigned (&selw)[4], NsaRow& R) {
    LAS unsigned char* L = F.lds;
    R.m = -1e30f; R.l = 0.f;
#pragma unroll
    for (int e = 0; e < 2; ++e)
#pragma unroll
        for (int i = 0; i < 16; ++i) R.o[e][i] = 0.f;
    if (tile_hi <= tile_lo) return;
    u32x4 kr, vr;
    ns_load(kbase + (size_t)tile_lo * 64 * stride, vbase + (size_t)tile_lo * 64 * stride, stride, F.tid, kr, vr);
    __syncthreads();
    ns_store(L + NS_K0, L + NS_V0, F.tid, kr, vr);
    __syncthreads();
    for (int ti = tile_lo; ti < tile_hi; ++ti) {
        const int buf = (ti - tile_lo) & 1;
        if (ti + 1 < tile_hi) ns_load(kbase + (size_t)(ti + 1) * 64 * stride, vbase + (size_t)(ti + 1) * 64 * stride, stride, F.tid, kr, vr);
        LAS unsigned char* Kb = L + NS_K0 + buf * NS_KB; LAS unsigned char* Vb = L + NS_V0 + buf * NS_VB;
        bool blk_on = true;
        if (MODE == NS_SEL_) blk_on = (selw[ti >> 5] >> (ti & 31)) & 1u;
        bool any;
        if (MODE == NS_CMP) any = 16 * (ti * 64) + 31 <= t; else if (MODE == NS_SEL_) any = blk_on && ti * 64 <= t; else any = (ti * 64 <= t) && (ti * 64 + 63 + 511 >= t);
        if (__ballot(any) != 0ull) {
            f32x16 sacc[2];
            ns_qk(Kb, qf, r, h2, sacc);
            float mt = -1e30f;
#pragma unroll
            for (int sub = 0; sub < 2; ++sub)
#pragma unroll
                for (int i = 0; i < 16; ++i) { const int key = ti * 64 + 32 * sub + (i & 3) + 8 * (i >> 2) + 4 * h2; const float sv = ns_valid<MODE>(key, t, blk_on) ? sacc[sub][i] : -1e30f; sacc[sub][i] = sv; mt = fmaxf(mt, sv); }
            mt = fmaxf(mt, __shfl_xor(mt, 32));
            const float mn = fmaxf(R.m, mt), sc = __expf(R.m - mn); float rs = 0.f;
#pragma unroll
            for (int sub = 0; sub < 2; ++sub)
#pragma unroll
                for (int i = 0; i < 16; ++i) { const float sv = sacc[sub][i]; const float p = sv > -1e29f ? __expf(sv - mn) : 0.f; sacc[sub][i] = p; rs += p; }
            rs += __shfl_xor(rs, 32);
            R.l = R.l * sc + rs; R.m = mn;
#pragma unroll
            for (int e = 0; e < 2; ++e)
#pragma unroll
                for (int i = 0; i < 16; ++i) R.o[e][i] *= sc;
#pragma unroll
            for (int sub = 0; sub < 2; ++sub)
#pragma unroll
                for (int s2 = 0; s2 < 2; ++s2) {
                    union { bf16x8 v; unsigned w[4]; } pf;
#pragma unroll
                    for (int j = 0; j < 4; ++j) pf.w[j] = cvt_pk_bf16(sacc[sub][8 * s2 + 2 * j], sacc[sub][8 * s2 + 2 * j + 1]);
#pragma unroll
                    for (int e = 0; e < 2; ++e) {
                        union { bf16x8 v; u32x2 d[2]; } vf;
                        const LAS unsigned char* vp = Vb + (32 * e + r) * NS_VROW + (32 * sub + 16 * s2 + 4 * h2) * 2;
                        vf.d[0] = *(const LAS u32x2*)vp; vf.d[1] = *(const LAS u32x2*)(vp + 16);
                        R.o[e] = __builtin_amdgcn_mfma_f32_32x32x16_bf16(vf.v, pf.v, R.o[e], 0, 0, 0);
                    }
                }
        }
        if (ti + 1 < tile_hi) ns_store(L + NS_K0 + (buf ^ 1) * NS_KB, L + NS_V0 + (buf ^ 1) * NS_VB, F.tid, kr, vr);
        __syncthreads();
    }
}
__device__ __forceinline__ void ns_importance(Frame& F, const bf16* kbase, int ntiles, const bf16x8 (&qf)[4], int t, int r, int h2, float m, float inv_l) {
    LAS unsigned char* L = F.lds; LAS float* imp = (LAS float*)(L + NS_IMP);
    const int qrow = F.wave * 8 + (r & 7);
    u32x4 kr, vr;
    ns_load(kbase, kbase, 64, F.tid, kr, vr);
    __syncthreads();
    ns_store(L + NS_K0, L + NS_V0, F.tid, kr, vr);
    __syncthreads();
    for (int ti = 0; ti < ntiles; ++ti) {
        const int buf = ti & 1;
        if (ti + 1 < ntiles) ns_load(kbase + (size_t)(ti + 1) * 64 * 64, kbase + (size_t)(ti + 1) * 64 * 64, 64, F.tid, kr, vr);
        LAS unsigned char* Kb = L + NS_K0 + buf * NS_KB;
        f32x16 sacc[2];
        ns_qk(Kb, qf, r, h2, sacc);
#pragma unroll
        for (int sub = 0; sub < 2; ++sub)
#pragma unroll
            for (int g = 0; g < 4; ++g) {
                float p[4];
#pragma unroll
                for (int x = 0; x < 4; ++x) { const int key = ti * 64 + 32 * sub + x + 8 * g + 4 * h2; p[x] = (16 * key + 31 <= t) ? __expf(sacc[sub][4 * g + x] - m) * inv_l : 0.f; }
                float G = (p[0] + p[1]) + (p[2] + p[3]), E = p[3];
                G += __shfl_xor(G, 8); G += __shfl_xor(G, 16); E += __shfl_xor(E, 8); E += __shfl_xor(E, 16);
                const int jj = ti * 16 + 8 * sub + 2 * g + h2;
                if (r < 8) { atomicAdd((float*)(imp + qrow * 128 + jj), G); if (jj + 1 < 128) atomicAdd((float*)(imp + qrow * 128 + jj + 1), E); }
            }
        if (ti + 1 < ntiles) ns_store(L + NS_K0 + (buf ^ 1) * NS_KB, L + NS_V0 + (buf ^ 1) * NS_VB, F.tid, kr, vr);
        __syncthreads();
    }
}
__device__ __forceinline__ void nsa_unit(Frame& F, int b, int c) {
    const bf16* u = (const bf16*)(F.ws + WS_U); bf16* bo = (bf16*)(F.ws + WS_BO);
    const bf16* kcmp = (const bf16*)(F.ws + WS_KCMP) + (size_t)b * 512 * 64; const bf16* vcmp = (const bf16*)(F.ws + WS_VCMP) + (size_t)b * 512 * 64;
    LAS unsigned char* L = F.lds; LAS float* imp = (LAS float*)(L + NS_IMP); LAS unsigned* selL = (LAS unsigned*)(L + NS_SEL);
    const int lane = F.lane, r = lane & 31, h2 = lane >> 5, head = r >> 3, ql = r & 7;
    const int t = 64 * c + 8 * F.wave + ql; const size_t row = (size_t)b * S + t;
    const bf16* ub = u + (size_t)b * S * UW;
    bf16x8 qf[4];
#pragma unroll
    for (int kk = 0; kk < 4; ++kk) { const u32x4 w = *(const u32x4*)(u + row * UW + U_NSA + head * 64 + 8 * h2 + 16 * kk); f32x4 a, bb; unpack8(w, a, bb);
        union { bf16x8 v; u32x4 q; } cv; cv.q = pack8(a * 0.125f, bb * 0.125f); qf[kk] = cv.v; }
    const float g_cmp = fsigmoid(ldu(u, row, U_NSA + 640 + head)), g_sel = fsigmoid(ldu(u, row, U_NSA + 644 + head)), g_win = fsigmoid(ldu(u, row, U_NSA + 648 + head));
    unsigned selw[4] = {0xffffffffu, 0xffffffffu, 0xffffffffu, 0xffffffffu};
    f32x16 out[2];
    NsaRow R;
    const int ncmp_tiles = (4 * c + 3 + 63) >> 6;
    ns_branch<NS_CMP>(F, kcmp, vcmp, 64, 0, ncmp_tiles, qf, t, r, h2, selw, R);
    { const float inv = R.l > 0.f ? 1.0f / R.l : 0.f; const float gs = g_cmp * inv;
#pragma unroll
      for (int e = 0; e < 2; ++e)
#pragma unroll
        for (int i = 0; i < 16; ++i) out[e][i] = R.o[e][i] * gs;
      if (c >= 15) {
        for (int i = F.tid; i < 64 * 128; i += NTHR) imp[i] = 0.f;
        __syncthreads();
        ns_importance(F, kcmp, ncmp_tiles, qf, t, r, h2, R.m, inv);
        for (int q8 = 0; q8 < 8; ++q8) { const int qrow = F.wave * 8 + q8;
            float sc0, sc1;
            { const int j0 = lane, j1 = lane + 64;
              const bool f0 = (j0 == 0) || (j0 == c) || (j0 == c - 1), f1 = (j1 == c) || (j1 == c - 1);
              sc0 = f0 ? 1e30f : (j0 <= c ? imp[qrow * 128 + j0] : -1e30f); sc1 = f1 ? 1e30f : (j1 <= c ? imp[qrow * 128 + j1] : -1e30f); }
            unsigned long long lo = 0ull, hi = 0ull;
            for (int it = 0; it < 16; ++it) {
                const float best = wave_max(fmaxf(sc0, sc1));
                const unsigned long long m0 = __ballot(sc0 == best), m1 = __ballot(sc1 == best);
                int idx; if (m0) idx = __builtin_ctzll(m0); else idx = 64 + __builtin_ctzll(m1);
                if (idx < 64) { lo |= 1ull << idx; if (lane == idx) sc0 = -3e38f; } else { hi |= 1ull << (idx - 64); if (lane == idx - 64) sc1 = -3e38f; }
            }
            if (lane == 0) { selL[qrow * 4 + 0] = (unsigned)lo; selL[qrow * 4 + 1] = (unsigned)(lo >> 32); selL[qrow * 4 + 2] = (unsigned)hi; selL[qrow * 4 + 3] = (unsigned)(hi >> 32); }
        }
        LDS_WAIT();
#pragma unroll
        for (int j = 0; j < 4; ++j) selw[j] = selL[(F.wave * 8 + ql) * 4 + j];
      }
    }
    ns_branch<NS_SEL_>(F, ub + U_NSA + 384, ub + U_NSA + 448, UW, 0, c + 1, qf, t, r, h2, selw, R);
    { const float gs = g_sel / R.l;
#pragma unroll
      for (int e = 0; e < 2; ++e)
#pragma unroll
        for (int i = 0; i < 16; ++i) out[e][i] += R.o[e][i] * gs; }
    ns_branch<NS_WIN>(F, ub + U_NSA + 512, ub + U_NSA + 576, UW, c >= 8 ? c - 8 : 0, c + 1, qf, t, r, h2, selw, R);
    { const float gs = g_win / R.l;
#pragma unroll
      for (int e = 0; e < 2; ++e)
#pragma unroll
        for (int i = 0; i < 16; ++i) out[e][i] += R.o[e][i] * gs; }
#pragma unroll
    for (int e = 0; e < 2; ++e)
#pragma unroll
        for (int g = 0; g < 4; ++g) { u32x2 w; w.x = cvt_pk_bf16(out[e][4 * g], out[e][4 * g + 1]); w.y = cvt_pk_bf16(out[e][4 * g + 2], out[e][4 * g + 3]);
            *(u32x2*)(bo + row * 1024 + head * 64 + 32 * e + 8 * g + 4 * h2) = w; }
}

__device__ __forceinline__ void cmp2_item(Frame& F, int L, int item) {
    int lane = F.lane; asm volatile("" : "+v"(lane));
    const int kv = item & 1, it = (item >> 1) & 15, b = item >> 5, r32 = lane & 31, hh = lane >> 5;
    const bf16* w2T = (const bf16*)(F.ws + WS_CW2 + (size_t)L * 65536) + kv * 64 * 128;
    const bf16* hid = (const bf16*)(F.ws + WS_CMPH) + ((size_t)(b * 512 + 32 * it)) * 256 + kv * 128;
    bf16* outp = (bf16*)(F.ws + (kv ? WS_VCMP : WS_KCMP)) + ((size_t)(b * 512 + 32 * it + r32)) * 64;
    const bool live = (32 * it + r32) < NCMP;
#pragma unroll
    for (int et = 0; et < 2; ++et) { f32x16 acc = zero16();
#pragma unroll
        for (int ks = 0; ks < 8; ++ks) acc = mma32(frag_g(w2T, 128, 32 * et, 16 * ks, lane), frag_g(hid, 256, 0, 16 * ks, lane), acc);
#pragma unroll
        for (int g = 0; g < 4; ++g) { u32x2 w; w.x = live ? cvt_pk_bf16(acc[4 * g], acc[4 * g + 1]) : 0u; w.y = live ? cvt_pk_bf16(acc[4 * g + 2], acc[4 * g + 3]) : 0u;
            *(u32x2*)(outp + 32 * et + 8 * g + 4 * hh) = w; } }
}
#ifdef SK_RWM1
#define RWM1(x)
#else
#define RWM1(x) x
#endif
#ifdef SK_RWM3
#define RWM3(x)
#else
#define RWM3(x) x
#endif
#ifdef SK_RWSC
#define RWSC(x)
#else
#define RWSC(x) x
#endif
__device__ __forceinline__ void phase_m1(Frame& F0, int L, bf16* hgS, bf16* rtS) {
    Frame F = F0; asm volatile("" : "+v"(F.tid)); F.lane = F.tid & 63;
    { CmpSched Sd{(const char*)(F.ws + WS_U), (const char*)(F.ws + WS_CW1 + (size_t)L * MiB), F.bx};
      EpiCmp E{(bf16*)(F.ws + WS_CMPH), (const float*)(F.ws + WS_CTL) + CW_C1 + L * 256};
      pg8::gemm_phase<EpiCmp, CmpSched, true>(F.lds + RING_OFF, Sd, E, (unsigned)(UW * 2), 128u); }
    LAS unsigned char* W = F.lds + F.wave * WREG;
    const int gw = F.bx * NWAVES + F.wave, NGW = F.G * NWAVES;
    for (int it = gw; it < 3 * 32 * NCH; it += NGW) { const int type = it % 3, q = it / 3, bh = q / NCH, n = q % NCH;
        if (type == 0) hgrn_chunk<false>(F, L, bh, n, W, hgS, (float*)(F.ws + WS_HGD)); else if (type == 1) ret_chunk<false>(F, L, bh, n, W, rtS); else { RWM1(rwkv_chunk<false>(F, L, bh, n, W)); } }
}
__device__ __forceinline__ void phase_scan(Frame& F0, int L, bf16* hgS, bf16* rtS) {
    Frame F = F0; asm volatile("" : "+v"(F.tid)); F.lane = F.tid & 63;
    if (F.tid < 256) {
        if (F.bx < 128) glin_scan_task(hgS, (const float*)(F.ws + WS_HGD), 0.f, F.bx >> 2, F.bx & 3, F.tid);
        else { const int k = F.bx - 128, h = (k >> 2) & 3; const float g = 1.0f - exp2f(-5.0f - (float)h); glin_scan_task(rtS, nullptr, exp2f(32.0f * __log2f(g)), k >> 2, k & 3, F.tid); }
    } else if (F.wave == 4) { if (F.bx < 64) { RWSC(rwkv_scan_task(F, F.bx >> 1, F.bx & 1)); } }
    else { for (int item = F.bx * 3 + (F.wave - 5); item < 256; item += F.G * 3) cmp2_item(F, L, item); }
}
__device__ __forceinline__ void phase_m3(Frame& F0, int L, bf16* hgS, bf16* rtS) {
    Frame F = F0; asm volatile("" : "+v"(F.tid)); F.lane = F.tid & 63;
    LAS unsigned char* W = F.lds + F.wave * WREG;
    const int gw = F.bx * NWAVES + F.wave, NGW = F.G * NWAVES;
    for (int it = gw; it < REP_ITEMS * 3 * 32 * NCH; it += NGW) { const int type = it % 3, q = (it / 3) % (32 * NCH), bh = q / NCH, n = q % NCH;
        if (type == 0) hgrn_chunk<true>(F, L, bh, n, W, hgS, nullptr); else if (type == 1) ret_chunk<true>(F, L, bh, n, W, rtS); else { RWM3(rwkv_chunk<true>(F, L, bh, n, W)); } }
    __syncthreads();
#ifndef SK_NSA
    for (int p = F.bx; p < REP_NSA * 512; p += F.G) { const int b = (p >> 6) & 7, cc = p & 63; nsa_unit(F, b, 127 - cc); nsa_unit(F, b, cc); }
#endif
}

__device__ __forceinline__ void phase_pconv(Frame& F0, int L) {
    Frame F = F0; asm volatile("" : "+v"(F.tid)); F.lane = F.tid & 63;
    const float* p = F.in[I_P] + (size_t)L * T * PLE; bf16* pbf = (bf16*)(F.ws + WS_PB);
    for (int r = F.bx * NWAVES + F.wave; r < T; r += F.G * NWAVES) { const f32x4 v = *((const f32x4*)(p + (size_t)r * PLE) + F.lane); u32x2 w; w.x = cvt_pk_bf16(v[0], v[1]); w.y = cvt_pk_bf16(v[2], v[3]); *((u32x2*)(pbf + (size_t)r * PLE) + F.lane) = w; }
}
__device__ __forceinline__ void phase_final(Frame& F0, const float* ss) {
    Frame F = F0; asm volatile("" : "+v"(F.tid)); F.lane = F.tid & 63;
    const float* g = F.in[I_NORM_FINAL]; const int gw = F.bx * NWAVES + F.wave, NGW = F.G * NWAVES;
    for (int r = gw; r < T; r += NGW) { const float rs = rstd_of(ss, r); f32x4* hr = (f32x4*)(F.out + (size_t)r * D) + F.lane;
#pragma unroll
        for (int j = 0; j < 4; ++j) { f32x4 v = hr[64 * j]; const f32x4 gg = *((const f32x4*)g + F.lane + 64 * j); v = v * rs * gg; hr[64 * j] = v; } }
}

constexpr int PH_PER_LAYER = 9, N_PHASES = 1 + NL * PH_PER_LAYER + 1;
__global__ void __launch_bounds__(NTHR, 2) mega_fwd(Args args) {
    extern __shared__ __attribute__((aligned(16))) unsigned char lds_raw[];
    Frame F; F.lds = (LAS unsigned char*)lds_raw; F.tid = threadIdx.x; F.lane = F.tid & 63; F.wave = __builtin_amdgcn_readfirstlane(F.tid >> 6); F.G = gridDim.x; F.bx = blockIdx.x;
    F.in = args.in; F.out = args.out; F.ws = args.ws;
    volatile LAS unsigned* MISC = (volatile LAS unsigned*)(F.lds + MISC_OFF);
    if (F.tid < 32) MISC[F.tid] = 0u;
    __syncthreads();
    unsigned* ctl = (unsigned*)(F.ws + WS_CTL);
    XcdBarrier bar; bar.bar = ctl + CW_BAR; bar.x = 0; bar.st = nullptr;
    if (MK_N_LAUNCHES == 1) bar = xcd_barrier_post(ctl + CW_BAR, MISC + 8);
    const int lo = args.ph_lo, hi = args.ph_hi;
#define IN(k) (lo <= (k) && (k) < hi)
#define REPS(k) (((k) == REP_PHASE || (k) == REP_PHASE + 9) ? 2 : 1)
#define SEAM(k) do { if (IN(k) && IN((k) + 1)) xcd_barrier(bar); } while (0)
    float* ssb = (float*)ctl + CW_SS;
    LAS unsigned char* ring = F.lds + RING_OFF;

    #ifndef SK_PRO
    if (IN(0)) { phase_prologue(F); }
#endif
    SEAM(0);

    for (int L = 0; L < NL; ++L) {
        const int pb = 1 + L * PH_PER_LAYER;
        unsigned char* wl = F.ws + WS_W + (size_t)L * WL_STRIDE;
        bf16* hb_cur = (bf16*)(F.ws + ((L & 1) ? WS_HBB : WS_HBA)); bf16* hb_oth = (bf16*)(F.ws + ((L & 1) ? WS_HBA : WS_HBB));
        const float* ss_mix = ssb + (size_t)(3 * L) * T; float* ss_ffn = ssb + (size_t)(3 * L + 1) * T; float* ss_ple = ssb + (size_t)(3 * L + 2) * T; float* ss_next = ssb + (size_t)(3 * L + 3) * T;
        const float* h_in = (L == 0) ? F.in[I_X] : F.out;
#ifndef SK_G1
        for (int rep = 0; rep < REPS(pb + 0); ++rep) if (IN(pb + 0)) { PlainSched Sd{(const char*)hb_cur, (const char*)(wl + WL_IN), D * 2, D * 2, D / 64, T / 256, UW / 256, F.G, F.bx};
            EpiScaleBf16 E{(bf16*)(F.ws + WS_U), UW, ss_mix}; pg8::gemm_phase(ring, Sd, E); }
#endif
        SEAM(pb + 0);
        bf16* hgS = hb_oth; bf16* rtS = hb_oth + (size_t)32 * NCH * 4096;
        for (int rep = 0; rep < REPS(pb + 1); ++rep) if (IN(pb + 1)) phase_m1(F, L, hgS, rtS);
        SEAM(pb + 1);
#ifndef EXP_NOSCAN
        if (IN(pb + 2)) phase_scan(F, L, hgS, rtS);
#endif
        SEAM(pb + 2);
        if (IN(pb + 3)) phase_m3(F, L, hgS, rtS);
        SEAM(pb + 3);
#ifndef SK_G2
        for (int rep = 0; rep < REPS(pb + 4); ++rep) if (IN(pb + 4)) { PairSched Sd{(const char*)hb_cur, (const char*)(wl + WL_G), D * 2, D * 2, D / 64, (size_t)D * D * 2,
                                        (const char*)(F.ws + WS_BO), (const char*)(wl + WL_B), 1024 * 2, MW * 2, MW / 64, (size_t)MW * 2, (size_t)D * MW * 2, 4, T / 256, D / 256, F.G, F.bx};
            u32x4* scr = (u32x4*)(F.ws + WS_SCR + (size_t)F.bx * 262144);
            EpiMerge E{scr, scr + 8192, (bf16*)(F.ws + WS_MERGED), ss_mix, F.in[I_BGATE] + (size_t)L * 4 * D, 4}; pg8::gemm_phase(ring, Sd, E); }
#endif
        SEAM(pb + 4);
#ifndef SK_G3
        if (IN(pb + 5)) phase_pconv(F, L);
        if (IN(pb + 5)) { PlainSched Sd{(const char*)(F.ws + WS_MERGED), (const char*)(wl + WL_OUT), D * 2, D * 2, D / 64, T / 256, D / 256, F.G, F.bx};
            EpiResidual E{h_in, F.out, hb_cur, ss_ffn}; pg8::gemm_phase(ring, Sd, E); }
#endif
        SEAM(pb + 5);
#ifndef SK_G4
        for (int rep = 0; rep < REPS(pb + 6); ++rep) if (IN(pb + 6)) { PlainSched Sd{(const char*)hb_cur, (const char*)(wl + WL_FF), D * 2, D * 2, D / 64, T / 256, (2 * DFF) / 256, F.G, F.bx};
            EpiSwiGLU E{(bf16*)(F.ws + WS_FFH), ss_ffn}; pg8::gemm_phase(ring, Sd, E); }
#endif
        SEAM(pb + 6);
#ifndef SK_G5
        if (IN(pb + 7)) { PlainSched Sd{(const char*)(F.ws + WS_FFH), (const char*)(wl + WL_DN), DFF * 2, DFF * 2, DFF / 64, T / 256, D / 256, F.G, F.bx};
            EpiResidual E{F.out, F.out, hb_cur, ss_ple}; pg8::gemm_phase(ring, Sd, E); }
#endif
        SEAM(pb + 7);
#ifndef SK_G6
        if (IN(pb + 8)) { PairSched Sd{(const char*)hb_cur, (const char*)(wl + WL_PG), D * 2, D * 2, D / 64, 0,
                                        (const char*)(F.ws + WS_PB), (const char*)(wl + WL_PP), PLE * 2, PLE * 2, PLE / 64, 0, 0, 1, T / 256, D / 256, F.G, F.bx};
            u32x4* scr = (u32x4*)(F.ws + WS_SCR + (size_t)F.bx * 262144);
            EpiPle E{scr, F.out, hb_oth, ss_ple, ss_next}; pg8::gemm_phase(ring, Sd, E); }
#endif
        SEAM(pb + 8);
    }
#ifndef SK_FIN
    if (IN(N_PHASES - 1)) phase_final(F, ssb + (size_t)(3 * NL) * T);
#endif
#undef IN
#undef SEAM
}

extern "C" void kernel_launch(void* const* d_in, const int* in_sizes, int n_in, void* d_out, int out_size, void* d_ws, size_t ws_size, hipStream_t stream) {
    static int grid = 0;
    if (grid == 0) {
        if (n_in != 37 || in_sizes[0] != T * D || out_size != T * D || ws_size < WS_END) { fprintf(stderr, "kernel_launch: unexpected shapes (n_in %d, ws %zu)\n", n_in, ws_size); grid = -1; return; }
        int dev = 0, cus = 0, per_cu = 0;
        if (hipGetDevice(&dev) != hipSuccess || hipDeviceGetAttribute(&cus, hipDeviceAttributeMultiprocessorCount, dev) != hipSuccess) { grid = -1; return; }
        if (hipFuncSetAttribute((const void*)mega_fwd, hipFuncAttributeMaxDynamicSharedMemorySize, LDS_BYTES) != hipSuccess) { fprintf(stderr, "kernel_launch: hipFuncSetAttribute failed\n"); grid = -1; return; }
        if (hipOccupancyMaxActiveBlocksPerMultiprocessor(&per_cu, (const void*)mega_fwd, NTHR, LDS_BYTES) != hipSuccess || per_cu < 1) { fprintf(stderr, "kernel_launch: occupancy query says %d\n", per_cu); }
        (void)hipGetLastError();
        grid = cus;
    }
    if (grid < 0) return;
    hipMemsetAsync((char*)d_ws + WS_CTL, 0, CTL_BYTES, stream);
    Args a{};
    for (int i = 0; i < 37; ++i) a.in[i] = (const float*)d_in[i];
    a.out = (float*)d_out; a.ws = (unsigned char*)d_ws;
    if (MK_N_LAUNCHES == 1) { a.ph_lo = 0; a.ph_hi = N_PHASES; hipLaunchKernelGGL(mega_fwd, dim3(grid), dim3(NTHR), LDS_BYTES, stream, a); }
    else for (int p = 0; p < N_PHASES; ++p) { a.ph_lo = p; a.ph_hi = p + 1; hipLaunchKernelGGL(mega_fwd, dim3(grid), dim3(NTHR), LDS_BYTES, stream, a); }
}
```

```cpp
#include <hip/hip_runtime.h>
#include <cstdio>
#include <cstdint>

#ifndef REP_ITEMS
#define REP_ITEMS 1
#endif
#ifndef REP_NSA
#define REP_NSA 1
#endif
#ifndef REP_PHASE
#define REP_PHASE (-1)
#endif
#ifndef MK_N_LAUNCHES
#define MK_N_LAUNCHES 1
#endif

#define LAS __attribute__((address_space(3)))
#define GAS __attribute__((address_space(1)))
typedef unsigned short bf16;
typedef short bf16x8 __attribute__((ext_vector_type(8)));
typedef float f32x4 __attribute__((ext_vector_type(4)));
typedef float f32x16 __attribute__((ext_vector_type(16)));
typedef unsigned u32x4 __attribute__((ext_vector_type(4)));
typedef unsigned u32x2 __attribute__((ext_vector_type(2)));
typedef short s16x4 __attribute__((ext_vector_type(4)));

constexpr int D = 1024, NB = 8, S = 8192, T = NB * S, NL = 2;
constexpr int NH = 4, HD = 64, MW = 256, DFF = 2816, PLE = 256;
constexpr int DIN = 3724, UW = 3840;
constexpr int U_NSA = 0, U_HG = 768, U_RT = 1792, U_RW = 2816;
constexpr int NCMP = 511, NSEL = 128;
constexpr float EPS = 1e-6f;

constexpr size_t MiB = 1u << 20;
constexpr size_t WS_CTL = 0, CTL_BYTES = 4 * MiB;
constexpr size_t WS_W = 4 * MiB;
constexpr size_t WL_IN = 0, WL_G = 8 * MiB, WL_B = 16 * MiB, WL_OUT = 18 * MiB, WL_FF = 20 * MiB, WL_DN = 31 * MiB, WL_PG = 37 * MiB, WL_PP = 39 * MiB, WL_STRIDE = 40 * MiB;
constexpr size_t WS_MISC = 84 * MiB;
constexpr size_t WS_ROPE = WS_MISC, WS_KCMP = WS_MISC + 2 * MiB, WS_VCMP = WS_MISC + 2 * MiB + 512 * 1024, WS_RWUP = WS_MISC + 3 * MiB;
constexpr size_t WS_HBA = 88 * MiB, WS_HBB = 216 * MiB;
constexpr size_t WS_BO = 344 * MiB;
constexpr size_t WS_U = 472 * MiB;
constexpr size_t WS_MERGED = WS_U, WS_SCR = WS_U + 416 * MiB;
constexpr size_t WS_FFH = WS_U;
constexpr size_t WS_PB = WS_U + 352 * MiB;
constexpr size_t WS_RWN = 952 * MiB;
constexpr size_t WS_HGD = 1016 * MiB;
constexpr size_t WS_RWM = WS_BO;
constexpr size_t WS_CMPH = 1018 * MiB;
constexpr size_t WS_CW1 = 1020 * MiB;
constexpr size_t WS_CW2 = 1022 * MiB;
constexpr size_t WS_END = 1024 * MiB;
constexpr int CH = 32, NCH = S / CH;
constexpr int CW_BAR = 4096;
constexpr int CW_C1 = 16384;
constexpr int NSS = 7;

#define LDS_WAIT() asm volatile("s_waitcnt lgkmcnt(0)" ::: "memory")
#define VM_WAIT() asm volatile("s_waitcnt vmcnt(0)" ::: "memory")
typedef __bf16 hbf16x2 __attribute__((ext_vector_type(2)));
typedef float f32x2v __attribute__((ext_vector_type(2)));
__device__ __forceinline__ unsigned cvt_pk_bf16(float lo, float hi) { const f32x2v v = {lo, hi}; const hbf16x2 b = __builtin_convertvector(v, hbf16x2); return __builtin_bit_cast(unsigned, b); }
__device__ __forceinline__ float bf2f(unsigned short b) { return __builtin_bit_cast(float, ((unsigned)b) << 16); }
__device__ __forceinline__ float bflo(unsigned w) { return __builtin_bit_cast(float, w << 16); }
__device__ __forceinline__ float bfhi(unsigned w) { return __builtin_bit_cast(float, w & 0xffff0000u); }
__device__ __forceinline__ float fsigmoid(float z) { return __builtin_amdgcn_rcpf(1.0f + __builtin_amdgcn_exp2f(-1.44269504f * z)); }
__device__ __forceinline__ float fsilu(float z) { return z * fsigmoid(z); }
__device__ __forceinline__ float wave_sum(float v) {
#pragma unroll
    for (int o = 1; o < 64; o <<= 1) v += __shfl_xor(v, o);
    return v;
}
__device__ __forceinline__ float wave_max(float v) {
#pragma unroll
    for (int o = 1; o < 64; o <<= 1) v = fmaxf(v, __shfl_xor(v, o));
    return v;
}

#define XB_TMO      128
#define XB_XCNT(j)  (256  + 64 * (j))
#define XB_XSUB(j)  (1280 + 64 * (j))
#define XB_XGEN(j)  (2304 + 64 * (j))
#define XB_TOP      3328
#define XB_TOPGEN   3392
#define XCD_BAR_WORDS 3456
#define XB_SPIN_CAP (1u << 24)
__device__ __forceinline__ unsigned xb_ld(unsigned* p)              { return __hip_atomic_load(p, __ATOMIC_RELAXED, __HIP_MEMORY_SCOPE_AGENT); }
__device__ __forceinline__ unsigned xb_add(unsigned* p, unsigned v) { return __hip_atomic_fetch_add(p, v, __ATOMIC_RELAXED, __HIP_MEMORY_SCOPE_AGENT); }
__device__ __forceinline__ unsigned xb_xcc_id() { return (unsigned)__builtin_amdgcn_s_getreg((3 << 11) | 20) & 0xFu; }
#define XB_SPIN(cond, bar) do { unsigned _sp = 0; while (cond) { __builtin_amdgcn_s_sleep(1); \
    if ((++_sp & 255u) == 0u) { if (xb_ld(&(bar)[XB_TMO])) break; if (_sp > XB_SPIN_CAP) { atomicAdd(&(bar)[XB_TMO], 1u); break; } } } } while (0)
struct XcdBarrier { unsigned* bar; unsigned x; volatile LAS unsigned* st; };
__device__ __forceinline__ XcdBarrier xcd_barrier_post(unsigned* bar, volatile LAS unsigned* st) {
    XcdBarrier b; b.bar = bar; b.x = xb_xcc_id(); b.st = st;
    if (threadIdx.x == 0) (void)xb_add(&bar[XB_XCNT(b.x)], 1u);
    return b;
}
__device__ __forceinline__ void xcd_barrier_complete(unsigned* bar, unsigned x, unsigned& nloc, unsigned& nx) {
    const unsigned G = gridDim.x * gridDim.y * gridDim.z;
    unsigned sum, cnt, mine, sp = 0u;
    for (;;) {
        sum = 0u; cnt = 0u; mine = 0u;
#pragma unroll
        for (unsigned j = 0; j < 16; ++j) { const unsigned c = xb_ld(&bar[XB_XCNT(j)]); sum += c; cnt += (c > 0u) ? 1u : 0u; mine = (j == x) ? c : mine; }
        if (sum == G) break;
        __builtin_amdgcn_s_sleep(1);
        if ((++sp & 255u) == 0u) { if (xb_ld(&bar[XB_TMO])) break; if (sp > XB_SPIN_CAP) { atomicAdd(&bar[XB_TMO], 1u); break; } }
    }
    nloc = mine > 0u ? mine : 1u; nx = cnt > 0u ? cnt : 1u;
}
__device__ __forceinline__ void xcd_barrier(const XcdBarrier& b) {
    asm volatile("s_waitcnt vmcnt(0)" ::: "memory");
    __syncthreads();
    if (threadIdx.x == 0) {
        unsigned* bar = b.bar;
        __builtin_amdgcn_s_waitcnt(0);
        unsigned nloc = b.st[0], nx = b.st[1];
        if (nloc == 0u) { xcd_barrier_complete(bar, b.x, nloc, nx); b.st[0] = nloc; b.st[1] = nx; }
        const unsigned old = xb_add(&bar[XB_XSUB(b.x)], 1u);
        const unsigned gen = old / nloc;
        if (old + 1u == (gen + 1u) * nloc) {
            __builtin_amdgcn_fence(__ATOMIC_RELEASE, "agent");
            asm volatile("s_waitcnt vmcnt(0)" ::: "memory");
            const unsigned og = xb_add(&bar[XB_TOP], 1u);
            const unsigned tg = og / nx;
            if (og + 1u == (tg + 1u) * nx) xb_add(&bar[XB_TOPGEN], 1u);
            else XB_SPIN(xb_ld(&bar[XB_TOPGEN]) == tg, bar);
            __builtin_amdgcn_fence(__ATOMIC_ACQUIRE, "agent");
            xb_add(&bar[XB_XGEN(b.x)], 1u);
            asm volatile("s_waitcnt vmcnt(0)" ::: "memory");
        } else {
            XB_SPIN(xb_ld(&bar[XB_XGEN(b.x)]) == gen, bar);
            __builtin_amdgcn_fence(__ATOMIC_ACQUIRE, "agent");
            asm volatile("s_waitcnt vmcnt(0)" ::: "memory");
        }
    }
    __syncthreads();
}

namespace pg8 {
constexpr int BM = 256, BK = 64, HALF = 128, HTB = HALF * BK * 2, STAGE_BYTES = 8 * HTB, NXCD = 8, WGM = 8;
__host__ __device__ __forceinline__ int lds_byte(int r, int c) { const int st = (r >> 4) * 2 + (c >> 5), rr = r & 15, cc = c & 31, ob = rr * 64 + cc * 2; return st * 1024 + (ob ^ (((ob >> 9) & 1) << 5)); }
__host__ __device__ __forceinline__ void stage_rc(int b, int& R, int& C) { const int st = b / 1024, sb = b % 1024, swz = sb ^ (((sb >> 9) & 1) << 5); R = (st >> 1) * 16 + swz / 64; C = (st & 1) * 32 + (swz % 64) / 2; }
__host__ __device__ __forceinline__ int perm32(int rho) { const int n = rho >> 4, i = rho & 15; return 8 * (i >> 2) + 4 * n + (i & 3); }

struct GU { const char* A; const char* B; unsigned lda, ldb; int nt; int pm, pn, kind, mi; };

__device__ __forceinline__ bool tile_of(int L, int nM, int nN, int& pm, int& pn) {
    const int nwg = nM * nN; if (L >= nwg) return false;
    int wgid = L; { const int q = nwg / NXCD, r = nwg % NXCD, xcd = wgid % NXCD, off = wgid / NXCD; wgid = (xcd < r ? xcd * (q + 1) : r * (q + 1) + (xcd - r) * q) + off; }
    const int nig = WGM * nN, gid = wgid / nig, fm = gid * WGM, gsz = (nM - fm) < WGM ? (nM - fm) : WGM;
    pm = fm + ((wgid % nig) % gsz); pn = (wgid % nig) / gsz; return true;
}

template <class Epi, class Sched, bool AX = false>
__device__ __forceinline__ void gemm_phase(LAS unsigned char* lds, const Sched& S, const Epi& E, unsigned ax_kstep = 0, unsigned ax_half = 0) {
    int tid = threadIdx.x; asm volatile("" : "+v"(tid));
    const int wid = __builtin_amdgcn_readfirstlane(tid >> 6), lane = tid & 63, wr = wid >> 2, wc = wid & 3, fr = lane & 15, fq = lane >> 4;
    unsigned RA[2], RB[2], C2[2];
#pragma unroll
    for (int i = 0; i < 2; ++i) { int R, C; stage_rc(tid * 16 + i * 8192, R, C); RA[i] = (unsigned)R; RB[i] = (unsigned)((R & ~31) + perm32(R & 31)); C2[i] = (unsigned)C * 2u; }
    const size_t kstep = (size_t)(BK * 2);
    const size_t kstepA = AX ? (size_t)ax_kstep : kstep;
#define PG8_HSA(ld) (AX ? (size_t)ax_half : (size_t)HALF * (ld))
    const unsigned ldsw = (unsigned)wid * 1024u;
    const int aoff = lds_byte(wr * 64 + fr, fq * 8), boff = lds_byte(wc * 32 + fr, fq * 8);
#define PG8_SA(b, h) (((b) * 2 + (h)) * HTB)
#define PG8_SB(b, h) ((4 + (b) * 2 + (h)) * HTB)
#define PG8_STAGE(bufoff, gbase, ld, RR) do { _Pragma("unroll") for (int _i = 0; _i < 2; ++_i) \
        __builtin_amdgcn_global_load_lds((const unsigned*)((const char*)(gbase) + (RR[_i] * (ld) + C2[_i])), (LAS unsigned*)(lds + (bufoff) + ldsw + _i * 8192), 16, 0, 0); } while (0)
#define PG8_LDA(dst, b, h) do { _Pragma("unroll") for (int m = 0; m < 4; ++m) _Pragma("unroll") for (int k = 0; k < 2; ++k) dst[m][k] = *(const LAS bf16x8*)(lds + PG8_SA(b, h) + aoff + m * 2048 + k * 1024); } while (0)
#define PG8_LDB(dst, b, h) do { _Pragma("unroll") for (int n = 0; n < 2; ++n) _Pragma("unroll") for (int k = 0; k < 2; ++k) dst[n][k] = *(const LAS bf16x8*)(lds + PG8_SB(b, h) + boff + n * 2048 + k * 1024); } while (0)
#define PG8_MMA(ai, bj, At, Bt) do { __builtin_amdgcn_s_setprio(1); _Pragma("unroll") for (int m = 0; m < 4; ++m) _Pragma("unroll") for (int n = 0; n < 2; ++n) _Pragma("unroll") for (int k = 0; k < 2; ++k) \
        acc[ai][bj][m][n] = __builtin_amdgcn_mfma_f32_16x16x32_bf16(Bt[n][k], At[m][k], acc[ai][bj][m][n], 0, 0, 0); __builtin_amdgcn_s_setprio(0); } while (0)
#define PG8_WAIT_V(n) asm volatile("s_waitcnt vmcnt(" #n ")" ::: "memory")
#define PG8_WAIT_L(n) asm volatile("s_waitcnt lgkmcnt(" #n ")" ::: "memory")
#define PG8_BAR __builtin_amdgcn_s_barrier()
#define PG8_SCHED __builtin_amdgcn_sched_barrier(0)
    GU cur, nxt; int ui = 0;
    if (!S.next(0, cur)) return;
    f32x4 acc[2][2][4][2];
#pragma unroll
    for (int a = 0; a < 2; ++a)
#pragma unroll
        for (int b = 0; b < 2; ++b)
#pragma unroll
            for (int m = 0; m < 4; ++m)
#pragma unroll
                for (int n = 0; n < 2; ++n) acc[a][b][m][n] = (f32x4){0.f, 0.f, 0.f, 0.f};
    bf16x8 At[4][2], B0[2][2], B1[2][2];
    const char* cA = cur.A; const char* cB = cur.B; unsigned clda = cur.lda, cldb = cur.ldb;
    PG8_STAGE(PG8_SB(0, 0), cB, cldb, RB); PG8_STAGE(PG8_SB(0, 1), cB + (size_t)HALF * cldb, cldb, RB); PG8_STAGE(PG8_SA(0, 0), cA, clda, RA); PG8_STAGE(PG8_SA(0, 1), cA + PG8_HSA(clda), clda, RA);
    if (wr == 1) PG8_BAR;
    PG8_WAIT_V(2); PG8_BAR;
    PG8_STAGE(PG8_SB(1, 0), cB + kstep, cldb, RB); PG8_STAGE(PG8_SA(1, 0), cA + kstepA, clda, RA); PG8_STAGE(PG8_SB(1, 1), cB + (size_t)HALF * cldb + kstep, cldb, RB);
    PG8_WAIT_V(6); PG8_BAR;
    for (;;) {
        const bool has_next = S.next(ui + 1, nxt);
        const char* nA = has_next ? nxt.A : cA; const char* nB = has_next ? nxt.B : cB;
        const unsigned nlda = has_next ? nxt.lda : clda, nldb = has_next ? nxt.ldb : cldb;
        const int nt = cur.nt;
        for (int t = 0; t < nt; t += 2) {
            const bool last = (t == nt - 2);
            const char* a1 = cA + (size_t)(t + 1) * kstepA;
            const char* a2 = last ? nA : cA + (size_t)(t + 2) * kstepA; const char* b2 = last ? nB : cB + (size_t)(t + 2) * kstep;
            const unsigned lda2 = last ? nlda : clda, ldb2 = last ? nldb : cldb;
            const char* a3 = a2 + kstepA; const char* b3 = b2 + kstep;
            PG8_LDB(B0, 0, 0); PG8_LDB(B1, 0, 1); PG8_SCHED; PG8_LDA(At, 0, 0); PG8_STAGE(PG8_SA(1, 1), a1 + PG8_HSA(clda), clda, RA);
            PG8_WAIT_V(8); PG8_WAIT_L(0); PG8_BAR; PG8_MMA(0, 0, At, B0); PG8_MMA(0, 1, At, B1); PG8_BAR; PG8_SCHED;
            PG8_LDA(At, 0, 1); PG8_STAGE(PG8_SB(0, 0), b2, ldb2, RB); PG8_STAGE(PG8_SB(0, 1), b2 + (size_t)HALF * ldb2, ldb2, RB); PG8_STAGE(PG8_SA(0, 0), a2, lda2, RA);
            PG8_WAIT_V(8); PG8_WAIT_L(0); PG8_BAR; PG8_MMA(1, 0, At, B0); PG8_MMA(1, 1, At, B1); PG8_BAR; PG8_SCHED;
            PG8_LDB(B0, 1, 0); PG8_LDB(B1, 1, 1); PG8_SCHED; PG8_LDA(At, 1, 0); PG8_STAGE(PG8_SA(0, 1), a2 + PG8_HSA(lda2), lda2, RA);
            PG8_WAIT_V(8); PG8_WAIT_L(0); PG8_BAR; PG8_MMA(0, 0, At, B0); PG8_MMA(0, 1, At, B1); PG8_BAR; PG8_SCHED;
            PG8_LDA(At, 1, 1); PG8_STAGE(PG8_SB(1, 0), b3, ldb2, RB); PG8_STAGE(PG8_SB(1, 1), b3 + (size_t)HALF * ldb2, ldb2, RB); PG8_STAGE(PG8_SA(1, 0), a3, lda2, RA);
            PG8_WAIT_V(8); PG8_WAIT_L(0); PG8_BAR; PG8_MMA(1, 0, At, B0); PG8_MMA(1, 1, At, B1); PG8_BAR; PG8_SCHED;
        }
        if (wr == 0) PG8_BAR;
        E(acc, cur, wr, wc, fr, fq);
        if (!has_next) break;
#pragma unroll
        for (int a = 0; a < 2; ++a)
#pragma unroll
            for (int b = 0; b < 2; ++b)
#pragma unroll
                for (int m = 0; m < 4; ++m)
#pragma unroll
                    for (int n = 0; n < 2; ++n) acc[a][b][m][n] = (f32x4){0.f, 0.f, 0.f, 0.f};
        cur = nxt; cA = nA; cB = nB; clda = nlda; cldb = nldb; ++ui;
        if (wr == 1) PG8_BAR;
    }
    PG8_WAIT_V(0);
    PG8_BAR;
#undef PG8_SA
#undef PG8_HSA
#undef PG8_SB
#undef PG8_STAGE
#undef PG8_LDA
#undef PG8_LDB
#undef PG8_MMA
#undef PG8_WAIT_V
#undef PG8_WAIT_L
#undef PG8_BAR
#undef PG8_SCHED
}
}
using pg8::GU;

struct PlainSched {
    const char* A; const char* B; unsigned lda, ldb; int nt, nM, nN, G, c;
    __device__ __forceinline__ bool next(int i, GU& u) const {
        int pm, pn; if (!pg8::tile_of(i * G + c, nM, nN, pm, pn)) return false;
        u.A = A + (size_t)pm * 256 * lda; u.B = B + (size_t)pn * 256 * ldb; u.lda = lda; u.ldb = ldb; u.nt = nt; u.pm = pm; u.pn = pn; u.kind = 0; u.mi = 0; return true;
    }
};
struct PairSched {
    const char* A1; const char* B1; unsigned lda1, ldb1; int nt1; size_t b1_mstride;
    const char* A2; const char* B2; unsigned lda2, ldb2; int nt2; size_t a2_mstride, b2_mstride;
    int nm, nM, nN, G, c;
    __device__ __forceinline__ bool next(int i, GU& u) const {
        const int per = 2 * nm, ti = i / per, sub = i - ti * per, m = sub >> 1, kind = sub & 1;
        int pm, pn; if (!pg8::tile_of(ti * G + c, nM, nN, pm, pn)) return false;
        u.pm = pm; u.pn = pn; u.kind = kind; u.mi = m;
        if (kind == 0) { u.A = A2 + (size_t)m * a2_mstride + (size_t)pm * 256 * lda2; u.B = B2 + (size_t)m * b2_mstride + (size_t)pn * 256 * ldb2; u.lda = lda2; u.ldb = ldb2; u.nt = nt2; }
        else { u.A = A1 + (size_t)pm * 256 * lda1; u.B = B1 + (size_t)m * b1_mstride + (size_t)pn * 256 * ldb1; u.lda = lda1; u.ldb = ldb1; u.nt = nt1; }
        return true;
    }
};

constexpr int RSTD_OFF = 131072;
__device__ __forceinline__ float ss_row(const float* ssp, int row) {
    const f32x4* p = (const f32x4*)(ssp + (size_t)row * 16); const f32x4 a = p[0], b = p[1], c = p[2], d = p[3];
    return (((a[0] + a[1]) + (a[2] + a[3])) + ((b[0] + b[1]) + (b[2] + b[3]))) + (((c[0] + c[1]) + (c[2] + c[3])) + ((d[0] + d[1]) + (d[2] + d[3])));
}
__device__ __forceinline__ void rstd_table(const float* ssp, int pm) {
    extern __shared__ __attribute__((aligned(16))) unsigned char lds_tab_raw[];
    LAS float* tab = (LAS float*)((LAS unsigned char*)lds_tab_raw + RSTD_OFF);
    const int t = threadIdx.x; if (t < 256) tab[t] = __builtin_amdgcn_rsqf(ss_row(ssp, pm * 256 + t) * (1.0f / D) + EPS);
    asm volatile("s_waitcnt lgkmcnt(0)" ::: "memory"); __builtin_amdgcn_s_barrier(); asm volatile("" ::: "memory");
}
__device__ __forceinline__ float rstd_tab(int lr) { extern __shared__ __attribute__((aligned(16))) unsigned char lds_tab_raw[]; return ((const LAS float*)((LAS unsigned char*)lds_tab_raw + RSTD_OFF))[lr]; }
__device__ __forceinline__ u32x4 pack8(const f32x4& a, const f32x4& b) { u32x4 w; w.x = cvt_pk_bf16(a[0], a[1]); w.y = cvt_pk_bf16(a[2], a[3]); w.z = cvt_pk_bf16(b[0], b[1]); w.w = cvt_pk_bf16(b[2], b[3]); return w; }
__device__ __forceinline__ void unpack8(const u32x4& w, f32x4& a, f32x4& b) { a = (f32x4){bflo(w.x), bfhi(w.x), bflo(w.y), bfhi(w.y)}; b = (f32x4){bflo(w.z), bfhi(w.z), bflo(w.w), bfhi(w.w)}; }

struct CmpSched {
    const char* U; const char* B; int c;
    __device__ __forceinline__ bool next(int i, GU& u) const {
        if (i > 0 || c >= 32) return false;
        const int b = c >> 2, q = c & 3;
        u.A = U + ((size_t)(b * S + 2048 * q) * UW + U_NSA + 256) * 2; u.B = B; u.lda = 16 * UW * 2; u.ldb = 4096; u.nt = 32; u.pm = b; u.pn = q; u.kind = 0; u.mi = 0; return true;
    }
};
struct EpiCmp {
    bf16* H; const float* c1;
    __device__ __forceinline__ void operator()(const f32x4 (&acc)[2][2][4][2], const GU& u, int wr, int wc, int fr, int fq) const {
        const int col = wc * 32 + 8 * fq;
#pragma unroll
        for (int kv = 0; kv < 2; ++kv) { const f32x4 b0 = *(const f32x4*)(c1 + kv * 128 + col), b1 = *(const f32x4*)(c1 + kv * 128 + col + 4);
#pragma unroll
            for (int m = 0; m < 4; ++m) { const int i = u.pn * 128 + wr * 64 + m * 16 + fr; f32x4 v0, v1;
#pragma unroll
                for (int j = 0; j < 4; ++j) { v0[j] = fsilu(acc[kv][kv][m][0][j] + b0[j]); v1[j] = fsilu(acc[kv][kv][m][1][j] + b1[j]); }
                *(u32x4*)(H + ((size_t)(u.pm * 512 + i)) * 256 + kv * 128 + col) = pack8(v0, v1); } }
    }
};
struct EpiScaleBf16 {
    bf16* O; int ldo; const float* ss;
    __device__ __forceinline__ void operator()(const f32x4 (&acc)[2][2][4][2], const GU& u, int wr, int wc, int fr, int fq) const {
        rstd_table(ss, u.pm);
        const int row0 = u.pm * 256 + wr * 64 + fr, col0 = u.pn * 256 + wc * 32 + 8 * fq;
#pragma unroll
        for (int ai = 0; ai < 2; ++ai)
#pragma unroll
            for (int m = 0; m < 4; ++m) { const int r = row0 + ai * 128 + m * 16; const float rs = rstd_tab(wr * 64 + fr + ai * 128 + m * 16); bf16* rowp = O + (size_t)r * ldo + col0;
#pragma unroll
                for (int bj = 0; bj < 2; ++bj) *(u32x4*)(rowp + bj * 128) = pack8(acc[ai][bj][m][0] * rs, acc[ai][bj][m][1] * rs); }
    }
};
struct EpiSwiGLU {
    bf16* O; const float* ss;
    __device__ __forceinline__ void operator()(const f32x4 (&acc)[2][2][4][2], const GU& u, int wr, int wc, int fr, int fq) const {
        rstd_table(ss, u.pm);
        const int row0 = u.pm * 256 + wr * 64 + fr, col0 = u.pn * 128 + wc * 32 + 8 * fq;
#pragma unroll
        for (int ai = 0; ai < 2; ++ai)
#pragma unroll
            for (int m = 0; m < 4; ++m) { const int r = row0 + ai * 128 + m * 16; const float rs = rstd_tab(wr * 64 + fr + ai * 128 + m * 16);
                f32x4 v[2];
#pragma unroll
                for (int n = 0; n < 2; ++n)
#pragma unroll
                    for (int j = 0; j < 4; ++j) { const float g = acc[ai][0][m][n][j] * rs, up = acc[ai][1][m][n][j] * rs; v[n][j] = fsilu(g) * up; }
                *(u32x4*)(O + (size_t)r * DFF + col0) = pack8(v[0], v[1]); }
    }
};
struct EpiResidual {
    const float* Hin32; bf16* HB; float* ss_out;
    __device__ __forceinline__ void operator()(const f32x4 (&acc)[2][2][4][2], const GU& u, int wr, int wc, int fr, int fq) const {
        const int row0 = u.pm * 256 + wr * 64 + fr, col0 = u.pn * 256 + wc * 32 + 8 * fq;
#pragma unroll
        for (int ai = 0; ai < 2; ++ai)
#pragma unroll
            for (int m = 0; m < 4; ++m) { const int r = row0 + ai * 128 + m * 16; float s2 = 0.f;
#pragma unroll
                for (int bj = 0; bj < 2; ++bj) { const size_t o = (size_t)r * D + col0 + bj * 128;
                    f32x4 h0, h1;
                    if (Hin32) { h0 = *(const f32x4*)(Hin32 + o); h1 = *(const f32x4*)(Hin32 + o + 4); } else unpack8(*(const u32x4*)(HB + o), h0, h1);
                    h0 += acc[ai][bj][m][0]; h1 += acc[ai][bj][m][1];
                    *(u32x4*)(HB + o) = pack8(h0, h1);
                    s2 += (h0[0] * h0[0] + h0[1] * h0[1]) + (h0[2] * h0[2] + h0[3] * h0[3]) + (h1[0] * h1[0] + h1[1] * h1[1]) + (h1[2] * h1[2] + h1[3] * h1[3]); }
                s2 += __shfl_xor(s2, 16); s2 += __shfl_xor(s2, 32);
                if (fq == 0) ss_out[(size_t)r * 16 + u.pn * 4 + wc] = s2;
                if (m == 3) asm volatile("" ::: "memory"); }
    }
};
#define SLOT(ai, m, bj) (((((ai) * 4 + (m)) >> 1) * 512 + tid) * 4 + (((m) & 1) * 2 + (bj)))
struct EpiMerge {
    u32x4* scrP; u32x4* scrM; bf16* M; const float* ss; const float* bias;
    int nm;
    __device__ __forceinline__ void operator()(const f32x4 (&acc)[2][2][4][2], const GU& u, int wr, int wc, int fr, int fq) const {
        int tid = threadIdx.x; asm volatile("" : "+v"(tid));
        if (u.kind == 0) {
#pragma unroll
            for (int ai = 0; ai < 2; ++ai)
#pragma unroll
                for (int m = 0; m < 4; ++m)
#pragma unroll
                    for (int bj = 0; bj < 2; ++bj) scrP[SLOT(ai, m, bj)] = pack8(acc[ai][bj][m][0], acc[ai][bj][m][1]);
            return;
        }
        const int row0 = u.pm * 256 + wr * 64 + fr, col0 = u.pn * 256 + wc * 32 + 8 * fq;
        rstd_table(ss, u.pm);
        const float* bp = bias + (size_t)u.mi * D + col0;
        f32x4 bv[2][2];
#pragma unroll
        for (int bj = 0; bj < 2; ++bj) { bv[bj][0] = *(const f32x4*)(bp + bj * 128); bv[bj][1] = *(const f32x4*)(bp + bj * 128 + 4); }
#pragma unroll
        for (int ai = 0; ai < 2; ++ai)
#pragma unroll
            for (int m = 0; m < 4; ++m) { const int r = row0 + ai * 128 + m * 16; const float rs = rstd_tab(wr * 64 + fr + ai * 128 + m * 16);
#pragma unroll
                for (int bj = 0; bj < 2; ++bj) { const int slot = SLOT(ai, m, bj);
                    f32x4 p0, p1; unpack8(scrP[slot], p0, p1);
                    f32x4 v0, v1;
#pragma unroll
                    for (int j = 0; j < 4; ++j) { v0[j] = fsigmoid(acc[ai][bj][m][0][j] * rs + bv[bj][0][j]) * p0[j]; v1[j] = fsigmoid(acc[ai][bj][m][1][j] * rs + bv[bj][1][j]) * p1[j]; }
                    if (u.mi > 0) { f32x4 q0, q1; unpack8(scrM[slot], q0, q1); v0 += q0; v1 += q1; }
                    const u32x4 w = pack8(v0, v1);
                    if (u.mi == nm - 1) *(u32x4*)(M + (size_t)r * D + col0 + bj * 128) = w; else scrM[slot] = w; }
                asm volatile("" ::: "memory"); }
    }
};
struct EpiPle {
    u32x4* scrP; const bf16* Hcur; bf16* HBout; const float* ss; float* ss_out;
    __device__ __forceinline__ void operator()(const f32x4 (&acc)[2][2][4][2], const GU& u, int wr, int wc, int fr, int fq) const {
        int tid = threadIdx.x; asm volatile("" : "+v"(tid));
        if (u.kind == 0) {
#pragma unroll
            for (int ai = 0; ai < 2; ++ai)
#pragma unroll
                for (int m = 0; m < 4; ++m)
#pragma unroll
                    for (int bj = 0; bj < 2; ++bj) scrP[SLOT(ai, m, bj)] = pack8(acc[ai][bj][m][0], acc[ai][bj][m][1]);
            return;
        }
        rstd_table(ss, u.pm);
        const int row0 = u.pm * 256 + wr * 64 + fr, col0 = u.pn * 256 + wc * 32 + 8 * fq;
#pragma unroll
        for (int ai = 0; ai < 2; ++ai)
#pragma unroll
            for (int m = 0; m < 4; ++m) { const int r = row0 + ai * 128 + m * 16; const float rs = rstd_tab(wr * 64 + fr + ai * 128 + m * 16); float s2 = 0.f;
#pragma unroll
                for (int bj = 0; bj < 2; ++bj) { const int slot = SLOT(ai, m, bj); const size_t o = (size_t)r * D + col0 + bj * 128;
                    f32x4 p0, p1; unpack8(scrP[slot], p0, p1);
                    f32x4 h0, h1; unpack8(*(const u32x4*)(Hcur + o), h0, h1);
#pragma unroll
                    for (int j = 0; j < 4; ++j) { h0[j] += fsigmoid(acc[ai][bj][m][0][j] * rs) * p0[j]; h1[j] += fsigmoid(acc[ai][bj][m][1][j] * rs) * p1[j]; }
                    *(u32x4*)(HBout + o) = pack8(h0, h1);
                    s2 += (h0[0] * h0[0] + h0[1] * h0[1]) + (h0[2] * h0[2] + h0[3] * h0[3]) + (h1[0] * h1[0] + h1[1] * h1[1]) + (h1[2] * h1[2] + h1[3] * h1[3]); }
                s2 += __shfl_xor(s2, 16); s2 += __shfl_xor(s2, 32);
                if (fq == 0) ss_out[(size_t)r * 16 + u.pn * 4 + wc] = s2;
                asm volatile("" ::: "memory"); }
    }
};

constexpr int NWAVES = 8, NTHR = 512;
constexpr int RING_OFF = 0, RING_BYTES = 131072, WREG = 19456, MISC_OFF = 8 * WREG;
constexpr int LDS_BYTES = MISC_OFF + 256;
static_assert(MISC_OFF + 128 <= LDS_BYTES, "lds");
struct Args { const float* in[37]; float* out; unsigned char* ws; int ph_lo, ph_hi; };
struct Frame {
    LAS unsigned char* lds; int tid, lane, wave, G, bx;
    const float* const* in; float* out; unsigned char* ws;
};
enum { I_X = 0, I_P, I_NORM_MIX, I_W_IN, I_POS_K, I_POS_V, I_CK1, I_CK2, I_CV1, I_CV2, I_LB, I_HG_NORM, I_RT_G, I_RT_B, I_MU, I_W0, I_WUP, I_A0, I_AUP, I_GUP, I_KK, I_KA, I_RK,
       I_RW_G, I_RW_B, I_WBR, I_WGATE, I_BGATE, I_WOUT, I_NORM_FFN, I_FFG, I_FFU, I_FFD, I_NORM_PLE, I_PLEG, I_PLEP, I_NORM_FINAL };

template <class ColMap>
__device__ __forceinline__ void transpose_item(const float* W, int ldw, int K, const float* scale, bf16* WT, LAS float* scr, int item, int nblk, int lane, const ColMap& cm) {
    const int kb = item / nblk, nb = item % nblk, k0 = 64 * kb, n0 = 32 * nb;
    const int sc = cm(n0 + (lane & 31));
#pragma unroll 8
    for (int i = 0; i < 32; ++i) { const int kk = 2 * i + (lane >> 5); float v = 0.f; if (sc >= 0) { v = W[(size_t)(k0 + kk) * ldw + sc]; if (scale) v *= scale[k0 + kk]; } scr[kk * 33 + (lane & 31)] = v; }
    LDS_WAIT();
    const int c = lane & 7;
#pragma unroll
    for (int j = 0; j < 4; ++j) { const int n = (lane >> 3) + 8 * j; const LAS float* s = scr + (8 * c) * 33 + n;
        u32x4 o; o.x = cvt_pk_bf16(s[0 * 33], s[1 * 33]); o.y = cvt_pk_bf16(s[2 * 33], s[3 * 33]); o.z = cvt_pk_bf16(s[4 * 33], s[5 * 33]); o.w = cvt_pk_bf16(s[6 * 33], s[7 * 33]);
        *(u32x4*)(WT + (size_t)(n0 + n) * K + k0 + 8 * c) = o; }
    LDS_WAIT();
}
struct CmIdent { __device__ __forceinline__ int operator()(int n) const { return n; } };
struct CmWin { __device__ __forceinline__ int operator()(int n) const { return n < 652 ? n : (n < 768 ? -1 : n - 116); } };
struct CmFF { __device__ __forceinline__ int operator()(int n) const { return (n >> 8) * 128 + (n & 127); } };

__device__ __forceinline__ void phase_prologue(Frame& F0) {
    Frame F = F0; asm volatile("" : "+v"(F.tid)); F.lane = F.tid & 63;
    LAS float* scr = (LAS float*)(F.lds + F.wave * WREG);
    const int gw = F.bx * NWAVES + F.wave, NGW = F.G * NWAVES;
    for (int L = 0; L < NL; ++L) {
        unsigned char* wl = F.ws + WS_W + (size_t)L * WL_STRIDE;
        const float* g_mix = F.in[I_NORM_MIX] + L * D; const float* g_ffn = F.in[I_NORM_FFN] + L * D; const float* g_ple = F.in[I_NORM_PLE] + L * D;
        { const int nblk = UW / 32, items = (D / 64) * nblk; const float* W = F.in[I_W_IN] + (size_t)L * D * DIN;
          for (int it = gw; it < items; it += NGW) transpose_item(W, DIN, D, g_mix, (bf16*)(wl + WL_IN), scr, it, nblk, F.lane, CmWin()); }
        for (int m = 0; m < 4; ++m) { const int nblk = D / 32, items = (D / 64) * nblk; const float* W = F.in[I_WGATE] + ((size_t)L * 4 + m) * D * D;
          for (int it = gw; it < items; it += NGW) transpose_item(W, D, D, g_mix, (bf16*)(wl + WL_G) + (size_t)m * D * D, scr, it, nblk, F.lane, CmIdent()); }
        for (int m = 0; m < 4; ++m) { const int nblk = D / 32, items = (MW / 64) * nblk; const float* W = F.in[I_WBR] + ((size_t)L * 4 + m) * MW * D;
          for (int it = gw; it < items; it += NGW) transpose_item(W, D, MW, nullptr, (bf16*)(wl + WL_B) + (size_t)m * D * MW, scr, it, nblk, F.lane, CmIdent()); }
        { const int nblk = D / 32, items = (D / 64) * nblk; const float* W = F.in[I_WOUT] + (size_t)L * D * D;
          for (int it = gw; it < items; it += NGW) transpose_item(W, D, D, nullptr, (bf16*)(wl + WL_OUT), scr, it, nblk, F.lane, CmIdent()); }
        { const int nblk = (2 * DFF) / 32, items = (D / 64) * nblk; const float* Wg = F.in[I_FFG] + (size_t)L * D * DFF; const float* Wu = F.in[I_FFU] + (size_t)L * D * DFF;
          for (int it = gw; it < items; it += NGW) { const int nb = it % nblk; const bool up = ((nb * 32) & 128) != 0; transpose_item(up ? Wu : Wg, DFF, D, g_ffn, (bf16*)(wl + WL_FF), scr, it, nblk, F.lane, CmFF()); } }
        { const int nblk = D / 32, items = (DFF / 64) * nblk; const float* W = F.in[I_FFD] + (size_t)L * DFF * D;
          for (int it = gw; it < items; it += NGW) transpose_item(W, D, DFF, nullptr, (bf16*)(wl + WL_DN), scr, it, nblk, F.lane, CmIdent()); }
        { const int nblk = D / 32, items = (D / 64) * nblk; const float* W = F.in[I_PLEG] + (size_t)L * D * D;
          for (int it = gw; it < items; it += NGW) transpose_item(W, D, D, g_ple, (bf16*)(wl + WL_PG), scr, it, nblk, F.lane, CmIdent()); }
        { const int nblk = D / 32, items = (PLE / 64) * nblk; const float* W = F.in[I_PLEP] + (size_t)L * PLE * D;
          for (int it = gw; it < items; it += NGW) transpose_item(W, D, PLE, nullptr, (bf16*)(wl + WL_PP), scr, it, nblk, F.lane, CmIdent()); }
    }
    for (int L = 0; L < NL; ++L) for (int kv = 0; kv < 2; ++kv) {
        const float* w1 = F.in[kv ? I_CV1 : I_CK1] + (size_t)L * 2048 * 128; const float* w2 = F.in[kv ? I_CV2 : I_CK2] + (size_t)L * 128 * 64;
        bf16* w1T = (bf16*)(F.ws + WS_CW1 + (size_t)L * MiB) + (size_t)kv * 128 * 2048; bf16* w2T = (bf16*)(F.ws + WS_CW2 + (size_t)L * 65536) + kv * 64 * 128;
        for (int it = gw; it < 128; it += NGW) transpose_item(w1, 128, 2048, nullptr, w1T, scr, it, 4, F.lane, CmIdent());
        for (int it = gw; it < 4; it += NGW) transpose_item(w2, 64, 128, nullptr, w2T, scr, it, 2, F.lane, CmIdent());
        for (int hf = gw; hf < 2; hf += NGW) { const float* pos = F.in[kv ? I_POS_V : I_POS_K] + (size_t)L * 2048; float a0 = 0.f, a1 = 0.f, a2 = 0.f, a3 = 0.f;
            for (int j = 0; j < 2048; j += 4) { a0 += pos[j] * w1[(size_t)j * 128 + hf * 64 + F.lane]; a1 += pos[j + 1] * w1[(size_t)(j + 1) * 128 + hf * 64 + F.lane];
                a2 += pos[j + 2] * w1[(size_t)(j + 2) * 128 + hf * 64 + F.lane]; a3 += pos[j + 3] * w1[(size_t)(j + 3) * 128 + hf * 64 + F.lane]; }
            ((float*)(F.ws + WS_CW2 + (size_t)L * 65536 + 32768))[kv * 128 + hf * 64 + F.lane] = (a0 + a1) + (a2 + a3); } }
    { const float* x = F.in[I_X]; bf16* hb = (bf16*)(F.ws + WS_HBA); float* ss0 = F.out;
      for (int r = gw; r < T; r += NGW) { const f32x4* xr = (const f32x4*)(x + (size_t)r * D) + F.lane; float s = 0.f;
#pragma unroll
        for (int j = 0; j < 4; ++j) { const f32x4 v = xr[64 * j]; s += (v[0] * v[0] + v[1] * v[1]) + (v[2] * v[2] + v[3] * v[3]);
            u32x2 w; w.x = cvt_pk_bf16(v[0], v[1]); w.y = cvt_pk_bf16(v[2], v[3]); *((u32x2*)(hb + (size_t)r * D) + F.lane + 64 * j) = w; }
        s = wave_sum(s); if (F.lane < 16) ss0[(size_t)r * 16 + F.lane] = (F.lane == 0) ? s : 0.f; } }
    for (int L = 0; L < NL; ++L) { bf16* base = (bf16*)(F.ws + WS_RWUP + (size_t)L * 131072);
        for (int it = gw; it < 8; it += NGW) transpose_item(F.in[I_WUP] + (size_t)L * 64 * 256, 256, 64, nullptr, base, scr, it, 8, F.lane, CmIdent());
        for (int it = gw; it < 8; it += NGW) transpose_item(F.in[I_AUP] + (size_t)L * 64 * 256, 256, 64, nullptr, base + 256 * 64, scr, it, 8, F.lane, CmIdent());
        for (int it = gw; it < 16; it += NGW) transpose_item(F.in[I_GUP] + (size_t)L * 128 * 256, 256, 128, nullptr, base + 2 * 256 * 64, scr, it, 8, F.lane, CmIdent()); }
    { float* rope = (float*)(F.ws + WS_ROPE); const int gt = F.bx * NTHR + F.tid, NT_ = F.G * NTHR;
      for (int i = gt; i < S * 32; i += NT_) { const int pos = i >> 5, j = i & 31; const double inv = pow(10000.0, -(double)(2 * j) / 64.0); const double a = (double)pos * (double)(float)inv;
        rope[2 * i] = (float)cos(a); rope[2 * i + 1] = (float)sin(a); } }
}

__device__ __forceinline__ float ldu(const bf16* u, size_t row, int col) { return bf2f(u[row * UW + col]); }

__device__ __forceinline__ bf16x8 frag_rm(const LAS unsigned char* X, int ld, int r0, int k0, int lane) { return *(const LAS bf16x8*)(X + (r0 + (lane & 31)) * ld + (k0 + 8 * (lane >> 5)) * 2); }
__device__ __forceinline__ bf16x8 frag_tr(const LAS unsigned char* X, int ld, int k0, int c0, int lane) {
    const LAS unsigned char* p = X + (k0 + 8 * (lane >> 5) + ((lane & 15) >> 2)) * ld + (c0 + 16 * ((lane >> 4) & 1) + 4 * (lane & 3)) * 2;
    const s16x4 a = __builtin_amdgcn_ds_read_tr16_b64_v4i16((LAS s16x4*)p), b = __builtin_amdgcn_ds_read_tr16_b64_v4i16((LAS s16x4*)(p + 4 * ld));
    return (bf16x8){a[0], a[1], a[2], a[3], b[0], b[1], b[2], b[3]};
}
__device__ __forceinline__ bf16x8 frag_g(const bf16* X, int ld, int r0, int k0, int lane) { return *(const bf16x8*)(X + (size_t)(r0 + (lane & 31)) * ld + k0 + 8 * (lane >> 5)); }
__device__ __forceinline__ f32x16 mma32(const bf16x8& a, const bf16x8& b, const f32x16& c) { return __builtin_amdgcn_mfma_f32_32x32x16_bf16(a, b, c, 0, 0, 0); }
__device__ __forceinline__ f32x16 zero16() { f32x16 z;
#pragma unroll
    for (int i = 0; i < 16; ++i) z[i] = 0.f;
    return z; }
__device__ __forceinline__ void st_T(LAS unsigned char* X, int ld, int j0, int i0, const f32x16& acc, int lane) {
#pragma unroll
    for (int g = 0; g < 4; ++g) { u32x2 w; w.x = cvt_pk_bf16(acc[4 * g], acc[4 * g + 1]); w.y = cvt_pk_bf16(acc[4 * g + 2], acc[4 * g + 3]);
        *(LAS u32x2*)(X + (j0 + (lane & 31)) * ld + (i0 + 8 * g + 4 * (lane >> 5)) * 2) = w; }
}
__device__ __forceinline__ void st_wt8(bf16* p, const u32x2& w) { __hip_atomic_store((unsigned long long*)p, ((unsigned long long)w.y << 32) | (unsigned long long)w.x, __ATOMIC_RELAXED, __HIP_MEMORY_SCOPE_AGENT); }
__device__ __forceinline__ void st_T_g(bf16* X, int ld, int j0, int i0, const f32x16& acc, int lane) {
#pragma unroll
    for (int g = 0; g < 4; ++g) { u32x2 w; w.x = cvt_pk_bf16(acc[4 * g], acc[4 * g + 1]); w.y = cvt_pk_bf16(acc[4 * g + 2], acc[4 * g + 3]);
        st_wt8(X + (size_t)(j0 + (lane & 31)) * ld + i0 + 8 * g + 4 * (lane >> 5), w); }
}
constexpr int LD64 = 144, LD32 = 80;
__device__ __forceinline__ float expc(float x) { return __expf(fminf(fmaxf(x, -80.f), 80.f)); }
__device__ __forceinline__ unsigned short f2b(float x) { return (unsigned short)(cvt_pk_bf16(x, 0.f) & 0xffffu); }
__device__ __forceinline__ void copy_tok64(LAS unsigned char* X, const bf16* src, int lane) {
#pragma unroll
    for (int p = 0; p < 4; ++p) { const int t = 8 * p + (lane >> 3), ch = lane & 7; *(LAS u32x4*)(X + t * LD64 + ch * 16) = *(const u32x4*)(src + (size_t)t * UW + ch * 8); }
}
__device__ __forceinline__ void glin_m1(const LAS unsigned char* Kh, const LAS unsigned char* Vv, bf16* Sg, int lane, bool cst = false) {
#pragma unroll
    for (int dt = 0; dt < 2; ++dt)
#pragma unroll
        for (int et = 0; et < 2; ++et) { f32x16 acc = zero16();
#pragma unroll
            for (int ks = 0; ks < 2; ++ks) acc = mma32(frag_tr(Kh, LD64, 16 * ks, 32 * dt, lane), frag_tr(Vv, LD64, 16 * ks, 32 * et, lane), acc);
            if (cst) {
#pragma unroll
            for (int i = 0; i < 16; ++i) acc[i] = 0.01f * (float)(1 + ((lane + i) & 7)); }
            st_T_g(Sg, 64, 32 * et, 32 * dt, acc, lane); }
}
__device__ __forceinline__ void glin_m3(const LAS unsigned char* Qt, const LAS unsigned char* Kt, const LAS unsigned char* Vv, LAS unsigned char* Xa, const bf16* S0, int lane, f32x16 (&o)[2]) {
    { f32x16 acc = zero16();
#pragma unroll
      for (int ks = 0; ks < 4; ++ks) acc = mma32(frag_rm(Kt, LD64, 0, 16 * ks, lane), frag_rm(Qt, LD64, 0, 16 * ks, lane), acc);
      const int t = lane & 31;
#pragma unroll
      for (int i = 0; i < 16; ++i) { const int sidx = (i & 3) + 8 * (i >> 2) + 4 * (lane >> 5); if (sidx > t) acc[i] = 0.f; }
      st_T(Xa, LD32, 0, 0, acc, lane); }
    LDS_WAIT();
#pragma unroll
    for (int et = 0; et < 2; ++et) { f32x16 acc = zero16();
        if (S0) {
#pragma unroll
            for (int ks = 0; ks < 4; ++ks) acc = mma32(frag_g(S0, 64, 32 * et, 16 * ks, lane), frag_rm(Qt, LD64, 0, 16 * ks, lane), acc); }
#pragma unroll
        for (int ks = 0; ks < 2; ++ks) acc = mma32(frag_tr(Vv, LD64, 16 * ks, 32 * et, lane), frag_rm(Xa, LD32, 0, 16 * ks, lane), acc);
        o[et] = acc; }
}
template <bool M3>
__device__ __forceinline__ void hgrn_chunk(Frame& F, int L, int bh, int n, LAS unsigned char* W, bf16* Sbase, float* Dbase) {
    const bf16* u = (const bf16*)(F.ws + WS_U); bf16* bo = (bf16*)(F.ws + WS_BO);
    int lane = F.lane; asm volatile("" : "+v"(lane));
    const int b = bh >> 2, h = bh & 3; const size_t row0 = (size_t)b * S + (size_t)n * CH;
    const bf16* ur = u + row0 * UW + U_HG + h * 64;
    bf16* Sg = Sbase + ((size_t)bh * NCH + n) * 4096;
    LAS unsigned char* Xq = W; LAS unsigned char* Xk = W + 4608; LAS unsigned char* Xv = W + 9216; LAS unsigned char* Xa = W + 13824;
    const float* lbl = F.in[I_LB]; const int ch = h * 64 + lane;
    float lb = 0.f; if (L > 0) { const float l0 = lbl[ch], l1 = lbl[256 + ch]; const float mx = fmaxf(l0, l1); const float e0 = __expf(l0 - mx), e1 = __expf(l1 - mx); lb = e1 / (e0 + e1); }
    float bcum[CH], kk[CH]; float run = 0.f;
#pragma unroll
    for (int t = 0; t < CH; ++t) { const float z = bf2f(ur[(size_t)t * UW + 256 + lane]); const float f = lb + (1.0f - lb) * fsigmoid(z); kk[t] = 1.0f - f; run += __logf(fmaxf(f, 1e-20f)); bcum[t] = run; }
    const float blast = bcum[CH - 1];
    copy_tok64(Xv, ur + 512, lane);
    if (!M3) {
#pragma unroll
        for (int t = 0; t < CH; ++t) *(LAS unsigned short*)(Xq + t * LD64 + lane * 2) = f2b(kk[t] * expc(blast - bcum[t]));
        Dbase[((size_t)bh * NCH + n) * 64 + lane] = expc(blast);
        LDS_WAIT();
        glin_m1(Xq, Xv, Sg, lane);
    } else {
#pragma unroll
        for (int t = 0; t < CH; ++t) { const float q = fsilu(bf2f(ur[(size_t)t * UW + lane]));
            *(LAS unsigned short*)(Xq + t * LD64 + lane * 2) = f2b(q * expc(bcum[t]));
            *(LAS unsigned short*)(Xk + t * LD64 + lane * 2) = f2b(kk[t] * expc(-bcum[t])); }
        LDS_WAIT();
        f32x16 o[2];
        glin_m3(Xq, Xk, Xv, Xa, n > 0 ? Sg - 4096 : nullptr, lane, o);
        const int t = lane & 31, hh = lane >> 5; float ss = 0.f;
#pragma unroll
        for (int et = 0; et < 2; ++et)
#pragma unroll
            for (int i = 0; i < 16; ++i) ss += o[et][i] * o[et][i];
        ss += __shfl_xor(ss, 32);
        const float rn = __builtin_amdgcn_rsqf(ss * (1.0f / 64.0f) + EPS);
        const float* ng = F.in[I_HG_NORM] + L * 256 + h * 64;
#pragma unroll
        for (int et = 0; et < 2; ++et)
#pragma unroll
            for (int g = 0; g < 4; ++g) { const int e0 = 32 * et + 8 * g + 4 * hh;
                const u32x2 og = *(const u32x2*)(ur + (size_t)t * UW + 768 + e0); const f32x4 gg = *(const f32x4*)(ng + e0);
                const float y0 = o[et][4 * g] * rn * gg[0] * fsilu(bflo(og.x)), y1 = o[et][4 * g + 1] * rn * gg[1] * fsilu(bfhi(og.x));
                const float y2 = o[et][4 * g + 2] * rn * gg[2] * fsilu(bflo(og.y)), y3 = o[et][4 * g + 3] * rn * gg[3] * fsilu(bfhi(og.y));
                u32x2 w; w.x = cvt_pk_bf16(y0, y1); w.y = cvt_pk_bf16(y2, y3);
                *(u32x2*)(bo + (row0 + t) * 1024 + 256 + h * 64 + e0) = w; }
    }
    LDS_WAIT();
}
template <bool M3>
__device__ __forceinline__ void ret_chunk(Frame& F, int L, int bh, int n, LAS unsigned char* W, bf16* Sbase) {
    const bf16* u = (const bf16*)(F.ws + WS_U); bf16* bo = (bf16*)(F.ws + WS_BO); const float* rope = (const float*)(F.ws + WS_ROPE);
    int lane = F.lane; asm volatile("" : "+v"(lane));
    const int b = bh >> 2, h = bh & 3; const int tpos0 = n * CH; const size_t row0 = (size_t)b * S + (size_t)tpos0;
    const bf16* ur = u + row0 * UW + U_RT + h * 64;
    bf16* Sg = Sbase + ((size_t)bh * NCH + n) * 4096;
    LAS unsigned char* Xq = W; LAS unsigned char* Xk = W + 4608; LAS unsigned char* Xv = W + 9216; LAS unsigned char* Xa = W + 13824;
    const float lg2 = __log2f(1.0f - exp2f(-5.0f - (float)h));
    copy_tok64(Xv, ur + 512, lane);
#pragma unroll
    for (int p = 0; p < 2; ++p) { const int idx = lane + 64 * p, t = idx >> 2, jc = idx & 3;
        f32x4 c0, c1, s0, s1;
        { const float* rp = rope + ((size_t)(tpos0 + t) * 32 + jc * 8) * 2; const f32x4 a = *(const f32x4*)rp, bq = *(const f32x4*)(rp + 4), c = *(const f32x4*)(rp + 8), d = *(const f32x4*)(rp + 12);
          c0 = (f32x4){a[0], a[2], bq[0], bq[2]}; s0 = (f32x4){a[1], a[3], bq[1], bq[3]}; c1 = (f32x4){c[0], c[2], d[0], d[2]}; s1 = (f32x4){c[1], c[3], d[1], d[3]}; }
        { const u32x4 w1 = *(const u32x4*)(ur + (size_t)t * UW + 256 + jc * 8), w2 = *(const u32x4*)(ur + (size_t)t * UW + 256 + 32 + jc * 8);
          f32x4 a0, a1, b0, b1; unpack8(w1, a0, a1); unpack8(w2, b0, b1);
          const float sc = 0.125f * exp2f(lg2 * (M3 ? -(float)(t + 1) : (float)(CH - 1 - t)));
          const f32x4 lo0 = (a0 * c0 - b0 * s0) * sc, lo1 = (a1 * c1 - b1 * s1) * sc, hi0 = (a0 * s0 + b0 * c0) * sc, hi1 = (a1 * s1 + b1 * c1) * sc;
          LAS unsigned char* dst = M3 ? Xk : Xq;
          *(LAS u32x4*)(dst + t * LD64 + jc * 16) = pack8(lo0, lo1); *(LAS u32x4*)(dst + t * LD64 + 64 + jc * 16) = pack8(hi0, hi1); }
        if (M3) { const u32x4 w1 = *(const u32x4*)(ur + (size_t)t * UW + jc * 8), w2 = *(const u32x4*)(ur + (size_t)t * UW + 32 + jc * 8);
          f32x4 a0, a1, b0, b1; unpack8(w1, a0, a1); unpack8(w2, b0, b1);
          const float sc = exp2f(lg2 * (float)(t + 1));
          const f32x4 lo0 = (a0 * c0 - b0 * s0) * sc, lo1 = (a1 * c1 - b1 * s1) * sc, hi0 = (a0 * s0 + b0 * c0) * sc, hi1 = (a1 * s1 + b1 * c1) * sc;
          *(LAS u32x4*)(Xq + t * LD64 + jc * 16) = pack8(lo0, lo1); *(LAS u32x4*)(Xq + t * LD64 + 64 + jc * 16) = pack8(hi0, hi1); }
    }
    LDS_WAIT();
    if (!M3) glin_m1(Xq, Xv, Sg, lane);
    else {
        f32x16 o[2];
        glin_m3(Xq, Xk, Xv, Xa, n > 0 ? Sg - 4096 : nullptr, lane, o);
        const int t = lane & 31, hh = lane >> 5; float sm = 0.f;
#pragma unroll
        for (int et = 0; et < 2; ++et)
#pragma unroll
            for (int i = 0; i < 16; ++i) sm += o[et][i];
        sm += __shfl_xor(sm, 32);
        const float mean = sm * (1.0f / 64.0f); float sv = 0.f;
#pragma unroll
        for (int et = 0; et < 2; ++et)
#pragma unroll
            for (int i = 0; i < 16; ++i) { const float dl = o[et][i] - mean; sv += dl * dl; }
        sv += __shfl_xor(sv, 32);
        const float rn = __builtin_amdgcn_rsqf(sv * (1.0f / 64.0f) + 1e-5f);
        const float* ng = F.in[I_RT_G] + L * 256 + h * 64; const float* nb = F.in[I_RT_B] + L * 256 + h * 64;
#pragma unroll
        for (int et = 0; et < 2; ++et)
#pragma unroll
            for (int g = 0; g < 4; ++g) { const int e0 = 32 * et + 8 * g + 4 * hh;
                const u32x2 og = *(const u32x2*)(ur + (size_t)t * UW + 768 + e0); const f32x4 gg = *(const f32x4*)(ng + e0), bb = *(const f32x4*)(nb + e0);
                const float y0 = ((o[et][4 * g] - mean) * rn * gg[0] + bb[0]) * fsilu(bflo(og.x)), y1 = ((o[et][4 * g + 1] - mean) * rn * gg[1] + bb[1]) * fsilu(bfhi(og.x));
                const float y2 = ((o[et][4 * g + 2] - mean) * rn * gg[2] + bb[2]) * fsilu(bflo(og.y)), y3 = ((o[et][4 * g + 3] - mean) * rn * gg[3] + bb[3]) * fsilu(bfhi(og.y));
                u32x2 w; w.x = cvt_pk_bf16(y0, y1); w.y = cvt_pk_bf16(y2, y3);
                *(u32x2*)(bo + (row0 + t) * 1024 + 512 + h * 64 + e0) = w; }
    }
    LDS_WAIT();
}
__device__ __forceinline__ void glin_scan_task(bf16* Sbase, const float* Dbase, float dscal, int bh, int quarter, int tl  ) {
    bf16* p = Sbase + (size_t)bh * NCH * 4096 + quarter * 1024 + tl * 4;
    const int d0 = (tl & 15) * 4;
    f32x4 st = {0.f, 0.f, 0.f, 0.f};
    for (int n0 = 0; n0 < NCH; n0 += 8) {
        u32x2 kv[8]; f32x4 dd[8];
#pragma unroll
        for (int j = 0; j < 8; ++j) { kv[j] = *(const u32x2*)(p + (size_t)(n0 + j) * 4096); if (Dbase) dd[j] = *(const f32x4*)(Dbase + ((size_t)bh * NCH + n0 + j) * 64 + d0); else dd[j] = (f32x4){dscal, dscal, dscal, dscal}; }
#pragma unroll
        for (int j = 0; j < 8; ++j) {
            st[0] = st[0] * dd[j][0] + bflo(kv[j].x); st[1] = st[1] * dd[j][1] + bfhi(kv[j].x); st[2] = st[2] * dd[j][2] + bflo(kv[j].y); st[3] = st[3] * dd[j][3] + bfhi(kv[j].y);
            u32x2 w; w.x = cvt_pk_bf16(st[0], st[1]); w.y = cvt_pk_bf16(st[2], st[3]); st_wt8(p + (size_t)(n0 + j) * 4096, w); }
    }
}

constexpr int RW_R0 = 0, RW_R1 = 4608, RW_R2 = 9216, RW_R3 = 13824, RW_R4 = 16384, RW_R5 = 18944, RW_LW = 0, RW_AG = 8704, LDLW = 272;
__device__ __forceinline__ void ld_shift8(const bf16* urow, bool has_prev, const float* mu8, f32x4& lo, f32x4& hi) {
    const u32x4 w1 = *(const u32x4*)urow; f32x4 a0, a1; unpack8(w1, a0, a1);
    f32x4 p0 = {0.f, 0.f, 0.f, 0.f}, p1 = {0.f, 0.f, 0.f, 0.f};
    if (has_prev) { const u32x4 w0 = *(const u32x4*)(urow - UW); unpack8(w0, p0, p1); }
    const f32x4 m0 = *(const f32x4*)mu8, m1 = *(const f32x4*)(mu8 + 4);
    lo = a0 + m0 * (p0 - a0); hi = a1 + m1 * (p1 - a1);
}
__device__ __forceinline__ float ftanh(float x) { return 1.0f - 2.0f * __builtin_amdgcn_rcpf(1.0f + __builtin_amdgcn_exp2f(2.8853900817779268f * x)); }
#ifndef RW_LIMIT
#define RW_LIMIT 100
#endif
#define RW_CUT(k) do { if (RW_LIMIT <= (k)) return; } while (0)
template <int SI> struct SubstStep {
    static __device__ __forceinline__ void run(float (&Tr)[CH], const LAS unsigned char* AT, int r32, int& ofs) {
        float a0 = (r32 == SI) ? 1.0f : 0.f, a1 = 0.f;
#pragma unroll
        for (int q = 0; q < 4; ++q) { if (8 * q + 7 > SI) { const u32x4 w = *(const LAS u32x4*)(AT + ofs + SI * LD32 + q * 16); f32x4 lo, hi; unpack8(w, lo, hi);
#pragma unroll
            for (int x = 0; x < 4; ++x) { if (8 * q + x > SI) a0 += Tr[8 * q + x] * lo[x]; if (8 * q + 4 + x > SI) a1 += Tr[8 * q + 4 + x] * hi[x]; } } }
        const float a = a0 + a1;
        Tr[SI] = a;
        asm volatile("" : "+v"(ofs) : "v"(a));
        SubstStep<SI - 1>::run(Tr, AT, r32, ofs);
    }
};
template <> struct SubstStep<-1> { static __device__ __forceinline__ void run(float (&)[CH], const LAS unsigned char*, int, int&) {} };
template <bool M3>
__device__ __forceinline__ void rwkv_chunk(Frame& F, int L, int bh, int n, LAS unsigned char* W) {
    const bf16* u = (const bf16*)(F.ws + WS_U); bf16* bo = (bf16*)(F.ws + WS_BO);
    int lane = F.lane; asm volatile("" : "+v"(lane));
    const int b = bh >> 2, h = bh & 3, r32 = lane & 31, hh = lane >> 5; const size_t row0 = (size_t)b * S + (size_t)n * CH;
    const bf16* ur = u + row0 * UW + U_RW;
    const float* mu = F.in[I_MU] + L * 1024;
    const bf16* upT = (const bf16*)(F.ws + WS_RWUP + (size_t)L * 131072);
    bf16* Mg = (bf16*)(F.ws + WS_RWM) + ((size_t)bh * NCH + n) * 4096;
    bf16* Ng = (bf16*)(F.ws + WS_RWN) + ((size_t)bh * NCH + n) * 4096;
    LAS unsigned char* R0 = W + RW_R0; LAS unsigned char* R1 = W + RW_R1; LAS unsigned char* R2 = W + RW_R2; LAS unsigned char* R3 = W + RW_R3; LAS unsigned char* R4 = W + RW_R4;
    LAS float* R5 = (LAS float*)(W + RW_R5);
#pragma unroll
    for (int i = 0; i < 8; ++i) { const int idx = lane + 64 * i, t = idx >> 4, part = (idx >> 3) & 1, ch = idx & 7, col = 768 + part * 64 + ch * 8;
        f32x4 lo, hi; ld_shift8(ur + (size_t)t * UW + col, (n * CH + t) > 0, mu + col, lo, hi);
        if (part == 0) {
#pragma unroll
            for (int j = 0; j < 4; ++j) { lo[j] = ftanh(lo[j]); hi[j] = ftanh(hi[j]); } }
        *(LAS u32x4*)(W + part * 4608 + t * LD64 + ch * 16) = pack8(lo, hi); }
    RW_CUT(0);
    LDS_WAIT();
    { f32x16 zw[2], za[2];
#pragma unroll
      for (int ct = 0; ct < 2; ++ct) { zw[ct] = zero16(); za[ct] = zero16();
#pragma unroll
        for (int ks = 0; ks < 4; ++ks) { zw[ct] = mma32(frag_g(upT + (size_t)(h * 64 + 32 * ct) * 64, 64, 0, 16 * ks, lane), frag_rm(W, LD64, 0, 16 * ks, lane), zw[ct]);
            za[ct] = mma32(frag_g(upT + 256 * 64 + (size_t)(h * 64 + 32 * ct) * 64, 64, 0, 16 * ks, lane), frag_rm(W + 4608, LD64, 0, 16 * ks, lane), za[ct]); } }
      const float* w0 = F.in[I_W0] + L * 256 + h * 64; const float* a0 = F.in[I_A0] + L * 256 + h * 64;
#pragma unroll
      for (int ct = 0; ct < 2; ++ct)
#pragma unroll
        for (int g = 0; g < 4; ++g) { const int c0 = 32 * ct + 8 * g + 4 * hh; const f32x4 wv = *(const f32x4*)(w0 + c0), av = *(const f32x4*)(a0 + c0);
            f32x4 lw, ag;
#pragma unroll
            for (int x = 0; x < 4; ++x) { lw[x] = -0.6065306597126334f * fsigmoid(zw[ct][4 * g + x] + wv[x]); ag[x] = fsigmoid(za[ct][4 * g + x] + av[x]); }
            *(LAS f32x4*)(W + RW_LW + r32 * LDLW + c0 * 4) = lw;
            u32x2 pk; pk.x = cvt_pk_bf16(ag[0], ag[1]); pk.y = cvt_pk_bf16(ag[2], ag[3]); *(LAS u32x2*)(W + RW_AG + r32 * LD64 + c0 * 2) = pk; } }
    RW_CUT(1);
    LDS_WAIT();
    { float run = 0.f;
#pragma unroll
      for (int t = 0; t < CH; ++t) { LAS float* p = (LAS float*)(W + RW_LW + t * LDLW) + lane; run += *p; *p = run; } }
    RW_CUT(2);
    LDS_WAIT();
    const int c0 = 8 * (lane & 7), tl = lane >> 3;
    u32x4 E1p[4], E2p[4], AGp[4];
#pragma unroll
    for (int p = 0; p < 4; ++p) { const int t = 8 * p + tl;
        const f32x4 ca = *(const LAS f32x4*)(W + RW_LW + t * LDLW + c0 * 4), cb = *(const LAS f32x4*)(W + RW_LW + t * LDLW + c0 * 4 + 16);
        f32x4 ea = {0.f, 0.f, 0.f, 0.f}, eb = {0.f, 0.f, 0.f, 0.f};
        if (t > 0) { ea = *(const LAS f32x4*)(W + RW_LW + (t - 1) * LDLW + c0 * 4); eb = *(const LAS f32x4*)(W + RW_LW + (t - 1) * LDLW + c0 * 4 + 16); }
        AGp[p] = *(const LAS u32x4*)(W + RW_AG + t * LD64 + c0 * 2);
        f32x4 x1a, x1b, x2a, x2b;
#pragma unroll
        for (int x = 0; x < 4; ++x) { x1a[x] = __expf(ea[x]); x1b[x] = __expf(eb[x]); x2a[x] = __expf(-ca[x]); x2b[x] = __expf(-cb[x]); }
        E1p[p] = pack8(x1a, x1b); E2p[p] = pack8(x2a, x2b); }
    float pcl[8];
    { const f32x4 la = *(const LAS f32x4*)(W + RW_LW + 31 * LDLW + c0 * 4), lb2 = *(const LAS f32x4*)(W + RW_LW + 31 * LDLW + c0 * 4 + 16);
#pragma unroll
      for (int x = 0; x < 4; ++x) { pcl[x] = __expf(la[x]); pcl[4 + x] = __expf(lb2[x]); } }
    RW_CUT(3);
    LDS_WAIT();
    const float* kkw = F.in[I_KK] + L * 256 + h * 64 + c0; const float* kaw = F.in[I_KA] + L * 256 + h * 64 + c0; const float* rkw = F.in[I_RK] + L * 256 + h * 64 + c0;
    u32x4 Ap[4];
    if (!M3 && tl == 0) { *(LAS f32x4*)(R5 + c0) = (f32x4){pcl[0], pcl[1], pcl[2], pcl[3]}; *(LAS f32x4*)(R5 + c0 + 4) = (f32x4){pcl[4], pcl[5], pcl[6], pcl[7]}; }
#pragma unroll
    for (int p = 0; p < 4; ++p) { const int t = 8 * p + tl; const bool hp = (n * CH + t) > 0; const bf16* ut = ur + (size_t)t * UW + h * 64 + c0;
        f32x4 k0, k1, r0 = {0.f, 0.f, 0.f, 0.f}, r1 = {0.f, 0.f, 0.f, 0.f};
        ld_shift8(ut + 256, hp, mu + 256 + h * 64 + c0, k0, k1);
        if (M3) ld_shift8(ut, hp, mu + h * 64 + c0, r0, r1);
        f32x4 ag0, ag1; unpack8(AGp[p], ag0, ag1);
        float E1[8], E2[8]; { f32x4 a, bq; unpack8(E1p[p], a, bq); f32x4 c, d; unpack8(E2p[p], c, d);
#pragma unroll
            for (int x = 0; x < 4; ++x) { E1[x] = a[x]; E1[4 + x] = bq[x]; E2[x] = c[x]; E2[4 + x] = d[x]; } }
        const f32x4 kw0 = *(const f32x4*)kkw, kw1 = *(const f32x4*)(kkw + 4), ka0 = *(const f32x4*)kaw, ka1 = *(const f32x4*)(kaw + 4);
        f32x4 q0 = k0 * kw0, q1 = k1 * kw1;
        float n2 = (q0[0] * q0[0] + q0[1] * q0[1]) + (q0[2] * q0[2] + q0[3] * q0[3]) + (q1[0] * q1[0] + q1[1] * q1[1]) + (q1[2] * q1[2] + q1[3] * q1[3]);
        n2 += __shfl_xor(n2, 1); n2 += __shfl_xor(n2, 2); n2 += __shfl_xor(n2, 4);
        const float rn = __builtin_amdgcn_rsqf(fmaxf(n2, 1e-24f)); q0 = q0 * rn; q1 = q1 * rn;
        f32x4 kp0, kp1, at0, at1, bt0, bt1, kt0, kt1;
#pragma unroll
        for (int x = 0; x < 4; ++x) { kp0[x] = k0[x] * (1.0f + (ag0[x] - 1.0f) * ka0[x]); kp1[x] = k1[x] * (1.0f + (ag1[x] - 1.0f) * ka1[x]);
            at0[x] = -q0[x] * E1[x]; at1[x] = -q1[x] * E1[4 + x]; bt0[x] = q0[x] * ag0[x] * E2[x]; bt1[x] = q1[x] * ag1[x] * E2[4 + x];
            kt0[x] = kp0[x] * E2[x]; kt1[x] = kp1[x] * E2[4 + x]; }
        *(LAS u32x4*)(R1 + t * LD64 + c0 * 2) = pack8(bt0, bt1); *(LAS u32x4*)(R2 + t * LD64 + c0 * 2) = pack8(kt0, kt1);
        if (!M3) *(LAS u32x4*)(R0 + t * LD64 + c0 * 2) = pack8(at0, at1);
        else { Ap[p] = pack8(at0, at1);
            const f32x4 rk0 = *(const f32x4*)rkw, rk1 = *(const f32x4*)(rkw + 4);
            f32x4 rt0, rt1; float bs = 0.f;
#pragma unroll
            for (int x = 0; x < 4; ++x) { rt0[x] = r0[x] * __builtin_amdgcn_rcpf(E2[x]); rt1[x] = r1[x] * __builtin_amdgcn_rcpf(E2[4 + x]); bs += r0[x] * kp0[x] * rk0[x] + r1[x] * kp1[x] * rk1[x]; }
            bs += __shfl_xor(bs, 1); bs += __shfl_xor(bs, 2); bs += __shfl_xor(bs, 4);
            if ((lane & 7) == 0) R5[t] = bs;
            *(LAS u32x4*)(R0 + t * LD64 + c0 * 2) = pack8(rt0, rt1); } }
    RW_CUT(4);
    LDS_WAIT();
    const bf16* S0 = n > 0 ? Ng - 4096 : nullptr;
    f32x16 yacc[2], g2acc;
    if (M3) {
#pragma unroll
        for (int vt = 0; vt < 2; ++vt) { yacc[vt] = zero16();
            if (S0) {
#pragma unroll
                for (int ks = 0; ks < 4; ++ks) yacc[vt] = mma32(frag_g(S0, 64, 32 * vt, 16 * ks, lane), frag_rm(R0, LD64, 0, 16 * ks, lane), yacc[vt]); } }
        f32x16 g1 = zero16(); g2acc = zero16();
#pragma unroll
        for (int ks = 0; ks < 4; ++ks) { const bf16x8 rf = frag_rm(R0, LD64, 0, 16 * ks, lane); g1 = mma32(frag_rm(R1, LD64, 0, 16 * ks, lane), rf, g1); g2acc = mma32(frag_rm(R2, LD64, 0, 16 * ks, lane), rf, g2acc); }
#pragma unroll
        for (int i = 0; i < 16; ++i) { const int sidx = (i & 3) + 8 * (i >> 2) + 4 * hh; if (sidx > r32) { g1[i] = 0.f; g2acc[i] = 0.f; } }
        st_T(R4, LD32, 0, 0, g1, lane);
        LDS_WAIT();
#pragma unroll
        for (int p = 0; p < 4; ++p) *(LAS u32x4*)(R0 + (8 * p + tl) * LD64 + c0 * 2) = Ap[p];
        LDS_WAIT();
    }
    RW_CUT(5);
    { f32x16 ab = zero16(), ak = zero16();
#pragma unroll
      for (int ks = 0; ks < 4; ++ks) { const bf16x8 af = frag_rm(R0, LD64, 0, 16 * ks, lane); ab = mma32(af, frag_rm(R1, LD64, 0, 16 * ks, lane), ab); ak = mma32(frag_rm(R2, LD64, 0, 16 * ks, lane), af, ak); }
#pragma unroll
      for (int i = 0; i < 16; ++i) { const int ridx = (i & 3) + 8 * (i >> 2) + 4 * hh;
          if (!(ridx > r32)) ab[i] = 0.f;
          if (!(ridx < r32)) ak[i] = 0.f; }
      st_T(R3, LD32, 0, 0, ab, lane);
      st_T(M3 ? R2 : R4, LD32, 0, 0, ak, lane); }
    LAS unsigned char* X1 = M3 ? R2 : R4;
    RW_CUT(6);
    LDS_WAIT();
    { float Tr[CH];
      int sofs = 0; asm volatile("" : "+v"(sofs)); SubstStep<CH - 1>::run(Tr, R3, r32, sofs);
      if (hh == 0) {
#pragma unroll
          for (int q = 0; q < 4; ++q) { f32x4 lo = {Tr[8 * q], Tr[8 * q + 1], Tr[8 * q + 2], Tr[8 * q + 3]}, hi = {Tr[8 * q + 4], Tr[8 * q + 5], Tr[8 * q + 6], Tr[8 * q + 7]};
              *(LAS u32x4*)(R3 + r32 * LD32 + q * 16) = pack8(lo, hi); } } }
    RW_CUT(7);
    LDS_WAIT();
    { f32x16 y = zero16(), ah[2];
#pragma unroll
      for (int ks = 0; ks < 2; ++ks) y = mma32(frag_tr(X1, LD32, 16 * ks, 0, lane), frag_rm(R3, LD32, 0, 16 * ks, lane), y);
#pragma unroll
      for (int ct = 0; ct < 2; ++ct) { ah[ct] = zero16();
#pragma unroll
        for (int ks = 0; ks < 2; ++ks) ah[ct] = mma32(frag_tr(R0, LD64, 16 * ks, 32 * ct, lane), frag_rm(R3, LD32, 0, 16 * ks, lane), ah[ct]); }
      st_T(X1, LD32, 0, 0, y, lane);
      st_T(R0, LD64, 0, 0, ah[0], lane); st_T(R0, LD64, 0, 32, ah[1], lane); }
    RW_CUT(8);
    LDS_WAIT();
    if (!M3) {
        { f32x16 z[2];
#pragma unroll
          for (int dt = 0; dt < 2; ++dt) {
#pragma unroll
            for (int g = 0; g < 4; ++g) { const u32x2 w = *(const LAS u32x2*)(R2 + r32 * LD64 + (32 * dt + 8 * g + 4 * hh) * 2); z[dt][4 * g] = bflo(w.x); z[dt][4 * g + 1] = bfhi(w.x); z[dt][4 * g + 2] = bflo(w.y); z[dt][4 * g + 3] = bfhi(w.y); }
#pragma unroll
            for (int ks = 0; ks < 2; ++ks) z[dt] = mma32(frag_tr(R1, LD64, 16 * ks, 32 * dt, lane), frag_tr(X1, LD32, 16 * ks, 0, lane), z[dt]); }
          st_T(R2, LD64, 0, 0, z[0], lane); st_T(R2, LD64, 0, 32, z[1], lane); }
#pragma unroll
        for (int d1t = 0; d1t < 2; ++d1t) { const float pc1 = R5[32 * d1t + r32];
#pragma unroll
            for (int d2t = 0; d2t < 2; ++d2t) { f32x16 m = zero16();
#pragma unroll
                for (int ks = 0; ks < 2; ++ks) m = mma32(frag_tr(R0, LD64, 16 * ks, 32 * d2t, lane), frag_tr(R1, LD64, 16 * ks, 32 * d1t, lane), m);
#pragma unroll
                for (int i = 0; i < 16; ++i) { const int d2 = 32 * d2t + (i & 3) + 8 * (i >> 2) + 4 * hh; m[i] = pc1 * (m[i] + ((d2 == 32 * d1t + r32) ? 1.0f : 0.f)); }
                st_T_g(Mg, 64, 32 * d1t, 32 * d2t, m, lane); } }
        LDS_WAIT();
#pragma unroll
        for (int p = 0; p < 4; ++p) { const int t = 8 * p + tl; f32x4 v0, v1; ld_shift8(ur + (size_t)t * UW + h * 64 + c0 + 512, (n * CH + t) > 0, mu + 512 + h * 64 + c0, v0, v1); *(LAS u32x4*)(R1 + t * LD64 + c0 * 2) = pack8(v0, v1); }
        LDS_WAIT();
#pragma unroll
        for (int dt = 0; dt < 2; ++dt)
#pragma unroll
            for (int vt = 0; vt < 2; ++vt) { f32x16 nn = zero16();
#pragma unroll
                for (int ks = 0; ks < 2; ++ks) nn = mma32(frag_tr(R2, LD64, 16 * ks, 32 * dt, lane), frag_tr(R1, LD64, 16 * ks, 32 * vt, lane), nn);
#pragma unroll
                for (int g = 0; g < 4; ++g) { const f32x4 pv = *(const LAS f32x4*)(R5 + 32 * dt + 8 * g + 4 * hh);
#pragma unroll
                    for (int x = 0; x < 4; ++x) nn[4 * g + x] *= pv[x]; }
                st_T_g(Ng, 64, 32 * vt, 32 * dt, nn, lane); }
    } else {
        { f32x16 rh[2];
#pragma unroll
          for (int dt = 0; dt < 2; ++dt) { rh[dt] = zero16();
#pragma unroll
            for (int ks = 0; ks < 2; ++ks) rh[dt] = mma32(frag_tr(R0, LD64, 16 * ks, 32 * dt, lane), frag_rm(R4, LD32, 0, 16 * ks, lane), rh[dt]); }
          st_T(R1, LD64, 0, 0, rh[0], lane); st_T(R1, LD64, 0, 32, rh[1], lane); }
        { f32x16 gh = g2acc;
#pragma unroll
          for (int ks = 0; ks < 2; ++ks) gh = mma32(frag_tr(X1, LD32, 16 * ks, 0, lane), frag_rm(R4, LD32, 0, 16 * ks, lane), gh);
          LDS_WAIT();
          st_T(R3, LD32, 0, 0, gh, lane); }
        LDS_WAIT();
        if (S0) {
#pragma unroll
            for (int vt = 0; vt < 2; ++vt)
#pragma unroll
                for (int ks = 0; ks < 4; ++ks) yacc[vt] = mma32(frag_g(S0, 64, 32 * vt, 16 * ks, lane), frag_rm(R1, LD64, 0, 16 * ks, lane), yacc[vt]); }
        LDS_WAIT();
#pragma unroll
        for (int p = 0; p < 4; ++p) { const int t = 8 * p + tl; f32x4 v0, v1; ld_shift8(ur + (size_t)t * UW + h * 64 + c0 + 512, (n * CH + t) > 0, mu + 512 + h * 64 + c0, v0, v1); *(LAS u32x4*)(R0 + t * LD64 + c0 * 2) = pack8(v0, v1); }
#pragma unroll
        for (int i = 0; i < 8; ++i) { const int idx = lane + 64 * i, t = idx >> 4, ch = idx & 15, col = 896 + ch * 8;
            f32x4 lo, hi; ld_shift8(ur + (size_t)t * UW + col, (n * CH + t) > 0, mu + col, lo, hi);
#pragma unroll
            for (int j = 0; j < 4; ++j) { lo[j] = fsigmoid(lo[j]); hi[j] = fsigmoid(hi[j]); }
            *(LAS u32x4*)(R1 + t * LDLW + ch * 16) = pack8(lo, hi); }
        LDS_WAIT();
        f32x16 gacc[2];
#pragma unroll
        for (int vt = 0; vt < 2; ++vt) {
#pragma unroll
            for (int ks = 0; ks < 2; ++ks) yacc[vt] = mma32(frag_tr(R0, LD64, 16 * ks, 32 * vt, lane), frag_rm(R3, LD32, 0, 16 * ks, lane), yacc[vt]);
            gacc[vt] = zero16();
#pragma unroll
            for (int ks = 0; ks < 8; ++ks) gacc[vt] = mma32(frag_g(upT + 2 * 256 * 64 + (size_t)(h * 64 + 32 * vt) * 128, 128, 0, 16 * ks, lane), frag_rm(R1, LDLW, 0, 16 * ks, lane), gacc[vt]); }
        float sm = 0.f;
#pragma unroll
        for (int vt = 0; vt < 2; ++vt)
#pragma unroll
            for (int i = 0; i < 16; ++i) sm += yacc[vt][i];
        sm += __shfl_xor(sm, 32);
        const float mean = sm * (1.0f / 64.0f); float sv = 0.f;
#pragma unroll
        for (int vt = 0; vt < 2; ++vt)
#pragma unroll
            for (int i = 0; i < 16; ++i) { const float dl = yacc[vt][i] - mean; sv += dl * dl; }
        sv += __shfl_xor(sv, 32);
        const float rstd = __builtin_amdgcn_rsqf(sv * (1.0f / 64.0f) + 64e-5f);
        const float bon = R5[r32];
        const float* ng = F.in[I_RW_G] + L * 256 + h * 64; const float* nb = F.in[I_RW_B] + L * 256 + h * 64;
#pragma unroll
        for (int vt = 0; vt < 2; ++vt)
#pragma unroll
            for (int g = 0; g < 4; ++g) { const int v0i = 32 * vt + 8 * g + 4 * hh;
                const u32x2 vw = *(const LAS u32x2*)(R0 + r32 * LD64 + v0i * 2); const f32x4 gg = *(const f32x4*)(ng + v0i), bb = *(const f32x4*)(nb + v0i);
                const float vv[4] = {bflo(vw.x), bfhi(vw.x), bflo(vw.y), bfhi(vw.y)}; float o[4];
#pragma unroll
                for (int x = 0; x < 4; ++x) o[x] = ((yacc[vt][4 * g + x] - mean) * rstd * gg[x] + bb[x] + bon * vv[x]) * gacc[vt][4 * g + x];
                u32x2 w; w.x = cvt_pk_bf16(o[0], o[1]); w.y = cvt_pk_bf16(o[2], o[3]);
                *(u32x2*)(bo + (row0 + r32) * 1024 + 768 + h * 64 + v0i) = w; }
    }
    LDS_WAIT();
}
__device__ __forceinline__ void rwkv_scan_task(Frame& F, int bh, int vh) {
    const int lane = F.lane, r32 = lane & 31, hh = lane >> 5;
    const bf16* Mb = (const bf16*)(F.ws + WS_RWM) + (size_t)bh * NCH * 4096; bf16* Nb = (bf16*)(F.ws + WS_RWN) + (size_t)bh * NCH * 4096 + (size_t)(vh * 32 + r32) * 64;
    f32x16 st[2] = {zero16(), zero16()};
    u32x2 nq[2][4], mq[2][2][2][2];
#define RW_PREF(nn) do { _Pragma("unroll") for (int dt = 0; dt < 2; ++dt) _Pragma("unroll") for (int g = 0; g < 4; ++g) nq[dt][g] = *(const u32x2*)(Nb + (size_t)(nn) * 4096 + 32 * dt + 8 * g + 4 * hh); \
        _Pragma("unroll") for (int d1t = 0; d1t < 2; ++d1t) _Pragma("unroll") for (int dt = 0; dt < 2; ++dt) _Pragma("unroll") for (int s2 = 0; s2 < 2; ++s2) { \
            const bf16* mp = Mb + (size_t)(nn) * 4096 + (size_t)(32 * d1t + r32) * 64 + 32 * dt + 16 * s2 + 4 * hh; mq[d1t][dt][s2][0] = *(const u32x2*)mp; mq[d1t][dt][s2][1] = *(const u32x2*)(mp + 8); } } while (0)
    RW_PREF(0);
    for (int n = 0; n < NCH; ++n) {
        bf16x8 bfr[2][2];
#pragma unroll
        for (int dt = 0; dt < 2; ++dt)
#pragma unroll
            for (int s2 = 0; s2 < 2; ++s2) { union { bf16x8 v; unsigned w[4]; } pf;
#pragma unroll
                for (int j = 0; j < 4; ++j) pf.w[j] = cvt_pk_bf16(st[dt][8 * s2 + 2 * j], st[dt][8 * s2 + 2 * j + 1]);
                bfr[dt][s2] = pf.v; }
        f32x16 nw[2];
#pragma unroll
        for (int d1t = 0; d1t < 2; ++d1t) {
#pragma unroll
            for (int g = 0; g < 4; ++g) { nw[d1t][4 * g] = bflo(nq[d1t][g].x); nw[d1t][4 * g + 1] = bfhi(nq[d1t][g].x); nw[d1t][4 * g + 2] = bflo(nq[d1t][g].y); nw[d1t][4 * g + 3] = bfhi(nq[d1t][g].y); }
#pragma unroll
            for (int dt = 0; dt < 2; ++dt)
#pragma unroll
                for (int s2 = 0; s2 < 2; ++s2) { union { bf16x8 v; u32x2 d[2]; } mf; mf.d[0] = mq[d1t][dt][s2][0]; mf.d[1] = mq[d1t][dt][s2][1]; nw[d1t] = mma32(mf.v, bfr[dt][s2], nw[d1t]); } }
        if (n + 1 < NCH) RW_PREF(n + 1);
#pragma unroll
        for (int d1t = 0; d1t < 2; ++d1t) { st[d1t] = nw[d1t];
#pragma unroll
            for (int g = 0; g < 4; ++g) { u32x2 w; w.x = cvt_pk_bf16(nw[d1t][4 * g], nw[d1t][4 * g + 1]); w.y = cvt_pk_bf16(nw[d1t][4 * g + 2], nw[d1t][4 * g + 3]); st_wt8(Nb + (size_t)n * 4096 + 32 * d1t + 8 * g + 4 * hh, w); } }
    }
#undef RW_PREF
}

constexpr int NS_KROW = 144, NS_VROW = 144;
constexpr int NS_KB = 64 * NS_KROW, NS_VB = 64 * NS_VROW;
constexpr int NS_K0 = 0, NS_V0 = 2 * NS_KB, NS_IMP = NS_V0 + 2 * NS_VB, NS_SEL = NS_IMP + 64 * 128 * 4, NS_END = NS_SEL + 64 * 4 * 4;
constexpr int NS_OUT = NS_END, NS_END2 = NS_OUT + 8 * 8192;
static_assert(NS_END2 <= MISC_OFF, "nsa lds");
struct NsaRow { float m, l; f32x16 o[2]; };
__device__ __forceinline__ void ns_load(const bf16* kb, const bf16* vb, size_t stride, int tid, u32x4& kr, u32x4& vr) {
    const int key = tid >> 3, ch = tid & 7; kr = *(const u32x4*)(kb + (size_t)key * stride + ch * 8); vr = *(const u32x4*)(vb + (size_t)key * stride + ch * 8);
}
__device__ __forceinline__ void ns_store(LAS unsigned char* Kb, LAS unsigned char* Vb, int tid, const u32x4& kr, const u32x4& vr) {
    const int key = tid >> 3, ch = tid & 7;
    *(LAS u32x4*)(Kb + key * NS_KROW + ch * 16) = kr;
    *(LAS u32x4*)(Vb + key * NS_VROW + ch * 16) = vr;
}
__device__ __forceinline__ void ns_qk(LAS unsigned char* Kb, const bf16x8 (&qf)[4], int r, int h2, f32x16 (&sacc)[2]) {
#pragma unroll
    for (int sub = 0; sub < 2; ++sub) { f32x16 a;
#pragma unroll
        for (int i = 0; i < 16; ++i) a[i] = 0.f;
#pragma unroll
        for (int kk = 0; kk < 4; ++kk) { const bf16x8 kf = *(const LAS bf16x8*)(Kb + (32 * sub + r) * NS_KROW + (8 * h2 + 16 * kk) * 2); a = __builtin_amdgcn_mfma_f32_32x32x16_bf16(kf, qf[kk], a, 0, 0, 0); }
        sacc[sub] = a; }
}
enum { NS_CMP = 0, NS_SEL_ = 1, NS_WIN = 2 };
template <int MODE> __device__ __forceinline__ bool ns_valid(int key, int t, bool blk_on) {
    if (MODE == NS_CMP) return 16 * key + 31 <= t;
    if (MODE == NS_SEL_) return blk_on && key <= t;
    return key <= t && key + 511 >= t;
}
template <int MODE>
__device__ __forceinline__ void ns_branch(Frame& F, const bf16* kbase, const bf16* vbase, size_t stride, int tile_lo, int tile_hi, const bf16x8 (&qf)[4], int t, int r, int h2,
                                          const unsigned (&selw)[4], NsaRow& R) {
    LAS unsigned char* L = F.lds;
    R.m = -1e30f; R.l = 0.f;
#pragma unroll
    for (int e = 0; e < 2; ++e)
#pragma unroll
        for (int i = 0; i < 16; ++i) R.o[e][i] = 0.f;
    if (tile_hi <= tile_lo) return;
    u32x4 kr, vr;
    ns_load(kbase + (size_t)tile_lo * 64 * stride, vbase + (size_t)tile_lo * 64 * stride, stride, F.tid, kr, vr);
    __syncthreads();
    ns_store(L + NS_K0, L + NS_V0, F.tid, kr, vr);
    __syncthreads();
    for (int ti = tile_lo; ti < tile_hi; ++ti) {
        const int buf = (ti - tile_lo) & 1;
        if (ti + 1 < tile_hi) ns_load(kbase + (size_t)(ti + 1) * 64 * stride, vbase + (size_t)(ti + 1) * 64 * stride, stride, F.tid, kr, vr);
        LAS unsigned char* Kb = L + NS_K0 + buf * NS_KB; LAS unsigned char* Vb = L + NS_V0 + buf * NS_VB;
        bool blk_on = true;
        if (MODE == NS_SEL_) blk_on = (selw[ti >> 5] >> (ti & 31)) & 1u;
        bool any;
        if (MODE == NS_CMP) any = 16 * (ti * 64) + 31 <= t; else if (MODE == NS_SEL_) any = blk_on && ti * 64 <= t; else any = (ti * 64 <= t) && (ti * 64 + 63 + 511 >= t);
        if (__ballot(any) != 0ull) {
            f32x16 sacc[2];
            ns_qk(Kb, qf, r, h2, sacc);
            bool full;
            { const int tmin = t - (r & 7), tmax = tmin + 7;
              if (MODE == NS_CMP) full = 16 * (ti * 64 + 63) + 31 <= tmin; else if (MODE == NS_SEL_) full = ti * 64 + 63 <= tmin; else full = (ti * 64 + 63 <= tmin) && (ti * 64 + 511 >= tmax); }
            float sc, rs = 0.f;
            if (full) {
                const bool rowon = (MODE != NS_SEL_) || blk_on;
                float m0 = sacc[0][0], m1 = sacc[1][0];
#pragma unroll
                for (int i = 1; i < 16; ++i) { m0 = fmaxf(m0, sacc[0][i]); m1 = fmaxf(m1, sacc[1][i]); }
                float mt = rowon ? fmaxf(m0, m1) : -1e30f;
                mt = fmaxf(mt, __shfl_xor(mt, 32));
                const float mn = fmaxf(R.m, mt); sc = __expf(R.m - mn);
                const float nb = -1.44269504f * (rowon ? mn : 1e30f);
#pragma unroll
                for (int sub = 0; sub < 2; ++sub)
#pragma unroll
                    for (int i = 0; i < 16; ++i) { const float p = __builtin_amdgcn_exp2f(__builtin_fmaf(sacc[sub][i], 1.44269504f, nb)); sacc[sub][i] = p; rs += p; }
                rs += __shfl_xor(rs, 32);
                R.l = R.l * sc + rs; R.m = mn;
            } else {
            float mt = -1e30f;
#pragma unroll
            for (int sub = 0; sub < 2; ++sub)
#pragma unroll
                for (int i = 0; i < 16; ++i) { const int key = ti * 64 + 32 * sub + (i & 3) + 8 * (i >> 2) + 4 * h2; const float sv = ns_valid<MODE>(key, t, blk_on) ? sacc[sub][i] : -1e30f; sacc[sub][i] = sv; mt = fmaxf(mt, sv); }
            mt = fmaxf(mt, __shfl_xor(mt, 32));
            const float mn = fmaxf(R.m, mt); sc = __expf(R.m - mn);
#pragma unroll
            for (int sub = 0; sub < 2; ++sub)
#pragma unroll
                for (int i = 0; i < 16; ++i) { const float sv = sacc[sub][i]; const float p = sv > -1e29f ? __expf(sv - mn) : 0.f; sacc[sub][i] = p; rs += p; }
            rs += __shfl_xor(rs, 32);
            R.l = R.l * sc + rs; R.m = mn;
            }
            if (__ballot(sc != 1.0f) != 0ull) {
#pragma unroll
                for (int e = 0; e < 2; ++e)
#pragma unroll
                    for (int i = 0; i < 16; ++i) R.o[e][i] *= sc; }
#pragma unroll
            for (int sub = 0; sub < 2; ++sub)
#pragma unroll
                for (int s2 = 0; s2 < 2; ++s2) {
                    union { bf16x8 v; unsigned w[4]; } pf;
#pragma unroll
                    for (int j = 0; j < 4; ++j) pf.w[j] = cvt_pk_bf16(sacc[sub][8 * s2 + 2 * j], sacc[sub][8 * s2 + 2 * j + 1]);
#pragma unroll
                    for (int e = 0; e < 2; ++e) {
                        const LAS unsigned char* vp = Vb + (32 * sub + 16 * s2 + 4 * h2 + ((F.lane & 15) >> 2)) * NS_VROW + (32 * e + 16 * ((F.lane >> 4) & 1) + 4 * (F.lane & 3)) * 2;
                        const s16x4 va = __builtin_amdgcn_ds_read_tr16_b64_v4i16((LAS s16x4*)vp), vb = __builtin_amdgcn_ds_read_tr16_b64_v4i16((LAS s16x4*)(vp + 8 * NS_VROW));
                        const bf16x8 vf = {va[0], va[1], va[2], va[3], vb[0], vb[1], vb[2], vb[3]};
                        R.o[e] = __builtin_amdgcn_mfma_f32_32x32x16_bf16(vf, pf.v, R.o[e], 0, 0, 0);
                    }
                }
        }
        if (ti + 1 < tile_hi) ns_store(L + NS_K0 + (buf ^ 1) * NS_KB, L + NS_V0 + (buf ^ 1) * NS_VB, F.tid, kr, vr);
        __syncthreads();
    }
}
__device__ __forceinline__ void ns_importance(Frame& F, const bf16* kbase, int ntiles, const bf16x8 (&qf)[4], int t, int r, int h2, float m, float inv_l) {
    LAS unsigned char* L = F.lds; LAS float* imp = (LAS float*)(L + NS_IMP);
    const int qrow = F.wave * 8 + (r & 7);
    u32x4 kr, vr;
    ns_load(kbase, kbase, 64, F.tid, kr, vr);
    __syncthreads();
    ns_store(L + NS_K0, L + NS_V0, F.tid, kr, vr);
    __syncthreads();
    for (int ti = 0; ti < ntiles; ++ti) {
        const int buf = ti & 1;
        if (ti + 1 < ntiles) ns_load(kbase + (size_t)(ti + 1) * 64 * 64, kbase + (size_t)(ti + 1) * 64 * 64, 64, F.tid, kr, vr);
        LAS unsigned char* Kb = L + NS_K0 + buf * NS_KB;
        f32x16 sacc[2];
        ns_qk(Kb, qf, r, h2, sacc);
#pragma unroll
        for (int sub = 0; sub < 2; ++sub)
#pragma unroll
            for (int g = 0; g < 4; ++g) {
                float p[4];
#pragma unroll
                for (int x = 0; x < 4; ++x) { const int key = ti * 64 + 32 * sub + x + 8 * g + 4 * h2; p[x] = (16 * key + 31 <= t) ? __expf(sacc[sub][4 * g + x] - m) * inv_l : 0.f; }
                float G = (p[0] + p[1]) + (p[2] + p[3]), E = p[3];
                G += __shfl_xor(G, 8); G += __shfl_xor(G, 16); E += __shfl_xor(E, 8); E += __shfl_xor(E, 16);
                const int jj = ti * 16 + 8 * sub + 2 * g + h2;
                if (r < 8) { atomicAdd((float*)(imp + qrow * 128 + jj), G); if (jj + 1 < 128) atomicAdd((float*)(imp + qrow * 128 + jj + 1), E); }
            }
        if (ti + 1 < ntiles) ns_store(L + NS_K0 + (buf ^ 1) * NS_KB, L + NS_V0 + (buf ^ 1) * NS_VB, F.tid, kr, vr);
        __syncthreads();
    }
}
__device__ __forceinline__ void nsa_unit(Frame& F, int b, int c) {
    const bf16* u = (const bf16*)(F.ws + WS_U); bf16* bo = (bf16*)(F.ws + WS_BO);
    const bf16* kcmp = (const bf16*)(F.ws + WS_KCMP) + (size_t)b * 512 * 64; const bf16* vcmp = (const bf16*)(F.ws + WS_VCMP) + (size_t)b * 512 * 64;
    LAS unsigned char* L = F.lds; LAS float* imp = (LAS float*)(L + NS_IMP); LAS unsigned* selL = (LAS unsigned*)(L + NS_SEL);
    int lane = F.lane; asm volatile("" : "+v"(lane));
    const int r = lane & 31, h2 = lane >> 5, head = r >> 3, ql = r & 7;
    const int t = 64 * c + 8 * F.wave + ql; const size_t row = (size_t)b * S + t;
    const bf16* ub = u + (size_t)b * S * UW;
    bf16x8 qf[4];
#pragma unroll
    for (int kk = 0; kk < 4; ++kk) { const u32x4 w = *(const u32x4*)(u + row * UW + U_NSA + head * 64 + 8 * h2 + 16 * kk); f32x4 a, bb; unpack8(w, a, bb);
        union { bf16x8 v; u32x4 q; } cv; cv.q = pack8(a * 0.125f, bb * 0.125f); qf[kk] = cv.v; }
    const float g_cmp = fsigmoid(ldu(u, row, U_NSA + 640 + head)), g_sel = fsigmoid(ldu(u, row, U_NSA + 644 + head)), g_win = fsigmoid(ldu(u, row, U_NSA + 648 + head));
    unsigned selw[4] = {0xffffffffu, 0xffffffffu, 0xffffffffu, 0xffffffffu};
    NsaRow R;
    const int ncmp_tiles = (4 * c + 3 + 63) >> 6;
    ns_branch<NS_CMP>(F, kcmp, vcmp, 64, 0, ncmp_tiles, qf, t, r, h2, selw, R);
    LAS f32x4* stash = (LAS f32x4*)(L + NS_OUT + F.wave * 8192) + lane;
    { const float inv = R.l > 0.f ? 1.0f / R.l : 0.f; const float gs = g_cmp * inv;
#pragma unroll
      for (int e = 0; e < 2; ++e)
#pragma unroll
        for (int g = 0; g < 4; ++g) stash[(e * 4 + g) * 64] = (f32x4){R.o[e][4 * g] * gs, R.o[e][4 * g + 1] * gs, R.o[e][4 * g + 2] * gs, R.o[e][4 * g + 3] * gs};
      if (c >= 15) {
        for (int i = F.tid; i < 64 * 128; i += NTHR) imp[i] = 0.f;
        __syncthreads();
        ns_importance(F, kcmp, ncmp_tiles, qf, t, r, h2, R.m, inv);
        for (int q8 = 0; q8 < 8; ++q8) { const int qrow = F.wave * 8 + q8;
            float sc0, sc1;
            { const int j0 = lane, j1 = lane + 64;
              const bool f0 = (j0 == 0) || (j0 == c) || (j0 == c - 1), f1 = (j1 == c) || (j1 == c - 1);
              sc0 = f0 ? 1e30f : (j0 <= c ? imp[qrow * 128 + j0] : -1e30f); sc1 = f1 ? 1e30f : (j1 <= c ? imp[qrow * 128 + j1] : -1e30f); }
            unsigned long long lo = 0ull, hi = 0ull;
            for (int it = 0; it < 16; ++it) {
                const float best = wave_max(fmaxf(sc0, sc1));
                const unsigned long long m0 = __ballot(sc0 == best), m1 = __ballot(sc1 == best);
                int idx; if (m0) idx = __builtin_ctzll(m0); else idx = 64 + __builtin_ctzll(m1);
                if (idx < 64) { lo |= 1ull << idx; if (lane == idx) sc0 = -3e38f; } else { hi |= 1ull << (idx - 64); if (lane == idx - 64) sc1 = -3e38f; }
            }
            if (lane == 0) { selL[qrow * 4 + 0] = (unsigned)lo; selL[qrow * 4 + 1] = (unsigned)(lo >> 32); selL[qrow * 4 + 2] = (unsigned)hi; selL[qrow * 4 + 3] = (unsigned)(hi >> 32); }
        }
        LDS_WAIT();
#pragma unroll
        for (int j = 0; j < 4; ++j) selw[j] = selL[(F.wave * 8 + ql) * 4 + j];
      }
    }
    ns_branch<NS_SEL_>(F, ub + U_NSA + 384, ub + U_NSA + 448, UW, 0, c + 1, qf, t, r, h2, selw, R);
    { const float gs = g_sel / R.l;
#pragma unroll
      for (int e = 0; e < 2; ++e)
#pragma unroll
        for (int g = 0; g < 4; ++g) { f32x4 a = stash[(e * 4 + g) * 64]; a += (f32x4){R.o[e][4 * g] * gs, R.o[e][4 * g + 1] * gs, R.o[e][4 * g + 2] * gs, R.o[e][4 * g + 3] * gs}; stash[(e * 4 + g) * 64] = a; } }
    ns_branch<NS_WIN>(F, ub + U_NSA + 512, ub + U_NSA + 576, UW, c >= 8 ? c - 8 : 0, c + 1, qf, t, r, h2, selw, R);
    f32x16 out[2];
    { const float gs = g_win / R.l;
#pragma unroll
      for (int e = 0; e < 2; ++e)
#pragma unroll
        for (int g = 0; g < 4; ++g) { const f32x4 a = stash[(e * 4 + g) * 64];
#pragma unroll
            for (int x = 0; x < 4; ++x) out[e][4 * g + x] = a[x] + R.o[e][4 * g + x] * gs; } }
#pragma unroll
    for (int e = 0; e < 2; ++e)
#pragma unroll
        for (int g = 0; g < 4; ++g) { u32x2 w; w.x = cvt_pk_bf16(out[e][4 * g], out[e][4 * g + 1]); w.y = cvt_pk_bf16(out[e][4 * g + 2], out[e][4 * g + 3]);
            *(u32x2*)(bo + row * 1024 + head * 64 + 32 * e + 8 * g + 4 * h2) = w; }
}

__device__ __forceinline__ void cmp2_item(Frame& F, int L, int item) {
    int lane = F.lane; asm volatile("" : "+v"(lane));
    const int kv = item & 1, it = (item >> 1) & 15, b = item >> 5, r32 = lane & 31, hh = lane >> 5;
    const bf16* w2T = (const bf16*)(F.ws + WS_CW2 + (size_t)L * 65536) + kv * 64 * 128;
    const bf16* hid = (const bf16*)(F.ws + WS_CMPH) + ((size_t)(b * 512 + 32 * it)) * 256 + kv * 128;
    bf16* outp = (bf16*)(F.ws + (kv ? WS_VCMP : WS_KCMP)) + ((size_t)(b * 512 + 32 * it + r32)) * 64;
    const bool live = (32 * it + r32) < NCMP;
#pragma unroll
    for (int et = 0; et < 2; ++et) { f32x16 acc = zero16();
#pragma unroll
        for (int ks = 0; ks < 8; ++ks) acc = mma32(frag_g(w2T, 128, 32 * et, 16 * ks, lane), frag_g(hid, 256, 0, 16 * ks, lane), acc);
#pragma unroll
        for (int g = 0; g < 4; ++g) { u32x2 w; w.x = live ? cvt_pk_bf16(acc[4 * g], acc[4 * g + 1]) : 0u; w.y = live ? cvt_pk_bf16(acc[4 * g + 2], acc[4 * g + 3]) : 0u;
            *(u32x2*)(outp + 32 * et + 8 * g + 4 * hh) = w; } }
}
#ifdef SK_RWM1
#define RWM1(x)
#else
#define RWM1(x) x
#endif
#ifdef SK_RWM3
#define RWM3(x)
#else
#define RWM3(x) x
#endif
#ifdef SK_RWSC
#define RWSC(x)
#else
#define RWSC(x) x
#endif
__device__ __forceinline__ void phase_m1(Frame& F0, int L, bf16* hgS, bf16* rtS) {
    Frame F = F0; asm volatile("" : "+v"(F.tid)); F.lane = F.tid & 63;
    { CmpSched Sd{(const char*)(F.ws + WS_U), (const char*)(F.ws + WS_CW1 + (size_t)L * MiB), F.bx};
      EpiCmp E{(bf16*)(F.ws + WS_CMPH), (const float*)(F.ws + WS_CW2 + (size_t)L * 65536 + 32768)};
      pg8::gemm_phase<EpiCmp, CmpSched, true>(F.lds + RING_OFF, Sd, E, (unsigned)(UW * 2), 128u); }
    LAS unsigned char* W = F.lds + F.wave * WREG;
    const int gw = F.bx * NWAVES + F.wave, NGW = F.G * NWAVES;
    for (int it = gw; it < 3 * 32 * NCH; it += NGW) { const int type = it % 3, q = it / 3, bh = q / NCH, n = q % NCH;
        if (type == 0) hgrn_chunk<false>(F, L, bh, n, W, hgS, (float*)(F.ws + WS_HGD)); else if (type == 1) ret_chunk<false>(F, L, bh, n, W, rtS); else { RWM1(rwkv_chunk<false>(F, L, bh, n, W)); } }
}
__device__ __forceinline__ void phase_scan(Frame& F0, int L, bf16* hgS, bf16* rtS) {
    Frame F = F0; asm volatile("" : "+v"(F.tid)); F.lane = F.tid & 63;
    if (F.tid < 256) {
        if (F.bx < 128) glin_scan_task(hgS, (const float*)(F.ws + WS_HGD), 0.f, F.bx >> 2, F.bx & 3, F.tid);
        else { const int k = F.bx - 128, h = (k >> 2) & 3; const float g = 1.0f - exp2f(-5.0f - (float)h); glin_scan_task(rtS, nullptr, exp2f(32.0f * __log2f(g)), k >> 2, k & 3, F.tid); }
    } else if (F.wave == 4) { if (F.bx < 64) { RWSC(rwkv_scan_task(F, F.bx >> 1, F.bx & 1)); } }
    else { for (int item = F.bx * 3 + (F.wave - 5); item < 256; item += F.G * 3) cmp2_item(F, L, item); }
}
__device__ __forceinline__ void phase_m3(Frame& F0, int L, bf16* hgS, bf16* rtS) {
    Frame F = F0; asm volatile("" : "+v"(F.tid)); F.lane = F.tid & 63;
    LAS unsigned char* W = F.lds + F.wave * WREG;
    const int gw = F.bx * NWAVES + F.wave, NGW = F.G * NWAVES;
    for (int it = gw; it < REP_ITEMS * 3 * 32 * NCH; it += NGW) { const int type = it % 3, q = (it / 3) % (32 * NCH), bh = q / NCH, n = q % NCH;
        if (type == 0) hgrn_chunk<true>(F, L, bh, n, W, hgS, nullptr); else if (type == 1) ret_chunk<true>(F, L, bh, n, W, rtS); else { RWM3(rwkv_chunk<true>(F, L, bh, n, W)); } }
    __syncthreads();
#ifndef SK_NSA
    for (int p = F.bx; p < REP_NSA * 512; p += F.G) { const int b = (p >> 6) & 7, cc = p & 63; nsa_unit(F, b, 127 - cc); nsa_unit(F, b, cc); }
#endif
}

__device__ __forceinline__ void phase_pconv(Frame& F0, int L) {
    Frame F = F0; asm volatile("" : "+v"(F.tid)); F.lane = F.tid & 63;
    const float* p = F.in[I_P] + (size_t)L * T * PLE; bf16* pbf = (bf16*)(F.ws + WS_PB);
    for (int r = F.bx * NWAVES + F.wave; r < T; r += F.G * NWAVES) { const f32x4 v = *((const f32x4*)(p + (size_t)r * PLE) + F.lane); u32x2 w; w.x = cvt_pk_bf16(v[0], v[1]); w.y = cvt_pk_bf16(v[2], v[3]); *((u32x2*)(pbf + (size_t)r * PLE) + F.lane) = w; }
}
__device__ __forceinline__ void phase_final_a(Frame& F0, const float* ss, float* rtab) {
    Frame F = F0; asm volatile("" : "+v"(F.tid)); F.lane = F.tid & 63;
    for (int r = F.bx * NTHR + F.tid; r < T; r += F.G * NTHR) rtab[r] = __builtin_amdgcn_rsqf(ss_row(ss, r) * (1.0f / D) + EPS);
}
__device__ __forceinline__ void phase_final_b(Frame& F0, const float* rtab, const bf16* hb) {
    Frame F = F0; asm volatile("" : "+v"(F.tid)); F.lane = F.tid & 63;
    const float* g = F.in[I_NORM_FINAL]; const int gw = F.bx * NWAVES + F.wave, NGW = F.G * NWAVES;
    for (int r = gw; r < T; r += NGW) { const float rs = rtab[r]; const u32x4* hr = (const u32x4*)(hb + (size_t)r * D) + F.lane; f32x4* orow = (f32x4*)(F.out + (size_t)r * D);
#pragma unroll
        for (int j = 0; j < 2; ++j) { f32x4 a, b; unpack8(hr[64 * j], a, b); const f32x4 g0 = *((const f32x4*)g + 2 * (F.lane + 64 * j)), g1 = *((const f32x4*)g + 2 * (F.lane + 64 * j) + 1);
            orow[2 * (F.lane + 64 * j)] = a * rs * g0; orow[2 * (F.lane + 64 * j) + 1] = b * rs * g1; } }
}

constexpr int PH_PER_LAYER = 9, N_PHASES = 1 + NL * PH_PER_LAYER + 2;
__global__ void __launch_bounds__(NTHR, 2) mega_fwd(Args args) {
    extern __shared__ __attribute__((aligned(16))) unsigned char lds_raw[];
    Frame F; F.lds = (LAS unsigned char*)lds_raw; F.tid = threadIdx.x; F.lane = F.tid & 63; F.wave = __builtin_amdgcn_readfirstlane(F.tid >> 6); F.G = gridDim.x; F.bx = blockIdx.x;
    F.in = args.in; F.out = args.out; F.ws = args.ws;
    volatile LAS unsigned* MISC = (volatile LAS unsigned*)(F.lds + MISC_OFF);
    if (F.tid < 32) MISC[F.tid] = 0u;
    __syncthreads();
    unsigned* ctl = (unsigned*)(F.ws + WS_CTL);
    XcdBarrier bar; bar.bar = ctl + CW_BAR; bar.x = 0; bar.st = nullptr;
    if (MK_N_LAUNCHES == 1) bar = xcd_barrier_post(ctl + CW_BAR, MISC + 8);
    const int lo = args.ph_lo, hi = args.ph_hi;
#define IN(k) (lo <= (k) && (k) < hi)
#define REPS(k) (((k) == REP_PHASE || (k) == REP_PHASE + 9) ? 2 : 1)
#define SEAM(k) do { if (IN(k) && IN((k) + 1)) xcd_barrier(bar); } while (0)
    float* ssb = F.out;
    LAS unsigned char* ring = F.lds + RING_OFF;

    #ifndef SK_PRO
    if (IN(0)) { phase_prologue(F); }
#endif
    SEAM(0);

    for (int L = 0; L < NL; ++L) {
        const int pb = 1 + L * PH_PER_LAYER;
        unsigned char* wl = F.ws + WS_W + (size_t)L * WL_STRIDE;
        bf16* hb_cur = (bf16*)(F.ws + ((L & 1) ? WS_HBB : WS_HBA)); bf16* hb_oth = (bf16*)(F.ws + ((L & 1) ? WS_HBA : WS_HBB));
        const float* ss_mix = ssb + (size_t)(3 * L) * T * 16; float* ss_ffn = ssb + (size_t)(3 * L + 1) * T * 16; float* ss_ple = ssb + (size_t)(3 * L + 2) * T * 16; float* ss_next = ssb + (size_t)(3 * L + 3) * T * 16;
#ifndef SK_G1
        for (int rep = 0; rep < REPS(pb + 0); ++rep) if (IN(pb + 0)) { PlainSched Sd{(const char*)hb_cur, (const char*)(wl + WL_IN), D * 2, D * 2, D / 64, T / 256, UW / 256, F.G, F.bx};
            EpiScaleBf16 E{(bf16*)(F.ws + WS_U), UW, ss_mix}; pg8::gemm_phase(ring, Sd, E); }
#endif
        SEAM(pb + 0);
        bf16* hgS = hb_oth; bf16* rtS = hb_oth + (size_t)32 * NCH * 4096;
        for (int rep = 0; rep < REPS(pb + 1); ++rep) if (IN(pb + 1)) phase_m1(F, L, hgS, rtS);
        SEAM(pb + 1);
#ifndef EXP_NOSCAN
        if (IN(pb + 2)) phase_scan(F, L, hgS, rtS);
#endif
        SEAM(pb + 2);
        if (IN(pb + 3)) phase_m3(F, L, hgS, rtS);
        SEAM(pb + 3);
#ifndef SK_G2
        for (int rep = 0; rep < REPS(pb + 4); ++rep) if (IN(pb + 4)) { PairSched Sd{(const char*)hb_cur, (const char*)(wl + WL_G), D * 2, D * 2, D / 64, (size_t)D * D * 2,
                                        (const char*)(F.ws + WS_BO), (const char*)(wl + WL_B), 1024 * 2, MW * 2, MW / 64, (size_t)MW * 2, (size_t)D * MW * 2, 4, T / 256, D / 256, F.G, F.bx};
            u32x4* scr = (u32x4*)(F.ws + WS_SCR + (size_t)F.bx * 262144);
            EpiMerge E{scr, scr + 8192, (bf16*)(F.ws + WS_MERGED), ss_mix, F.in[I_BGATE] + (size_t)L * 4 * D, 4}; pg8::gemm_phase(ring, Sd, E); }
#endif
        SEAM(pb + 4);
#ifndef SK_G3
        if (IN(pb + 5)) phase_pconv(F, L);
        if (IN(pb + 5)) { PlainSched Sd{(const char*)(F.ws + WS_MERGED), (const char*)(wl + WL_OUT), D * 2, D * 2, D / 64, T / 256, D / 256, F.G, F.bx};
            EpiResidual E{(L == 0) ? F.in[I_X] : nullptr, hb_cur, ss_ffn}; pg8::gemm_phase(ring, Sd, E); }
#endif
        SEAM(pb + 5);
#ifndef SK_G4
        for (int rep = 0; rep < REPS(pb + 6); ++rep) if (IN(pb + 6)) { PlainSched Sd{(const char*)hb_cur, (const char*)(wl + WL_FF), D * 2, D * 2, D / 64, T / 256, (2 * DFF) / 256, F.G, F.bx};
            EpiSwiGLU E{(bf16*)(F.ws + WS_FFH), ss_ffn}; pg8::gemm_phase(ring, Sd, E); }
#endif
        SEAM(pb + 6);
#ifndef SK_G5
        if (IN(pb + 7)) { PlainSched Sd{(const char*)(F.ws + WS_FFH), (const char*)(wl + WL_DN), DFF * 2, DFF * 2, DFF / 64, T / 256, D / 256, F.G, F.bx};
            EpiResidual E{nullptr, hb_cur, ss_ple}; pg8::gemm_phase(ring, Sd, E); }
#endif
        SEAM(pb + 7);
#ifndef SK_G6
        if (IN(pb + 8)) { PairSched Sd{(const char*)hb_cur, (const char*)(wl + WL_PG), D * 2, D * 2, D / 64, 0,
                                        (const char*)(F.ws + WS_PB), (const char*)(wl + WL_PP), PLE * 2, PLE * 2, PLE / 64, 0, 0, 1, T / 256, D / 256, F.G, F.bx};
            u32x4* scr = (u32x4*)(F.ws + WS_SCR + (size_t)F.bx * 262144);
            EpiPle E{scr, hb_cur, hb_oth, ss_ple, ss_next}; pg8::gemm_phase(ring, Sd, E); }
#endif
        SEAM(pb + 8);
    }
#ifndef SK_FIN
    if (IN(N_PHASES - 2)) phase_final_a(F, ssb + (size_t)(3 * NL) * T * 16, (float*)(F.ws + WS_CTL) + 65536);
    SEAM(N_PHASES - 2);
    if (IN(N_PHASES - 1)) phase_final_b(F, (const float*)(F.ws + WS_CTL) + 65536, (const bf16*)(F.ws + ((NL & 1) ? WS_HBB : WS_HBA)));
#endif
#undef IN
#undef SEAM
}

extern "C" void kernel_launch(void* const* d_in, const int* in_sizes, int n_in, void* d_out, int out_size, void* d_ws, size_t ws_size, hipStream_t stream) {
    static int grid = 0;
    if (grid == 0) {
        if (n_in != 37 || in_sizes[0] != T * D || out_size != T * D || ws_size < WS_END) { fprintf(stderr, "kernel_launch: unexpected shapes (n_in %d, ws %zu)\n", n_in, ws_size); grid = -1; return; }
        int dev = 0, cus = 0, per_cu = 0;
        if (hipGetDevice(&dev) != hipSuccess || hipDeviceGetAttribute(&cus, hipDeviceAttributeMultiprocessorCount, dev) != hipSuccess) { grid = -1; return; }
        if (hipFuncSetAttribute((const void*)mega_fwd, hipFuncAttributeMaxDynamicSharedMemorySize, LDS_BYTES) != hipSuccess) { fprintf(stderr, "kernel_launch: hipFuncSetAttribute failed\n"); grid = -1; return; }
        if (hipOccupancyMaxActiveBlocksPerMultiprocessor(&per_cu, (const void*)mega_fwd, NTHR, LDS_BYTES) != hipSuccess || per_cu < 1) { fprintf(stderr, "kernel_launch: occupancy query says %d\n", per_cu); }
        (void)hipGetLastError();
        grid = cus;
    }
    if (grid < 0) return;
    hipMemsetAsync((char*)d_ws + WS_CTL, 0, CTL_BYTES, stream);
    Args a{};
    for (int i = 0; i < 37; ++i) a.in[i] = (const float*)d_in[i];
    a.out = (float*)d_out; a.ws = (unsigned char*)d_ws;
    if (MK_N_LAUNCHES == 1) { a.ph_lo = 0; a.ph_hi = N_PHASES; hipLaunchKernelGGL(mega_fwd, dim3(grid), dim3(NTHR), LDS_BYTES, stream, a); }
    else for (int p = 0; p < N_PHASES; ++p) { a.ph_lo = p; a.ph_hi = p + 1; hipLaunchKernelGGL(mega_fwd, dim3(grid), dim3(NTHR), LDS_BYTES, stream, a); }
}
```

```cpp
#include <hip/hip_runtime.h>
#include <cstdio>
#include <cstdint>

#ifndef REP_ITEMS
#define REP_ITEMS 1
#endif
#ifndef REP_NSA
#define REP_NSA 1
#endif
#ifndef REP_PHASE
#define REP_PHASE (-1)
#endif
#ifndef MK_N_LAUNCHES
#define MK_N_LAUNCHES 1
#endif

#define LAS __attribute__((address_space(3)))
#define GAS __attribute__((address_space(1)))
typedef unsigned short bf16;
typedef short bf16x8 __attribute__((ext_vector_type(8)));
typedef float f32x4 __attribute__((ext_vector_type(4)));
typedef float f32x16 __attribute__((ext_vector_type(16)));
typedef unsigned u32x4 __attribute__((ext_vector_type(4)));
typedef unsigned u32x2 __attribute__((ext_vector_type(2)));
typedef short s16x4 __attribute__((ext_vector_type(4)));

constexpr int D = 1024, NB = 8, S = 8192, T = NB * S, NL = 2;
constexpr int NH = 4, HD = 64, MW = 256, DFF = 2816, PLE = 256;
constexpr int DIN = 3724, UW = 3840;
constexpr int U_NSA = 0, U_HG = 768, U_RT = 1792, U_RW = 2816;
constexpr int NCMP = 511, NSEL = 128;
constexpr float EPS = 1e-6f;

constexpr size_t MiB = 1u << 20;
constexpr size_t WS_CTL = 0, CTL_BYTES = 4 * MiB;
constexpr size_t WS_W = 4 * MiB;
constexpr size_t WL_IN = 0, WL_G = 8 * MiB, WL_B = 16 * MiB, WL_OUT = 18 * MiB, WL_FF = 20 * MiB, WL_DN = 31 * MiB, WL_PG = 37 * MiB, WL_PP = 39 * MiB, WL_STRIDE = 40 * MiB;
constexpr size_t WS_MISC = 84 * MiB;
constexpr size_t WS_ROPE = WS_MISC, WS_KCMP = WS_MISC + 2 * MiB, WS_VCMP = WS_MISC + 2 * MiB + 512 * 1024, WS_RWUP = WS_MISC + 3 * MiB;
constexpr size_t WS_HBA = 88 * MiB, WS_HBB = 216 * MiB;
constexpr size_t WS_BO = 344 * MiB;
constexpr size_t WS_U = 472 * MiB;
constexpr size_t WS_MERGED = WS_U, WS_SCR = WS_U + 416 * MiB;
constexpr size_t WS_FFH = WS_U;
constexpr size_t WS_PB = WS_U + 352 * MiB;
constexpr size_t WS_RWN = 952 * MiB;
constexpr size_t WS_HGD = 1016 * MiB;
constexpr size_t WS_RWM = WS_BO;
constexpr size_t WS_CMPH = 1018 * MiB;
constexpr size_t WS_CW1 = 1020 * MiB;
constexpr size_t WS_CW2 = 1022 * MiB;
constexpr size_t WS_END = 1024 * MiB;
constexpr int CH = 32, NCH = S / CH;
constexpr int CW_BAR = 4096;
constexpr int CW_C1 = 16384;
constexpr int NSS = 7;

#define LDS_WAIT() asm volatile("s_waitcnt lgkmcnt(0)" ::: "memory")
#define VM_WAIT() asm volatile("s_waitcnt vmcnt(0)" ::: "memory")
typedef __bf16 hbf16x2 __attribute__((ext_vector_type(2)));
typedef float f32x2v __attribute__((ext_vector_type(2)));
__device__ __forceinline__ unsigned cvt_pk_bf16(float lo, float hi) { const f32x2v v = {lo, hi}; const hbf16x2 b = __builtin_convertvector(v, hbf16x2); return __builtin_bit_cast(unsigned, b); }
__device__ __forceinline__ float bf2f(unsigned short b) { return __builtin_bit_cast(float, ((unsigned)b) << 16); }
__device__ __forceinline__ float bflo(unsigned w) { return __builtin_bit_cast(float, w << 16); }
__device__ __forceinline__ float bfhi(unsigned w) { return __builtin_bit_cast(float, w & 0xffff0000u); }
__device__ __forceinline__ float fsigmoid(float z) { return __builtin_amdgcn_rcpf(1.0f + __builtin_amdgcn_exp2f(-1.44269504f * z)); }
__device__ __forceinline__ float fsilu(float z) { return z * fsigmoid(z); }
__device__ __forceinline__ float wave_sum(float v) {
#pragma unroll
    for (int o = 1; o < 64; o <<= 1) v += __shfl_xor(v, o);
    return v;
}
__device__ __forceinline__ float wave_max(float v) {
#pragma unroll
    for (int o = 1; o < 64; o <<= 1) v = fmaxf(v, __shfl_xor(v, o));
    return v;
}

#define XB_TMO      128
#define XB_XCNT(j)  (256  + 64 * (j))
#define XB_XSUB(j)  (1280 + 64 * (j))
#define XB_XGEN(j)  (2304 + 64 * (j))
#define XB_TOP      3328
#define XB_TOPGEN   3392
#define XCD_BAR_WORDS 3456
#define XB_SPIN_CAP (1u << 24)
__device__ __forceinline__ unsigned xb_ld(unsigned* p)              { return __hip_atomic_load(p, __ATOMIC_RELAXED, __HIP_MEMORY_SCOPE_AGENT); }
__device__ __forceinline__ unsigned xb_add(unsigned* p, unsigned v) { return __hip_atomic_fetch_add(p, v, __ATOMIC_RELAXED, __HIP_MEMORY_SCOPE_AGENT); }
__device__ __forceinline__ unsigned xb_xcc_id() { return (unsigned)__builtin_amdgcn_s_getreg((3 << 11) | 20) & 0xFu; }
#define XB_SPIN(cond, bar) do { unsigned _sp = 0; while (cond) { __builtin_amdgcn_s_sleep(1); \
    if ((++_sp & 255u) == 0u) { if (xb_ld(&(bar)[XB_TMO])) break; if (_sp > XB_SPIN_CAP) { atomicAdd(&(bar)[XB_TMO], 1u); break; } } } } while (0)
struct XcdBarrier { unsigned* bar; unsigned x; volatile LAS unsigned* st; };
__device__ __forceinline__ XcdBarrier xcd_barrier_post(unsigned* bar, volatile LAS unsigned* st) {
    XcdBarrier b; b.bar = bar; b.x = xb_xcc_id(); b.st = st;
    if (threadIdx.x == 0) (void)xb_add(&bar[XB_XCNT(b.x)], 1u);
    return b;
}
__device__ __forceinline__ void xcd_barrier_complete(unsigned* bar, unsigned x, unsigned& nloc, unsigned& nx) {
    const unsigned G = gridDim.x * gridDim.y * gridDim.z;
    unsigned sum, cnt, mine, sp = 0u;
    for (;;) {
        sum = 0u; cnt = 0u; mine = 0u;
#pragma unroll
        for (unsigned j = 0; j < 16; ++j) { const unsigned c = xb_ld(&bar[XB_XCNT(j)]); sum += c; cnt += (c > 0u) ? 1u : 0u; mine = (j == x) ? c : mine; }
        if (sum == G) break;
        __builtin_amdgcn_s_sleep(1);
        if ((++sp & 255u) == 0u) { if (xb_ld(&bar[XB_TMO])) break; if (sp > XB_SPIN_CAP) { atomicAdd(&bar[XB_TMO], 1u); break; } }
    }
    nloc = mine > 0u ? mine : 1u; nx = cnt > 0u ? cnt : 1u;
}
__device__ __forceinline__ void xcd_barrier(const XcdBarrier& b) {
    asm volatile("s_waitcnt vmcnt(0)" ::: "memory");
    __syncthreads();
    if (threadIdx.x == 0) {
        unsigned* bar = b.bar;
        __builtin_amdgcn_s_waitcnt(0);
        unsigned nloc = b.st[0], nx = b.st[1];
        if (nloc == 0u) { xcd_barrier_complete(bar, b.x, nloc, nx); b.st[0] = nloc; b.st[1] = nx; }
        const unsigned old = xb_add(&bar[XB_XSUB(b.x)], 1u);
        const unsigned gen = old / nloc;
        if (old + 1u == (gen + 1u) * nloc) {
            __builtin_amdgcn_fence(__ATOMIC_RELEASE, "agent");
            asm volatile("s_waitcnt vmcnt(0)" ::: "memory");
            const unsigned og = xb_add(&bar[XB_TOP], 1u);
            const unsigned tg = og / nx;
            if (og + 1u == (tg + 1u) * nx) xb_add(&bar[XB_TOPGEN], 1u);
            else XB_SPIN(xb_ld(&bar[XB_TOPGEN]) == tg, bar);
            __builtin_amdgcn_fence(__ATOMIC_ACQUIRE, "agent");
            xb_add(&bar[XB_XGEN(b.x)], 1u);
            asm volatile("s_waitcnt vmcnt(0)" ::: "memory");
        } else {
            XB_SPIN(xb_ld(&bar[XB_XGEN(b.x)]) == gen, bar);
            __builtin_amdgcn_fence(__ATOMIC_ACQUIRE, "agent");
            asm volatile("s_waitcnt vmcnt(0)" ::: "memory");
        }
    }
    __syncthreads();
}

namespace pg8 {
constexpr int BM = 256, BK = 64, HALF = 128, HTB = HALF * BK * 2, STAGE_BYTES = 8 * HTB, NXCD = 8, WGM = 8;
__host__ __device__ __forceinline__ int lds_byte(int r, int c) { const int st = (r >> 4) * 2 + (c >> 5), rr = r & 15, cc = c & 31, ob = rr * 64 + cc * 2; return st * 1024 + (ob ^ (((ob >> 9) & 1) << 5)); }
__host__ __device__ __forceinline__ void stage_rc(int b, int& R, int& C) { const int st = b / 1024, sb = b % 1024, swz = sb ^ (((sb >> 9) & 1) << 5); R = (st >> 1) * 16 + swz / 64; C = (st & 1) * 32 + (swz % 64) / 2; }
__host__ __device__ __forceinline__ int perm32(int rho) { const int n = rho >> 4, i = rho & 15; return 8 * (i >> 2) + 4 * n + (i & 3); }

struct GU { const char* A; const char* B; unsigned lda, ldb; int nt; int pm, pn, kind, mi; };

__device__ __forceinline__ bool tile_of(int L, int nM, int nN, int& pm, int& pn) {
    const int nwg = nM * nN; if (L >= nwg) return false;
    int wgid = L; { const int q = nwg / NXCD, r = nwg % NXCD, xcd = wgid % NXCD, off = wgid / NXCD; wgid = (xcd < r ? xcd * (q + 1) : r * (q + 1) + (xcd - r) * q) + off; }
    const int nig = WGM * nN, gid = wgid / nig, fm = gid * WGM, gsz = (nM - fm) < WGM ? (nM - fm) : WGM;
    pm = fm + ((wgid % nig) % gsz); pn = (wgid % nig) / gsz; return true;
}

template <class Epi, class Sched, bool AX = false>
__device__ __forceinline__ void gemm_phase(LAS unsigned char* lds, const Sched& S, const Epi& E, unsigned ax_kstep = 0, unsigned ax_half = 0) {
    int tid = threadIdx.x; asm volatile("" : "+v"(tid));
    const int wid = __builtin_amdgcn_readfirstlane(tid >> 6), lane = tid & 63, wr = wid >> 2, wc = wid & 3, fr = lane & 15, fq = lane >> 4;
    unsigned RA[2], RB[2], C2[2];
#pragma unroll
    for (int i = 0; i < 2; ++i) { int R, C; stage_rc(tid * 16 + i * 8192, R, C); RA[i] = (unsigned)R; RB[i] = (unsigned)((R & ~31) + perm32(R & 31)); C2[i] = (unsigned)C * 2u; }
    const size_t kstep = (size_t)(BK * 2);
    const size_t kstepA = AX ? (size_t)ax_kstep : kstep;
#define PG8_HSA(ld) (AX ? (size_t)ax_half : (size_t)HALF * (ld))
    const unsigned ldsw = (unsigned)wid * 1024u;
    const int aoff = lds_byte(wr * 64 + fr, fq * 8), boff = lds_byte(wc * 32 + fr, fq * 8);
#define PG8_SA(b, h) (((b) * 2 + (h)) * HTB)
#define PG8_SB(b, h) ((4 + (b) * 2 + (h)) * HTB)
#define PG8_STAGE(bufoff, gbase, ld, RR) do { _Pragma("unroll") for (int _i = 0; _i < 2; ++_i) \
        __builtin_amdgcn_global_load_lds((const unsigned*)((const char*)(gbase) + (RR[_i] * (ld) + C2[_i])), (LAS unsigned*)(lds + (bufoff) + ldsw + _i * 8192), 16, 0, 0); } while (0)
#define PG8_LDA(dst, b, h) do { _Pragma("unroll") for (int m = 0; m < 4; ++m) _Pragma("unroll") for (int k = 0; k < 2; ++k) dst[m][k] = *(const LAS bf16x8*)(lds + PG8_SA(b, h) + aoff + m * 2048 + k * 1024); } while (0)
#define PG8_LDB(dst, b, h) do { _Pragma("unroll") for (int n = 0; n < 2; ++n) _Pragma("unroll") for (int k = 0; k < 2; ++k) dst[n][k] = *(const LAS bf16x8*)(lds + PG8_SB(b, h) + boff + n * 2048 + k * 1024); } while (0)
#define PG8_MMA(ai, bj, At, Bt) do { __builtin_amdgcn_s_setprio(1); _Pragma("unroll") for (int m = 0; m < 4; ++m) _Pragma("unroll") for (int n = 0; n < 2; ++n) _Pragma("unroll") for (int k = 0; k < 2; ++k) \
        acc[ai][bj][m][n] = __builtin_amdgcn_mfma_f32_16x16x32_bf16(Bt[n][k], At[m][k], acc[ai][bj][m][n], 0, 0, 0); __builtin_amdgcn_s_setprio(0); } while (0)
#define PG8_WAIT_V(n) asm volatile("s_waitcnt vmcnt(" #n ")" ::: "memory")
#define PG8_WAIT_L(n) asm volatile("s_waitcnt lgkmcnt(" #n ")" ::: "memory")
#define PG8_BAR __builtin_amdgcn_s_barrier()
#define PG8_SCHED __builtin_amdgcn_sched_barrier(0)
    GU cur, nxt; int ui = 0;
    if (!S.next(0, cur)) return;
    f32x4 acc[2][2][4][2];
#pragma unroll
    for (int a = 0; a < 2; ++a)
#pragma unroll
        for (int b = 0; b < 2; ++b)
#pragma unroll
            for (int m = 0; m < 4; ++m)
#pragma unroll
                for (int n = 0; n < 2; ++n) acc[a][b][m][n] = (f32x4){0.f, 0.f, 0.f, 0.f};
    bf16x8 At[4][2], B0[2][2], B1[2][2];
    const char* cA = cur.A; const char* cB = cur.B; unsigned clda = cur.lda, cldb = cur.ldb;
    PG8_STAGE(PG8_SB(0, 0), cB, cldb, RB); PG8_STAGE(PG8_SB(0, 1), cB + (size_t)HALF * cldb, cldb, RB); PG8_STAGE(PG8_SA(0, 0), cA, clda, RA); PG8_STAGE(PG8_SA(0, 1), cA + PG8_HSA(clda), clda, RA);
    if (wr == 1) PG8_BAR;
    PG8_WAIT_V(2); PG8_BAR;
    PG8_STAGE(PG8_SB(1, 0), cB + kstep, cldb, RB); PG8_STAGE(PG8_SA(1, 0), cA + kstepA, clda, RA); PG8_STAGE(PG8_SB(1, 1), cB + (size_t)HALF * cldb + kstep, cldb, RB);
    PG8_WAIT_V(6); PG8_BAR;
    for (;;) {
        const bool has_next = S.next(ui + 1, nxt);
        const char* nA = has_next ? nxt.A : cA; const char* nB = has_next ? nxt.B : cB;
        const unsigned nlda = has_next ? nxt.lda : clda, nldb = has_next ? nxt.ldb : cldb;
        const int nt = cur.nt;
        for (int t = 0; t < nt; t += 2) {
            const bool last = (t == nt - 2);
            const char* a1 = cA + (size_t)(t + 1) * kstepA;
            const char* a2 = last ? nA : cA + (size_t)(t + 2) * kstepA; const char* b2 = last ? nB : cB + (size_t)(t + 2) * kstep;
            const unsigned lda2 = last ? nlda : clda, ldb2 = last ? nldb : cldb;
            const char* a3 = a2 + kstepA; const char* b3 = b2 + kstep;
            PG8_LDB(B0, 0, 0); PG8_LDB(B1, 0, 1); PG8_SCHED; PG8_LDA(At, 0, 0); PG8_STAGE(PG8_SA(1, 1), a1 + PG8_HSA(clda), clda, RA);
            PG8_WAIT_V(8); PG8_WAIT_L(0); PG8_BAR; PG8_MMA(0, 0, At, B0); PG8_MMA(0, 1, At, B1); PG8_BAR; PG8_SCHED;
            PG8_LDA(At, 0, 1); PG8_STAGE(PG8_SB(0, 0), b2, ldb2, RB); PG8_STAGE(PG8_SB(0, 1), b2 + (size_t)HALF * ldb2, ldb2, RB); PG8_STAGE(PG8_SA(0, 0), a2, lda2, RA);
            PG8_WAIT_V(8); PG8_WAIT_L(0); PG8_BAR; PG8_MMA(1, 0, At, B0); PG8_MMA(1, 1, At, B1); PG8_BAR; PG8_SCHED;
            PG8_LDB(B0, 1, 0); PG8_LDB(B1, 1, 1); PG8_SCHED; PG8_LDA(At, 1, 0); PG8_STAGE(PG8_SA(0, 1), a2 + PG8_HSA(lda2), lda2, RA);
            PG8_WAIT_V(8); PG8_WAIT_L(0); PG8_BAR; PG8_MMA(0, 0, At, B0); PG8_MMA(0, 1, At, B1); PG8_BAR; PG8_SCHED;
            PG8_LDA(At, 1, 1); PG8_STAGE(PG8_SB(1, 0), b3, ldb2, RB); PG8_STAGE(PG8_SB(1, 1), b3 + (size_t)HALF * ldb2, ldb2, RB); PG8_STAGE(PG8_SA(1, 0), a3, lda2, RA);
            PG8_WAIT_V(8); PG8_WAIT_L(0); PG8_BAR; PG8_MMA(1, 0, At, B0); PG8_MMA(1, 1, At, B1); PG8_BAR; PG8_SCHED;
        }
        if (wr == 0) PG8_BAR;
        E(acc, cur, wr, wc, fr, fq);
        if (!has_next) break;
#pragma unroll
        for (int a = 0; a < 2; ++a)
#pragma unroll
            for (int b = 0; b < 2; ++b)
#pragma unroll
                for (int m = 0; m < 4; ++m)
#pragma unroll
                    for (int n = 0; n < 2; ++n) acc[a][b][m][n] = (f32x4){0.f, 0.f, 0.f, 0.f};
        cur = nxt; cA = nA; cB = nB; clda = nlda; cldb = nldb; ++ui;
        if (wr == 1) PG8_BAR;
    }
    PG8_WAIT_V(0);
    PG8_BAR;
#undef PG8_SA
#undef PG8_HSA
#undef PG8_SB
#undef PG8_STAGE
#undef PG8_LDA
#undef PG8_LDB
#undef PG8_MMA
#undef PG8_WAIT_V
#undef PG8_WAIT_L
#undef PG8_BAR
#undef PG8_SCHED
}
}
using pg8::GU;

struct PlainSched {
    const char* A; const char* B; unsigned lda, ldb; int nt, nM, nN, G, c;
    __device__ __forceinline__ bool next(int i, GU& u) const {
        int pm, pn; if (!pg8::tile_of(i * G + c, nM, nN, pm, pn)) return false;
        u.A = A + (size_t)pm * 256 * lda; u.B = B + (size_t)pn * 256 * ldb; u.lda = lda; u.ldb = ldb; u.nt = nt; u.pm = pm; u.pn = pn; u.kind = 0; u.mi = 0; return true;
    }
};
struct PairSched {
    const char* A1; const char* B1; unsigned lda1, ldb1; int nt1; size_t b1_mstride;
    const char* A2; const char* B2; unsigned lda2, ldb2; int nt2; size_t a2_mstride, b2_mstride;
    int nm, nM, nN, G, c;
    __device__ __forceinline__ bool next(int i, GU& u) const {
        const int per = 2 * nm, ti = i / per, sub = i - ti * per, m = sub >> 1, kind = sub & 1;
        int pm, pn; if (!pg8::tile_of(ti * G + c, nM, nN, pm, pn)) return false;
        u.pm = pm; u.pn = pn; u.kind = kind; u.mi = m;
        if (kind == 0) { u.A = A2 + (size_t)m * a2_mstride + (size_t)pm * 256 * lda2; u.B = B2 + (size_t)m * b2_mstride + (size_t)pn * 256 * ldb2; u.lda = lda2; u.ldb = ldb2; u.nt = nt2; }
        else { u.A = A1 + (size_t)pm * 256 * lda1; u.B = B1 + (size_t)m * b1_mstride + (size_t)pn * 256 * ldb1; u.lda = lda1; u.ldb = ldb1; u.nt = nt1; }
        return true;
    }
};

constexpr int RSTD_OFF = 131072;
__device__ __forceinline__ float ss_row(const float* ssp, int row) {
    const f32x4* p = (const f32x4*)(ssp + (size_t)row * 16); const f32x4 a = p[0], b = p[1], c = p[2], d = p[3];
    return (((a[0] + a[1]) + (a[2] + a[3])) + ((b[0] + b[1]) + (b[2] + b[3]))) + (((c[0] + c[1]) + (c[2] + c[3])) + ((d[0] + d[1]) + (d[2] + d[3])));
}
__device__ __forceinline__ void rstd_table(const float* ssp, int pm) {
    extern __shared__ __attribute__((aligned(16))) unsigned char lds_tab_raw[];
    LAS float* tab = (LAS float*)((LAS unsigned char*)lds_tab_raw + RSTD_OFF);
    const int t = threadIdx.x; if (t < 256) tab[t] = __builtin_amdgcn_rsqf(ss_row(ssp, pm * 256 + t) * (1.0f / D) + EPS);
    asm volatile("s_waitcnt lgkmcnt(0)" ::: "memory"); __builtin_amdgcn_s_barrier(); asm volatile("" ::: "memory");
}
__device__ __forceinline__ float rstd_tab(int lr) { extern __shared__ __attribute__((aligned(16))) unsigned char lds_tab_raw[]; return ((const LAS float*)((LAS unsigned char*)lds_tab_raw + RSTD_OFF))[lr]; }
__device__ __forceinline__ u32x4 pack8(const f32x4& a, const f32x4& b) { u32x4 w; w.x = cvt_pk_bf16(a[0], a[1]); w.y = cvt_pk_bf16(a[2], a[3]); w.z = cvt_pk_bf16(b[0], b[1]); w.w = cvt_pk_bf16(b[2], b[3]); return w; }
__device__ __forceinline__ void unpack8(const u32x4& w, f32x4& a, f32x4& b) { a = (f32x4){bflo(w.x), bfhi(w.x), bflo(w.y), bfhi(w.y)}; b = (f32x4){bflo(w.z), bfhi(w.z), bflo(w.w), bfhi(w.w)}; }

struct CmpSched {
    const char* U; const char* B; int c;
    __device__ __forceinline__ bool next(int i, GU& u) const {
        if (i > 0 || c >= 32) return false;
        const int b = c >> 2, q = c & 3;
        u.A = U + ((size_t)(b * S + 2048 * q) * UW + U_NSA + 256) * 2; u.B = B; u.lda = 16 * UW * 2; u.ldb = 4096; u.nt = 32; u.pm = b; u.pn = q; u.kind = 0; u.mi = 0; return true;
    }
};
struct EpiCmp {
    bf16* H;
    __device__ __forceinline__ void operator()(const f32x4 (&acc)[2][2][4][2], const GU& u, int wr, int wc, int fr, int fq) const {
        const int col = wc * 32 + 8 * fq;
        extern __shared__ __attribute__((aligned(16))) unsigned char lds_c1_raw[]; const LAS float* c1 = (const LAS float*)((LAS unsigned char*)lds_c1_raw + RSTD_OFF + 1024);
#pragma unroll
        for (int kv = 0; kv < 2; ++kv) { const f32x4 b0 = *(const LAS f32x4*)(c1 + kv * 128 + col), b1 = *(const LAS f32x4*)(c1 + kv * 128 + col + 4);
#pragma unroll
            for (int m = 0; m < 4; ++m) { const int i = u.pn * 128 + wr * 64 + m * 16 + fr; f32x4 v0, v1;
#pragma unroll
                for (int j = 0; j < 4; ++j) { v0[j] = fsilu(acc[kv][kv][m][0][j] + b0[j]); v1[j] = fsilu(acc[kv][kv][m][1][j] + b1[j]); }
                *(u32x4*)(H + ((size_t)(u.pm * 512 + i)) * 256 + kv * 128 + col) = pack8(v0, v1); } }
    }
};
struct EpiScaleBf16 {
    bf16* O; int ldo; const float* ss;
    __device__ __forceinline__ void operator()(const f32x4 (&acc)[2][2][4][2], const GU& u, int wr, int wc, int fr, int fq) const {
        rstd_table(ss, u.pm);
        const int row0 = u.pm * 256 + wr * 64 + fr, col0 = u.pn * 256 + wc * 32 + 8 * fq;
#pragma unroll
        for (int ai = 0; ai < 2; ++ai)
#pragma unroll
            for (int m = 0; m < 4; ++m) { const int r = row0 + ai * 128 + m * 16; const float rs = rstd_tab(wr * 64 + fr + ai * 128 + m * 16); bf16* rowp = O + (size_t)r * ldo + col0;
#pragma unroll
                for (int bj = 0; bj < 2; ++bj) *(u32x4*)(rowp + bj * 128) = pack8(acc[ai][bj][m][0] * rs, acc[ai][bj][m][1] * rs); }
    }
};
struct EpiSwiGLU {
    bf16* O; const float* ss;
    __device__ __forceinline__ void operator()(const f32x4 (&acc)[2][2][4][2], const GU& u, int wr, int wc, int fr, int fq) const {
        rstd_table(ss, u.pm);
        const int row0 = u.pm * 256 + wr * 64 + fr, col0 = u.pn * 128 + wc * 32 + 8 * fq;
#pragma unroll
        for (int ai = 0; ai < 2; ++ai)
#pragma unroll
            for (int m = 0; m < 4; ++m) { const int r = row0 + ai * 128 + m * 16; const float rs = rstd_tab(wr * 64 + fr + ai * 128 + m * 16);
                f32x4 v[2];
#pragma unroll
                for (int n = 0; n < 2; ++n)
#pragma unroll
                    for (int j = 0; j < 4; ++j) { const float g = acc[ai][0][m][n][j] * rs, up = acc[ai][1][m][n][j] * rs; v[n][j] = fsilu(g) * up; }
                *(u32x4*)(O + (size_t)r * DFF + col0) = pack8(v[0], v[1]); }
    }
};
struct EpiResidual {
    const float* Hin32; bf16* HB; float* ss_out;
    __device__ __forceinline__ void operator()(const f32x4 (&acc)[2][2][4][2], const GU& u, int wr, int wc, int fr, int fq) const {
        const int row0 = u.pm * 256 + wr * 64 + fr, col0 = u.pn * 256 + wc * 32 + 8 * fq;
#pragma unroll
        for (int ai = 0; ai < 2; ++ai)
#pragma unroll
            for (int m = 0; m < 4; ++m) { const int r = row0 + ai * 128 + m * 16; float s2 = 0.f;
#pragma unroll
                for (int bj = 0; bj < 2; ++bj) { const size_t o = (size_t)r * D + col0 + bj * 128;
                    f32x4 h0, h1;
                    if (Hin32) { h0 = *(const f32x4*)(Hin32 + o); h1 = *(const f32x4*)(Hin32 + o + 4); } else unpack8(*(const u32x4*)(HB + o), h0, h1);
                    h0 += acc[ai][bj][m][0]; h1 += acc[ai][bj][m][1];
                    *(u32x4*)(HB + o) = pack8(h0, h1);
                    s2 += (h0[0] * h0[0] + h0[1] * h0[1]) + (h0[2] * h0[2] + h0[3] * h0[3]) + (h1[0] * h1[0] + h1[1] * h1[1]) + (h1[2] * h1[2] + h1[3] * h1[3]); }
                s2 += __shfl_xor(s2, 16); s2 += __shfl_xor(s2, 32);
                if (fq == 0) ss_out[(size_t)r * 16 + u.pn * 4 + wc] = s2;
                if (m == 3) asm volatile("" ::: "memory"); }
    }
};
#define SLOT(ai, m, bj) (((((ai) * 4 + (m)) >> 1) * 512 + tid) * 4 + (((m) & 1) * 2 + (bj)))
struct EpiMerge {
    u32x4* scrP; u32x4* scrM; bf16* M; const float* ss; const float* bias;
    int nm;
    __device__ __forceinline__ void operator()(const f32x4 (&acc)[2][2][4][2], const GU& u, int wr, int wc, int fr, int fq) const {
        int tid = threadIdx.x; asm volatile("" : "+v"(tid));
        if (u.kind == 0) {
#pragma unroll
            for (int ai = 0; ai < 2; ++ai)
#pragma unroll
                for (int m = 0; m < 4; ++m)
#pragma unroll
                    for (int bj = 0; bj < 2; ++bj) scrP[SLOT(ai, m, bj)] = pack8(acc[ai][bj][m][0], acc[ai][bj][m][1]);
            return;
        }
        const int row0 = u.pm * 256 + wr * 64 + fr, col0 = u.pn * 256 + wc * 32 + 8 * fq;
        rstd_table(ss, u.pm);
        const float* bp = bias + (size_t)u.mi * D + col0;
        f32x4 bv[2][2];
#pragma unroll
        for (int bj = 0; bj < 2; ++bj) { bv[bj][0] = *(const f32x4*)(bp + bj * 128); bv[bj][1] = *(const f32x4*)(bp + bj * 128 + 4); }
#pragma unroll
        for (int ai = 0; ai < 2; ++ai)
#pragma unroll
            for (int m = 0; m < 4; ++m) { const int r = row0 + ai * 128 + m * 16; const float rs = rstd_tab(wr * 64 + fr + ai * 128 + m * 16);
#pragma unroll
                for (int bj = 0; bj < 2; ++bj) { const int slot = SLOT(ai, m, bj);
                    f32x4 p0, p1; unpack8(scrP[slot], p0, p1);
                    f32x4 v0, v1;
#pragma unroll
                    for (int j = 0; j < 4; ++j) { v0[j] = fsigmoid(acc[ai][bj][m][0][j] * rs + bv[bj][0][j]) * p0[j]; v1[j] = fsigmoid(acc[ai][bj][m][1][j] * rs + bv[bj][1][j]) * p1[j]; }
                    if (u.mi > 0) { f32x4 q0, q1; unpack8(scrM[slot], q0, q1); v0 += q0; v1 += q1; }
                    const u32x4 w = pack8(v0, v1);
                    if (u.mi == nm - 1) *(u32x4*)(M + (size_t)r * D + col0 + bj * 128) = w; else scrM[slot] = w; }
                asm volatile("" ::: "memory"); }
    }
};
struct EpiPle {
    u32x4* scrP; const bf16* Hcur; bf16* HBout; const float* ss; float* ss_out;
    __device__ __forceinline__ void operator()(const f32x4 (&acc)[2][2][4][2], const GU& u, int wr, int wc, int fr, int fq) const {
        int tid = threadIdx.x; asm volatile("" : "+v"(tid));
        if (u.kind == 0) {
#pragma unroll
            for (int ai = 0; ai < 2; ++ai)
#pragma unroll
                for (int m = 0; m < 4; ++m)
#pragma unroll
                    for (int bj = 0; bj < 2; ++bj) scrP[SLOT(ai, m, bj)] = pack8(acc[ai][bj][m][0], acc[ai][bj][m][1]);
            return;
        }
        rstd_table(ss, u.pm);
        const int row0 = u.pm * 256 + wr * 64 + fr, col0 = u.pn * 256 + wc * 32 + 8 * fq;
#pragma unroll
        for (int ai = 0; ai < 2; ++ai)
#pragma unroll
            for (int m = 0; m < 4; ++m) { const int r = row0 + ai * 128 + m * 16; const float rs = rstd_tab(wr * 64 + fr + ai * 128 + m * 16); float s2 = 0.f;
#pragma unroll
                for (int bj = 0; bj < 2; ++bj) { const int slot = SLOT(ai, m, bj); const size_t o = (size_t)r * D + col0 + bj * 128;
                    f32x4 p0, p1; unpack8(scrP[slot], p0, p1);
                    f32x4 h0, h1; unpack8(*(const u32x4*)(Hcur + o), h0, h1);
#pragma unroll
                    for (int j = 0; j < 4; ++j) { h0[j] += fsigmoid(acc[ai][bj][m][0][j] * rs) * p0[j]; h1[j] += fsigmoid(acc[ai][bj][m][1][j] * rs) * p1[j]; }
                    *(u32x4*)(HBout + o) = pack8(h0, h1);
                    s2 += (h0[0] * h0[0] + h0[1] * h0[1]) + (h0[2] * h0[2] + h0[3] * h0[3]) + (h1[0] * h1[0] + h1[1] * h1[1]) + (h1[2] * h1[2] + h1[3] * h1[3]); }
                s2 += __shfl_xor(s2, 16); s2 += __shfl_xor(s2, 32);
                if (fq == 0) ss_out[(size_t)r * 16 + u.pn * 4 + wc] = s2;
                asm volatile("" ::: "memory"); }
    }
};

constexpr int NWAVES = 8, NTHR = 512;
constexpr int RING_OFF = 0, RING_BYTES = 131072, WREG = 19456, MISC_OFF = 8 * WREG;
constexpr int LDS_BYTES = MISC_OFF + 256;
static_assert(MISC_OFF + 128 <= LDS_BYTES, "lds");
struct Args { const float* in[37]; float* out; unsigned char* ws; int ph_lo, ph_hi; };
struct Frame {
    LAS unsigned char* lds; int tid, lane, wave, G, bx;
    const float* const* in; float* out; unsigned char* ws;
};
enum { I_X = 0, I_P, I_NORM_MIX, I_W_IN, I_POS_K, I_POS_V, I_CK1, I_CK2, I_CV1, I_CV2, I_LB, I_HG_NORM, I_RT_G, I_RT_B, I_MU, I_W0, I_WUP, I_A0, I_AUP, I_GUP, I_KK, I_KA, I_RK,
       I_RW_G, I_RW_B, I_WBR, I_WGATE, I_BGATE, I_WOUT, I_NORM_FFN, I_FFG, I_FFU, I_FFD, I_NORM_PLE, I_PLEG, I_PLEP, I_NORM_FINAL };

template <class ColMap>
__device__ __forceinline__ void transpose_item(const float* W, int ldw, int K, const float* scale, bf16* WT, LAS float* scr, int item, int nblk, int lane, const ColMap& cm) {
    const int kb = item / nblk, nb = item % nblk, k0 = 64 * kb, n0 = 32 * nb;
    const int sc = cm(n0 + (lane & 31));
#pragma unroll 8
    for (int i = 0; i < 32; ++i) { const int kk = 2 * i + (lane >> 5); float v = 0.f; if (sc >= 0) { v = W[(size_t)(k0 + kk) * ldw + sc]; if (scale) v *= scale[k0 + kk]; } scr[kk * 33 + (lane & 31)] = v; }
    LDS_WAIT();
    const int c = lane & 7;
#pragma unroll
    for (int j = 0; j < 4; ++j) { const int n = (lane >> 3) + 8 * j; const LAS float* s = scr + (8 * c) * 33 + n;
        u32x4 o; o.x = cvt_pk_bf16(s[0 * 33], s[1 * 33]); o.y = cvt_pk_bf16(s[2 * 33], s[3 * 33]); o.z = cvt_pk_bf16(s[4 * 33], s[5 * 33]); o.w = cvt_pk_bf16(s[6 * 33], s[7 * 33]);
        *(u32x4*)(WT + (size_t)(n0 + n) * K + k0 + 8 * c) = o; }
    LDS_WAIT();
}
struct CmIdent { __device__ __forceinline__ int operator()(int n) const { return n; } };
struct CmWin { __device__ __forceinline__ int operator()(int n) const { return n < 652 ? n : (n < 768 ? -1 : n - 116); } };
struct CmFF { __device__ __forceinline__ int operator()(int n) const { return (n >> 8) * 128 + (n & 127); } };

__device__ __forceinline__ void phase_prologue(Frame& F0) {
    Frame F = F0; asm volatile("" : "+v"(F.tid)); F.lane = F.tid & 63;
    LAS float* scr = (LAS float*)(F.lds + F.wave * WREG);
    const int gw = F.bx * NWAVES + F.wave, NGW = F.G * NWAVES;
    int dbase = 0;
#define DEAL(var, n) for (int _n = (n), var = (int)((unsigned)(gw + NGW - (dbase % NGW)) % (unsigned)NGW), _once = ((dbase += _n), 0); var < _n; var += NGW)
    for (int L = 0; L < NL; ++L) {
        unsigned char* wl = F.ws + WS_W + (size_t)L * WL_STRIDE;
        const float* g_mix = F.in[I_NORM_MIX] + L * D; const float* g_ffn = F.in[I_NORM_FFN] + L * D; const float* g_ple = F.in[I_NORM_PLE] + L * D;
        { const int nblk = UW / 32, items = (D / 64) * nblk; const float* W = F.in[I_W_IN] + (size_t)L * D * DIN;
          DEAL(it, items) transpose_item(W, DIN, D, g_mix, (bf16*)(wl + WL_IN), scr, it, nblk, F.lane, CmWin()); }
        for (int m = 0; m < 4; ++m) { const int nblk = D / 32, items = (D / 64) * nblk; const float* W = F.in[I_WGATE] + ((size_t)L * 4 + m) * D * D;
          DEAL(it, items) transpose_item(W, D, D, g_mix, (bf16*)(wl + WL_G) + (size_t)m * D * D, scr, it, nblk, F.lane, CmIdent()); }
        for (int m = 0; m < 4; ++m) { const int nblk = D / 32, items = (MW / 64) * nblk; const float* W = F.in[I_WBR] + ((size_t)L * 4 + m) * MW * D;
          DEAL(it, items) transpose_item(W, D, MW, nullptr, (bf16*)(wl + WL_B) + (size_t)m * D * MW, scr, it, nblk, F.lane, CmIdent()); }
        { const int nblk = D / 32, items = (D / 64) * nblk; const float* W = F.in[I_WOUT] + (size_t)L * D * D;
          DEAL(it, items) transpose_item(W, D, D, nullptr, (bf16*)(wl + WL_OUT), scr, it, nblk, F.lane, CmIdent()); }
        { const int nblk = (2 * DFF) / 32, items = (D / 64) * nblk; const float* Wg = F.in[I_FFG] + (size_t)L * D * DFF; const float* Wu = F.in[I_FFU] + (size_t)L * D * DFF;
          DEAL(it, items) { const int nb = it % nblk; const bool up = ((nb * 32) & 128) != 0; transpose_item(up ? Wu : Wg, DFF, D, g_ffn, (bf16*)(wl + WL_FF), scr, it, nblk, F.lane, CmFF()); } }
        { const int nblk = D / 32, items = (DFF / 64) * nblk; const float* W = F.in[I_FFD] + (size_t)L * DFF * D;
          DEAL(it, items) transpose_item(W, D, DFF, nullptr, (bf16*)(wl + WL_DN), scr, it, nblk, F.lane, CmIdent()); }
        { const int nblk = D / 32, items = (D / 64) * nblk; const float* W = F.in[I_PLEG] + (size_t)L * D * D;
          DEAL(it, items) transpose_item(W, D, D, g_ple, (bf16*)(wl + WL_PG), scr, it, nblk, F.lane, CmIdent()); }
        { const int nblk = D / 32, items = (PLE / 64) * nblk; const float* W = F.in[I_PLEP] + (size_t)L * PLE * D;
          DEAL(it, items) transpose_item(W, D, PLE, nullptr, (bf16*)(wl + WL_PP), scr, it, nblk, F.lane, CmIdent()); }
    }
    for (int L = 0; L < NL; ++L) for (int kv = 0; kv < 2; ++kv) {
        const float* w1 = F.in[kv ? I_CV1 : I_CK1] + (size_t)L * 2048 * 128; const float* w2 = F.in[kv ? I_CV2 : I_CK2] + (size_t)L * 128 * 64;
        bf16* w1T = (bf16*)(F.ws + WS_CW1 + (size_t)L * MiB) + (size_t)kv * 128 * 2048; bf16* w2T = (bf16*)(F.ws + WS_CW2 + (size_t)L * 65536) + kv * 64 * 128;
        DEAL(it, 128) transpose_item(w1, 128, 2048, nullptr, w1T, scr, it, 4, F.lane, CmIdent());
        DEAL(it, 4) transpose_item(w2, 64, 128, nullptr, w2T, scr, it, 2, F.lane, CmIdent());
        DEAL(tk, 64) { const int hf = tk & 1, jq = tk >> 1; const float* pos = F.in[kv ? I_POS_V : I_POS_K] + (size_t)L * 2048; float a = 0.f;
#pragma unroll 8
            for (int j = 64 * jq; j < 64 * jq + 64; ++j) a += pos[j] * w1[(size_t)j * 128 + hf * 64 + F.lane];
            ((float*)(F.ws + WS_CW2 + (size_t)L * 65536 + 32768))[(kv * 32 + jq) * 128 + hf * 64 + F.lane] = a; } }
#undef DEAL
    { const float* x = F.in[I_X]; bf16* hb = (bf16*)(F.ws + WS_HBA); float* ss0 = F.out;
      for (int r = gw; r < T; r += NGW) { const f32x4* xr = (const f32x4*)(x + (size_t)r * D) + F.lane; float s = 0.f;
#pragma unroll
        for (int j = 0; j < 4; ++j) { const f32x4 v = xr[64 * j]; s += (v[0] * v[0] + v[1] * v[1]) + (v[2] * v[2] + v[3] * v[3]);
            u32x2 w; w.x = cvt_pk_bf16(v[0], v[1]); w.y = cvt_pk_bf16(v[2], v[3]); *((u32x2*)(hb + (size_t)r * D) + F.lane + 64 * j) = w; }
        s = wave_sum(s); if (F.lane < 16) ss0[(size_t)r * 16 + F.lane] = (F.lane == 0) ? s : 0.f; } }
    for (int L = 0; L < NL; ++L) { bf16* base = (bf16*)(F.ws + WS_RWUP + (size_t)L * 131072);
        for (int it = gw; it < 8; it += NGW) transpose_item(F.in[I_WUP] + (size_t)L * 64 * 256, 256, 64, nullptr, base, scr, it, 8, F.lane, CmIdent());
        for (int it = gw; it < 8; it += NGW) transpose_item(F.in[I_AUP] + (size_t)L * 64 * 256, 256, 64, nullptr, base + 256 * 64, scr, it, 8, F.lane, CmIdent());
        for (int it = gw; it < 16; it += NGW) transpose_item(F.in[I_GUP] + (size_t)L * 128 * 256, 256, 128, nullptr, base + 2 * 256 * 64, scr, it, 8, F.lane, CmIdent()); }
    { float* rope = (float*)(F.ws + WS_ROPE); const int gt = F.bx * NTHR + F.tid, NT_ = F.G * NTHR;
      for (int i = gt; i < S * 32; i += NT_) { const int pos = i >> 5, j = i & 31; const float inv = exp2f(-(float)(2 * j) * (13.287712379549449f / 64.0f));
        const float a = (float)pos * inv;
        rope[2 * i] = cosf(a); rope[2 * i + 1] = sinf(a); } }
}

__device__ __forceinline__ float ldu(const bf16* u, size_t row, int col) { return bf2f(u[row * UW + col]); }

__device__ __forceinline__ bf16x8 frag_rm(const LAS unsigned char* X, int ld, int r0, int k0, int lane) { return *(const LAS bf16x8*)(X + (r0 + (lane & 31)) * ld + (k0 + 8 * (lane >> 5)) * 2); }
__device__ __forceinline__ bf16x8 frag_tr(const LAS unsigned char* X, int ld, int k0, int c0, int lane) {
    const LAS unsigned char* p = X + (k0 + 8 * (lane >> 5) + ((lane & 15) >> 2)) * ld + (c0 + 16 * ((lane >> 4) & 1) + 4 * (lane & 3)) * 2;
    const s16x4 a = __builtin_amdgcn_ds_read_tr16_b64_v4i16((LAS s16x4*)p), b = __builtin_amdgcn_ds_read_tr16_b64_v4i16((LAS s16x4*)(p + 4 * ld));
    return (bf16x8){a[0], a[1], a[2], a[3], b[0], b[1], b[2], b[3]};
}
__device__ __forceinline__ bf16x8 frag_g(const bf16* X, int ld, int r0, int k0, int lane) { return *(const bf16x8*)(X + (size_t)(r0 + (lane & 31)) * ld + k0 + 8 * (lane >> 5)); }
__device__ __forceinline__ f32x16 mma32(const bf16x8& a, const bf16x8& b, const f32x16& c) { return __builtin_amdgcn_mfma_f32_32x32x16_bf16(a, b, c, 0, 0, 0); }
__device__ __forceinline__ f32x16 zero16() { f32x16 z;
#pragma unroll
    for (int i = 0; i < 16; ++i) z[i] = 0.f;
    return z; }
__device__ __forceinline__ void st_T(LAS unsigned char* X, int ld, int j0, int i0, const f32x16& acc, int lane) {
#pragma unroll
    for (int g = 0; g < 4; ++g) { u32x2 w; w.x = cvt_pk_bf16(acc[4 * g], acc[4 * g + 1]); w.y = cvt_pk_bf16(acc[4 * g + 2], acc[4 * g + 3]);
        *(LAS u32x2*)(X + (j0 + (lane & 31)) * ld + (i0 + 8 * g + 4 * (lane >> 5)) * 2) = w; }
}
__device__ __forceinline__ void st_wt8(bf16* p, const u32x2& w) { __hip_atomic_store((unsigned long long*)p, ((unsigned long long)w.y << 32) | (unsigned long long)w.x, __ATOMIC_RELAXED, __HIP_MEMORY_SCOPE_AGENT); }
__device__ __forceinline__ void st_T_g(bf16* X, int ld, int j0, int i0, const f32x16& acc, int lane) {
#pragma unroll
    for (int g = 0; g < 4; ++g) { u32x2 w; w.x = cvt_pk_bf16(acc[4 * g], acc[4 * g + 1]); w.y = cvt_pk_bf16(acc[4 * g + 2], acc[4 * g + 3]);
        st_wt8(X + (size_t)(j0 + (lane & 31)) * ld + i0 + 8 * g + 4 * (lane >> 5), w); }
}
constexpr int LD64 = 144, LD32 = 80;
__device__ __forceinline__ float expc(float x) { return __expf(fminf(fmaxf(x, -80.f), 80.f)); }
__device__ __forceinline__ unsigned short f2b(float x) { return (unsigned short)(cvt_pk_bf16(x, 0.f) & 0xffffu); }
__device__ __forceinline__ void copy_tok64(LAS unsigned char* X, const bf16* src, int lane) {
#pragma unroll
    for (int p = 0; p < 4; ++p) { const int t = 8 * p + (lane >> 3), ch = lane & 7; *(LAS u32x4*)(X + t * LD64 + ch * 16) = *(const u32x4*)(src + (size_t)t * UW + ch * 8); }
}
__device__ __forceinline__ void glin_m1(const LAS unsigned char* Kh, const LAS unsigned char* Vv, bf16* Sg, int lane, bool cst = false) {
#pragma unroll
    for (int dt = 0; dt < 2; ++dt)
#pragma unroll
        for (int et = 0; et < 2; ++et) { f32x16 acc = zero16();
#pragma unroll
            for (int ks = 0; ks < 2; ++ks) acc = mma32(frag_tr(Kh, LD64, 16 * ks, 32 * dt, lane), frag_tr(Vv, LD64, 16 * ks, 32 * et, lane), acc);
            if (cst) {
#pragma unroll
            for (int i = 0; i < 16; ++i) acc[i] = 0.01f * (float)(1 + ((lane + i) & 7)); }
            st_T_g(Sg, 64, 32 * et, 32 * dt, acc, lane); }
}
__device__ __forceinline__ void glin_m3(const LAS unsigned char* Qt, const LAS unsigned char* Kt, const LAS unsigned char* Vv, LAS unsigned char* Xa, const bf16* S0, int lane, f32x16 (&o)[2]) {
    { f32x16 acc = zero16();
#pragma unroll
      for (int ks = 0; ks < 4; ++ks) acc = mma32(frag_rm(Kt, LD64, 0, 16 * ks, lane), frag_rm(Qt, LD64, 0, 16 * ks, lane), acc);
      const int t = lane & 31;
#pragma unroll
      for (int i = 0; i < 16; ++i) { const int sidx = (i & 3) + 8 * (i >> 2) + 4 * (lane >> 5); if (sidx > t) acc[i] = 0.f; }
      st_T(Xa, LD32, 0, 0, acc, lane); }
    LDS_WAIT();
#pragma unroll
    for (int et = 0; et < 2; ++et) { f32x16 acc = zero16();
        if (S0) {
#pragma unroll
            for (int ks = 0; ks < 4; ++ks) acc = mma32(frag_g(S0, 64, 32 * et, 16 * ks, lane), frag_rm(Qt, LD64, 0, 16 * ks, lane), acc); }
#pragma unroll
        for (int ks = 0; ks < 2; ++ks) acc = mma32(frag_tr(Vv, LD64, 16 * ks, 32 * et, lane), frag_rm(Xa, LD32, 0, 16 * ks, lane), acc);
        o[et] = acc; }
}
template <bool M3>
__device__ __forceinline__ void hgrn_chunk(Frame& F, int L, int bh, int n, LAS unsigned char* W, bf16* Sbase, float* Dbase) {
    const bf16* u = (const bf16*)(F.ws + WS_U); bf16* bo = (bf16*)(F.ws + WS_BO);
    int lane = F.lane; asm volatile("" : "+v"(lane));
    const int b = bh >> 2, h = bh & 3; const size_t row0 = (size_t)b * S + (size_t)n * CH;
    const bf16* ur = u + row0 * UW + U_HG + h * 64;
    bf16* Sg = Sbase + ((size_t)bh * NCH + n) * 4096;
    LAS unsigned char* Xq = W; LAS unsigned char* Xk = W + 4608; LAS unsigned char* Xv = W + 9216; LAS unsigned char* Xa = W + 13824;
    const float* lbl = F.in[I_LB]; const int ch = h * 64 + lane;
    float lb = 0.f; if (L > 0) { const float l0 = lbl[ch], l1 = lbl[256 + ch]; const float mx = fmaxf(l0, l1); const float e0 = __expf(l0 - mx), e1 = __expf(l1 - mx); lb = e1 / (e0 + e1); }
    float bcum[CH], kk[CH]; float run = 0.f;
#pragma unroll
    for (int t = 0; t < CH; ++t) { const float z = bf2f(ur[(size_t)t * UW + 256 + lane]); const float f = lb + (1.0f - lb) * fsigmoid(z); kk[t] = 1.0f - f; run += __logf(fmaxf(f, 1e-20f)); bcum[t] = run; }
    const float blast = bcum[CH - 1];
    copy_tok64(Xv, ur + 512, lane);
    if (!M3) {
#pragma unroll
        for (int t = 0; t < CH; ++t) *(LAS unsigned short*)(Xq + t * LD64 + lane * 2) = f2b(kk[t] * expc(blast - bcum[t]));
        Dbase[((size_t)bh * NCH + n) * 64 + lane] = expc(blast);
        LDS_WAIT();
        glin_m1(Xq, Xv, Sg, lane);
    } else {
#pragma unroll
        for (int t = 0; t < CH; ++t) { const float q = fsilu(bf2f(ur[(size_t)t * UW + lane]));
            *(LAS unsigned short*)(Xq + t * LD64 + lane * 2) = f2b(q * expc(bcum[t]));
            *(LAS unsigned short*)(Xk + t * LD64 + lane * 2) = f2b(kk[t] * expc(-bcum[t])); }
        LDS_WAIT();
        f32x16 o[2];
        glin_m3(Xq, Xk, Xv, Xa, n > 0 ? Sg - 4096 : nullptr, lane, o);
        const int t = lane & 31, hh = lane >> 5; float ss = 0.f;
#pragma unroll
        for (int et = 0; et < 2; ++et)
#pragma unroll
            for (int i = 0; i < 16; ++i) ss += o[et][i] * o[et][i];
        ss += __shfl_xor(ss, 32);
        const float rn = __builtin_amdgcn_rsqf(ss * (1.0f / 64.0f) + EPS);
        const float* ng = F.in[I_HG_NORM] + L * 256 + h * 64;
#pragma unroll
        for (int et = 0; et < 2; ++et)
#pragma unroll
            for (int g = 0; g < 4; ++g) { const int e0 = 32 * et + 8 * g + 4 * hh;
                const u32x2 og = *(const u32x2*)(ur + (size_t)t * UW + 768 + e0); const f32x4 gg = *(const f32x4*)(ng + e0);
                const float y0 = o[et][4 * g] * rn * gg[0] * fsilu(bflo(og.x)), y1 = o[et][4 * g + 1] * rn * gg[1] * fsilu(bfhi(og.x));
                const float y2 = o[et][4 * g + 2] * rn * gg[2] * fsilu(bflo(og.y)), y3 = o[et][4 * g + 3] * rn * gg[3] * fsilu(bfhi(og.y));
                u32x2 w; w.x = cvt_pk_bf16(y0, y1); w.y = cvt_pk_bf16(y2, y3);
                *(u32x2*)(bo + (row0 + t) * 1024 + 256 + h * 64 + e0) = w; }
    }
    LDS_WAIT();
}
template <bool M3>
__device__ __forceinline__ void ret_chunk(Frame& F, int L, int bh, int n, LAS unsigned char* W, bf16* Sbase) {
    const bf16* u = (const bf16*)(F.ws + WS_U); bf16* bo = (bf16*)(F.ws + WS_BO); const float* rope = (const float*)(F.ws + WS_ROPE);
    int lane = F.lane; asm volatile("" : "+v"(lane));
    const int b = bh >> 2, h = bh & 3; const int tpos0 = n * CH; const size_t row0 = (size_t)b * S + (size_t)tpos0;
    const bf16* ur = u + row0 * UW + U_RT + h * 64;
    bf16* Sg = Sbase + ((size_t)bh * NCH + n) * 4096;
    LAS unsigned char* Xq = W; LAS unsigned char* Xk = W + 4608; LAS unsigned char* Xv = W + 9216; LAS unsigned char* Xa = W + 13824;
    const float lg2 = __log2f(1.0f - exp2f(-5.0f - (float)h));
    copy_tok64(Xv, ur + 512, lane);
#pragma unroll
    for (int p = 0; p < 2; ++p) { const int idx = lane + 64 * p, t = idx >> 2, jc = idx & 3;
        f32x4 c0, c1, s0, s1;
        { const float* rp = rope + ((size_t)(tpos0 + t) * 32 + jc * 8) * 2; const f32x4 a = *(const f32x4*)rp, bq = *(const f32x4*)(rp + 4), c = *(const f32x4*)(rp + 8), d = *(const f32x4*)(rp + 12);
          c0 = (f32x4){a[0], a[2], bq[0], bq[2]}; s0 = (f32x4){a[1], a[3], bq[1], bq[3]}; c1 = (f32x4){c[0], c[2], d[0], d[2]}; s1 = (f32x4){c[1], c[3], d[1], d[3]}; }
        { const u32x4 w1 = *(const u32x4*)(ur + (size_t)t * UW + 256 + jc * 8), w2 = *(const u32x4*)(ur + (size_t)t * UW + 256 + 32 + jc * 8);
          f32x4 a0, a1, b0, b1; unpack8(w1, a0, a1); unpack8(w2, b0, b1);
          const float sc = 0.125f * exp2f(lg2 * (M3 ? -(float)(t + 1) : (float)(CH - 1 - t)));
          const f32x4 lo0 = (a0 * c0 - b0 * s0) * sc, lo1 = (a1 * c1 - b1 * s1) * sc, hi0 = (a0 * s0 + b0 * c0) * sc, hi1 = (a1 * s1 + b1 * c1) * sc;
          LAS unsigned char* dst = M3 ? Xk : Xq;
          *(LAS u32x4*)(dst + t * LD64 + jc * 16) = pack8(lo0, lo1); *(LAS u32x4*)(dst + t * LD64 + 64 + jc * 16) = pack8(hi0, hi1); }
        if (M3) { const u32x4 w1 = *(const u32x4*)(ur + (size_t)t * UW + jc * 8), w2 = *(const u32x4*)(ur + (size_t)t * UW + 32 + jc * 8);
          f32x4 a0, a1, b0, b1; unpack8(w1, a0, a1); unpack8(w2, b0, b1);
          const float sc = exp2f(lg2 * (float)(t + 1));
          const f32x4 lo0 = (a0 * c0 - b0 * s0) * sc, lo1 = (a1 * c1 - b1 * s1) * sc, hi0 = (a0 * s0 + b0 * c0) * sc, hi1 = (a1 * s1 + b1 * c1) * sc;
          *(LAS u32x4*)(Xq + t * LD64 + jc * 16) = pack8(lo0, lo1); *(LAS u32x4*)(Xq + t * LD64 + 64 + jc * 16) = pack8(hi0, hi1); }
    }
    LDS_WAIT();
    if (!M3) glin_m1(Xq, Xv, Sg, lane);
    else {
        f32x16 o[2];
        glin_m3(Xq, Xk, Xv, Xa, n > 0 ? Sg - 4096 : nullptr, lane, o);
        const int t = lane & 31, hh = lane >> 5; float sm = 0.f;
#pragma unroll
        for (int et = 0; et < 2; ++et)
#pragma unroll
            for (int i = 0; i < 16; ++i) sm += o[et][i];
        sm += __shfl_xor(sm, 32);
        const float mean = sm * (1.0f / 64.0f); float sv = 0.f;
#pragma unroll
        for (int et = 0; et < 2; ++et)
#pragma unroll
            for (int i = 0; i < 16; ++i) { const float dl = o[et][i] - mean; sv += dl * dl; }
        sv += __shfl_xor(sv, 32);
        const float rn = __builtin_amdgcn_rsqf(sv * (1.0f / 64.0f) + 1e-5f);
        const float* ng = F.in[I_RT_G] + L * 256 + h * 64; const float* nb = F.in[I_RT_B] + L * 256 + h * 64;
#pragma unroll
        for (int et = 0; et < 2; ++et)
#pragma unroll
            for (int g = 0; g < 4; ++g) { const int e0 = 32 * et + 8 * g + 4 * hh;
                const u32x2 og = *(const u32x2*)(ur + (size_t)t * UW + 768 + e0); const f32x4 gg = *(const f32x4*)(ng + e0), bb = *(const f32x4*)(nb + e0);
                const float y0 = ((o[et][4 * g] - mean) * rn * gg[0] + bb[0]) * fsilu(bflo(og.x)), y1 = ((o[et][4 * g + 1] - mean) * rn * gg[1] + bb[1]) * fsilu(bfhi(og.x));
                const float y2 = ((o[et][4 * g + 2] - mean) * rn * gg[2] + bb[2]) * fsilu(bflo(og.y)), y3 = ((o[et][4 * g + 3] - mean) * rn * gg[3] + bb[3]) * fsilu(bfhi(og.y));
                u32x2 w; w.x = cvt_pk_bf16(y0, y1); w.y = cvt_pk_bf16(y2, y3);
                *(u32x2*)(bo + (row0 + t) * 1024 + 512 + h * 64 + e0) = w; }
    }
    LDS_WAIT();
}
__device__ __forceinline__ void glin_scan_task(bf16* Sbase, const float* Dbase, float dscal, int bh, int quarter, int tl  ) {
    bf16* p = Sbase + (size_t)bh * NCH * 4096 + quarter * 1024 + tl * 4;
    const int d0 = (tl & 15) * 4;
    f32x4 st = {0.f, 0.f, 0.f, 0.f};
    for (int n0 = 0; n0 < NCH; n0 += 8) {
        u32x2 kv[8]; f32x4 dd[8];
#pragma unroll
        for (int j = 0; j < 8; ++j) { kv[j] = *(const u32x2*)(p + (size_t)(n0 + j) * 4096); if (Dbase) dd[j] = *(const f32x4*)(Dbase + ((size_t)bh * NCH + n0 + j) * 64 + d0); else dd[j] = (f32x4){dscal, dscal, dscal, dscal}; }
#pragma unroll
        for (int j = 0; j < 8; ++j) {
            st[0] = st[0] * dd[j][0] + bflo(kv[j].x); st[1] = st[1] * dd[j][1] + bfhi(kv[j].x); st[2] = st[2] * dd[j][2] + bflo(kv[j].y); st[3] = st[3] * dd[j][3] + bfhi(kv[j].y);
            u32x2 w; w.x = cvt_pk_bf16(st[0], st[1]); w.y = cvt_pk_bf16(st[2], st[3]); st_wt8(p + (size_t)(n0 + j) * 4096, w); }
    }
}

constexpr int RW_R0 = 0, RW_R1 = 4608, RW_R2 = 9216, RW_R3 = 13824, RW_R4 = 16384, RW_R5 = 18944, RW_LW = 0, RW_AG = 8704, LDLW = 272;
__device__ __forceinline__ void ld_shift8(const bf16* urow, bool has_prev, const float* mu8, f32x4& lo, f32x4& hi) {
    const u32x4 w1 = *(const u32x4*)urow; f32x4 a0, a1; unpack8(w1, a0, a1);
    f32x4 p0 = {0.f, 0.f, 0.f, 0.f}, p1 = {0.f, 0.f, 0.f, 0.f};
    if (has_prev) { const u32x4 w0 = *(const u32x4*)(urow - UW); unpack8(w0, p0, p1); }
    const f32x4 m0 = *(const f32x4*)mu8, m1 = *(const f32x4*)(mu8 + 4);
    lo = a0 + m0 * (p0 - a0); hi = a1 + m1 * (p1 - a1);
}
__device__ __forceinline__ float ftanh(float x) { return 1.0f - 2.0f * __builtin_amdgcn_rcpf(1.0f + __builtin_amdgcn_exp2f(2.8853900817779268f * x)); }
#ifndef RW_LIMIT
#define RW_LIMIT 100
#endif
#define RW_CUT(k) do { if (RW_LIMIT <= (k)) return; } while (0)
template <int SI> struct SubstStep {
    static __device__ __forceinline__ void run(float (&Tr)[CH], const LAS unsigned char* AT, int r32, int& ofs) {
        float a0 = (r32 == SI) ? 1.0f : 0.f, a1 = 0.f;
#pragma unroll
        for (int q = 0; q < 4; ++q) { if (8 * q + 7 > SI) { const u32x4 w = *(const LAS u32x4*)(AT + ofs + SI * LD32 + q * 16); f32x4 lo, hi; unpack8(w, lo, hi);
#pragma unroll
            for (int x = 0; x < 4; ++x) { if (8 * q + x > SI) a0 += Tr[8 * q + x] * lo[x]; if (8 * q + 4 + x > SI) a1 += Tr[8 * q + 4 + x] * hi[x]; } } }
        const float a = a0 + a1;
        Tr[SI] = a;
        asm volatile("" : "+v"(ofs) : "v"(a));
        SubstStep<SI - 1>::run(Tr, AT, r32, ofs);
    }
};
template <> struct SubstStep<-1> { static __device__ __forceinline__ void run(float (&)[CH], const LAS unsigned char*, int, int&) {} };
template <bool M3>
__device__ __forceinline__ void rwkv_chunk(Frame& F, int L, int bh, int n, LAS unsigned char* W) {
    const bf16* u = (const bf16*)(F.ws + WS_U); bf16* bo = (bf16*)(F.ws + WS_BO);
    int lane = F.lane; asm volatile("" : "+v"(lane));
    const int b = bh >> 2, h = bh & 3, r32 = lane & 31, hh = lane >> 5; const size_t row0 = (size_t)b * S + (size_t)n * CH;
    const bf16* ur = u + row0 * UW + U_RW;
    const float* mu = F.in[I_MU] + L * 1024;
    const bf16* upT = (const bf16*)(F.ws + WS_RWUP + (size_t)L * 131072);
    bf16* Mg = (bf16*)(F.ws + WS_RWM) + ((size_t)bh * NCH + n) * 4096;
    bf16* Ng = (bf16*)(F.ws + WS_RWN) + ((size_t)bh * NCH + n) * 4096;
    LAS unsigned char* R0 = W + RW_R0; LAS unsigned char* R1 = W + RW_R1; LAS unsigned char* R2 = W + RW_R2; LAS unsigned char* R3 = W + RW_R3; LAS unsigned char* R4 = W + RW_R4;
    LAS float* R5 = (LAS float*)(W + RW_R5);
#pragma unroll
    for (int i = 0; i < 8; ++i) { const int idx = lane + 64 * i, t = idx >> 4, part = (idx >> 3) & 1, ch = idx & 7, col = 768 + part * 64 + ch * 8;
        f32x4 lo, hi; ld_shift8(ur + (size_t)t * UW + col, (n * CH + t) > 0, mu + col, lo, hi);
        if (part == 0) {
#pragma unroll
            for (int j = 0; j < 4; ++j) { lo[j] = ftanh(lo[j]); hi[j] = ftanh(hi[j]); } }
        *(LAS u32x4*)(W + part * 4608 + t * LD64 + ch * 16) = pack8(lo, hi); }
    RW_CUT(0);
    LDS_WAIT();
    { f32x16 zw[2], za[2];
#pragma unroll
      for (int ct = 0; ct < 2; ++ct) { zw[ct] = zero16(); za[ct] = zero16();
#pragma unroll
        for (int ks = 0; ks < 4; ++ks) { zw[ct] = mma32(frag_g(upT + (size_t)(h * 64 + 32 * ct) * 64, 64, 0, 16 * ks, lane), frag_rm(W, LD64, 0, 16 * ks, lane), zw[ct]);
            za[ct] = mma32(frag_g(upT + 256 * 64 + (size_t)(h * 64 + 32 * ct) * 64, 64, 0, 16 * ks, lane), frag_rm(W + 4608, LD64, 0, 16 * ks, lane), za[ct]); } }
      const float* w0 = F.in[I_W0] + L * 256 + h * 64; const float* a0 = F.in[I_A0] + L * 256 + h * 64;
#pragma unroll
      for (int ct = 0; ct < 2; ++ct)
#pragma unroll
        for (int g = 0; g < 4; ++g) { const int c0 = 32 * ct + 8 * g + 4 * hh; const f32x4 wv = *(const f32x4*)(w0 + c0), av = *(const f32x4*)(a0 + c0);
            f32x4 lw, ag;
#pragma unroll
            for (int x = 0; x < 4; ++x) { lw[x] = -0.6065306597126334f * fsigmoid(zw[ct][4 * g + x] + wv[x]); ag[x] = fsigmoid(za[ct][4 * g + x] + av[x]); }
            *(LAS f32x4*)(W + RW_LW + r32 * LDLW + c0 * 4) = lw;
            u32x2 pk; pk.x = cvt_pk_bf16(ag[0], ag[1]); pk.y = cvt_pk_bf16(ag[2], ag[3]); *(LAS u32x2*)(W + RW_AG + r32 * LD64 + c0 * 2) = pk; } }
    RW_CUT(1);
    LDS_WAIT();
    { float run = 0.f;
#pragma unroll
      for (int t = 0; t < CH; ++t) { LAS float* p = (LAS float*)(W + RW_LW + t * LDLW) + lane; run += *p; *p = run; } }
    RW_CUT(2);
    LDS_WAIT();
    const int c0 = 8 * (lane & 7), tl = lane >> 3;
    u32x4 E1p[4], E2p[4], AGp[4];
#pragma unroll
    for (int p = 0; p < 4; ++p) { const int t = 8 * p + tl;
        const f32x4 ca = *(const LAS f32x4*)(W + RW_LW + t * LDLW + c0 * 4), cb = *(const LAS f32x4*)(W + RW_LW + t * LDLW + c0 * 4 + 16);
        f32x4 ea = {0.f, 0.f, 0.f, 0.f}, eb = {0.f, 0.f, 0.f, 0.f};
        if (t > 0) { ea = *(const LAS f32x4*)(W + RW_LW + (t - 1) * LDLW + c0 * 4); eb = *(const LAS f32x4*)(W + RW_LW + (t - 1) * LDLW + c0 * 4 + 16); }
        AGp[p] = *(const LAS u32x4*)(W + RW_AG + t * LD64 + c0 * 2);
        f32x4 x1a, x1b, x2a, x2b;
#pragma unroll
        for (int x = 0; x < 4; ++x) { x1a[x] = __expf(ea[x]); x1b[x] = __expf(eb[x]); x2a[x] = __expf(-ca[x]); x2b[x] = __expf(-cb[x]); }
        E1p[p] = pack8(x1a, x1b); E2p[p] = pack8(x2a, x2b); }
    float pcl[8];
    { const f32x4 la = *(const LAS f32x4*)(W + RW_LW + 31 * LDLW + c0 * 4), lb2 = *(const LAS f32x4*)(W + RW_LW + 31 * LDLW + c0 * 4 + 16);
#pragma unroll
      for (int x = 0; x < 4; ++x) { pcl[x] = __expf(la[x]); pcl[4 + x] = __expf(lb2[x]); } }
    RW_CUT(3);
    LDS_WAIT();
    const float* kkw = F.in[I_KK] + L * 256 + h * 64 + c0; const float* kaw = F.in[I_KA] + L * 256 + h * 64 + c0; const float* rkw = F.in[I_RK] + L * 256 + h * 64 + c0;
    u32x4 Ap[4];
    if (!M3 && tl == 0) { *(LAS f32x4*)(R5 + c0) = (f32x4){pcl[0], pcl[1], pcl[2], pcl[3]}; *(LAS f32x4*)(R5 + c0 + 4) = (f32x4){pcl[4], pcl[5], pcl[6], pcl[7]}; }
#pragma unroll
    for (int p = 0; p < 4; ++p) { const int t = 8 * p + tl; const bool hp = (n * CH + t) > 0; const bf16* ut = ur + (size_t)t * UW + h * 64 + c0;
        f32x4 k0, k1, r0 = {0.f, 0.f, 0.f, 0.f}, r1 = {0.f, 0.f, 0.f, 0.f};
        ld_shift8(ut + 256, hp, mu + 256 + h * 64 + c0, k0, k1);
        if (M3) ld_shift8(ut, hp, mu + h * 64 + c0, r0, r1);
        f32x4 ag0, ag1; unpack8(AGp[p], ag0, ag1);
        float E1[8], E2[8]; { f32x4 a, bq; unpack8(E1p[p], a, bq); f32x4 c, d; unpack8(E2p[p], c, d);
#pragma unroll
            for (int x = 0; x < 4; ++x) { E1[x] = a[x]; E1[4 + x] = bq[x]; E2[x] = c[x]; E2[4 + x] = d[x]; } }
        const f32x4 kw0 = *(const f32x4*)kkw, kw1 = *(const f32x4*)(kkw + 4), ka0 = *(const f32x4*)kaw, ka1 = *(const f32x4*)(kaw + 4);
        f32x4 q0 = k0 * kw0, q1 = k1 * kw1;
        float n2 = (q0[0] * q0[0] + q0[1] * q0[1]) + (q0[2] * q0[2] + q0[3] * q0[3]) + (q1[0] * q1[0] + q1[1] * q1[1]) + (q1[2] * q1[2] + q1[3] * q1[3]);
        n2 += __shfl_xor(n2, 1); n2 += __shfl_xor(n2, 2); n2 += __shfl_xor(n2, 4);
        const float rn = __builtin_amdgcn_rsqf(fmaxf(n2, 1e-24f)); q0 = q0 * rn; q1 = q1 * rn;
        f32x4 kp0, kp1, at0, at1, bt0, bt1, kt0, kt1;
#pragma unroll
        for (int x = 0; x < 4; ++x) { kp0[x] = k0[x] * (1.0f + (ag0[x] - 1.0f) * ka0[x]); kp1[x] = k1[x] * (1.0f + (ag1[x] - 1.0f) * ka1[x]);
            at0[x] = -q0[x] * E1[x]; at1[x] = -q1[x] * E1[4 + x]; bt0[x] = q0[x] * ag0[x] * E2[x]; bt1[x] = q1[x] * ag1[x] * E2[4 + x];
            kt0[x] = kp0[x] * E2[x]; kt1[x] = kp1[x] * E2[4 + x]; }
        *(LAS u32x4*)(R1 + t * LD64 + c0 * 2) = pack8(bt0, bt1); *(LAS u32x4*)(R2 + t * LD64 + c0 * 2) = pack8(kt0, kt1);
        if (!M3) *(LAS u32x4*)(R0 + t * LD64 + c0 * 2) = pack8(at0, at1);
        else { Ap[p] = pack8(at0, at1);
            const f32x4 rk0 = *(const f32x4*)rkw, rk1 = *(const f32x4*)(rkw + 4);
            f32x4 rt0, rt1; float bs = 0.f;
#pragma unroll
            for (int x = 0; x < 4; ++x) { rt0[x] = r0[x] * __builtin_amdgcn_rcpf(E2[x]); rt1[x] = r1[x] * __builtin_amdgcn_rcpf(E2[4 + x]); bs += r0[x] * kp0[x] * rk0[x] + r1[x] * kp1[x] * rk1[x]; }
            bs += __shfl_xor(bs, 1); bs += __shfl_xor(bs, 2); bs += __shfl_xor(bs, 4);
            if ((lane & 7) == 0) R5[t] = bs;
            *(LAS u32x4*)(R0 + t * LD64 + c0 * 2) = pack8(rt0, rt1); } }
    RW_CUT(4);
    LDS_WAIT();
    const bf16* S0 = n > 0 ? Ng - 4096 : nullptr;
    f32x16 yacc[2], g2acc;
    if (M3) {
#pragma unroll
        for (int vt = 0; vt < 2; ++vt) { yacc[vt] = zero16();
            if (S0) {
#pragma unroll
                for (int ks = 0; ks < 4; ++ks) yacc[vt] = mma32(frag_g(S0, 64, 32 * vt, 16 * ks, lane), frag_rm(R0, LD64, 0, 16 * ks, lane), yacc[vt]); } }
        f32x16 g1 = zero16(); g2acc = zero16();
#pragma unroll
        for (int ks = 0; ks < 4; ++ks) { const bf16x8 rf = frag_rm(R0, LD64, 0, 16 * ks, lane); g1 = mma32(frag_rm(R1, LD64, 0, 16 * ks, lane), rf, g1); g2acc = mma32(frag_rm(R2, LD64, 0, 16 * ks, lane), rf, g2acc); }
#pragma unroll
        for (int i = 0; i < 16; ++i) { const int sidx = (i & 3) + 8 * (i >> 2) + 4 * hh; if (sidx > r32) { g1[i] = 0.f; g2acc[i] = 0.f; } }
        st_T(R4, LD32, 0, 0, g1, lane);
        LDS_WAIT();
#pragma unroll
        for (int p = 0; p < 4; ++p) *(LAS u32x4*)(R0 + (8 * p + tl) * LD64 + c0 * 2) = Ap[p];
        LDS_WAIT();
    }
    RW_CUT(5);
    { f32x16 ab = zero16(), ak = zero16();
#pragma unroll
      for (int ks = 0; ks < 4; ++ks) { const bf16x8 af = frag_rm(R0, LD64, 0, 16 * ks, lane); ab = mma32(af, frag_rm(R1, LD64, 0, 16 * ks, lane), ab); ak = mma32(frag_rm(R2, LD64, 0, 16 * ks, lane), af, ak); }
#pragma unroll
      for (int i = 0; i < 16; ++i) { const int ridx = (i & 3) + 8 * (i >> 2) + 4 * hh;
          if (!(ridx > r32)) ab[i] = 0.f;
          if (!(ridx < r32)) ak[i] = 0.f; }
      st_T(R3, LD32, 0, 0, ab, lane);
      st_T(M3 ? R2 : R4, LD32, 0, 0, ak, lane); }
    LAS unsigned char* X1 = M3 ? R2 : R4;
    RW_CUT(6);
    LDS_WAIT();
    { float Tr[CH];
      int sofs = 0; asm volatile("" : "+v"(sofs)); SubstStep<CH - 1>::run(Tr, R3, r32, sofs);
      if (hh == 0) {
#pragma unroll
          for (int q = 0; q < 4; ++q) { f32x4 lo = {Tr[8 * q], Tr[8 * q + 1], Tr[8 * q + 2], Tr[8 * q + 3]}, hi = {Tr[8 * q + 4], Tr[8 * q + 5], Tr[8 * q + 6], Tr[8 * q + 7]};
              *(LAS u32x4*)(R3 + r32 * LD32 + q * 16) = pack8(lo, hi); } } }
    RW_CUT(7);
    LDS_WAIT();
    { f32x16 y = zero16(), ah[2];
#pragma unroll
      for (int ks = 0; ks < 2; ++ks) y = mma32(frag_tr(X1, LD32, 16 * ks, 0, lane), frag_rm(R3, LD32, 0, 16 * ks, lane), y);
#pragma unroll
      for (int ct = 0; ct < 2; ++ct) { ah[ct] = zero16();
#pragma unroll
        for (int ks = 0; ks < 2; ++ks) ah[ct] = mma32(frag_tr(R0, LD64, 16 * ks, 32 * ct, lane), frag_rm(R3, LD32, 0, 16 * ks, lane), ah[ct]); }
      st_T(X1, LD32, 0, 0, y, lane);
      st_T(R0, LD64, 0, 0, ah[0], lane); st_T(R0, LD64, 0, 32, ah[1], lane); }
    RW_CUT(8);
    LDS_WAIT();
    if (!M3) {
        { f32x16 z[2];
#pragma unroll
          for (int dt = 0; dt < 2; ++dt) {
#pragma unroll
            for (int g = 0; g < 4; ++g) { const u32x2 w = *(const LAS u32x2*)(R2 + r32 * LD64 + (32 * dt + 8 * g + 4 * hh) * 2); z[dt][4 * g] = bflo(w.x); z[dt][4 * g + 1] = bfhi(w.x); z[dt][4 * g + 2] = bflo(w.y); z[dt][4 * g + 3] = bfhi(w.y); }
#pragma unroll
            for (int ks = 0; ks < 2; ++ks) z[dt] = mma32(frag_tr(R1, LD64, 16 * ks, 32 * dt, lane), frag_tr(X1, LD32, 16 * ks, 0, lane), z[dt]); }
          st_T(R2, LD64, 0, 0, z[0], lane); st_T(R2, LD64, 0, 32, z[1], lane); }
#pragma unroll
        for (int d1t = 0; d1t < 2; ++d1t) { const float pc1 = R5[32 * d1t + r32];
#pragma unroll
            for (int d2t = 0; d2t < 2; ++d2t) { f32x16 m = zero16();
#pragma unroll
                for (int ks = 0; ks < 2; ++ks) m = mma32(frag_tr(R0, LD64, 16 * ks, 32 * d2t, lane), frag_tr(R1, LD64, 16 * ks, 32 * d1t, lane), m);
#pragma unroll
                for (int i = 0; i < 16; ++i) { const int d2 = 32 * d2t + (i & 3) + 8 * (i >> 2) + 4 * hh; m[i] = pc1 * (m[i] + ((d2 == 32 * d1t + r32) ? 1.0f : 0.f)); }
                st_T_g(Mg, 64, 32 * d1t, 32 * d2t, m, lane); } }
        LDS_WAIT();
#pragma unroll
        for (int p = 0; p < 4; ++p) { const int t = 8 * p + tl; f32x4 v0, v1; ld_shift8(ur + (size_t)t * UW + h * 64 + c0 + 512, (n * CH + t) > 0, mu + 512 + h * 64 + c0, v0, v1); *(LAS u32x4*)(R1 + t * LD64 + c0 * 2) = pack8(v0, v1); }
        LDS_WAIT();
#pragma unroll
        for (int dt = 0; dt < 2; ++dt)
#pragma unroll
            for (int vt = 0; vt < 2; ++vt) { f32x16 nn = zero16();
#pragma unroll
                for (int ks = 0; ks < 2; ++ks) nn = mma32(frag_tr(R2, LD64, 16 * ks, 32 * dt, lane), frag_tr(R1, LD64, 16 * ks, 32 * vt, lane), nn);
#pragma unroll
                for (int g = 0; g < 4; ++g) { const f32x4 pv = *(const LAS f32x4*)(R5 + 32 * dt + 8 * g + 4 * hh);
#pragma unroll
                    for (int x = 0; x < 4; ++x) nn[4 * g + x] *= pv[x]; }
                st_T_g(Ng, 64, 32 * vt, 32 * dt, nn, lane); }
    } else {
        { f32x16 rh[2];
#pragma unroll
          for (int dt = 0; dt < 2; ++dt) { rh[dt] = zero16();
#pragma unroll
            for (int ks = 0; ks < 2; ++ks) rh[dt] = mma32(frag_tr(R0, LD64, 16 * ks, 32 * dt, lane), frag_rm(R4, LD32, 0, 16 * ks, lane), rh[dt]); }
          st_T(R1, LD64, 0, 0, rh[0], lane); st_T(R1, LD64, 0, 32, rh[1], lane); }
        { f32x16 gh = g2acc;
#pragma unroll
          for (int ks = 0; ks < 2; ++ks) gh = mma32(frag_tr(X1, LD32, 16 * ks, 0, lane), frag_rm(R4, LD32, 0, 16 * ks, lane), gh);
          LDS_WAIT();
          st_T(R3, LD32, 0, 0, gh, lane); }
        LDS_WAIT();
        if (S0) {
#pragma unroll
            for (int vt = 0; vt < 2; ++vt)
#pragma unroll
                for (int ks = 0; ks < 4; ++ks) yacc[vt] = mma32(frag_g(S0, 64, 32 * vt, 16 * ks, lane), frag_rm(R1, LD64, 0, 16 * ks, lane), yacc[vt]); }
        LDS_WAIT();
#pragma unroll
        for (int p = 0; p < 4; ++p) { const int t = 8 * p + tl; f32x4 v0, v1; ld_shift8(ur + (size_t)t * UW + h * 64 + c0 + 512, (n * CH + t) > 0, mu + 512 + h * 64 + c0, v0, v1); *(LAS u32x4*)(R0 + t * LD64 + c0 * 2) = pack8(v0, v1); }
#pragma unroll
        for (int i = 0; i < 8; ++i) { const int idx = lane + 64 * i, t = idx >> 4, ch = idx & 15, col = 896 + ch * 8;
            f32x4 lo, hi; ld_shift8(ur + (size_t)t * UW + col, (n * CH + t) > 0, mu + col, lo, hi);
#pragma unroll
            for (int j = 0; j < 4; ++j) { lo[j] = fsigmoid(lo[j]); hi[j] = fsigmoid(hi[j]); }
            *(LAS u32x4*)(R1 + t * LDLW + ch * 16) = pack8(lo, hi); }
        LDS_WAIT();
        f32x16 gacc[2];
#pragma unroll
        for (int vt = 0; vt < 2; ++vt) {
#pragma unroll
            for (int ks = 0; ks < 2; ++ks) yacc[vt] = mma32(frag_tr(R0, LD64, 16 * ks, 32 * vt, lane), frag_rm(R3, LD32, 0, 16 * ks, lane), yacc[vt]);
            gacc[vt] = zero16();
#pragma unroll
            for (int ks = 0; ks < 8; ++ks) gacc[vt] = mma32(frag_g(upT + 2 * 256 * 64 + (size_t)(h * 64 + 32 * vt) * 128, 128, 0, 16 * ks, lane), frag_rm(R1, LDLW, 0, 16 * ks, lane), gacc[vt]); }
        float sm = 0.f;
#pragma unroll
        for (int vt = 0; vt < 2; ++vt)
#pragma unroll
            for (int i = 0; i < 16; ++i) sm += yacc[vt][i];
        sm += __shfl_xor(sm, 32);
        const float mean = sm * (1.0f / 64.0f); float sv = 0.f;
#pragma unroll
        for (int vt = 0; vt < 2; ++vt)
#pragma unroll
            for (int i = 0; i < 16; ++i) { const float dl = yacc[vt][i] - mean; sv += dl * dl; }
        sv += __shfl_xor(sv, 32);
        const float rstd = __builtin_amdgcn_rsqf(sv * (1.0f / 64.0f) + 64e-5f);
        const float bon = R5[r32];
        const float* ng = F.in[I_RW_G] + L * 256 + h * 64; const float* nb = F.in[I_RW_B] + L * 256 + h * 64;
#pragma unroll
        for (int vt = 0; vt < 2; ++vt)
#pragma unroll
            for (int g = 0; g < 4; ++g) { const int v0i = 32 * vt + 8 * g + 4 * hh;
                const u32x2 vw = *(const LAS u32x2*)(R0 + r32 * LD64 + v0i * 2); const f32x4 gg = *(const f32x4*)(ng + v0i), bb = *(const f32x4*)(nb + v0i);
                const float vv[4] = {bflo(vw.x), bfhi(vw.x), bflo(vw.y), bfhi(vw.y)}; float o[4];
#pragma unroll
                for (int x = 0; x < 4; ++x) o[x] = ((yacc[vt][4 * g + x] - mean) * rstd * gg[x] + bb[x] + bon * vv[x]) * gacc[vt][4 * g + x];
                u32x2 w; w.x = cvt_pk_bf16(o[0], o[1]); w.y = cvt_pk_bf16(o[2], o[3]);
                *(u32x2*)(bo + (row0 + r32) * 1024 + 768 + h * 64 + v0i) = w; }
    }
    LDS_WAIT();
}
__device__ __forceinline__ void rwkv_scan_task(Frame& F, int bh, int vh) {
    const int lane = F.lane, r32 = lane & 31, hh = lane >> 5;
    const bf16* Mb = (const bf16*)(F.ws + WS_RWM) + (size_t)bh * NCH * 4096; bf16* Nb = (bf16*)(F.ws + WS_RWN) + (size_t)bh * NCH * 4096 + (size_t)(vh * 32 + r32) * 64;
    f32x16 st[2] = {zero16(), zero16()};
    u32x2 nq[2][4], mq[2][2][2][2];
#define RW_PREF(nn) do { _Pragma("unroll") for (int dt = 0; dt < 2; ++dt) _Pragma("unroll") for (int g = 0; g < 4; ++g) nq[dt][g] = *(const u32x2*)(Nb + (size_t)(nn) * 4096 + 32 * dt + 8 * g + 4 * hh); \
        _Pragma("unroll") for (int d1t = 0; d1t < 2; ++d1t) _Pragma("unroll") for (int dt = 0; dt < 2; ++dt) _Pragma("unroll") for (int s2 = 0; s2 < 2; ++s2) { \
            const bf16* mp = Mb + (size_t)(nn) * 4096 + (size_t)(32 * d1t + r32) * 64 + 32 * dt + 16 * s2 + 4 * hh; mq[d1t][dt][s2][0] = *(const u32x2*)mp; mq[d1t][dt][s2][1] = *(const u32x2*)(mp + 8); } } while (0)
    RW_PREF(0);
    for (int n = 0; n < NCH; ++n) {
        bf16x8 bfr[2][2];
#pragma unroll
        for (int dt = 0; dt < 2; ++dt)
#pragma unroll
            for (int s2 = 0; s2 < 2; ++s2) { union { bf16x8 v; unsigned w[4]; } pf;
#pragma unroll
                for (int j = 0; j < 4; ++j) pf.w[j] = cvt_pk_bf16(st[dt][8 * s2 + 2 * j], st[dt][8 * s2 + 2 * j + 1]);
                bfr[dt][s2] = pf.v; }
        f32x16 nw[2];
#pragma unroll
        for (int d1t = 0; d1t < 2; ++d1t) {
#pragma unroll
            for (int g = 0; g < 4; ++g) { nw[d1t][4 * g] = bflo(nq[d1t][g].x); nw[d1t][4 * g + 1] = bfhi(nq[d1t][g].x); nw[d1t][4 * g + 2] = bflo(nq[d1t][g].y); nw[d1t][4 * g + 3] = bfhi(nq[d1t][g].y); }
#pragma unroll
            for (int dt = 0; dt < 2; ++dt)
#pragma unroll
                for (int s2 = 0; s2 < 2; ++s2) { union { bf16x8 v; u32x2 d[2]; } mf; mf.d[0] = mq[d1t][dt][s2][0]; mf.d[1] = mq[d1t][dt][s2][1]; nw[d1t] = mma32(mf.v, bfr[dt][s2], nw[d1t]); } }
        if (n + 1 < NCH) RW_PREF(n + 1);
#pragma unroll
        for (int d1t = 0; d1t < 2; ++d1t) { st[d1t] = nw[d1t];
#pragma unroll
            for (int g = 0; g < 4; ++g) { u32x2 w; w.x = cvt_pk_bf16(nw[d1t][4 * g], nw[d1t][4 * g + 1]); w.y = cvt_pk_bf16(nw[d1t][4 * g + 2], nw[d1t][4 * g + 3]); st_wt8(Nb + (size_t)n * 4096 + 32 * d1t + 8 * g + 4 * hh, w); } }
    }
#undef RW_PREF
}

constexpr int NS_KROW = 144, NS_VROW = 144;
constexpr int NS_KB = 64 * NS_KROW, NS_VB = 64 * NS_VROW;
constexpr int NS_K0 = 0, NS_V0 = 2 * NS_KB, NS_IMP = NS_V0 + 2 * NS_VB, NS_SEL = NS_IMP + 64 * 128 * 4, NS_END = NS_SEL + 64 * 4 * 4;
constexpr int NS_OUT = NS_END, NS_END2 = NS_OUT + 8 * 8192;
static_assert(NS_END2 <= MISC_OFF, "nsa lds");
struct NsaRow { float m, l; f32x16 o[2]; };
__device__ __forceinline__ void ns_load(const bf16* kb, const bf16* vb, size_t stride, int tid, u32x4& kr, u32x4& vr) {
    const int key = tid >> 3, ch = tid & 7; kr = *(const u32x4*)(kb + (size_t)key * stride + ch * 8); vr = *(const u32x4*)(vb + (size_t)key * stride + ch * 8);
}
__device__ __forceinline__ void ns_store(LAS unsigned char* Kb, LAS unsigned char* Vb, int tid, const u32x4& kr, const u32x4& vr) {
    const int key = tid >> 3, ch = tid & 7;
    *(LAS u32x4*)(Kb + key * NS_KROW + ch * 16) = kr;
    *(LAS u32x4*)(Vb + key * NS_VROW + ch * 16) = vr;
}
__device__ __forceinline__ void ns_qk(LAS unsigned char* Kb, const bf16x8 (&qf)[4], int r, int h2, f32x16 (&sacc)[2]) {
#pragma unroll
    for (int sub = 0; sub < 2; ++sub) { f32x16 a;
#pragma unroll
        for (int i = 0; i < 16; ++i) a[i] = 0.f;
#pragma unroll
        for (int kk = 0; kk < 4; ++kk) { const bf16x8 kf = *(const LAS bf16x8*)(Kb + (32 * sub + r) * NS_KROW + (8 * h2 + 16 * kk) * 2); a = __builtin_amdgcn_mfma_f32_32x32x16_bf16(kf, qf[kk], a, 0, 0, 0); }
        sacc[sub] = a; }
}
enum { NS_CMP = 0, NS_SEL_ = 1, NS_WIN = 2 };
template <int MODE> __device__ __forceinline__ bool ns_valid(int key, int t, bool blk_on) {
    if (MODE == NS_CMP) return 16 * key + 31 <= t;
    if (MODE == NS_SEL_) return blk_on && key <= t;
    return key <= t && key + 511 >= t;
}
template <int MODE>
__device__ __forceinline__ void ns_branch(Frame& F, const bf16* kbase, const bf16* vbase, size_t stride, int tile_lo, int tile_hi, const bf16x8 (&qf)[4], int t, int r, int h2,
                                          const unsigned (&selw)[4], NsaRow& R) {
    LAS unsigned char* L = F.lds;
    R.m = -1e30f; R.l = 0.f;
#pragma unroll
    for (int e = 0; e < 2; ++e)
#pragma unroll
        for (int i = 0; i < 16; ++i) R.o[e][i] = 0.f;
    if (tile_hi <= tile_lo) return;
    u32x4 kr, vr;
    ns_load(kbase + (size_t)tile_lo * 64 * stride, vbase + (size_t)tile_lo * 64 * stride, stride, F.tid, kr, vr);
    __syncthreads();
    ns_store(L + NS_K0, L + NS_V0, F.tid, kr, vr);
    __syncthreads();
    for (int ti = tile_lo; ti < tile_hi; ++ti) {
        const int buf = (ti - tile_lo) & 1;
        if (ti + 1 < tile_hi) ns_load(kbase + (size_t)(ti + 1) * 64 * stride, vbase + (size_t)(ti + 1) * 64 * stride, stride, F.tid, kr, vr);
        LAS unsigned char* Kb = L + NS_K0 + buf * NS_KB; LAS unsigned char* Vb = L + NS_V0 + buf * NS_VB;
        bool blk_on = true;
        if (MODE == NS_SEL_) blk_on = (selw[ti >> 5] >> (ti & 31)) & 1u;
        bool any;
        if (MODE == NS_CMP) any = 16 * (ti * 64) + 31 <= t; else if (MODE == NS_SEL_) any = blk_on && ti * 64 <= t; else any = (ti * 64 <= t) && (ti * 64 + 63 + 511 >= t);
        if (__ballot(any) != 0ull) {
            f32x16 sacc[2];
            ns_qk(Kb, qf, r, h2, sacc);
            bool full;
            { const int tmin = t - (r & 7), tmax = tmin + 7;
              if (MODE == NS_CMP) full = 16 * (ti * 64 + 63) + 31 <= tmin; else if (MODE == NS_SEL_) full = ti * 64 + 63 <= tmin; else full = (ti * 64 + 63 <= tmin) && (ti * 64 + 511 >= tmax); }
            float sc, rs = 0.f;
            if (full) {
                const bool rowon = (MODE != NS_SEL_) || blk_on;
                float m0 = sacc[0][0], m1 = sacc[1][0];
#pragma unroll
                for (int i = 1; i < 16; ++i) { m0 = fmaxf(m0, sacc[0][i]); m1 = fmaxf(m1, sacc[1][i]); }
                float mt = rowon ? fmaxf(m0, m1) : -1e30f;
                mt = fmaxf(mt, __shfl_xor(mt, 32));
                const float mn = fmaxf(R.m, mt); sc = __expf(R.m - mn);
                const float nb = -1.44269504f * (rowon ? mn : 1e30f);
#pragma unroll
                for (int sub = 0; sub < 2; ++sub)
#pragma unroll
                    for (int i = 0; i < 16; ++i) { const float p = __builtin_amdgcn_exp2f(__builtin_fmaf(sacc[sub][i], 1.44269504f, nb)); sacc[sub][i] = p; rs += p; }
                rs += __shfl_xor(rs, 32);
                R.l = R.l * sc + rs; R.m = mn;
            } else {
            float mt = -1e30f;
#pragma unroll
            for (int sub = 0; sub < 2; ++sub)
#pragma unroll
                for (int i = 0; i < 16; ++i) { const int key = ti * 64 + 32 * sub + (i & 3) + 8 * (i >> 2) + 4 * h2; const float sv = ns_valid<MODE>(key, t, blk_on) ? sacc[sub][i] : -1e30f; sacc[sub][i] = sv; mt = fmaxf(mt, sv); }
            mt = fmaxf(mt, __shfl_xor(mt, 32));
            const float mn = fmaxf(R.m, mt); sc = __expf(R.m - mn);
#pragma unroll
            for (int sub = 0; sub < 2; ++sub)
#pragma unroll
                for (int i = 0; i < 16; ++i) { const float sv = sacc[sub][i]; const float p = sv > -1e29f ? __expf(sv - mn) : 0.f; sacc[sub][i] = p; rs += p; }
            rs += __shfl_xor(rs, 32);
            R.l = R.l * sc + rs; R.m = mn;
            }
            if (__ballot(sc != 1.0f) != 0ull) {
#pragma unroll
                for (int e = 0; e < 2; ++e)
#pragma unroll
                    for (int i = 0; i < 16; ++i) R.o[e][i] *= sc; }
#pragma unroll
            for (int sub = 0; sub < 2; ++sub)
#pragma unroll
                for (int s2 = 0; s2 < 2; ++s2) {
                    union { bf16x8 v; unsigned w[4]; } pf;
#pragma unroll
                    for (int j = 0; j < 4; ++j) pf.w[j] = cvt_pk_bf16(sacc[sub][8 * s2 + 2 * j], sacc[sub][8 * s2 + 2 * j + 1]);
#pragma unroll
                    for (int e = 0; e < 2; ++e) {
                        const LAS unsigned char* vp = Vb + (32 * sub + 16 * s2 + 4 * h2 + ((F.lane & 15) >> 2)) * NS_VROW + (32 * e + 16 * ((F.lane >> 4) & 1) + 4 * (F.lane & 3)) * 2;
                        const s16x4 va = __builtin_amdgcn_ds_read_tr16_b64_v4i16((LAS s16x4*)vp), vb = __builtin_amdgcn_ds_read_tr16_b64_v4i16((LAS s16x4*)(vp + 8 * NS_VROW));
                        const bf16x8 vf = {va[0], va[1], va[2], va[3], vb[0], vb[1], vb[2], vb[3]};
                        R.o[e] = __builtin_amdgcn_mfma_f32_32x32x16_bf16(vf, pf.v, R.o[e], 0, 0, 0);
                    }
                }
        }
        if (ti + 1 < tile_hi) ns_store(L + NS_K0 + (buf ^ 1) * NS_KB, L + NS_V0 + (buf ^ 1) * NS_VB, F.tid, kr, vr);
        __syncthreads();
    }
}
__device__ __forceinline__ void ns_importance(Frame& F, const bf16* kbase, int ntiles, const bf16x8 (&qf)[4], int t, int r, int h2, float m, float inv_l) {
    LAS unsigned char* L = F.lds; LAS float* imp = (LAS float*)(L + NS_IMP);
    const int qrow = F.wave * 8 + (r & 7);
    u32x4 kr, vr;
    ns_load(kbase, kbase, 64, F.tid, kr, vr);
    __syncthreads();
    ns_store(L + NS_K0, L + NS_V0, F.tid, kr, vr);
    __syncthreads();
    for (int ti = 0; ti < ntiles; ++ti) {
        const int buf = ti & 1;
        if (ti + 1 < ntiles) ns_load(kbase + (size_t)(ti + 1) * 64 * 64, kbase + (size_t)(ti + 1) * 64 * 64, 64, F.tid, kr, vr);
        LAS unsigned char* Kb = L + NS_K0 + buf * NS_KB;
        f32x16 sacc[2];
        ns_qk(Kb, qf, r, h2, sacc);
#pragma unroll
        for (int sub = 0; sub < 2; ++sub)
#pragma unroll
            for (int g = 0; g < 4; ++g) {
                float p[4];
#pragma unroll
                for (int x = 0; x < 4; ++x) { const int key = ti * 64 + 32 * sub + x + 8 * g + 4 * h2; p[x] = (16 * key + 31 <= t) ? __expf(sacc[sub][4 * g + x] - m) * inv_l : 0.f; }
                float G = (p[0] + p[1]) + (p[2] + p[3]), E = p[3];
                G += __shfl_xor(G, 8); G += __shfl_xor(G, 16); E += __shfl_xor(E, 8); E += __shfl_xor(E, 16);
                const int jj = ti * 16 + 8 * sub + 2 * g + h2;
                if (r < 8) { atomicAdd((float*)(imp + qrow * 128 + jj), G); if (jj + 1 < 128) atomicAdd((float*)(imp + qrow * 128 + jj + 1), E); }
            }
        if (ti + 1 < ntiles) ns_store(L + NS_K0 + (buf ^ 1) * NS_KB, L + NS_V0 + (buf ^ 1) * NS_VB, F.tid, kr, vr);
        __syncthreads();
    }
}
__device__ __forceinline__ void nsa_unit(Frame& F, int b, int c) {
    const bf16* u = (const bf16*)(F.ws + WS_U); bf16* bo = (bf16*)(F.ws + WS_BO);
    const bf16* kcmp = (const bf16*)(F.ws + WS_KCMP) + (size_t)b * 512 * 64; const bf16* vcmp = (const bf16*)(F.ws + WS_VCMP) + (size_t)b * 512 * 64;
    LAS unsigned char* L = F.lds; LAS float* imp = (LAS float*)(L + NS_IMP); LAS unsigned* selL = (LAS unsigned*)(L + NS_SEL);
    int lane = F.lane; asm volatile("" : "+v"(lane));
    const int r = lane & 31, h2 = lane >> 5, head = r >> 3, ql = r & 7;
    const int t = 64 * c + 8 * F.wave + ql; const size_t row = (size_t)b * S + t;
    const bf16* ub = u + (size_t)b * S * UW;
    bf16x8 qf[4];
#pragma unroll
    for (int kk = 0; kk < 4; ++kk) { const u32x4 w = *(const u32x4*)(u + row * UW + U_NSA + head * 64 + 8 * h2 + 16 * kk); f32x4 a, bb; unpack8(w, a, bb);
        union { bf16x8 v; u32x4 q; } cv; cv.q = pack8(a * 0.125f, bb * 0.125f); qf[kk] = cv.v; }
    const float g_cmp = fsigmoid(ldu(u, row, U_NSA + 640 + head)), g_sel = fsigmoid(ldu(u, row, U_NSA + 644 + head)), g_win = fsigmoid(ldu(u, row, U_NSA + 648 + head));
    unsigned selw[4] = {0xffffffffu, 0xffffffffu, 0xffffffffu, 0xffffffffu};
    NsaRow R;
    const int ncmp_tiles = (4 * c + 3 + 63) >> 6;
    ns_branch<NS_CMP>(F, kcmp, vcmp, 64, 0, ncmp_tiles, qf, t, r, h2, selw, R);
    LAS f32x4* stash = (LAS f32x4*)(L + NS_OUT + F.wave * 8192) + lane;
    { const float inv = R.l > 0.f ? 1.0f / R.l : 0.f; const float gs = g_cmp * inv;
#pragma unroll
      for (int e = 0; e < 2; ++e)
#pragma unroll
        for (int g = 0; g < 4; ++g) stash[(e * 4 + g) * 64] = (f32x4){R.o[e][4 * g] * gs, R.o[e][4 * g + 1] * gs, R.o[e][4 * g + 2] * gs, R.o[e][4 * g + 3] * gs};
      if (c >= 15) {
        for (int i = F.tid; i < 64 * 128; i += NTHR) imp[i] = 0.f;
        __syncthreads();
        ns_importance(F, kcmp, ncmp_tiles, qf, t, r, h2, R.m, inv);
        for (int q8 = 0; q8 < 8; ++q8) { const int qrow = F.wave * 8 + q8;
            float sc0, sc1;
            { const int j0 = lane, j1 = lane + 64;
              const bool f0 = (j0 == 0) || (j0 == c) || (j0 == c - 1), f1 = (j1 == c) || (j1 == c - 1);
              sc0 = f0 ? 1e30f : (j0 <= c ? imp[qrow * 128 + j0] : -1e30f); sc1 = f1 ? 1e30f : (j1 <= c ? imp[qrow * 128 + j1] : -1e30f); }
            unsigned long long lo = 0ull, hi = 0ull;
            for (int it = 0; it < 16; ++it) {
                const float best = wave_max(fmaxf(sc0, sc1));
                const unsigned long long m0 = __ballot(sc0 == best), m1 = __ballot(sc1 == best);
                int idx; if (m0) idx = __builtin_ctzll(m0); else idx = 64 + __builtin_ctzll(m1);
                if (idx < 64) { lo |= 1ull << idx; if (lane == idx) sc0 = -3e38f; } else { hi |= 1ull << (idx - 64); if (lane == idx - 64) sc1 = -3e38f; }
            }
            if (lane == 0) { selL[qrow * 4 + 0] = (unsigned)lo; selL[qrow * 4 + 1] = (unsigned)(lo >> 32); selL[qrow * 4 + 2] = (unsigned)hi; selL[qrow * 4 + 3] = (unsigned)(hi >> 32); }
        }
        LDS_WAIT();
#pragma unroll
        for (int j = 0; j < 4; ++j) selw[j] = selL[(F.wave * 8 + ql) * 4 + j];
      }
    }
    ns_branch<NS_SEL_>(F, ub + U_NSA + 384, ub + U_NSA + 448, UW, 0, c + 1, qf, t, r, h2, selw, R);
    { const float gs = g_sel / R.l;
#pragma unroll
      for (int e = 0; e < 2; ++e)
#pragma unroll
        for (int g = 0; g < 4; ++g) { f32x4 a = stash[(e * 4 + g) * 64]; a += (f32x4){R.o[e][4 * g] * gs, R.o[e][4 * g + 1] * gs, R.o[e][4 * g + 2] * gs, R.o[e][4 * g + 3] * gs}; stash[(e * 4 + g) * 64] = a; } }
    ns_branch<NS_WIN>(F, ub + U_NSA + 512, ub + U_NSA + 576, UW, c >= 8 ? c - 8 : 0, c + 1, qf, t, r, h2, selw, R);
    f32x16 out[2];
    { const float gs = g_win / R.l;
#pragma unroll
      for (int e = 0; e < 2; ++e)
#pragma unroll
        for (int g = 0; g < 4; ++g) { const f32x4 a = stash[(e * 4 + g) * 64];
#pragma unroll
            for (int x = 0; x < 4; ++x) out[e][4 * g + x] = a[x] + R.o[e][4 * g + x] * gs; } }
#pragma unroll
    for (int e = 0; e < 2; ++e)
#pragma unroll
        for (int g = 0; g < 4; ++g) { u32x2 w; w.x = cvt_pk_bf16(out[e][4 * g], out[e][4 * g + 1]); w.y = cvt_pk_bf16(out[e][4 * g + 2], out[e][4 * g + 3]);
            *(u32x2*)(bo + row * 1024 + head * 64 + 32 * e + 8 * g + 4 * h2) = w; }
}

__device__ __forceinline__ void cmp2_item(Frame& F, int L, int item) {
    int lane = F.lane; asm volatile("" : "+v"(lane));
    const int kv = item & 1, it = (item >> 1) & 15, b = item >> 5, r32 = lane & 31, hh = lane >> 5;
    const bf16* w2T = (const bf16*)(F.ws + WS_CW2 + (size_t)L * 65536) + kv * 64 * 128;
    const bf16* hid = (const bf16*)(F.ws + WS_CMPH) + ((size_t)(b * 512 + 32 * it)) * 256 + kv * 128;
    bf16* outp = (bf16*)(F.ws + (kv ? WS_VCMP : WS_KCMP)) + ((size_t)(b * 512 + 32 * it + r32)) * 64;
    const bool live = (32 * it + r32) < NCMP;
#pragma unroll
    for (int et = 0; et < 2; ++et) { f32x16 acc = zero16();
#pragma unroll
        for (int ks = 0; ks < 8; ++ks) acc = mma32(frag_g(w2T, 128, 32 * et, 16 * ks, lane), frag_g(hid, 256, 0, 16 * ks, lane), acc);
#pragma unroll
        for (int g = 0; g < 4; ++g) { u32x2 w; w.x = live ? cvt_pk_bf16(acc[4 * g], acc[4 * g + 1]) : 0u; w.y = live ? cvt_pk_bf16(acc[4 * g + 2], acc[4 * g + 3]) : 0u;
            *(u32x2*)(outp + 32 * et + 8 * g + 4 * hh) = w; } }
}
#ifdef SK_RWM1
#define RWM1(x)
#else
#define RWM1(x) x
#endif
#ifdef SK_RWM3
#define RWM3(x)
#else
#define RWM3(x) x
#endif
#ifdef SK_RWSC
#define RWSC(x)
#else
#define RWSC(x) x
#endif
__device__ __forceinline__ void phase_m1(Frame& F0, int L, bf16* hgS, bf16* rtS) {
    Frame F = F0; asm volatile("" : "+v"(F.tid)); F.lane = F.tid & 63;
    if (F.bx < 32) { LAS float* c1l = (LAS float*)(F.lds + RSTD_OFF + 1024);
      if (F.tid < 256) { const float* cp = (const float*)(F.ws + WS_CW2 + (size_t)L * 65536 + 32768) + (F.tid >> 7) * 32 * 128 + (F.tid & 127); float a = 0.f;
          for (int jq = 0; jq < 32; ++jq) a += cp[jq * 128];
          c1l[F.tid] = a; }
      __syncthreads(); }
    { CmpSched Sd{(const char*)(F.ws + WS_U), (const char*)(F.ws + WS_CW1 + (size_t)L * MiB), F.bx};
      EpiCmp E{(bf16*)(F.ws + WS_CMPH)};
      pg8::gemm_phase<EpiCmp, CmpSched, true>(F.lds + RING_OFF, Sd, E, (unsigned)(UW * 2), 128u); }
    LAS unsigned char* W = F.lds + F.wave * WREG;
    const int gw = F.bx * NWAVES + F.wave, NGW = F.G * NWAVES;
    for (int it = gw; it < 3 * 32 * NCH; it += NGW) { const int type = it % 3, q = it / 3, bh = q / NCH, n = q % NCH;
        if (type == 0) hgrn_chunk<false>(F, L, bh, n, W, hgS, (float*)(F.ws + WS_HGD)); else if (type == 1) ret_chunk<false>(F, L, bh, n, W, rtS); else { RWM1(rwkv_chunk<false>(F, L, bh, n, W)); } }
}
__device__ __forceinline__ void phase_scan(Frame& F0, int L, bf16* hgS, bf16* rtS) {
    Frame F = F0; asm volatile("" : "+v"(F.tid)); F.lane = F.tid & 63;
    if (F.tid < 256) {
        if (F.bx < 128) glin_scan_task(hgS, (const float*)(F.ws + WS_HGD), 0.f, F.bx >> 2, F.bx & 3, F.tid);
        else { const int k = F.bx - 128, h = (k >> 2) & 3; const float g = 1.0f - exp2f(-5.0f - (float)h); glin_scan_task(rtS, nullptr, exp2f(32.0f * __log2f(g)), k >> 2, k & 3, F.tid); }
    } else if (F.wave == 4) { if (F.bx < 64) { RWSC(rwkv_scan_task(F, F.bx >> 1, F.bx & 1)); } }
    else { for (int item = F.bx * 3 + (F.wave - 5); item < 256; item += F.G * 3) cmp2_item(F, L, item); }
}
__device__ __forceinline__ void phase_m3(Frame& F0, int L, bf16* hgS, bf16* rtS) {
    Frame F = F0; asm volatile("" : "+v"(F.tid)); F.lane = F.tid & 63;
    LAS unsigned char* W = F.lds + F.wave * WREG;
    const int gw = F.bx * NWAVES + F.wave, NGW = F.G * NWAVES;
    for (int it = gw; it < REP_ITEMS * 3 * 32 * NCH; it += NGW) { const int type = it % 3, q = (it / 3) % (32 * NCH), bh = q / NCH, n = q % NCH;
        if (type == 0) hgrn_chunk<true>(F, L, bh, n, W, hgS, nullptr); else if (type == 1) ret_chunk<true>(F, L, bh, n, W, rtS); else { RWM3(rwkv_chunk<true>(F, L, bh, n, W)); } }
    __syncthreads();
#ifndef SK_NSA
    for (int p = F.bx; p < REP_NSA * 512; p += F.G) { const int b = (p >> 6) & 7, cc = p & 63; nsa_unit(F, b, 127 - cc); nsa_unit(F, b, cc); }
#endif
}

__device__ __forceinline__ void phase_pconv(Frame& F0, int L) {
    Frame F = F0; asm volatile("" : "+v"(F.tid)); F.lane = F.tid & 63;
    const float* p = F.in[I_P] + (size_t)L * T * PLE; bf16* pbf = (bf16*)(F.ws + WS_PB);
    for (int r = F.bx * NWAVES + F.wave; r < T; r += F.G * NWAVES) { const f32x4 v = *((const f32x4*)(p + (size_t)r * PLE) + F.lane); u32x2 w; w.x = cvt_pk_bf16(v[0], v[1]); w.y = cvt_pk_bf16(v[2], v[3]); *((u32x2*)(pbf + (size_t)r * PLE) + F.lane) = w; }
}
__device__ __forceinline__ void phase_final_a(Frame& F0, const float* ss, float* rtab) {
    Frame F = F0; asm volatile("" : "+v"(F.tid)); F.lane = F.tid & 63;
    for (int r = F.bx * NTHR + F.tid; r < T; r += F.G * NTHR) rtab[r] = __builtin_amdgcn_rsqf(ss_row(ss, r) * (1.0f / D) + EPS);
}
__device__ __forceinline__ void phase_final_b(Frame& F0, const float* rtab, const bf16* hb) {
    Frame F = F0; asm volatile("" : "+v"(F.tid)); F.lane = F.tid & 63;
    const float* g = F.in[I_NORM_FINAL]; const int gw = F.bx * NWAVES + F.wave, NGW = F.G * NWAVES;
    for (int r = gw; r < T; r += NGW) { const float rs = rtab[r]; const u32x4* hr = (const u32x4*)(hb + (size_t)r * D) + F.lane; f32x4* orow = (f32x4*)(F.out + (size_t)r * D);
#pragma unroll
        for (int j = 0; j < 2; ++j) { f32x4 a, b; unpack8(hr[64 * j], a, b); const f32x4 g0 = *((const f32x4*)g + 2 * (F.lane + 64 * j)), g1 = *((const f32x4*)g + 2 * (F.lane + 64 * j) + 1);
            orow[2 * (F.lane + 64 * j)] = a * rs * g0; orow[2 * (F.lane + 64 * j) + 1] = b * rs * g1; } }
}

constexpr int PH_PER_LAYER = 9, N_PHASES = 1 + NL * PH_PER_LAYER + 2;
__global__ void __launch_bounds__(NTHR, 2) mega_fwd(Args args) {
    extern __shared__ __attribute__((aligned(16))) unsigned char lds_raw[];
    Frame F; F.lds = (LAS unsigned char*)lds_raw; F.tid = threadIdx.x; F.lane = F.tid & 63; F.wave = __builtin_amdgcn_readfirstlane(F.tid >> 6); F.G = gridDim.x; F.bx = blockIdx.x;
    F.in = args.in; F.out = args.out; F.ws = args.ws;
    volatile LAS unsigned* MISC = (volatile LAS unsigned*)(F.lds + MISC_OFF);
    if (F.tid < 32) MISC[F.tid] = 0u;
    __syncthreads();
    unsigned* ctl = (unsigned*)(F.ws + WS_CTL);
    XcdBarrier bar; bar.bar = ctl + CW_BAR; bar.x = 0; bar.st = nullptr;
    if (MK_N_LAUNCHES == 1) bar = xcd_barrier_post(ctl + CW_BAR, MISC + 8);
    const int lo = args.ph_lo, hi = args.ph_hi;
#define IN(k) (lo <= (k) && (k) < hi)
#define REPS(k) (((k) == REP_PHASE || (k) == REP_PHASE + 9) ? 2 : 1)
#define SEAM(k) do { if (IN(k) && IN((k) + 1)) xcd_barrier(bar); } while (0)
    float* ssb = F.out;
    LAS unsigned char* ring = F.lds + RING_OFF;

    #ifndef SK_PRO
    for (int rep = 0; rep < ((REP_PHASE == 0) ? 2 : 1); ++rep) if (IN(0)) { if (rep) xcd_barrier(bar); phase_prologue(F); }
#endif
    SEAM(0);

    for (int L = 0; L < NL; ++L) {
        const int pb = 1 + L * PH_PER_LAYER;
        unsigned char* wl = F.ws + WS_W + (size_t)L * WL_STRIDE;
        bf16* hb_cur = (bf16*)(F.ws + ((L & 1) ? WS_HBB : WS_HBA)); bf16* hb_oth = (bf16*)(F.ws + ((L & 1) ? WS_HBA : WS_HBB));
        const float* ss_mix = ssb + (size_t)(3 * L) * T * 16; float* ss_ffn = ssb + (size_t)(3 * L + 1) * T * 16; float* ss_ple = ssb + (size_t)(3 * L + 2) * T * 16; float* ss_next = ssb + (size_t)(3 * L + 3) * T * 16;
#ifndef SK_G1
        for (int rep = 0; rep < REPS(pb + 0); ++rep) if (IN(pb + 0)) { PlainSched Sd{(const char*)hb_cur, (const char*)(wl + WL_IN), D * 2, D * 2, D / 64, T / 256, UW / 256, F.G, F.bx};
            EpiScaleBf16 E{(bf16*)(F.ws + WS_U), UW, ss_mix}; pg8::gemm_phase(ring, Sd, E); }
#endif
        SEAM(pb + 0);
        bf16* hgS = hb_oth; bf16* rtS = hb_oth + (size_t)32 * NCH * 4096;
        for (int rep = 0; rep < REPS(pb + 1); ++rep) if (IN(pb + 1)) { if (rep) xcd_barrier(bar); phase_m1(F, L, hgS, rtS); }
        SEAM(pb + 1);
#ifndef EXP_NOSCAN
        if (IN(pb + 2)) phase_scan(F, L, hgS, rtS);
#endif
        SEAM(pb + 2);
        if (IN(pb + 3)) phase_m3(F, L, hgS, rtS);
        SEAM(pb + 3);
#ifndef SK_G2
        for (int rep = 0; rep < REPS(pb + 4); ++rep) if (IN(pb + 4)) { PairSched Sd{(const char*)hb_cur, (const char*)(wl + WL_G), D * 2, D * 2, D / 64, (size_t)D * D * 2,
                                        (const char*)(F.ws + WS_BO), (const char*)(wl + WL_B), 1024 * 2, MW * 2, MW / 64, (size_t)MW * 2, (size_t)D * MW * 2, 4, T / 256, D / 256, F.G, F.bx};
            u32x4* scr = (u32x4*)(F.ws + WS_SCR + (size_t)F.bx * 262144);
            EpiMerge E{scr, scr + 8192, (bf16*)(F.ws + WS_MERGED), ss_mix, F.in[I_BGATE] + (size_t)L * 4 * D, 4}; pg8::gemm_phase(ring, Sd, E); }
#endif
        SEAM(pb + 4);
#ifndef SK_G3
        if (IN(pb + 5)) phase_pconv(F, L);
        if (IN(pb + 5)) { PlainSched Sd{(const char*)(F.ws + WS_MERGED), (const char*)(wl + WL_OUT), D * 2, D * 2, D / 64, T / 256, D / 256, F.G, F.bx};
            EpiResidual E{(L == 0) ? F.in[I_X] : nullptr, hb_cur, ss_ffn}; pg8::gemm_phase(ring, Sd, E); }
#endif
        SEAM(pb + 5);
#ifndef SK_G4
        for (int rep = 0; rep < REPS(pb + 6); ++rep) if (IN(pb + 6)) { PlainSched Sd{(const char*)hb_cur, (const char*)(wl + WL_FF), D * 2, D * 2, D / 64, T / 256, (2 * DFF) / 256, F.G, F.bx};
            EpiSwiGLU E{(bf16*)(F.ws + WS_FFH), ss_ffn}; pg8::gemm_phase(ring, Sd, E); }
#endif
        SEAM(pb + 6);
#ifndef SK_G5
        if (IN(pb + 7)) { PlainSched Sd{(const char*)(F.ws + WS_FFH), (const char*)(wl + WL_DN), DFF * 2, DFF * 2, DFF / 64, T / 256, D / 256, F.G, F.bx};
            EpiResidual E{nullptr, hb_cur, ss_ple}; pg8::gemm_phase(ring, Sd, E); }
#endif
        SEAM(pb + 7);
#ifndef SK_G6
        if (IN(pb + 8)) { PairSched Sd{(const char*)hb_cur, (const char*)(wl + WL_PG), D * 2, D * 2, D / 64, 0,
                                        (const char*)(F.ws + WS_PB), (const char*)(wl + WL_PP), PLE * 2, PLE * 2, PLE / 64, 0, 0, 1, T / 256, D / 256, F.G, F.bx};
            u32x4* scr = (u32x4*)(F.ws + WS_SCR + (size_t)F.bx * 262144);
            EpiPle E{scr, hb_cur, hb_oth, ss_ple, ss_next}; pg8::gemm_phase(ring, Sd, E); }
#endif
        SEAM(pb + 8);
    }
#ifndef SK_FIN
    if (IN(N_PHASES - 2)) phase_final_a(F, ssb + (size_t)(3 * NL) * T * 16, (float*)(F.ws + WS_CTL) + 65536);
    SEAM(N_PHASES - 2);
    if (IN(N_PHASES - 1)) phase_final_b(F, (const float*)(F.ws + WS_CTL) + 65536, (const bf16*)(F.ws + ((NL & 1) ? WS_HBB : WS_HBA)));
#endif
#undef IN
#undef SEAM
}

extern "C" void kernel_launch(void* const* d_in, const int* in_sizes, int n_in, void* d_out, int out_size, void* d_ws, size_t ws_size, hipStream_t stream) {
    static int grid = 0;
    if (grid == 0) {
        if (n_in != 37 || in_sizes[0] != T * D || out_size != T * D || ws_size < WS_END) { fprintf(stderr, "kernel_launch: unexpected shapes (n_in %d, ws %zu)\n", n_in, ws_size); grid = -1; return; }
        int dev = 0, cus = 0, per_cu = 0;
        if (hipGetDevice(&dev) != hipSuccess || hipDeviceGetAttribute(&cus, hipDeviceAttributeMultiprocessorCount, dev) != hipSuccess) { grid = -1; return; }
        if (hipFuncSetAttribute((const void*)mega_fwd, hipFuncAttributeMaxDynamicSharedMemorySize, LDS_BYTES) != hipSuccess) { fprintf(stderr, "kernel_launch: hipFuncSetAttribute failed\n"); grid = -1; return; }
        if (hipOccupancyMaxActiveBlocksPerMultiprocessor(&per_cu, (const void*)mega_fwd, NTHR, LDS_BYTES) != hipSuccess || per_cu < 1) { fprintf(stderr, "kernel_launch: occupancy query says %d\n", per_cu); }
        (void)hipGetLastError();
        grid = cus;
    }
    if (grid < 0) return;
    hipMemsetAsync((char*)d_ws + WS_CTL, 0, CTL_BYTES, stream);
    Args a{};
    for (int i = 0; i < 37; ++i) a.in[i] = (const float*)d_in[i];
    a.out = (float*)d_out; a.ws = (unsigned char*)d_ws;
    if (MK_N_LAUNCHES == 1) { a.ph_lo = 0; a.ph_hi = N_PHASES; hipLaunchKernelGGL(mega_fwd, dim3(grid), dim3(NTHR), LDS_BYTES, stream, a); }
    else for (int p = 0; p < N_PHASES; ++p) { a.ph_lo = p; a.ph_hi = p + 1; hipLaunchKernelGGL(mega_fwd, dim3(grid), dim3(NTHR), LDS_BYTES, stream, a); }
}
```

```cpp
#include <hip/hip_runtime.h>
#include <cstdio>
#include <cstdint>

#ifndef REP_ITEMS
#define REP_ITEMS 1
#endif
#ifndef REP_NSA
#define REP_NSA 1
#endif
#ifndef REP_PHASE
#define REP_PHASE (-1)
#endif
#ifndef MK_N_LAUNCHES
#define MK_N_LAUNCHES 1
#endif

#define LAS __attribute__((address_space(3)))
#define GAS __attribute__((address_space(1)))
typedef unsigned short bf16;
typedef short bf16x8 __attribute__((ext_vector_type(8)));
typedef float f32x4 __attribute__((ext_vector_type(4)));
typedef float f32x16 __attribute__((ext_vector_type(16)));
typedef unsigned u32x4 __attribute__((ext_vector_type(4)));
typedef unsigned u32x2 __attribute__((ext_vector_type(2)));
typedef short s16x4 __attribute__((ext_vector_type(4)));

constexpr int D = 1024, NB = 8, S = 8192, T = NB * S, NL = 2;
constexpr int NH = 4, HD = 64, MW = 256, DFF = 2816, PLE = 256;
constexpr int DIN = 3724, UW = 3840;
constexpr int U_NSA = 0, U_HG = 768, U_RT = 1792, U_RW = 2816;
constexpr int NCMP = 511, NSEL = 128;
constexpr float EPS = 1e-6f;

constexpr size_t MiB = 1u << 20;
constexpr size_t WS_CTL = 0, CTL_BYTES = 4 * MiB;
constexpr size_t WS_W = 4 * MiB;
constexpr size_t WL_IN = 0, WL_G = 8 * MiB, WL_B = 16 * MiB, WL_OUT = 18 * MiB, WL_FF = 20 * MiB, WL_DN = 31 * MiB, WL_PG = 37 * MiB, WL_PP = 39 * MiB, WL_STRIDE = 40 * MiB;
constexpr size_t WS_MISC = 84 * MiB;
constexpr size_t WS_ROPE = WS_MISC, WS_KCMP = WS_MISC + 2 * MiB, WS_VCMP = WS_MISC + 2 * MiB + 512 * 1024, WS_RWUP = WS_MISC + 3 * MiB;
constexpr size_t WS_HBA = 88 * MiB, WS_HBB = 216 * MiB;
constexpr size_t WS_BO = 344 * MiB;
constexpr size_t WS_U = 472 * MiB;
constexpr size_t WS_MERGED = WS_U, WS_SCR = WS_U + 416 * MiB;
constexpr size_t WS_FFH = WS_U;
constexpr size_t WS_PB = WS_U + 352 * MiB;
constexpr size_t WS_RWN = 952 * MiB;
constexpr size_t WS_HGD = 1016 * MiB;
constexpr size_t WS_RWM = WS_BO;
constexpr size_t WS_CMPH = 1018 * MiB;
constexpr size_t WS_CW1 = 1020 * MiB;
constexpr size_t WS_CW2 = 1022 * MiB;
constexpr size_t WS_END = 1024 * MiB;
constexpr int CH = 32, NCH = S / CH;
constexpr int CW_BAR = 4096;
constexpr int CW_C1 = 16384;
constexpr int NSS = 7;

#define LDS_WAIT() asm volatile("s_waitcnt lgkmcnt(0)" ::: "memory")
#define VM_WAIT() asm volatile("s_waitcnt vmcnt(0)" ::: "memory")
typedef __bf16 hbf16x2 __attribute__((ext_vector_type(2)));
typedef float f32x2v __attribute__((ext_vector_type(2)));
__device__ __forceinline__ unsigned cvt_pk_bf16(float lo, float hi) { const f32x2v v = {lo, hi}; const hbf16x2 b = __builtin_convertvector(v, hbf16x2); return __builtin_bit_cast(unsigned, b); }
__device__ __forceinline__ float bf2f(unsigned short b) { return __builtin_bit_cast(float, ((unsigned)b) << 16); }
__device__ __forceinline__ float bflo(unsigned w) { return __builtin_bit_cast(float, w << 16); }
__device__ __forceinline__ float bfhi(unsigned w) { return __builtin_bit_cast(float, w & 0xffff0000u); }
__device__ __forceinline__ float fsigmoid(float z) { return __builtin_amdgcn_rcpf(1.0f + __builtin_amdgcn_exp2f(-1.44269504f * z)); }
__device__ __forceinline__ float fsilu(float z) { return z * fsigmoid(z); }
__device__ __forceinline__ float wave_sum(float v) {
#pragma unroll
    for (int o = 1; o < 64; o <<= 1) v += __shfl_xor(v, o);
    return v;
}
__device__ __forceinline__ float wave_max(float v) {
#pragma unroll
    for (int o = 1; o < 64; o <<= 1) v = fmaxf(v, __shfl_xor(v, o));
    return v;
}

#define XB_TMO      128
#define XB_XCNT(j)  (256  + 64 * (j))
#define XB_XSUB(j)  (1280 + 64 * (j))
#define XB_XGEN(j)  (2304 + 64 * (j))
#define XB_TOP      3328
#define XB_TOPGEN   3392
#define XCD_BAR_WORDS 3456
#define XB_SPIN_CAP (1u << 24)
__device__ __forceinline__ unsigned xb_ld(unsigned* p)              { return __hip_atomic_load(p, __ATOMIC_RELAXED, __HIP_MEMORY_SCOPE_AGENT); }
__device__ __forceinline__ unsigned xb_add(unsigned* p, unsigned v) { return __hip_atomic_fetch_add(p, v, __ATOMIC_RELAXED, __HIP_MEMORY_SCOPE_AGENT); }
__device__ __forceinline__ unsigned xb_xcc_id() { return (unsigned)__builtin_amdgcn_s_getreg((3 << 11) | 20) & 0xFu; }
#define XB_SPIN(cond, bar) do { unsigned _sp = 0; while (cond) { __builtin_amdgcn_s_sleep(1); \
    if ((++_sp & 255u) == 0u) { if (xb_ld(&(bar)[XB_TMO])) break; if (_sp > XB_SPIN_CAP) { atomicAdd(&(bar)[XB_TMO], 1u); break; } } } } while (0)
struct XcdBarrier { unsigned* bar; unsigned x; volatile LAS unsigned* st; };
__device__ __forceinline__ XcdBarrier xcd_barrier_post(unsigned* bar, volatile LAS unsigned* st) {
    XcdBarrier b; b.bar = bar; b.x = xb_xcc_id(); b.st = st;
    if (threadIdx.x == 0) (void)xb_add(&bar[XB_XCNT(b.x)], 1u);
    return b;
}
__device__ __forceinline__ void xcd_barrier_complete(unsigned* bar, unsigned x, unsigned& nloc, unsigned& nx) {
    const unsigned G = gridDim.x * gridDim.y * gridDim.z;
    unsigned sum, cnt, mine, sp = 0u;
    for (;;) {
        sum = 0u; cnt = 0u; mine = 0u;
#pragma unroll
        for (unsigned j = 0; j < 16; ++j) { const unsigned c = xb_ld(&bar[XB_XCNT(j)]); sum += c; cnt += (c > 0u) ? 1u : 0u; mine = (j == x) ? c : mine; }
        if (sum == G) break;
        __builtin_amdgcn_s_sleep(1);
        if ((++sp & 255u) == 0u) { if (xb_ld(&bar[XB_TMO])) break; if (sp > XB_SPIN_CAP) { atomicAdd(&bar[XB_TMO], 1u); break; } }
    }
    nloc = mine > 0u ? mine : 1u; nx = cnt > 0u ? cnt : 1u;
}
__device__ __forceinline__ void xcd_barrier(const XcdBarrier& b) {
    asm volatile("s_waitcnt vmcnt(0)" ::: "memory");
    __syncthreads();
    if (threadIdx.x == 0) {
        unsigned* bar = b.bar;
        __builtin_amdgcn_s_waitcnt(0);
        unsigned nloc = b.st[0], nx = b.st[1];
        if (nloc == 0u) { xcd_barrier_complete(bar, b.x, nloc, nx); b.st[0] = nloc; b.st[1] = nx; }
        const unsigned old = xb_add(&bar[XB_XSUB(b.x)], 1u);
        const unsigned gen = old / nloc;
        if (old + 1u == (gen + 1u) * nloc) {
            __builtin_amdgcn_fence(__ATOMIC_RELEASE, "agent");
            asm volatile("s_waitcnt vmcnt(0)" ::: "memory");
            const unsigned og = xb_add(&bar[XB_TOP], 1u);
            const unsigned tg = og / nx;
            if (og + 1u == (tg + 1u) * nx) xb_add(&bar[XB_TOPGEN], 1u);
            else XB_SPIN(xb_ld(&bar[XB_TOPGEN]) == tg, bar);
            __builtin_amdgcn_fence(__ATOMIC_ACQUIRE, "agent");
            xb_add(&bar[XB_XGEN(b.x)], 1u);
            asm volatile("s_waitcnt vmcnt(0)" ::: "memory");
        } else {
            XB_SPIN(xb_ld(&bar[XB_XGEN(b.x)]) == gen, bar);
            __builtin_amdgcn_fence(__ATOMIC_ACQUIRE, "agent");
            asm volatile("s_waitcnt vmcnt(0)" ::: "memory");
        }
    }
    __syncthreads();
}

namespace pg8 {
constexpr int BM = 256, BK = 64, HALF = 128, HTB = HALF * BK * 2, STAGE_BYTES = 8 * HTB, NXCD = 8, WGM = 8;
__host__ __device__ __forceinline__ int lds_byte(int r, int c) { const int st = (r >> 4) * 2 + (c >> 5), rr = r & 15, cc = c & 31, ob = rr * 64 + cc * 2; return st * 1024 + (ob ^ (((ob >> 9) & 1) << 5)); }
__host__ __device__ __forceinline__ void stage_rc(int b, int& R, int& C) { const int st = b / 1024, sb = b % 1024, swz = sb ^ (((sb >> 9) & 1) << 5); R = (st >> 1) * 16 + swz / 64; C = (st & 1) * 32 + (swz % 64) / 2; }
__host__ __device__ __forceinline__ int perm32(int rho) { const int n = rho >> 4, i = rho & 15; return 8 * (i >> 2) + 4 * n + (i & 3); }

struct GU { const char* A; const char* B; unsigned lda, ldb; int nt; int pm, pn, kind, mi; };

__device__ __forceinline__ bool tile_of(int L, int nM, int nN, int& pm, int& pn) {
    const int nwg = nM * nN; if (L >= nwg) return false;
    int wgid = L; { const int q = nwg / NXCD, r = nwg % NXCD, xcd = wgid % NXCD, off = wgid / NXCD; wgid = (xcd < r ? xcd * (q + 1) : r * (q + 1) + (xcd - r) * q) + off; }
    const int nig = WGM * nN, gid = wgid / nig, fm = gid * WGM, gsz = (nM - fm) < WGM ? (nM - fm) : WGM;
    pm = fm + ((wgid % nig) % gsz); pn = (wgid % nig) / gsz; return true;
}

template <class Epi, class Sched, bool AX = false>
__device__ __forceinline__ void gemm_phase(LAS unsigned char* lds, const Sched& S, const Epi& E, unsigned ax_kstep = 0, unsigned ax_half = 0) {
    int tid = threadIdx.x; asm volatile("" : "+v"(tid));
    const int wid = __builtin_amdgcn_readfirstlane(tid >> 6), lane = tid & 63, wr = wid >> 2, wc = wid & 3, fr = lane & 15, fq = lane >> 4;
    unsigned RA[2], RB[2], C2[2];
#pragma unroll
    for (int i = 0; i < 2; ++i) { int R, C; stage_rc(tid * 16 + i * 8192, R, C); RA[i] = (unsigned)R; RB[i] = (unsigned)((R & ~31) + perm32(R & 31)); C2[i] = (unsigned)C * 2u; }
    const size_t kstep = (size_t)(BK * 2);
    const size_t kstepA = AX ? (size_t)ax_kstep : kstep;
#define PG8_HSA(ld) (AX ? (size_t)ax_half : (size_t)HALF * (ld))
    const unsigned ldsw = (unsigned)wid * 1024u;
    const int aoff = lds_byte(wr * 64 + fr, fq * 8), boff = lds_byte(wc * 32 + fr, fq * 8);
#define PG8_SA(b, h) (((b) * 2 + (h)) * HTB)
#define PG8_SB(b, h) ((4 + (b) * 2 + (h)) * HTB)
#define PG8_STAGE(bufoff, gbase, ld, RR) do { _Pragma("unroll") for (int _i = 0; _i < 2; ++_i) \
        __builtin_amdgcn_global_load_lds((const unsigned*)((const char*)(gbase) + (RR[_i] * (ld) + C2[_i])), (LAS unsigned*)(lds + (bufoff) + ldsw + _i * 8192), 16, 0, 0); } while (0)
#define PG8_LDA(dst, b, h) do { _Pragma("unroll") for (int m = 0; m < 4; ++m) _Pragma("unroll") for (int k = 0; k < 2; ++k) dst[m][k] = *(const LAS bf16x8*)(lds + PG8_SA(b, h) + aoff + m * 2048 + k * 1024); } while (0)
#define PG8_LDB(dst, b, h) do { _Pragma("unroll") for (int n = 0; n < 2; ++n) _Pragma("unroll") for (int k = 0; k < 2; ++k) dst[n][k] = *(const LAS bf16x8*)(lds + PG8_SB(b, h) + boff + n * 2048 + k * 1024); } while (0)
#define PG8_MMA(ai, bj, At, Bt) do { __builtin_amdgcn_s_setprio(1); _Pragma("unroll") for (int m = 0; m < 4; ++m) _Pragma("unroll") for (int n = 0; n < 2; ++n) _Pragma("unroll") for (int k = 0; k < 2; ++k) \
        acc[ai][bj][m][n] = __builtin_amdgcn_mfma_f32_16x16x32_bf16(Bt[n][k], At[m][k], acc[ai][bj][m][n], 0, 0, 0); __builtin_amdgcn_s_setprio(0); } while (0)
#define PG8_WAIT_V(n) asm volatile("s_waitcnt vmcnt(" #n ")" ::: "memory")
#define PG8_WAIT_L(n) asm volatile("s_waitcnt lgkmcnt(" #n ")" ::: "memory")
#define PG8_BAR __builtin_amdgcn_s_barrier()
#define PG8_SCHED __builtin_amdgcn_sched_barrier(0)
    GU cur, nxt; int ui = 0;
    if (!S.next(0, cur)) return;
    f32x4 acc[2][2][4][2];
#pragma unroll
    for (int a = 0; a < 2; ++a)
#pragma unroll
        for (int b = 0; b < 2; ++b)
#pragma unroll
            for (int m = 0; m < 4; ++m)
#pragma unroll
                for (int n = 0; n < 2; ++n) acc[a][b][m][n] = (f32x4){0.f, 0.f, 0.f, 0.f};
    bf16x8 At[4][2], B0[2][2], B1[2][2];
    const char* cA = cur.A; const char* cB = cur.B; unsigned clda = cur.lda, cldb = cur.ldb;
    PG8_STAGE(PG8_SB(0, 0), cB, cldb, RB); PG8_STAGE(PG8_SB(0, 1), cB + (size_t)HALF * cldb, cldb, RB); PG8_STAGE(PG8_SA(0, 0), cA, clda, RA); PG8_STAGE(PG8_SA(0, 1), cA + PG8_HSA(clda), clda, RA);
    if (wr == 1) PG8_BAR;
    PG8_WAIT_V(2); PG8_BAR;
    PG8_STAGE(PG8_SB(1, 0), cB + kstep, cldb, RB); PG8_STAGE(PG8_SA(1, 0), cA + kstepA, clda, RA); PG8_STAGE(PG8_SB(1, 1), cB + (size_t)HALF * cldb + kstep, cldb, RB);
    PG8_WAIT_V(6); PG8_BAR;
    for (;;) {
        const bool has_next = S.next(ui + 1, nxt);
        const char* nA = has_next ? nxt.A : cA; const char* nB = has_next ? nxt.B : cB;
        const unsigned nlda = has_next ? nxt.lda : clda, nldb = has_next ? nxt.ldb : cldb;
        const int nt = cur.nt;
        for (int t = 0; t < nt; t += 2) {
            const bool last = (t == nt - 2);
            const char* a1 = cA + (size_t)(t + 1) * kstepA;
            const char* a2 = last ? nA : cA + (size_t)(t + 2) * kstepA; const char* b2 = last ? nB : cB + (size_t)(t + 2) * kstep;
            const unsigned lda2 = last ? nlda : clda, ldb2 = last ? nldb : cldb;
            const char* a3 = a2 + kstepA; const char* b3 = b2 + kstep;
            PG8_LDB(B0, 0, 0); PG8_LDB(B1, 0, 1); PG8_SCHED; PG8_LDA(At, 0, 0); PG8_STAGE(PG8_SA(1, 1), a1 + PG8_HSA(clda), clda, RA);
            PG8_WAIT_V(8); PG8_WAIT_L(0); PG8_BAR; PG8_MMA(0, 0, At, B0); PG8_MMA(0, 1, At, B1); PG8_BAR; PG8_SCHED;
            PG8_LDA(At, 0, 1); PG8_STAGE(PG8_SB(0, 0), b2, ldb2, RB); PG8_STAGE(PG8_SB(0, 1), b2 + (size_t)HALF * ldb2, ldb2, RB); PG8_STAGE(PG8_SA(0, 0), a2, lda2, RA);
            PG8_WAIT_V(8); PG8_WAIT_L(0); PG8_BAR; PG8_MMA(1, 0, At, B0); PG8_MMA(1, 1, At, B1); PG8_BAR; PG8_SCHED;
            PG8_LDB(B0, 1, 0); PG8_LDB(B1, 1, 1); PG8_SCHED; PG8_LDA(At, 1, 0); PG8_STAGE(PG8_SA(0, 1), a2 + PG8_HSA(lda2), lda2, RA);
            PG8_WAIT_V(8); PG8_WAIT_L(0); PG8_BAR; PG8_MMA(0, 0, At, B0); PG8_MMA(0, 1, At, B1); PG8_BAR; PG8_SCHED;
            PG8_LDA(At, 1, 1); PG8_STAGE(PG8_SB(1, 0), b3, ldb2, RB); PG8_STAGE(PG8_SB(1, 1), b3 + (size_t)HALF * ldb2, ldb2, RB); PG8_STAGE(PG8_SA(1, 0), a3, lda2, RA);
            PG8_WAIT_V(8); PG8_WAIT_L(0); PG8_BAR; PG8_MMA(1, 0, At, B0); PG8_MMA(1, 1, At, B1); PG8_BAR; PG8_SCHED;
        }
        if (wr == 0) PG8_BAR;
        E(acc, cur, wr, wc, fr, fq);
        if (!has_next) break;
#pragma unroll
        for (int a = 0; a < 2; ++a)
#pragma unroll
            for (int b = 0; b < 2; ++b)
#pragma unroll
                for (int m = 0; m < 4; ++m)
#pragma unroll
                    for (int n = 0; n < 2; ++n) acc[a][b][m][n] = (f32x4){0.f, 0.f, 0.f, 0.f};
        cur = nxt; cA = nA; cB = nB; clda = nlda; cldb = nldb; ++ui;
        if (wr == 1) PG8_BAR;
    }
    PG8_WAIT_V(0);
    PG8_BAR;
#undef PG8_SA
#undef PG8_HSA
#undef PG8_SB
#undef PG8_STAGE
#undef PG8_LDA
#undef PG8_LDB
#undef PG8_MMA
#undef PG8_WAIT_V
#undef PG8_WAIT_L
#undef PG8_BAR
#undef PG8_SCHED
}
}
using pg8::GU;

struct PlainSched {
    const char* A; const char* B; unsigned lda, ldb; int nt, nM, nN, G, c;
    __device__ __forceinline__ bool next(int i, GU& u) const {
        int pm, pn; if (!pg8::tile_of(i * G + c, nM, nN, pm, pn)) return false;
        u.A = A + (size_t)pm * 256 * lda; u.B = B + (size_t)pn * 256 * ldb; u.lda = lda; u.ldb = ldb; u.nt = nt; u.pm = pm; u.pn = pn; u.kind = 0; u.mi = 0; return true;
    }
};
struct PairSched {
    const char* A1; const char* B1; unsigned lda1, ldb1; int nt1; size_t b1_mstride;
    const char* A2; const char* B2; unsigned lda2, ldb2; int nt2; size_t a2_mstride, b2_mstride;
    int nm, nM, nN, G, c;
    __device__ __forceinline__ bool next(int i, GU& u) const {
        const int per = 2 * nm, ti = i / per, sub = i - ti * per, m = sub >> 1, kind = sub & 1;
        int pm, pn; if (!pg8::tile_of(ti * G + c, nM, nN, pm, pn)) return false;
        u.pm = pm; u.pn = pn; u.kind = kind; u.mi = m;
        if (kind == 0) { u.A = A2 + (size_t)m * a2_mstride + (size_t)pm * 256 * lda2; u.B = B2 + (size_t)m * b2_mstride + (size_t)pn * 256 * ldb2; u.lda = lda2; u.ldb = ldb2; u.nt = nt2; }
        else { u.A = A1 + (size_t)pm * 256 * lda1; u.B = B1 + (size_t)m * b1_mstride + (size_t)pn * 256 * ldb1; u.lda = lda1; u.ldb = ldb1; u.nt = nt1; }
        return true;
    }
};

constexpr int RSTD_OFF = 131072;
__device__ __forceinline__ float ss_row(const float* ssp, int row) {
    const f32x4* p = (const f32x4*)(ssp + (size_t)row * 16); const f32x4 a = p[0], b = p[1], c = p[2], d = p[3];
    return (((a[0] + a[1]) + (a[2] + a[3])) + ((b[0] + b[1]) + (b[2] + b[3]))) + (((c[0] + c[1]) + (c[2] + c[3])) + ((d[0] + d[1]) + (d[2] + d[3])));
}
__device__ __forceinline__ void rstd_table(const float* ssp, int pm) {
    extern __shared__ __attribute__((aligned(16))) unsigned char lds_tab_raw[];
    LAS float* tab = (LAS float*)((LAS unsigned char*)lds_tab_raw + RSTD_OFF);
    const int t = threadIdx.x; if (t < 256) tab[t] = __builtin_amdgcn_rsqf(ss_row(ssp, pm * 256 + t) * (1.0f / D) + EPS);
    asm volatile("s_waitcnt lgkmcnt(0)" ::: "memory"); __builtin_amdgcn_s_barrier(); asm volatile("" ::: "memory");
}
__device__ __forceinline__ float rstd_tab(int lr) { extern __shared__ __attribute__((aligned(16))) unsigned char lds_tab_raw[]; return ((const LAS float*)((LAS unsigned char*)lds_tab_raw + RSTD_OFF))[lr]; }
__device__ __forceinline__ u32x4 pack8(const f32x4& a, const f32x4& b) { u32x4 w; w.x = cvt_pk_bf16(a[0], a[1]); w.y = cvt_pk_bf16(a[2], a[3]); w.z = cvt_pk_bf16(b[0], b[1]); w.w = cvt_pk_bf16(b[2], b[3]); return w; }
__device__ __forceinline__ void unpack8(const u32x4& w, f32x4& a, f32x4& b) { a = (f32x4){bflo(w.x), bfhi(w.x), bflo(w.y), bfhi(w.y)}; b = (f32x4){bflo(w.z), bfhi(w.z), bflo(w.w), bfhi(w.w)}; }

struct CmpSched {
    const char* U; const char* B; int c;
    __device__ __forceinline__ bool next(int i, GU& u) const {
        if (i > 0 || c >= 32) return false;
        const int b = c >> 2, q = c & 3;
        u.A = U + ((size_t)(b * S + 2048 * q) * UW + U_NSA + 256) * 2; u.B = B; u.lda = 16 * UW * 2; u.ldb = 4096; u.nt = 32; u.pm = b; u.pn = q; u.kind = 0; u.mi = 0; return true;
    }
};
struct EpiCmp {
    bf16* H;
    __device__ __forceinline__ void operator()(const f32x4 (&acc)[2][2][4][2], const GU& u, int wr, int wc, int fr, int fq) const {
        const int col = wc * 32 + 8 * fq;
        extern __shared__ __attribute__((aligned(16))) unsigned char lds_c1_raw[]; const LAS float* c1 = (const LAS float*)((LAS unsigned char*)lds_c1_raw + RSTD_OFF + 1024);
#pragma unroll
        for (int kv = 0; kv < 2; ++kv) { const f32x4 b0 = *(const LAS f32x4*)(c1 + kv * 128 + col), b1 = *(const LAS f32x4*)(c1 + kv * 128 + col + 4);
#pragma unroll
            for (int m = 0; m < 4; ++m) { const int i = u.pn * 128 + wr * 64 + m * 16 + fr; f32x4 v0, v1;
#pragma unroll
                for (int j = 0; j < 4; ++j) { v0[j] = fsilu(acc[kv][kv][m][0][j] + b0[j]); v1[j] = fsilu(acc[kv][kv][m][1][j] + b1[j]); }
                *(u32x4*)(H + ((size_t)(u.pm * 512 + i)) * 256 + kv * 128 + col) = pack8(v0, v1); } }
    }
};
struct EpiScaleBf16 {
    bf16* O; int ldo; const float* ss;
    __device__ __forceinline__ void operator()(const f32x4 (&acc)[2][2][4][2], const GU& u, int wr, int wc, int fr, int fq) const {
        rstd_table(ss, u.pm);
        const int row0 = u.pm * 256 + wr * 64 + fr, col0 = u.pn * 256 + wc * 32 + 8 * fq;
#pragma unroll
        for (int ai = 0; ai < 2; ++ai)
#pragma unroll
            for (int m = 0; m < 4; ++m) { const int r = row0 + ai * 128 + m * 16; const float rs = rstd_tab(wr * 64 + fr + ai * 128 + m * 16); bf16* rowp = O + (size_t)r * ldo + col0;
#pragma unroll
                for (int bj = 0; bj < 2; ++bj) *(u32x4*)(rowp + bj * 128) = pack8(acc[ai][bj][m][0] * rs, acc[ai][bj][m][1] * rs); }
    }
};
struct EpiSwiGLU {
    bf16* O; const float* ss;
    __device__ __forceinline__ void operator()(const f32x4 (&acc)[2][2][4][2], const GU& u, int wr, int wc, int fr, int fq) const {
        rstd_table(ss, u.pm);
        const int row0 = u.pm * 256 + wr * 64 + fr, col0 = u.pn * 128 + wc * 32 + 8 * fq;
#pragma unroll
        for (int ai = 0; ai < 2; ++ai)
#pragma unroll
            for (int m = 0; m < 4; ++m) { const int r = row0 + ai * 128 + m * 16; const float rs = rstd_tab(wr * 64 + fr + ai * 128 + m * 16);
                f32x4 v[2];
#pragma unroll
                for (int n = 0; n < 2; ++n)
#pragma unroll
                    for (int j = 0; j < 4; ++j) { const float g = acc[ai][0][m][n][j] * rs, up = acc[ai][1][m][n][j] * rs; v[n][j] = fsilu(g) * up; }
                *(u32x4*)(O + (size_t)r * DFF + col0) = pack8(v[0], v[1]); }
    }
};
struct EpiResidual {
    const float* Hin32; bf16* HB; float* ss_out;
    __device__ __forceinline__ void operator()(const f32x4 (&acc)[2][2][4][2], const GU& u, int wr, int wc, int fr, int fq) const {
        const int row0 = u.pm * 256 + wr * 64 + fr, col0 = u.pn * 256 + wc * 32 + 8 * fq;
#pragma unroll
        for (int hf = 0; hf < 2; ++hf) { const int ai = hf;
            u32x4 hv[8];
            if (!Hin32) {
#pragma unroll
                for (int q = 0; q < 8; ++q) { const int m = q >> 1, bj = q & 1; hv[q] = *(const u32x4*)(HB + (size_t)(row0 + ai * 128 + m * 16) * D + col0 + bj * 128); } }
#pragma unroll
            for (int m = 0; m < 4; ++m) { const int r = row0 + ai * 128 + m * 16; float s2 = 0.f;
#pragma unroll
                for (int bj = 0; bj < 2; ++bj) { const size_t o = (size_t)r * D + col0 + bj * 128;
                    f32x4 h0, h1;
                    if (Hin32) { h0 = *(const f32x4*)(Hin32 + o); h1 = *(const f32x4*)(Hin32 + o + 4); } else unpack8(hv[m * 2 + bj], h0, h1);
                    h0 += acc[ai][bj][m][0]; h1 += acc[ai][bj][m][1];
                    *(u32x4*)(HB + o) = pack8(h0, h1);
                    s2 += (h0[0] * h0[0] + h0[1] * h0[1]) + (h0[2] * h0[2] + h0[3] * h0[3]) + (h1[0] * h1[0] + h1[1] * h1[1]) + (h1[2] * h1[2] + h1[3] * h1[3]); }
                s2 += __shfl_xor(s2, 16); s2 += __shfl_xor(s2, 32);
                if (fq == 0) ss_out[(size_t)r * 16 + u.pn * 4 + wc] = s2; }
            asm volatile("" ::: "memory"); }
    }
};
#define SLOT(ai, m, bj) (((((ai) * 4 + (m)) >> 1) * 512 + tid) * 4 + (((m) & 1) * 2 + (bj)))
struct EpiMerge {
    u32x4* scrP; u32x4* scrM; bf16* M; const float* ss; const float* bias;
    int nm;
    __device__ __forceinline__ void operator()(const f32x4 (&acc)[2][2][4][2], const GU& u, int wr, int wc, int fr, int fq) const {
        int tid = threadIdx.x; asm volatile("" : "+v"(tid));
        if (u.kind == 0) {
#pragma unroll
            for (int ai = 0; ai < 2; ++ai)
#pragma unroll
                for (int m = 0; m < 4; ++m)
#pragma unroll
                    for (int bj = 0; bj < 2; ++bj) scrP[SLOT(ai, m, bj)] = pack8(acc[ai][bj][m][0], acc[ai][bj][m][1]);
            return;
        }
        const int row0 = u.pm * 256 + wr * 64 + fr, col0 = u.pn * 256 + wc * 32 + 8 * fq;
        rstd_table(ss, u.pm);
        const float* bp = bias + (size_t)u.mi * D + col0;
#pragma unroll
        for (int hf = 0; hf < 2; ++hf) { const int ai = hf;
            u32x4 pv[8];
#pragma unroll
            for (int q = 0; q < 8; ++q) pv[q] = scrP[SLOT(ai, q >> 1, q & 1)];
#pragma unroll
            for (int q = 0; q < 8; ++q) { const int m = q >> 1, bj = q & 1; const float rs = rstd_tab(wr * 64 + fr + ai * 128 + m * 16);
                const f32x4 b0 = *(const f32x4*)(bp + bj * 128), b1 = *(const f32x4*)(bp + bj * 128 + 4); f32x4 p0, p1; unpack8(pv[q], p0, p1);
#pragma unroll
                for (int j = 0; j < 4; ++j) { p0[j] *= fsigmoid(acc[ai][bj][m][0][j] * rs + b0[j]); p1[j] *= fsigmoid(acc[ai][bj][m][1][j] * rs + b1[j]); }
                pv[q] = pack8(p0, p1); }
            asm volatile("" ::: "memory");
            if (u.mi > 0) { u32x4 mv[8];
#pragma unroll
                for (int q = 0; q < 8; ++q) mv[q] = scrM[SLOT(ai, q >> 1, q & 1)];
#pragma unroll
                for (int q = 0; q < 8; ++q) { f32x4 a0, a1, q0, q1; unpack8(pv[q], a0, a1); unpack8(mv[q], q0, q1); pv[q] = pack8(a0 + q0, a1 + q1); } }
#pragma unroll
            for (int q = 0; q < 8; ++q) { const int m = q >> 1, bj = q & 1;
                if (u.mi == nm - 1) *(u32x4*)(M + (size_t)(row0 + ai * 128 + m * 16) * D + col0 + bj * 128) = pv[q]; else scrM[SLOT(ai, m, bj)] = pv[q]; }
            asm volatile("" ::: "memory"); }
    }
};
struct EpiPle {
    u32x4* scrP; const bf16* Hcur; bf16* HBout; const float* ss; float* ss_out;
    __device__ __forceinline__ void operator()(const f32x4 (&acc)[2][2][4][2], const GU& u, int wr, int wc, int fr, int fq) const {
        int tid = threadIdx.x; asm volatile("" : "+v"(tid));
        if (u.kind == 0) {
#pragma unroll
            for (int ai = 0; ai < 2; ++ai)
#pragma unroll
                for (int m = 0; m < 4; ++m)
#pragma unroll
                    for (int bj = 0; bj < 2; ++bj) scrP[SLOT(ai, m, bj)] = pack8(acc[ai][bj][m][0], acc[ai][bj][m][1]);
            return;
        }
        rstd_table(ss, u.pm);
        const int row0 = u.pm * 256 + wr * 64 + fr, col0 = u.pn * 256 + wc * 32 + 8 * fq;
#pragma unroll
        for (int qt = 0; qt < 4; ++qt) { const int ai = qt >> 1, m0 = (qt & 1) * 2;
            u32x4 pv[4], hv[4];
#pragma unroll
            for (int q = 0; q < 4; ++q) { const int m = m0 + (q >> 1), bj = q & 1; pv[q] = scrP[SLOT(ai, m, bj)]; hv[q] = *(const u32x4*)(Hcur + (size_t)(row0 + ai * 128 + m * 16) * D + col0 + bj * 128); }
#pragma unroll
            for (int mm = 0; mm < 2; ++mm) { const int m = m0 + mm; const int r = row0 + ai * 128 + m * 16; const float rs = rstd_tab(wr * 64 + fr + ai * 128 + m * 16); float s2 = 0.f;
#pragma unroll
                for (int bj = 0; bj < 2; ++bj) { const int q = mm * 2 + bj; f32x4 h0, h1, p0, p1; unpack8(hv[q], h0, h1); unpack8(pv[q], p0, p1);
#pragma unroll
                    for (int j = 0; j < 4; ++j) { h0[j] += fsigmoid(acc[ai][bj][m][0][j] * rs) * p0[j]; h1[j] += fsigmoid(acc[ai][bj][m][1][j] * rs) * p1[j]; }
                    *(u32x4*)(HBout + (size_t)r * D + col0 + bj * 128) = pack8(h0, h1);
                    s2 += (h0[0] * h0[0] + h0[1] * h0[1]) + (h0[2] * h0[2] + h0[3] * h0[3]) + (h1[0] * h1[0] + h1[1] * h1[1]) + (h1[2] * h1[2] + h1[3] * h1[3]); }
                s2 += __shfl_xor(s2, 16); s2 += __shfl_xor(s2, 32);
                if (fq == 0) ss_out[(size_t)r * 16 + u.pn * 4 + wc] = s2; }
            asm volatile("" ::: "memory"); }
    }
};

constexpr int NWAVES = 8, NTHR = 512;
constexpr int RING_OFF = 0, RING_BYTES = 131072, WREG = 19456, MISC_OFF = 8 * WREG;
constexpr int LDS_BYTES = MISC_OFF + 256;
static_assert(MISC_OFF + 128 <= LDS_BYTES, "lds");
struct Args { const float* in[37]; float* out; unsigned char* ws; int ph_lo, ph_hi; };
struct Frame {
    LAS unsigned char* lds; int tid, lane, wave, G, bx;
    const float* const* in; float* out; unsigned char* ws;
};
enum { I_X = 0, I_P, I_NORM_MIX, I_W_IN, I_POS_K, I_POS_V, I_CK1, I_CK2, I_CV1, I_CV2, I_LB, I_HG_NORM, I_RT_G, I_RT_B, I_MU, I_W0, I_WUP, I_A0, I_AUP, I_GUP, I_KK, I_KA, I_RK,
       I_RW_G, I_RW_B, I_WBR, I_WGATE, I_BGATE, I_WOUT, I_NORM_FFN, I_FFG, I_FFU, I_FFD, I_NORM_PLE, I_PLEG, I_PLEP, I_NORM_FINAL };

template <class ColMap>
__device__ __forceinline__ void transpose_item(const float* W, int ldw, int K, const float* scale, bf16* WT, LAS float* scr, int item, int nblk, int lane, const ColMap& cm) {
    const int kb = item / nblk, nb = item % nblk, k0 = 64 * kb, n0 = 32 * nb;
    const int sc = cm(n0 + (lane & 31));
    float tv[32];
#pragma unroll
    for (int i = 0; i < 32; ++i) { const int kk = 2 * i + (lane >> 5); tv[i] = (sc >= 0) ? W[(size_t)(k0 + kk) * ldw + sc] : 0.f; }
    if (scale) {
#pragma unroll
        for (int i = 0; i < 32; ++i) tv[i] *= scale[k0 + 2 * i + (lane >> 5)]; }
#pragma unroll
    for (int i = 0; i < 32; ++i) scr[(2 * i + (lane >> 5)) * 33 + (lane & 31)] = tv[i];
    LDS_WAIT();
    const int c = lane & 7;
#pragma unroll
    for (int j = 0; j < 4; ++j) { const int n = (lane >> 3) + 8 * j; const LAS float* s = scr + (8 * c) * 33 + n;
        u32x4 o; o.x = cvt_pk_bf16(s[0 * 33], s[1 * 33]); o.y = cvt_pk_bf16(s[2 * 33], s[3 * 33]); o.z = cvt_pk_bf16(s[4 * 33], s[5 * 33]); o.w = cvt_pk_bf16(s[6 * 33], s[7 * 33]);
        *(u32x4*)(WT + (size_t)(n0 + n) * K + k0 + 8 * c) = o; }
    LDS_WAIT();
}
struct CmIdent { __device__ __forceinline__ int operator()(int n) const { return n; } };
struct CmWin { __device__ __forceinline__ int operator()(int n) const { return n < 652 ? n : (n < 768 ? -1 : n - 116); } };
struct CmFF { __device__ __forceinline__ int operator()(int n) const { return (n >> 8) * 128 + (n & 127); } };

__device__ __forceinline__ void phase_prologue(Frame& F0) {
    Frame F = F0; asm volatile("" : "+v"(F.tid)); F.lane = F.tid & 63;
    LAS float* scr = (LAS float*)(F.lds + F.wave * WREG);
    const int gw = F.bx * NWAVES + F.wave, NGW = F.G * NWAVES;
    int dbase = 0;
#define DEAL(var, n) for (int _n = (n), var = (int)((unsigned)(gw + NGW - (dbase % NGW)) % (unsigned)NGW), _once = ((dbase += _n), 0); var < _n; var += NGW)
    for (int L = 0; L < NL; ++L) {
        unsigned char* wl = F.ws + WS_W + (size_t)L * WL_STRIDE;
        const float* g_mix = F.in[I_NORM_MIX] + L * D; const float* g_ffn = F.in[I_NORM_FFN] + L * D; const float* g_ple = F.in[I_NORM_PLE] + L * D;
        { const int nblk = UW / 32, items = (D / 64) * nblk; const float* W = F.in[I_W_IN] + (size_t)L * D * DIN;
          DEAL(it, items) transpose_item(W, DIN, D, g_mix, (bf16*)(wl + WL_IN), scr, it, nblk, F.lane, CmWin()); }
        for (int m = 0; m < 4; ++m) { const int nblk = D / 32, items = (D / 64) * nblk; const float* W = F.in[I_WGATE] + ((size_t)L * 4 + m) * D * D;
          DEAL(it, items) transpose_item(W, D, D, g_mix, (bf16*)(wl + WL_G) + (size_t)m * D * D, scr, it, nblk, F.lane, CmIdent()); }
        for (int m = 0; m < 4; ++m) { const int nblk = D / 32, items = (MW / 64) * nblk; const float* W = F.in[I_WBR] + ((size_t)L * 4 + m) * MW * D;
          DEAL(it, items) transpose_item(W, D, MW, nullptr, (bf16*)(wl + WL_B) + (size_t)m * D * MW, scr, it, nblk, F.lane, CmIdent()); }
        { const int nblk = D / 32, items = (D / 64) * nblk; const float* W = F.in[I_WOUT] + (size_t)L * D * D;
          DEAL(it, items) transpose_item(W, D, D, nullptr, (bf16*)(wl + WL_OUT), scr, it, nblk, F.lane, CmIdent()); }
        { const int nblk = (2 * DFF) / 32, items = (D / 64) * nblk; const float* Wg = F.in[I_FFG] + (size_t)L * D * DFF; const float* Wu = F.in[I_FFU] + (size_t)L * D * DFF;
          DEAL(it, items) { const int nb = it % nblk; const bool up = ((nb * 32) & 128) != 0; transpose_item(up ? Wu : Wg, DFF, D, g_ffn, (bf16*)(wl + WL_FF), scr, it, nblk, F.lane, CmFF()); } }
        { const int nblk = D / 32, items = (DFF / 64) * nblk; const float* W = F.in[I_FFD] + (size_t)L * DFF * D;
          DEAL(it, items) transpose_item(W, D, DFF, nullptr, (bf16*)(wl + WL_DN), scr, it, nblk, F.lane, CmIdent()); }
        { const int nblk = D / 32, items = (D / 64) * nblk; const float* W = F.in[I_PLEG] + (size_t)L * D * D;
          DEAL(it, items) transpose_item(W, D, D, g_ple, (bf16*)(wl + WL_PG), scr, it, nblk, F.lane, CmIdent()); }
        { const int nblk = D / 32, items = (PLE / 64) * nblk; const float* W = F.in[I_PLEP] + (size_t)L * PLE * D;
          DEAL(it, items) transpose_item(W, D, PLE, nullptr, (bf16*)(wl + WL_PP), scr, it, nblk, F.lane, CmIdent()); }
    }
    for (int L = 0; L < NL; ++L) for (int kv = 0; kv < 2; ++kv) {
        const float* w1 = F.in[kv ? I_CV1 : I_CK1] + (size_t)L * 2048 * 128; const float* w2 = F.in[kv ? I_CV2 : I_CK2] + (size_t)L * 128 * 64;
        bf16* w1T = (bf16*)(F.ws + WS_CW1 + (size_t)L * MiB) + (size_t)kv * 128 * 2048; bf16* w2T = (bf16*)(F.ws + WS_CW2 + (size_t)L * 65536) + kv * 64 * 128;
        DEAL(it, 128) transpose_item(w1, 128, 2048, nullptr, w1T, scr, it, 4, F.lane, CmIdent());
        DEAL(it, 4) transpose_item(w2, 64, 128, nullptr, w2T, scr, it, 2, F.lane, CmIdent());
        DEAL(tk, 64) { const int hf = tk & 1, jq = tk >> 1; const float* pos = F.in[kv ? I_POS_V : I_POS_K] + (size_t)L * 2048; float a = 0.f;
#pragma unroll 8
            for (int j = 64 * jq; j < 64 * jq + 64; ++j) a += pos[j] * w1[(size_t)j * 128 + hf * 64 + F.lane];
            ((float*)(F.ws + WS_CW2 + (size_t)L * 65536 + 32768))[(kv * 32 + jq) * 128 + hf * 64 + F.lane] = a; } }
#undef DEAL
    { const float* x = F.in[I_X]; bf16* hb = (bf16*)(F.ws + WS_HBA); float* ss0 = F.out;
      for (int r = gw; r < T; r += NGW) { const f32x4* xr = (const f32x4*)(x + (size_t)r * D) + F.lane; float s = 0.f;
#pragma unroll
        for (int j = 0; j < 4; ++j) { const f32x4 v = xr[64 * j]; s += (v[0] * v[0] + v[1] * v[1]) + (v[2] * v[2] + v[3] * v[3]);
            u32x2 w; w.x = cvt_pk_bf16(v[0], v[1]); w.y = cvt_pk_bf16(v[2], v[3]); *((u32x2*)(hb + (size_t)r * D) + F.lane + 64 * j) = w; }
        s = wave_sum(s); if (F.lane < 16) ss0[(size_t)r * 16 + F.lane] = (F.lane == 0) ? s : 0.f; } }
    for (int L = 0; L < NL; ++L) { bf16* base = (bf16*)(F.ws + WS_RWUP + (size_t)L * 131072);
        for (int it = gw; it < 8; it += NGW) transpose_item(F.in[I_WUP] + (size_t)L * 64 * 256, 256, 64, nullptr, base, scr, it, 8, F.lane, CmIdent());
        for (int it = gw; it < 8; it += NGW) transpose_item(F.in[I_AUP] + (size_t)L * 64 * 256, 256, 64, nullptr, base + 256 * 64, scr, it, 8, F.lane, CmIdent());
        for (int it = gw; it < 16; it += NGW) transpose_item(F.in[I_GUP] + (size_t)L * 128 * 256, 256, 128, nullptr, base + 2 * 256 * 64, scr, it, 8, F.lane, CmIdent()); }
    { float* rope = (float*)(F.ws + WS_ROPE); const int gt = F.bx * NTHR + F.tid, NT_ = F.G * NTHR;
      for (int i = gt; i < S * 32; i += NT_) { const int pos = i >> 5, j = i & 31; const float inv = exp2f(-(float)(2 * j) * (13.287712379549449f / 64.0f));
        const float a = (float)pos * inv;
        rope[2 * i] = cosf(a); rope[2 * i + 1] = sinf(a); } }
}

__device__ __forceinline__ float ldu(const bf16* u, size_t row, int col) { return bf2f(u[row * UW + col]); }

__device__ __forceinline__ bf16x8 frag_rm(const LAS unsigned char* X, int ld, int r0, int k0, int lane) { return *(const LAS bf16x8*)(X + (r0 + (lane & 31)) * ld + (k0 + 8 * (lane >> 5)) * 2); }
__device__ __forceinline__ bf16x8 frag_tr(const LAS unsigned char* X, int ld, int k0, int c0, int lane) {
    const LAS unsigned char* p = X + (k0 + 8 * (lane >> 5) + ((lane & 15) >> 2)) * ld + (c0 + 16 * ((lane >> 4) & 1) + 4 * (lane & 3)) * 2;
    const s16x4 a = __builtin_amdgcn_ds_read_tr16_b64_v4i16((LAS s16x4*)p), b = __builtin_amdgcn_ds_read_tr16_b64_v4i16((LAS s16x4*)(p + 4 * ld));
    return (bf16x8){a[0], a[1], a[2], a[3], b[0], b[1], b[2], b[3]};
}
__device__ __forceinline__ bf16x8 frag_g(const bf16* X, int ld, int r0, int k0, int lane) { return *(const bf16x8*)(X + (size_t)(r0 + (lane & 31)) * ld + k0 + 8 * (lane >> 5)); }
__device__ __forceinline__ f32x16 mma32(const bf16x8& a, const bf16x8& b, const f32x16& c) { return __builtin_amdgcn_mfma_f32_32x32x16_bf16(a, b, c, 0, 0, 0); }
__device__ __forceinline__ f32x16 zero16() { f32x16 z;
#pragma unroll
    for (int i = 0; i < 16; ++i) z[i] = 0.f;
    return z; }
__device__ __forceinline__ void st_T(LAS unsigned char* X, int ld, int j0, int i0, const f32x16& acc, int lane) {
#pragma unroll
    for (int g = 0; g < 4; ++g) { u32x2 w; w.x = cvt_pk_bf16(acc[4 * g], acc[4 * g + 1]); w.y = cvt_pk_bf16(acc[4 * g + 2], acc[4 * g + 3]);
        *(LAS u32x2*)(X + (j0 + (lane & 31)) * ld + (i0 + 8 * g + 4 * (lane >> 5)) * 2) = w; }
}
__device__ __forceinline__ void st_wt8(bf16* p, const u32x2& w) { __hip_atomic_store((unsigned long long*)p, ((unsigned long long)w.y << 32) | (unsigned long long)w.x, __ATOMIC_RELAXED, __HIP_MEMORY_SCOPE_AGENT); }
__device__ __forceinline__ void st_T_g(bf16* X, int ld, int j0, int i0, const f32x16& acc, int lane) {
#pragma unroll
    for (int g = 0; g < 4; ++g) { u32x2 w; w.x = cvt_pk_bf16(acc[4 * g], acc[4 * g + 1]); w.y = cvt_pk_bf16(acc[4 * g + 2], acc[4 * g + 3]);
        st_wt8(X + (size_t)(j0 + (lane & 31)) * ld + i0 + 8 * g + 4 * (lane >> 5), w); }
}
constexpr int LD64 = 144, LD32 = 80;
__device__ __forceinline__ float expc(float x) { return __expf(fminf(fmaxf(x, -80.f), 80.f)); }
__device__ __forceinline__ unsigned short f2b(float x) { return (unsigned short)(cvt_pk_bf16(x, 0.f) & 0xffffu); }
__device__ __forceinline__ void copy_tok64(LAS unsigned char* X, const bf16* src, int lane) {
#pragma unroll
    for (int p = 0; p < 4; ++p) { const int t = 8 * p + (lane >> 3), ch = lane & 7; *(LAS u32x4*)(X + t * LD64 + ch * 16) = *(const u32x4*)(src + (size_t)t * UW + ch * 8); }
}
__device__ __forceinline__ void glin_m1(const LAS unsigned char* Kh, const LAS unsigned char* Vv, bf16* Sg, int lane, bool cst = false) {
#pragma unroll
    for (int dt = 0; dt < 2; ++dt)
#pragma unroll
        for (int et = 0; et < 2; ++et) { f32x16 acc = zero16();
#pragma unroll
            for (int ks = 0; ks < 2; ++ks) acc = mma32(frag_tr(Kh, LD64, 16 * ks, 32 * dt, lane), frag_tr(Vv, LD64, 16 * ks, 32 * et, lane), acc);
            if (cst) {
#pragma unroll
            for (int i = 0; i < 16; ++i) acc[i] = 0.01f * (float)(1 + ((lane + i) & 7)); }
            st_T_g(Sg, 64, 32 * et, 32 * dt, acc, lane); }
}
__device__ __forceinline__ void glin_m3(const LAS unsigned char* Qt, const LAS unsigned char* Kt, const LAS unsigned char* Vv, LAS unsigned char* Xa, const bf16* S0, int lane, f32x16 (&o)[2]) {
    { f32x16 acc = zero16();
#pragma unroll
      for (int ks = 0; ks < 4; ++ks) acc = mma32(frag_rm(Kt, LD64, 0, 16 * ks, lane), frag_rm(Qt, LD64, 0, 16 * ks, lane), acc);
      const int t = lane & 31;
#pragma unroll
      for (int i = 0; i < 16; ++i) { const int sidx = (i & 3) + 8 * (i >> 2) + 4 * (lane >> 5); if (sidx > t) acc[i] = 0.f; }
      st_T(Xa, LD32, 0, 0, acc, lane); }
    LDS_WAIT();
#pragma unroll
    for (int et = 0; et < 2; ++et) { f32x16 acc = zero16();
        if (S0) {
#pragma unroll
            for (int ks = 0; ks < 4; ++ks) acc = mma32(frag_g(S0, 64, 32 * et, 16 * ks, lane), frag_rm(Qt, LD64, 0, 16 * ks, lane), acc); }
#pragma unroll
        for (int ks = 0; ks < 2; ++ks) acc = mma32(frag_tr(Vv, LD64, 16 * ks, 32 * et, lane), frag_rm(Xa, LD32, 0, 16 * ks, lane), acc);
        o[et] = acc; }
}
template <bool M3>
__device__ __forceinline__ void hgrn_chunk(Frame& F, int L, int bh, int n, LAS unsigned char* W, bf16* Sbase, float* Dbase) {
    const bf16* u = (const bf16*)(F.ws + WS_U); bf16* bo = (bf16*)(F.ws + WS_BO);
    int lane = F.lane; asm volatile("" : "+v"(lane));
    const int b = bh >> 2, h = bh & 3; const size_t row0 = (size_t)b * S + (size_t)n * CH;
    const bf16* ur = u + row0 * UW + U_HG + h * 64;
    bf16* Sg = Sbase + ((size_t)bh * NCH + n) * 4096;
    LAS unsigned char* Xq = W; LAS unsigned char* Xk = W + 4608; LAS unsigned char* Xv = W + 9216; LAS unsigned char* Xa = W + 13824;
    const float* lbl = F.in[I_LB]; const int ch = h * 64 + lane;
    float lb = 0.f; if (L > 0) { const float l0 = lbl[ch], l1 = lbl[256 + ch]; const float mx = fmaxf(l0, l1); const float e0 = __expf(l0 - mx), e1 = __expf(l1 - mx); lb = e1 / (e0 + e1); }
    float bcum[CH], kk[CH]; float run = 0.f;
#pragma unroll
    for (int t = 0; t < CH; ++t) { const float z = bf2f(ur[(size_t)t * UW + 256 + lane]); const float f = lb + (1.0f - lb) * fsigmoid(z); kk[t] = 1.0f - f; run += __logf(fmaxf(f, 1e-20f)); bcum[t] = run; }
    const float blast = bcum[CH - 1];
    copy_tok64(Xv, ur + 512, lane);
    if (!M3) {
#pragma unroll
        for (int t = 0; t < CH; ++t) *(LAS unsigned short*)(Xq + t * LD64 + lane * 2) = f2b(kk[t] * expc(blast - bcum[t]));
        Dbase[((size_t)bh * NCH + n) * 64 + lane] = expc(blast);
        LDS_WAIT();
        glin_m1(Xq, Xv, Sg, lane);
    } else {
#pragma unroll
        for (int t = 0; t < CH; ++t) { const float q = fsilu(bf2f(ur[(size_t)t * UW + lane]));
            *(LAS unsigned short*)(Xq + t * LD64 + lane * 2) = f2b(q * expc(bcum[t]));
            *(LAS unsigned short*)(Xk + t * LD64 + lane * 2) = f2b(kk[t] * expc(-bcum[t])); }
        LDS_WAIT();
        f32x16 o[2];
        glin_m3(Xq, Xk, Xv, Xa, n > 0 ? Sg - 4096 : nullptr, lane, o);
        const int t = lane & 31, hh = lane >> 5; float ss = 0.f;
#pragma unroll
        for (int et = 0; et < 2; ++et)
#pragma unroll
            for (int i = 0; i < 16; ++i) ss += o[et][i] * o[et][i];
        ss += __shfl_xor(ss, 32);
        const float rn = __builtin_amdgcn_rsqf(ss * (1.0f / 64.0f) + EPS);
        const float* ng = F.in[I_HG_NORM] + L * 256 + h * 64;
#pragma unroll
        for (int et = 0; et < 2; ++et)
#pragma unroll
            for (int g = 0; g < 4; ++g) { const int e0 = 32 * et + 8 * g + 4 * hh;
                const u32x2 og = *(const u32x2*)(ur + (size_t)t * UW + 768 + e0); const f32x4 gg = *(const f32x4*)(ng + e0);
                const float y0 = o[et][4 * g] * rn * gg[0] * fsilu(bflo(og.x)), y1 = o[et][4 * g + 1] * rn * gg[1] * fsilu(bfhi(og.x));
                const float y2 = o[et][4 * g + 2] * rn * gg[2] * fsilu(bflo(og.y)), y3 = o[et][4 * g + 3] * rn * gg[3] * fsilu(bfhi(og.y));
                u32x2 w; w.x = cvt_pk_bf16(y0, y1); w.y = cvt_pk_bf16(y2, y3);
                *(u32x2*)(bo + (row0 + t) * 1024 + 256 + h * 64 + e0) = w; }
    }
    LDS_WAIT();
}
template <bool M3>
__device__ __forceinline__ void ret_chunk(Frame& F, int L, int bh, int n, LAS unsigned char* W, bf16* Sbase) {
    const bf16* u = (const bf16*)(F.ws + WS_U); bf16* bo = (bf16*)(F.ws + WS_BO); const float* rope = (const float*)(F.ws + WS_ROPE);
    int lane = F.lane; asm volatile("" : "+v"(lane));
    const int b = bh >> 2, h = bh & 3; const int tpos0 = n * CH; const size_t row0 = (size_t)b * S + (size_t)tpos0;
    const bf16* ur = u + row0 * UW + U_RT + h * 64;
    bf16* Sg = Sbase + ((size_t)bh * NCH + n) * 4096;
    LAS unsigned char* Xq = W; LAS unsigned char* Xk = W + 4608; LAS unsigned char* Xv = W + 9216; LAS unsigned char* Xa = W + 13824;
    const float lg2 = __log2f(1.0f - exp2f(-5.0f - (float)h));
    copy_tok64(Xv, ur + 512, lane);
#pragma unroll
    for (int p = 0; p < 2; ++p) { const int idx = lane + 64 * p, t = idx >> 2, jc = idx & 3;
        f32x4 c0, c1, s0, s1;
        { const float* rp = rope + ((size_t)(tpos0 + t) * 32 + jc * 8) * 2; const f32x4 a = *(const f32x4*)rp, bq = *(const f32x4*)(rp + 4), c = *(const f32x4*)(rp + 8), d = *(const f32x4*)(rp + 12);
          c0 = (f32x4){a[0], a[2], bq[0], bq[2]}; s0 = (f32x4){a[1], a[3], bq[1], bq[3]}; c1 = (f32x4){c[0], c[2], d[0], d[2]}; s1 = (f32x4){c[1], c[3], d[1], d[3]}; }
        { const u32x4 w1 = *(const u32x4*)(ur + (size_t)t * UW + 256 + jc * 8), w2 = *(const u32x4*)(ur + (size_t)t * UW + 256 + 32 + jc * 8);
          f32x4 a0, a1, b0, b1; unpack8(w1, a0, a1); unpack8(w2, b0, b1);
          const float sc = 0.125f * exp2f(lg2 * (M3 ? -(float)(t + 1) : (float)(CH - 1 - t)));
          const f32x4 lo0 = (a0 * c0 - b0 * s0) * sc, lo1 = (a1 * c1 - b1 * s1) * sc, hi0 = (a0 * s0 + b0 * c0) * sc, hi1 = (a1 * s1 + b1 * c1) * sc;
          LAS unsigned char* dst = M3 ? Xk : Xq;
          *(LAS u32x4*)(dst + t * LD64 + jc * 16) = pack8(lo0, lo1); *(LAS u32x4*)(dst + t * LD64 + 64 + jc * 16) = pack8(hi0, hi1); }
        if (M3) { const u32x4 w1 = *(const u32x4*)(ur + (size_t)t * UW + jc * 8), w2 = *(const u32x4*)(ur + (size_t)t * UW + 32 + jc * 8);
          f32x4 a0, a1, b0, b1; unpack8(w1, a0, a1); unpack8(w2, b0, b1);
          const float sc = exp2f(lg2 * (float)(t + 1));
          const f32x4 lo0 = (a0 * c0 - b0 * s0) * sc, lo1 = (a1 * c1 - b1 * s1) * sc, hi0 = (a0 * s0 + b0 * c0) * sc, hi1 = (a1 * s1 + b1 * c1) * sc;
          *(LAS u32x4*)(Xq + t * LD64 + jc * 16) = pack8(lo0, lo1); *(LAS u32x4*)(Xq + t * LD64 + 64 + jc * 16) = pack8(hi0, hi1); }
    }
    LDS_WAIT();
    if (!M3) glin_m1(Xq, Xv, Sg, lane);
    else {
        f32x16 o[2];
        glin_m3(Xq, Xk, Xv, Xa, n > 0 ? Sg - 4096 : nullptr, lane, o);
        const int t = lane & 31, hh = lane >> 5; float sm = 0.f;
#pragma unroll
        for (int et = 0; et < 2; ++et)
#pragma unroll
            for (int i = 0; i < 16; ++i) sm += o[et][i];
        sm += __shfl_xor(sm, 32);
        const float mean = sm * (1.0f / 64.0f); float sv = 0.f;
#pragma unroll
        for (int et = 0; et < 2; ++et)
#pragma unroll
            for (int i = 0; i < 16; ++i) { const float dl = o[et][i] - mean; sv += dl * dl; }
        sv += __shfl_xor(sv, 32);
        const float rn = __builtin_amdgcn_rsqf(sv * (1.0f / 64.0f) + 1e-5f);
        const float* ng = F.in[I_RT_G] + L * 256 + h * 64; const float* nb = F.in[I_RT_B] + L * 256 + h * 64;
#pragma unroll
        for (int et = 0; et < 2; ++et)
#pragma unroll
            for (int g = 0; g < 4; ++g) { const int e0 = 32 * et + 8 * g + 4 * hh;
                const u32x2 og = *(const u32x2*)(ur + (size_t)t * UW + 768 + e0); const f32x4 gg = *(const f32x4*)(ng + e0), bb = *(const f32x4*)(nb + e0);
                const float y0 = ((o[et][4 * g] - mean) * rn * gg[0] + bb[0]) * fsilu(bflo(og.x)), y1 = ((o[et][4 * g + 1] - mean) * rn * gg[1] + bb[1]) * fsilu(bfhi(og.x));
                const float y2 = ((o[et][4 * g + 2] - mean) * rn * gg[2] + bb[2]) * fsilu(bflo(og.y)), y3 = ((o[et][4 * g + 3] - mean) * rn * gg[3] + bb[3]) * fsilu(bfhi(og.y));
                u32x2 w; w.x = cvt_pk_bf16(y0, y1); w.y = cvt_pk_bf16(y2, y3);
                *(u32x2*)(bo + (row0 + t) * 1024 + 512 + h * 64 + e0) = w; }
    }
    LDS_WAIT();
}
__device__ __forceinline__ void glin_scan_task(bf16* Sbase, const float* Dbase, float dscal, int bh, int quarter, int tl  ) {
    bf16* p = Sbase + (size_t)bh * NCH * 4096 + quarter * 1024 + tl * 4;
    const int d0 = (tl & 15) * 4;
    f32x4 st = {0.f, 0.f, 0.f, 0.f};
    for (int n0 = 0; n0 < NCH; n0 += 8) {
        u32x2 kv[8]; f32x4 dd[8];
#pragma unroll
        for (int j = 0; j < 8; ++j) { kv[j] = *(const u32x2*)(p + (size_t)(n0 + j) * 4096); if (Dbase) dd[j] = *(const f32x4*)(Dbase + ((size_t)bh * NCH + n0 + j) * 64 + d0); else dd[j] = (f32x4){dscal, dscal, dscal, dscal}; }
#pragma unroll
        for (int j = 0; j < 8; ++j) {
            st[0] = st[0] * dd[j][0] + bflo(kv[j].x); st[1] = st[1] * dd[j][1] + bfhi(kv[j].x); st[2] = st[2] * dd[j][2] + bflo(kv[j].y); st[3] = st[3] * dd[j][3] + bfhi(kv[j].y);
            u32x2 w; w.x = cvt_pk_bf16(st[0], st[1]); w.y = cvt_pk_bf16(st[2], st[3]); st_wt8(p + (size_t)(n0 + j) * 4096, w); }
    }
}

constexpr int RW_R0 = 0, RW_R1 = 4608, RW_R2 = 9216, RW_R3 = 13824, RW_R4 = 16384, RW_R5 = 18944, RW_LW = 0, RW_AG = 8704, LDLW = 272;
__device__ __forceinline__ void ld_shift8(const bf16* urow, bool has_prev, const float* mu8, f32x4& lo, f32x4& hi) {
    const u32x4 w1 = *(const u32x4*)urow; f32x4 a0, a1; unpack8(w1, a0, a1);
    f32x4 p0 = {0.f, 0.f, 0.f, 0.f}, p1 = {0.f, 0.f, 0.f, 0.f};
    if (has_prev) { const u32x4 w0 = *(const u32x4*)(urow - UW); unpack8(w0, p0, p1); }
    const f32x4 m0 = *(const f32x4*)mu8, m1 = *(const f32x4*)(mu8 + 4);
    lo = a0 + m0 * (p0 - a0); hi = a1 + m1 * (p1 - a1);
}
__device__ __forceinline__ float ftanh(float x) { return 1.0f - 2.0f * __builtin_amdgcn_rcpf(1.0f + __builtin_amdgcn_exp2f(2.8853900817779268f * x)); }
#ifndef RW_LIMIT
#define RW_LIMIT 100
#endif
#define RW_CUT(k) do { if (RW_LIMIT <= (k)) return; } while (0)
template <int SI> struct SubstStep {
    static __device__ __forceinline__ void run(float (&Tr)[CH], const LAS unsigned char* AT, int r32, int& ofs) {
        float a0 = (r32 == SI) ? 1.0f : 0.f, a1 = 0.f;
#pragma unroll
        for (int q = 0; q < 4; ++q) { if (8 * q + 7 > SI) { const u32x4 w = *(const LAS u32x4*)(AT + ofs + SI * LD32 + q * 16); f32x4 lo, hi; unpack8(w, lo, hi);
#pragma unroll
            for (int x = 0; x < 4; ++x) { if (8 * q + x > SI) a0 += Tr[8 * q + x] * lo[x]; if (8 * q + 4 + x > SI) a1 += Tr[8 * q + 4 + x] * hi[x]; } } }
        const float a = a0 + a1;
        Tr[SI] = a;
        asm volatile("" : "+v"(ofs) : "v"(a));
        SubstStep<SI - 1>::run(Tr, AT, r32, ofs);
    }
};
template <> struct SubstStep<-1> { static __device__ __forceinline__ void run(float (&)[CH], const LAS unsigned char*, int, int&) {} };
template <bool M3>
__device__ __forceinline__ void rwkv_chunk(Frame& F, int L, int bh, int n, LAS unsigned char* W) {
    const bf16* u = (const bf16*)(F.ws + WS_U); bf16* bo = (bf16*)(F.ws + WS_BO);
    int lane = F.lane; asm volatile("" : "+v"(lane));
    const int b = bh >> 2, h = bh & 3, r32 = lane & 31, hh = lane >> 5; const size_t row0 = (size_t)b * S + (size_t)n * CH;
    const bf16* ur = u + row0 * UW + U_RW;
    const float* mu = F.in[I_MU] + L * 1024;
    const bf16* upT = (const bf16*)(F.ws + WS_RWUP + (size_t)L * 131072);
    bf16* Mg = (bf16*)(F.ws + WS_RWM) + ((size_t)bh * NCH + n) * 4096;
    bf16* Ng = (bf16*)(F.ws + WS_RWN) + ((size_t)bh * NCH + n) * 4096;
    LAS unsigned char* R0 = W + RW_R0; LAS unsigned char* R1 = W + RW_R1; LAS unsigned char* R2 = W + RW_R2; LAS unsigned char* R3 = W + RW_R3; LAS unsigned char* R4 = W + RW_R4;
    LAS float* R5 = (LAS float*)(W + RW_R5);
#pragma unroll
    for (int i = 0; i < 8; ++i) { const int idx = lane + 64 * i, t = idx >> 4, part = (idx >> 3) & 1, ch = idx & 7, col = 768 + part * 64 + ch * 8;
        f32x4 lo, hi; ld_shift8(ur + (size_t)t * UW + col, (n * CH + t) > 0, mu + col, lo, hi);
        if (part == 0) {
#pragma unroll
            for (int j = 0; j < 4; ++j) { lo[j] = ftanh(lo[j]); hi[j] = ftanh(hi[j]); } }
        *(LAS u32x4*)(W + part * 4608 + t * LD64 + ch * 16) = pack8(lo, hi); }
    RW_CUT(0);
    LDS_WAIT();
    { f32x16 zw[2], za[2];
#pragma unroll
      for (int ct = 0; ct < 2; ++ct) { zw[ct] = zero16(); za[ct] = zero16();
#pragma unroll
        for (int ks = 0; ks < 4; ++ks) { zw[ct] = mma32(frag_g(upT + (size_t)(h * 64 + 32 * ct) * 64, 64, 0, 16 * ks, lane), frag_rm(W, LD64, 0, 16 * ks, lane), zw[ct]);
            za[ct] = mma32(frag_g(upT + 256 * 64 + (size_t)(h * 64 + 32 * ct) * 64, 64, 0, 16 * ks, lane), frag_rm(W + 4608, LD64, 0, 16 * ks, lane), za[ct]); } }
      const float* w0 = F.in[I_W0] + L * 256 + h * 64; const float* a0 = F.in[I_A0] + L * 256 + h * 64;
#pragma unroll
      for (int ct = 0; ct < 2; ++ct)
#pragma unroll
        for (int g = 0; g < 4; ++g) { const int c0 = 32 * ct + 8 * g + 4 * hh; const f32x4 wv = *(const f32x4*)(w0 + c0), av = *(const f32x4*)(a0 + c0);
            f32x4 lw, ag;
#pragma unroll
            for (int x = 0; x < 4; ++x) { lw[x] = -0.6065306597126334f * fsigmoid(zw[ct][4 * g + x] + wv[x]); ag[x] = fsigmoid(za[ct][4 * g + x] + av[x]); }
            *(LAS f32x4*)(W + RW_LW + r32 * LDLW + c0 * 4) = lw;
            u32x2 pk; pk.x = cvt_pk_bf16(ag[0], ag[1]); pk.y = cvt_pk_bf16(ag[2], ag[3]); *(LAS u32x2*)(W + RW_AG + r32 * LD64 + c0 * 2) = pk; } }
    RW_CUT(1);
    LDS_WAIT();
    { float run = 0.f;
#pragma unroll
      for (int t = 0; t < CH; ++t) { LAS float* p = (LAS float*)(W + RW_LW + t * LDLW) + lane; run += *p; *p = run; } }
    RW_CUT(2);
    LDS_WAIT();
    const int c0 = 8 * (lane & 7), tl = lane >> 3;
    u32x4 E1p[4], E2p[4], AGp[4];
#pragma unroll
    for (int p = 0; p < 4; ++p) { const int t = 8 * p + tl;
        const f32x4 ca = *(const LAS f32x4*)(W + RW_LW + t * LDLW + c0 * 4), cb = *(const LAS f32x4*)(W + RW_LW + t * LDLW + c0 * 4 + 16);
        f32x4 ea = {0.f, 0.f, 0.f, 0.f}, eb = {0.f, 0.f, 0.f, 0.f};
        if (t > 0) { ea = *(const LAS f32x4*)(W + RW_LW + (t - 1) * LDLW + c0 * 4); eb = *(const LAS f32x4*)(W + RW_LW + (t - 1) * LDLW + c0 * 4 + 16); }
        AGp[p] = *(const LAS u32x4*)(W + RW_AG + t * LD64 + c0 * 2);
        f32x4 x1a, x1b, x2a, x2b;
#pragma unroll
        for (int x = 0; x < 4; ++x) { x1a[x] = __expf(ea[x]); x1b[x] = __expf(eb[x]); x2a[x] = __expf(-ca[x]); x2b[x] = __expf(-cb[x]); }
        E1p[p] = pack8(x1a, x1b); E2p[p] = pack8(x2a, x2b); }
    float pcl[8];
    { const f32x4 la = *(const LAS f32x4*)(W + RW_LW + 31 * LDLW + c0 * 4), lb2 = *(const LAS f32x4*)(W + RW_LW + 31 * LDLW + c0 * 4 + 16);
#pragma unroll
      for (int x = 0; x < 4; ++x) { pcl[x] = __expf(la[x]); pcl[4 + x] = __expf(lb2[x]); } }
    RW_CUT(3);
    LDS_WAIT();
    const float* kkw = F.in[I_KK] + L * 256 + h * 64 + c0; const float* kaw = F.in[I_KA] + L * 256 + h * 64 + c0; const float* rkw = F.in[I_RK] + L * 256 + h * 64 + c0;
    u32x4 Ap[4];
    if (!M3 && tl == 0) { *(LAS f32x4*)(R5 + c0) = (f32x4){pcl[0], pcl[1], pcl[2], pcl[3]}; *(LAS f32x4*)(R5 + c0 + 4) = (f32x4){pcl[4], pcl[5], pcl[6], pcl[7]}; }
#pragma unroll
    for (int p = 0; p < 4; ++p) { const int t = 8 * p + tl; const bool hp = (n * CH + t) > 0; const bf16* ut = ur + (size_t)t * UW + h * 64 + c0;
        f32x4 k0, k1, r0 = {0.f, 0.f, 0.f, 0.f}, r1 = {0.f, 0.f, 0.f, 0.f};
        ld_shift8(ut + 256, hp, mu + 256 + h * 64 + c0, k0, k1);
        if (M3) ld_shift8(ut, hp, mu + h * 64 + c0, r0, r1);
        f32x4 ag0, ag1; unpack8(AGp[p], ag0, ag1);
        float E1[8], E2[8]; { f32x4 a, bq; unpack8(E1p[p], a, bq); f32x4 c, d; unpack8(E2p[p], c, d);
#pragma unroll
            for (int x = 0; x < 4; ++x) { E1[x] = a[x]; E1[4 + x] = bq[x]; E2[x] = c[x]; E2[4 + x] = d[x]; } }
        const f32x4 kw0 = *(const f32x4*)kkw, kw1 = *(const f32x4*)(kkw + 4), ka0 = *(const f32x4*)kaw, ka1 = *(const f32x4*)(kaw + 4);
        f32x4 q0 = k0 * kw0, q1 = k1 * kw1;
        float n2 = (q0[0] * q0[0] + q0[1] * q0[1]) + (q0[2] * q0[2] + q0[3] * q0[3]) + (q1[0] * q1[0] + q1[1] * q1[1]) + (q1[2] * q1[2] + q1[3] * q1[3]);
        n2 += __shfl_xor(n2, 1); n2 += __shfl_xor(n2, 2); n2 += __shfl_xor(n2, 4);
        const float rn = __builtin_amdgcn_rsqf(fmaxf(n2, 1e-24f)); q0 = q0 * rn; q1 = q1 * rn;
        f32x4 kp0, kp1, at0, at1, bt0, bt1, kt0, kt1;
#pragma unroll
        for (int x = 0; x < 4; ++x) { kp0[x] = k0[x] * (1.0f + (ag0[x] - 1.0f) * ka0[x]); kp1[x] = k1[x] * (1.0f + (ag1[x] - 1.0f) * ka1[x]);
            at0[x] = -q0[x] * E1[x]; at1[x] = -q1[x] * E1[4 + x]; bt0[x] = q0[x] * ag0[x] * E2[x]; bt1[x] = q1[x] * ag1[x] * E2[4 + x];
            kt0[x] = kp0[x] * E2[x]; kt1[x] = kp1[x] * E2[4 + x]; }
        *(LAS u32x4*)(R1 + t * LD64 + c0 * 2) = pack8(bt0, bt1); *(LAS u32x4*)(R2 + t * LD64 + c0 * 2) = pack8(kt0, kt1);
        if (!M3) *(LAS u32x4*)(R0 + t * LD64 + c0 * 2) = pack8(at0, at1);
        else { Ap[p] = pack8(at0, at1);
            const f32x4 rk0 = *(const f32x4*)rkw, rk1 = *(const f32x4*)(rkw + 4);
            f32x4 rt0, rt1; float bs = 0.f;
#pragma unroll
            for (int x = 0; x < 4; ++x) { rt0[x] = r0[x] * __builtin_amdgcn_rcpf(E2[x]); rt1[x] = r1[x] * __builtin_amdgcn_rcpf(E2[4 + x]); bs += r0[x] * kp0[x] * rk0[x] + r1[x] * kp1[x] * rk1[x]; }
            bs += __shfl_xor(bs, 1); bs += __shfl_xor(bs, 2); bs += __shfl_xor(bs, 4);
            if ((lane & 7) == 0) R5[t] = bs;
            *(LAS u32x4*)(R0 + t * LD64 + c0 * 2) = pack8(rt0, rt1); } }
    RW_CUT(4);
    LDS_WAIT();
    const bf16* S0 = n > 0 ? Ng - 4096 : nullptr;
    f32x16 yacc[2], g2acc;
    if (M3) {
#pragma unroll
        for (int vt = 0; vt < 2; ++vt) { yacc[vt] = zero16();
            if (S0) {
#pragma unroll
                for (int ks = 0; ks < 4; ++ks) yacc[vt] = mma32(frag_g(S0, 64, 32 * vt, 16 * ks, lane), frag_rm(R0, LD64, 0, 16 * ks, lane), yacc[vt]); } }
        f32x16 g1 = zero16(); g2acc = zero16();
#pragma unroll
        for (int ks = 0; ks < 4; ++ks) { const bf16x8 rf = frag_rm(R0, LD64, 0, 16 * ks, lane); g1 = mma32(frag_rm(R1, LD64, 0, 16 * ks, lane), rf, g1); g2acc = mma32(frag_rm(R2, LD64, 0, 16 * ks, lane), rf, g2acc); }
#pragma unroll
        for (int i = 0; i < 16; ++i) { const int sidx = (i & 3) + 8 * (i >> 2) + 4 * hh; if (sidx > r32) { g1[i] = 0.f; g2acc[i] = 0.f; } }
        st_T(R4, LD32, 0, 0, g1, lane);
        LDS_WAIT();
#pragma unroll
        for (int p = 0; p < 4; ++p) *(LAS u32x4*)(R0 + (8 * p + tl) * LD64 + c0 * 2) = Ap[p];
        LDS_WAIT();
    }
    RW_CUT(5);
    { f32x16 ab = zero16(), ak = zero16();
#pragma unroll
      for (int ks = 0; ks < 4; ++ks) { const bf16x8 af = frag_rm(R0, LD64, 0, 16 * ks, lane); ab = mma32(af, frag_rm(R1, LD64, 0, 16 * ks, lane), ab); ak = mma32(frag_rm(R2, LD64, 0, 16 * ks, lane), af, ak); }
#pragma unroll
      for (int i = 0; i < 16; ++i) { const int ridx = (i & 3) + 8 * (i >> 2) + 4 * hh;
          if (!(ridx > r32)) ab[i] = 0.f;
          if (!(ridx < r32)) ak[i] = 0.f; }
      st_T(R3, LD32, 0, 0, ab, lane);
      st_T(M3 ? R2 : R4, LD32, 0, 0, ak, lane); }
    LAS unsigned char* X1 = M3 ? R2 : R4;
    RW_CUT(6);
    LDS_WAIT();
    { float Tr[CH];
      int sofs = 0; asm volatile("" : "+v"(sofs)); SubstStep<CH - 1>::run(Tr, R3, r32, sofs);
      if (hh == 0) {
#pragma unroll
          for (int q = 0; q < 4; ++q) { f32x4 lo = {Tr[8 * q], Tr[8 * q + 1], Tr[8 * q + 2], Tr[8 * q + 3]}, hi = {Tr[8 * q + 4], Tr[8 * q + 5], Tr[8 * q + 6], Tr[8 * q + 7]};
              *(LAS u32x4*)(R3 + r32 * LD32 + q * 16) = pack8(lo, hi); } } }
    RW_CUT(7);
    LDS_WAIT();
    { f32x16 y = zero16(), ah[2];
#pragma unroll
      for (int ks = 0; ks < 2; ++ks) y = mma32(frag_tr(X1, LD32, 16 * ks, 0, lane), frag_rm(R3, LD32, 0, 16 * ks, lane), y);
#pragma unroll
      for (int ct = 0; ct < 2; ++ct) { ah[ct] = zero16();
#pragma unroll
        for (int ks = 0; ks < 2; ++ks) ah[ct] = mma32(frag_tr(R0, LD64, 16 * ks, 32 * ct, lane), frag_rm(R3, LD32, 0, 16 * ks, lane), ah[ct]); }
      st_T(X1, LD32, 0, 0, y, lane);
      st_T(R0, LD64, 0, 0, ah[0], lane); st_T(R0, LD64, 0, 32, ah[1], lane); }
    RW_CUT(8);
    LDS_WAIT();
    if (!M3) {
        { f32x16 z[2];
#pragma unroll
          for (int dt = 0; dt < 2; ++dt) {
#pragma unroll
            for (int g = 0; g < 4; ++g) { const u32x2 w = *(const LAS u32x2*)(R2 + r32 * LD64 + (32 * dt + 8 * g + 4 * hh) * 2); z[dt][4 * g] = bflo(w.x); z[dt][4 * g + 1] = bfhi(w.x); z[dt][4 * g + 2] = bflo(w.y); z[dt][4 * g + 3] = bfhi(w.y); }
#pragma unroll
            for (int ks = 0; ks < 2; ++ks) z[dt] = mma32(frag_tr(R1, LD64, 16 * ks, 32 * dt, lane), frag_tr(X1, LD32, 16 * ks, 0, lane), z[dt]); }
          st_T(R2, LD64, 0, 0, z[0], lane); st_T(R2, LD64, 0, 32, z[1], lane); }
#pragma unroll
        for (int d1t = 0; d1t < 2; ++d1t) { const float pc1 = R5[32 * d1t + r32];
#pragma unroll
            for (int d2t = 0; d2t < 2; ++d2t) { f32x16 m = zero16();
#pragma unroll
                for (int ks = 0; ks < 2; ++ks) m = mma32(frag_tr(R0, LD64, 16 * ks, 32 * d2t, lane), frag_tr(R1, LD64, 16 * ks, 32 * d1t, lane), m);
#pragma unroll
                for (int i = 0; i < 16; ++i) { const int d2 = 32 * d2t + (i & 3) + 8 * (i >> 2) + 4 * hh; m[i] = pc1 * (m[i] + ((d2 == 32 * d1t + r32) ? 1.0f : 0.f)); }
                st_T_g(Mg, 64, 32 * d1t, 32 * d2t, m, lane); } }
        LDS_WAIT();
#pragma unroll
        for (int p = 0; p < 4; ++p) { const int t = 8 * p + tl; f32x4 v0, v1; ld_shift8(ur + (size_t)t * UW + h * 64 + c0 + 512, (n * CH + t) > 0, mu + 512 + h * 64 + c0, v0, v1); *(LAS u32x4*)(R1 + t * LD64 + c0 * 2) = pack8(v0, v1); }
        LDS_WAIT();
#pragma unroll
        for (int dt = 0; dt < 2; ++dt)
#pragma unroll
            for (int vt = 0; vt < 2; ++vt) { f32x16 nn = zero16();
#pragma unroll
                for (int ks = 0; ks < 2; ++ks) nn = mma32(frag_tr(R2, LD64, 16 * ks, 32 * dt, lane), frag_tr(R1, LD64, 16 * ks, 32 * vt, lane), nn);
#pragma unroll
                for (int g = 0; g < 4; ++g) { const f32x4 pv = *(const LAS f32x4*)(R5 + 32 * dt + 8 * g + 4 * hh);
#pragma unroll
                    for (int x = 0; x < 4; ++x) nn[4 * g + x] *= pv[x]; }
                st_T_g(Ng, 64, 32 * vt, 32 * dt, nn, lane); }
    } else {
        { f32x16 rh[2];
#pragma unroll
          for (int dt = 0; dt < 2; ++dt) { rh[dt] = zero16();
#pragma unroll
            for (int ks = 0; ks < 2; ++ks) rh[dt] = mma32(frag_tr(R0, LD64, 16 * ks, 32 * dt, lane), frag_rm(R4, LD32, 0, 16 * ks, lane), rh[dt]); }
          st_T(R1, LD64, 0, 0, rh[0], lane); st_T(R1, LD64, 0, 32, rh[1], lane); }
        { f32x16 gh = g2acc;
#pragma unroll
          for (int ks = 0; ks < 2; ++ks) gh = mma32(frag_tr(X1, LD32, 16 * ks, 0, lane), frag_rm(R4, LD32, 0, 16 * ks, lane), gh);
          LDS_WAIT();
          st_T(R3, LD32, 0, 0, gh, lane); }
        LDS_WAIT();
        if (S0) {
#pragma unroll
            for (int vt = 0; vt < 2; ++vt)
#pragma unroll
                for (int ks = 0; ks < 4; ++ks) yacc[vt] = mma32(frag_g(S0, 64, 32 * vt, 16 * ks, lane), frag_rm(R1, LD64, 0, 16 * ks, lane), yacc[vt]); }
        LDS_WAIT();
#pragma unroll
        for (int p = 0; p < 4; ++p) { const int t = 8 * p + tl; f32x4 v0, v1; ld_shift8(ur + (size_t)t * UW + h * 64 + c0 + 512, (n * CH + t) > 0, mu + 512 + h * 64 + c0, v0, v1); *(LAS u32x4*)(R0 + t * LD64 + c0 * 2) = pack8(v0, v1); }
#pragma unroll
        for (int i = 0; i < 8; ++i) { const int idx = lane + 64 * i, t = idx >> 4, ch = idx & 15, col = 896 + ch * 8;
            f32x4 lo, hi; ld_shift8(ur + (size_t)t * UW + col, (n * CH + t) > 0, mu + col, lo, hi);
#pragma unroll
            for (int j = 0; j < 4; ++j) { lo[j] = fsigmoid(lo[j]); hi[j] = fsigmoid(hi[j]); }
            *(LAS u32x4*)(R1 + t * LDLW + ch * 16) = pack8(lo, hi); }
        LDS_WAIT();
        f32x16 gacc[2];
#pragma unroll
        for (int vt = 0; vt < 2; ++vt) {
#pragma unroll
            for (int ks = 0; ks < 2; ++ks) yacc[vt] = mma32(frag_tr(R0, LD64, 16 * ks, 32 * vt, lane), frag_rm(R3, LD32, 0, 16 * ks, lane), yacc[vt]);
            gacc[vt] = zero16();
#pragma unroll
            for (int ks = 0; ks < 8; ++ks) gacc[vt] = mma32(frag_g(upT + 2 * 256 * 64 + (size_t)(h * 64 + 32 * vt) * 128, 128, 0, 16 * ks, lane), frag_rm(R1, LDLW, 0, 16 * ks, lane), gacc[vt]); }
        float sm = 0.f;
#pragma unroll
        for (int vt = 0; vt < 2; ++vt)
#pragma unroll
            for (int i = 0; i < 16; ++i) sm += yacc[vt][i];
        sm += __shfl_xor(sm, 32);
        const float mean = sm * (1.0f / 64.0f); float sv = 0.f;
#pragma unroll
        for (int vt = 0; vt < 2; ++vt)
#pragma unroll
            for (int i = 0; i < 16; ++i) { const float dl = yacc[vt][i] - mean; sv += dl * dl; }
        sv += __shfl_xor(sv, 32);
        const float rstd = __builtin_amdgcn_rsqf(sv * (1.0f / 64.0f) + 64e-5f);
        const float bon = R5[r32];
        const float* ng = F.in[I_RW_G] + L * 256 + h * 64; const float* nb = F.in[I_RW_B] + L * 256 + h * 64;
#pragma unroll
        for (int vt = 0; vt < 2; ++vt)
#pragma unroll
            for (int g = 0; g < 4; ++g) { const int v0i = 32 * vt + 8 * g + 4 * hh;
                const u32x2 vw = *(const LAS u32x2*)(R0 + r32 * LD64 + v0i * 2); const f32x4 gg = *(const f32x4*)(ng + v0i), bb = *(const f32x4*)(nb + v0i);
                const float vv[4] = {bflo(vw.x), bfhi(vw.x), bflo(vw.y), bfhi(vw.y)}; float o[4];
#pragma unroll
                for (int x = 0; x < 4; ++x) o[x] = ((yacc[vt][4 * g + x] - mean) * rstd * gg[x] + bb[x] + bon * vv[x]) * gacc[vt][4 * g + x];
                u32x2 w; w.x = cvt_pk_bf16(o[0], o[1]); w.y = cvt_pk_bf16(o[2], o[3]);
                *(u32x2*)(bo + (row0 + r32) * 1024 + 768 + h * 64 + v0i) = w; }
    }
    LDS_WAIT();
}
__device__ __forceinline__ void rwkv_scan_task(Frame& F, int bh, int vh) {
    const int lane = F.lane, r32 = lane & 31, hh = lane >> 5;
    const bf16* Mb = (const bf16*)(F.ws + WS_RWM) + (size_t)bh * NCH * 4096; bf16* Nb = (bf16*)(F.ws + WS_RWN) + (size_t)bh * NCH * 4096 + (size_t)(vh * 32 + r32) * 64;
    f32x16 st[2] = {zero16(), zero16()};
    u32x2 nq[2][4], mq[2][2][2][2];
#define RW_PREF(nn) do { _Pragma("unroll") for (int dt = 0; dt < 2; ++dt) _Pragma("unroll") for (int g = 0; g < 4; ++g) nq[dt][g] = *(const u32x2*)(Nb + (size_t)(nn) * 4096 + 32 * dt + 8 * g + 4 * hh); \
        _Pragma("unroll") for (int d1t = 0; d1t < 2; ++d1t) _Pragma("unroll") for (int dt = 0; dt < 2; ++dt) _Pragma("unroll") for (int s2 = 0; s2 < 2; ++s2) { \
            const bf16* mp = Mb + (size_t)(nn) * 4096 + (size_t)(32 * d1t + r32) * 64 + 32 * dt + 16 * s2 + 4 * hh; mq[d1t][dt][s2][0] = *(const u32x2*)mp; mq[d1t][dt][s2][1] = *(const u32x2*)(mp + 8); } } while (0)
    RW_PREF(0);
    for (int n = 0; n < NCH; ++n) {
        bf16x8 bfr[2][2];
#pragma unroll
        for (int dt = 0; dt < 2; ++dt)
#pragma unroll
            for (int s2 = 0; s2 < 2; ++s2) { union { bf16x8 v; unsigned w[4]; } pf;
#pragma unroll
                for (int j = 0; j < 4; ++j) pf.w[j] = cvt_pk_bf16(st[dt][8 * s2 + 2 * j], st[dt][8 * s2 + 2 * j + 1]);
                bfr[dt][s2] = pf.v; }
        f32x16 nw[2];
#pragma unroll
        for (int d1t = 0; d1t < 2; ++d1t) {
#pragma unroll
            for (int g = 0; g < 4; ++g) { nw[d1t][4 * g] = bflo(nq[d1t][g].x); nw[d1t][4 * g + 1] = bfhi(nq[d1t][g].x); nw[d1t][4 * g + 2] = bflo(nq[d1t][g].y); nw[d1t][4 * g + 3] = bfhi(nq[d1t][g].y); }
#pragma unroll
            for (int dt = 0; dt < 2; ++dt)
#pragma unroll
                for (int s2 = 0; s2 < 2; ++s2) { union { bf16x8 v; u32x2 d[2]; } mf; mf.d[0] = mq[d1t][dt][s2][0]; mf.d[1] = mq[d1t][dt][s2][1]; nw[d1t] = mma32(mf.v, bfr[dt][s2], nw[d1t]); } }
        if (n + 1 < NCH) RW_PREF(n + 1);
#pragma unroll
        for (int d1t = 0; d1t < 2; ++d1t) { st[d1t] = nw[d1t];
#pragma unroll
            for (int g = 0; g < 4; ++g) { u32x2 w; w.x = cvt_pk_bf16(nw[d1t][4 * g], nw[d1t][4 * g + 1]); w.y = cvt_pk_bf16(nw[d1t][4 * g + 2], nw[d1t][4 * g + 3]); st_wt8(Nb + (size_t)n * 4096 + 32 * d1t + 8 * g + 4 * hh, w); } }
    }
#undef RW_PREF
}

constexpr int NS_KROW = 144, NS_VROW = 144;
constexpr int NS_KB = 64 * NS_KROW, NS_VB = 64 * NS_VROW;
constexpr int NS_K0 = 0, NS_V0 = 2 * NS_KB, NS_IMP = NS_V0 + 2 * NS_VB, NS_SEL = NS_IMP + 64 * 128 * 4, NS_END = NS_SEL + 64 * 4 * 4;
constexpr int NS_OUT = NS_END, NS_END2 = NS_OUT + 8 * 8192;
static_assert(NS_END2 <= MISC_OFF, "nsa lds");
struct NsaRow { float m, l; f32x16 o[2]; };
__device__ __forceinline__ void ns_load(const bf16* kb, const bf16* vb, size_t stride, int tid, u32x4& kr, u32x4& vr) {
    const int key = tid >> 3, ch = tid & 7; kr = *(const u32x4*)(kb + (size_t)key * stride + ch * 8); vr = *(const u32x4*)(vb + (size_t)key * stride + ch * 8);
}
__device__ __forceinline__ void ns_store(LAS unsigned char* Kb, LAS unsigned char* Vb, int tid, const u32x4& kr, const u32x4& vr) {
    const int key = tid >> 3, ch = tid & 7;
    *(LAS u32x4*)(Kb + key * NS_KROW + ch * 16) = kr;
    *(LAS u32x4*)(Vb + key * NS_VROW + ch * 16) = vr;
}
__device__ __forceinline__ void ns_qk(LAS unsigned char* Kb, const bf16x8 (&qf)[4], int r, int h2, f32x16 (&sacc)[2]) {
#pragma unroll
    for (int sub = 0; sub < 2; ++sub) { f32x16 a;
#pragma unroll
        for (int i = 0; i < 16; ++i) a[i] = 0.f;
#pragma unroll
        for (int kk = 0; kk < 4; ++kk) { const bf16x8 kf = *(const LAS bf16x8*)(Kb + (32 * sub + r) * NS_KROW + (8 * h2 + 16 * kk) * 2); a = __builtin_amdgcn_mfma_f32_32x32x16_bf16(kf, qf[kk], a, 0, 0, 0); }
        sacc[sub] = a; }
}
enum { NS_CMP = 0, NS_SEL_ = 1, NS_WIN = 2 };
template <int MODE> __device__ __forceinline__ bool ns_valid(int key, int t, bool blk_on) {
    if (MODE == NS_CMP) return 16 * key + 31 <= t;
    if (MODE == NS_SEL_) return blk_on && key <= t;
    return key <= t && key + 511 >= t;
}
template <int MODE>
__device__ __forceinline__ void ns_branch(Frame& F, const bf16* kbase, const bf16* vbase, size_t stride, int tile_lo, int tile_hi, const bf16x8 (&qf)[4], int t, int r, int h2,
                                          const unsigned (&selw)[4], NsaRow& R) {
    LAS unsigned char* L = F.lds;
    R.m = -1e30f; R.l = 0.f;
#pragma unroll
    for (int e = 0; e < 2; ++e)
#pragma unroll
        for (int i = 0; i < 16; ++i) R.o[e][i] = 0.f;
    if (tile_hi <= tile_lo) return;
    u32x4 kr, vr;
    ns_load(kbase + (size_t)tile_lo * 64 * stride, vbase + (size_t)tile_lo * 64 * stride, stride, F.tid, kr, vr);
    __syncthreads();
    ns_store(L + NS_K0, L + NS_V0, F.tid, kr, vr);
    __syncthreads();
    for (int ti = tile_lo; ti < tile_hi; ++ti) {
        const int buf = (ti - tile_lo) & 1;
        if (ti + 1 < tile_hi) ns_load(kbase + (size_t)(ti + 1) * 64 * stride, vbase + (size_t)(ti + 1) * 64 * stride, stride, F.tid, kr, vr);
        LAS unsigned char* Kb = L + NS_K0 + buf * NS_KB; LAS unsigned char* Vb = L + NS_V0 + buf * NS_VB;
        bool blk_on = true;
        if (MODE == NS_SEL_) blk_on = (selw[ti >> 5] >> (ti & 31)) & 1u;
        bool any;
        if (MODE == NS_CMP) any = 16 * (ti * 64) + 31 <= t; else if (MODE == NS_SEL_) any = blk_on && ti * 64 <= t; else any = (ti * 64 <= t) && (ti * 64 + 63 + 511 >= t);
        if (__ballot(any) != 0ull) {
            f32x16 sacc[2];
            ns_qk(Kb, qf, r, h2, sacc);
            bool full;
            { const int tmin = t - (r & 7), tmax = tmin + 7;
              if (MODE == NS_CMP) full = 16 * (ti * 64 + 63) + 31 <= tmin; else if (MODE == NS_SEL_) full = ti * 64 + 63 <= tmin; else full = (ti * 64 + 63 <= tmin) && (ti * 64 + 511 >= tmax); }
            float sc, rs = 0.f;
            if (full) {
                const bool rowon = (MODE != NS_SEL_) || blk_on;
                float m0 = sacc[0][0], m1 = sacc[1][0];
#pragma unroll
                for (int i = 1; i < 16; ++i) { m0 = fmaxf(m0, sacc[0][i]); m1 = fmaxf(m1, sacc[1][i]); }
                float mt = rowon ? fmaxf(m0, m1) : -1e30f;
                mt = fmaxf(mt, __shfl_xor(mt, 32));
                const float mn = fmaxf(R.m, mt); sc = __expf(R.m - mn);
                const float nb = -1.44269504f * (rowon ? mn : 1e30f);
#pragma unroll
                for (int sub = 0; sub < 2; ++sub)
#pragma unroll
                    for (int i = 0; i < 16; ++i) { const float p = __builtin_amdgcn_exp2f(__builtin_fmaf(sacc[sub][i], 1.44269504f, nb)); sacc[sub][i] = p; rs += p; }
                rs += __shfl_xor(rs, 32);
                R.l = R.l * sc + rs; R.m = mn;
            } else {
            float mt = -1e30f;
#pragma unroll
            for (int sub = 0; sub < 2; ++sub)
#pragma unroll
                for (int i = 0; i < 16; ++i) { const int key = ti * 64 + 32 * sub + (i & 3) + 8 * (i >> 2) + 4 * h2; const float sv = ns_valid<MODE>(key, t, blk_on) ? sacc[sub][i] : -1e30f; sacc[sub][i] = sv; mt = fmaxf(mt, sv); }
            mt = fmaxf(mt, __shfl_xor(mt, 32));
            const float mn = fmaxf(R.m, mt); sc = __expf(R.m - mn);
#pragma unroll
            for (int sub = 0; sub < 2; ++sub)
#pragma unroll
                for (int i = 0; i < 16; ++i) { const float sv = sacc[sub][i]; const float p = sv > -1e29f ? __expf(sv - mn) : 0.f; sacc[sub][i] = p; rs += p; }
            rs += __shfl_xor(rs, 32);
            R.l = R.l * sc + rs; R.m = mn;
            }
            if (__ballot(sc != 1.0f) != 0ull) {
#pragma unroll
                for (int e = 0; e < 2; ++e)
#pragma unroll
                    for (int i = 0; i < 16; ++i) R.o[e][i] *= sc; }
#pragma unroll
            for (int sub = 0; sub < 2; ++sub)
#pragma unroll
                for (int s2 = 0; s2 < 2; ++s2) {
                    union { bf16x8 v; unsigned w[4]; } pf;
#pragma unroll
                    for (int j = 0; j < 4; ++j) pf.w[j] = cvt_pk_bf16(sacc[sub][8 * s2 + 2 * j], sacc[sub][8 * s2 + 2 * j + 1]);
#pragma unroll
                    for (int e = 0; e < 2; ++e) {
                        const LAS unsigned char* vp = Vb + (32 * sub + 16 * s2 + 4 * h2 + ((F.lane & 15) >> 2)) * NS_VROW + (32 * e + 16 * ((F.lane >> 4) & 1) + 4 * (F.lane & 3)) * 2;
                        const s16x4 va = __builtin_amdgcn_ds_read_tr16_b64_v4i16((LAS s16x4*)vp), vb = __builtin_amdgcn_ds_read_tr16_b64_v4i16((LAS s16x4*)(vp + 8 * NS_VROW));
                        const bf16x8 vf = {va[0], va[1], va[2], va[3], vb[0], vb[1], vb[2], vb[3]};
                        R.o[e] = __builtin_amdgcn_mfma_f32_32x32x16_bf16(vf, pf.v, R.o[e], 0, 0, 0);
                    }
                }
        }
        if (ti + 1 < tile_hi) ns_store(L + NS_K0 + (buf ^ 1) * NS_KB, L + NS_V0 + (buf ^ 1) * NS_VB, F.tid, kr, vr);
        __syncthreads();
    }
}
__device__ __forceinline__ void ns_importance(Frame& F, const bf16* kbase, int ntiles, const bf16x8 (&qf)[4], int t, int r, int h2, float m, float inv_l) {
    LAS unsigned char* L = F.lds; LAS float* imp = (LAS float*)(L + NS_IMP);
    const int qrow = F.wave * 8 + (r & 7);
    u32x4 kr, vr;
    ns_load(kbase, kbase, 64, F.tid, kr, vr);
    __syncthreads();
    ns_store(L + NS_K0, L + NS_V0, F.tid, kr, vr);
    __syncthreads();
    for (int ti = 0; ti < ntiles; ++ti) {
        const int buf = ti & 1;
        if (ti + 1 < ntiles) ns_load(kbase + (size_t)(ti + 1) * 64 * 64, kbase + (size_t)(ti + 1) * 64 * 64, 64, F.tid, kr, vr);
        LAS unsigned char* Kb = L + NS_K0 + buf * NS_KB;
        f32x16 sacc[2];
        ns_qk(Kb, qf, r, h2, sacc);
#pragma unroll
        for (int sub = 0; sub < 2; ++sub)
#pragma unroll
            for (int g = 0; g < 4; ++g) {
                float p[4];
#pragma unroll
                for (int x = 0; x < 4; ++x) { const int key = ti * 64 + 32 * sub + x + 8 * g + 4 * h2; p[x] = (16 * key + 31 <= t) ? __expf(sacc[sub][4 * g + x] - m) * inv_l : 0.f; }
                float G = (p[0] + p[1]) + (p[2] + p[3]), E = p[3];
                G += __shfl_xor(G, 8); G += __shfl_xor(G, 16); E += __shfl_xor(E, 8); E += __shfl_xor(E, 16);
                const int jj = ti * 16 + 8 * sub + 2 * g + h2;
                if (r < 8) { atomicAdd((float*)(imp + qrow * 128 + jj), G); if (jj + 1 < 128) atomicAdd((float*)(imp + qrow * 128 + jj + 1), E); }
            }
        if (ti + 1 < ntiles) ns_store(L + NS_K0 + (buf ^ 1) * NS_KB, L + NS_V0 + (buf ^ 1) * NS_VB, F.tid, kr, vr);
        __syncthreads();
    }
}
__device__ __forceinline__ void nsa_unit(Frame& F0, int b, int c) {
    Frame F = F0; asm volatile("" : "+v"(F.tid)); F.lane = F.tid & 63;
    const bf16* u = (const bf16*)(F.ws + WS_U); bf16* bo = (bf16*)(F.ws + WS_BO);
    const bf16* kcmp = (const bf16*)(F.ws + WS_KCMP) + (size_t)b * 512 * 64; const bf16* vcmp = (const bf16*)(F.ws + WS_VCMP) + (size_t)b * 512 * 64;
    LAS unsigned char* L = F.lds; LAS float* imp = (LAS float*)(L + NS_IMP); LAS unsigned* selL = (LAS unsigned*)(L + NS_SEL);
    int lane = F.lane; asm volatile("" : "+v"(lane));
    const int r = lane & 31, h2 = lane >> 5, head = r >> 3, ql = r & 7;
    const int t = 64 * c + 8 * F.wave + ql; const size_t row = (size_t)b * S + t;
    const bf16* ub = u + (size_t)b * S * UW;
    bf16x8 qf[4];
#pragma unroll
    for (int kk = 0; kk < 4; ++kk) { const u32x4 w = *(const u32x4*)(u + row * UW + U_NSA + head * 64 + 8 * h2 + 16 * kk); f32x4 a, bb; unpack8(w, a, bb);
        union { bf16x8 v; u32x4 q; } cv; cv.q = pack8(a * 0.125f, bb * 0.125f); qf[kk] = cv.v; }
    const float g_cmp = fsigmoid(ldu(u, row, U_NSA + 640 + head)), g_sel = fsigmoid(ldu(u, row, U_NSA + 644 + head)), g_win = fsigmoid(ldu(u, row, U_NSA + 648 + head));
    unsigned selw[4] = {0xffffffffu, 0xffffffffu, 0xffffffffu, 0xffffffffu};
    NsaRow R;
    const int ncmp_tiles = (4 * c + 3 + 63) >> 6;
    ns_branch<NS_CMP>(F, kcmp, vcmp, 64, 0, ncmp_tiles, qf, t, r, h2, selw, R);
    LAS f32x4* stash = (LAS f32x4*)(L + NS_OUT + F.wave * 8192) + lane;
    { const float inv = R.l > 0.f ? 1.0f / R.l : 0.f; const float gs = g_cmp * inv;
#pragma unroll
      for (int e = 0; e < 2; ++e)
#pragma unroll
        for (int g = 0; g < 4; ++g) stash[(e * 4 + g) * 64] = (f32x4){R.o[e][4 * g] * gs, R.o[e][4 * g + 1] * gs, R.o[e][4 * g + 2] * gs, R.o[e][4 * g + 3] * gs};
      if (c >= 15) {
        for (int i = F.tid; i < 64 * 128; i += NTHR) imp[i] = 0.f;
        __syncthreads();
        ns_importance(F, kcmp, ncmp_tiles, qf, t, r, h2, R.m, inv);
        for (int q8 = 0; q8 < 8; ++q8) { const int qrow = F.wave * 8 + q8;
            float sc0, sc1;
            { const int j0 = lane, j1 = lane + 64;
              const bool f0 = (j0 == 0) || (j0 == c) || (j0 == c - 1), f1 = (j1 == c) || (j1 == c - 1);
              sc0 = f0 ? 1e30f : (j0 <= c ? imp[qrow * 128 + j0] : -1e30f); sc1 = f1 ? 1e30f : (j1 <= c ? imp[qrow * 128 + j1] : -1e30f); }
            unsigned long long lo = 0ull, hi = 0ull;
            for (int it = 0; it < 16; ++it) {
                const float best = wave_max(fmaxf(sc0, sc1));
                const unsigned long long m0 = __ballot(sc0 == best), m1 = __ballot(sc1 == best);
                int idx; if (m0) idx = __builtin_ctzll(m0); else idx = 64 + __builtin_ctzll(m1);
                if (idx < 64) { lo |= 1ull << idx; if (lane == idx) sc0 = -3e38f; } else { hi |= 1ull << (idx - 64); if (lane == idx - 64) sc1 = -3e38f; }
            }
            if (lane == 0) { selL[qrow * 4 + 0] = (unsigned)lo; selL[qrow * 4 + 1] = (unsigned)(lo >> 32); selL[qrow * 4 + 2] = (unsigned)hi; selL[qrow * 4 + 3] = (unsigned)(hi >> 32); }
        }
        LDS_WAIT();
#pragma unroll
        for (int j = 0; j < 4; ++j) selw[j] = selL[(F.wave * 8 + ql) * 4 + j];
      }
    }
    ns_branch<NS_SEL_>(F, ub + U_NSA + 384, ub + U_NSA + 448, UW, 0, c + 1, qf, t, r, h2, selw, R);
    { const float gs = g_sel / R.l;
#pragma unroll
      for (int e = 0; e < 2; ++e)
#pragma unroll
        for (int g = 0; g < 4; ++g) { f32x4 a = stash[(e * 4 + g) * 64]; a += (f32x4){R.o[e][4 * g] * gs, R.o[e][4 * g + 1] * gs, R.o[e][4 * g + 2] * gs, R.o[e][4 * g + 3] * gs}; stash[(e * 4 + g) * 64] = a; } }
    ns_branch<NS_WIN>(F, ub + U_NSA + 512, ub + U_NSA + 576, UW, c >= 8 ? c - 8 : 0, c + 1, qf, t, r, h2, selw, R);
    f32x16 out[2];
    { const float gs = g_win / R.l;
#pragma unroll
      for (int e = 0; e < 2; ++e)
#pragma unroll
        for (int g = 0; g < 4; ++g) { const f32x4 a = stash[(e * 4 + g) * 64];
#pragma unroll
            for (int x = 0; x < 4; ++x) out[e][4 * g + x] = a[x] + R.o[e][4 * g + x] * gs; } }
#pragma unroll
    for (int e = 0; e < 2; ++e)
#pragma unroll
        for (int g = 0; g < 4; ++g) { u32x2 w; w.x = cvt_pk_bf16(out[e][4 * g], out[e][4 * g + 1]); w.y = cvt_pk_bf16(out[e][4 * g + 2], out[e][4 * g + 3]);
            *(u32x2*)(bo + row * 1024 + head * 64 + 32 * e + 8 * g + 4 * h2) = w; }
}

__device__ __forceinline__ void cmp2_item(Frame& F, int L, int item) {
    int lane = F.lane; asm volatile("" : "+v"(lane));
    const int kv = item & 1, it = (item >> 1) & 15, b = item >> 5, r32 = lane & 31, hh = lane >> 5;
    const bf16* w2T = (const bf16*)(F.ws + WS_CW2 + (size_t)L * 65536) + kv * 64 * 128;
    const bf16* hid = (const bf16*)(F.ws + WS_CMPH) + ((size_t)(b * 512 + 32 * it)) * 256 + kv * 128;
    bf16* outp = (bf16*)(F.ws + (kv ? WS_VCMP : WS_KCMP)) + ((size_t)(b * 512 + 32 * it + r32)) * 64;
    const bool live = (32 * it + r32) < NCMP;
#pragma unroll
    for (int et = 0; et < 2; ++et) { f32x16 acc = zero16();
#pragma unroll
        for (int ks = 0; ks < 8; ++ks) acc = mma32(frag_g(w2T, 128, 32 * et, 16 * ks, lane), frag_g(hid, 256, 0, 16 * ks, lane), acc);
#pragma unroll
        for (int g = 0; g < 4; ++g) { u32x2 w; w.x = live ? cvt_pk_bf16(acc[4 * g], acc[4 * g + 1]) : 0u; w.y = live ? cvt_pk_bf16(acc[4 * g + 2], acc[4 * g + 3]) : 0u;
            *(u32x2*)(outp + 32 * et + 8 * g + 4 * hh) = w; } }
}
#ifdef SK_RWM1
#define RWM1(x)
#else
#define RWM1(x) x
#endif
#ifdef SK_RWM3
#define RWM3(x)
#else
#define RWM3(x) x
#endif
#ifdef SK_RWSC
#define RWSC(x)
#else
#define RWSC(x) x
#endif
__device__ __forceinline__ void phase_m1(Frame& F0, int L, bf16* hgS, bf16* rtS) {
    Frame F = F0; asm volatile("" : "+v"(F.tid)); F.lane = F.tid & 63;
    if (F.bx < 32) { LAS float* c1l = (LAS float*)(F.lds + RSTD_OFF + 1024);
      if (F.tid < 256) { const float* cp = (const float*)(F.ws + WS_CW2 + (size_t)L * 65536 + 32768) + (F.tid >> 7) * 32 * 128 + (F.tid & 127); float a = 0.f;
          for (int jq = 0; jq < 32; ++jq) a += cp[jq * 128];
          c1l[F.tid] = a; }
      __syncthreads(); }
    { CmpSched Sd{(const char*)(F.ws + WS_U), (const char*)(F.ws + WS_CW1 + (size_t)L * MiB), F.bx};
      EpiCmp E{(bf16*)(F.ws + WS_CMPH)};
      pg8::gemm_phase<EpiCmp, CmpSched, true>(F.lds + RING_OFF, Sd, E, (unsigned)(UW * 2), 128u); }
    LAS unsigned char* W = F.lds + F.wave * WREG;
    const int gw = F.bx * NWAVES + F.wave, NGW = F.G * NWAVES;
    for (int it = gw; it < 3 * 32 * NCH; it += NGW) { const int type = it % 3, q = it / 3, bh = q / NCH, n = q % NCH;
        if (type == 0) hgrn_chunk<false>(F, L, bh, n, W, hgS, (float*)(F.ws + WS_HGD)); else if (type == 1) ret_chunk<false>(F, L, bh, n, W, rtS); else { RWM1(rwkv_chunk<false>(F, L, bh, n, W)); } }
}
__device__ __forceinline__ void phase_scan(Frame& F0, int L, bf16* hgS, bf16* rtS) {
    Frame F = F0; asm volatile("" : "+v"(F.tid)); F.lane = F.tid & 63;
    if (F.tid < 256) {
        if (F.bx < 128) glin_scan_task(hgS, (const float*)(F.ws + WS_HGD), 0.f, F.bx >> 2, F.bx & 3, F.tid);
        else { const int k = F.bx - 128, h = (k >> 2) & 3; const float g = 1.0f - exp2f(-5.0f - (float)h); glin_scan_task(rtS, nullptr, exp2f(32.0f * __log2f(g)), k >> 2, k & 3, F.tid); }
    } else if (F.wave == 4) { if (F.bx < 64) { RWSC(rwkv_scan_task(F, F.bx >> 1, F.bx & 1)); } }
    else { for (int item = F.bx * 3 + (F.wave - 5); item < 256; item += F.G * 3) cmp2_item(F, L, item); }
}
__device__ __forceinline__ void phase_m3(Frame& F0, int L, bf16* hgS, bf16* rtS) {
    Frame F = F0; asm volatile("" : "+v"(F.tid)); F.lane = F.tid & 63;
    LAS unsigned char* W = F.lds + F.wave * WREG;
    const int gw = F.bx * NWAVES + F.wave, NGW = F.G * NWAVES;
    for (int it = gw; it < REP_ITEMS * 3 * 32 * NCH; it += NGW) { const int type = it % 3, q = (it / 3) % (32 * NCH), bh = q / NCH, n = q % NCH;
        if (type == 0) hgrn_chunk<true>(F, L, bh, n, W, hgS, nullptr); else if (type == 1) ret_chunk<true>(F, L, bh, n, W, rtS); else { RWM3(rwkv_chunk<true>(F, L, bh, n, W)); } }
    __syncthreads();
#ifndef SK_NSA
    for (int p = F.bx; p < REP_NSA * 512; p += F.G) { const int b = (p >> 6) & 7, cc = p & 63; nsa_unit(F, b, 127 - cc); nsa_unit(F, b, cc); }
#endif
}

__device__ __forceinline__ void phase_pconv(Frame& F0, int L) {
    Frame F = F0; asm volatile("" : "+v"(F.tid)); F.lane = F.tid & 63;
    const float* p = F.in[I_P] + (size_t)L * T * PLE; bf16* pbf = (bf16*)(F.ws + WS_PB);
    for (int r = F.bx * NWAVES + F.wave; r < T; r += F.G * NWAVES) { const f32x4 v = *((const f32x4*)(p + (size_t)r * PLE) + F.lane); u32x2 w; w.x = cvt_pk_bf16(v[0], v[1]); w.y = cvt_pk_bf16(v[2], v[3]); *((u32x2*)(pbf + (size_t)r * PLE) + F.lane) = w; }
}
__device__ __forceinline__ void phase_final_a(Frame& F0, const float* ss, float* rtab) {
    Frame F = F0; asm volatile("" : "+v"(F.tid)); F.lane = F.tid & 63;
    for (int r = F.bx * NTHR + F.tid; r < T; r += F.G * NTHR) rtab[r] = __builtin_amdgcn_rsqf(ss_row(ss, r) * (1.0f / D) + EPS);
}
__device__ __forceinline__ void phase_final_b(Frame& F0, const float* rtab, const bf16* hb) {
    Frame F = F0; asm volatile("" : "+v"(F.tid)); F.lane = F.tid & 63;
    const float* g = F.in[I_NORM_FINAL]; const int gw = F.bx * NWAVES + F.wave, NGW = F.G * NWAVES;
    for (int r = gw; r < T; r += NGW) { const float rs = rtab[r]; const u32x4* hr = (const u32x4*)(hb + (size_t)r * D) + F.lane; f32x4* orow = (f32x4*)(F.out + (size_t)r * D);
#pragma unroll
        for (int j = 0; j < 2; ++j) { f32x4 a, b; unpack8(hr[64 * j], a, b); const f32x4 g0 = *((const f32x4*)g + 2 * (F.lane + 64 * j)), g1 = *((const f32x4*)g + 2 * (F.lane + 64 * j) + 1);
            orow[2 * (F.lane + 64 * j)] = a * rs * g0; orow[2 * (F.lane + 64 * j) + 1] = b * rs * g1; } }
}

constexpr int PH_PER_LAYER = 9, N_PHASES = 1 + NL * PH_PER_LAYER + 2;
__global__ void __launch_bounds__(NTHR, 2) mega_fwd(Args args) {
    extern __shared__ __attribute__((aligned(16))) unsigned char lds_raw[];
    Frame F; F.lds = (LAS unsigned char*)lds_raw; F.tid = threadIdx.x; F.lane = F.tid & 63; F.wave = __builtin_amdgcn_readfirstlane(F.tid >> 6); F.G = gridDim.x; F.bx = blockIdx.x;
    F.in = args.in; F.out = args.out; F.ws = args.ws;
    volatile LAS unsigned* MISC = (volatile LAS unsigned*)(F.lds + MISC_OFF);
    if (F.tid < 32) MISC[F.tid] = 0u;
    __syncthreads();
    unsigned* ctl = (unsigned*)(F.ws + WS_CTL);
    XcdBarrier bar; bar.bar = ctl + CW_BAR; bar.x = 0; bar.st = nullptr;
    if (MK_N_LAUNCHES == 1) bar = xcd_barrier_post(ctl + CW_BAR, MISC + 8);
    const int lo = args.ph_lo, hi = args.ph_hi;
#define IN(k) (lo <= (k) && (k) < hi)
#define REPS(k) (((k) == REP_PHASE || (k) == REP_PHASE + 9) ? 2 : 1)
#define SEAM(k) do { if (IN(k) && IN((k) + 1)) xcd_barrier(bar); } while (0)
    float* ssb = F.out;
    LAS unsigned char* ring = F.lds + RING_OFF;

    #ifndef SK_PRO
    for (int rep = 0; rep < ((REP_PHASE == 0) ? 2 : 1); ++rep) if (IN(0)) { if (rep) xcd_barrier(bar); phase_prologue(F); }
#endif
    SEAM(0);

    for (int L = 0; L < NL; ++L) {
        asm volatile("" : "+v"(F.tid)); F.lane = F.tid & 63;
        const int pb = 1 + L * PH_PER_LAYER;
        unsigned char* wl = F.ws + WS_W + (size_t)L * WL_STRIDE;
        bf16* hb_cur = (bf16*)(F.ws + ((L & 1) ? WS_HBB : WS_HBA)); bf16* hb_oth = (bf16*)(F.ws + ((L & 1) ? WS_HBA : WS_HBB));
        const float* ss_mix = ssb + (size_t)(3 * L) * T * 16; float* ss_ffn = ssb + (size_t)(3 * L + 1) * T * 16; float* ss_ple = ssb + (size_t)(3 * L + 2) * T * 16; float* ss_next = ssb + (size_t)(3 * L + 3) * T * 16;
#ifndef SK_G1
        for (int rep = 0; rep < REPS(pb + 0); ++rep) if (IN(pb + 0)) { PlainSched Sd{(const char*)hb_cur, (const char*)(wl + WL_IN), D * 2, D * 2, D / 64, T / 256, UW / 256, F.G, F.bx};
            EpiScaleBf16 E{(bf16*)(F.ws + WS_U), UW, ss_mix}; pg8::gemm_phase(ring, Sd, E); }
#endif
        SEAM(pb + 0);
        bf16* hgS = hb_oth; bf16* rtS = hb_oth + (size_t)32 * NCH * 4096;
        for (int rep = 0; rep < REPS(pb + 1); ++rep) if (IN(pb + 1)) { if (rep) xcd_barrier(bar); phase_m1(F, L, hgS, rtS); }
        SEAM(pb + 1);
#ifndef EXP_NOSCAN
        if (IN(pb + 2)) phase_scan(F, L, hgS, rtS);
#endif
        SEAM(pb + 2);
        if (IN(pb + 3)) phase_m3(F, L, hgS, rtS);
        SEAM(pb + 3);
#ifndef SK_G2
        for (int rep = 0; rep < REPS(pb + 4); ++rep) if (IN(pb + 4)) { PairSched Sd{(const char*)hb_cur, (const char*)(wl + WL_G), D * 2, D * 2, D / 64, (size_t)D * D * 2,
                                        (const char*)(F.ws + WS_BO), (const char*)(wl + WL_B), 1024 * 2, MW * 2, MW / 64, (size_t)MW * 2, (size_t)D * MW * 2, 4, T / 256, D / 256, F.G, F.bx};
            u32x4* scr = (u32x4*)(F.ws + WS_SCR + (size_t)F.bx * 262144);
            EpiMerge E{scr, scr + 8192, (bf16*)(F.ws + WS_MERGED), ss_mix, F.in[I_BGATE] + (size_t)L * 4 * D, 4}; pg8::gemm_phase(ring, Sd, E); }
#endif
        SEAM(pb + 4);
#ifndef SK_G3
        if (IN(pb + 5)) phase_pconv(F, L);
        if (IN(pb + 5)) { PlainSched Sd{(const char*)(F.ws + WS_MERGED), (const char*)(wl + WL_OUT), D * 2, D * 2, D / 64, T / 256, D / 256, F.G, F.bx};
            EpiResidual E{(L == 0) ? F.in[I_X] : nullptr, hb_cur, ss_ffn}; pg8::gemm_phase(ring, Sd, E); }
#endif
        SEAM(pb + 5);
#ifndef SK_G4
        for (int rep = 0; rep < REPS(pb + 6); ++rep) if (IN(pb + 6)) { PlainSched Sd{(const char*)hb_cur, (const char*)(wl + WL_FF), D * 2, D * 2, D / 64, T / 256, (2 * DFF) / 256, F.G, F.bx};
            EpiSwiGLU E{(bf16*)(F.ws + WS_FFH), ss_ffn}; pg8::gemm_phase(ring, Sd, E); }
#endif
        SEAM(pb + 6);
#ifndef SK_G5
        if (IN(pb + 7)) { PlainSched Sd{(const char*)(F.ws + WS_FFH), (const char*)(wl + WL_DN), DFF * 2, DFF * 2, DFF / 64, T / 256, D / 256, F.G, F.bx};
            EpiResidual E{nullptr, hb_cur, ss_ple}; pg8::gemm_phase(ring, Sd, E); }
#endif
        SEAM(pb + 7);
#ifndef SK_G6
        if (IN(pb + 8)) { PairSched Sd{(const char*)hb_cur, (const char*)(wl + WL_PG), D * 2, D * 2, D / 64, 0,
                                        (const char*)(F.ws + WS_PB), (const char*)(wl + WL_PP), PLE * 2, PLE * 2, PLE / 64, 0, 0, 1, T / 256, D / 256, F.G, F.bx};
            u32x4* scr = (u32x4*)(F.ws + WS_SCR + (size_t)F.bx * 262144);
            EpiPle E{scr, hb_cur, hb_oth, ss_ple, ss_next}; pg8::gemm_phase(ring, Sd, E); }
#endif
        SEAM(pb + 8);
    }
#ifndef SK_FIN
    if (IN(N_PHASES - 2)) phase_final_a(F, ssb + (size_t)(3 * NL) * T * 16, (float*)(F.ws + WS_CTL) + 65536);
    SEAM(N_PHASES - 2);
    if (IN(N_PHASES - 1)) phase_final_b(F, (const float*)(F.ws + WS_CTL) + 65536, (const bf16*)(F.ws + ((NL & 1) ? WS_HBB : WS_HBA)));
#endif
#undef IN
#undef SEAM
}

extern "C" void kernel_launch(void* const* d_in, const int* in_sizes, int n_in, void* d_out, int out_size, void* d_ws, size_t ws_size, hipStream_t stream) {
    static int grid = 0;
    if (grid == 0) {
        if (n_in != 37 || in_sizes[0] != T * D || out_size != T * D || ws_size < WS_END) { fprintf(stderr, "kernel_launch: unexpected shapes (n_in %d, ws %zu)\n", n_in, ws_size); grid = -1; return; }
        int dev = 0, cus = 0, per_cu = 0;
        if (hipGetDevice(&dev) != hipSuccess || hipDeviceGetAttribute(&cus, hipDeviceAttributeMultiprocessorCount, dev) != hipSuccess) { grid = -1; return; }
        if (hipFuncSetAttribute((const void*)mega_fwd, hipFuncAttributeMaxDynamicSharedMemorySize, LDS_BYTES) != hipSuccess) { fprintf(stderr, "kernel_launch: hipFuncSetAttribute failed\n"); grid = -1; return; }
        if (hipOccupancyMaxActiveBlocksPerMultiprocessor(&per_cu, (const void*)mega_fwd, NTHR, LDS_BYTES) != hipSuccess || per_cu < 1) { fprintf(stderr, "kernel_launch: occupancy query says %d\n", per_cu); }
        (void)hipGetLastError();
        grid = cus;
    }
    if (grid < 0) return;
    hipMemsetAsync((char*)d_ws + WS_CTL, 0, CTL_BYTES, stream);
    Args a{};
    for (int i = 0; i < 37; ++i) a.in[i] = (const float*)d_in[i];
    a.out = (float*)d_out; a.ws = (unsigned char*)d_ws;
    if (MK_N_LAUNCHES == 1) { a.ph_lo = 0; a.ph_hi = N_PHASES; hipLaunchKernelGGL(mega_fwd, dim3(grid), dim3(NTHR), LDS_BYTES, stream, a); }
    else for (int p = 0; p < N_PHASES; ++p) { a.ph_lo = p; a.ph_hi = p + 1; hipLaunchKernelGGL(mega_fwd, dim3(grid), dim3(NTHR), LDS_BYTES, stream, a); }
}
```

```cpp
#include <hip/hip_runtime.h>
#include <cstdio>
#include <cstdint>

#ifndef REP_ITEMS
#define REP_ITEMS 1
#endif
#ifndef REP_NSA
#define REP_NSA 1
#endif
#ifndef REP_PHASE
#define REP_PHASE (-1)
#endif
#ifndef MK_N_LAUNCHES
#define MK_N_LAUNCHES 1
#endif

#define LAS __attribute__((address_space(3)))
#define GAS __attribute__((address_space(1)))
typedef unsigned short bf16;
typedef short bf16x8 __attribute__((ext_vector_type(8)));
typedef float f32x4 __attribute__((ext_vector_type(4)));
typedef float f32x16 __attribute__((ext_vector_type(16)));
typedef unsigned u32x4 __attribute__((ext_vector_type(4)));
typedef unsigned u32x2 __attribute__((ext_vector_type(2)));
typedef short s16x4 __attribute__((ext_vector_type(4)));

constexpr int D = 1024, NB = 8, S = 8192, T = NB * S, NL = 2;
constexpr int NH = 4, HD = 64, MW = 256, DFF = 2816, PLE = 256;
constexpr int DIN = 3724, UW = 3840;
constexpr int U_NSA = 0, U_HG = 768, U_RT = 1792, U_RW = 2816;
constexpr int NCMP = 511, NSEL = 128;
constexpr float EPS = 1e-6f;

constexpr size_t MiB = 1u << 20;
constexpr size_t WS_CTL = 0, CTL_BYTES = 4 * MiB;
constexpr size_t WS_W = 4 * MiB;
constexpr size_t WL_IN = 0, WL_G = 8 * MiB, WL_B = 16 * MiB, WL_OUT = 18 * MiB, WL_FF = 20 * MiB, WL_DN = 31 * MiB, WL_PG = 37 * MiB, WL_PP = 39 * MiB, WL_STRIDE = 40 * MiB;
constexpr size_t WS_MISC = 84 * MiB;
constexpr size_t WS_ROPE = WS_MISC, WS_KCMP = WS_MISC + 2 * MiB, WS_VCMP = WS_MISC + 2 * MiB + 512 * 1024, WS_RWUP = WS_MISC + 3 * MiB;
constexpr size_t WS_HBA = 88 * MiB, WS_HBB = 216 * MiB;
constexpr size_t WS_BO = 344 * MiB;
constexpr size_t WS_U = 472 * MiB;
constexpr size_t WS_MERGED = WS_U, WS_SCR = WS_U + 416 * MiB;
constexpr size_t WS_FFH = WS_U;
constexpr size_t WS_PB = WS_U + 352 * MiB;
constexpr size_t WS_RWN = 952 * MiB;
constexpr size_t WS_HGD = 1016 * MiB;
constexpr size_t WS_RWM = WS_BO;
constexpr size_t WS_CMPH = 1018 * MiB;
constexpr size_t WS_CW1 = 1020 * MiB;
constexpr size_t WS_CW2 = 1022 * MiB;
constexpr size_t WS_SSF = 1016 * MiB;
constexpr size_t WS_END = 1024 * MiB;
constexpr int CH = 32, NCH = S / CH;
constexpr int CW_BAR = 4096;
constexpr int CW_C1 = 16384;
constexpr int NSS = 7;

#define LDS_WAIT() asm volatile("s_waitcnt lgkmcnt(0)" ::: "memory")
#define VM_WAIT() asm volatile("s_waitcnt vmcnt(0)" ::: "memory")
typedef __bf16 hbf16x2 __attribute__((ext_vector_type(2)));
typedef float f32x2v __attribute__((ext_vector_type(2)));
__device__ __forceinline__ unsigned cvt_pk_bf16(float lo, float hi) { const f32x2v v = {lo, hi}; const hbf16x2 b = __builtin_convertvector(v, hbf16x2); return __builtin_bit_cast(unsigned, b); }
__device__ __forceinline__ float bf2f(unsigned short b) { return __builtin_bit_cast(float, ((unsigned)b) << 16); }
__device__ __forceinline__ float bflo(unsigned w) { return __builtin_bit_cast(float, w << 16); }
__device__ __forceinline__ float bfhi(unsigned w) { return __builtin_bit_cast(float, w & 0xffff0000u); }
__device__ __forceinline__ float fsigmoid(float z) { return __builtin_amdgcn_rcpf(1.0f + __builtin_amdgcn_exp2f(-1.44269504f * z)); }
__device__ __forceinline__ float fsilu(float z) { return z * fsigmoid(z); }
__device__ __forceinline__ float wave_sum(float v) {
#pragma unroll
    for (int o = 1; o < 64; o <<= 1) v += __shfl_xor(v, o);
    return v;
}
__device__ __forceinline__ float wave_max(float v) {
#pragma unroll
    for (int o = 1; o < 64; o <<= 1) v = fmaxf(v, __shfl_xor(v, o));
    return v;
}

#define XB_TMO      128
#define XB_XCNT(j)  (256  + 64 * (j))
#define XB_XSUB(j)  (1280 + 64 * (j))
#define XB_XGEN(j)  (2304 + 64 * (j))
#define XB_TOP      3328
#define XB_TOPGEN   3392
#define XCD_BAR_WORDS 3456
#define XB_SPIN_CAP (1u << 24)
__device__ __forceinline__ unsigned xb_ld(unsigned* p)              { return __hip_atomic_load(p, __ATOMIC_RELAXED, __HIP_MEMORY_SCOPE_AGENT); }
__device__ __forceinline__ unsigned xb_add(unsigned* p, unsigned v) { return __hip_atomic_fetch_add(p, v, __ATOMIC_RELAXED, __HIP_MEMORY_SCOPE_AGENT); }
__device__ __forceinline__ unsigned xb_xcc_id() { return (unsigned)__builtin_amdgcn_s_getreg((3 << 11) | 20) & 0xFu; }
#define XB_SPIN(cond, bar) do { unsigned _sp = 0; while (cond) { __builtin_amdgcn_s_sleep(1); \
    if ((++_sp & 255u) == 0u) { if (xb_ld(&(bar)[XB_TMO])) break; if (_sp > XB_SPIN_CAP) { atomicAdd(&(bar)[XB_TMO], 1u); break; } } } } while (0)
struct XcdBarrier { unsigned* bar; unsigned x; volatile LAS unsigned* st; };
__device__ __forceinline__ XcdBarrier xcd_barrier_post(unsigned* bar, volatile LAS unsigned* st) {
    XcdBarrier b; b.bar = bar; b.x = xb_xcc_id(); b.st = st;
    if (threadIdx.x == 0) (void)xb_add(&bar[XB_XCNT(b.x)], 1u);
    return b;
}
__device__ __forceinline__ void xcd_barrier_complete(unsigned* bar, unsigned x, unsigned& nloc, unsigned& nx) {
    const unsigned G = gridDim.x * gridDim.y * gridDim.z;
    unsigned sum, cnt, mine, sp = 0u;
    for (;;) {
        sum = 0u; cnt = 0u; mine = 0u;
#pragma unroll
        for (unsigned j = 0; j < 16; ++j) { const unsigned c = xb_ld(&bar[XB_XCNT(j)]); sum += c; cnt += (c > 0u) ? 1u : 0u; mine = (j == x) ? c : mine; }
        if (sum == G) break;
        __builtin_amdgcn_s_sleep(1);
        if ((++sp & 255u) == 0u) { if (xb_ld(&bar[XB_TMO])) break; if (sp > XB_SPIN_CAP) { atomicAdd(&bar[XB_TMO], 1u); break; } }
    }
    nloc = mine > 0u ? mine : 1u; nx = cnt > 0u ? cnt : 1u;
}
__device__ __forceinline__ void xcd_barrier(const XcdBarrier& b) {
    asm volatile("s_waitcnt vmcnt(0)" ::: "memory");
    __syncthreads();
    if (threadIdx.x == 0) {
        unsigned* bar = b.bar;
        __builtin_amdgcn_s_waitcnt(0);
        unsigned nloc = b.st[0], nx = b.st[1];
        if (nloc == 0u) { xcd_barrier_complete(bar, b.x, nloc, nx); b.st[0] = nloc; b.st[1] = nx; }
        const unsigned old = xb_add(&bar[XB_XSUB(b.x)], 1u);
        const unsigned gen = old / nloc;
        if (old + 1u == (gen + 1u) * nloc) {
            __builtin_amdgcn_fence(__ATOMIC_RELEASE, "agent");
            asm volatile("s_waitcnt vmcnt(0)" ::: "memory");
            const unsigned og = xb_add(&bar[XB_TOP], 1u);
            const unsigned tg = og / nx;
            if (og + 1u == (tg + 1u) * nx) xb_add(&bar[XB_TOPGEN], 1u);
            else XB_SPIN(xb_ld(&bar[XB_TOPGEN]) == tg, bar);
            __builtin_amdgcn_fence(__ATOMIC_ACQUIRE, "agent");
            xb_add(&bar[XB_XGEN(b.x)], 1u);
            asm volatile("s_waitcnt vmcnt(0)" ::: "memory");
        } else {
            XB_SPIN(xb_ld(&bar[XB_XGEN(b.x)]) == gen, bar);
            __builtin_amdgcn_fence(__ATOMIC_ACQUIRE, "agent");
            asm volatile("s_waitcnt vmcnt(0)" ::: "memory");
        }
    }
    __syncthreads();
}

namespace pg8 {
constexpr int BM = 256, BK = 64, HALF = 128, HTB = HALF * BK * 2, STAGE_BYTES = 8 * HTB, NXCD = 8, WGM = 8;
__host__ __device__ __forceinline__ int lds_byte(int r, int c) { const int st = (r >> 4) * 2 + (c >> 5), rr = r & 15, cc = c & 31, ob = rr * 64 + cc * 2; return st * 1024 + (ob ^ (((ob >> 9) & 1) << 5)); }
__host__ __device__ __forceinline__ void stage_rc(int b, int& R, int& C) { const int st = b / 1024, sb = b % 1024, swz = sb ^ (((sb >> 9) & 1) << 5); R = (st >> 1) * 16 + swz / 64; C = (st & 1) * 32 + (swz % 64) / 2; }
__host__ __device__ __forceinline__ int perm32(int rho) { const int n = rho >> 4, i = rho & 15; return 8 * (i >> 2) + 4 * n + (i & 3); }

struct GU { const char* A; const char* B; unsigned lda, ldb; int nt; int pm, pn, kind, mi; };

__device__ __forceinline__ bool tile_of(int L, int nM, int nN, int& pm, int& pn) {
    const int nwg = nM * nN; if (L >= nwg) return false;
    int wgid = L; { const int q = nwg / NXCD, r = nwg % NXCD, xcd = wgid % NXCD, off = wgid / NXCD; wgid = (xcd < r ? xcd * (q + 1) : r * (q + 1) + (xcd - r) * q) + off; }
    const int nig = WGM * nN, gid = wgid / nig, fm = gid * WGM, gsz = (nM - fm) < WGM ? (nM - fm) : WGM;
    pm = fm + ((wgid % nig) % gsz); pn = (wgid % nig) / gsz; return true;
}

template <class Epi, class Sched, bool AX = false>
__device__ __forceinline__ void gemm_phase(LAS unsigned char* lds, const Sched& S, const Epi& E, unsigned ax_kstep = 0, unsigned ax_half = 0) {
    int tid = threadIdx.x; asm volatile("" : "+v"(tid));
    const int wid = __builtin_amdgcn_readfirstlane(tid >> 6), lane = tid & 63, wr = wid >> 2, wc = wid & 3, fr = lane & 15, fq = lane >> 4;
    unsigned RA[2], RB[2], C2[2];
#pragma unroll
    for (int i = 0; i < 2; ++i) { int R, C; stage_rc(tid * 16 + i * 8192, R, C); RA[i] = (unsigned)R; RB[i] = (unsigned)((R & ~31) + perm32(R & 31)); C2[i] = (unsigned)C * 2u; }
    const size_t kstep = (size_t)(BK * 2);
    const size_t kstepA = AX ? (size_t)ax_kstep : kstep;
#define PG8_HSA(ld) (AX ? (size_t)ax_half : (size_t)HALF * (ld))
    const unsigned ldsw = (unsigned)wid * 1024u;
    const int aoff = lds_byte(wr * 64 + fr, fq * 8), boff = lds_byte(wc * 32 + fr, fq * 8);
#define PG8_SA(b, h) (((b) * 2 + (h)) * HTB)
#define PG8_SB(b, h) ((4 + (b) * 2 + (h)) * HTB)
#define PG8_STAGE(bufoff, gbase, ld, RR) do { _Pragma("unroll") for (int _i = 0; _i < 2; ++_i) \
        __builtin_amdgcn_global_load_lds((const unsigned*)((const char*)(gbase) + (RR[_i] * (ld) + C2[_i])), (LAS unsigned*)(lds + (bufoff) + ldsw + _i * 8192), 16, 0, 0); } while (0)
#define PG8_LDA(dst, b, h) do { _Pragma("unroll") for (int m = 0; m < 4; ++m) _Pragma("unroll") for (int k = 0; k < 2; ++k) dst[m][k] = *(const LAS bf16x8*)(lds + PG8_SA(b, h) + aoff + m * 2048 + k * 1024); } while (0)
#define PG8_LDB(dst, b, h) do { _Pragma("unroll") for (int n = 0; n < 2; ++n) _Pragma("unroll") for (int k = 0; k < 2; ++k) dst[n][k] = *(const LAS bf16x8*)(lds + PG8_SB(b, h) + boff + n * 2048 + k * 1024); } while (0)
#define PG8_MMA(ai, bj, At, Bt) do { __builtin_amdgcn_s_setprio(1); _Pragma("unroll") for (int m = 0; m < 4; ++m) _Pragma("unroll") for (int n = 0; n < 2; ++n) _Pragma("unroll") for (int k = 0; k < 2; ++k) \
        acc[ai][bj][m][n] = __builtin_amdgcn_mfma_f32_16x16x32_bf16(Bt[n][k], At[m][k], acc[ai][bj][m][n], 0, 0, 0); __builtin_amdgcn_s_setprio(0); } while (0)
#define PG8_WAIT_V(n) asm volatile("s_waitcnt vmcnt(" #n ")" ::: "memory")
#define PG8_WAIT_L(n) asm volatile("s_waitcnt lgkmcnt(" #n ")" ::: "memory")
#define PG8_BAR __builtin_amdgcn_s_barrier()
#define PG8_SCHED __builtin_amdgcn_sched_barrier(0)
    GU cur, nxt; int ui = 0;
    if (!S.next(0, cur)) return;
    f32x4 acc[2][2][4][2];
#pragma unroll
    for (int a = 0; a < 2; ++a)
#pragma unroll
        for (int b = 0; b < 2; ++b)
#pragma unroll
            for (int m = 0; m < 4; ++m)
#pragma unroll
                for (int n = 0; n < 2; ++n) acc[a][b][m][n] = (f32x4){0.f, 0.f, 0.f, 0.f};
    bf16x8 At[4][2], B0[2][2], B1[2][2];
    const char* cA = cur.A; const char* cB = cur.B; unsigned clda = cur.lda, cldb = cur.ldb;
    PG8_STAGE(PG8_SB(0, 0), cB, cldb, RB); PG8_STAGE(PG8_SB(0, 1), cB + (size_t)HALF * cldb, cldb, RB); PG8_STAGE(PG8_SA(0, 0), cA, clda, RA); PG8_STAGE(PG8_SA(0, 1), cA + PG8_HSA(clda), clda, RA);
    if (wr == 1) PG8_BAR;
    PG8_WAIT_V(2); PG8_BAR;
    PG8_STAGE(PG8_SB(1, 0), cB + kstep, cldb, RB); PG8_STAGE(PG8_SA(1, 0), cA + kstepA, clda, RA); PG8_STAGE(PG8_SB(1, 1), cB + (size_t)HALF * cldb + kstep, cldb, RB);
    PG8_WAIT_V(6); PG8_BAR;
    for (;;) {
        const bool has_next = S.next(ui + 1, nxt);
        const char* nA = has_next ? nxt.A : cA; const char* nB = has_next ? nxt.B : cB;
        const unsigned nlda = has_next ? nxt.lda : clda, nldb = has_next ? nxt.ldb : cldb;
        const int nt = cur.nt;
        for (int t = 0; t < nt; t += 2) {
            const bool last = (t == nt - 2);
            const char* a1 = cA + (size_t)(t + 1) * kstepA;
            const char* a2 = last ? nA : cA + (size_t)(t + 2) * kstepA; const char* b2 = last ? nB : cB + (size_t)(t + 2) * kstep;
            const unsigned lda2 = last ? nlda : clda, ldb2 = last ? nldb : cldb;
            const char* a3 = a2 + kstepA; const char* b3 = b2 + kstep;
            PG8_LDB(B0, 0, 0); PG8_LDB(B1, 0, 1); PG8_SCHED; PG8_LDA(At, 0, 0); PG8_STAGE(PG8_SA(1, 1), a1 + PG8_HSA(clda), clda, RA);
            PG8_WAIT_V(8); PG8_WAIT_L(0); PG8_BAR; PG8_MMA(0, 0, At, B0); PG8_MMA(0, 1, At, B1); PG8_BAR; PG8_SCHED;
            PG8_LDA(At, 0, 1); PG8_STAGE(PG8_SB(0, 0), b2, ldb2, RB); PG8_STAGE(PG8_SB(0, 1), b2 + (size_t)HALF * ldb2, ldb2, RB); PG8_STAGE(PG8_SA(0, 0), a2, lda2, RA);
            PG8_WAIT_V(8); PG8_WAIT_L(0); PG8_BAR; PG8_MMA(1, 0, At, B0); PG8_MMA(1, 1, At, B1); PG8_BAR; PG8_SCHED;
            PG8_LDB(B0, 1, 0); PG8_LDB(B1, 1, 1); PG8_SCHED; PG8_LDA(At, 1, 0); PG8_STAGE(PG8_SA(0, 1), a2 + PG8_HSA(lda2), lda2, RA);
            PG8_WAIT_V(8); PG8_WAIT_L(0); PG8_BAR; PG8_MMA(0, 0, At, B0); PG8_MMA(0, 1, At, B1); PG8_BAR; PG8_SCHED;
            PG8_LDA(At, 1, 1); PG8_STAGE(PG8_SB(1, 0), b3, ldb2, RB); PG8_STAGE(PG8_SB(1, 1), b3 + (size_t)HALF * ldb2, ldb2, RB); PG8_STAGE(PG8_SA(1, 0), a3, lda2, RA);
            PG8_WAIT_V(8); PG8_WAIT_L(0); PG8_BAR; PG8_MMA(1, 0, At, B0); PG8_MMA(1, 1, At, B1); PG8_BAR; PG8_SCHED;
        }
        if (wr == 0) PG8_BAR;
        E(acc, cur, wr, wc, fr, fq);
        if (!has_next) break;
#pragma unroll
        for (int a = 0; a < 2; ++a)
#pragma unroll
            for (int b = 0; b < 2; ++b)
#pragma unroll
                for (int m = 0; m < 4; ++m)
#pragma unroll
                    for (int n = 0; n < 2; ++n) acc[a][b][m][n] = (f32x4){0.f, 0.f, 0.f, 0.f};
        cur = nxt; cA = nA; cB = nB; clda = nlda; cldb = nldb; ++ui;
        if (wr == 1) PG8_BAR;
    }
    PG8_WAIT_V(0);
    PG8_BAR;
#undef PG8_SA
#undef PG8_HSA
#undef PG8_SB
#undef PG8_STAGE
#undef PG8_LDA
#undef PG8_LDB
#undef PG8_MMA
#undef PG8_WAIT_V
#undef PG8_WAIT_L
#undef PG8_BAR
#undef PG8_SCHED
}
}
using pg8::GU;

struct PlainSched {
    const char* A; const char* B; unsigned lda, ldb; int nt, nM, nN, G, c;
    __device__ __forceinline__ bool next(int i, GU& u) const {
        int pm, pn; if (!pg8::tile_of(i * G + c, nM, nN, pm, pn)) return false;
        u.A = A + (size_t)pm * 256 * lda; u.B = B + (size_t)pn * 256 * ldb; u.lda = lda; u.ldb = ldb; u.nt = nt; u.pm = pm; u.pn = pn; u.kind = 0; u.mi = 0; return true;
    }
};
struct PairSched {
    const char* A1; const char* B1; unsigned lda1, ldb1; int nt1; size_t b1_mstride;
    const char* A2; const char* B2; unsigned lda2, ldb2; int nt2; size_t a2_mstride, b2_mstride;
    int nm, nM, nN, G, c;
    __device__ __forceinline__ bool next(int i, GU& u) const {
        const int per = 2 * nm, ti = i / per, sub = i - ti * per, m = sub >> 1, kind = sub & 1;
        int pm, pn; if (!pg8::tile_of(ti * G + c, nM, nN, pm, pn)) return false;
        u.pm = pm; u.pn = pn; u.kind = kind; u.mi = m;
        if (kind == 0) { u.A = A2 + (size_t)m * a2_mstride + (size_t)pm * 256 * lda2; u.B = B2 + (size_t)m * b2_mstride + (size_t)pn * 256 * ldb2; u.lda = lda2; u.ldb = ldb2; u.nt = nt2; }
        else { u.A = A1 + (size_t)pm * 256 * lda1; u.B = B1 + (size_t)m * b1_mstride + (size_t)pn * 256 * ldb1; u.lda = lda1; u.ldb = ldb1; u.nt = nt1; }
        return true;
    }
};

constexpr int RSTD_OFF = 131072;
__device__ __forceinline__ float ss_row(const float* ssp, int row) {
    const f32x4* p = (const f32x4*)(ssp + (size_t)row * 16); const f32x4 a = p[0], b = p[1], c = p[2], d = p[3];
    return (((a[0] + a[1]) + (a[2] + a[3])) + ((b[0] + b[1]) + (b[2] + b[3]))) + (((c[0] + c[1]) + (c[2] + c[3])) + ((d[0] + d[1]) + (d[2] + d[3])));
}
__device__ __forceinline__ void rstd_table(const float* ssp, int pm) {
    extern __shared__ __attribute__((aligned(16))) unsigned char lds_tab_raw[];
    LAS float* tab = (LAS float*)((LAS unsigned char*)lds_tab_raw + RSTD_OFF);
    const int t = threadIdx.x; if (t < 256) tab[t] = __builtin_amdgcn_rsqf(ss_row(ssp, pm * 256 + t) * (1.0f / D) + EPS);
    asm volatile("s_waitcnt lgkmcnt(0)" ::: "memory"); __builtin_amdgcn_s_barrier(); asm volatile("" ::: "memory");
}
__device__ __forceinline__ float rstd_tab(int lr) { extern __shared__ __attribute__((aligned(16))) unsigned char lds_tab_raw[]; return ((const LAS float*)((LAS unsigned char*)lds_tab_raw + RSTD_OFF))[lr]; }
__device__ __forceinline__ u32x4 pack8(const f32x4& a, const f32x4& b) { u32x4 w; w.x = cvt_pk_bf16(a[0], a[1]); w.y = cvt_pk_bf16(a[2], a[3]); w.z = cvt_pk_bf16(b[0], b[1]); w.w = cvt_pk_bf16(b[2], b[3]); return w; }
__device__ __forceinline__ void unpack8(const u32x4& w, f32x4& a, f32x4& b) { a = (f32x4){bflo(w.x), bfhi(w.x), bflo(w.y), bfhi(w.y)}; b = (f32x4){bflo(w.z), bfhi(w.z), bflo(w.w), bfhi(w.w)}; }

struct CmpSched {
    const char* U; const char* B; int c;
    __device__ __forceinline__ bool next(int i, GU& u) const {
        if (i > 0 || c >= 32) return false;
        const int b = c >> 2, q = c & 3;
        u.A = U + ((size_t)(b * S + 2048 * q) * UW + U_NSA + 256) * 2; u.B = B; u.lda = 16 * UW * 2; u.ldb = 4096; u.nt = 32; u.pm = b; u.pn = q; u.kind = 0; u.mi = 0; return true;
    }
};
struct EpiCmp {
    bf16* H;
    __device__ __forceinline__ void operator()(const f32x4 (&acc)[2][2][4][2], const GU& u, int wr, int wc, int fr, int fq) const {
        const int col = wc * 32 + 8 * fq;
        extern __shared__ __attribute__((aligned(16))) unsigned char lds_c1_raw[]; const LAS float* c1 = (const LAS float*)((LAS unsigned char*)lds_c1_raw + RSTD_OFF + 1024);
#pragma unroll
        for (int kv = 0; kv < 2; ++kv) { const f32x4 b0 = *(const LAS f32x4*)(c1 + kv * 128 + col), b1 = *(const LAS f32x4*)(c1 + kv * 128 + col + 4);
#pragma unroll
            for (int m = 0; m < 4; ++m) { const int i = u.pn * 128 + wr * 64 + m * 16 + fr; f32x4 v0, v1;
#pragma unroll
                for (int j = 0; j < 4; ++j) { v0[j] = fsilu(acc[kv][kv][m][0][j] + b0[j]); v1[j] = fsilu(acc[kv][kv][m][1][j] + b1[j]); }
                *(u32x4*)(H + ((size_t)(u.pm * 512 + i)) * 256 + kv * 128 + col) = pack8(v0, v1); } }
    }
};
struct EpiScaleBf16 {
    bf16* O; int ldo; const float* ss;
    __device__ __forceinline__ void operator()(const f32x4 (&acc)[2][2][4][2], const GU& u, int wr, int wc, int fr, int fq) const {
        rstd_table(ss, u.pm);
        const int row0 = u.pm * 256 + wr * 64 + fr, col0 = u.pn * 256 + wc * 32 + 8 * fq;
#pragma unroll
        for (int ai = 0; ai < 2; ++ai)
#pragma unroll
            for (int m = 0; m < 4; ++m) { const int r = row0 + ai * 128 + m * 16; const float rs = rstd_tab(wr * 64 + fr + ai * 128 + m * 16); bf16* rowp = O + (size_t)r * ldo + col0;
#pragma unroll
                for (int bj = 0; bj < 2; ++bj) *(u32x4*)(rowp + bj * 128) = pack8(acc[ai][bj][m][0] * rs, acc[ai][bj][m][1] * rs); }
    }
};
struct EpiSwiGLU {
    bf16* O; const float* ss;
    __device__ __forceinline__ void operator()(const f32x4 (&acc)[2][2][4][2], const GU& u, int wr, int wc, int fr, int fq) const {
        rstd_table(ss, u.pm);
        const int row0 = u.pm * 256 + wr * 64 + fr, col0 = u.pn * 128 + wc * 32 + 8 * fq;
#pragma unroll
        for (int ai = 0; ai < 2; ++ai)
#pragma unroll
            for (int m = 0; m < 4; ++m) { const int r = row0 + ai * 128 + m * 16; const float rs = rstd_tab(wr * 64 + fr + ai * 128 + m * 16);
                f32x4 v[2];
#pragma unroll
                for (int n = 0; n < 2; ++n)
#pragma unroll
                    for (int j = 0; j < 4; ++j) { const float g = acc[ai][0][m][n][j] * rs, up = acc[ai][1][m][n][j] * rs; v[n][j] = fsilu(g) * up; }
                *(u32x4*)(O + (size_t)r * DFF + col0) = pack8(v[0], v[1]); }
    }
};
struct EpiResidual {
    const float* Hin32; bf16* HB; float* ss_out;
    __device__ __forceinline__ void operator()(const f32x4 (&acc)[2][2][4][2], const GU& u, int wr, int wc, int fr, int fq) const {
        const int row0 = u.pm * 256 + wr * 64 + fr, col0 = u.pn * 256 + wc * 32 + 8 * fq;
#pragma unroll
        for (int hf = 0; hf < 2; ++hf) { const int ai = hf;
            u32x4 hv[8];
            if (!Hin32) {
#pragma unroll
                for (int q = 0; q < 8; ++q) { const int m = q >> 1, bj = q & 1; hv[q] = *(const u32x4*)(HB + (size_t)(row0 + ai * 128 + m * 16) * D + col0 + bj * 128); } }
#pragma unroll
            for (int m = 0; m < 4; ++m) { const int r = row0 + ai * 128 + m * 16; float s2 = 0.f;
#pragma unroll
                for (int bj = 0; bj < 2; ++bj) { const size_t o = (size_t)r * D + col0 + bj * 128;
                    f32x4 h0, h1;
                    if (Hin32) { h0 = *(const f32x4*)(Hin32 + o); h1 = *(const f32x4*)(Hin32 + o + 4); } else unpack8(hv[m * 2 + bj], h0, h1);
                    h0 += acc[ai][bj][m][0]; h1 += acc[ai][bj][m][1];
                    *(u32x4*)(HB + o) = pack8(h0, h1);
                    s2 += (h0[0] * h0[0] + h0[1] * h0[1]) + (h0[2] * h0[2] + h0[3] * h0[3]) + (h1[0] * h1[0] + h1[1] * h1[1]) + (h1[2] * h1[2] + h1[3] * h1[3]); }
                s2 += __shfl_xor(s2, 16); s2 += __shfl_xor(s2, 32);
                if (fq == 0) ss_out[(size_t)r * 16 + u.pn * 4 + wc] = s2; }
            asm volatile("" ::: "memory"); }
    }
};
#define SLOT(ai, m, bj) (((((ai) * 4 + (m)) >> 1) * 512 + tid) * 4 + (((m) & 1) * 2 + (bj)))
struct EpiMerge {
    u32x4* scrP; u32x4* scrM; bf16* M; const float* ss; const float* bias;
    int nm;
    __device__ __forceinline__ void operator()(const f32x4 (&acc)[2][2][4][2], const GU& u, int wr, int wc, int fr, int fq) const {
        int tid = threadIdx.x; asm volatile("" : "+v"(tid));
        if (u.kind == 0) {
#pragma unroll
            for (int ai = 0; ai < 2; ++ai)
#pragma unroll
                for (int m = 0; m < 4; ++m)
#pragma unroll
                    for (int bj = 0; bj < 2; ++bj) scrP[SLOT(ai, m, bj)] = pack8(acc[ai][bj][m][0], acc[ai][bj][m][1]);
            return;
        }
        const int row0 = u.pm * 256 + wr * 64 + fr, col0 = u.pn * 256 + wc * 32 + 8 * fq;
        rstd_table(ss, u.pm);
        const float* bp = bias + (size_t)u.mi * D + col0;
#pragma unroll
        for (int hf = 0; hf < 2; ++hf) { const int ai = hf;
            u32x4 pv[8];
#pragma unroll
            for (int q = 0; q < 8; ++q) pv[q] = scrP[SLOT(ai, q >> 1, q & 1)];
#pragma unroll
            for (int q = 0; q < 8; ++q) { const int m = q >> 1, bj = q & 1; const float rs = rstd_tab(wr * 64 + fr + ai * 128 + m * 16);
                const f32x4 b0 = *(const f32x4*)(bp + bj * 128), b1 = *(const f32x4*)(bp + bj * 128 + 4); f32x4 p0, p1; unpack8(pv[q], p0, p1);
#pragma unroll
                for (int j = 0; j < 4; ++j) { p0[j] *= fsigmoid(acc[ai][bj][m][0][j] * rs + b0[j]); p1[j] *= fsigmoid(acc[ai][bj][m][1][j] * rs + b1[j]); }
                pv[q] = pack8(p0, p1); }
            asm volatile("" ::: "memory");
            if (u.mi > 0) { u32x4 mv[8];
#pragma unroll
                for (int q = 0; q < 8; ++q) mv[q] = scrM[SLOT(ai, q >> 1, q & 1)];
#pragma unroll
                for (int q = 0; q < 8; ++q) { f32x4 a0, a1, q0, q1; unpack8(pv[q], a0, a1); unpack8(mv[q], q0, q1); pv[q] = pack8(a0 + q0, a1 + q1); } }
#pragma unroll
            for (int q = 0; q < 8; ++q) { const int m = q >> 1, bj = q & 1;
                if (u.mi == nm - 1) *(u32x4*)(M + (size_t)(row0 + ai * 128 + m * 16) * D + col0 + bj * 128) = pv[q]; else scrM[SLOT(ai, m, bj)] = pv[q]; }
            asm volatile("" ::: "memory"); }
    }
};
struct EpiPle {
    u32x4* scrP; const bf16* Hcur; bf16* HBout; const float* ss; float* ss_out;
    __device__ __forceinline__ void operator()(const f32x4 (&acc)[2][2][4][2], const GU& u, int wr, int wc, int fr, int fq) const {
        int tid = threadIdx.x; asm volatile("" : "+v"(tid));
        if (u.kind == 0) {
#pragma unroll
            for (int ai = 0; ai < 2; ++ai)
#pragma unroll
                for (int m = 0; m < 4; ++m)
#pragma unroll
                    for (int bj = 0; bj < 2; ++bj) scrP[SLOT(ai, m, bj)] = pack8(acc[ai][bj][m][0], acc[ai][bj][m][1]);
            return;
        }
        rstd_table(ss, u.pm);
        const int row0 = u.pm * 256 + wr * 64 + fr, col0 = u.pn * 256 + wc * 32 + 8 * fq;
#pragma unroll
        for (int qt = 0; qt < 4; ++qt) { const int ai = qt >> 1, m0 = (qt & 1) * 2;
            u32x4 pv[4], hv[4];
#pragma unroll
            for (int q = 0; q < 4; ++q) { const int m = m0 + (q >> 1), bj = q & 1; pv[q] = scrP[SLOT(ai, m, bj)]; hv[q] = *(const u32x4*)(Hcur + (size_t)(row0 + ai * 128 + m * 16) * D + col0 + bj * 128); }
#pragma unroll
            for (int mm = 0; mm < 2; ++mm) { const int m = m0 + mm; const int r = row0 + ai * 128 + m * 16; const float rs = rstd_tab(wr * 64 + fr + ai * 128 + m * 16); float s2 = 0.f;
#pragma unroll
                for (int bj = 0; bj < 2; ++bj) { const int q = mm * 2 + bj; f32x4 h0, h1, p0, p1; unpack8(hv[q], h0, h1); unpack8(pv[q], p0, p1);
#pragma unroll
                    for (int j = 0; j < 4; ++j) { h0[j] += fsigmoid(acc[ai][bj][m][0][j] * rs) * p0[j]; h1[j] += fsigmoid(acc[ai][bj][m][1][j] * rs) * p1[j]; }
                    *(u32x4*)(HBout + (size_t)r * D + col0 + bj * 128) = pack8(h0, h1);
                    s2 += (h0[0] * h0[0] + h0[1] * h0[1]) + (h0[2] * h0[2] + h0[3] * h0[3]) + (h1[0] * h1[0] + h1[1] * h1[1]) + (h1[2] * h1[2] + h1[3] * h1[3]); }
                s2 += __shfl_xor(s2, 16); s2 += __shfl_xor(s2, 32);
                if (fq == 0) ss_out[(size_t)r * 16 + u.pn * 4 + wc] = s2; }
            asm volatile("" ::: "memory"); }
    }
};

constexpr int NWAVES = 8, NTHR = 512;
constexpr int RING_OFF = 0, RING_BYTES = 131072, WREG = 19456, MISC_OFF = 8 * WREG;
constexpr int LDS_BYTES = MISC_OFF + 256;
static_assert(MISC_OFF + 128 <= LDS_BYTES, "lds");
struct Args { const float* in[37]; float* out; unsigned char* ws; int ph_lo, ph_hi; };
struct Frame {
    LAS unsigned char* lds; int tid, lane, wave, G, bx;
    const float* const* in; float* out; unsigned char* ws;
};
enum { I_X = 0, I_P, I_NORM_MIX, I_W_IN, I_POS_K, I_POS_V, I_CK1, I_CK2, I_CV1, I_CV2, I_LB, I_HG_NORM, I_RT_G, I_RT_B, I_MU, I_W0, I_WUP, I_A0, I_AUP, I_GUP, I_KK, I_KA, I_RK,
       I_RW_G, I_RW_B, I_WBR, I_WGATE, I_BGATE, I_WOUT, I_NORM_FFN, I_FFG, I_FFU, I_FFD, I_NORM_PLE, I_PLEG, I_PLEP, I_NORM_FINAL };

template <class ColMap>
__device__ __forceinline__ void transpose_item(const float* W, int ldw, int K, const float* scale, bf16* WT, LAS float* scr, int item, int nblk, int lane, const ColMap& cm) {
    const int kb = item / nblk, nb = item % nblk, k0 = 64 * kb, n0 = 32 * nb;
    const int sc = cm(n0 + (lane & 31));
    float tv[32];
#pragma unroll
    for (int i = 0; i < 32; ++i) { const int kk = 2 * i + (lane >> 5); tv[i] = (sc >= 0) ? W[(size_t)(k0 + kk) * ldw + sc] : 0.f; }
    if (scale) {
#pragma unroll
        for (int i = 0; i < 32; ++i) tv[i] *= scale[k0 + 2 * i + (lane >> 5)]; }
#pragma unroll
    for (int i = 0; i < 32; ++i) scr[(2 * i + (lane >> 5)) * 33 + (lane & 31)] = tv[i];
    LDS_WAIT();
    const int c = lane & 7;
#pragma unroll
    for (int j = 0; j < 4; ++j) { const int n = (lane >> 3) + 8 * j; const LAS float* s = scr + (8 * c) * 33 + n;
        u32x4 o; o.x = cvt_pk_bf16(s[0 * 33], s[1 * 33]); o.y = cvt_pk_bf16(s[2 * 33], s[3 * 33]); o.z = cvt_pk_bf16(s[4 * 33], s[5 * 33]); o.w = cvt_pk_bf16(s[6 * 33], s[7 * 33]);
        *(u32x4*)(WT + (size_t)(n0 + n) * K + k0 + 8 * c) = o; }
    LDS_WAIT();
}
struct CmIdent { __device__ __forceinline__ int operator()(int n) const { return n; } };
struct CmWin { __device__ __forceinline__ int operator()(int n) const { return n < 652 ? n : (n < 768 ? -1 : n - 116); } };
struct CmFF { __device__ __forceinline__ int operator()(int n) const { return (n >> 8) * 128 + (n & 127); } };

__device__ __forceinline__ void phase_prologue(Frame& F0) {
    Frame F = F0; asm volatile("" : "+v"(F.tid)); F.lane = F.tid & 63;
    LAS float* scr = (LAS float*)(F.lds + F.wave * WREG);
    const int gw = F.bx * NWAVES + F.wave, NGW = F.G * NWAVES;
    int dbase = 0;
#define DEAL(var, n) for (int _n = (n), var = (int)((unsigned)(gw + NGW - (dbase % NGW)) % (unsigned)NGW), _once = ((dbase += _n), 0); var < _n; var += NGW)
    for (int L = 0; L < NL; ++L) {
        unsigned char* wl = F.ws + WS_W + (size_t)L * WL_STRIDE;
        const float* g_mix = F.in[I_NORM_MIX] + L * D; const float* g_ffn = F.in[I_NORM_FFN] + L * D; const float* g_ple = F.in[I_NORM_PLE] + L * D;
        { const int nblk = UW / 32, items = (D / 64) * nblk; const float* W = F.in[I_W_IN] + (size_t)L * D * DIN;
          DEAL(it, items) transpose_item(W, DIN, D, g_mix, (bf16*)(wl + WL_IN), scr, it, nblk, F.lane, CmWin()); }
        for (int m = 0; m < 4; ++m) { const int nblk = D / 32, items = (D / 64) * nblk; const float* W = F.in[I_WGATE] + ((size_t)L * 4 + m) * D * D;
          DEAL(it, items) transpose_item(W, D, D, g_mix, (bf16*)(wl + WL_G) + (size_t)m * D * D, scr, it, nblk, F.lane, CmIdent()); }
        for (int m = 0; m < 4; ++m) { const int nblk = D / 32, items = (MW / 64) * nblk; const float* W = F.in[I_WBR] + ((size_t)L * 4 + m) * MW * D;
          DEAL(it, items) transpose_item(W, D, MW, nullptr, (bf16*)(wl + WL_B) + (size_t)m * D * MW, scr, it, nblk, F.lane, CmIdent()); }
        { const int nblk = D / 32, items = (D / 64) * nblk; const float* W = F.in[I_WOUT] + (size_t)L * D * D;
          DEAL(it, items) transpose_item(W, D, D, nullptr, (bf16*)(wl + WL_OUT), scr, it, nblk, F.lane, CmIdent()); }
        { const int nblk = (2 * DFF) / 32, items = (D / 64) * nblk; const float* Wg = F.in[I_FFG] + (size_t)L * D * DFF; const float* Wu = F.in[I_FFU] + (size_t)L * D * DFF;
          DEAL(it, items) { const int nb = it % nblk; const bool up = ((nb * 32) & 128) != 0; transpose_item(up ? Wu : Wg, DFF, D, g_ffn, (bf16*)(wl + WL_FF), scr, it, nblk, F.lane, CmFF()); } }
        { const int nblk = D / 32, items = (DFF / 64) * nblk; const float* W = F.in[I_FFD] + (size_t)L * DFF * D;
          DEAL(it, items) transpose_item(W, D, DFF, nullptr, (bf16*)(wl + WL_DN), scr, it, nblk, F.lane, CmIdent()); }
        { const int nblk = D / 32, items = (D / 64) * nblk; const float* W = F.in[I_PLEG] + (size_t)L * D * D;
          DEAL(it, items) transpose_item(W, D, D, g_ple, (bf16*)(wl + WL_PG), scr, it, nblk, F.lane, CmIdent()); }
        { const int nblk = D / 32, items = (PLE / 64) * nblk; const float* W = F.in[I_PLEP] + (size_t)L * PLE * D;
          DEAL(it, items) transpose_item(W, D, PLE, nullptr, (bf16*)(wl + WL_PP), scr, it, nblk, F.lane, CmIdent()); }
    }
    for (int L = 0; L < NL; ++L) for (int kv = 0; kv < 2; ++kv) {
        const float* w1 = F.in[kv ? I_CV1 : I_CK1] + (size_t)L * 2048 * 128; const float* w2 = F.in[kv ? I_CV2 : I_CK2] + (size_t)L * 128 * 64;
        bf16* w1T = (bf16*)(F.ws + WS_CW1 + (size_t)L * MiB) + (size_t)kv * 128 * 2048; bf16* w2T = (bf16*)(F.ws + WS_CW2 + (size_t)L * 65536) + kv * 64 * 128;
        DEAL(it, 128) transpose_item(w1, 128, 2048, nullptr, w1T, scr, it, 4, F.lane, CmIdent());
        DEAL(it, 4) transpose_item(w2, 64, 128, nullptr, w2T, scr, it, 2, F.lane, CmIdent());
        DEAL(tk, 64) { const int hf = tk & 1, jq = tk >> 1; const float* pos = F.in[kv ? I_POS_V : I_POS_K] + (size_t)L * 2048; float a = 0.f;
#pragma unroll 8
            for (int j = 64 * jq; j < 64 * jq + 64; ++j) a += pos[j] * w1[(size_t)j * 128 + hf * 64 + F.lane];
            ((float*)(F.ws + WS_CW2 + (size_t)L * 65536 + 32768))[(kv * 32 + jq) * 128 + hf * 64 + F.lane] = a; } }
#undef DEAL
    { const float* x = F.in[I_X]; bf16* hb = (bf16*)(F.ws + WS_HBA); float* ss0 = F.out;
      for (int r = gw; r < T; r += NGW) { const f32x4* xr = (const f32x4*)(x + (size_t)r * D) + F.lane; float s = 0.f;
#pragma unroll
        for (int j = 0; j < 4; ++j) { const f32x4 v = xr[64 * j]; s += (v[0] * v[0] + v[1] * v[1]) + (v[2] * v[2] + v[3] * v[3]);
            u32x2 w; w.x = cvt_pk_bf16(v[0], v[1]); w.y = cvt_pk_bf16(v[2], v[3]); *((u32x2*)(hb + (size_t)r * D) + F.lane + 64 * j) = w; }
        s = wave_sum(s); if (F.lane < 16) ss0[(size_t)r * 16 + F.lane] = (F.lane == 0) ? s : 0.f; } }
    for (int L = 0; L < NL; ++L) { bf16* base = (bf16*)(F.ws + WS_RWUP + (size_t)L * 131072);
        for (int it = gw; it < 8; it += NGW) transpose_item(F.in[I_WUP] + (size_t)L * 64 * 256, 256, 64, nullptr, base, scr, it, 8, F.lane, CmIdent());
        for (int it = gw; it < 8; it += NGW) transpose_item(F.in[I_AUP] + (size_t)L * 64 * 256, 256, 64, nullptr, base + 256 * 64, scr, it, 8, F.lane, CmIdent());
        for (int it = gw; it < 16; it += NGW) transpose_item(F.in[I_GUP] + (size_t)L * 128 * 256, 256, 128, nullptr, base + 2 * 256 * 64, scr, it, 8, F.lane, CmIdent()); }
    { float* rope = (float*)(F.ws + WS_ROPE); const int gt = F.bx * NTHR + F.tid, NT_ = F.G * NTHR;
      for (int i = gt; i < S * 32; i += NT_) { const int pos = i >> 5, j = i & 31; const float inv = exp2f(-(float)(2 * j) * (13.287712379549449f / 64.0f));
        const float a = (float)pos * inv;
        rope[2 * i] = cosf(a); rope[2 * i + 1] = sinf(a); } }
}

__device__ __forceinline__ float ldu(const bf16* u, size_t row, int col) { return bf2f(u[row * UW + col]); }

__device__ __forceinline__ bf16x8 frag_rm(const LAS unsigned char* X, int ld, int r0, int k0, int lane) { return *(const LAS bf16x8*)(X + (r0 + (lane & 31)) * ld + (k0 + 8 * (lane >> 5)) * 2); }
__device__ __forceinline__ bf16x8 frag_tr(const LAS unsigned char* X, int ld, int k0, int c0, int lane) {
    const LAS unsigned char* p = X + (k0 + 8 * (lane >> 5) + ((lane & 15) >> 2)) * ld + (c0 + 16 * ((lane >> 4) & 1) + 4 * (lane & 3)) * 2;
    const s16x4 a = __builtin_amdgcn_ds_read_tr16_b64_v4i16((LAS s16x4*)p), b = __builtin_amdgcn_ds_read_tr16_b64_v4i16((LAS s16x4*)(p + 4 * ld));
    return (bf16x8){a[0], a[1], a[2], a[3], b[0], b[1], b[2], b[3]};
}
__device__ __forceinline__ bf16x8 frag_g(const bf16* X, int ld, int r0, int k0, int lane) { return *(const bf16x8*)(X + (size_t)(r0 + (lane & 31)) * ld + k0 + 8 * (lane >> 5)); }
__device__ __forceinline__ f32x16 mma32(const bf16x8& a, const bf16x8& b, const f32x16& c) { return __builtin_amdgcn_mfma_f32_32x32x16_bf16(a, b, c, 0, 0, 0); }
__device__ __forceinline__ f32x16 zero16() { f32x16 z;
#pragma unroll
    for (int i = 0; i < 16; ++i) z[i] = 0.f;
    return z; }
__device__ __forceinline__ void st_T(LAS unsigned char* X, int ld, int j0, int i0, const f32x16& acc, int lane) {
#pragma unroll
    for (int g = 0; g < 4; ++g) { u32x2 w; w.x = cvt_pk_bf16(acc[4 * g], acc[4 * g + 1]); w.y = cvt_pk_bf16(acc[4 * g + 2], acc[4 * g + 3]);
        *(LAS u32x2*)(X + (j0 + (lane & 31)) * ld + (i0 + 8 * g + 4 * (lane >> 5)) * 2) = w; }
}
__device__ __forceinline__ void st_wt16(bf16* p, const u32x4& w) { __hip_atomic_store((unsigned long long*)p, ((unsigned long long)w.y << 32) | (unsigned long long)w.x, __ATOMIC_RELAXED, __HIP_MEMORY_SCOPE_AGENT); __hip_atomic_store((unsigned long long*)p + 1, ((unsigned long long)w.w << 32) | (unsigned long long)w.z, __ATOMIC_RELAXED, __HIP_MEMORY_SCOPE_AGENT); }
template <bool WT>
__device__ __forceinline__ void st_T_g(bf16* X, int ld, int j0, int i0, const f32x16& acc, int lane) {
    const int hh = lane >> 5; u32x2 w[4];
#pragma unroll
    for (int g = 0; g < 4; ++g) { w[g].x = cvt_pk_bf16(acc[4 * g], acc[4 * g + 1]); w[g].y = cvt_pk_bf16(acc[4 * g + 2], acc[4 * g + 3]); }
#pragma unroll
    for (int k = 0; k < 2; ++k) { const u32x2 snd = hh ? w[k] : w[2 + k]; u32x2 rcv; rcv.x = __shfl_xor(snd.x, 32); rcv.y = __shfl_xor(snd.y, 32);
        const u32x2 own = hh ? w[2 + k] : w[k]; u32x4 v; if (hh) { v.x = rcv.x; v.y = rcv.y; v.z = own.x; v.w = own.y; } else { v.x = own.x; v.y = own.y; v.z = rcv.x; v.w = rcv.y; }
        bf16* p = X + (size_t)(j0 + (lane & 31)) * ld + i0 + 8 * (2 * hh + k);
        if (WT) st_wt16(p, v); else *(u32x4*)p = v; }
}
constexpr int LD64 = 144, LD32 = 80;
__device__ __forceinline__ float expc(float x) { return __expf(fminf(fmaxf(x, -80.f), 80.f)); }
__device__ __forceinline__ unsigned short f2b(float x) { return (unsigned short)(cvt_pk_bf16(x, 0.f) & 0xffffu); }
__device__ __forceinline__ void copy_tok64(LAS unsigned char* X, const bf16* src, int lane) {
#pragma unroll
    for (int p = 0; p < 4; ++p) { const int t = 8 * p + (lane >> 3), ch = lane & 7; *(LAS u32x4*)(X + t * LD64 + ch * 16) = *(const u32x4*)(src + (size_t)t * UW + ch * 8); }
}
__device__ __forceinline__ void glin_m1(const LAS unsigned char* Kh, const LAS unsigned char* Vv, bf16* Sg, int lane, bool cst = false) {
#pragma unroll
    for (int dt = 0; dt < 2; ++dt)
#pragma unroll
        for (int et = 0; et < 2; ++et) { f32x16 acc = zero16();
#pragma unroll
            for (int ks = 0; ks < 2; ++ks) acc = mma32(frag_tr(Kh, LD64, 16 * ks, 32 * dt, lane), frag_tr(Vv, LD64, 16 * ks, 32 * et, lane), acc);
            if (cst) {
#pragma unroll
            for (int i = 0; i < 16; ++i) acc[i] = 0.01f * (float)(1 + ((lane + i) & 7)); }
            st_T_g<true>(Sg, 64, 32 * et, 32 * dt, acc, lane); }
}
__device__ __forceinline__ void glin_m3(const LAS unsigned char* Qt, const LAS unsigned char* Kt, const LAS unsigned char* Vv, LAS unsigned char* Xa, const bf16* S0, int lane, f32x16 (&o)[2]) {
    { f32x16 acc = zero16();
#pragma unroll
      for (int ks = 0; ks < 4; ++ks) acc = mma32(frag_rm(Kt, LD64, 0, 16 * ks, lane), frag_rm(Qt, LD64, 0, 16 * ks, lane), acc);
      const int t = lane & 31;
#pragma unroll
      for (int i = 0; i < 16; ++i) { const int sidx = (i & 3) + 8 * (i >> 2) + 4 * (lane >> 5); if (sidx > t) acc[i] = 0.f; }
      st_T(Xa, LD32, 0, 0, acc, lane); }
    LDS_WAIT();
#pragma unroll
    for (int et = 0; et < 2; ++et) { f32x16 acc = zero16();
        if (S0) {
#pragma unroll
            for (int ks = 0; ks < 4; ++ks) acc = mma32(frag_g(S0, 64, 32 * et, 16 * ks, lane), frag_rm(Qt, LD64, 0, 16 * ks, lane), acc); }
#pragma unroll
        for (int ks = 0; ks < 2; ++ks) acc = mma32(frag_tr(Vv, LD64, 16 * ks, 32 * et, lane), frag_rm(Xa, LD32, 0, 16 * ks, lane), acc);
        o[et] = acc; }
}
template <bool M3>
__device__ __forceinline__ void hgrn_chunk(Frame& F, int L, int bh, int n, LAS unsigned char* W, bf16* Sbase, float* Dbase) {
    const bf16* u = (const bf16*)(F.ws + WS_U); bf16* bo = (bf16*)(F.ws + WS_BO);
    int lane = F.lane; asm volatile("" : "+v"(lane));
    const int b = bh >> 2, h = bh & 3; const size_t row0 = (size_t)b * S + (size_t)n * CH;
    const bf16* ur = u + row0 * UW + U_HG + h * 64;
    bf16* Sg = Sbase + ((size_t)bh * NCH + n) * 4096;
    LAS unsigned char* Xq = W; LAS unsigned char* Xk = W + 4608; LAS unsigned char* Xv = W + 9216; LAS unsigned char* Xa = W + 13824;
    const float* lbl = F.in[I_LB]; const int ch = h * 64 + lane;
    float lb = 0.f; if (L > 0) { const float l0 = lbl[ch], l1 = lbl[256 + ch]; const float mx = fmaxf(l0, l1); const float e0 = __expf(l0 - mx), e1 = __expf(l1 - mx); lb = e1 / (e0 + e1); }
    float bcum[CH], kk[CH]; float run = 0.f;
#pragma unroll
    for (int t = 0; t < CH; ++t) { const float z = bf2f(ur[(size_t)t * UW + 256 + lane]); const float f = lb + (1.0f - lb) * fsigmoid(z); kk[t] = 1.0f - f; run += __logf(fmaxf(f, 1e-20f)); bcum[t] = run; }
    const float blast = bcum[CH - 1];
    copy_tok64(Xv, ur + 512, lane);
    if (!M3) {
#pragma unroll
        for (int t = 0; t < CH; ++t) *(LAS unsigned short*)(Xq + t * LD64 + lane * 2) = f2b(kk[t] * expc(blast - bcum[t]));
        Dbase[((size_t)bh * NCH + n) * 64 + lane] = expc(blast);
        LDS_WAIT();
        glin_m1(Xq, Xv, Sg, lane);
    } else {
#pragma unroll
        for (int t = 0; t < CH; ++t) { const float q = fsilu(bf2f(ur[(size_t)t * UW + lane]));
            *(LAS unsigned short*)(Xq + t * LD64 + lane * 2) = f2b(q * expc(bcum[t]));
            *(LAS unsigned short*)(Xk + t * LD64 + lane * 2) = f2b(kk[t] * expc(-bcum[t])); }
        LDS_WAIT();
        f32x16 o[2];
        glin_m3(Xq, Xk, Xv, Xa, n > 0 ? Sg - 4096 : nullptr, lane, o);
        const int t = lane & 31, hh = lane >> 5; float ss = 0.f;
#pragma unroll
        for (int et = 0; et < 2; ++et)
#pragma unroll
            for (int i = 0; i < 16; ++i) ss += o[et][i] * o[et][i];
        ss += __shfl_xor(ss, 32);
        const float rn = __builtin_amdgcn_rsqf(ss * (1.0f / 64.0f) + EPS);
        const float* ng = F.in[I_HG_NORM] + L * 256 + h * 64;
#pragma unroll
        for (int et = 0; et < 2; ++et)
#pragma unroll
            for (int g = 0; g < 4; ++g) { const int e0 = 32 * et + 8 * g + 4 * hh;
                const u32x2 og = *(const u32x2*)(ur + (size_t)t * UW + 768 + e0); const f32x4 gg = *(const f32x4*)(ng + e0);
                const float y0 = o[et][4 * g] * rn * gg[0] * fsilu(bflo(og.x)), y1 = o[et][4 * g + 1] * rn * gg[1] * fsilu(bfhi(og.x));
                const float y2 = o[et][4 * g + 2] * rn * gg[2] * fsilu(bflo(og.y)), y3 = o[et][4 * g + 3] * rn * gg[3] * fsilu(bfhi(og.y));
                u32x2 w; w.x = cvt_pk_bf16(y0, y1); w.y = cvt_pk_bf16(y2, y3);
                *(u32x2*)(bo + (row0 + t) * 1024 + 256 + h * 64 + e0) = w; }
    }
    LDS_WAIT();
}
template <bool M3>
__device__ __forceinline__ void ret_chunk(Frame& F, int L, int bh, int n, LAS unsigned char* W, bf16* Sbase) {
    const bf16* u = (const bf16*)(F.ws + WS_U); bf16* bo = (bf16*)(F.ws + WS_BO); const float* rope = (const float*)(F.ws + WS_ROPE);
    int lane = F.lane; asm volatile("" : "+v"(lane));
    const int b = bh >> 2, h = bh & 3; const int tpos0 = n * CH; const size_t row0 = (size_t)b * S + (size_t)tpos0;
    const bf16* ur = u + row0 * UW + U_RT + h * 64;
    bf16* Sg = Sbase + ((size_t)bh * NCH + n) * 4096;
    LAS unsigned char* Xq = W; LAS unsigned char* Xk = W + 4608; LAS unsigned char* Xv = W + 9216; LAS unsigned char* Xa = W + 13824;
    const float lg2 = __log2f(1.0f - exp2f(-5.0f - (float)h));
    copy_tok64(Xv, ur + 512, lane);
#pragma unroll
    for (int p = 0; p < 2; ++p) { const int idx = lane + 64 * p, t = idx >> 2, jc = idx & 3;
        f32x4 c0, c1, s0, s1;
        { const float* rp = rope + ((size_t)(tpos0 + t) * 32 + jc * 8) * 2; const f32x4 a = *(const f32x4*)rp, bq = *(const f32x4*)(rp + 4), c = *(const f32x4*)(rp + 8), d = *(const f32x4*)(rp + 12);
          c0 = (f32x4){a[0], a[2], bq[0], bq[2]}; s0 = (f32x4){a[1], a[3], bq[1], bq[3]}; c1 = (f32x4){c[0], c[2], d[0], d[2]}; s1 = (f32x4){c[1], c[3], d[1], d[3]}; }
        { const u32x4 w1 = *(const u32x4*)(ur + (size_t)t * UW + 256 + jc * 8), w2 = *(const u32x4*)(ur + (size_t)t * UW + 256 + 32 + jc * 8);
          f32x4 a0, a1, b0, b1; unpack8(w1, a0, a1); unpack8(w2, b0, b1);
          const float sc = 0.125f * exp2f(lg2 * (M3 ? -(float)(t + 1) : (float)(CH - 1 - t)));
          const f32x4 lo0 = (a0 * c0 - b0 * s0) * sc, lo1 = (a1 * c1 - b1 * s1) * sc, hi0 = (a0 * s0 + b0 * c0) * sc, hi1 = (a1 * s1 + b1 * c1) * sc;
          LAS unsigned char* dst = M3 ? Xk : Xq;
          *(LAS u32x4*)(dst + t * LD64 + jc * 16) = pack8(lo0, lo1); *(LAS u32x4*)(dst + t * LD64 + 64 + jc * 16) = pack8(hi0, hi1); }
        if (M3) { const u32x4 w1 = *(const u32x4*)(ur + (size_t)t * UW + jc * 8), w2 = *(const u32x4*)(ur + (size_t)t * UW + 32 + jc * 8);
          f32x4 a0, a1, b0, b1; unpack8(w1, a0, a1); unpack8(w2, b0, b1);
          const float sc = exp2f(lg2 * (float)(t + 1));
          const f32x4 lo0 = (a0 * c0 - b0 * s0) * sc, lo1 = (a1 * c1 - b1 * s1) * sc, hi0 = (a0 * s0 + b0 * c0) * sc, hi1 = (a1 * s1 + b1 * c1) * sc;
          *(LAS u32x4*)(Xq + t * LD64 + jc * 16) = pack8(lo0, lo1); *(LAS u32x4*)(Xq + t * LD64 + 64 + jc * 16) = pack8(hi0, hi1); }
    }
    LDS_WAIT();
    if (!M3) glin_m1(Xq, Xv, Sg, lane);
    else {
        f32x16 o[2];
        glin_m3(Xq, Xk, Xv, Xa, n > 0 ? Sg - 4096 : nullptr, lane, o);
        const int t = lane & 31, hh = lane >> 5; float sm = 0.f;
#pragma unroll
        for (int et = 0; et < 2; ++et)
#pragma unroll
            for (int i = 0; i < 16; ++i) sm += o[et][i];
        sm += __shfl_xor(sm, 32);
        const float mean = sm * (1.0f / 64.0f); float sv = 0.f;
#pragma unroll
        for (int et = 0; et < 2; ++et)
#pragma unroll
            for (int i = 0; i < 16; ++i) { const float dl = o[et][i] - mean; sv += dl * dl; }
        sv += __shfl_xor(sv, 32);
        const float rn = __builtin_amdgcn_rsqf(sv * (1.0f / 64.0f) + 1e-5f);
        const float* ng = F.in[I_RT_G] + L * 256 + h * 64; const float* nb = F.in[I_RT_B] + L * 256 + h * 64;
#pragma unroll
        for (int et = 0; et < 2; ++et)
#pragma unroll
            for (int g = 0; g < 4; ++g) { const int e0 = 32 * et + 8 * g + 4 * hh;
                const u32x2 og = *(const u32x2*)(ur + (size_t)t * UW + 768 + e0); const f32x4 gg = *(const f32x4*)(ng + e0), bb = *(const f32x4*)(nb + e0);
                const float y0 = ((o[et][4 * g] - mean) * rn * gg[0] + bb[0]) * fsilu(bflo(og.x)), y1 = ((o[et][4 * g + 1] - mean) * rn * gg[1] + bb[1]) * fsilu(bfhi(og.x));
                const float y2 = ((o[et][4 * g + 2] - mean) * rn * gg[2] + bb[2]) * fsilu(bflo(og.y)), y3 = ((o[et][4 * g + 3] - mean) * rn * gg[3] + bb[3]) * fsilu(bfhi(og.y));
                u32x2 w; w.x = cvt_pk_bf16(y0, y1); w.y = cvt_pk_bf16(y2, y3);
                *(u32x2*)(bo + (row0 + t) * 1024 + 512 + h * 64 + e0) = w; }
    }
    LDS_WAIT();
}
__device__ __forceinline__ void glin_scan_task(bf16* Sbase, const float* Dbase, float dscal, int bh, int half, int tl  ) {
    bf16* p = Sbase + (size_t)bh * NCH * 4096 + half * 2048 + tl * 8;
    const int d0 = (tl & 7) * 8;
    float st[8];
#pragma unroll
    for (int x = 0; x < 8; ++x) st[x] = 0.f;
    for (int n0 = 0; n0 < NCH; n0 += 8) {
        u32x4 kv[8]; f32x4 da[8], db[8];
#pragma unroll
        for (int j = 0; j < 8; ++j) { kv[j] = *(const u32x4*)(p + (size_t)(n0 + j) * 4096);
            if (Dbase) { da[j] = *(const f32x4*)(Dbase + ((size_t)bh * NCH + n0 + j) * 64 + d0); db[j] = *(const f32x4*)(Dbase + ((size_t)bh * NCH + n0 + j) * 64 + d0 + 4); } else { da[j] = (f32x4){dscal, dscal, dscal, dscal}; db[j] = da[j]; } }
#pragma unroll
        for (int j = 0; j < 8; ++j) { f32x4 a, b; unpack8(kv[j], a, b);
#pragma unroll
            for (int x = 0; x < 4; ++x) { st[x] = st[x] * da[j][x] + a[x]; st[4 + x] = st[4 + x] * db[j][x] + b[x]; }
            st_wt16(p + (size_t)(n0 + j) * 4096, pack8((f32x4){st[0], st[1], st[2], st[3]}, (f32x4){st[4], st[5], st[6], st[7]})); }
    }
}

constexpr int RW_R0 = 0, RW_R1 = 4608, RW_R2 = 9216, RW_R3 = 13824, RW_R4 = 16384, RW_R5 = 18944, RW_LW = 0, RW_AG = 8704, LDLW = 272;
__device__ __forceinline__ void ld_shift8(const bf16* urow, bool has_prev, const float* mu8, f32x4& lo, f32x4& hi) {
    const u32x4 w1 = *(const u32x4*)urow; f32x4 a0, a1; unpack8(w1, a0, a1);
    f32x4 p0 = {0.f, 0.f, 0.f, 0.f}, p1 = {0.f, 0.f, 0.f, 0.f};
    if (has_prev) { const u32x4 w0 = *(const u32x4*)(urow - UW); unpack8(w0, p0, p1); }
    const f32x4 m0 = *(const f32x4*)mu8, m1 = *(const f32x4*)(mu8 + 4);
    lo = a0 + m0 * (p0 - a0); hi = a1 + m1 * (p1 - a1);
}
__device__ __forceinline__ float ftanh(float x) { return 1.0f - 2.0f * __builtin_amdgcn_rcpf(1.0f + __builtin_amdgcn_exp2f(2.8853900817779268f * x)); }
#ifndef RW_LIMIT
#define RW_LIMIT 100
#endif
#define RW_CUT(k) do { if (RW_LIMIT <= (k)) return; } while (0)
template <int SI> struct SubstStep {
    static __device__ __forceinline__ void run(float (&Tr)[CH], const LAS unsigned char* AT, int r32, int& ofs) {
        float a0 = (r32 == SI) ? 1.0f : 0.f, a1 = 0.f;
#pragma unroll
        for (int q = 0; q < 4; ++q) { if (8 * q + 7 > SI) { const u32x4 w = *(const LAS u32x4*)(AT + ofs + SI * LD32 + q * 16); f32x4 lo, hi; unpack8(w, lo, hi);
#pragma unroll
            for (int x = 0; x < 4; ++x) { if (8 * q + x > SI) a0 += Tr[8 * q + x] * lo[x]; if (8 * q + 4 + x > SI) a1 += Tr[8 * q + 4 + x] * hi[x]; } } }
        const float a = a0 + a1;
        Tr[SI] = a;
        asm volatile("" : "+v"(ofs) : "v"(a));
        SubstStep<SI - 1>::run(Tr, AT, r32, ofs);
    }
};
template <> struct SubstStep<-1> { static __device__ __forceinline__ void run(float (&)[CH], const LAS unsigned char*, int, int&) {} };
template <bool M3>
__device__ __forceinline__ void rwkv_chunk(Frame& F, int L, int bh, int n, LAS unsigned char* W) {
    const bf16* u = (const bf16*)(F.ws + WS_U); bf16* bo = (bf16*)(F.ws + WS_BO);
    int lane = F.lane; asm volatile("" : "+v"(lane));
    const int b = bh >> 2, h = bh & 3, r32 = lane & 31, hh = lane >> 5; const size_t row0 = (size_t)b * S + (size_t)n * CH;
    const bf16* ur = u + row0 * UW + U_RW;
    const float* mu = F.in[I_MU] + L * 1024;
    const bf16* upT = (const bf16*)(F.ws + WS_RWUP + (size_t)L * 131072);
    bf16* Mg = (bf16*)(F.ws + WS_RWM) + ((size_t)bh * NCH + n) * 4096;
    bf16* Ng = (bf16*)(F.ws + WS_RWN) + ((size_t)bh * NCH + n) * 4096;
    bf16* Tg = (bf16*)((unsigned char*)F.out + 28 * MiB) + ((size_t)bh * NCH + n) * 1024;
    LAS unsigned char* R0 = W + RW_R0; LAS unsigned char* R1 = W + RW_R1; LAS unsigned char* R2 = W + RW_R2; LAS unsigned char* R3 = W + RW_R3; LAS unsigned char* R4 = W + RW_R4;
    LAS float* R5 = (LAS float*)(W + RW_R5);
#pragma unroll
    for (int i = 0; i < 8; ++i) { const int idx = lane + 64 * i, t = idx >> 4, part = (idx >> 3) & 1, ch = idx & 7, col = 768 + part * 64 + ch * 8;
        f32x4 lo, hi; ld_shift8(ur + (size_t)t * UW + col, (n * CH + t) > 0, mu + col, lo, hi);
        if (part == 0) {
#pragma unroll
            for (int j = 0; j < 4; ++j) { lo[j] = ftanh(lo[j]); hi[j] = ftanh(hi[j]); } }
        *(LAS u32x4*)(W + part * 4608 + t * LD64 + ch * 16) = pack8(lo, hi); }
    RW_CUT(0);
    LDS_WAIT();
    { f32x16 zw[2], za[2];
#pragma unroll
      for (int ct = 0; ct < 2; ++ct) { zw[ct] = zero16(); za[ct] = zero16();
#pragma unroll
        for (int ks = 0; ks < 4; ++ks) { zw[ct] = mma32(frag_g(upT + (size_t)(h * 64 + 32 * ct) * 64, 64, 0, 16 * ks, lane), frag_rm(W, LD64, 0, 16 * ks, lane), zw[ct]);
            za[ct] = mma32(frag_g(upT + 256 * 64 + (size_t)(h * 64 + 32 * ct) * 64, 64, 0, 16 * ks, lane), frag_rm(W + 4608, LD64, 0, 16 * ks, lane), za[ct]); } }
      const float* w0 = F.in[I_W0] + L * 256 + h * 64; const float* a0 = F.in[I_A0] + L * 256 + h * 64;
#pragma unroll
      for (int ct = 0; ct < 2; ++ct)
#pragma unroll
        for (int g = 0; g < 4; ++g) { const int c0 = 32 * ct + 8 * g + 4 * hh; const f32x4 wv = *(const f32x4*)(w0 + c0), av = *(const f32x4*)(a0 + c0);
            f32x4 lw, ag;
#pragma unroll
            for (int x = 0; x < 4; ++x) { lw[x] = -0.6065306597126334f * fsigmoid(zw[ct][4 * g + x] + wv[x]); ag[x] = fsigmoid(za[ct][4 * g + x] + av[x]); }
            *(LAS f32x4*)(W + RW_LW + r32 * LDLW + c0 * 4) = lw;
            u32x2 pk; pk.x = cvt_pk_bf16(ag[0], ag[1]); pk.y = cvt_pk_bf16(ag[2], ag[3]); *(LAS u32x2*)(W + RW_AG + r32 * LD64 + c0 * 2) = pk; } }
    RW_CUT(1);
    LDS_WAIT();
    { float run = 0.f;
#pragma unroll
      for (int t = 0; t < CH; ++t) { LAS float* p = (LAS float*)(W + RW_LW + t * LDLW) + lane; run += *p; *p = run; } }
    RW_CUT(2);
    LDS_WAIT();
    const int c0 = 8 * (lane & 7), tl = lane >> 3;
    u32x4 E1p[4], E2p[4], AGp[4];
#pragma unroll
    for (int p = 0; p < 4; ++p) { const int t = 8 * p + tl;
        const f32x4 ca = *(const LAS f32x4*)(W + RW_LW + t * LDLW + c0 * 4), cb = *(const LAS f32x4*)(W + RW_LW + t * LDLW + c0 * 4 + 16);
        f32x4 ea = {0.f, 0.f, 0.f, 0.f}, eb = {0.f, 0.f, 0.f, 0.f};
        if (t > 0) { ea = *(const LAS f32x4*)(W + RW_LW + (t - 1) * LDLW + c0 * 4); eb = *(const LAS f32x4*)(W + RW_LW + (t - 1) * LDLW + c0 * 4 + 16); }
        AGp[p] = *(const LAS u32x4*)(W + RW_AG + t * LD64 + c0 * 2);
        f32x4 x1a, x1b, x2a, x2b;
#pragma unroll
        for (int x = 0; x < 4; ++x) { x1a[x] = __expf(ea[x]); x1b[x] = __expf(eb[x]); x2a[x] = __expf(-ca[x]); x2b[x] = __expf(-cb[x]); }
        E1p[p] = pack8(x1a, x1b); E2p[p] = pack8(x2a, x2b); }
    float pcl[8];
    { const f32x4 la = *(const LAS f32x4*)(W + RW_LW + 31 * LDLW + c0 * 4), lb2 = *(const LAS f32x4*)(W + RW_LW + 31 * LDLW + c0 * 4 + 16);
#pragma unroll
      for (int x = 0; x < 4; ++x) { pcl[x] = __expf(la[x]); pcl[4 + x] = __expf(lb2[x]); } }
    RW_CUT(3);
    LDS_WAIT();
    const float* kkw = F.in[I_KK] + L * 256 + h * 64 + c0; const float* kaw = F.in[I_KA] + L * 256 + h * 64 + c0; const float* rkw = F.in[I_RK] + L * 256 + h * 64 + c0;
    u32x4 Ap[4];
    if (!M3 && tl == 0) { *(LAS f32x4*)(R5 + c0) = (f32x4){pcl[0], pcl[1], pcl[2], pcl[3]}; *(LAS f32x4*)(R5 + c0 + 4) = (f32x4){pcl[4], pcl[5], pcl[6], pcl[7]}; }
#pragma unroll
    for (int p = 0; p < 4; ++p) { const int t = 8 * p + tl; const bool hp = (n * CH + t) > 0; const bf16* ut = ur + (size_t)t * UW + h * 64 + c0;
        f32x4 k0, k1, r0 = {0.f, 0.f, 0.f, 0.f}, r1 = {0.f, 0.f, 0.f, 0.f};
        ld_shift8(ut + 256, hp, mu + 256 + h * 64 + c0, k0, k1);
        if (M3) ld_shift8(ut, hp, mu + h * 64 + c0, r0, r1);
        f32x4 ag0, ag1; unpack8(AGp[p], ag0, ag1);
        float E1[8], E2[8]; { f32x4 a, bq; unpack8(E1p[p], a, bq); f32x4 c, d; unpack8(E2p[p], c, d);
#pragma unroll
            for (int x = 0; x < 4; ++x) { E1[x] = a[x]; E1[4 + x] = bq[x]; E2[x] = c[x]; E2[4 + x] = d[x]; } }
        const f32x4 kw0 = *(const f32x4*)kkw, kw1 = *(const f32x4*)(kkw + 4), ka0 = *(const f32x4*)kaw, ka1 = *(const f32x4*)(kaw + 4);
        f32x4 q0 = k0 * kw0, q1 = k1 * kw1;
        float n2 = (q0[0] * q0[0] + q0[1] * q0[1]) + (q0[2] * q0[2] + q0[3] * q0[3]) + (q1[0] * q1[0] + q1[1] * q1[1]) + (q1[2] * q1[2] + q1[3] * q1[3]);
        n2 += __shfl_xor(n2, 1); n2 += __shfl_xor(n2, 2); n2 += __shfl_xor(n2, 4);
        const float rn = __builtin_amdgcn_rsqf(fmaxf(n2, 1e-24f)); q0 = q0 * rn; q1 = q1 * rn;
        f32x4 kp0, kp1, at0, at1, bt0, bt1, kt0, kt1;
#pragma unroll
        for (int x = 0; x < 4; ++x) { kp0[x] = k0[x] * (1.0f + (ag0[x] - 1.0f) * ka0[x]); kp1[x] = k1[x] * (1.0f + (ag1[x] - 1.0f) * ka1[x]);
            at0[x] = -q0[x] * E1[x]; at1[x] = -q1[x] * E1[4 + x]; bt0[x] = q0[x] * ag0[x] * E2[x]; bt1[x] = q1[x] * ag1[x] * E2[4 + x];
            kt0[x] = kp0[x] * E2[x]; kt1[x] = kp1[x] * E2[4 + x]; }
        *(LAS u32x4*)(R1 + t * LD64 + c0 * 2) = pack8(bt0, bt1); *(LAS u32x4*)(R2 + t * LD64 + c0 * 2) = pack8(kt0, kt1);
        if (!M3) *(LAS u32x4*)(R0 + t * LD64 + c0 * 2) = pack8(at0, at1);
        else { Ap[p] = pack8(at0, at1);
            const f32x4 rk0 = *(const f32x4*)rkw, rk1 = *(const f32x4*)(rkw + 4);
            f32x4 rt0, rt1; float bs = 0.f;
#pragma unroll
            for (int x = 0; x < 4; ++x) { rt0[x] = r0[x] * __builtin_amdgcn_rcpf(E2[x]); rt1[x] = r1[x] * __builtin_amdgcn_rcpf(E2[4 + x]); bs += r0[x] * kp0[x] * rk0[x] + r1[x] * kp1[x] * rk1[x]; }
            bs += __shfl_xor(bs, 1); bs += __shfl_xor(bs, 2); bs += __shfl_xor(bs, 4);
            if ((lane & 7) == 0) R5[t] = bs;
            *(LAS u32x4*)(R0 + t * LD64 + c0 * 2) = pack8(rt0, rt1); } }
    RW_CUT(4);
    LDS_WAIT();
    const bf16* S0 = n > 0 ? Ng - 4096 : nullptr;
    f32x16 yacc[2], g2acc;
    if (M3) {
#pragma unroll
        for (int vt = 0; vt < 2; ++vt) { yacc[vt] = zero16();
            if (S0) {
#pragma unroll
                for (int ks = 0; ks < 4; ++ks) yacc[vt] = mma32(frag_g(S0, 64, 32 * vt, 16 * ks, lane), frag_rm(R0, LD64, 0, 16 * ks, lane), yacc[vt]); } }
        f32x16 g1 = zero16(); g2acc = zero16();
#pragma unroll
        for (int ks = 0; ks < 4; ++ks) { const bf16x8 rf = frag_rm(R0, LD64, 0, 16 * ks, lane); g1 = mma32(frag_rm(R1, LD64, 0, 16 * ks, lane), rf, g1); g2acc = mma32(frag_rm(R2, LD64, 0, 16 * ks, lane), rf, g2acc); }
#pragma unroll
        for (int i = 0; i < 16; ++i) { const int sidx = (i & 3) + 8 * (i >> 2) + 4 * hh; if (sidx > r32) { g1[i] = 0.f; g2acc[i] = 0.f; } }
        st_T(R4, LD32, 0, 0, g1, lane);
        LDS_WAIT();
#pragma unroll
        for (int p = 0; p < 4; ++p) *(LAS u32x4*)(R0 + (8 * p + tl) * LD64 + c0 * 2) = Ap[p];
        LDS_WAIT();
    }
    RW_CUT(5);
    { f32x16 ab = zero16(), ak = zero16();
#pragma unroll
      for (int ks = 0; ks < 4; ++ks) { const bf16x8 af = frag_rm(R0, LD64, 0, 16 * ks, lane); if (!M3) ab = mma32(af, frag_rm(R1, LD64, 0, 16 * ks, lane), ab); ak = mma32(frag_rm(R2, LD64, 0, 16 * ks, lane), af, ak); }
#pragma unroll
      for (int i = 0; i < 16; ++i) { const int ridx = (i & 3) + 8 * (i >> 2) + 4 * hh;
          if (!(ridx > r32)) ab[i] = 0.f;
          if (!(ridx < r32)) ak[i] = 0.f; }
      if (!M3) st_T(R3, LD32, 0, 0, ab, lane);
      st_T(M3 ? R2 : R4, LD32, 0, 0, ak, lane); }
    LAS unsigned char* X1 = M3 ? R2 : R4;
    RW_CUT(6);
    LDS_WAIT();
    if (!M3) {
      float Tr[CH];
      int sofs = 0; asm volatile("" : "+v"(sofs)); SubstStep<CH - 1>::run(Tr, R3, r32, sofs);
      if (hh == 0) {
#pragma unroll
          for (int q = 0; q < 4; ++q) { f32x4 lo = {Tr[8 * q], Tr[8 * q + 1], Tr[8 * q + 2], Tr[8 * q + 3]}, hi = {Tr[8 * q + 4], Tr[8 * q + 5], Tr[8 * q + 6], Tr[8 * q + 7]};
              const u32x4 w = pack8(lo, hi); *(LAS u32x4*)(R3 + r32 * LD32 + q * 16) = w; *(u32x4*)(Tg + r32 * 32 + q * 8) = w; } }
    } else if (hh == 0) {
#pragma unroll
        for (int q = 0; q < 4; ++q) *(LAS u32x4*)(R3 + r32 * LD32 + q * 16) = *(const u32x4*)(Tg + r32 * 32 + q * 8);
    }
    RW_CUT(7);
    LDS_WAIT();
    { f32x16 y = zero16(), ah[2];
#pragma unroll
      for (int ks = 0; ks < 2; ++ks) y = mma32(frag_tr(X1, LD32, 16 * ks, 0, lane), frag_rm(R3, LD32, 0, 16 * ks, lane), y);
#pragma unroll
      for (int ct = 0; ct < 2; ++ct) { ah[ct] = zero16();
#pragma unroll
        for (int ks = 0; ks < 2; ++ks) ah[ct] = mma32(frag_tr(R0, LD64, 16 * ks, 32 * ct, lane), frag_rm(R3, LD32, 0, 16 * ks, lane), ah[ct]); }
      st_T(X1, LD32, 0, 0, y, lane);
      st_T(R0, LD64, 0, 0, ah[0], lane); st_T(R0, LD64, 0, 32, ah[1], lane); }
    RW_CUT(8);
    LDS_WAIT();
    if (!M3) {
        { f32x16 z[2];
#pragma unroll
          for (int dt = 0; dt < 2; ++dt) {
#pragma unroll
            for (int g = 0; g < 4; ++g) { const u32x2 w = *(const LAS u32x2*)(R2 + r32 * LD64 + (32 * dt + 8 * g + 4 * hh) * 2); z[dt][4 * g] = bflo(w.x); z[dt][4 * g + 1] = bfhi(w.x); z[dt][4 * g + 2] = bflo(w.y); z[dt][4 * g + 3] = bfhi(w.y); }
#pragma unroll
            for (int ks = 0; ks < 2; ++ks) z[dt] = mma32(frag_tr(R1, LD64, 16 * ks, 32 * dt, lane), frag_tr(X1, LD32, 16 * ks, 0, lane), z[dt]); }
          st_T(R2, LD64, 0, 0, z[0], lane); st_T(R2, LD64, 0, 32, z[1], lane); }
#pragma unroll
        for (int d1t = 0; d1t < 2; ++d1t) { const float pc1 = R5[32 * d1t + r32];
#pragma unroll
            for (int d2t = 0; d2t < 2; ++d2t) { f32x16 m = zero16();
#pragma unroll
                for (int ks = 0; ks < 2; ++ks) m = mma32(frag_tr(R0, LD64, 16 * ks, 32 * d2t, lane), frag_tr(R1, LD64, 16 * ks, 32 * d1t, lane), m);
#pragma unroll
                for (int i = 0; i < 16; ++i) { const int d2 = 32 * d2t + (i & 3) + 8 * (i >> 2) + 4 * hh; m[i] = pc1 * (m[i] + ((d2 == 32 * d1t + r32) ? 1.0f : 0.f)); }
                st_T_g<false>(Mg, 64, 32 * d1t, 32 * d2t, m, lane); } }
        LDS_WAIT();
#pragma unroll
        for (int p = 0; p < 4; ++p) { const int t = 8 * p + tl; f32x4 v0, v1; ld_shift8(ur + (size_t)t * UW + h * 64 + c0 + 512, (n * CH + t) > 0, mu + 512 + h * 64 + c0, v0, v1); *(LAS u32x4*)(R1 + t * LD64 + c0 * 2) = pack8(v0, v1); }
        LDS_WAIT();
#pragma unroll
        for (int dt = 0; dt < 2; ++dt)
#pragma unroll
            for (int vt = 0; vt < 2; ++vt) { f32x16 nn = zero16();
#pragma unroll
                for (int ks = 0; ks < 2; ++ks) nn = mma32(frag_tr(R2, LD64, 16 * ks, 32 * dt, lane), frag_tr(R1, LD64, 16 * ks, 32 * vt, lane), nn);
#pragma unroll
                for (int g = 0; g < 4; ++g) { const f32x4 pv = *(const LAS f32x4*)(R5 + 32 * dt + 8 * g + 4 * hh);
#pragma unroll
                    for (int x = 0; x < 4; ++x) nn[4 * g + x] *= pv[x]; }
                st_T_g<true>(Ng, 64, 32 * vt, 32 * dt, nn, lane); }
    } else {
        { f32x16 rh[2];
#pragma unroll
          for (int dt = 0; dt < 2; ++dt) { rh[dt] = zero16();
#pragma unroll
            for (int ks = 0; ks < 2; ++ks) rh[dt] = mma32(frag_tr(R0, LD64, 16 * ks, 32 * dt, lane), frag_rm(R4, LD32, 0, 16 * ks, lane), rh[dt]); }
          st_T(R1, LD64, 0, 0, rh[0], lane); st_T(R1, LD64, 0, 32, rh[1], lane); }
        { f32x16 gh = g2acc;
#pragma unroll
          for (int ks = 0; ks < 2; ++ks) gh = mma32(frag_tr(X1, LD32, 16 * ks, 0, lane), frag_rm(R4, LD32, 0, 16 * ks, lane), gh);
          LDS_WAIT();
          st_T(R3, LD32, 0, 0, gh, lane); }
        LDS_WAIT();
        if (S0) {
#pragma unroll
            for (int vt = 0; vt < 2; ++vt)
#pragma unroll
                for (int ks = 0; ks < 4; ++ks) yacc[vt] = mma32(frag_g(S0, 64, 32 * vt, 16 * ks, lane), frag_rm(R1, LD64, 0, 16 * ks, lane), yacc[vt]); }
        LDS_WAIT();
#pragma unroll
        for (int p = 0; p < 4; ++p) { const int t = 8 * p + tl; f32x4 v0, v1; ld_shift8(ur + (size_t)t * UW + h * 64 + c0 + 512, (n * CH + t) > 0, mu + 512 + h * 64 + c0, v0, v1); *(LAS u32x4*)(R0 + t * LD64 + c0 * 2) = pack8(v0, v1); }
#pragma unroll
        for (int i = 0; i < 8; ++i) { const int idx = lane + 64 * i, t = idx >> 4, ch = idx & 15, col = 896 + ch * 8;
            f32x4 lo, hi; ld_shift8(ur + (size_t)t * UW + col, (n * CH + t) > 0, mu + col, lo, hi);
#pragma unroll
            for (int j = 0; j < 4; ++j) { lo[j] = fsigmoid(lo[j]); hi[j] = fsigmoid(hi[j]); }
            *(LAS u32x4*)(R1 + t * LDLW + ch * 16) = pack8(lo, hi); }
        LDS_WAIT();
        f32x16 gacc[2];
#pragma unroll
        for (int vt = 0; vt < 2; ++vt) {
#pragma unroll
            for (int ks = 0; ks < 2; ++ks) yacc[vt] = mma32(frag_tr(R0, LD64, 16 * ks, 32 * vt, lane), frag_rm(R3, LD32, 0, 16 * ks, lane), yacc[vt]);
            gacc[vt] = zero16();
#pragma unroll
            for (int ks = 0; ks < 8; ++ks) gacc[vt] = mma32(frag_g(upT + 2 * 256 * 64 + (size_t)(h * 64 + 32 * vt) * 128, 128, 0, 16 * ks, lane), frag_rm(R1, LDLW, 0, 16 * ks, lane), gacc[vt]); }
        float sm = 0.f;
#pragma unroll
        for (int vt = 0; vt < 2; ++vt)
#pragma unroll
            for (int i = 0; i < 16; ++i) sm += yacc[vt][i];
        sm += __shfl_xor(sm, 32);
        const float mean = sm * (1.0f / 64.0f); float sv = 0.f;
#pragma unroll
        for (int vt = 0; vt < 2; ++vt)
#pragma unroll
            for (int i = 0; i < 16; ++i) { const float dl = yacc[vt][i] - mean; sv += dl * dl; }
        sv += __shfl_xor(sv, 32);
        const float rstd = __builtin_amdgcn_rsqf(sv * (1.0f / 64.0f) + 64e-5f);
        const float bon = R5[r32];
        const float* ng = F.in[I_RW_G] + L * 256 + h * 64; const float* nb = F.in[I_RW_B] + L * 256 + h * 64;
#pragma unroll
        for (int vt = 0; vt < 2; ++vt)
#pragma unroll
            for (int g = 0; g < 4; ++g) { const int v0i = 32 * vt + 8 * g + 4 * hh;
                const u32x2 vw = *(const LAS u32x2*)(R0 + r32 * LD64 + v0i * 2); const f32x4 gg = *(const f32x4*)(ng + v0i), bb = *(const f32x4*)(nb + v0i);
                const float vv[4] = {bflo(vw.x), bfhi(vw.x), bflo(vw.y), bfhi(vw.y)}; float o[4];
#pragma unroll
                for (int x = 0; x < 4; ++x) o[x] = ((yacc[vt][4 * g + x] - mean) * rstd * gg[x] + bb[x] + bon * vv[x]) * gacc[vt][4 * g + x];
                u32x2 w; w.x = cvt_pk_bf16(o[0], o[1]); w.y = cvt_pk_bf16(o[2], o[3]);
                *(u32x2*)(bo + (row0 + r32) * 1024 + 768 + h * 64 + v0i) = w; }
    }
    LDS_WAIT();
}
__device__ __forceinline__ void rwkv_scan_task(Frame& F, int bh, int vh) {
    const int lane = F.lane, r32 = lane & 31, hh = lane >> 5;
    const bf16* Mb = (const bf16*)(F.ws + WS_RWM) + (size_t)bh * NCH * 4096; bf16* Nb = (bf16*)(F.ws + WS_RWN) + (size_t)bh * NCH * 4096 + (size_t)(vh * 32 + r32) * 64;
    f32x16 st[2] = {zero16(), zero16()};
    u32x2 nq[2][4], mq[2][2][2][2];
#define RW_PREF(nn) do { _Pragma("unroll") for (int dt = 0; dt < 2; ++dt) _Pragma("unroll") for (int g = 0; g < 4; ++g) nq[dt][g] = *(const u32x2*)(Nb + (size_t)(nn) * 4096 + 32 * dt + 8 * g + 4 * hh); \
        _Pragma("unroll") for (int d1t = 0; d1t < 2; ++d1t) _Pragma("unroll") for (int dt = 0; dt < 2; ++dt) _Pragma("unroll") for (int s2 = 0; s2 < 2; ++s2) { \
            const bf16* mp = Mb + (size_t)(nn) * 4096 + (size_t)(32 * d1t + r32) * 64 + 32 * dt + 16 * s2 + 4 * hh; mq[d1t][dt][s2][0] = *(const u32x2*)mp; mq[d1t][dt][s2][1] = *(const u32x2*)(mp + 8); } } while (0)
    RW_PREF(0);
    for (int n = 0; n < NCH; ++n) {
        bf16x8 bfr[2][2];
#pragma unroll
        for (int dt = 0; dt < 2; ++dt)
#pragma unroll
            for (int s2 = 0; s2 < 2; ++s2) { union { bf16x8 v; unsigned w[4]; } pf;
#pragma unroll
                for (int j = 0; j < 4; ++j) pf.w[j] = cvt_pk_bf16(st[dt][8 * s2 + 2 * j], st[dt][8 * s2 + 2 * j + 1]);
                bfr[dt][s2] = pf.v; }
        f32x16 nw[2];
#pragma unroll
        for (int d1t = 0; d1t < 2; ++d1t) {
#pragma unroll
            for (int g = 0; g < 4; ++g) { nw[d1t][4 * g] = bflo(nq[d1t][g].x); nw[d1t][4 * g + 1] = bfhi(nq[d1t][g].x); nw[d1t][4 * g + 2] = bflo(nq[d1t][g].y); nw[d1t][4 * g + 3] = bfhi(nq[d1t][g].y); }
#pragma unroll
            for (int dt = 0; dt < 2; ++dt)
#pragma unroll
                for (int s2 = 0; s2 < 2; ++s2) { union { bf16x8 v; u32x2 d[2]; } mf; mf.d[0] = mq[d1t][dt][s2][0]; mf.d[1] = mq[d1t][dt][s2][1]; nw[d1t] = mma32(mf.v, bfr[dt][s2], nw[d1t]); } }
        if (n + 1 < NCH) RW_PREF(n + 1);
#pragma unroll
        for (int d1t = 0; d1t < 2; ++d1t) { st[d1t] = nw[d1t];
            st_T_g<true>((bf16*)(F.ws + WS_RWN) + ((size_t)bh * NCH + n) * 4096, 64, vh * 32, 32 * d1t, nw[d1t], lane); }
    }
#undef RW_PREF
}

constexpr int NS_KROW = 144, NS_VROW = 144;
constexpr int NS_KB = 64 * NS_KROW, NS_VB = 64 * NS_VROW;
constexpr int NS_K0 = 0, NS_V0 = 2 * NS_KB, NS_IMP = NS_V0 + 2 * NS_VB, NS_SEL = NS_IMP + 64 * 128 * 4, NS_END = NS_SEL + 64 * 4 * 4;
constexpr int NS_OUT = NS_END, NS_END2 = NS_OUT + 8 * 8192;
static_assert(NS_END2 <= MISC_OFF, "nsa lds");
struct NsaRow { float m, l; f32x16 o[2]; };
__device__ __forceinline__ void ns_load(const bf16* kb, const bf16* vb, size_t stride, int tid, u32x4& kr, u32x4& vr) {
    const int key = tid >> 3, ch = tid & 7; kr = *(const u32x4*)(kb + (size_t)key * stride + ch * 8); vr = *(const u32x4*)(vb + (size_t)key * stride + ch * 8);
}
__device__ __forceinline__ void ns_store(LAS unsigned char* Kb, LAS unsigned char* Vb, int tid, const u32x4& kr, const u32x4& vr) {
    const int key = tid >> 3, ch = tid & 7;
    *(LAS u32x4*)(Kb + key * NS_KROW + ch * 16) = kr;
    *(LAS u32x4*)(Vb + key * NS_VROW + ch * 16) = vr;
}
__device__ __forceinline__ void ns_qk(LAS unsigned char* Kb, const bf16x8 (&qf)[4], int r, int h2, f32x16 (&sacc)[2]) {
#pragma unroll
    for (int sub = 0; sub < 2; ++sub) { f32x16 a;
#pragma unroll
        for (int i = 0; i < 16; ++i) a[i] = 0.f;
#pragma unroll
        for (int kk = 0; kk < 4; ++kk) { const bf16x8 kf = *(const LAS bf16x8*)(Kb + (32 * sub + r) * NS_KROW + (8 * h2 + 16 * kk) * 2); a = __builtin_amdgcn_mfma_f32_32x32x16_bf16(kf, qf[kk], a, 0, 0, 0); }
        sacc[sub] = a; }
}
enum { NS_CMP = 0, NS_SEL_ = 1, NS_WIN = 2 };
template <int MODE> __device__ __forceinline__ bool ns_valid(int key, int t, bool blk_on) {
    if (MODE == NS_CMP) return 16 * key + 31 <= t;
    if (MODE == NS_SEL_) return blk_on && key <= t;
    return key <= t && key + 511 >= t;
}
template <int MODE>
__device__ __forceinline__ void ns_branch(Frame& F, const bf16* kbase, const bf16* vbase, size_t stride, int tile_lo, int tile_hi, const bf16x8 (&qf)[4], int t, int r, int h2,
                                          const unsigned (&selw)[4], NsaRow& R) {
    LAS unsigned char* L = F.lds;
    R.m = -1e30f; R.l = 0.f;
#pragma unroll
    for (int e = 0; e < 2; ++e)
#pragma unroll
        for (int i = 0; i < 16; ++i) R.o[e][i] = 0.f;
    if (tile_hi <= tile_lo) return;
    u32x4 kr, vr;
    ns_load(kbase + (size_t)tile_lo * 64 * stride, vbase + (size_t)tile_lo * 64 * stride, stride, F.tid, kr, vr);
    __syncthreads();
    ns_store(L + NS_K0, L + NS_V0, F.tid, kr, vr);
    __syncthreads();
    for (int ti = tile_lo; ti < tile_hi; ++ti) {
        const int buf = (ti - tile_lo) & 1;
        if (ti + 1 < tile_hi) ns_load(kbase + (size_t)(ti + 1) * 64 * stride, vbase + (size_t)(ti + 1) * 64 * stride, stride, F.tid, kr, vr);
        LAS unsigned char* Kb = L + NS_K0 + buf * NS_KB; LAS unsigned char* Vb = L + NS_V0 + buf * NS_VB;
        bool blk_on = true;
        if (MODE == NS_SEL_) blk_on = (selw[ti >> 5] >> (ti & 31)) & 1u;
        bool any;
        if (MODE == NS_CMP) any = 16 * (ti * 64) + 31 <= t; else if (MODE == NS_SEL_) any = blk_on && ti * 64 <= t; else any = (ti * 64 <= t) && (ti * 64 + 63 + 511 >= t);
        if (__ballot(any) != 0ull) {
            f32x16 sacc[2];
            ns_qk(Kb, qf, r, h2, sacc);
            bool full;
            { const int tmin = t - (r & 7), tmax = tmin + 7;
              if (MODE == NS_CMP) full = 16 * (ti * 64 + 63) + 31 <= tmin; else if (MODE == NS_SEL_) full = ti * 64 + 63 <= tmin; else full = (ti * 64 + 63 <= tmin) && (ti * 64 + 511 >= tmax); }
            float sc, rs = 0.f;
            if (full) {
                const bool rowon = (MODE != NS_SEL_) || blk_on;
                float m0 = sacc[0][0], m1 = sacc[1][0];
#pragma unroll
                for (int i = 1; i < 16; ++i) { m0 = fmaxf(m0, sacc[0][i]); m1 = fmaxf(m1, sacc[1][i]); }
                float mt = rowon ? fmaxf(m0, m1) : -1e30f;
                mt = fmaxf(mt, __shfl_xor(mt, 32));
                const float mn = fmaxf(R.m, mt); sc = __expf(R.m - mn);
                const float nb = -1.44269504f * (rowon ? mn : 1e30f);
#pragma unroll
                for (int sub = 0; sub < 2; ++sub)
#pragma unroll
                    for (int i = 0; i < 16; ++i) { const float p = __builtin_amdgcn_exp2f(__builtin_fmaf(sacc[sub][i], 1.44269504f, nb)); sacc[sub][i] = p; rs += p; }
                rs += __shfl_xor(rs, 32);
                R.l = R.l * sc + rs; R.m = mn;
            } else {
            float mt = -1e30f;
#pragma unroll
            for (int sub = 0; sub < 2; ++sub)
#pragma unroll
                for (int i = 0; i < 16; ++i) { const int key = ti * 64 + 32 * sub + (i & 3) + 8 * (i >> 2) + 4 * h2; const float sv = ns_valid<MODE>(key, t, blk_on) ? sacc[sub][i] : -1e30f; sacc[sub][i] = sv; mt = fmaxf(mt, sv); }
            mt = fmaxf(mt, __shfl_xor(mt, 32));
            const float mn = fmaxf(R.m, mt); sc = __expf(R.m - mn);
#pragma unroll
            for (int sub = 0; sub < 2; ++sub)
#pragma unroll
                for (int i = 0; i < 16; ++i) { const float sv = sacc[sub][i]; const float p = sv > -1e29f ? __expf(sv - mn) : 0.f; sacc[sub][i] = p; rs += p; }
            rs += __shfl_xor(rs, 32);
            R.l = R.l * sc + rs; R.m = mn;
            }
            if (__ballot(sc != 1.0f) != 0ull) {
#pragma unroll
                for (int e = 0; e < 2; ++e)
#pragma unroll
                    for (int i = 0; i < 16; ++i) R.o[e][i] *= sc; }
#pragma unroll
            for (int sub = 0; sub < 2; ++sub)
#pragma unroll
                for (int s2 = 0; s2 < 2; ++s2) {
                    union { bf16x8 v; unsigned w[4]; } pf;
#pragma unroll
                    for (int j = 0; j < 4; ++j) pf.w[j] = cvt_pk_bf16(sacc[sub][8 * s2 + 2 * j], sacc[sub][8 * s2 + 2 * j + 1]);
#pragma unroll
                    for (int e = 0; e < 2; ++e) {
                        const LAS unsigned char* vp = Vb + (32 * sub + 16 * s2 + 4 * h2 + ((F.lane & 15) >> 2)) * NS_VROW + (32 * e + 16 * ((F.lane >> 4) & 1) + 4 * (F.lane & 3)) * 2;
                        const s16x4 va = __builtin_amdgcn_ds_read_tr16_b64_v4i16((LAS s16x4*)vp), vb = __builtin_amdgcn_ds_read_tr16_b64_v4i16((LAS s16x4*)(vp + 8 * NS_VROW));
                        const bf16x8 vf = {va[0], va[1], va[2], va[3], vb[0], vb[1], vb[2], vb[3]};
                        R.o[e] = __builtin_amdgcn_mfma_f32_32x32x16_bf16(vf, pf.v, R.o[e], 0, 0, 0);
                    }
                }
        }
        if (ti + 1 < tile_hi) ns_store(L + NS_K0 + (buf ^ 1) * NS_KB, L + NS_V0 + (buf ^ 1) * NS_VB, F.tid, kr, vr);
        __syncthreads();
    }
}
__device__ __forceinline__ void ns_importance(Frame& F, const bf16* kbase, int ntiles, const bf16x8 (&qf)[4], int t, int r, int h2, float m, float inv_l) {
    LAS unsigned char* L = F.lds; LAS float* imp = (LAS float*)(L + NS_IMP);
    const int qrow = F.wave * 8 + (r & 7);
    u32x4 kr, vr;
    ns_load(kbase, kbase, 64, F.tid, kr, vr);
    __syncthreads();
    ns_store(L + NS_K0, L + NS_V0, F.tid, kr, vr);
    __syncthreads();
    for (int ti = 0; ti < ntiles; ++ti) {
        const int buf = ti & 1;
        if (ti + 1 < ntiles) ns_load(kbase + (size_t)(ti + 1) * 64 * 64, kbase + (size_t)(ti + 1) * 64 * 64, 64, F.tid, kr, vr);
        LAS unsigned char* Kb = L + NS_K0 + buf * NS_KB;
        f32x16 sacc[2];
        ns_qk(Kb, qf, r, h2, sacc);
#pragma unroll
        for (int sub = 0; sub < 2; ++sub)
#pragma unroll
            for (int g = 0; g < 4; ++g) {
                float p[4];
#pragma unroll
                for (int x = 0; x < 4; ++x) { const int key = ti * 64 + 32 * sub + x + 8 * g + 4 * h2; p[x] = (16 * key + 31 <= t) ? __expf(sacc[sub][4 * g + x] - m) * inv_l : 0.f; }
                float G = (p[0] + p[1]) + (p[2] + p[3]), E = p[3];
                G += __shfl_xor(G, 8); G += __shfl_xor(G, 16); E += __shfl_xor(E, 8); E += __shfl_xor(E, 16);
                const int jj = ti * 16 + 8 * sub + 2 * g + h2;
                if (r < 8) { atomicAdd((float*)(imp + qrow * 128 + jj), G); if (jj + 1 < 128) atomicAdd((float*)(imp + qrow * 128 + jj + 1), E); }
            }
        if (ti + 1 < ntiles) ns_store(L + NS_K0 + (buf ^ 1) * NS_KB, L + NS_V0 + (buf ^ 1) * NS_VB, F.tid, kr, vr);
        __syncthreads();
    }
}
__device__ __forceinline__ void nsa_unit(Frame& F0, int b, int c) {
    Frame F = F0; asm volatile("" : "+v"(F.tid)); F.lane = F.tid & 63;
    const bf16* u = (const bf16*)(F.ws + WS_U); bf16* bo = (bf16*)(F.ws + WS_BO);
    const bf16* kcmp = (const bf16*)(F.ws + WS_KCMP) + (size_t)b * 512 * 64; const bf16* vcmp = (const bf16*)(F.ws + WS_VCMP) + (size_t)b * 512 * 64;
    LAS unsigned char* L = F.lds; LAS float* imp = (LAS float*)(L + NS_IMP); LAS unsigned* selL = (LAS unsigned*)(L + NS_SEL);
    int lane = F.lane; asm volatile("" : "+v"(lane));
    const int r = lane & 31, h2 = lane >> 5, head = r >> 3, ql = r & 7;
    const int t = 64 * c + 8 * F.wave + ql; const size_t row = (size_t)b * S + t;
    const bf16* ub = u + (size_t)b * S * UW;
    bf16x8 qf[4];
#pragma unroll
    for (int kk = 0; kk < 4; ++kk) { const u32x4 w = *(const u32x4*)(u + row * UW + U_NSA + head * 64 + 8 * h2 + 16 * kk); f32x4 a, bb; unpack8(w, a, bb);
        union { bf16x8 v; u32x4 q; } cv; cv.q = pack8(a * 0.125f, bb * 0.125f); qf[kk] = cv.v; }
    const float g_cmp = fsigmoid(ldu(u, row, U_NSA + 640 + head)), g_sel = fsigmoid(ldu(u, row, U_NSA + 644 + head)), g_win = fsigmoid(ldu(u, row, U_NSA + 648 + head));
    unsigned selw[4] = {0xffffffffu, 0xffffffffu, 0xffffffffu, 0xffffffffu};
    NsaRow R;
    const int ncmp_tiles = (4 * c + 3 + 63) >> 6;
    ns_branch<NS_CMP>(F, kcmp, vcmp, 64, 0, ncmp_tiles, qf, t, r, h2, selw, R);
    LAS f32x4* stash = (LAS f32x4*)(L + NS_OUT + F.wave * 8192) + lane;
    { const float inv = R.l > 0.f ? 1.0f / R.l : 0.f; const float gs = g_cmp * inv;
#pragma unroll
      for (int e = 0; e < 2; ++e)
#pragma unroll
        for (int g = 0; g < 4; ++g) stash[(e * 4 + g) * 64] = (f32x4){R.o[e][4 * g] * gs, R.o[e][4 * g + 1] * gs, R.o[e][4 * g + 2] * gs, R.o[e][4 * g + 3] * gs};
      if (c >= 15) {
        for (int i = F.tid; i < 64 * 128; i += NTHR) imp[i] = 0.f;
        __syncthreads();
        ns_importance(F, kcmp, ncmp_tiles, qf, t, r, h2, R.m, inv);
        for (int q8 = 0; q8 < 8; ++q8) { const int qrow = F.wave * 8 + q8;
            float sc0, sc1;
            { const int j0 = lane, j1 = lane + 64;
              const bool f0 = (j0 == 0) || (j0 == c) || (j0 == c - 1), f1 = (j1 == c) || (j1 == c - 1);
              sc0 = f0 ? 1e30f : (j0 <= c ? imp[qrow * 128 + j0] : -1e30f); sc1 = f1 ? 1e30f : (j1 <= c ? imp[qrow * 128 + j1] : -1e30f); }
            unsigned long long lo = 0ull, hi = 0ull;
            for (int it = 0; it < 16; ++it) {
                const float best = wave_max(fmaxf(sc0, sc1));
                const unsigned long long m0 = __ballot(sc0 == best), m1 = __ballot(sc1 == best);
                int idx; if (m0) idx = __builtin_ctzll(m0); else idx = 64 + __builtin_ctzll(m1);
                if (idx < 64) { lo |= 1ull << idx; if (lane == idx) sc0 = -3e38f; } else { hi |= 1ull << (idx - 64); if (lane == idx - 64) sc1 = -3e38f; }
            }
            if (lane == 0) { selL[qrow * 4 + 0] = (unsigned)lo; selL[qrow * 4 + 1] = (unsigned)(lo >> 32); selL[qrow * 4 + 2] = (unsigned)hi; selL[qrow * 4 + 3] = (unsigned)(hi >> 32); }
        }
        LDS_WAIT();
#pragma unroll
        for (int j = 0; j < 4; ++j) selw[j] = selL[(F.wave * 8 + ql) * 4 + j];
      }
    }
    ns_branch<NS_SEL_>(F, ub + U_NSA + 384, ub + U_NSA + 448, UW, 0, c + 1, qf, t, r, h2, selw, R);
    { const float gs = g_sel / R.l;
#pragma unroll
      for (int e = 0; e < 2; ++e)
#pragma unroll
        for (int g = 0; g < 4; ++g) { f32x4 a = stash[(e * 4 + g) * 64]; a += (f32x4){R.o[e][4 * g] * gs, R.o[e][4 * g + 1] * gs, R.o[e][4 * g + 2] * gs, R.o[e][4 * g + 3] * gs}; stash[(e * 4 + g) * 64] = a; } }
    ns_branch<NS_WIN>(F, ub + U_NSA + 512, ub + U_NSA + 576, UW, c >= 8 ? c - 8 : 0, c + 1, qf, t, r, h2, selw, R);
    f32x16 out[2];
    { const float gs = g_win / R.l;
#pragma unroll
      for (int e = 0; e < 2; ++e)
#pragma unroll
        for (int g = 0; g < 4; ++g) { const f32x4 a = stash[(e * 4 + g) * 64];
#pragma unroll
            for (int x = 0; x < 4; ++x) out[e][4 * g + x] = a[x] + R.o[e][4 * g + x] * gs; } }
#pragma unroll
    for (int e = 0; e < 2; ++e)
#pragma unroll
        for (int g = 0; g < 4; ++g) { u32x2 w; w.x = cvt_pk_bf16(out[e][4 * g], out[e][4 * g + 1]); w.y = cvt_pk_bf16(out[e][4 * g + 2], out[e][4 * g + 3]);
            *(u32x2*)(bo + row * 1024 + head * 64 + 32 * e + 8 * g + 4 * h2) = w; }
}

__device__ __forceinline__ void cmp2_item(Frame& F, int L, int item) {
    int lane = F.lane; asm volatile("" : "+v"(lane));
    const int kv = item & 1, it = (item >> 1) & 15, b = item >> 5, r32 = lane & 31, hh = lane >> 5;
    const bf16* w2T = (const bf16*)(F.ws + WS_CW2 + (size_t)L * 65536) + kv * 64 * 128;
    const bf16* hid = (const bf16*)(F.ws + WS_CMPH) + ((size_t)(b * 512 + 32 * it)) * 256 + kv * 128;
    bf16* outp = (bf16*)(F.ws + (kv ? WS_VCMP : WS_KCMP)) + ((size_t)(b * 512 + 32 * it + r32)) * 64;
    const bool live = (32 * it + r32) < NCMP;
#pragma unroll
    for (int et = 0; et < 2; ++et) { f32x16 acc = zero16();
#pragma unroll
        for (int ks = 0; ks < 8; ++ks) acc = mma32(frag_g(w2T, 128, 32 * et, 16 * ks, lane), frag_g(hid, 256, 0, 16 * ks, lane), acc);
#pragma unroll
        for (int g = 0; g < 4; ++g) { u32x2 w; w.x = live ? cvt_pk_bf16(acc[4 * g], acc[4 * g + 1]) : 0u; w.y = live ? cvt_pk_bf16(acc[4 * g + 2], acc[4 * g + 3]) : 0u;
            *(u32x2*)(outp + 32 * et + 8 * g + 4 * hh) = w; } }
}
#ifdef SK_RWM1
#define RWM1(x)
#else
#define RWM1(x) x
#endif
#ifdef SK_RWM3
#define RWM3(x)
#else
#define RWM3(x) x
#endif
#ifdef SK_RWSC
#define RWSC(x)
#else
#define RWSC(x) x
#endif
__device__ __forceinline__ void phase_m1(Frame& F0, int L, bf16* hgS, bf16* rtS) {
    Frame F = F0; asm volatile("" : "+v"(F.tid)); F.lane = F.tid & 63;
    if (F.bx < 32) { LAS float* c1l = (LAS float*)(F.lds + RSTD_OFF + 1024);
      if (F.tid < 256) { const float* cp = (const float*)(F.ws + WS_CW2 + (size_t)L * 65536 + 32768) + (F.tid >> 7) * 32 * 128 + (F.tid & 127); float a = 0.f;
          for (int jq = 0; jq < 32; ++jq) a += cp[jq * 128];
          c1l[F.tid] = a; }
      __syncthreads(); }
    { CmpSched Sd{(const char*)(F.ws + WS_U), (const char*)(F.ws + WS_CW1 + (size_t)L * MiB), F.bx};
      EpiCmp E{(bf16*)(F.ws + WS_CMPH)};
      pg8::gemm_phase<EpiCmp, CmpSched, true>(F.lds + RING_OFF, Sd, E, (unsigned)(UW * 2), 128u); }
    LAS unsigned char* W = F.lds + F.wave * WREG;
    const int gw = F.bx * NWAVES + F.wave, NGW = F.G * NWAVES;
    for (int it = gw; it < 3 * 32 * NCH; it += NGW) { const int type = it % 3, q = it / 3, bh = q / NCH, n = q % NCH;
        if (type == 0) hgrn_chunk<false>(F, L, bh, n, W, hgS, (float*)(F.ws + WS_HGD)); else if (type == 1) ret_chunk<false>(F, L, bh, n, W, rtS); else { RWM1(rwkv_chunk<false>(F, L, bh, n, W)); } }
}
__device__ __forceinline__ void phase_scan(Frame& F0, int L, bf16* hgS, bf16* rtS) {
    Frame F = F0; asm volatile("" : "+v"(F.tid)); F.lane = F.tid & 63;
    if (F.tid < 256) {
        if (F.bx < 64) glin_scan_task(hgS, (const float*)(F.ws + WS_HGD), 0.f, F.bx >> 1, F.bx & 1, F.tid);
        else if (F.bx < 128) { const int k = F.bx - 64, h = (k >> 1) & 3; const float g = 1.0f - exp2f(-5.0f - (float)h); glin_scan_task(rtS, nullptr, exp2f(32.0f * __log2f(g)), k >> 1, k & 1, F.tid); }
    } else if (F.wave == 4) { if (F.bx < 64) { RWSC(rwkv_scan_task(F, F.bx >> 1, F.bx & 1)); } }
    else { for (int item = F.bx * 3 + (F.wave - 5); item < 256; item += F.G * 3) cmp2_item(F, L, item); }
}
__device__ __forceinline__ void phase_m3(Frame& F0, int L, bf16* hgS, bf16* rtS) {
    Frame F = F0; asm volatile("" : "+v"(F.tid)); F.lane = F.tid & 63;
    LAS unsigned char* W = F.lds + F.wave * WREG;
    const int gw = F.bx * NWAVES + F.wave, NGW = F.G * NWAVES;
    for (int it = gw; it < REP_ITEMS * 3 * 32 * NCH; it += NGW) { const int type = it % 3, q = (it / 3) % (32 * NCH), bh = q / NCH, n = q % NCH;
        if (type == 0) hgrn_chunk<true>(F, L, bh, n, W, hgS, nullptr); else if (type == 1) ret_chunk<true>(F, L, bh, n, W, rtS); else { RWM3(rwkv_chunk<true>(F, L, bh, n, W)); } }
    __syncthreads();
#ifndef SK_NSA
    for (int p = F.bx; p < REP_NSA * 512; p += F.G) { const int b = (p >> 6) & 7, cc = p & 63; nsa_unit(F, b, 127 - cc); nsa_unit(F, b, cc); }
#endif
}

__device__ __forceinline__ void phase_pconv(Frame& F0, int L) {
    Frame F = F0; asm volatile("" : "+v"(F.tid)); F.lane = F.tid & 63;
    const float* p = F.in[I_P] + (size_t)L * T * PLE; bf16* pbf = (bf16*)(F.ws + WS_PB);
    for (int r = F.bx * NWAVES + F.wave; r < T; r += F.G * NWAVES) { const f32x4 v = *((const f32x4*)(p + (size_t)r * PLE) + F.lane); u32x2 w; w.x = cvt_pk_bf16(v[0], v[1]); w.y = cvt_pk_bf16(v[2], v[3]); *((u32x2*)(pbf + (size_t)r * PLE) + F.lane) = w; }
}
__device__ __forceinline__ void phase_final(Frame& F0, const float* ssf, const bf16* hb) {
    Frame F = F0; asm volatile("" : "+v"(F.tid)); F.lane = F.tid & 63;
    const float* g = F.in[I_NORM_FINAL]; const int gw = F.bx * NWAVES + F.wave, NGW = F.G * NWAVES;
    for (int r = gw; r < T; r += NGW) { const float rs = __builtin_amdgcn_rsqf(ss_row(ssf, r) * (1.0f / D) + EPS); const u32x4* hr = (const u32x4*)(hb + (size_t)r * D) + F.lane; f32x4* orow = (f32x4*)(F.out + (size_t)r * D);
#pragma unroll
        for (int j = 0; j < 2; ++j) { f32x4 a, b; unpack8(hr[64 * j], a, b); const f32x4 g0 = *((const f32x4*)g + 2 * (F.lane + 64 * j)), g1 = *((const f32x4*)g + 2 * (F.lane + 64 * j) + 1);
            orow[2 * (F.lane + 64 * j)] = a * rs * g0; orow[2 * (F.lane + 64 * j) + 1] = b * rs * g1; } }
}

constexpr int PH_PER_LAYER = 9, N_PHASES = 1 + NL * PH_PER_LAYER + 1;
__global__ void __launch_bounds__(NTHR, 2) mega_fwd(Args args) {
    extern __shared__ __attribute__((aligned(16))) unsigned char lds_raw[];
    Frame F; F.lds = (LAS unsigned char*)lds_raw; F.tid = threadIdx.x; F.lane = F.tid & 63; F.wave = __builtin_amdgcn_readfirstlane(F.tid >> 6); F.G = gridDim.x; F.bx = blockIdx.x;
    F.in = args.in; F.out = args.out; F.ws = args.ws;
    volatile LAS unsigned* MISC = (volatile LAS unsigned*)(F.lds + MISC_OFF);
    if (F.tid < 32) MISC[F.tid] = 0u;
    __syncthreads();
    unsigned* ctl = (unsigned*)(F.ws + WS_CTL);
    XcdBarrier bar; bar.bar = ctl + CW_BAR; bar.x = 0; bar.st = nullptr;
    if (MK_N_LAUNCHES == 1) bar = xcd_barrier_post(ctl + CW_BAR, MISC + 8);
    const int lo = args.ph_lo, hi = args.ph_hi;
#define IN(k) (lo <= (k) && (k) < hi)
#define REPS(k) (((k) == REP_PHASE || (k) == REP_PHASE + 9) ? 2 : 1)
#define SEAM(k) do { if (IN(k) && IN((k) + 1)) xcd_barrier(bar); } while (0)
    float* ssb = F.out;
    LAS unsigned char* ring = F.lds + RING_OFF;

    #ifndef SK_PRO
    for (int rep = 0; rep < ((REP_PHASE == 0) ? 2 : 1); ++rep) if (IN(0)) { if (rep) xcd_barrier(bar); phase_prologue(F); }
#endif
    SEAM(0);

    for (int L = 0; L < NL; ++L) {
        asm volatile("" : "+v"(F.tid)); F.lane = F.tid & 63;
        const int pb = 1 + L * PH_PER_LAYER;
        unsigned char* wl = F.ws + WS_W + (size_t)L * WL_STRIDE;
        bf16* hb_cur = (bf16*)(F.ws + ((L & 1) ? WS_HBB : WS_HBA)); bf16* hb_oth = (bf16*)(F.ws + ((L & 1) ? WS_HBA : WS_HBB));
        const float* ss_mix = ssb + (size_t)(3 * L) * T * 16; float* ss_ffn = ssb + (size_t)(3 * L + 1) * T * 16; float* ss_ple = ssb + (size_t)(3 * L + 2) * T * 16; float* ss_next = (L == NL - 1) ? (float*)(F.ws + WS_SSF) : ssb + (size_t)(3 * L + 3) * T * 16;
#ifndef SK_G1
        for (int rep = 0; rep < REPS(pb + 0); ++rep) if (IN(pb + 0)) { PlainSched Sd{(const char*)hb_cur, (const char*)(wl + WL_IN), D * 2, D * 2, D / 64, T / 256, UW / 256, F.G, F.bx};
            EpiScaleBf16 E{(bf16*)(F.ws + WS_U), UW, ss_mix}; pg8::gemm_phase(ring, Sd, E); }
#endif
        SEAM(pb + 0);
        bf16* hgS = hb_oth; bf16* rtS = hb_oth + (size_t)32 * NCH * 4096;
        for (int rep = 0; rep < REPS(pb + 1); ++rep) if (IN(pb + 1)) { if (rep) xcd_barrier(bar); phase_m1(F, L, hgS, rtS); }
        SEAM(pb + 1);
#ifndef EXP_NOSCAN
        if (IN(pb + 2)) phase_scan(F, L, hgS, rtS);
#endif
        SEAM(pb + 2);
        if (IN(pb + 3)) phase_m3(F, L, hgS, rtS);
        SEAM(pb + 3);
#ifndef SK_G2
        for (int rep = 0; rep < REPS(pb + 4); ++rep) if (IN(pb + 4)) { PairSched Sd{(const char*)hb_cur, (const char*)(wl + WL_G), D * 2, D * 2, D / 64, (size_t)D * D * 2,
                                        (const char*)(F.ws + WS_BO), (const char*)(wl + WL_B), 1024 * 2, MW * 2, MW / 64, (size_t)MW * 2, (size_t)D * MW * 2, 4, T / 256, D / 256, F.G, F.bx};
            u32x4* scr = (u32x4*)(F.ws + WS_SCR + (size_t)F.bx * 262144);
            EpiMerge E{scr, scr + 8192, (bf16*)(F.ws + WS_MERGED), ss_mix, F.in[I_BGATE] + (size_t)L * 4 * D, 4}; pg8::gemm_phase(ring, Sd, E); }
#endif
        SEAM(pb + 4);
#ifndef SK_G3
        if (IN(pb + 5)) phase_pconv(F, L);
        if (IN(pb + 5)) { PlainSched Sd{(const char*)(F.ws + WS_MERGED), (const char*)(wl + WL_OUT), D * 2, D * 2, D / 64, T / 256, D / 256, F.G, F.bx};
            EpiResidual E{(L == 0) ? F.in[I_X] : nullptr, hb_cur, ss_ffn}; pg8::gemm_phase(ring, Sd, E); }
#endif
        SEAM(pb + 5);
#ifndef SK_G4
        for (int rep = 0; rep < REPS(pb + 6); ++rep) if (IN(pb + 6)) { PlainSched Sd{(const char*)hb_cur, (const char*)(wl + WL_FF), D * 2, D * 2, D / 64, T / 256, (2 * DFF) / 256, F.G, F.bx};
            EpiSwiGLU E{(bf16*)(F.ws + WS_FFH), ss_ffn}; pg8::gemm_phase(ring, Sd, E); }
#endif
        SEAM(pb + 6);
#ifndef SK_G5
        if (IN(pb + 7)) { PlainSched Sd{(const char*)(F.ws + WS_FFH), (const char*)(wl + WL_DN), DFF * 2, DFF * 2, DFF / 64, T / 256, D / 256, F.G, F.bx};
            EpiResidual E{nullptr, hb_cur, ss_ple}; pg8::gemm_phase(ring, Sd, E); }
#endif
        SEAM(pb + 7);
#ifndef SK_G6
        if (IN(pb + 8)) { PairSched Sd{(const char*)hb_cur, (const char*)(wl + WL_PG), D * 2, D * 2, D / 64, 0,
                                        (const char*)(F.ws + WS_PB), (const char*)(wl + WL_PP), PLE * 2, PLE * 2, PLE / 64, 0, 0, 1, T / 256, D / 256, F.G, F.bx};
            u32x4* scr = (u32x4*)(F.ws + WS_SCR + (size_t)F.bx * 262144);
            EpiPle E{scr, hb_cur, hb_oth, ss_ple, ss_next}; pg8::gemm_phase(ring, Sd, E); }
#endif
        SEAM(pb + 8);
    }
#ifndef SK_FIN
    if (IN(N_PHASES - 1)) phase_final(F, (const float*)(F.ws + WS_SSF), (const bf16*)(F.ws + ((NL & 1) ? WS_HBB : WS_HBA)));
#endif
#undef IN
#undef SEAM
}

extern "C" void kernel_launch(void* const* d_in, const int* in_sizes, int n_in, void* d_out, int out_size, void* d_ws, size_t ws_size, hipStream_t stream) {
    static int grid = 0;
    if (grid == 0) {
        if (n_in != 37 || in_sizes[0] != T * D || out_size != T * D || ws_size < WS_END) { fprintf(stderr, "kernel_launch: unexpected shapes (n_in %d, ws %zu)\n", n_in, ws_size); grid = -1; return; }
        int dev = 0, cus = 0, per_cu = 0;
        if (hipGetDevice(&dev) != hipSuccess || hipDeviceGetAttribute(&cus, hipDeviceAttributeMultiprocessorCount, dev) != hipSuccess) { grid = -1; return; }
        if (hipFuncSetAttribute((const void*)mega_fwd, hipFuncAttributeMaxDynamicSharedMemorySize, LDS_BYTES) != hipSuccess) { fprintf(stderr, "kernel_launch: hipFuncSetAttribute failed\n"); grid = -1; return; }
        if (hipOccupancyMaxActiveBlocksPerMultiprocessor(&per_cu, (const void*)mega_fwd, NTHR, LDS_BYTES) != hipSuccess || per_cu < 1) { fprintf(stderr, "kernel_launch: occupancy query says %d\n", per_cu); }
        (void)hipGetLastError();
        grid = cus;
    }
    if (grid < 0) return;
    hipMemsetAsync((char*)d_ws + WS_CTL, 0, CTL_BYTES, stream);
    Args a{};
    for (int i = 0; i < 37; ++i) a.in[i] = (const float*)d_in[i];
    a.out = (float*)d_out; a.ws = (unsigned char*)d_ws;
    if (MK_N_LAUNCHES == 1) { a.ph_lo = 0; a.ph_hi = N_PHASES; hipLaunchKernelGGL(mega_fwd, dim3(grid), dim3(NTHR), LDS_BYTES, stream, a); }
    else for (int p = 0; p < N_PHASES; ++p) { a.ph_lo = p; a.ph_hi = p + 1; hipLaunchKernelGGL(mega_fwd, dim3(grid), dim3(NTHR), LDS_BYTES, stream, a); }
}
```

```cpp
#include <hip/hip_runtime.h>
#include <cstdio>
#include <cstdint>

#ifndef REP_ITEMS
#define REP_ITEMS 1
#endif
#ifndef REP_NSA
#define REP_NSA 1
#endif
#ifndef REP_PHASE
#define REP_PHASE (-1)
#endif
#ifndef MK_N_LAUNCHES
#define MK_N_LAUNCHES 1
#endif

#define LAS __attribute__((address_space(3)))
#define GAS __attribute__((address_space(1)))
typedef unsigned short bf16;
typedef short bf16x8 __attribute__((ext_vector_type(8)));
typedef float f32x4 __attribute__((ext_vector_type(4)));
typedef float f32x16 __attribute__((ext_vector_type(16)));
typedef unsigned u32x4 __attribute__((ext_vector_type(4)));
typedef unsigned u32x2 __attribute__((ext_vector_type(2)));
typedef short s16x4 __attribute__((ext_vector_type(4)));

constexpr int D = 1024, NB = 8, S = 8192, T = NB * S, NL = 2;
constexpr int NH = 4, HD = 64, MW = 256, DFF = 2816, PLE = 256;
constexpr int DIN = 3724, UW = 3840;
constexpr int U_NSA = 0, U_HG = 768, U_RT = 1792, U_RW = 2816;
constexpr int NCMP = 511, NSEL = 128;
constexpr float EPS = 1e-6f;

constexpr size_t MiB = 1u << 20;
constexpr size_t WS_CTL = 0, CTL_BYTES = 4 * MiB;
constexpr size_t WS_W = 4 * MiB;
constexpr size_t WL_IN = 0, WL_G = 8 * MiB, WL_B = 16 * MiB, WL_OUT = 18 * MiB, WL_FF = 20 * MiB, WL_DN = 31 * MiB, WL_PG = 37 * MiB, WL_PP = 39 * MiB, WL_STRIDE = 40 * MiB;
constexpr size_t WS_MISC = 84 * MiB;
constexpr size_t WS_ROPE = WS_MISC, WS_KCMP = WS_MISC + 2 * MiB, WS_VCMP = WS_MISC + 2 * MiB + 512 * 1024, WS_RWUP = WS_MISC + 3 * MiB;
constexpr size_t WS_HBA = 88 * MiB, WS_HBB = 216 * MiB;
constexpr size_t WS_BO = 344 * MiB;
constexpr size_t WS_U = 472 * MiB;
constexpr size_t WS_MERGED = WS_U, WS_SCR = WS_U + 416 * MiB;
constexpr size_t WS_FFH = WS_U;
constexpr size_t WS_PB = WS_U + 352 * MiB;
constexpr size_t WS_RWN = 952 * MiB;
constexpr size_t WS_HGD = 1016 * MiB;
constexpr size_t WS_RWM = WS_BO;
constexpr size_t WS_CMPH = 1018 * MiB;
constexpr size_t WS_CW1 = 1020 * MiB;
constexpr size_t WS_CW2 = 1022 * MiB;
constexpr size_t WS_SSF = 1016 * MiB;
constexpr size_t DO_T = 28 * MiB, DO_HGS = 44 * MiB, DO_RTS = 108 * MiB, DO_RWS = 172 * MiB;
constexpr size_t WS_END = 1024 * MiB;
constexpr int CH = 32, NCH = S / CH;
constexpr int CW_BAR = 4096;
constexpr int CW_C1 = 16384;
constexpr int NSS = 7;

#define LDS_WAIT() asm volatile("s_waitcnt lgkmcnt(0)" ::: "memory")
#define VM_WAIT() asm volatile("s_waitcnt vmcnt(0)" ::: "memory")
typedef __bf16 hbf16x2 __attribute__((ext_vector_type(2)));
typedef float f32x2v __attribute__((ext_vector_type(2)));
__device__ __forceinline__ unsigned cvt_pk_bf16(float lo, float hi) { const f32x2v v = {lo, hi}; const hbf16x2 b = __builtin_convertvector(v, hbf16x2); return __builtin_bit_cast(unsigned, b); }
__device__ __forceinline__ float bf2f(unsigned short b) { return __builtin_bit_cast(float, ((unsigned)b) << 16); }
__device__ __forceinline__ float bflo(unsigned w) { return __builtin_bit_cast(float, w << 16); }
__device__ __forceinline__ float bfhi(unsigned w) { return __builtin_bit_cast(float, w & 0xffff0000u); }
__device__ __forceinline__ float fsigmoid(float z) { return __builtin_amdgcn_rcpf(1.0f + __builtin_amdgcn_exp2f(-1.44269504f * z)); }
__device__ __forceinline__ float fsilu(float z) { return z * fsigmoid(z); }
__device__ __forceinline__ float wave_sum(float v) {
#pragma unroll
    for (int o = 1; o < 64; o <<= 1) v += __shfl_xor(v, o);
    return v;
}
__device__ __forceinline__ float wave_max(float v) {
#pragma unroll
    for (int o = 1; o < 64; o <<= 1) v = fmaxf(v, __shfl_xor(v, o));
    return v;
}

#define XB_TMO      128
#define XB_XCNT(j)  (256  + 64 * (j))
#define XB_XSUB(j)  (1280 + 64 * (j))
#define XB_XGEN(j)  (2304 + 64 * (j))
#define XB_TOP      3328
#define XB_TOPGEN   3392
#define XCD_BAR_WORDS 3456
#define XB_SPIN_CAP (1u << 24)
__device__ __forceinline__ unsigned xb_ld(unsigned* p)              { return __hip_atomic_load(p, __ATOMIC_RELAXED, __HIP_MEMORY_SCOPE_AGENT); }
__device__ __forceinline__ unsigned xb_add(unsigned* p, unsigned v) { return __hip_atomic_fetch_add(p, v, __ATOMIC_RELAXED, __HIP_MEMORY_SCOPE_AGENT); }
__device__ __forceinline__ unsigned xb_xcc_id() { return (unsigned)__builtin_amdgcn_s_getreg((3 << 11) | 20) & 0xFu; }
#define XB_SPIN(cond, bar) do { unsigned _sp = 0; while (cond) { __builtin_amdgcn_s_sleep(1); \
    if ((++_sp & 255u) == 0u) { if (xb_ld(&(bar)[XB_TMO])) break; if (_sp > XB_SPIN_CAP) { atomicAdd(&(bar)[XB_TMO], 1u); break; } } } } while (0)
struct XcdBarrier { unsigned* bar; unsigned x; volatile LAS unsigned* st; };
__device__ __forceinline__ XcdBarrier xcd_barrier_post(unsigned* bar, volatile LAS unsigned* st) {
    XcdBarrier b; b.bar = bar; b.x = xb_xcc_id(); b.st = st;
    if (threadIdx.x == 0) (void)xb_add(&bar[XB_XCNT(b.x)], 1u);
    return b;
}
__device__ __forceinline__ void xcd_barrier_complete(unsigned* bar, unsigned x, unsigned& nloc, unsigned& nx) {
    const unsigned G = gridDim.x * gridDim.y * gridDim.z;
    unsigned sum, cnt, mine, sp = 0u;
    for (;;) {
        sum = 0u; cnt = 0u; mine = 0u;
#pragma unroll
        for (unsigned j = 0; j < 16; ++j) { const unsigned c = xb_ld(&bar[XB_XCNT(j)]); sum += c; cnt += (c > 0u) ? 1u : 0u; mine = (j == x) ? c : mine; }
        if (sum == G) break;
        __builtin_amdgcn_s_sleep(1);
        if ((++sp & 255u) == 0u) { if (xb_ld(&bar[XB_TMO])) break; if (sp > XB_SPIN_CAP) { atomicAdd(&bar[XB_TMO], 1u); break; } }
    }
    nloc = mine > 0u ? mine : 1u; nx = cnt > 0u ? cnt : 1u;
}
__device__ __forceinline__ void xcd_barrier(const XcdBarrier& b) {
    asm volatile("s_waitcnt vmcnt(0)" ::: "memory");
    __syncthreads();
    if (threadIdx.x == 0) {
        unsigned* bar = b.bar;
        __builtin_amdgcn_s_waitcnt(0);
        unsigned nloc = b.st[0], nx = b.st[1];
        if (nloc == 0u) { xcd_barrier_complete(bar, b.x, nloc, nx); b.st[0] = nloc; b.st[1] = nx; }
        const unsigned old = xb_add(&bar[XB_XSUB(b.x)], 1u);
        const unsigned gen = old / nloc;
        if (old + 1u == (gen + 1u) * nloc) {
            __builtin_amdgcn_fence(__ATOMIC_RELEASE, "agent");
            asm volatile("s_waitcnt vmcnt(0)" ::: "memory");
            const unsigned og = xb_add(&bar[XB_TOP], 1u);
            const unsigned tg = og / nx;
            if (og + 1u == (tg + 1u) * nx) xb_add(&bar[XB_TOPGEN], 1u);
            else XB_SPIN(xb_ld(&bar[XB_TOPGEN]) == tg, bar);
            __builtin_amdgcn_fence(__ATOMIC_ACQUIRE, "agent");
            xb_add(&bar[XB_XGEN(b.x)], 1u);
            asm volatile("s_waitcnt vmcnt(0)" ::: "memory");
        } else {
            XB_SPIN(xb_ld(&bar[XB_XGEN(b.x)]) == gen, bar);
            __builtin_amdgcn_fence(__ATOMIC_ACQUIRE, "agent");
            asm volatile("s_waitcnt vmcnt(0)" ::: "memory");
        }
    }
    __syncthreads();
}

namespace pg8 {
constexpr int BM = 256, BK = 64, HALF = 128, HTB = HALF * BK * 2, STAGE_BYTES = 8 * HTB, NXCD = 8, WGM = 8;
__host__ __device__ __forceinline__ int lds_byte(int r, int c) { const int st = (r >> 4) * 2 + (c >> 5), rr = r & 15, cc = c & 31, ob = rr * 64 + cc * 2; return st * 1024 + (ob ^ (((ob >> 9) & 1) << 5)); }
__host__ __device__ __forceinline__ void stage_rc(int b, int& R, int& C) { const int st = b / 1024, sb = b % 1024, swz = sb ^ (((sb >> 9) & 1) << 5); R = (st >> 1) * 16 + swz / 64; C = (st & 1) * 32 + (swz % 64) / 2; }
__host__ __device__ __forceinline__ int perm32(int rho) { const int n = rho >> 4, i = rho & 15; return 8 * (i >> 2) + 4 * n + (i & 3); }

struct GU { const char* A; const char* B; unsigned lda, ldb; int nt; int pm, pn, kind, mi; };

__device__ __forceinline__ bool tile_of(int L, int nM, int nN, int& pm, int& pn) {
    const int nwg = nM * nN; if (L >= nwg) return false;
    int wgid = L; { const int q = nwg / NXCD, r = nwg % NXCD, xcd = wgid % NXCD, off = wgid / NXCD; wgid = (xcd < r ? xcd * (q + 1) : r * (q + 1) + (xcd - r) * q) + off; }
    const int nig = WGM * nN, gid = wgid / nig, fm = gid * WGM, gsz = (nM - fm) < WGM ? (nM - fm) : WGM;
    pm = fm + ((wgid % nig) % gsz); pn = (wgid % nig) / gsz; return true;
}

template <class Epi, class Sched, bool AX = false>
__device__ __forceinline__ void gemm_phase(LAS unsigned char* lds, const Sched& S, const Epi& E, unsigned ax_kstep = 0, unsigned ax_half = 0) {
    int tid = threadIdx.x; asm volatile("" : "+v"(tid));
    const int wid = __builtin_amdgcn_readfirstlane(tid >> 6), lane = tid & 63, wr = wid >> 2, wc = wid & 3, fr = lane & 15, fq = lane >> 4;
    unsigned RA[2], RB[2], C2[2];
#pragma unroll
    for (int i = 0; i < 2; ++i) { int R, C; stage_rc(tid * 16 + i * 8192, R, C); RA[i] = (unsigned)R; RB[i] = (unsigned)((R & ~31) + perm32(R & 31)); C2[i] = (unsigned)C * 2u; }
    const size_t kstep = (size_t)(BK * 2);
    const size_t kstepA = AX ? (size_t)ax_kstep : kstep;
#define PG8_HSA(ld) (AX ? (size_t)ax_half : (size_t)HALF * (ld))
    const unsigned ldsw = (unsigned)wid * 1024u;
    const int aoff = lds_byte(wr * 64 + fr, fq * 8), boff = lds_byte(wc * 32 + fr, fq * 8);
#define PG8_SA(b, h) (((b) * 2 + (h)) * HTB)
#define PG8_SB(b, h) ((4 + (b) * 2 + (h)) * HTB)
#define PG8_STAGE(bufoff, gbase, ld, RR) do { _Pragma("unroll") for (int _i = 0; _i < 2; ++_i) \
        __builtin_amdgcn_global_load_lds((const unsigned*)((const char*)(gbase) + (RR[_i] * (ld) + C2[_i])), (LAS unsigned*)(lds + (bufoff) + ldsw + _i * 8192), 16, 0, 0); } while (0)
#define PG8_LDA(dst, b, h) do { _Pragma("unroll") for (int m = 0; m < 4; ++m) _Pragma("unroll") for (int k = 0; k < 2; ++k) dst[m][k] = *(const LAS bf16x8*)(lds + PG8_SA(b, h) + aoff + m * 2048 + k * 1024); } while (0)
#define PG8_LDB(dst, b, h) do { _Pragma("unroll") for (int n = 0; n < 2; ++n) _Pragma("unroll") for (int k = 0; k < 2; ++k) dst[n][k] = *(const LAS bf16x8*)(lds + PG8_SB(b, h) + boff + n * 2048 + k * 1024); } while (0)
#define PG8_MMA(ai, bj, At, Bt) do { __builtin_amdgcn_s_setprio(1); _Pragma("unroll") for (int m = 0; m < 4; ++m) _Pragma("unroll") for (int n = 0; n < 2; ++n) _Pragma("unroll") for (int k = 0; k < 2; ++k) \
        acc[ai][bj][m][n] = __builtin_amdgcn_mfma_f32_16x16x32_bf16(Bt[n][k], At[m][k], acc[ai][bj][m][n], 0, 0, 0); __builtin_amdgcn_s_setprio(0); } while (0)
#define PG8_WAIT_V(n) asm volatile("s_waitcnt vmcnt(" #n ")" ::: "memory")
#define PG8_WAIT_L(n) asm volatile("s_waitcnt lgkmcnt(" #n ")" ::: "memory")
#define PG8_BAR __builtin_amdgcn_s_barrier()
#define PG8_SCHED __builtin_amdgcn_sched_barrier(0)
    GU cur, nxt; int ui = 0;
    if (!S.next(0, cur)) return;
    f32x4 acc[2][2][4][2];
#pragma unroll
    for (int a = 0; a < 2; ++a)
#pragma unroll
        for (int b = 0; b < 2; ++b)
#pragma unroll
            for (int m = 0; m < 4; ++m)
#pragma unroll
                for (int n = 0; n < 2; ++n) acc[a][b][m][n] = (f32x4){0.f, 0.f, 0.f, 0.f};
    bf16x8 At[4][2], B0[2][2], B1[2][2];
    const char* cA = cur.A; const char* cB = cur.B; unsigned clda = cur.lda, cldb = cur.ldb;
    PG8_STAGE(PG8_SB(0, 0), cB, cldb, RB); PG8_STAGE(PG8_SB(0, 1), cB + (size_t)HALF * cldb, cldb, RB); PG8_STAGE(PG8_SA(0, 0), cA, clda, RA); PG8_STAGE(PG8_SA(0, 1), cA + PG8_HSA(clda), clda, RA);
    if (wr == 1) PG8_BAR;
    PG8_WAIT_V(2); PG8_BAR;
    PG8_STAGE(PG8_SB(1, 0), cB + kstep, cldb, RB); PG8_STAGE(PG8_SA(1, 0), cA + kstepA, clda, RA); PG8_STAGE(PG8_SB(1, 1), cB + (size_t)HALF * cldb + kstep, cldb, RB);
    PG8_WAIT_V(6); PG8_BAR;
    for (;;) {
        const bool has_next = S.next(ui + 1, nxt);
        const char* nA = has_next ? nxt.A : cA; const char* nB = has_next ? nxt.B : cB;
        const unsigned nlda = has_next ? nxt.lda : clda, nldb = has_next ? nxt.ldb : cldb;
        const int nt = cur.nt;
        for (int t = 0; t < nt; t += 2) {
            const bool last = (t == nt - 2);
            const char* a1 = cA + (size_t)(t + 1) * kstepA;
            const char* a2 = last ? nA : cA + (size_t)(t + 2) * kstepA; const char* b2 = last ? nB : cB + (size_t)(t + 2) * kstep;
            const unsigned lda2 = last ? nlda : clda, ldb2 = last ? nldb : cldb;
            const char* a3 = a2 + kstepA; const char* b3 = b2 + kstep;
            PG8_LDB(B0, 0, 0); PG8_LDB(B1, 0, 1); PG8_SCHED; PG8_LDA(At, 0, 0); PG8_STAGE(PG8_SA(1, 1), a1 + PG8_HSA(clda), clda, RA);
            PG8_WAIT_V(8); PG8_WAIT_L(0); PG8_BAR; PG8_MMA(0, 0, At, B0); PG8_MMA(0, 1, At, B1); PG8_BAR; PG8_SCHED;
            PG8_LDA(At, 0, 1); PG8_STAGE(PG8_SB(0, 0), b2, ldb2, RB); PG8_STAGE(PG8_SB(0, 1), b2 + (size_t)HALF * ldb2, ldb2, RB); PG8_STAGE(PG8_SA(0, 0), a2, lda2, RA);
            PG8_WAIT_V(8); PG8_WAIT_L(0); PG8_BAR; PG8_MMA(1, 0, At, B0); PG8_MMA(1, 1, At, B1); PG8_BAR; PG8_SCHED;
            PG8_LDB(B0, 1, 0); PG8_LDB(B1, 1, 1); PG8_SCHED; PG8_LDA(At, 1, 0); PG8_STAGE(PG8_SA(0, 1), a2 + PG8_HSA(lda2), lda2, RA);
            PG8_WAIT_V(8); PG8_WAIT_L(0); PG8_BAR; PG8_MMA(0, 0, At, B0); PG8_MMA(0, 1, At, B1); PG8_BAR; PG8_SCHED;
            PG8_LDA(At, 1, 1); PG8_STAGE(PG8_SB(1, 0), b3, ldb2, RB); PG8_STAGE(PG8_SB(1, 1), b3 + (size_t)HALF * ldb2, ldb2, RB); PG8_STAGE(PG8_SA(1, 0), a3, lda2, RA);
            PG8_WAIT_V(8); PG8_WAIT_L(0); PG8_BAR; PG8_MMA(1, 0, At, B0); PG8_MMA(1, 1, At, B1); PG8_BAR; PG8_SCHED;
        }
        if (wr == 0) PG8_BAR;
        E(acc, cur, wr, wc, fr, fq);
        if (!has_next) break;
#pragma unroll
        for (int a = 0; a < 2; ++a)
#pragma unroll
            for (int b = 0; b < 2; ++b)
#pragma unroll
                for (int m = 0; m < 4; ++m)
#pragma unroll
                    for (int n = 0; n < 2; ++n) acc[a][b][m][n] = (f32x4){0.f, 0.f, 0.f, 0.f};
        cur = nxt; cA = nA; cB = nB; clda = nlda; cldb = nldb; ++ui;
        if (wr == 1) PG8_BAR;
    }
    PG8_WAIT_V(0);
    PG8_BAR;
#undef PG8_SA
#undef PG8_HSA
#undef PG8_SB
#undef PG8_STAGE
#undef PG8_LDA
#undef PG8_LDB
#undef PG8_MMA
#undef PG8_WAIT_V
#undef PG8_WAIT_L
#undef PG8_BAR
#undef PG8_SCHED
}
}
using pg8::GU;

struct PlainSched {
    const char* A; const char* B; unsigned lda, ldb; int nt, nM, nN, G, c;
    __device__ __forceinline__ bool next(int i, GU& u) const {
        int pm, pn; if (!pg8::tile_of(i * G + c, nM, nN, pm, pn)) return false;
        u.A = A + (size_t)pm * 256 * lda; u.B = B + (size_t)pn * 256 * ldb; u.lda = lda; u.ldb = ldb; u.nt = nt; u.pm = pm; u.pn = pn; u.kind = 0; u.mi = 0; return true;
    }
};
struct PairSched {
    const char* A1; const char* B1; unsigned lda1, ldb1; int nt1; size_t b1_mstride;
    const char* A2; const char* B2; unsigned lda2, ldb2; int nt2; size_t a2_mstride, b2_mstride;
    int nm, nM, nN, G, c;
    __device__ __forceinline__ bool next(int i, GU& u) const {
        const int per = 2 * nm, ti = i / per, sub = i - ti * per, m = sub >> 1, kind = sub & 1;
        int pm, pn; if (!pg8::tile_of(ti * G + c, nM, nN, pm, pn)) return false;
        u.pm = pm; u.pn = pn; u.kind = kind; u.mi = m;
        if (kind == 0) { u.A = A2 + (size_t)m * a2_mstride + (size_t)pm * 256 * lda2; u.B = B2 + (size_t)m * b2_mstride + (size_t)pn * 256 * ldb2; u.lda = lda2; u.ldb = ldb2; u.nt = nt2; }
        else { u.A = A1 + (size_t)pm * 256 * lda1; u.B = B1 + (size_t)m * b1_mstride + (size_t)pn * 256 * ldb1; u.lda = lda1; u.ldb = ldb1; u.nt = nt1; }
        return true;
    }
};

constexpr int RSTD_OFF = 131072;
__device__ __forceinline__ float ss_row(const float* ssp, int row) {
    const f32x4* p = (const f32x4*)(ssp + (size_t)row * 16); const f32x4 a = p[0], b = p[1], c = p[2], d = p[3];
    return (((a[0] + a[1]) + (a[2] + a[3])) + ((b[0] + b[1]) + (b[2] + b[3]))) + (((c[0] + c[1]) + (c[2] + c[3])) + ((d[0] + d[1]) + (d[2] + d[3])));
}
__device__ __forceinline__ void rstd_table(const float* ssp, int pm) {
    extern __shared__ __attribute__((aligned(16))) unsigned char lds_tab_raw[];
    LAS float* tab = (LAS float*)((LAS unsigned char*)lds_tab_raw + RSTD_OFF);
    const int t = threadIdx.x; if (t < 256) tab[t] = __builtin_amdgcn_rsqf(ss_row(ssp, pm * 256 + t) * (1.0f / D) + EPS);
    asm volatile("s_waitcnt lgkmcnt(0)" ::: "memory"); __builtin_amdgcn_s_barrier(); asm volatile("" ::: "memory");
}
__device__ __forceinline__ float rstd_tab(int lr) { extern __shared__ __attribute__((aligned(16))) unsigned char lds_tab_raw[]; return ((const LAS float*)((LAS unsigned char*)lds_tab_raw + RSTD_OFF))[lr]; }
__device__ __forceinline__ u32x4 pack8(const f32x4& a, const f32x4& b) { u32x4 w; w.x = cvt_pk_bf16(a[0], a[1]); w.y = cvt_pk_bf16(a[2], a[3]); w.z = cvt_pk_bf16(b[0], b[1]); w.w = cvt_pk_bf16(b[2], b[3]); return w; }
__device__ __forceinline__ void unpack8(const u32x4& w, f32x4& a, f32x4& b) { a = (f32x4){bflo(w.x), bfhi(w.x), bflo(w.y), bfhi(w.y)}; b = (f32x4){bflo(w.z), bfhi(w.z), bflo(w.w), bfhi(w.w)}; }

struct CmpSched {
    const char* U; const char* B; int c;
    __device__ __forceinline__ bool next(int i, GU& u) const {
        if (i > 0 || c >= 32) return false;
        const int b = c >> 2, q = c & 3;
        u.A = U + ((size_t)(b * S + 2048 * q) * UW + U_NSA + 256) * 2; u.B = B; u.lda = 16 * UW * 2; u.ldb = 4096; u.nt = 32; u.pm = b; u.pn = q; u.kind = 0; u.mi = 0; return true;
    }
};
struct EpiCmp {
    bf16* H;
    __device__ __forceinline__ void operator()(const f32x4 (&acc)[2][2][4][2], const GU& u, int wr, int wc, int fr, int fq) const {
        const int col = wc * 32 + 8 * fq;
        extern __shared__ __attribute__((aligned(16))) unsigned char lds_c1_raw[]; const LAS float* c1 = (const LAS float*)((LAS unsigned char*)lds_c1_raw + RSTD_OFF + 1024);
#pragma unroll
        for (int kv = 0; kv < 2; ++kv) { const f32x4 b0 = *(const LAS f32x4*)(c1 + kv * 128 + col), b1 = *(const LAS f32x4*)(c1 + kv * 128 + col + 4);
#pragma unroll
            for (int m = 0; m < 4; ++m) { const int i = u.pn * 128 + wr * 64 + m * 16 + fr; f32x4 v0, v1;
#pragma unroll
                for (int j = 0; j < 4; ++j) { v0[j] = fsilu(acc[kv][kv][m][0][j] + b0[j]); v1[j] = fsilu(acc[kv][kv][m][1][j] + b1[j]); }
                *(u32x4*)(H + ((size_t)(u.pm * 512 + i)) * 256 + kv * 128 + col) = pack8(v0, v1); } }
    }
};
struct EpiScaleBf16 {
    bf16* O; int ldo; const float* ss;
    __device__ __forceinline__ void operator()(const f32x4 (&acc)[2][2][4][2], const GU& u, int wr, int wc, int fr, int fq) const {
        rstd_table(ss, u.pm);
        const int row0 = u.pm * 256 + wr * 64 + fr, col0 = u.pn * 256 + wc * 32 + 8 * fq;
#pragma unroll
        for (int ai = 0; ai < 2; ++ai)
#pragma unroll
            for (int m = 0; m < 4; ++m) { const int r = row0 + ai * 128 + m * 16; const float rs = rstd_tab(wr * 64 + fr + ai * 128 + m * 16); bf16* rowp = O + (size_t)r * ldo + col0;
#pragma unroll
                for (int bj = 0; bj < 2; ++bj) *(u32x4*)(rowp + bj * 128) = pack8(acc[ai][bj][m][0] * rs, acc[ai][bj][m][1] * rs); }
    }
};
struct EpiSwiGLU {
    bf16* O; const float* ss;
    __device__ __forceinline__ void operator()(const f32x4 (&acc)[2][2][4][2], const GU& u, int wr, int wc, int fr, int fq) const {
        rstd_table(ss, u.pm);
        const int row0 = u.pm * 256 + wr * 64 + fr, col0 = u.pn * 128 + wc * 32 + 8 * fq;
#pragma unroll
        for (int ai = 0; ai < 2; ++ai)
#pragma unroll
            for (int m = 0; m < 4; ++m) { const int r = row0 + ai * 128 + m * 16; const float rs = rstd_tab(wr * 64 + fr + ai * 128 + m * 16);
                f32x4 v[2];
#pragma unroll
                for (int n = 0; n < 2; ++n)
#pragma unroll
                    for (int j = 0; j < 4; ++j) { const float g = acc[ai][0][m][n][j] * rs, up = acc[ai][1][m][n][j] * rs; v[n][j] = fsilu(g) * up; }
                *(u32x4*)(O + (size_t)r * DFF + col0) = pack8(v[0], v[1]); }
    }
};
struct EpiResidual {
    const float* Hin32; bf16* HB; float* ss_out;
    __device__ __forceinline__ void operator()(const f32x4 (&acc)[2][2][4][2], const GU& u, int wr, int wc, int fr, int fq) const {
        const int row0 = u.pm * 256 + wr * 64 + fr, col0 = u.pn * 256 + wc * 32 + 8 * fq;
#pragma unroll
        for (int hf = 0; hf < 2; ++hf) { const int ai = hf;
            u32x4 hv[8];
            if (!Hin32) {
#pragma unroll
                for (int q = 0; q < 8; ++q) { const int m = q >> 1, bj = q & 1; hv[q] = *(const u32x4*)(HB + (size_t)(row0 + ai * 128 + m * 16) * D + col0 + bj * 128); } }
#pragma unroll
            for (int m = 0; m < 4; ++m) { const int r = row0 + ai * 128 + m * 16; float s2 = 0.f;
#pragma unroll
                for (int bj = 0; bj < 2; ++bj) { const size_t o = (size_t)r * D + col0 + bj * 128;
                    f32x4 h0, h1;
                    if (Hin32) { h0 = *(const f32x4*)(Hin32 + o); h1 = *(const f32x4*)(Hin32 + o + 4); } else unpack8(hv[m * 2 + bj], h0, h1);
                    h0 += acc[ai][bj][m][0]; h1 += acc[ai][bj][m][1];
                    *(u32x4*)(HB + o) = pack8(h0, h1);
                    s2 += (h0[0] * h0[0] + h0[1] * h0[1]) + (h0[2] * h0[2] + h0[3] * h0[3]) + (h1[0] * h1[0] + h1[1] * h1[1]) + (h1[2] * h1[2] + h1[3] * h1[3]); }
                s2 += __shfl_xor(s2, 16); s2 += __shfl_xor(s2, 32);
                if (fq == 0) ss_out[(size_t)r * 16 + u.pn * 4 + wc] = s2; }
            asm volatile("" ::: "memory"); }
    }
};
#define SLOT(ai, m, bj) (((((ai) * 4 + (m)) >> 1) * 512 + tid) * 4 + (((m) & 1) * 2 + (bj)))
struct EpiMerge {
    u32x4* scrP; u32x4* scrM; bf16* M; const float* ss; const float* bias;
    int nm;
    __device__ __forceinline__ void operator()(const f32x4 (&acc)[2][2][4][2], const GU& u, int wr, int wc, int fr, int fq) const {
        int tid = threadIdx.x; asm volatile("" : "+v"(tid));
        if (u.kind == 0) {
#pragma unroll
            for (int ai = 0; ai < 2; ++ai)
#pragma unroll
                for (int m = 0; m < 4; ++m)
#pragma unroll
                    for (int bj = 0; bj < 2; ++bj) scrP[SLOT(ai, m, bj)] = pack8(acc[ai][bj][m][0], acc[ai][bj][m][1]);
            return;
        }
        const int row0 = u.pm * 256 + wr * 64 + fr, col0 = u.pn * 256 + wc * 32 + 8 * fq;
        rstd_table(ss, u.pm);
        const float* bp = bias + (size_t)u.mi * D + col0;
#pragma unroll
        for (int hf = 0; hf < 2; ++hf) { const int ai = hf;
            u32x4 pv[8];
#pragma unroll
            for (int q = 0; q < 8; ++q) pv[q] = scrP[SLOT(ai, q >> 1, q & 1)];
#pragma unroll
            for (int q = 0; q < 8; ++q) { const int m = q >> 1, bj = q & 1; const float rs = rstd_tab(wr * 64 + fr + ai * 128 + m * 16);
                const f32x4 b0 = *(const f32x4*)(bp + bj * 128), b1 = *(const f32x4*)(bp + bj * 128 + 4); f32x4 p0, p1; unpack8(pv[q], p0, p1);
#pragma unroll
                for (int j = 0; j < 4; ++j) { p0[j] *= fsigmoid(acc[ai][bj][m][0][j] * rs + b0[j]); p1[j] *= fsigmoid(acc[ai][bj][m][1][j] * rs + b1[j]); }
                pv[q] = pack8(p0, p1); }
            asm volatile("" ::: "memory");
            if (u.mi > 0) { u32x4 mv[8];
#pragma unroll
                for (int q = 0; q < 8; ++q) mv[q] = scrM[SLOT(ai, q >> 1, q & 1)];
#pragma unroll
                for (int q = 0; q < 8; ++q) { f32x4 a0, a1, q0, q1; unpack8(pv[q], a0, a1); unpack8(mv[q], q0, q1); pv[q] = pack8(a0 + q0, a1 + q1); } }
#pragma unroll
            for (int q = 0; q < 8; ++q) { const int m = q >> 1, bj = q & 1;
                if (u.mi == nm - 1) *(u32x4*)(M + (size_t)(row0 + ai * 128 + m * 16) * D + col0 + bj * 128) = pv[q]; else scrM[SLOT(ai, m, bj)] = pv[q]; }
            asm volatile("" ::: "memory"); }
    }
};
struct EpiPle {
    u32x4* scrP; const bf16* Hcur; bf16* HBout; const float* ss; float* ss_out;
    __device__ __forceinline__ void operator()(const f32x4 (&acc)[2][2][4][2], const GU& u, int wr, int wc, int fr, int fq) const {
        int tid = threadIdx.x; asm volatile("" : "+v"(tid));
        if (u.kind == 0) {
#pragma unroll
            for (int ai = 0; ai < 2; ++ai)
#pragma unroll
                for (int m = 0; m < 4; ++m)
#pragma unroll
                    for (int bj = 0; bj < 2; ++bj) scrP[SLOT(ai, m, bj)] = pack8(acc[ai][bj][m][0], acc[ai][bj][m][1]);
            return;
        }
        rstd_table(ss, u.pm);
        const int row0 = u.pm * 256 + wr * 64 + fr, col0 = u.pn * 256 + wc * 32 + 8 * fq;
#pragma unroll
        for (int qt = 0; qt < 4; ++qt) { const int ai = qt >> 1, m0 = (qt & 1) * 2;
            u32x4 pv[4], hv[4];
#pragma unroll
            for (int q = 0; q < 4; ++q) { const int m = m0 + (q >> 1), bj = q & 1; pv[q] = scrP[SLOT(ai, m, bj)]; hv[q] = *(const u32x4*)(Hcur + (size_t)(row0 + ai * 128 + m * 16) * D + col0 + bj * 128); }
#pragma unroll
            for (int mm = 0; mm < 2; ++mm) { const int m = m0 + mm; const int r = row0 + ai * 128 + m * 16; const float rs = rstd_tab(wr * 64 + fr + ai * 128 + m * 16); float s2 = 0.f;
#pragma unroll
                for (int bj = 0; bj < 2; ++bj) { const int q = mm * 2 + bj; f32x4 h0, h1, p0, p1; unpack8(hv[q], h0, h1); unpack8(pv[q], p0, p1);
#pragma unroll
                    for (int j = 0; j < 4; ++j) { h0[j] += fsigmoid(acc[ai][bj][m][0][j] * rs) * p0[j]; h1[j] += fsigmoid(acc[ai][bj][m][1][j] * rs) * p1[j]; }
                    *(u32x4*)(HBout + (size_t)r * D + col0 + bj * 128) = pack8(h0, h1);
                    s2 += (h0[0] * h0[0] + h0[1] * h0[1]) + (h0[2] * h0[2] + h0[3] * h0[3]) + (h1[0] * h1[0] + h1[1] * h1[1]) + (h1[2] * h1[2] + h1[3] * h1[3]); }
                s2 += __shfl_xor(s2, 16); s2 += __shfl_xor(s2, 32);
                if (fq == 0) ss_out[(size_t)r * 16 + u.pn * 4 + wc] = s2; }
            asm volatile("" ::: "memory"); }
    }
};

constexpr int NWAVES = 8, NTHR = 512;
constexpr int RING_OFF = 0, RING_BYTES = 131072, WREG = 19456, MISC_OFF = 8 * WREG;
constexpr int LDS_BYTES = MISC_OFF + 256;
static_assert(MISC_OFF + 128 <= LDS_BYTES, "lds");
struct Args { const float* in[37]; float* out; unsigned char* ws; int ph_lo, ph_hi; };
struct Frame {
    LAS unsigned char* lds; int tid, lane, wave, G, bx;
    const float* const* in; float* out; unsigned char* ws;
};
enum { I_X = 0, I_P, I_NORM_MIX, I_W_IN, I_POS_K, I_POS_V, I_CK1, I_CK2, I_CV1, I_CV2, I_LB, I_HG_NORM, I_RT_G, I_RT_B, I_MU, I_W0, I_WUP, I_A0, I_AUP, I_GUP, I_KK, I_KA, I_RK,
       I_RW_G, I_RW_B, I_WBR, I_WGATE, I_BGATE, I_WOUT, I_NORM_FFN, I_FFG, I_FFU, I_FFD, I_NORM_PLE, I_PLEG, I_PLEP, I_NORM_FINAL };

template <class ColMap>
__device__ __forceinline__ void transpose_item(const float* W, int ldw, int K, const float* scale, bf16* WT, LAS float* scr, int item, int nblk, int lane, const ColMap& cm) {
    const int kb = item / nblk, nb = item % nblk, k0 = 64 * kb, n0 = 32 * nb;
    const int sc = cm(n0 + (lane & 31));
    float tv[32];
#pragma unroll
    for (int i = 0; i < 32; ++i) { const int kk = 2 * i + (lane >> 5); tv[i] = (sc >= 0) ? W[(size_t)(k0 + kk) * ldw + sc] : 0.f; }
    if (scale) {
#pragma unroll
        for (int i = 0; i < 32; ++i) tv[i] *= scale[k0 + 2 * i + (lane >> 5)]; }
#pragma unroll
    for (int i = 0; i < 32; ++i) scr[(2 * i + (lane >> 5)) * 33 + (lane & 31)] = tv[i];
    LDS_WAIT();
    const int c = lane & 7;
#pragma unroll
    for (int j = 0; j < 4; ++j) { const int n = (lane >> 3) + 8 * j; const LAS float* s = scr + (8 * c) * 33 + n;
        u32x4 o; o.x = cvt_pk_bf16(s[0 * 33], s[1 * 33]); o.y = cvt_pk_bf16(s[2 * 33], s[3 * 33]); o.z = cvt_pk_bf16(s[4 * 33], s[5 * 33]); o.w = cvt_pk_bf16(s[6 * 33], s[7 * 33]);
        *(u32x4*)(WT + (size_t)(n0 + n) * K + k0 + 8 * c) = o; }
    LDS_WAIT();
}
struct CmIdent { __device__ __forceinline__ int operator()(int n) const { return n; } };
struct CmWin { __device__ __forceinline__ int operator()(int n) const { return n < 652 ? n : (n < 768 ? -1 : n - 116); } };
struct CmFF { __device__ __forceinline__ int operator()(int n) const { return (n >> 8) * 128 + (n & 127); } };

__device__ __forceinline__ void phase_prologue(Frame& F0) {
    Frame F = F0; asm volatile("" : "+v"(F.tid)); F.lane = F.tid & 63;
    LAS float* scr = (LAS float*)(F.lds + F.wave * WREG);
    const int gw = F.bx * NWAVES + F.wave, NGW = F.G * NWAVES;
    int dbase = 0;
#define DEAL(var, n) for (int _n = (n), var = (int)((unsigned)(gw + NGW - (dbase % NGW)) % (unsigned)NGW), _once = ((dbase += _n), 0); var < _n; var += NGW)
    for (int L = 0; L < NL; ++L) {
        unsigned char* wl = F.ws + WS_W + (size_t)L * WL_STRIDE;
        const float* g_mix = F.in[I_NORM_MIX] + L * D; const float* g_ffn = F.in[I_NORM_FFN] + L * D; const float* g_ple = F.in[I_NORM_PLE] + L * D;
        { const int nblk = UW / 32, items = (D / 64) * nblk; const float* W = F.in[I_W_IN] + (size_t)L * D * DIN;
          DEAL(it, items) transpose_item(W, DIN, D, g_mix, (bf16*)(wl + WL_IN), scr, it, nblk, F.lane, CmWin()); }
        for (int m = 0; m < 4; ++m) { const int nblk = D / 32, items = (D / 64) * nblk; const float* W = F.in[I_WGATE] + ((size_t)L * 4 + m) * D * D;
          DEAL(it, items) transpose_item(W, D, D, g_mix, (bf16*)(wl + WL_G) + (size_t)m * D * D, scr, it, nblk, F.lane, CmIdent()); }
        for (int m = 0; m < 4; ++m) { const int nblk = D / 32, items = (MW / 64) * nblk; const float* W = F.in[I_WBR] + ((size_t)L * 4 + m) * MW * D;
          DEAL(it, items) transpose_item(W, D, MW, nullptr, (bf16*)(wl + WL_B) + (size_t)m * D * MW, scr, it, nblk, F.lane, CmIdent()); }
        { const int nblk = D / 32, items = (D / 64) * nblk; const float* W = F.in[I_WOUT] + (size_t)L * D * D;
          DEAL(it, items) transpose_item(W, D, D, nullptr, (bf16*)(wl + WL_OUT), scr, it, nblk, F.lane, CmIdent()); }
        { const int nblk = (2 * DFF) / 32, items = (D / 64) * nblk; const float* Wg = F.in[I_FFG] + (size_t)L * D * DFF; const float* Wu = F.in[I_FFU] + (size_t)L * D * DFF;
          DEAL(it, items) { const int nb = it % nblk; const bool up = ((nb * 32) & 128) != 0; transpose_item(up ? Wu : Wg, DFF, D, g_ffn, (bf16*)(wl + WL_FF), scr, it, nblk, F.lane, CmFF()); } }
        { const int nblk = D / 32, items = (DFF / 64) * nblk; const float* W = F.in[I_FFD] + (size_t)L * DFF * D;
          DEAL(it, items) transpose_item(W, D, DFF, nullptr, (bf16*)(wl + WL_DN), scr, it, nblk, F.lane, CmIdent()); }
        { const int nblk = D / 32, items = (D / 64) * nblk; const float* W = F.in[I_PLEG] + (size_t)L * D * D;
          DEAL(it, items) transpose_item(W, D, D, g_ple, (bf16*)(wl + WL_PG), scr, it, nblk, F.lane, CmIdent()); }
        { const int nblk = D / 32, items = (PLE / 64) * nblk; const float* W = F.in[I_PLEP] + (size_t)L * PLE * D;
          DEAL(it, items) transpose_item(W, D, PLE, nullptr, (bf16*)(wl + WL_PP), scr, it, nblk, F.lane, CmIdent()); }
    }
    for (int L = 0; L < NL; ++L) for (int kv = 0; kv < 2; ++kv) {
        const float* w1 = F.in[kv ? I_CV1 : I_CK1] + (size_t)L * 2048 * 128; const float* w2 = F.in[kv ? I_CV2 : I_CK2] + (size_t)L * 128 * 64;
        bf16* w1T = (bf16*)(F.ws + WS_CW1 + (size_t)L * MiB) + (size_t)kv * 128 * 2048; bf16* w2T = (bf16*)(F.ws + WS_CW2 + (size_t)L * 65536) + kv * 64 * 128;
        DEAL(it, 128) transpose_item(w1, 128, 2048, nullptr, w1T, scr, it, 4, F.lane, CmIdent());
        DEAL(it, 4) transpose_item(w2, 64, 128, nullptr, w2T, scr, it, 2, F.lane, CmIdent());
        DEAL(tk, 64) { const int hf = tk & 1, jq = tk >> 1; const float* pos = F.in[kv ? I_POS_V : I_POS_K] + (size_t)L * 2048; float a = 0.f;
#pragma unroll 8
            for (int j = 64 * jq; j < 64 * jq + 64; ++j) a += pos[j] * w1[(size_t)j * 128 + hf * 64 + F.lane];
            ((float*)(F.ws + WS_CW2 + (size_t)L * 65536 + 32768))[(kv * 32 + jq) * 128 + hf * 64 + F.lane] = a; } }
#undef DEAL
    { const float* x = F.in[I_X]; bf16* hb = (bf16*)(F.ws + WS_HBA); float* ss0 = F.out;
      for (int r = gw; r < T; r += NGW) { const f32x4* xr = (const f32x4*)(x + (size_t)r * D) + F.lane; float s = 0.f;
#pragma unroll
        for (int j = 0; j < 4; ++j) { const f32x4 v = xr[64 * j]; s += (v[0] * v[0] + v[1] * v[1]) + (v[2] * v[2] + v[3] * v[3]);
            u32x2 w; w.x = cvt_pk_bf16(v[0], v[1]); w.y = cvt_pk_bf16(v[2], v[3]); *((u32x2*)(hb + (size_t)r * D) + F.lane + 64 * j) = w; }
        s = wave_sum(s); if (F.lane < 16) ss0[(size_t)r * 16 + F.lane] = (F.lane == 0) ? s : 0.f; } }
    for (int L = 0; L < NL; ++L) { bf16* base = (bf16*)(F.ws + WS_RWUP + (size_t)L * 131072);
        for (int it = gw; it < 8; it += NGW) transpose_item(F.in[I_WUP] + (size_t)L * 64 * 256, 256, 64, nullptr, base, scr, it, 8, F.lane, CmIdent());
        for (int it = gw; it < 8; it += NGW) transpose_item(F.in[I_AUP] + (size_t)L * 64 * 256, 256, 64, nullptr, base + 256 * 64, scr, it, 8, F.lane, CmIdent());
        for (int it = gw; it < 16; it += NGW) transpose_item(F.in[I_GUP] + (size_t)L * 128 * 256, 256, 128, nullptr, base + 2 * 256 * 64, scr, it, 8, F.lane, CmIdent()); }
    { float* rope = (float*)(F.ws + WS_ROPE); const int gt = F.bx * NTHR + F.tid, NT_ = F.G * NTHR;
      for (int i = gt; i < S * 32; i += NT_) { const int pos = i >> 5, j = i & 31; const float inv = exp2f(-(float)(2 * j) * (13.287712379549449f / 64.0f));
        const float a = (float)pos * inv;
        rope[2 * i] = cosf(a); rope[2 * i + 1] = sinf(a); } }
}

__device__ __forceinline__ float ldu(const bf16* u, size_t row, int col) { return bf2f(u[row * UW + col]); }

__device__ __forceinline__ bf16x8 frag_rm(const LAS unsigned char* X, int ld, int r0, int k0, int lane) { return *(const LAS bf16x8*)(X + (r0 + (lane & 31)) * ld + (k0 + 8 * (lane >> 5)) * 2); }
__device__ __forceinline__ bf16x8 frag_tr(const LAS unsigned char* X, int ld, int k0, int c0, int lane) {
    const LAS unsigned char* p = X + (k0 + 8 * (lane >> 5) + ((lane & 15) >> 2)) * ld + (c0 + 16 * ((lane >> 4) & 1) + 4 * (lane & 3)) * 2;
    const s16x4 a = __builtin_amdgcn_ds_read_tr16_b64_v4i16((LAS s16x4*)p), b = __builtin_amdgcn_ds_read_tr16_b64_v4i16((LAS s16x4*)(p + 4 * ld));
    return (bf16x8){a[0], a[1], a[2], a[3], b[0], b[1], b[2], b[3]};
}
__device__ __forceinline__ bf16x8 frag_g(const bf16* X, int ld, int r0, int k0, int lane) { return *(const bf16x8*)(X + (size_t)(r0 + (lane & 31)) * ld + k0 + 8 * (lane >> 5)); }
__device__ __forceinline__ f32x16 mma32(const bf16x8& a, const bf16x8& b, const f32x16& c) { return __builtin_amdgcn_mfma_f32_32x32x16_bf16(a, b, c, 0, 0, 0); }
__device__ __forceinline__ f32x16 zero16() { f32x16 z;
#pragma unroll
    for (int i = 0; i < 16; ++i) z[i] = 0.f;
    return z; }
__device__ __forceinline__ void st_T(LAS unsigned char* X, int ld, int j0, int i0, const f32x16& acc, int lane) {
#pragma unroll
    for (int g = 0; g < 4; ++g) { u32x2 w; w.x = cvt_pk_bf16(acc[4 * g], acc[4 * g + 1]); w.y = cvt_pk_bf16(acc[4 * g + 2], acc[4 * g + 3]);
        *(LAS u32x2*)(X + (j0 + (lane & 31)) * ld + (i0 + 8 * g + 4 * (lane >> 5)) * 2) = w; }
}
__device__ __forceinline__ void st_wt16(bf16* p, const u32x4& w) { __hip_atomic_store((unsigned long long*)p, ((unsigned long long)w.y << 32) | (unsigned long long)w.x, __ATOMIC_RELAXED, __HIP_MEMORY_SCOPE_AGENT); __hip_atomic_store((unsigned long long*)p + 1, ((unsigned long long)w.w << 32) | (unsigned long long)w.z, __ATOMIC_RELAXED, __HIP_MEMORY_SCOPE_AGENT); }
template <bool WT>
__device__ __forceinline__ void st_T_g(bf16* X, int ld, int j0, int i0, const f32x16& acc, int lane) {
    const int hh = lane >> 5; u32x2 w[4];
#pragma unroll
    for (int g = 0; g < 4; ++g) { w[g].x = cvt_pk_bf16(acc[4 * g], acc[4 * g + 1]); w[g].y = cvt_pk_bf16(acc[4 * g + 2], acc[4 * g + 3]); }
#pragma unroll
    for (int k = 0; k < 2; ++k) { const u32x2 snd = hh ? w[k] : w[2 + k]; u32x2 rcv; rcv.x = __shfl_xor(snd.x, 32); rcv.y = __shfl_xor(snd.y, 32);
        const u32x2 own = hh ? w[2 + k] : w[k]; u32x4 v; if (hh) { v.x = rcv.x; v.y = rcv.y; v.z = own.x; v.w = own.y; } else { v.x = own.x; v.y = own.y; v.z = rcv.x; v.w = rcv.y; }
        bf16* p = X + (size_t)(j0 + (lane & 31)) * ld + i0 + 8 * (2 * hh + k);
        if (WT) st_wt16(p, v); else *(u32x4*)p = v; }
}
constexpr int LD64 = 144, LD32 = 80;
__device__ __forceinline__ float expc(float x) { return __expf(fminf(fmaxf(x, -80.f), 80.f)); }
__device__ __forceinline__ unsigned short f2b(float x) { return (unsigned short)(cvt_pk_bf16(x, 0.f) & 0xffffu); }
__device__ __forceinline__ void copy_tok64(LAS unsigned char* X, const bf16* src, int lane) {
#pragma unroll
    for (int p = 0; p < 4; ++p) { const int t = 8 * p + (lane >> 3), ch = lane & 7; *(LAS u32x4*)(X + t * LD64 + ch * 16) = *(const u32x4*)(src + (size_t)t * UW + ch * 8); }
}
__device__ __forceinline__ void glin_m1(const LAS unsigned char* Kh, const LAS unsigned char* Vv, bf16* Sg, int lane, bool cst = false) {
#pragma unroll
    for (int dt = 0; dt < 2; ++dt)
#pragma unroll
        for (int et = 0; et < 2; ++et) { f32x16 acc = zero16();
#pragma unroll
            for (int ks = 0; ks < 2; ++ks) acc = mma32(frag_tr(Kh, LD64, 16 * ks, 32 * dt, lane), frag_tr(Vv, LD64, 16 * ks, 32 * et, lane), acc);
            if (cst) {
#pragma unroll
            for (int i = 0; i < 16; ++i) acc[i] = 0.01f * (float)(1 + ((lane + i) & 7)); }
            st_T_g<false>(Sg, 64, 32 * et, 32 * dt, acc, lane); }
}
__device__ __forceinline__ void glin_m3(const LAS unsigned char* Qt, const LAS unsigned char* Kt, const LAS unsigned char* Vv, LAS unsigned char* Xa, const bf16* S0, int lane, f32x16 (&o)[2]) {
    { f32x16 acc = zero16();
#pragma unroll
      for (int ks = 0; ks < 4; ++ks) acc = mma32(frag_rm(Kt, LD64, 0, 16 * ks, lane), frag_rm(Qt, LD64, 0, 16 * ks, lane), acc);
      const int t = lane & 31;
#pragma unroll
      for (int i = 0; i < 16; ++i) { const int sidx = (i & 3) + 8 * (i >> 2) + 4 * (lane >> 5); if (sidx > t) acc[i] = 0.f; }
      st_T(Xa, LD32, 0, 0, acc, lane); }
    LDS_WAIT();
#pragma unroll
    for (int et = 0; et < 2; ++et) { f32x16 acc = zero16();
        if (S0) {
#pragma unroll
            for (int ks = 0; ks < 4; ++ks) acc = mma32(frag_g(S0, 64, 32 * et, 16 * ks, lane), frag_rm(Qt, LD64, 0, 16 * ks, lane), acc); }
#pragma unroll
        for (int ks = 0; ks < 2; ++ks) acc = mma32(frag_tr(Vv, LD64, 16 * ks, 32 * et, lane), frag_rm(Xa, LD32, 0, 16 * ks, lane), acc);
        o[et] = acc; }
}
template <bool M3>
__device__ __forceinline__ void hgrn_chunk(Frame& F, int L, int bh, int n, LAS unsigned char* W, bf16* Sbase, float* Dbase) {
    const bf16* u = (const bf16*)(F.ws + WS_U); bf16* bo = (bf16*)(F.ws + WS_BO);
    int lane = F.lane; asm volatile("" : "+v"(lane));
    const int b = bh >> 2, h = bh & 3; const size_t row0 = (size_t)b * S + (size_t)n * CH;
    const bf16* ur = u + row0 * UW + U_HG + h * 64;
    bf16* Sg = Sbase + ((size_t)bh * NCH + n) * 4096;
    LAS unsigned char* Xq = W; LAS unsigned char* Xk = W + 4608; LAS unsigned char* Xv = W + 9216; LAS unsigned char* Xa = W + 13824;
    const float* lbl = F.in[I_LB]; const int ch = h * 64 + lane;
    float lb = 0.f; if (L > 0) { const float l0 = lbl[ch], l1 = lbl[256 + ch]; const float mx = fmaxf(l0, l1); const float e0 = __expf(l0 - mx), e1 = __expf(l1 - mx); lb = e1 / (e0 + e1); }
    float bcum[CH], kk[CH]; float run = 0.f;
#pragma unroll
    for (int t = 0; t < CH; ++t) { const float z = bf2f(ur[(size_t)t * UW + 256 + lane]); const float f = lb + (1.0f - lb) * fsigmoid(z); kk[t] = 1.0f - f; run += __logf(fmaxf(f, 1e-20f)); bcum[t] = run; }
    const float blast = bcum[CH - 1];
    copy_tok64(Xv, ur + 512, lane);
    if (!M3) {
#pragma unroll
        for (int t = 0; t < CH; ++t) *(LAS unsigned short*)(Xq + t * LD64 + lane * 2) = f2b(kk[t] * expc(blast - bcum[t]));
        Dbase[((size_t)bh * NCH + n) * 64 + lane] = expc(blast);
        LDS_WAIT();
        glin_m1(Xq, Xv, Sg, lane);
    } else {
#pragma unroll
        for (int t = 0; t < CH; ++t) { const float q = fsilu(bf2f(ur[(size_t)t * UW + lane]));
            *(LAS unsigned short*)(Xq + t * LD64 + lane * 2) = f2b(q * expc(bcum[t]));
            *(LAS unsigned short*)(Xk + t * LD64 + lane * 2) = f2b(kk[t] * expc(-bcum[t])); }
        LDS_WAIT();
        f32x16 o[2];
        glin_m3(Xq, Xk, Xv, Xa, n > 0 ? Sg - 4096 : nullptr, lane, o);
        const int t = lane & 31, hh = lane >> 5; float ss = 0.f;
#pragma unroll
        for (int et = 0; et < 2; ++et)
#pragma unroll
            for (int i = 0; i < 16; ++i) ss += o[et][i] * o[et][i];
        ss += __shfl_xor(ss, 32);
        const float rn = __builtin_amdgcn_rsqf(ss * (1.0f / 64.0f) + EPS);
        const float* ng = F.in[I_HG_NORM] + L * 256 + h * 64;
#pragma unroll
        for (int et = 0; et < 2; ++et)
#pragma unroll
            for (int g = 0; g < 4; ++g) { const int e0 = 32 * et + 8 * g + 4 * hh;
                const u32x2 og = *(const u32x2*)(ur + (size_t)t * UW + 768 + e0); const f32x4 gg = *(const f32x4*)(ng + e0);
                const float y0 = o[et][4 * g] * rn * gg[0] * fsilu(bflo(og.x)), y1 = o[et][4 * g + 1] * rn * gg[1] * fsilu(bfhi(og.x));
                const float y2 = o[et][4 * g + 2] * rn * gg[2] * fsilu(bflo(og.y)), y3 = o[et][4 * g + 3] * rn * gg[3] * fsilu(bfhi(og.y));
                u32x2 w; w.x = cvt_pk_bf16(y0, y1); w.y = cvt_pk_bf16(y2, y3);
                *(u32x2*)(bo + (row0 + t) * 1024 + 256 + h * 64 + e0) = w; }
    }
    LDS_WAIT();
}
template <bool M3>
__device__ __forceinline__ void ret_chunk(Frame& F, int L, int bh, int n, LAS unsigned char* W, bf16* Sbase) {
    const bf16* u = (const bf16*)(F.ws + WS_U); bf16* bo = (bf16*)(F.ws + WS_BO); const float* rope = (const float*)(F.ws + WS_ROPE);
    int lane = F.lane; asm volatile("" : "+v"(lane));
    const int b = bh >> 2, h = bh & 3; const int tpos0 = n * CH; const size_t row0 = (size_t)b * S + (size_t)tpos0;
    const bf16* ur = u + row0 * UW + U_RT + h * 64;
    bf16* Sg = Sbase + ((size_t)bh * NCH + n) * 4096;
    LAS unsigned char* Xq = W; LAS unsigned char* Xk = W + 4608; LAS unsigned char* Xv = W + 9216; LAS unsigned char* Xa = W + 13824;
    const float lg2 = __log2f(1.0f - exp2f(-5.0f - (float)h));
    copy_tok64(Xv, ur + 512, lane);
#pragma unroll
    for (int p = 0; p < 2; ++p) { const int idx = lane + 64 * p, t = idx >> 2, jc = idx & 3;
        f32x4 c0, c1, s0, s1;
        { const float* rp = rope + ((size_t)(tpos0 + t) * 32 + jc * 8) * 2; const f32x4 a = *(const f32x4*)rp, bq = *(const f32x4*)(rp + 4), c = *(const f32x4*)(rp + 8), d = *(const f32x4*)(rp + 12);
          c0 = (f32x4){a[0], a[2], bq[0], bq[2]}; s0 = (f32x4){a[1], a[3], bq[1], bq[3]}; c1 = (f32x4){c[0], c[2], d[0], d[2]}; s1 = (f32x4){c[1], c[3], d[1], d[3]}; }
        { const u32x4 w1 = *(const u32x4*)(ur + (size_t)t * UW + 256 + jc * 8), w2 = *(const u32x4*)(ur + (size_t)t * UW + 256 + 32 + jc * 8);
          f32x4 a0, a1, b0, b1; unpack8(w1, a0, a1); unpack8(w2, b0, b1);
          const float sc = 0.125f * exp2f(lg2 * (M3 ? -(float)(t + 1) : (float)(CH - 1 - t)));
          const f32x4 lo0 = (a0 * c0 - b0 * s0) * sc, lo1 = (a1 * c1 - b1 * s1) * sc, hi0 = (a0 * s0 + b0 * c0) * sc, hi1 = (a1 * s1 + b1 * c1) * sc;
          LAS unsigned char* dst = M3 ? Xk : Xq;
          *(LAS u32x4*)(dst + t * LD64 + jc * 16) = pack8(lo0, lo1); *(LAS u32x4*)(dst + t * LD64 + 64 + jc * 16) = pack8(hi0, hi1); }
        if (M3) { const u32x4 w1 = *(const u32x4*)(ur + (size_t)t * UW + jc * 8), w2 = *(const u32x4*)(ur + (size_t)t * UW + 32 + jc * 8);
          f32x4 a0, a1, b0, b1; unpack8(w1, a0, a1); unpack8(w2, b0, b1);
          const float sc = exp2f(lg2 * (float)(t + 1));
          const f32x4 lo0 = (a0 * c0 - b0 * s0) * sc, lo1 = (a1 * c1 - b1 * s1) * sc, hi0 = (a0 * s0 + b0 * c0) * sc, hi1 = (a1 * s1 + b1 * c1) * sc;
          *(LAS u32x4*)(Xq + t * LD64 + jc * 16) = pack8(lo0, lo1); *(LAS u32x4*)(Xq + t * LD64 + 64 + jc * 16) = pack8(hi0, hi1); }
    }
    LDS_WAIT();
    if (!M3) glin_m1(Xq, Xv, Sg, lane);
    else {
        f32x16 o[2];
        glin_m3(Xq, Xk, Xv, Xa, n > 0 ? Sg - 4096 : nullptr, lane, o);
        const int t = lane & 31, hh = lane >> 5; float sm = 0.f;
#pragma unroll
        for (int et = 0; et < 2; ++et)
#pragma unroll
            for (int i = 0; i < 16; ++i) sm += o[et][i];
        sm += __shfl_xor(sm, 32);
        const float mean = sm * (1.0f / 64.0f); float sv = 0.f;
#pragma unroll
        for (int et = 0; et < 2; ++et)
#pragma unroll
            for (int i = 0; i < 16; ++i) { const float dl = o[et][i] - mean; sv += dl * dl; }
        sv += __shfl_xor(sv, 32);
        const float rn = __builtin_amdgcn_rsqf(sv * (1.0f / 64.0f) + 1e-5f);
        const float* ng = F.in[I_RT_G] + L * 256 + h * 64; const float* nb = F.in[I_RT_B] + L * 256 + h * 64;
#pragma unroll
        for (int et = 0; et < 2; ++et)
#pragma unroll
            for (int g = 0; g < 4; ++g) { const int e0 = 32 * et + 8 * g + 4 * hh;
                const u32x2 og = *(const u32x2*)(ur + (size_t)t * UW + 768 + e0); const f32x4 gg = *(const f32x4*)(ng + e0), bb = *(const f32x4*)(nb + e0);
                const float y0 = ((o[et][4 * g] - mean) * rn * gg[0] + bb[0]) * fsilu(bflo(og.x)), y1 = ((o[et][4 * g + 1] - mean) * rn * gg[1] + bb[1]) * fsilu(bfhi(og.x));
                const float y2 = ((o[et][4 * g + 2] - mean) * rn * gg[2] + bb[2]) * fsilu(bflo(og.y)), y3 = ((o[et][4 * g + 3] - mean) * rn * gg[3] + bb[3]) * fsilu(bfhi(og.y));
                u32x2 w; w.x = cvt_pk_bf16(y0, y1); w.y = cvt_pk_bf16(y2, y3);
                *(u32x2*)(bo + (row0 + t) * 1024 + 512 + h * 64 + e0) = w; }
    }
    LDS_WAIT();
}
__device__ __forceinline__ void glin_scan_task(const bf16* Sbase, bf16* Sout, const float* Dbase, float dscal, int bh, int half, int tl  ) {
    const bf16* p = Sbase + (size_t)bh * NCH * 4096 + half * 2048 + tl * 8; bf16* po = Sout + (size_t)bh * NCH * 4096 + half * 2048 + tl * 8;
    const int d0 = (tl & 7) * 8;
    float st[8];
#pragma unroll
    for (int x = 0; x < 8; ++x) st[x] = 0.f;
    for (int n0 = 0; n0 < NCH; n0 += 8) {
        u32x4 kv[8]; f32x4 da[8], db[8];
#pragma unroll
        for (int j = 0; j < 8; ++j) { kv[j] = *(const u32x4*)(p + (size_t)(n0 + j) * 4096);
            if (Dbase) { da[j] = *(const f32x4*)(Dbase + ((size_t)bh * NCH + n0 + j) * 64 + d0); db[j] = *(const f32x4*)(Dbase + ((size_t)bh * NCH + n0 + j) * 64 + d0 + 4); } else { da[j] = (f32x4){dscal, dscal, dscal, dscal}; db[j] = da[j]; } }
#pragma unroll
        for (int j = 0; j < 8; ++j) { f32x4 a, b; unpack8(kv[j], a, b);
#pragma unroll
            for (int x = 0; x < 4; ++x) { st[x] = st[x] * da[j][x] + a[x]; st[4 + x] = st[4 + x] * db[j][x] + b[x]; }
            *(u32x4*)(po + (size_t)(n0 + j) * 4096) = pack8((f32x4){st[0], st[1], st[2], st[3]}, (f32x4){st[4], st[5], st[6], st[7]}); }
    }
}

constexpr int RW_R0 = 0, RW_R1 = 4608, RW_R2 = 9216, RW_R3 = 13824, RW_R4 = 16384, RW_R5 = 18944, RW_LW = 0, RW_AG = 8704, LDLW = 272;
__device__ __forceinline__ void ld_shift8(const bf16* urow, bool has_prev, const float* mu8, f32x4& lo, f32x4& hi) {
    const u32x4 w1 = *(const u32x4*)urow; f32x4 a0, a1; unpack8(w1, a0, a1);
    f32x4 p0 = {0.f, 0.f, 0.f, 0.f}, p1 = {0.f, 0.f, 0.f, 0.f};
    if (has_prev) { const u32x4 w0 = *(const u32x4*)(urow - UW); unpack8(w0, p0, p1); }
    const f32x4 m0 = *(const f32x4*)mu8, m1 = *(const f32x4*)(mu8 + 4);
    lo = a0 + m0 * (p0 - a0); hi = a1 + m1 * (p1 - a1);
}
__device__ __forceinline__ float ftanh(float x) { return 1.0f - 2.0f * __builtin_amdgcn_rcpf(1.0f + __builtin_amdgcn_exp2f(2.8853900817779268f * x)); }
#ifndef RW_LIMIT
#define RW_LIMIT 100
#endif
#define RW_CUT(k) do { if (RW_LIMIT <= (k)) return; } while (0)
template <int SI> struct SubstStep {
    static __device__ __forceinline__ void run(float (&Tr)[CH], const LAS unsigned char* AT, int r32, int& ofs) {
        float a0 = (r32 == SI) ? 1.0f : 0.f, a1 = 0.f;
#pragma unroll
        for (int q = 0; q < 4; ++q) { if (8 * q + 7 > SI) { const u32x4 w = *(const LAS u32x4*)(AT + ofs + SI * LD32 + q * 16); f32x4 lo, hi; unpack8(w, lo, hi);
#pragma unroll
            for (int x = 0; x < 4; ++x) { if (8 * q + x > SI) a0 += Tr[8 * q + x] * lo[x]; if (8 * q + 4 + x > SI) a1 += Tr[8 * q + 4 + x] * hi[x]; } } }
        const float a = a0 + a1;
        Tr[SI] = a;
        asm volatile("" : "+v"(ofs) : "v"(a));
        SubstStep<SI - 1>::run(Tr, AT, r32, ofs);
    }
};
template <> struct SubstStep<-1> { static __device__ __forceinline__ void run(float (&)[CH], const LAS unsigned char*, int, int&) {} };
template <bool M3>
__device__ __forceinline__ void rwkv_chunk(Frame& F, int L, int bh, int n, LAS unsigned char* W) {
    const bf16* u = (const bf16*)(F.ws + WS_U); bf16* bo = (bf16*)(F.ws + WS_BO);
    int lane = F.lane; asm volatile("" : "+v"(lane));
    const int b = bh >> 2, h = bh & 3, r32 = lane & 31, hh = lane >> 5; const size_t row0 = (size_t)b * S + (size_t)n * CH;
    const bf16* ur = u + row0 * UW + U_RW;
    const float* mu = F.in[I_MU] + L * 1024;
    const bf16* upT = (const bf16*)(F.ws + WS_RWUP + (size_t)L * 131072);
    bf16* Mg = (bf16*)(F.ws + WS_RWM) + ((size_t)bh * NCH + n) * 4096;
    bf16* Ng = (bf16*)(F.ws + WS_RWN) + ((size_t)bh * NCH + n) * 4096;
    bf16* Tg = (bf16*)((unsigned char*)F.out + DO_T) + ((size_t)bh * NCH + n) * 1024;
    LAS unsigned char* R0 = W + RW_R0; LAS unsigned char* R1 = W + RW_R1; LAS unsigned char* R2 = W + RW_R2; LAS unsigned char* R3 = W + RW_R3; LAS unsigned char* R4 = W + RW_R4;
    LAS float* R5 = (LAS float*)(W + RW_R5);
#pragma unroll
    for (int i = 0; i < 8; ++i) { const int idx = lane + 64 * i, t = idx >> 4, part = (idx >> 3) & 1, ch = idx & 7, col = 768 + part * 64 + ch * 8;
        f32x4 lo, hi; ld_shift8(ur + (size_t)t * UW + col, (n * CH + t) > 0, mu + col, lo, hi);
        if (part == 0) {
#pragma unroll
            for (int j = 0; j < 4; ++j) { lo[j] = ftanh(lo[j]); hi[j] = ftanh(hi[j]); } }
        *(LAS u32x4*)(W + part * 4608 + t * LD64 + ch * 16) = pack8(lo, hi); }
    RW_CUT(0);
    LDS_WAIT();
    { f32x16 zw[2], za[2];
#pragma unroll
      for (int ct = 0; ct < 2; ++ct) { zw[ct] = zero16(); za[ct] = zero16();
#pragma unroll
        for (int ks = 0; ks < 4; ++ks) { zw[ct] = mma32(frag_g(upT + (size_t)(h * 64 + 32 * ct) * 64, 64, 0, 16 * ks, lane), frag_rm(W, LD64, 0, 16 * ks, lane), zw[ct]);
            za[ct] = mma32(frag_g(upT + 256 * 64 + (size_t)(h * 64 + 32 * ct) * 64, 64, 0, 16 * ks, lane), frag_rm(W + 4608, LD64, 0, 16 * ks, lane), za[ct]); } }
      const float* w0 = F.in[I_W0] + L * 256 + h * 64; const float* a0 = F.in[I_A0] + L * 256 + h * 64;
#pragma unroll
      for (int ct = 0; ct < 2; ++ct)
#pragma unroll
        for (int g = 0; g < 4; ++g) { const int c0 = 32 * ct + 8 * g + 4 * hh; const f32x4 wv = *(const f32x4*)(w0 + c0), av = *(const f32x4*)(a0 + c0);
            f32x4 lw, ag;
#pragma unroll
            for (int x = 0; x < 4; ++x) { lw[x] = -0.6065306597126334f * fsigmoid(zw[ct][4 * g + x] + wv[x]); ag[x] = fsigmoid(za[ct][4 * g + x] + av[x]); }
            *(LAS f32x4*)(W + RW_LW + r32 * LDLW + c0 * 4) = lw;
            u32x2 pk; pk.x = cvt_pk_bf16(ag[0], ag[1]); pk.y = cvt_pk_bf16(ag[2], ag[3]); *(LAS u32x2*)(W + RW_AG + r32 * LD64 + c0 * 2) = pk; } }
    RW_CUT(1);
    LDS_WAIT();
    { float run = 0.f;
#pragma unroll
      for (int t = 0; t < CH; ++t) { LAS float* p = (LAS float*)(W + RW_LW + t * LDLW) + lane; run += *p; *p = run; } }
    RW_CUT(2);
    LDS_WAIT();
    const int c0 = 8 * (lane & 7), tl = lane >> 3;
    u32x4 E1p[4], E2p[4], AGp[4];
#pragma unroll
    for (int p = 0; p < 4; ++p) { const int t = 8 * p + tl;
        const f32x4 ca = *(const LAS f32x4*)(W + RW_LW + t * LDLW + c0 * 4), cb = *(const LAS f32x4*)(W + RW_LW + t * LDLW + c0 * 4 + 16);
        f32x4 ea = {0.f, 0.f, 0.f, 0.f}, eb = {0.f, 0.f, 0.f, 0.f};
        if (t > 0) { ea = *(const LAS f32x4*)(W + RW_LW + (t - 1) * LDLW + c0 * 4); eb = *(const LAS f32x4*)(W + RW_LW + (t - 1) * LDLW + c0 * 4 + 16); }
        AGp[p] = *(const LAS u32x4*)(W + RW_AG + t * LD64 + c0 * 2);
        f32x4 x1a, x1b, x2a, x2b;
#pragma unroll
        for (int x = 0; x < 4; ++x) { x1a[x] = __expf(ea[x]); x1b[x] = __expf(eb[x]); x2a[x] = __expf(-ca[x]); x2b[x] = __expf(-cb[x]); }
        E1p[p] = pack8(x1a, x1b); E2p[p] = pack8(x2a, x2b); }
    float pcl[8];
    { const f32x4 la = *(const LAS f32x4*)(W + RW_LW + 31 * LDLW + c0 * 4), lb2 = *(const LAS f32x4*)(W + RW_LW + 31 * LDLW + c0 * 4 + 16);
#pragma unroll
      for (int x = 0; x < 4; ++x) { pcl[x] = __expf(la[x]); pcl[4 + x] = __expf(lb2[x]); } }
    RW_CUT(3);
    LDS_WAIT();
    const float* kkw = F.in[I_KK] + L * 256 + h * 64 + c0; const float* kaw = F.in[I_KA] + L * 256 + h * 64 + c0; const float* rkw = F.in[I_RK] + L * 256 + h * 64 + c0;
    u32x4 Ap[4];
    if (!M3 && tl == 0) { *(LAS f32x4*)(R5 + c0) = (f32x4){pcl[0], pcl[1], pcl[2], pcl[3]}; *(LAS f32x4*)(R5 + c0 + 4) = (f32x4){pcl[4], pcl[5], pcl[6], pcl[7]}; }
#pragma unroll
    for (int p = 0; p < 4; ++p) { const int t = 8 * p + tl; const bool hp = (n * CH + t) > 0; const bf16* ut = ur + (size_t)t * UW + h * 64 + c0;
        f32x4 k0, k1, r0 = {0.f, 0.f, 0.f, 0.f}, r1 = {0.f, 0.f, 0.f, 0.f};
        ld_shift8(ut + 256, hp, mu + 256 + h * 64 + c0, k0, k1);
        if (M3) ld_shift8(ut, hp, mu + h * 64 + c0, r0, r1);
        f32x4 ag0, ag1; unpack8(AGp[p], ag0, ag1);
        float E1[8], E2[8]; { f32x4 a, bq; unpack8(E1p[p], a, bq); f32x4 c, d; unpack8(E2p[p], c, d);
#pragma unroll
            for (int x = 0; x < 4; ++x) { E1[x] = a[x]; E1[4 + x] = bq[x]; E2[x] = c[x]; E2[4 + x] = d[x]; } }
        const f32x4 kw0 = *(const f32x4*)kkw, kw1 = *(const f32x4*)(kkw + 4), ka0 = *(const f32x4*)kaw, ka1 = *(const f32x4*)(kaw + 4);
        f32x4 q0 = k0 * kw0, q1 = k1 * kw1;
        float n2 = (q0[0] * q0[0] + q0[1] * q0[1]) + (q0[2] * q0[2] + q0[3] * q0[3]) + (q1[0] * q1[0] + q1[1] * q1[1]) + (q1[2] * q1[2] + q1[3] * q1[3]);
        n2 += __shfl_xor(n2, 1); n2 += __shfl_xor(n2, 2); n2 += __shfl_xor(n2, 4);
        const float rn = __builtin_amdgcn_rsqf(fmaxf(n2, 1e-24f)); q0 = q0 * rn; q1 = q1 * rn;
        f32x4 kp0, kp1, at0, at1, bt0, bt1, kt0, kt1;
#pragma unroll
        for (int x = 0; x < 4; ++x) { kp0[x] = k0[x] * (1.0f + (ag0[x] - 1.0f) * ka0[x]); kp1[x] = k1[x] * (1.0f + (ag1[x] - 1.0f) * ka1[x]);
            at0[x] = -q0[x] * E1[x]; at1[x] = -q1[x] * E1[4 + x]; bt0[x] = q0[x] * ag0[x] * E2[x]; bt1[x] = q1[x] * ag1[x] * E2[4 + x];
            kt0[x] = kp0[x] * E2[x]; kt1[x] = kp1[x] * E2[4 + x]; }
        *(LAS u32x4*)(R1 + t * LD64 + c0 * 2) = pack8(bt0, bt1); *(LAS u32x4*)(R2 + t * LD64 + c0 * 2) = pack8(kt0, kt1);
        if (!M3) *(LAS u32x4*)(R0 + t * LD64 + c0 * 2) = pack8(at0, at1);
        else { Ap[p] = pack8(at0, at1);
            const f32x4 rk0 = *(const f32x4*)rkw, rk1 = *(const f32x4*)(rkw + 4);
            f32x4 rt0, rt1; float bs = 0.f;
#pragma unroll
            for (int x = 0; x < 4; ++x) { rt0[x] = r0[x] * __builtin_amdgcn_rcpf(E2[x]); rt1[x] = r1[x] * __builtin_amdgcn_rcpf(E2[4 + x]); bs += r0[x] * kp0[x] * rk0[x] + r1[x] * kp1[x] * rk1[x]; }
            bs += __shfl_xor(bs, 1); bs += __shfl_xor(bs, 2); bs += __shfl_xor(bs, 4);
            if ((lane & 7) == 0) R5[t] = bs;
            *(LAS u32x4*)(R0 + t * LD64 + c0 * 2) = pack8(rt0, rt1); } }
    RW_CUT(4);
    LDS_WAIT();
    const bf16* S0 = n > 0 ? (const bf16*)((unsigned char*)F.out + DO_RWS) + ((size_t)bh * NCH + n - 1) * 4096 : nullptr;
    f32x16 yacc[2], g2acc;
    if (M3) {
#pragma unroll
        for (int vt = 0; vt < 2; ++vt) { yacc[vt] = zero16();
            if (S0) {
#pragma unroll
                for (int ks = 0; ks < 4; ++ks) yacc[vt] = mma32(frag_g(S0, 64, 32 * vt, 16 * ks, lane), frag_rm(R0, LD64, 0, 16 * ks, lane), yacc[vt]); } }
        f32x16 g1 = zero16(); g2acc = zero16();
#pragma unroll
        for (int ks = 0; ks < 4; ++ks) { const bf16x8 rf = frag_rm(R0, LD64, 0, 16 * ks, lane); g1 = mma32(frag_rm(R1, LD64, 0, 16 * ks, lane), rf, g1); g2acc = mma32(frag_rm(R2, LD64, 0, 16 * ks, lane), rf, g2acc); }
#pragma unroll
        for (int i = 0; i < 16; ++i) { const int sidx = (i & 3) + 8 * (i >> 2) + 4 * hh; if (sidx > r32) { g1[i] = 0.f; g2acc[i] = 0.f; } }
        st_T(R4, LD32, 0, 0, g1, lane);
        LDS_WAIT();
#pragma unroll
        for (int p = 0; p < 4; ++p) *(LAS u32x4*)(R0 + (8 * p + tl) * LD64 + c0 * 2) = Ap[p];
        LDS_WAIT();
    }
    RW_CUT(5);
    { f32x16 ab = zero16(), ak = zero16();
#pragma unroll
      for (int ks = 0; ks < 4; ++ks) { const bf16x8 af = frag_rm(R0, LD64, 0, 16 * ks, lane); if (!M3) ab = mma32(af, frag_rm(R1, LD64, 0, 16 * ks, lane), ab); ak = mma32(frag_rm(R2, LD64, 0, 16 * ks, lane), af, ak); }
#pragma unroll
      for (int i = 0; i < 16; ++i) { const int ridx = (i & 3) + 8 * (i >> 2) + 4 * hh;
          if (!(ridx > r32)) ab[i] = 0.f;
          if (!(ridx < r32)) ak[i] = 0.f; }
      if (!M3) st_T(R3, LD32, 0, 0, ab, lane);
      st_T(M3 ? R2 : R4, LD32, 0, 0, ak, lane); }
    LAS unsigned char* X1 = M3 ? R2 : R4;
    RW_CUT(6);
    LDS_WAIT();
    if (!M3) {
      float Tr[CH];
      int sofs = 0; asm volatile("" : "+v"(sofs)); SubstStep<CH - 1>::run(Tr, R3, r32, sofs);
      if (hh == 0) {
#pragma unroll
          for (int q = 0; q < 4; ++q) { f32x4 lo = {Tr[8 * q], Tr[8 * q + 1], Tr[8 * q + 2], Tr[8 * q + 3]}, hi = {Tr[8 * q + 4], Tr[8 * q + 5], Tr[8 * q + 6], Tr[8 * q + 7]};
              const u32x4 w = pack8(lo, hi); *(LAS u32x4*)(R3 + r32 * LD32 + q * 16) = w; *(u32x4*)(Tg + r32 * 32 + q * 8) = w; } }
    } else if (hh == 0) {
#pragma unroll
        for (int q = 0; q < 4; ++q) *(LAS u32x4*)(R3 + r32 * LD32 + q * 16) = *(const u32x4*)(Tg + r32 * 32 + q * 8);
    }
    RW_CUT(7);
    LDS_WAIT();
    { f32x16 y = zero16(), ah[2];
#pragma unroll
      for (int ks = 0; ks < 2; ++ks) y = mma32(frag_tr(X1, LD32, 16 * ks, 0, lane), frag_rm(R3, LD32, 0, 16 * ks, lane), y);
#pragma unroll
      for (int ct = 0; ct < 2; ++ct) { ah[ct] = zero16();
#pragma unroll
        for (int ks = 0; ks < 2; ++ks) ah[ct] = mma32(frag_tr(R0, LD64, 16 * ks, 32 * ct, lane), frag_rm(R3, LD32, 0, 16 * ks, lane), ah[ct]); }
      st_T(X1, LD32, 0, 0, y, lane);
      st_T(R0, LD64, 0, 0, ah[0], lane); st_T(R0, LD64, 0, 32, ah[1], lane); }
    RW_CUT(8);
    LDS_WAIT();
    if (!M3) {
        { f32x16 z[2];
#pragma unroll
          for (int dt = 0; dt < 2; ++dt) {
#pragma unroll
            for (int g = 0; g < 4; ++g) { const u32x2 w = *(const LAS u32x2*)(R2 + r32 * LD64 + (32 * dt + 8 * g + 4 * hh) * 2); z[dt][4 * g] = bflo(w.x); z[dt][4 * g + 1] = bfhi(w.x); z[dt][4 * g + 2] = bflo(w.y); z[dt][4 * g + 3] = bfhi(w.y); }
#pragma unroll
            for (int ks = 0; ks < 2; ++ks) z[dt] = mma32(frag_tr(R1, LD64, 16 * ks, 32 * dt, lane), frag_tr(X1, LD32, 16 * ks, 0, lane), z[dt]); }
          st_T(R2, LD64, 0, 0, z[0], lane); st_T(R2, LD64, 0, 32, z[1], lane); }
#pragma unroll
        for (int d1t = 0; d1t < 2; ++d1t) { const float pc1 = R5[32 * d1t + r32];
#pragma unroll
            for (int d2t = 0; d2t < 2; ++d2t) { f32x16 m = zero16();
#pragma unroll
                for (int ks = 0; ks < 2; ++ks) m = mma32(frag_tr(R0, LD64, 16 * ks, 32 * d2t, lane), frag_tr(R1, LD64, 16 * ks, 32 * d1t, lane), m);
#pragma unroll
                for (int i = 0; i < 16; ++i) { const int d2 = 32 * d2t + (i & 3) + 8 * (i >> 2) + 4 * hh; m[i] = pc1 * (m[i] + ((d2 == 32 * d1t + r32) ? 1.0f : 0.f)); }
                st_T_g<false>(Mg, 64, 32 * d1t, 32 * d2t, m, lane); } }
        LDS_WAIT();
#pragma unroll
        for (int p = 0; p < 4; ++p) { const int t = 8 * p + tl; f32x4 v0, v1; ld_shift8(ur + (size_t)t * UW + h * 64 + c0 + 512, (n * CH + t) > 0, mu + 512 + h * 64 + c0, v0, v1); *(LAS u32x4*)(R1 + t * LD64 + c0 * 2) = pack8(v0, v1); }
        LDS_WAIT();
#pragma unroll
        for (int dt = 0; dt < 2; ++dt)
#pragma unroll
            for (int vt = 0; vt < 2; ++vt) { f32x16 nn = zero16();
#pragma unroll
                for (int ks = 0; ks < 2; ++ks) nn = mma32(frag_tr(R2, LD64, 16 * ks, 32 * dt, lane), frag_tr(R1, LD64, 16 * ks, 32 * vt, lane), nn);
#pragma unroll
                for (int g = 0; g < 4; ++g) { const f32x4 pv = *(const LAS f32x4*)(R5 + 32 * dt + 8 * g + 4 * hh);
#pragma unroll
                    for (int x = 0; x < 4; ++x) nn[4 * g + x] *= pv[x]; }
                st_T_g<false>(Ng, 64, 32 * vt, 32 * dt, nn, lane); }
    } else {
        { f32x16 rh[2];
#pragma unroll
          for (int dt = 0; dt < 2; ++dt) { rh[dt] = zero16();
#pragma unroll
            for (int ks = 0; ks < 2; ++ks) rh[dt] = mma32(frag_tr(R0, LD64, 16 * ks, 32 * dt, lane), frag_rm(R4, LD32, 0, 16 * ks, lane), rh[dt]); }
          st_T(R1, LD64, 0, 0, rh[0], lane); st_T(R1, LD64, 0, 32, rh[1], lane); }
        { f32x16 gh = g2acc;
#pragma unroll
          for (int ks = 0; ks < 2; ++ks) gh = mma32(frag_tr(X1, LD32, 16 * ks, 0, lane), frag_rm(R4, LD32, 0, 16 * ks, lane), gh);
          LDS_WAIT();
          st_T(R3, LD32, 0, 0, gh, lane); }
        LDS_WAIT();
        if (S0) {
#pragma unroll
            for (int vt = 0; vt < 2; ++vt)
#pragma unroll
                for (int ks = 0; ks < 4; ++ks) yacc[vt] = mma32(frag_g(S0, 64, 32 * vt, 16 * ks, lane), frag_rm(R1, LD64, 0, 16 * ks, lane), yacc[vt]); }
        LDS_WAIT();
#pragma unroll
        for (int p = 0; p < 4; ++p) { const int t = 8 * p + tl; f32x4 v0, v1; ld_shift8(ur + (size_t)t * UW + h * 64 + c0 + 512, (n * CH + t) > 0, mu + 512 + h * 64 + c0, v0, v1); *(LAS u32x4*)(R0 + t * LD64 + c0 * 2) = pack8(v0, v1); }
#pragma unroll
        for (int i = 0; i < 8; ++i) { const int idx = lane + 64 * i, t = idx >> 4, ch = idx & 15, col = 896 + ch * 8;
            f32x4 lo, hi; ld_shift8(ur + (size_t)t * UW + col, (n * CH + t) > 0, mu + col, lo, hi);
#pragma unroll
            for (int j = 0; j < 4; ++j) { lo[j] = fsigmoid(lo[j]); hi[j] = fsigmoid(hi[j]); }
            *(LAS u32x4*)(R1 + t * LDLW + ch * 16) = pack8(lo, hi); }
        LDS_WAIT();
        f32x16 gacc[2];
#pragma unroll
        for (int vt = 0; vt < 2; ++vt) {
#pragma unroll
            for (int ks = 0; ks < 2; ++ks) yacc[vt] = mma32(frag_tr(R0, LD64, 16 * ks, 32 * vt, lane), frag_rm(R3, LD32, 0, 16 * ks, lane), yacc[vt]);
            gacc[vt] = zero16();
#pragma unroll
            for (int ks = 0; ks < 8; ++ks) gacc[vt] = mma32(frag_g(upT + 2 * 256 * 64 + (size_t)(h * 64 + 32 * vt) * 128, 128, 0, 16 * ks, lane), frag_rm(R1, LDLW, 0, 16 * ks, lane), gacc[vt]); }
        float sm = 0.f;
#pragma unroll
        for (int vt = 0; vt < 2; ++vt)
#pragma unroll
            for (int i = 0; i < 16; ++i) sm += yacc[vt][i];
        sm += __shfl_xor(sm, 32);
        const float mean = sm * (1.0f / 64.0f); float sv = 0.f;
#pragma unroll
        for (int vt = 0; vt < 2; ++vt)
#pragma unroll
            for (int i = 0; i < 16; ++i) { const float dl = yacc[vt][i] - mean; sv += dl * dl; }
        sv += __shfl_xor(sv, 32);
        const float rstd = __builtin_amdgcn_rsqf(sv * (1.0f / 64.0f) + 64e-5f);
        const float bon = R5[r32];
        const float* ng = F.in[I_RW_G] + L * 256 + h * 64; const float* nb = F.in[I_RW_B] + L * 256 + h * 64;
#pragma unroll
        for (int vt = 0; vt < 2; ++vt)
#pragma unroll
            for (int g = 0; g < 4; ++g) { const int v0i = 32 * vt + 8 * g + 4 * hh;
                const u32x2 vw = *(const LAS u32x2*)(R0 + r32 * LD64 + v0i * 2); const f32x4 gg = *(const f32x4*)(ng + v0i), bb = *(const f32x4*)(nb + v0i);
                const float vv[4] = {bflo(vw.x), bfhi(vw.x), bflo(vw.y), bfhi(vw.y)}; float o[4];
#pragma unroll
                for (int x = 0; x < 4; ++x) o[x] = ((yacc[vt][4 * g + x] - mean) * rstd * gg[x] + bb[x] + bon * vv[x]) * gacc[vt][4 * g + x];
                u32x2 w; w.x = cvt_pk_bf16(o[0], o[1]); w.y = cvt_pk_bf16(o[2], o[3]);
                *(u32x2*)(bo + (row0 + r32) * 1024 + 768 + h * 64 + v0i) = w; }
    }
    LDS_WAIT();
}
__device__ __forceinline__ void rwkv_scan_task(Frame& F, int bh, int vh) {
    const int lane = F.lane, r32 = lane & 31, hh = lane >> 5;
    const bf16* Mb = (const bf16*)(F.ws + WS_RWM) + (size_t)bh * NCH * 4096; bf16* Nb = (bf16*)(F.ws + WS_RWN) + (size_t)bh * NCH * 4096 + (size_t)(vh * 32 + r32) * 64;
    f32x16 st[2] = {zero16(), zero16()};
    u32x2 nq[2][4], mq[2][2][2][2];
#define RW_PREF(nn) do { _Pragma("unroll") for (int dt = 0; dt < 2; ++dt) _Pragma("unroll") for (int g = 0; g < 4; ++g) nq[dt][g] = *(const u32x2*)(Nb + (size_t)(nn) * 4096 + 32 * dt + 8 * g + 4 * hh); \
        _Pragma("unroll") for (int d1t = 0; d1t < 2; ++d1t) _Pragma("unroll") for (int dt = 0; dt < 2; ++dt) _Pragma("unroll") for (int s2 = 0; s2 < 2; ++s2) { \
            const bf16* mp = Mb + (size_t)(nn) * 4096 + (size_t)(32 * d1t + r32) * 64 + 32 * dt + 16 * s2 + 4 * hh; mq[d1t][dt][s2][0] = *(const u32x2*)mp; mq[d1t][dt][s2][1] = *(const u32x2*)(mp + 8); } } while (0)
    RW_PREF(0);
    for (int n = 0; n < NCH; ++n) {
        bf16x8 bfr[2][2];
#pragma unroll
        for (int dt = 0; dt < 2; ++dt)
#pragma unroll
            for (int s2 = 0; s2 < 2; ++s2) { union { bf16x8 v; unsigned w[4]; } pf;
#pragma unroll
                for (int j = 0; j < 4; ++j) pf.w[j] = cvt_pk_bf16(st[dt][8 * s2 + 2 * j], st[dt][8 * s2 + 2 * j + 1]);
                bfr[dt][s2] = pf.v; }
        f32x16 nw[2];
#pragma unroll
        for (int d1t = 0; d1t < 2; ++d1t) {
#pragma unroll
            for (int g = 0; g < 4; ++g) { nw[d1t][4 * g] = bflo(nq[d1t][g].x); nw[d1t][4 * g + 1] = bfhi(nq[d1t][g].x); nw[d1t][4 * g + 2] = bflo(nq[d1t][g].y); nw[d1t][4 * g + 3] = bfhi(nq[d1t][g].y); }
#pragma unroll
            for (int dt = 0; dt < 2; ++dt)
#pragma unroll
                for (int s2 = 0; s2 < 2; ++s2) { union { bf16x8 v; u32x2 d[2]; } mf; mf.d[0] = mq[d1t][dt][s2][0]; mf.d[1] = mq[d1t][dt][s2][1]; nw[d1t] = mma32(mf.v, bfr[dt][s2], nw[d1t]); } }
        if (n + 1 < NCH) RW_PREF(n + 1);
#pragma unroll
        for (int d1t = 0; d1t < 2; ++d1t) { st[d1t] = nw[d1t];
            st_T_g<false>((bf16*)((unsigned char*)F.out + DO_RWS) + ((size_t)bh * NCH + n) * 4096, 64, vh * 32, 32 * d1t, nw[d1t], lane); }
    }
#undef RW_PREF
}

constexpr int NS_KROW = 144, NS_VROW = 144;
constexpr int NS_KB = 64 * NS_KROW, NS_VB = 64 * NS_VROW;
constexpr int NS_K0 = 0, NS_V0 = 2 * NS_KB, NS_IMP = NS_V0 + 2 * NS_VB, NS_SEL = NS_IMP + 64 * 128 * 4, NS_END = NS_SEL + 64 * 4 * 4;
constexpr int NS_OUT = NS_END, NS_END2 = NS_OUT + 8 * 8192;
static_assert(NS_END2 <= MISC_OFF, "nsa lds");
struct NsaRow { float m, l; f32x16 o[2]; };
__device__ __forceinline__ void ns_load(const bf16* kb, const bf16* vb, size_t stride, int tid, u32x4& kr, u32x4& vr) {
    const int key = tid >> 3, ch = tid & 7; kr = *(const u32x4*)(kb + (size_t)key * stride + ch * 8); vr = *(const u32x4*)(vb + (size_t)key * stride + ch * 8);
}
__device__ __forceinline__ void ns_store(LAS unsigned char* Kb, LAS unsigned char* Vb, int tid, const u32x4& kr, const u32x4& vr) {
    const int key = tid >> 3, ch = tid & 7;
    *(LAS u32x4*)(Kb + key * NS_KROW + ch * 16) = kr;
    *(LAS u32x4*)(Vb + key * NS_VROW + ch * 16) = vr;
}
__device__ __forceinline__ void ns_qk(LAS unsigned char* Kb, const bf16x8 (&qf)[4], int r, int h2, f32x16 (&sacc)[2]) {
#pragma unroll
    for (int sub = 0; sub < 2; ++sub) { f32x16 a;
#pragma unroll
        for (int i = 0; i < 16; ++i) a[i] = 0.f;
#pragma unroll
        for (int kk = 0; kk < 4; ++kk) { const bf16x8 kf = *(const LAS bf16x8*)(Kb + (32 * sub + r) * NS_KROW + (8 * h2 + 16 * kk) * 2); a = __builtin_amdgcn_mfma_f32_32x32x16_bf16(kf, qf[kk], a, 0, 0, 0); }
        sacc[sub] = a; }
}
enum { NS_CMP = 0, NS_SEL_ = 1, NS_WIN = 2 };
template <int MODE> __device__ __forceinline__ bool ns_valid(int key, int t, bool blk_on) {
    if (MODE == NS_CMP) return 16 * key + 31 <= t;
    if (MODE == NS_SEL_) return blk_on && key <= t;
    return key <= t && key + 511 >= t;
}
template <int MODE>
__device__ __forceinline__ void ns_branch(Frame& F, const bf16* kbase, const bf16* vbase, size_t stride, int tile_lo, int tile_hi, const bf16x8 (&qf)[4], int t, int r, int h2,
                                          const unsigned (&selw)[4], NsaRow& R) {
    LAS unsigned char* L = F.lds;
    R.m = -1e30f; R.l = 0.f;
#pragma unroll
    for (int e = 0; e < 2; ++e)
#pragma unroll
        for (int i = 0; i < 16; ++i) R.o[e][i] = 0.f;
    if (tile_hi <= tile_lo) return;
    u32x4 kr, vr;
    ns_load(kbase + (size_t)tile_lo * 64 * stride, vbase + (size_t)tile_lo * 64 * stride, stride, F.tid, kr, vr);
    __syncthreads();
    ns_store(L + NS_K0, L + NS_V0, F.tid, kr, vr);
    __syncthreads();
    for (int ti = tile_lo; ti < tile_hi; ++ti) {
        const int buf = (ti - tile_lo) & 1;
        if (ti + 1 < tile_hi) ns_load(kbase + (size_t)(ti + 1) * 64 * stride, vbase + (size_t)(ti + 1) * 64 * stride, stride, F.tid, kr, vr);
        LAS unsigned char* Kb = L + NS_K0 + buf * NS_KB; LAS unsigned char* Vb = L + NS_V0 + buf * NS_VB;
        bool blk_on = true;
        if (MODE == NS_SEL_) blk_on = (selw[ti >> 5] >> (ti & 31)) & 1u;
        bool any;
        if (MODE == NS_CMP) any = 16 * (ti * 64) + 31 <= t; else if (MODE == NS_SEL_) any = blk_on && ti * 64 <= t; else any = (ti * 64 <= t) && (ti * 64 + 63 + 511 >= t);
        if (__ballot(any) != 0ull) {
            f32x16 sacc[2];
            ns_qk(Kb, qf, r, h2, sacc);
            bool full;
            { const int tmin = t - (r & 7), tmax = tmin + 7;
              if (MODE == NS_CMP) full = 16 * (ti * 64 + 63) + 31 <= tmin; else if (MODE == NS_SEL_) full = ti * 64 + 63 <= tmin; else full = (ti * 64 + 63 <= tmin) && (ti * 64 + 511 >= tmax); }
            float sc, rs = 0.f;
            if (full) {
                const bool rowon = (MODE != NS_SEL_) || blk_on;
                float m0 = sacc[0][0], m1 = sacc[1][0];
#pragma unroll
                for (int i = 1; i < 16; ++i) { m0 = fmaxf(m0, sacc[0][i]); m1 = fmaxf(m1, sacc[1][i]); }
                float mt = rowon ? fmaxf(m0, m1) : -1e30f;
                mt = fmaxf(mt, __shfl_xor(mt, 32));
                const float mn = fmaxf(R.m, mt); sc = __expf(R.m - mn);
                const float nb = -1.44269504f * (rowon ? mn : 1e30f);
#pragma unroll
                for (int sub = 0; sub < 2; ++sub)
#pragma unroll
                    for (int i = 0; i < 16; ++i) { const float p = __builtin_amdgcn_exp2f(__builtin_fmaf(sacc[sub][i], 1.44269504f, nb)); sacc[sub][i] = p; rs += p; }
                rs += __shfl_xor(rs, 32);
                R.l = R.l * sc + rs; R.m = mn;
            } else {
            float mt = -1e30f;
#pragma unroll
            for (int sub = 0; sub < 2; ++sub)
#pragma unroll
                for (int i = 0; i < 16; ++i) { const int key = ti * 64 + 32 * sub + (i & 3) + 8 * (i >> 2) + 4 * h2; const float sv = ns_valid<MODE>(key, t, blk_on) ? sacc[sub][i] : -1e30f; sacc[sub][i] = sv; mt = fmaxf(mt, sv); }
            mt = fmaxf(mt, __shfl_xor(mt, 32));
            const float mn = fmaxf(R.m, mt); sc = __expf(R.m - mn);
#pragma unroll
            for (int sub = 0; sub < 2; ++sub)
#pragma unroll
                for (int i = 0; i < 16; ++i) { const float sv = sacc[sub][i]; const float p = sv > -1e29f ? __expf(sv - mn) : 0.f; sacc[sub][i] = p; rs += p; }
            rs += __shfl_xor(rs, 32);
            R.l = R.l * sc + rs; R.m = mn;
            }
            if (__ballot(sc != 1.0f) != 0ull) {
#pragma unroll
                for (int e = 0; e < 2; ++e)
#pragma unroll
                    for (int i = 0; i < 16; ++i) R.o[e][i] *= sc; }
#pragma unroll
            for (int sub = 0; sub < 2; ++sub)
#pragma unroll
                for (int s2 = 0; s2 < 2; ++s2) {
                    union { bf16x8 v; unsigned w[4]; } pf;
#pragma unroll
                    for (int j = 0; j < 4; ++j) pf.w[j] = cvt_pk_bf16(sacc[sub][8 * s2 + 2 * j], sacc[sub][8 * s2 + 2 * j + 1]);
#pragma unroll
                    for (int e = 0; e < 2; ++e) {
                        const LAS unsigned char* vp = Vb + (32 * sub + 16 * s2 + 4 * h2 + ((F.lane & 15) >> 2)) * NS_VROW + (32 * e + 16 * ((F.lane >> 4) & 1) + 4 * (F.lane & 3)) * 2;
                        const s16x4 va = __builtin_amdgcn_ds_read_tr16_b64_v4i16((LAS s16x4*)vp), vb = __builtin_amdgcn_ds_read_tr16_b64_v4i16((LAS s16x4*)(vp + 8 * NS_VROW));
                        const bf16x8 vf = {va[0], va[1], va[2], va[3], vb[0], vb[1], vb[2], vb[3]};
                        R.o[e] = __builtin_amdgcn_mfma_f32_32x32x16_bf16(vf, pf.v, R.o[e], 0, 0, 0);
                    }
                }
        }
        if (ti + 1 < tile_hi) ns_store(L + NS_K0 + (buf ^ 1) * NS_KB, L + NS_V0 + (buf ^ 1) * NS_VB, F.tid, kr, vr);
        __syncthreads();
    }
}
__device__ __forceinline__ void ns_importance(Frame& F, const bf16* kbase, int ntiles, const bf16x8 (&qf)[4], int t, int r, int h2, float m, float inv_l) {
    LAS unsigned char* L = F.lds; LAS float* imp = (LAS float*)(L + NS_IMP);
    const int qrow = F.wave * 8 + (r & 7);
    u32x4 kr, vr;
    ns_load(kbase, kbase, 64, F.tid, kr, vr);
    __syncthreads();
    ns_store(L + NS_K0, L + NS_V0, F.tid, kr, vr);
    __syncthreads();
    for (int ti = 0; ti < ntiles; ++ti) {
        const int buf = ti & 1;
        if (ti + 1 < ntiles) ns_load(kbase + (size_t)(ti + 1) * 64 * 64, kbase + (size_t)(ti + 1) * 64 * 64, 64, F.tid, kr, vr);
        LAS unsigned char* Kb = L + NS_K0 + buf * NS_KB;
        f32x16 sacc[2];
        ns_qk(Kb, qf, r, h2, sacc);
#pragma unroll
        for (int sub = 0; sub < 2; ++sub)
#pragma unroll
            for (int g = 0; g < 4; ++g) {
                float p[4];
#pragma unroll
                for (int x = 0; x < 4; ++x) { const int key = ti * 64 + 32 * sub + x + 8 * g + 4 * h2; p[x] = (16 * key + 31 <= t) ? __expf(sacc[sub][4 * g + x] - m) * inv_l : 0.f; }
                float G = (p[0] + p[1]) + (p[2] + p[3]), E = p[3];
                G += __shfl_xor(G, 8); G += __shfl_xor(G, 16); E += __shfl_xor(E, 8); E += __shfl_xor(E, 16);
                const int jj = ti * 16 + 8 * sub + 2 * g + h2;
                if (r < 8) { atomicAdd((float*)(imp + qrow * 128 + jj), G); if (jj + 1 < 128) atomicAdd((float*)(imp + qrow * 128 + jj + 1), E); }
            }
        if (ti + 1 < ntiles) ns_store(L + NS_K0 + (buf ^ 1) * NS_KB, L + NS_V0 + (buf ^ 1) * NS_VB, F.tid, kr, vr);
        __syncthreads();
    }
}
__device__ __forceinline__ void nsa_unit(Frame& F0, int b, int c) {
    Frame F = F0; asm volatile("" : "+v"(F.tid)); F.lane = F.tid & 63;
    const bf16* u = (const bf16*)(F.ws + WS_U); bf16* bo = (bf16*)(F.ws + WS_BO);
    const bf16* kcmp = (const bf16*)(F.ws + WS_KCMP) + (size_t)b * 512 * 64; const bf16* vcmp = (const bf16*)(F.ws + WS_VCMP) + (size_t)b * 512 * 64;
    LAS unsigned char* L = F.lds; LAS float* imp = (LAS float*)(L + NS_IMP); LAS unsigned* selL = (LAS unsigned*)(L + NS_SEL);
    int lane = F.lane; asm volatile("" : "+v"(lane));
    const int r = lane & 31, h2 = lane >> 5, head = r >> 3, ql = r & 7;
    const int t = 64 * c + 8 * F.wave + ql; const size_t row = (size_t)b * S + t;
    const bf16* ub = u + (size_t)b * S * UW;
    bf16x8 qf[4];
#pragma unroll
    for (int kk = 0; kk < 4; ++kk) { const u32x4 w = *(const u32x4*)(u + row * UW + U_NSA + head * 64 + 8 * h2 + 16 * kk); f32x4 a, bb; unpack8(w, a, bb);
        union { bf16x8 v; u32x4 q; } cv; cv.q = pack8(a * 0.125f, bb * 0.125f); qf[kk] = cv.v; }
    const float g_cmp = fsigmoid(ldu(u, row, U_NSA + 640 + head)), g_sel = fsigmoid(ldu(u, row, U_NSA + 644 + head)), g_win = fsigmoid(ldu(u, row, U_NSA + 648 + head));
    unsigned selw[4] = {0xffffffffu, 0xffffffffu, 0xffffffffu, 0xffffffffu};
    NsaRow R;
    const int ncmp_tiles = (4 * c + 3 + 63) >> 6;
    ns_branch<NS_CMP>(F, kcmp, vcmp, 64, 0, ncmp_tiles, qf, t, r, h2, selw, R);
    LAS f32x4* stash = (LAS f32x4*)(L + NS_OUT + F.wave * 8192) + lane;
    { const float inv = R.l > 0.f ? 1.0f / R.l : 0.f; const float gs = g_cmp * inv;
#pragma unroll
      for (int e = 0; e < 2; ++e)
#pragma unroll
        for (int g = 0; g < 4; ++g) stash[(e * 4 + g) * 64] = (f32x4){R.o[e][4 * g] * gs, R.o[e][4 * g + 1] * gs, R.o[e][4 * g + 2] * gs, R.o[e][4 * g + 3] * gs};
      if (c >= 15) {
        for (int i = F.tid; i < 64 * 128; i += NTHR) imp[i] = 0.f;
        __syncthreads();
        ns_importance(F, kcmp, ncmp_tiles, qf, t, r, h2, R.m, inv);
        for (int q8 = 0; q8 < 8; ++q8) { const int qrow = F.wave * 8 + q8;
            float sc0, sc1;
            { const int j0 = lane, j1 = lane + 64;
              const bool f0 = (j0 == 0) || (j0 == c) || (j0 == c - 1), f1 = (j1 == c) || (j1 == c - 1);
              sc0 = f0 ? 1e30f : (j0 <= c ? imp[qrow * 128 + j0] : -1e30f); sc1 = f1 ? 1e30f : (j1 <= c ? imp[qrow * 128 + j1] : -1e30f); }
            unsigned long long lo = 0ull, hi = 0ull;
            for (int it = 0; it < 16; ++it) {
                const float best = wave_max(fmaxf(sc0, sc1));
                const unsigned long long m0 = __ballot(sc0 == best), m1 = __ballot(sc1 == best);
                int idx; if (m0) idx = __builtin_ctzll(m0); else idx = 64 + __builtin_ctzll(m1);
                if (idx < 64) { lo |= 1ull << idx; if (lane == idx) sc0 = -3e38f; } else { hi |= 1ull << (idx - 64); if (lane == idx - 64) sc1 = -3e38f; }
            }
            if (lane == 0) { selL[qrow * 4 + 0] = (unsigned)lo; selL[qrow * 4 + 1] = (unsigned)(lo >> 32); selL[qrow * 4 + 2] = (unsigned)hi; selL[qrow * 4 + 3] = (unsigned)(hi >> 32); }
        }
        LDS_WAIT();
#pragma unroll
        for (int j = 0; j < 4; ++j) selw[j] = selL[(F.wave * 8 + ql) * 4 + j];
      }
    }
    ns_branch<NS_SEL_>(F, ub + U_NSA + 384, ub + U_NSA + 448, UW, 0, c + 1, qf, t, r, h2, selw, R);
    { const float gs = g_sel / R.l;
#pragma unroll
      for (int e = 0; e < 2; ++e)
#pragma unroll
        for (int g = 0; g < 4; ++g) { f32x4 a = stash[(e * 4 + g) * 64]; a += (f32x4){R.o[e][4 * g] * gs, R.o[e][4 * g + 1] * gs, R.o[e][4 * g + 2] * gs, R.o[e][4 * g + 3] * gs}; stash[(e * 4 + g) * 64] = a; } }
    ns_branch<NS_WIN>(F, ub + U_NSA + 512, ub + U_NSA + 576, UW, c >= 8 ? c - 8 : 0, c + 1, qf, t, r, h2, selw, R);
    f32x16 out[2];
    { const float gs = g_win / R.l;
#pragma unroll
      for (int e = 0; e < 2; ++e)
#pragma unroll
        for (int g = 0; g < 4; ++g) { const f32x4 a = stash[(e * 4 + g) * 64];
#pragma unroll
            for (int x = 0; x < 4; ++x) out[e][4 * g + x] = a[x] + R.o[e][4 * g + x] * gs; } }
#pragma unroll
    for (int e = 0; e < 2; ++e)
#pragma unroll
        for (int g = 0; g < 4; ++g) { u32x2 w; w.x = cvt_pk_bf16(out[e][4 * g], out[e][4 * g + 1]); w.y = cvt_pk_bf16(out[e][4 * g + 2], out[e][4 * g + 3]);
            *(u32x2*)(bo + row * 1024 + head * 64 + 32 * e + 8 * g + 4 * h2) = w; }
}

__device__ __forceinline__ void cmp2_item(Frame& F, int L, int item) {
    int lane = F.lane; asm volatile("" : "+v"(lane));
    const int kv = item & 1, it = (item >> 1) & 15, b = item >> 5, r32 = lane & 31, hh = lane >> 5;
    const bf16* w2T = (const bf16*)(F.ws + WS_CW2 + (size_t)L * 65536) + kv * 64 * 128;
    const bf16* hid = (const bf16*)(F.ws + WS_CMPH) + ((size_t)(b * 512 + 32 * it)) * 256 + kv * 128;
    bf16* outp = (bf16*)(F.ws + (kv ? WS_VCMP : WS_KCMP)) + ((size_t)(b * 512 + 32 * it + r32)) * 64;
    const bool live = (32 * it + r32) < NCMP;
#pragma unroll
    for (int et = 0; et < 2; ++et) { f32x16 acc = zero16();
#pragma unroll
        for (int ks = 0; ks < 8; ++ks) acc = mma32(frag_g(w2T, 128, 32 * et, 16 * ks, lane), frag_g(hid, 256, 0, 16 * ks, lane), acc);
#pragma unroll
        for (int g = 0; g < 4; ++g) { u32x2 w; w.x = live ? cvt_pk_bf16(acc[4 * g], acc[4 * g + 1]) : 0u; w.y = live ? cvt_pk_bf16(acc[4 * g + 2], acc[4 * g + 3]) : 0u;
            *(u32x2*)(outp + 32 * et + 8 * g + 4 * hh) = w; } }
}
#ifdef SK_RWM1
#define RWM1(x)
#else
#define RWM1(x) x
#endif
#ifdef SK_RWM3
#define RWM3(x)
#else
#define RWM3(x) x
#endif
#ifdef SK_RWSC
#define RWSC(x)
#else
#define RWSC(x) x
#endif
__device__ __forceinline__ void phase_m1(Frame& F0, int L, bf16* hgS, bf16* rtS) {
    Frame F = F0; asm volatile("" : "+v"(F.tid)); F.lane = F.tid & 63;
    if (F.bx < 32) { LAS float* c1l = (LAS float*)(F.lds + RSTD_OFF + 1024);
      if (F.tid < 256) { const float* cp = (const float*)(F.ws + WS_CW2 + (size_t)L * 65536 + 32768) + (F.tid >> 7) * 32 * 128 + (F.tid & 127); float a = 0.f;
          for (int jq = 0; jq < 32; ++jq) a += cp[jq * 128];
          c1l[F.tid] = a; }
      __syncthreads(); }
    { CmpSched Sd{(const char*)(F.ws + WS_U), (const char*)(F.ws + WS_CW1 + (size_t)L * MiB), F.bx};
      EpiCmp E{(bf16*)(F.ws + WS_CMPH)};
      pg8::gemm_phase<EpiCmp, CmpSched, true>(F.lds + RING_OFF, Sd, E, (unsigned)(UW * 2), 128u); }
    LAS unsigned char* W = F.lds + F.wave * WREG;
    const int gw = F.bx * NWAVES + F.wave, NGW = F.G * NWAVES;
    for (int it = gw; it < 3 * 32 * NCH; it += NGW) { const int type = it % 3, q = it / 3, bh = q / NCH, n = q % NCH;
        if (type == 0) hgrn_chunk<false>(F, L, bh, n, W, hgS, (float*)(F.ws + WS_HGD)); else if (type == 1) ret_chunk<false>(F, L, bh, n, W, rtS); else { RWM1(rwkv_chunk<false>(F, L, bh, n, W)); } }
}
__device__ __forceinline__ void phase_scan(Frame& F0, int L, bf16* hgS, bf16* rtS) {
    Frame F = F0; asm volatile("" : "+v"(F.tid)); F.lane = F.tid & 63;
    if (F.tid < 256) {
        if (F.bx < 64) glin_scan_task(hgS, (bf16*)((unsigned char*)F.out + DO_HGS), (const float*)(F.ws + WS_HGD), 0.f, F.bx >> 1, F.bx & 1, F.tid);
        else if (F.bx < 128) { const int k = F.bx - 64, h = (k >> 1) & 3; const float g = 1.0f - exp2f(-5.0f - (float)h); glin_scan_task(rtS, (bf16*)((unsigned char*)F.out + DO_RTS), nullptr, exp2f(32.0f * __log2f(g)), k >> 1, k & 1, F.tid); }
    } else if (F.wave == 4) { if (F.bx < 64) { RWSC(rwkv_scan_task(F, F.bx >> 1, F.bx & 1)); } }
    else { for (int item = F.bx * 3 + (F.wave - 5); item < 256; item += F.G * 3) cmp2_item(F, L, item); }
}
__device__ __forceinline__ void phase_m3(Frame& F0, int L, bf16* hgS, bf16* rtS) {
    Frame F = F0; asm volatile("" : "+v"(F.tid)); F.lane = F.tid & 63;
    LAS unsigned char* W = F.lds + F.wave * WREG;
    const int gw = F.bx * NWAVES + F.wave, NGW = F.G * NWAVES;
    for (int it = gw; it < REP_ITEMS * 3 * 32 * NCH; it += NGW) { const int type = it % 3, q = (it / 3) % (32 * NCH), bh = q / NCH, n = q % NCH;
        if (type == 0) hgrn_chunk<true>(F, L, bh, n, W, (bf16*)((unsigned char*)F.out + DO_HGS), nullptr); else if (type == 1) ret_chunk<true>(F, L, bh, n, W, (bf16*)((unsigned char*)F.out + DO_RTS)); else { RWM3(rwkv_chunk<true>(F, L, bh, n, W)); } }
    __syncthreads();
#ifndef SK_NSA
    for (int p = F.bx; p < REP_NSA * 512; p += F.G) { const int b = (p >> 6) & 7, cc = p & 63; nsa_unit(F, b, 127 - cc); nsa_unit(F, b, cc); }
#endif
}

__device__ __forceinline__ void phase_pconv(Frame& F0, int L) {
    Frame F = F0; asm volatile("" : "+v"(F.tid)); F.lane = F.tid & 63;
    const float* p = F.in[I_P] + (size_t)L * T * PLE; bf16* pbf = (bf16*)(F.ws + WS_PB);
    for (int r = F.bx * NWAVES + F.wave; r < T; r += F.G * NWAVES) { const f32x4 v = *((const f32x4*)(p + (size_t)r * PLE) + F.lane); u32x2 w; w.x = cvt_pk_bf16(v[0], v[1]); w.y = cvt_pk_bf16(v[2], v[3]); *((u32x2*)(pbf + (size_t)r * PLE) + F.lane) = w; }
}
__device__ __forceinline__ void phase_final(Frame& F0, const float* ssf, const bf16* hb) {
    Frame F = F0; asm volatile("" : "+v"(F.tid)); F.lane = F.tid & 63;
    const float* g = F.in[I_NORM_FINAL]; const int gw = F.bx * NWAVES + F.wave, NGW = F.G * NWAVES;
    for (int r = gw; r < T; r += NGW) { const float rs = __builtin_amdgcn_rsqf(ss_row(ssf, r) * (1.0f / D) + EPS); const u32x4* hr = (const u32x4*)(hb + (size_t)r * D) + F.lane; f32x4* orow = (f32x4*)(F.out + (size_t)r * D);
#pragma unroll
        for (int j = 0; j < 2; ++j) { f32x4 a, b; unpack8(hr[64 * j], a, b); const f32x4 g0 = *((const f32x4*)g + 2 * (F.lane + 64 * j)), g1 = *((const f32x4*)g + 2 * (F.lane + 64 * j) + 1);
            orow[2 * (F.lane + 64 * j)] = a * rs * g0; orow[2 * (F.lane + 64 * j) + 1] = b * rs * g1; } }
}

constexpr int PH_PER_LAYER = 9, N_PHASES = 1 + NL * PH_PER_LAYER + 1;
__global__ void __launch_bounds__(NTHR, 2) mega_fwd(Args args) {
    extern __shared__ __attribute__((aligned(16))) unsigned char lds_raw[];
    Frame F; F.lds = (LAS unsigned char*)lds_raw; F.tid = threadIdx.x; F.lane = F.tid & 63; F.wave = __builtin_amdgcn_readfirstlane(F.tid >> 6); F.G = gridDim.x; F.bx = blockIdx.x;
    F.in = args.in; F.out = args.out; F.ws = args.ws;
    volatile LAS unsigned* MISC = (volatile LAS unsigned*)(F.lds + MISC_OFF);
    if (F.tid < 32) MISC[F.tid] = 0u;
    __syncthreads();
    unsigned* ctl = (unsigned*)(F.ws + WS_CTL);
    XcdBarrier bar; bar.bar = ctl + CW_BAR; bar.x = 0; bar.st = nullptr;
    if (MK_N_LAUNCHES == 1) bar = xcd_barrier_post(ctl + CW_BAR, MISC + 8);
    const int lo = args.ph_lo, hi = args.ph_hi;
#define IN(k) (lo <= (k) && (k) < hi)
#define REPS(k) (((k) == REP_PHASE || (k) == REP_PHASE + 9) ? 2 : 1)
#define SEAM(k) do { if (IN(k) && IN((k) + 1)) xcd_barrier(bar); } while (0)
    float* ssb = F.out;
    LAS unsigned char* ring = F.lds + RING_OFF;

    #ifndef SK_PRO
    for (int rep = 0; rep < ((REP_PHASE == 0) ? 2 : 1); ++rep) if (IN(0)) { if (rep) xcd_barrier(bar); phase_prologue(F); }
#endif
    SEAM(0);

    for (int L = 0; L < NL; ++L) {
        asm volatile("" : "+v"(F.tid)); F.lane = F.tid & 63;
        const int pb = 1 + L * PH_PER_LAYER;
        unsigned char* wl = F.ws + WS_W + (size_t)L * WL_STRIDE;
        bf16* hb_cur = (bf16*)(F.ws + ((L & 1) ? WS_HBB : WS_HBA)); bf16* hb_oth = (bf16*)(F.ws + ((L & 1) ? WS_HBA : WS_HBB));
        const float* ss_mix = ssb + (size_t)(3 * L) * T * 16; float* ss_ffn = ssb + (size_t)(3 * L + 1) * T * 16; float* ss_ple = ssb + (size_t)(3 * L + 2) * T * 16; float* ss_next = (L == NL - 1) ? (float*)(F.ws + WS_SSF) : ssb + (size_t)(3 * L + 3) * T * 16;
#ifndef SK_G1
        for (int rep = 0; rep < REPS(pb + 0); ++rep) if (IN(pb + 0)) { PlainSched Sd{(const char*)hb_cur, (const char*)(wl + WL_IN), D * 2, D * 2, D / 64, T / 256, UW / 256, F.G, F.bx};
            EpiScaleBf16 E{(bf16*)(F.ws + WS_U), UW, ss_mix}; pg8::gemm_phase(ring, Sd, E); }
#endif
        SEAM(pb + 0);
        bf16* hgS = hb_oth; bf16* rtS = hb_oth + (size_t)32 * NCH * 4096;
        for (int rep = 0; rep < REPS(pb + 1); ++rep) if (IN(pb + 1)) { if (rep) xcd_barrier(bar); phase_m1(F, L, hgS, rtS); }
        SEAM(pb + 1);
#ifndef EXP_NOSCAN
        if (IN(pb + 2)) phase_scan(F, L, hgS, rtS);
#endif
        SEAM(pb + 2);
        if (IN(pb + 3)) phase_m3(F, L, hgS, rtS);
        SEAM(pb + 3);
#ifndef SK_G2
        for (int rep = 0; rep < REPS(pb + 4); ++rep) if (IN(pb + 4)) { PairSched Sd{(const char*)hb_cur, (const char*)(wl + WL_G), D * 2, D * 2, D / 64, (size_t)D * D * 2,
                                        (const char*)(F.ws + WS_BO), (const char*)(wl + WL_B), 1024 * 2, MW * 2, MW / 64, (size_t)MW * 2, (size_t)D * MW * 2, 4, T / 256, D / 256, F.G, F.bx};
            u32x4* scr = (u32x4*)(F.ws + WS_SCR + (size_t)F.bx * 262144);
            EpiMerge E{scr, scr + 8192, (bf16*)(F.ws + WS_MERGED), ss_mix, F.in[I_BGATE] + (size_t)L * 4 * D, 4}; pg8::gemm_phase(ring, Sd, E); }
#endif
        SEAM(pb + 4);
#ifndef SK_G3
        if (IN(pb + 5)) phase_pconv(F, L);
        if (IN(pb + 5)) { PlainSched Sd{(const char*)(F.ws + WS_MERGED), (const char*)(wl + WL_OUT), D * 2, D * 2, D / 64, T / 256, D / 256, F.G, F.bx};
            EpiResidual E{(L == 0) ? F.in[I_X] : nullptr, hb_cur, ss_ffn}; pg8::gemm_phase(ring, Sd, E); }
#endif
        SEAM(pb + 5);
#ifndef SK_G4
        for (int rep = 0; rep < REPS(pb + 6); ++rep) if (IN(pb + 6)) { PlainSched Sd{(const char*)hb_cur, (const char*)(wl + WL_FF), D * 2, D * 2, D / 64, T / 256, (2 * DFF) / 256, F.G, F.bx};
            EpiSwiGLU E{(bf16*)(F.ws + WS_FFH), ss_ffn}; pg8::gemm_phase(ring, Sd, E); }
#endif
        SEAM(pb + 6);
#ifndef SK_G5
        if (IN(pb + 7)) { PlainSched Sd{(const char*)(F.ws + WS_FFH), (const char*)(wl + WL_DN), DFF * 2, DFF * 2, DFF / 64, T / 256, D / 256, F.G, F.bx};
            EpiResidual E{nullptr, hb_cur, ss_ple}; pg8::gemm_phase(ring, Sd, E); }
#endif
        SEAM(pb + 7);
#ifndef SK_G6
        if (IN(pb + 8)) { PairSched Sd{(const char*)hb_cur, (const char*)(wl + WL_PG), D * 2, D * 2, D / 64, 0,
                                        (const char*)(F.ws + WS_PB), (const char*)(wl + WL_PP), PLE * 2, PLE * 2, PLE / 64, 0, 0, 1, T / 256, D / 256, F.G, F.bx};
            u32x4* scr = (u32x4*)(F.ws + WS_SCR + (size_t)F.bx * 262144);
            EpiPle E{scr, hb_cur, hb_oth, ss_ple, ss_next}; pg8::gemm_phase(ring, Sd, E); }
#endif
        SEAM(pb + 8);
    }
#ifndef SK_FIN
    if (IN(N_PHASES - 1)) phase_final(F, (const float*)(F.ws + WS_SSF), (const bf16*)(F.ws + ((NL & 1) ? WS_HBB : WS_HBA)));
#endif
#undef IN
#undef SEAM
}

extern "C" void kernel_launch(void* const* d_in, const int* in_sizes, int n_in, void* d_out, int out_size, void* d_ws, size_t ws_size, hipStream_t stream) {
    static int grid = 0;
    if (grid == 0) {
        if (n_in != 37 || in_sizes[0] != T * D || out_size != T * D || ws_size < WS_END) { fprintf(stderr, "kernel_launch: unexpected shapes (n_in %d, ws %zu)\n", n_in, ws_size); grid = -1; return; }
        int dev = 0, cus = 0, per_cu = 0;
        if (hipGetDevice(&dev) != hipSuccess || hipDeviceGetAttribute(&cus, hipDeviceAttributeMultiprocessorCount, dev) != hipSuccess) { grid = -1; return; }
        if (hipFuncSetAttribute((const void*)mega_fwd, hipFuncAttributeMaxDynamicSharedMemorySize, LDS_BYTES) != hipSuccess) { fprintf(stderr, "kernel_launch: hipFuncSetAttribute failed\n"); grid = -1; return; }
        if (hipOccupancyMaxActiveBlocksPerMultiprocessor(&per_cu, (const void*)mega_fwd, NTHR, LDS_BYTES) != hipSuccess || per_cu < 1) { fprintf(stderr, "kernel_launch: occupancy query says %d\n", per_cu); }
        (void)hipGetLastError();
        grid = cus;
    }
    if (grid < 0) return;
    hipMemsetAsync((char*)d_ws + WS_CTL, 0, CTL_BYTES, stream);
    Args a{};
    for (int i = 0; i < 37; ++i) a.in[i] = (const float*)d_in[i];
    a.out = (float*)d_out; a.ws = (unsigned char*)d_ws;
    if (MK_N_LAUNCHES == 1) { a.ph_lo = 0; a.ph_hi = N_PHASES; hipLaunchKernelGGL(mega_fwd, dim3(grid), dim3(NTHR), LDS_BYTES, stream, a); }
    else for (int p = 0; p < N_PHASES; ++p) { a.ph_lo = p; a.ph_hi = p + 1; hipLaunchKernelGGL(mega_fwd, dim3(grid), dim3(NTHR), LDS_BYTES, stream, a); }
}
```

```cpp
#include <hip/hip_runtime.h>
#include <cstdio>
#include <cstdint>

#ifndef REP_ITEMS
#define REP_ITEMS 1
#endif
#ifndef REP_NSA
#define REP_NSA 1
#endif
#ifndef REP_PHASE
#define REP_PHASE (-1)
#endif
#ifndef MK_N_LAUNCHES
#define MK_N_LAUNCHES 1
#endif

#define LAS __attribute__((address_space(3)))
#define GAS __attribute__((address_space(1)))
typedef unsigned short bf16;
typedef short bf16x8 __attribute__((ext_vector_type(8)));
typedef float f32x4 __attribute__((ext_vector_type(4)));
typedef float f32x16 __attribute__((ext_vector_type(16)));
typedef unsigned u32x4 __attribute__((ext_vector_type(4)));
typedef unsigned u32x2 __attribute__((ext_vector_type(2)));
typedef short s16x4 __attribute__((ext_vector_type(4)));

constexpr int D = 1024, NB = 8, S = 8192, T = NB * S, NL = 2;
constexpr int NH = 4, HD = 64, MW = 256, DFF = 2816, PLE = 256;
constexpr int DIN = 3724, UW = 3840;
constexpr int U_NSA = 0, U_HG = 768, U_RT = 1792, U_RW = 2816;
constexpr int NCMP = 511, NSEL = 128;
constexpr float EPS = 1e-6f;

constexpr size_t MiB = 1u << 20;
constexpr size_t WS_CTL = 0, CTL_BYTES = 4 * MiB;
constexpr size_t WS_W = 4 * MiB;
constexpr size_t WL_IN = 0, WL_G = 8 * MiB, WL_B = 16 * MiB, WL_OUT = 18 * MiB, WL_FF = 20 * MiB, WL_DN = 31 * MiB, WL_PG = 37 * MiB, WL_PP = 39 * MiB, WL_STRIDE = 40 * MiB;
constexpr size_t WS_MISC = 84 * MiB;
constexpr size_t WS_ROPE = WS_MISC, WS_KCMP = WS_MISC + 2 * MiB, WS_VCMP = WS_MISC + 2 * MiB + 512 * 1024, WS_RWUP = WS_MISC + 3 * MiB;
constexpr size_t WS_HBA = 88 * MiB, WS_HBB = 216 * MiB;
constexpr size_t WS_BO = 344 * MiB;
constexpr size_t WS_U = 472 * MiB;
constexpr size_t WS_MERGED = WS_U, WS_SCR = WS_U + 416 * MiB;
constexpr size_t WS_FFH = WS_U;
constexpr size_t WS_PB = WS_U + 352 * MiB;
constexpr size_t WS_RWN = 952 * MiB;
constexpr size_t WS_HGD = 1016 * MiB;
constexpr size_t WS_RWM = WS_BO;
constexpr size_t WS_CMPH = 1018 * MiB;
constexpr size_t WS_CW1 = 1020 * MiB;
constexpr size_t WS_CW2 = 1022 * MiB;
constexpr size_t WS_SSF = 1016 * MiB;
constexpr size_t DO_T = 28 * MiB, DO_HGS = 44 * MiB, DO_RTS = 108 * MiB, DO_RWS = 172 * MiB;
constexpr size_t WS_END = 1024 * MiB;
constexpr int CH = 32, NCH = S / CH;
constexpr int CW_BAR = 4096;
constexpr int CW_C1 = 16384;
constexpr int NSS = 7;

#define LDS_WAIT() asm volatile("s_waitcnt lgkmcnt(0)" ::: "memory")
#define VM_WAIT() asm volatile("s_waitcnt vmcnt(0)" ::: "memory")
typedef __bf16 hbf16x2 __attribute__((ext_vector_type(2)));
typedef float f32x2v __attribute__((ext_vector_type(2)));
__device__ __forceinline__ unsigned cvt_pk_bf16(float lo, float hi) { const f32x2v v = {lo, hi}; const hbf16x2 b = __builtin_convertvector(v, hbf16x2); return __builtin_bit_cast(unsigned, b); }
__device__ __forceinline__ float bf2f(unsigned short b) { return __builtin_bit_cast(float, ((unsigned)b) << 16); }
__device__ __forceinline__ float bflo(unsigned w) { return __builtin_bit_cast(float, w << 16); }
__device__ __forceinline__ float bfhi(unsigned w) { return __builtin_bit_cast(float, w & 0xffff0000u); }
__device__ __forceinline__ float fsigmoid(float z) { return __builtin_amdgcn_rcpf(1.0f + __builtin_amdgcn_exp2f(-1.44269504f * z)); }
__device__ __forceinline__ float fsilu(float z) { return z * fsigmoid(z); }
__device__ __forceinline__ float wave_sum(float v) {
#pragma unroll
    for (int o = 1; o < 64; o <<= 1) v += __shfl_xor(v, o);
    return v;
}
__device__ __forceinline__ float wave_max(float v) {
#pragma unroll
    for (int o = 1; o < 64; o <<= 1) v = fmaxf(v, __shfl_xor(v, o));
    return v;
}

#define XB_TMO      128
#define XB_XCNT(j)  (256  + 64 * (j))
#define XB_XSUB(j)  (1280 + 64 * (j))
#define XB_XGEN(j)  (2304 + 64 * (j))
#define XB_TOP      3328
#define XB_TOPGEN   3392
#define XCD_BAR_WORDS 3456
#define XB_SPIN_CAP (1u << 24)
__device__ __forceinline__ unsigned xb_ld(unsigned* p)              { return __hip_atomic_load(p, __ATOMIC_RELAXED, __HIP_MEMORY_SCOPE_AGENT); }
__device__ __forceinline__ unsigned xb_add(unsigned* p, unsigned v) { return __hip_atomic_fetch_add(p, v, __ATOMIC_RELAXED, __HIP_MEMORY_SCOPE_AGENT); }
__device__ __forceinline__ unsigned xb_xcc_id() { return (unsigned)__builtin_amdgcn_s_getreg((3 << 11) | 20) & 0xFu; }
#define XB_SPIN(cond, bar) do { unsigned _sp = 0; while (cond) { __builtin_amdgcn_s_sleep(1); \
    if ((++_sp & 255u) == 0u) { if (xb_ld(&(bar)[XB_TMO])) break; if (_sp > XB_SPIN_CAP) { atomicAdd(&(bar)[XB_TMO], 1u); break; } } } } while (0)
struct XcdBarrier { unsigned* bar; unsigned x; volatile LAS unsigned* st; };
__device__ __forceinline__ XcdBarrier xcd_barrier_post(unsigned* bar, volatile LAS unsigned* st) {
    XcdBarrier b; b.bar = bar; b.x = xb_xcc_id(); b.st = st;
    if (threadIdx.x == 0) (void)xb_add(&bar[XB_XCNT(b.x)], 1u);
    return b;
}
__device__ __forceinline__ void xcd_barrier_complete(unsigned* bar, unsigned x, unsigned& nloc, unsigned& nx) {
    const unsigned G = gridDim.x * gridDim.y * gridDim.z;
    unsigned sum, cnt, mine, sp = 0u;
    for (;;) {
        sum = 0u; cnt = 0u; mine = 0u;
#pragma unroll
        for (unsigned j = 0; j < 16; ++j) { const unsigned c = xb_ld(&bar[XB_XCNT(j)]); sum += c; cnt += (c > 0u) ? 1u : 0u; mine = (j == x) ? c : mine; }
        if (sum == G) break;
        __builtin_amdgcn_s_sleep(1);
        if ((++sp & 255u) == 0u) { if (xb_ld(&bar[XB_TMO])) break; if (sp > XB_SPIN_CAP) { atomicAdd(&bar[XB_TMO], 1u); break; } }
    }
    nloc = mine > 0u ? mine : 1u; nx = cnt > 0u ? cnt : 1u;
}
__device__ __forceinline__ void xcd_barrier(const XcdBarrier& b) {
    asm volatile("s_waitcnt vmcnt(0)" ::: "memory");
    __syncthreads();
    if (threadIdx.x == 0) {
        unsigned* bar = b.bar;
        __builtin_amdgcn_s_waitcnt(0);
        unsigned nloc = b.st[0], nx = b.st[1];
        if (nloc == 0u) { xcd_barrier_complete(bar, b.x, nloc, nx); b.st[0] = nloc; b.st[1] = nx; }
        const unsigned old = xb_add(&bar[XB_XSUB(b.x)], 1u);
        const unsigned gen = old / nloc;
        if (old + 1u == (gen + 1u) * nloc) {
            __builtin_amdgcn_fence(__ATOMIC_RELEASE, "agent");
            asm volatile("s_waitcnt vmcnt(0)" ::: "memory");
            const unsigned og = xb_add(&bar[XB_TOP], 1u);
            const unsigned tg = og / nx;
            if (og + 1u == (tg + 1u) * nx) xb_add(&bar[XB_TOPGEN], 1u);
            else XB_SPIN(xb_ld(&bar[XB_TOPGEN]) == tg, bar);
            __builtin_amdgcn_fence(__ATOMIC_ACQUIRE, "agent");
            xb_add(&bar[XB_XGEN(b.x)], 1u);
            asm volatile("s_waitcnt vmcnt(0)" ::: "memory");
        } else {
            XB_SPIN(xb_ld(&bar[XB_XGEN(b.x)]) == gen, bar);
            __builtin_amdgcn_fence(__ATOMIC_ACQUIRE, "agent");
            asm volatile("s_waitcnt vmcnt(0)" ::: "memory");
        }
    }
    __syncthreads();
}

namespace pg8 {
constexpr int BM = 256, BK = 64, HALF = 128, HTB = HALF * BK * 2, STAGE_BYTES = 8 * HTB, NXCD = 8, WGM = 8;
__host__ __device__ __forceinline__ int lds_byte(int r, int c) { const int st = (r >> 4) * 2 + (c >> 5), rr = r & 15, cc = c & 31, ob = rr * 64 + cc * 2; return st * 1024 + (ob ^ (((ob >> 9) & 1) << 5)); }
__host__ __device__ __forceinline__ void stage_rc(int b, int& R, int& C) { const int st = b / 1024, sb = b % 1024, swz = sb ^ (((sb >> 9) & 1) << 5); R = (st >> 1) * 16 + swz / 64; C = (st & 1) * 32 + (swz % 64) / 2; }
__host__ __device__ __forceinline__ int perm32(int rho) { const int n = rho >> 4, i = rho & 15; return 8 * (i >> 2) + 4 * n + (i & 3); }

struct GU { const char* A; const char* B; unsigned lda, ldb; int nt; int pm, pn, kind, mi; };

__device__ __forceinline__ bool tile_of(int L, int nM, int nN, int& pm, int& pn) {
    const int nwg = nM * nN; if (L >= nwg) return false;
    int wgid = L; { const int q = nwg / NXCD, r = nwg % NXCD, xcd = wgid % NXCD, off = wgid / NXCD; wgid = (xcd < r ? xcd * (q + 1) : r * (q + 1) + (xcd - r) * q) + off; }
    const int nig = WGM * nN, gid = wgid / nig, fm = gid * WGM, gsz = (nM - fm) < WGM ? (nM - fm) : WGM;
    pm = fm + ((wgid % nig) % gsz); pn = (wgid % nig) / gsz; return true;
}

template <class Epi, class Sched, bool AX = false>
__device__ __forceinline__ void gemm_phase(LAS unsigned char* lds, const Sched& S, const Epi& E, unsigned ax_kstep = 0, unsigned ax_half = 0) {
    int tid = threadIdx.x; asm volatile("" : "+v"(tid));
    const int wid = __builtin_amdgcn_readfirstlane(tid >> 6), lane = tid & 63, wr = wid >> 2, wc = wid & 3, fr = lane & 15, fq = lane >> 4;
    unsigned RA[2], RB[2], C2[2];
#pragma unroll
    for (int i = 0; i < 2; ++i) { int R, C; stage_rc(tid * 16 + i * 8192, R, C); RA[i] = (unsigned)R; RB[i] = (unsigned)((R & ~31) + perm32(R & 31)); C2[i] = (unsigned)C * 2u; }
    const size_t kstep = (size_t)(BK * 2);
    const size_t kstepA = AX ? (size_t)ax_kstep : kstep;
#define PG8_HSA(ld) (AX ? (size_t)ax_half : (size_t)HALF * (ld))
    const unsigned ldsw = (unsigned)wid * 1024u;
    const int aoff = lds_byte(wr * 64 + fr, fq * 8), boff = lds_byte(wc * 32 + fr, fq * 8);
#define PG8_SA(b, h) (((b) * 2 + (h)) * HTB)
#define PG8_SB(b, h) ((4 + (b) * 2 + (h)) * HTB)
#define PG8_STAGE(bufoff, gbase, ld, RR) do { _Pragma("unroll") for (int _i = 0; _i < 2; ++_i) \
        __builtin_amdgcn_global_load_lds((const unsigned*)((const char*)(gbase) + (RR[_i] * (ld) + C2[_i])), (LAS unsigned*)(lds + (bufoff) + ldsw + _i * 8192), 16, 0, 0); } while (0)
#define PG8_LDA(dst, b, h) do { _Pragma("unroll") for (int m = 0; m < 4; ++m) _Pragma("unroll") for (int k = 0; k < 2; ++k) dst[m][k] = *(const LAS bf16x8*)(lds + PG8_SA(b, h) + aoff + m * 2048 + k * 1024); } while (0)
#define PG8_LDB(dst, b, h) do { _Pragma("unroll") for (int n = 0; n < 2; ++n) _Pragma("unroll") for (int k = 0; k < 2; ++k) dst[n][k] = *(const LAS bf16x8*)(lds + PG8_SB(b, h) + boff + n * 2048 + k * 1024); } while (0)
#define PG8_MMA(ai, bj, At, Bt) do { __builtin_amdgcn_s_setprio(1); _Pragma("unroll") for (int m = 0; m < 4; ++m) _Pragma("unroll") for (int n = 0; n < 2; ++n) _Pragma("unroll") for (int k = 0; k < 2; ++k) \
        acc[ai][bj][m][n] = __builtin_amdgcn_mfma_f32_16x16x32_bf16(Bt[n][k], At[m][k], acc[ai][bj][m][n], 0, 0, 0); __builtin_amdgcn_s_setprio(0); } while (0)
#define PG8_WAIT_V(n) asm volatile("s_waitcnt vmcnt(" #n ")" ::: "memory")
#define PG8_WAIT_L(n) asm volatile("s_waitcnt lgkmcnt(" #n ")" ::: "memory")
#define PG8_BAR __builtin_amdgcn_s_barrier()
#define PG8_SCHED __builtin_amdgcn_sched_barrier(0)
    GU cur, nxt; int ui = 0;
    if (!S.next(0, cur)) return;
    f32x4 acc[2][2][4][2];
#pragma unroll
    for (int a = 0; a < 2; ++a)
#pragma unroll
        for (int b = 0; b < 2; ++b)
#pragma unroll
            for (int m = 0; m < 4; ++m)
#pragma unroll
                for (int n = 0; n < 2; ++n) acc[a][b][m][n] = (f32x4){0.f, 0.f, 0.f, 0.f};
    bf16x8 At[4][2], B0[2][2], B1[2][2];
    const char* cA = cur.A; const char* cB = cur.B; unsigned clda = cur.lda, cldb = cur.ldb;
    PG8_STAGE(PG8_SB(0, 0), cB, cldb, RB); PG8_STAGE(PG8_SB(0, 1), cB + (size_t)HALF * cldb, cldb, RB); PG8_STAGE(PG8_SA(0, 0), cA, clda, RA); PG8_STAGE(PG8_SA(0, 1), cA + PG8_HSA(clda), clda, RA);
    if (wr == 1) PG8_BAR;
    PG8_WAIT_V(2); PG8_BAR;
    PG8_STAGE(PG8_SB(1, 0), cB + kstep, cldb, RB); PG8_STAGE(PG8_SA(1, 0), cA + kstepA, clda, RA); PG8_STAGE(PG8_SB(1, 1), cB + (size_t)HALF * cldb + kstep, cldb, RB);
    PG8_WAIT_V(6); PG8_BAR;
    for (;;) {
        const bool has_next = S.next(ui + 1, nxt);
        const char* nA = has_next ? nxt.A : cA; const char* nB = has_next ? nxt.B : cB;
        const unsigned nlda = has_next ? nxt.lda : clda, nldb = has_next ? nxt.ldb : cldb;
        const int nt = cur.nt;
        for (int t = 0; t < nt; t += 2) {
            const bool last = (t == nt - 2);
            const char* a1 = cA + (size_t)(t + 1) * kstepA;
            const char* a2 = last ? nA : cA + (size_t)(t + 2) * kstepA; const char* b2 = last ? nB : cB + (size_t)(t + 2) * kstep;
            const unsigned lda2 = last ? nlda : clda, ldb2 = last ? nldb : cldb;
            const char* a3 = a2 + kstepA; const char* b3 = b2 + kstep;
            PG8_LDB(B0, 0, 0); PG8_LDB(B1, 0, 1); PG8_SCHED; PG8_LDA(At, 0, 0); PG8_STAGE(PG8_SA(1, 1), a1 + PG8_HSA(clda), clda, RA);
            PG8_WAIT_V(8); PG8_WAIT_L(0); PG8_BAR; PG8_MMA(0, 0, At, B0); PG8_MMA(0, 1, At, B1); PG8_BAR; PG8_SCHED;
            PG8_LDA(At, 0, 1); PG8_STAGE(PG8_SB(0, 0), b2, ldb2, RB); PG8_STAGE(PG8_SB(0, 1), b2 + (size_t)HALF * ldb2, ldb2, RB); PG8_STAGE(PG8_SA(0, 0), a2, lda2, RA);
            PG8_WAIT_V(8); PG8_WAIT_L(0); PG8_BAR; PG8_MMA(1, 0, At, B0); PG8_MMA(1, 1, At, B1); PG8_BAR; PG8_SCHED;
            PG8_LDB(B0, 1, 0); PG8_LDB(B1, 1, 1); PG8_SCHED; PG8_LDA(At, 1, 0); PG8_STAGE(PG8_SA(0, 1), a2 + PG8_HSA(lda2), lda2, RA);
            PG8_WAIT_V(8); PG8_WAIT_L(0); PG8_BAR; PG8_MMA(0, 0, At, B0); PG8_MMA(0, 1, At, B1); PG8_BAR; PG8_SCHED;
            PG8_LDA(At, 1, 1); PG8_STAGE(PG8_SB(1, 0), b3, ldb2, RB); PG8_STAGE(PG8_SB(1, 1), b3 + (size_t)HALF * ldb2, ldb2, RB); PG8_STAGE(PG8_SA(1, 0), a3, lda2, RA);
            PG8_WAIT_V(8); PG8_WAIT_L(0); PG8_BAR; PG8_MMA(1, 0, At, B0); PG8_MMA(1, 1, At, B1); PG8_BAR; PG8_SCHED;
        }
        if (wr == 0) PG8_BAR;
        E(acc, cur, wr, wc, fr, fq);
        if (!has_next) break;
#pragma unroll
        for (int a = 0; a < 2; ++a)
#pragma unroll
            for (int b = 0; b < 2; ++b)
#pragma unroll
                for (int m = 0; m < 4; ++m)
#pragma unroll
                    for (int n = 0; n < 2; ++n) acc[a][b][m][n] = (f32x4){0.f, 0.f, 0.f, 0.f};
        cur = nxt; cA = nA; cB = nB; clda = nlda; cldb = nldb; ++ui;
        if (wr == 1) PG8_BAR;
    }
    PG8_WAIT_V(0);
    PG8_BAR;
#undef PG8_SA
#undef PG8_HSA
#undef PG8_SB
#undef PG8_STAGE
#undef PG8_LDA
#undef PG8_LDB
#undef PG8_MMA
#undef PG8_WAIT_V
#undef PG8_WAIT_L
#undef PG8_BAR
#undef PG8_SCHED
}
}
using pg8::GU;

struct PlainSched {
    const char* A; const char* B; unsigned lda, ldb; int nt, nM, nN, G, c;
    __device__ __forceinline__ bool next(int i, GU& u) const {
        int pm, pn; if (!pg8::tile_of(i * G + c, nM, nN, pm, pn)) return false;
        u.A = A + (size_t)pm * 256 * lda; u.B = B + (size_t)pn * 256 * ldb; u.lda = lda; u.ldb = ldb; u.nt = nt; u.pm = pm; u.pn = pn; u.kind = 0; u.mi = 0; return true;
    }
};
struct PairSched {
    const char* A1; const char* B1; unsigned lda1, ldb1; int nt1; size_t b1_mstride;
    const char* A2; const char* B2; unsigned lda2, ldb2; int nt2; size_t a2_mstride, b2_mstride;
    int nm, nM, nN, G, c;
    __device__ __forceinline__ bool next(int i, GU& u) const {
        const int per = 2 * nm, ti = i / per, sub = i - ti * per, m = sub >> 1, kind = sub & 1;
        int pm, pn; if (!pg8::tile_of(ti * G + c, nM, nN, pm, pn)) return false;
        u.pm = pm; u.pn = pn; u.kind = kind; u.mi = m;
        if (kind == 0) { u.A = A2 + (size_t)m * a2_mstride + (size_t)pm * 256 * lda2; u.B = B2 + (size_t)m * b2_mstride + (size_t)pn * 256 * ldb2; u.lda = lda2; u.ldb = ldb2; u.nt = nt2; }
        else { u.A = A1 + (size_t)pm * 256 * lda1; u.B = B1 + (size_t)m * b1_mstride + (size_t)pn * 256 * ldb1; u.lda = lda1; u.ldb = ldb1; u.nt = nt1; }
        return true;
    }
};

constexpr int RSTD_OFF = 131072;
__device__ __forceinline__ float ss_row(const float* ssp, int row) {
    const f32x4* p = (const f32x4*)(ssp + (size_t)row * 16); const f32x4 a = p[0], b = p[1], c = p[2], d = p[3];
    return (((a[0] + a[1]) + (a[2] + a[3])) + ((b[0] + b[1]) + (b[2] + b[3]))) + (((c[0] + c[1]) + (c[2] + c[3])) + ((d[0] + d[1]) + (d[2] + d[3])));
}
__device__ __forceinline__ void rstd_table(const float* ssp, int pm) {
    extern __shared__ __attribute__((aligned(16))) unsigned char lds_tab_raw[];
    LAS float* tab = (LAS float*)((LAS unsigned char*)lds_tab_raw + RSTD_OFF);
    const int t = threadIdx.x; if (t < 256) tab[t] = __builtin_amdgcn_rsqf(ss_row(ssp, pm * 256 + t) * (1.0f / D) + EPS);
    asm volatile("s_waitcnt lgkmcnt(0)" ::: "memory"); __builtin_amdgcn_s_barrier(); asm volatile("" ::: "memory");
}
__device__ __forceinline__ float rstd_tab(int lr) { extern __shared__ __attribute__((aligned(16))) unsigned char lds_tab_raw[]; return ((const LAS float*)((LAS unsigned char*)lds_tab_raw + RSTD_OFF))[lr]; }
__device__ __forceinline__ u32x4 pack8(const f32x4& a, const f32x4& b) { u32x4 w; w.x = cvt_pk_bf16(a[0], a[1]); w.y = cvt_pk_bf16(a[2], a[3]); w.z = cvt_pk_bf16(b[0], b[1]); w.w = cvt_pk_bf16(b[2], b[3]); return w; }
__device__ __forceinline__ void unpack8(const u32x4& w, f32x4& a, f32x4& b) { a = (f32x4){bflo(w.x), bfhi(w.x), bflo(w.y), bfhi(w.y)}; b = (f32x4){bflo(w.z), bfhi(w.z), bflo(w.w), bfhi(w.w)}; }

struct CmpSched {
    const char* U; const char* B; int c;
    __device__ __forceinline__ bool next(int i, GU& u) const {
        if (i > 0 || c >= 32) return false;
        const int b = c >> 2, q = c & 3;
        u.A = U + ((size_t)(b * S + 2048 * q) * UW + U_NSA + 256) * 2; u.B = B; u.lda = 16 * UW * 2; u.ldb = 4096; u.nt = 32; u.pm = b; u.pn = q; u.kind = 0; u.mi = 0; return true;
    }
};
struct EpiCmp {
    bf16* H;
    __device__ __forceinline__ void operator()(const f32x4 (&acc)[2][2][4][2], const GU& u, int wr, int wc, int fr, int fq) const {
        const int col = wc * 32 + 8 * fq;
        extern __shared__ __attribute__((aligned(16))) unsigned char lds_c1_raw[]; const LAS float* c1 = (const LAS float*)((LAS unsigned char*)lds_c1_raw + RSTD_OFF + 1024);
#pragma unroll
        for (int kv = 0; kv < 2; ++kv) { const f32x4 b0 = *(const LAS f32x4*)(c1 + kv * 128 + col), b1 = *(const LAS f32x4*)(c1 + kv * 128 + col + 4);
#pragma unroll
            for (int m = 0; m < 4; ++m) { const int i = u.pn * 128 + wr * 64 + m * 16 + fr; f32x4 v0, v1;
#pragma unroll
                for (int j = 0; j < 4; ++j) { v0[j] = fsilu(acc[kv][kv][m][0][j] + b0[j]); v1[j] = fsilu(acc[kv][kv][m][1][j] + b1[j]); }
                *(u32x4*)(H + ((size_t)(u.pm * 512 + i)) * 256 + kv * 128 + col) = pack8(v0, v1); } }
    }
};
struct EpiScaleBf16 {
    bf16* O; int ldo; const float* ss;
    __device__ __forceinline__ void operator()(const f32x4 (&acc)[2][2][4][2], const GU& u, int wr, int wc, int fr, int fq) const {
        rstd_table(ss, u.pm);
        const int row0 = u.pm * 256 + wr * 64 + fr, col0 = u.pn * 256 + wc * 32 + 8 * fq;
#pragma unroll
        for (int ai = 0; ai < 2; ++ai)
#pragma unroll
            for (int m = 0; m < 4; ++m) { const int r = row0 + ai * 128 + m * 16; const float rs = rstd_tab(wr * 64 + fr + ai * 128 + m * 16); bf16* rowp = O + (size_t)r * ldo + col0;
#pragma unroll
                for (int bj = 0; bj < 2; ++bj) *(u32x4*)(rowp + bj * 128) = pack8(acc[ai][bj][m][0] * rs, acc[ai][bj][m][1] * rs); }
    }
};
struct EpiSwiGLU {
    bf16* O; const float* ss;
    __device__ __forceinline__ void operator()(const f32x4 (&acc)[2][2][4][2], const GU& u, int wr, int wc, int fr, int fq) const {
        rstd_table(ss, u.pm);
        const int row0 = u.pm * 256 + wr * 64 + fr, col0 = u.pn * 128 + wc * 32 + 8 * fq;
#pragma unroll
        for (int ai = 0; ai < 2; ++ai)
#pragma unroll
            for (int m = 0; m < 4; ++m) { const int r = row0 + ai * 128 + m * 16; const float rs = rstd_tab(wr * 64 + fr + ai * 128 + m * 16);
                f32x4 v[2];
#pragma unroll
                for (int n = 0; n < 2; ++n)
#pragma unroll
                    for (int j = 0; j < 4; ++j) { const float g = acc[ai][0][m][n][j] * rs, up = acc[ai][1][m][n][j] * rs; v[n][j] = fsilu(g) * up; }
                *(u32x4*)(O + (size_t)r * DFF + col0) = pack8(v[0], v[1]); }
    }
};
struct EpiResidual {
    const float* Hin32; bf16* HB; float* ss_out;
    __device__ __forceinline__ void operator()(const f32x4 (&acc)[2][2][4][2], const GU& u, int wr, int wc, int fr, int fq) const {
        const int row0 = u.pm * 256 + wr * 64 + fr, col0 = u.pn * 256 + wc * 32 + 8 * fq;
#pragma unroll
        for (int hf = 0; hf < 2; ++hf) { const int ai = hf;
            u32x4 hv[8];
            if (!Hin32) {
#pragma unroll
                for (int q = 0; q < 8; ++q) { const int m = q >> 1, bj = q & 1; hv[q] = *(const u32x4*)(HB + (size_t)(row0 + ai * 128 + m * 16) * D + col0 + bj * 128); } }
#pragma unroll
            for (int m = 0; m < 4; ++m) { const int r = row0 + ai * 128 + m * 16; float s2 = 0.f;
#pragma unroll
                for (int bj = 0; bj < 2; ++bj) { const size_t o = (size_t)r * D + col0 + bj * 128;
                    f32x4 h0, h1;
                    if (Hin32) { h0 = *(const f32x4*)(Hin32 + o); h1 = *(const f32x4*)(Hin32 + o + 4); } else unpack8(hv[m * 2 + bj], h0, h1);
                    h0 += acc[ai][bj][m][0]; h1 += acc[ai][bj][m][1];
                    *(u32x4*)(HB + o) = pack8(h0, h1);
                    s2 += (h0[0] * h0[0] + h0[1] * h0[1]) + (h0[2] * h0[2] + h0[3] * h0[3]) + (h1[0] * h1[0] + h1[1] * h1[1]) + (h1[2] * h1[2] + h1[3] * h1[3]); }
                s2 += __shfl_xor(s2, 16); s2 += __shfl_xor(s2, 32);
                if (fq == 0) ss_out[(size_t)r * 16 + u.pn * 4 + wc] = s2; }
            asm volatile("" ::: "memory"); }
    }
};
#define SLOT(ai, m, bj) (((((ai) * 4 + (m)) >> 1) * 512 + tid) * 4 + (((m) & 1) * 2 + (bj)))
struct EpiMerge {
    u32x4* scrP; u32x4* scrM; bf16* M; const float* ss; const float* bias;
    int nm;
    __device__ __forceinline__ void operator()(const f32x4 (&acc)[2][2][4][2], const GU& u, int wr, int wc, int fr, int fq) const {
        int tid = threadIdx.x; asm volatile("" : "+v"(tid));
        if (u.kind == 0) {
#pragma unroll
            for (int ai = 0; ai < 2; ++ai)
#pragma unroll
                for (int m = 0; m < 4; ++m)
#pragma unroll
                    for (int bj = 0; bj < 2; ++bj) scrP[SLOT(ai, m, bj)] = pack8(acc[ai][bj][m][0], acc[ai][bj][m][1]);
            return;
        }
        const int row0 = u.pm * 256 + wr * 64 + fr, col0 = u.pn * 256 + wc * 32 + 8 * fq;
        rstd_table(ss, u.pm);
        const float* bp = bias + (size_t)u.mi * D + col0;
#pragma unroll
        for (int hf = 0; hf < 2; ++hf) { const int ai = hf;
            u32x4 pv[8];
#pragma unroll
            for (int q = 0; q < 8; ++q) pv[q] = scrP[SLOT(ai, q >> 1, q & 1)];
#pragma unroll
            for (int q = 0; q < 8; ++q) { const int m = q >> 1, bj = q & 1; const float rs = rstd_tab(wr * 64 + fr + ai * 128 + m * 16);
                const f32x4 b0 = *(const f32x4*)(bp + bj * 128), b1 = *(const f32x4*)(bp + bj * 128 + 4); f32x4 p0, p1; unpack8(pv[q], p0, p1);
#pragma unroll
                for (int j = 0; j < 4; ++j) { p0[j] *= fsigmoid(acc[ai][bj][m][0][j] * rs + b0[j]); p1[j] *= fsigmoid(acc[ai][bj][m][1][j] * rs + b1[j]); }
                pv[q] = pack8(p0, p1); }
            asm volatile("" ::: "memory");
            if (u.mi > 0) { u32x4 mv[8];
#pragma unroll
                for (int q = 0; q < 8; ++q) mv[q] = scrM[SLOT(ai, q >> 1, q & 1)];
#pragma unroll
                for (int q = 0; q < 8; ++q) { f32x4 a0, a1, q0, q1; unpack8(pv[q], a0, a1); unpack8(mv[q], q0, q1); pv[q] = pack8(a0 + q0, a1 + q1); } }
#pragma unroll
            for (int q = 0; q < 8; ++q) { const int m = q >> 1, bj = q & 1;
                if (u.mi == nm - 1) *(u32x4*)(M + (size_t)(row0 + ai * 128 + m * 16) * D + col0 + bj * 128) = pv[q]; else scrM[SLOT(ai, m, bj)] = pv[q]; }
            asm volatile("" ::: "memory"); }
    }
};
struct EpiPle {
    u32x4* scrP; const bf16* Hcur; bf16* HBout; const float* ss; float* ss_out;
    __device__ __forceinline__ void operator()(const f32x4 (&acc)[2][2][4][2], const GU& u, int wr, int wc, int fr, int fq) const {
        int tid = threadIdx.x; asm volatile("" : "+v"(tid));
        if (u.kind == 0) {
#pragma unroll
            for (int ai = 0; ai < 2; ++ai)
#pragma unroll
                for (int m = 0; m < 4; ++m)
#pragma unroll
                    for (int bj = 0; bj < 2; ++bj) scrP[SLOT(ai, m, bj)] = pack8(acc[ai][bj][m][0], acc[ai][bj][m][1]);
            return;
        }
        rstd_table(ss, u.pm);
        const int row0 = u.pm * 256 + wr * 64 + fr, col0 = u.pn * 256 + wc * 32 + 8 * fq;
#pragma unroll
        for (int qt = 0; qt < 4; ++qt) { const int ai = qt >> 1, m0 = (qt & 1) * 2;
            u32x4 pv[4], hv[4];
#pragma unroll
            for (int q = 0; q < 4; ++q) { const int m = m0 + (q >> 1), bj = q & 1; pv[q] = scrP[SLOT(ai, m, bj)]; hv[q] = *(const u32x4*)(Hcur + (size_t)(row0 + ai * 128 + m * 16) * D + col0 + bj * 128); }
#pragma unroll
            for (int mm = 0; mm < 2; ++mm) { const int m = m0 + mm; const int r = row0 + ai * 128 + m * 16; const float rs = rstd_tab(wr * 64 + fr + ai * 128 + m * 16); float s2 = 0.f;
#pragma unroll
                for (int bj = 0; bj < 2; ++bj) { const int q = mm * 2 + bj; f32x4 h0, h1, p0, p1; unpack8(hv[q], h0, h1); unpack8(pv[q], p0, p1);
#pragma unroll
                    for (int j = 0; j < 4; ++j) { h0[j] += fsigmoid(acc[ai][bj][m][0][j] * rs) * p0[j]; h1[j] += fsigmoid(acc[ai][bj][m][1][j] * rs) * p1[j]; }
                    *(u32x4*)(HBout + (size_t)r * D + col0 + bj * 128) = pack8(h0, h1);
                    s2 += (h0[0] * h0[0] + h0[1] * h0[1]) + (h0[2] * h0[2] + h0[3] * h0[3]) + (h1[0] * h1[0] + h1[1] * h1[1]) + (h1[2] * h1[2] + h1[3] * h1[3]); }
                s2 += __shfl_xor(s2, 16); s2 += __shfl_xor(s2, 32);
                if (fq == 0) ss_out[(size_t)r * 16 + u.pn * 4 + wc] = s2; }
            asm volatile("" ::: "memory"); }
    }
};

constexpr int NWAVES = 8, NTHR = 512;
constexpr int RING_OFF = 0, RING_BYTES = 131072, WREG = 19456, MISC_OFF = 8 * WREG;
constexpr int LDS_BYTES = MISC_OFF + 256;
static_assert(MISC_OFF + 128 <= LDS_BYTES, "lds");
struct Args { const float* in[37]; float* out; unsigned char* ws; int ph_lo, ph_hi; };
struct Frame {
    LAS unsigned char* lds; int tid, lane, wave, G, bx;
    const float* const* in; float* out; unsigned char* ws;
};
enum { I_X = 0, I_P, I_NORM_MIX, I_W_IN, I_POS_K, I_POS_V, I_CK1, I_CK2, I_CV1, I_CV2, I_LB, I_HG_NORM, I_RT_G, I_RT_B, I_MU, I_W0, I_WUP, I_A0, I_AUP, I_GUP, I_KK, I_KA, I_RK,
       I_RW_G, I_RW_B, I_WBR, I_WGATE, I_BGATE, I_WOUT, I_NORM_FFN, I_FFG, I_FFU, I_FFD, I_NORM_PLE, I_PLEG, I_PLEP, I_NORM_FINAL };

template <class ColMap>
__device__ __forceinline__ void transpose_item(const float* W, int ldw, int K, const float* scale, bf16* WT, LAS float* scr, int item, int nblk, int lane, const ColMap& cm) {
    const int kb = item / nblk, nb = item % nblk, k0 = 64 * kb, n0 = 32 * nb;
    const int sc = cm(n0 + (lane & 31));
    float tv[32];
#pragma unroll
    for (int i = 0; i < 32; ++i) { const int kk = 2 * i + (lane >> 5); tv[i] = (sc >= 0) ? W[(size_t)(k0 + kk) * ldw + sc] : 0.f; }
    if (scale) {
#pragma unroll
        for (int i = 0; i < 32; ++i) tv[i] *= scale[k0 + 2 * i + (lane >> 5)]; }
#pragma unroll
    for (int i = 0; i < 32; ++i) scr[(2 * i + (lane >> 5)) * 33 + (lane & 31)] = tv[i];
    LDS_WAIT();
    const int c = lane & 7;
#pragma unroll
    for (int j = 0; j < 4; ++j) { const int n = (lane >> 3) + 8 * j; const LAS float* s = scr + (8 * c) * 33 + n;
        u32x4 o; o.x = cvt_pk_bf16(s[0 * 33], s[1 * 33]); o.y = cvt_pk_bf16(s[2 * 33], s[3 * 33]); o.z = cvt_pk_bf16(s[4 * 33], s[5 * 33]); o.w = cvt_pk_bf16(s[6 * 33], s[7 * 33]);
        *(u32x4*)(WT + (size_t)(n0 + n) * K + k0 + 8 * c) = o; }
    LDS_WAIT();
}
struct CmIdent { __device__ __forceinline__ int operator()(int n) const { return n; } };
struct CmWin { __device__ __forceinline__ int operator()(int n) const { return n < 652 ? n : (n < 768 ? -1 : n - 116); } };
struct CmFF { __device__ __forceinline__ int operator()(int n) const { return (n >> 8) * 128 + (n & 127); } };

__device__ __forceinline__ void phase_prologue(Frame& F0) {
    Frame F = F0; asm volatile("" : "+v"(F.tid)); F.lane = F.tid & 63;
    LAS float* scr = (LAS float*)(F.lds + F.wave * WREG);
    const int gw = F.bx * NWAVES + F.wave, NGW = F.G * NWAVES;
    int dbase = 0;
#define DEAL(var, n) for (int _n = (n), var = (int)((unsigned)(gw + NGW - (dbase % NGW)) % (unsigned)NGW), _once = ((dbase += _n), 0); var < _n; var += NGW)
    for (int L = 0; L < NL; ++L) {
        unsigned char* wl = F.ws + WS_W + (size_t)L * WL_STRIDE;
        const float* g_mix = F.in[I_NORM_MIX] + L * D; const float* g_ffn = F.in[I_NORM_FFN] + L * D; const float* g_ple = F.in[I_NORM_PLE] + L * D;
        { const int nblk = UW / 32, items = (D / 64) * nblk; const float* W = F.in[I_W_IN] + (size_t)L * D * DIN;
          DEAL(it, items) transpose_item(W, DIN, D, g_mix, (bf16*)(wl + WL_IN), scr, it, nblk, F.lane, CmWin()); }
        for (int m = 0; m < 4; ++m) { const int nblk = D / 32, items = (D / 64) * nblk; const float* W = F.in[I_WGATE] + ((size_t)L * 4 + m) * D * D;
          DEAL(it, items) transpose_item(W, D, D, g_mix, (bf16*)(wl + WL_G) + (size_t)m * D * D, scr, it, nblk, F.lane, CmIdent()); }
        for (int m = 0; m < 4; ++m) { const int nblk = D / 32, items = (MW / 64) * nblk; const float* W = F.in[I_WBR] + ((size_t)L * 4 + m) * MW * D;
          DEAL(it, items) transpose_item(W, D, MW, nullptr, (bf16*)(wl + WL_B) + (size_t)m * D * MW, scr, it, nblk, F.lane, CmIdent()); }
        { const int nblk = D / 32, items = (D / 64) * nblk; const float* W = F.in[I_WOUT] + (size_t)L * D * D;
          DEAL(it, items) transpose_item(W, D, D, nullptr, (bf16*)(wl + WL_OUT), scr, it, nblk, F.lane, CmIdent()); }
        { const int nblk = (2 * DFF) / 32, items = (D / 64) * nblk; const float* Wg = F.in[I_FFG] + (size_t)L * D * DFF; const float* Wu = F.in[I_FFU] + (size_t)L * D * DFF;
          DEAL(it, items) { const int nb = it % nblk; const bool up = ((nb * 32) & 128) != 0; transpose_item(up ? Wu : Wg, DFF, D, g_ffn, (bf16*)(wl + WL_FF), scr, it, nblk, F.lane, CmFF()); } }
        { const int nblk = D / 32, items = (DFF / 64) * nblk; const float* W = F.in[I_FFD] + (size_t)L * DFF * D;
          DEAL(it, items) transpose_item(W, D, DFF, nullptr, (bf16*)(wl + WL_DN), scr, it, nblk, F.lane, CmIdent()); }
        { const int nblk = D / 32, items = (D / 64) * nblk; const float* W = F.in[I_PLEG] + (size_t)L * D * D;
          DEAL(it, items) transpose_item(W, D, D, g_ple, (bf16*)(wl + WL_PG), scr, it, nblk, F.lane, CmIdent()); }
        { const int nblk = D / 32, items = (PLE / 64) * nblk; const float* W = F.in[I_PLEP] + (size_t)L * PLE * D;
          DEAL(it, items) transpose_item(W, D, PLE, nullptr, (bf16*)(wl + WL_PP), scr, it, nblk, F.lane, CmIdent()); }
    }
    for (int L = 0; L < NL; ++L) for (int kv = 0; kv < 2; ++kv) {
        const float* w1 = F.in[kv ? I_CV1 : I_CK1] + (size_t)L * 2048 * 128; const float* w2 = F.in[kv ? I_CV2 : I_CK2] + (size_t)L * 128 * 64;
        bf16* w1T = (bf16*)(F.ws + WS_CW1 + (size_t)L * MiB) + (size_t)kv * 128 * 2048; bf16* w2T = (bf16*)(F.ws + WS_CW2 + (size_t)L * 65536) + kv * 64 * 128;
        DEAL(it, 128) transpose_item(w1, 128, 2048, nullptr, w1T, scr, it, 4, F.lane, CmIdent());
        DEAL(it, 4) transpose_item(w2, 64, 128, nullptr, w2T, scr, it, 2, F.lane, CmIdent());
        DEAL(tk, 64) { const int hf = tk & 1, jq = tk >> 1; const float* pos = F.in[kv ? I_POS_V : I_POS_K] + (size_t)L * 2048; float a = 0.f;
#pragma unroll 8
            for (int j = 64 * jq; j < 64 * jq + 64; ++j) a += pos[j] * w1[(size_t)j * 128 + hf * 64 + F.lane];
            ((float*)(F.ws + WS_CW2 + (size_t)L * 65536 + 32768))[(kv * 32 + jq) * 128 + hf * 64 + F.lane] = a; } }
#undef DEAL
    { const float* x = F.in[I_X]; bf16* hb = (bf16*)(F.ws + WS_HBA); float* ss0 = F.out;
      for (int r = gw; r < T; r += NGW) { const f32x4* xr = (const f32x4*)(x + (size_t)r * D) + F.lane; float s = 0.f;
#pragma unroll
        for (int j = 0; j < 4; ++j) { const f32x4 v = xr[64 * j]; s += (v[0] * v[0] + v[1] * v[1]) + (v[2] * v[2] + v[3] * v[3]);
            u32x2 w; w.x = cvt_pk_bf16(v[0], v[1]); w.y = cvt_pk_bf16(v[2], v[3]); *((u32x2*)(hb + (size_t)r * D) + F.lane + 64 * j) = w; }
        s = wave_sum(s); if (F.lane < 16) ss0[(size_t)r * 16 + F.lane] = (F.lane == 0) ? s : 0.f; } }
    for (int L = 0; L < NL; ++L) { bf16* base = (bf16*)(F.ws + WS_RWUP + (size_t)L * 131072);
        for (int it = gw; it < 8; it += NGW) transpose_item(F.in[I_WUP] + (size_t)L * 64 * 256, 256, 64, nullptr, base, scr, it, 8, F.lane, CmIdent());
        for (int it = gw; it < 8; it += NGW) transpose_item(F.in[I_AUP] + (size_t)L * 64 * 256, 256, 64, nullptr, base + 256 * 64, scr, it, 8, F.lane, CmIdent());
        for (int it = gw; it < 16; it += NGW) transpose_item(F.in[I_GUP] + (size_t)L * 128 * 256, 256, 128, nullptr, base + 2 * 256 * 64, scr, it, 8, F.lane, CmIdent()); }
    { float* rope = (float*)(F.ws + WS_ROPE); const int gt = F.bx * NTHR + F.tid, NT_ = F.G * NTHR;
      for (int i = gt; i < S * 32; i += NT_) { const int pos = i >> 5, j = i & 31; const float inv = exp2f(-(float)(2 * j) * (13.287712379549449f / 64.0f));
        const float a = (float)pos * inv;
        rope[2 * i] = cosf(a); rope[2 * i + 1] = sinf(a); } }
}

__device__ __forceinline__ float ldu(const bf16* u, size_t row, int col) { return bf2f(u[row * UW + col]); }

__device__ __forceinline__ bf16x8 frag_rm(const LAS unsigned char* X, int ld, int r0, int k0, int lane) { return *(const LAS bf16x8*)(X + (r0 + (lane & 31)) * ld + (k0 + 8 * (lane >> 5)) * 2); }
__device__ __forceinline__ bf16x8 frag_tr(const LAS unsigned char* X, int ld, int k0, int c0, int lane) {
    const LAS unsigned char* p = X + (k0 + 8 * (lane >> 5) + ((lane & 15) >> 2)) * ld + (c0 + 16 * ((lane >> 4) & 1) + 4 * (lane & 3)) * 2;
    const s16x4 a = __builtin_amdgcn_ds_read_tr16_b64_v4i16((LAS s16x4*)p), b = __builtin_amdgcn_ds_read_tr16_b64_v4i16((LAS s16x4*)(p + 4 * ld));
    return (bf16x8){a[0], a[1], a[2], a[3], b[0], b[1], b[2], b[3]};
}
__device__ __forceinline__ bf16x8 frag_g(const bf16* X, int ld, int r0, int k0, int lane) { return *(const bf16x8*)(X + (size_t)(r0 + (lane & 31)) * ld + k0 + 8 * (lane >> 5)); }
__device__ __forceinline__ f32x16 mma32(const bf16x8& a, const bf16x8& b, const f32x16& c) { return __builtin_amdgcn_mfma_f32_32x32x16_bf16(a, b, c, 0, 0, 0); }
__device__ __forceinline__ f32x16 zero16() { f32x16 z;
#pragma unroll
    for (int i = 0; i < 16; ++i) z[i] = 0.f;
    return z; }
__device__ __forceinline__ void st_T(LAS unsigned char* X, int ld, int j0, int i0, const f32x16& acc, int lane) {
#pragma unroll
    for (int g = 0; g < 4; ++g) { u32x2 w; w.x = cvt_pk_bf16(acc[4 * g], acc[4 * g + 1]); w.y = cvt_pk_bf16(acc[4 * g + 2], acc[4 * g + 3]);
        *(LAS u32x2*)(X + (j0 + (lane & 31)) * ld + (i0 + 8 * g + 4 * (lane >> 5)) * 2) = w; }
}
__device__ __forceinline__ void st_wt16(bf16* p, const u32x4& w) { __hip_atomic_store((unsigned long long*)p, ((unsigned long long)w.y << 32) | (unsigned long long)w.x, __ATOMIC_RELAXED, __HIP_MEMORY_SCOPE_AGENT); __hip_atomic_store((unsigned long long*)p + 1, ((unsigned long long)w.w << 32) | (unsigned long long)w.z, __ATOMIC_RELAXED, __HIP_MEMORY_SCOPE_AGENT); }
template <bool WT>
__device__ __forceinline__ void st_T_g(bf16* X, int ld, int j0, int i0, const f32x16& acc, int lane) {
    const int hh = lane >> 5; u32x2 w[4];
#pragma unroll
    for (int g = 0; g < 4; ++g) { w[g].x = cvt_pk_bf16(acc[4 * g], acc[4 * g + 1]); w[g].y = cvt_pk_bf16(acc[4 * g + 2], acc[4 * g + 3]); }
#pragma unroll
    for (int k = 0; k < 2; ++k) { const u32x2 snd = hh ? w[k] : w[2 + k]; u32x2 rcv; rcv.x = __shfl_xor(snd.x, 32); rcv.y = __shfl_xor(snd.y, 32);
        const u32x2 own = hh ? w[2 + k] : w[k]; u32x4 v; if (hh) { v.x = rcv.x; v.y = rcv.y; v.z = own.x; v.w = own.y; } else { v.x = own.x; v.y = own.y; v.z = rcv.x; v.w = rcv.y; }
        bf16* p = X + (size_t)(j0 + (lane & 31)) * ld + i0 + 8 * (2 * hh + k);
        if (WT) st_wt16(p, v); else *(u32x4*)p = v; }
}
__device__ __forceinline__ void st_T_row(bf16* rowp, int i0, const f32x16& acc, int lane) {
    const int hh = lane >> 5; u32x2 w[4];
#pragma unroll
    for (int g = 0; g < 4; ++g) { w[g].x = cvt_pk_bf16(acc[4 * g], acc[4 * g + 1]); w[g].y = cvt_pk_bf16(acc[4 * g + 2], acc[4 * g + 3]); }
#pragma unroll
    for (int k = 0; k < 2; ++k) { const u32x2 snd = hh ? w[k] : w[2 + k]; u32x2 rcv; rcv.x = __shfl_xor(snd.x, 32); rcv.y = __shfl_xor(snd.y, 32);
        const u32x2 own = hh ? w[2 + k] : w[k]; u32x4 v; if (hh) { v.x = rcv.x; v.y = rcv.y; v.z = own.x; v.w = own.y; } else { v.x = own.x; v.y = own.y; v.z = rcv.x; v.w = rcv.y; }
        *(u32x4*)(rowp + i0 + 8 * (2 * hh + k)) = v; }
}
constexpr int LD64 = 144, LD32 = 80;
__device__ __forceinline__ float expc(float x) { return __expf(fminf(fmaxf(x, -80.f), 80.f)); }
__device__ __forceinline__ unsigned short f2b(float x) { return (unsigned short)(cvt_pk_bf16(x, 0.f) & 0xffffu); }
__device__ __forceinline__ void copy_tok64(LAS unsigned char* X, const bf16* src, int lane) {
#pragma unroll
    for (int p = 0; p < 4; ++p) { const int t = 8 * p + (lane >> 3), ch = lane & 7; *(LAS u32x4*)(X + t * LD64 + ch * 16) = *(const u32x4*)(src + (size_t)t * UW + ch * 8); }
}
__device__ __forceinline__ void glin_m1(const LAS unsigned char* Kh, const LAS unsigned char* Vv, bf16* Sg, int lane, bool cst = false) {
#pragma unroll
    for (int dt = 0; dt < 2; ++dt)
#pragma unroll
        for (int et = 0; et < 2; ++et) { f32x16 acc = zero16();
#pragma unroll
            for (int ks = 0; ks < 2; ++ks) acc = mma32(frag_tr(Kh, LD64, 16 * ks, 32 * dt, lane), frag_tr(Vv, LD64, 16 * ks, 32 * et, lane), acc);
            if (cst) {
#pragma unroll
            for (int i = 0; i < 16; ++i) acc[i] = 0.01f * (float)(1 + ((lane + i) & 7)); }
            st_T_g<false>(Sg, 64, 32 * et, 32 * dt, acc, lane); }
}
__device__ __forceinline__ void glin_m3(const LAS unsigned char* Qt, const LAS unsigned char* Kt, const LAS unsigned char* Vv, LAS unsigned char* Xa, const bf16* S0, int lane, f32x16 (&o)[2]) {
    { f32x16 acc = zero16();
#pragma unroll
      for (int ks = 0; ks < 4; ++ks) acc = mma32(frag_rm(Kt, LD64, 0, 16 * ks, lane), frag_rm(Qt, LD64, 0, 16 * ks, lane), acc);
      const int t = lane & 31;
#pragma unroll
      for (int i = 0; i < 16; ++i) { const int sidx = (i & 3) + 8 * (i >> 2) + 4 * (lane >> 5); if (sidx > t) acc[i] = 0.f; }
      st_T(Xa, LD32, 0, 0, acc, lane); }
    LDS_WAIT();
#pragma unroll
    for (int et = 0; et < 2; ++et) { f32x16 acc = zero16();
        if (S0) {
#pragma unroll
            for (int ks = 0; ks < 4; ++ks) acc = mma32(frag_g(S0, 64, 32 * et, 16 * ks, lane), frag_rm(Qt, LD64, 0, 16 * ks, lane), acc); }
#pragma unroll
        for (int ks = 0; ks < 2; ++ks) acc = mma32(frag_tr(Vv, LD64, 16 * ks, 32 * et, lane), frag_rm(Xa, LD32, 0, 16 * ks, lane), acc);
        o[et] = acc; }
}
template <bool M3>
__device__ __forceinline__ void hgrn_chunk(Frame& F, int L, int bh, int n, LAS unsigned char* W, bf16* Sbase, float* Dbase) {
    const bf16* u = (const bf16*)(F.ws + WS_U); bf16* bo = (bf16*)(F.ws + WS_BO);
    int lane = F.lane; asm volatile("" : "+v"(lane));
    const int b = bh >> 2, h = bh & 3; const size_t row0 = (size_t)b * S + (size_t)n * CH;
    const bf16* ur = u + row0 * UW + U_HG + h * 64;
    bf16* Sg = Sbase + ((size_t)bh * NCH + n) * 4096;
    LAS unsigned char* Xq = W; LAS unsigned char* Xk = W + 4608; LAS unsigned char* Xv = W + 9216; LAS unsigned char* Xa = W + 13824;
    const float* lbl = F.in[I_LB]; const int ch = h * 64 + lane;
    float lb = 0.f; if (L > 0) { const float l0 = lbl[ch], l1 = lbl[256 + ch]; const float mx = fmaxf(l0, l1); const float e0 = __expf(l0 - mx), e1 = __expf(l1 - mx); lb = e1 / (e0 + e1); }
    copy_tok64(Xq, ur + 256, lane); if (M3) copy_tok64(Xk, ur, lane);
    copy_tok64(Xv, ur + 512, lane);
    LDS_WAIT();
    float bcum[CH], kk[CH]; float run = 0.f;
#pragma unroll
    for (int t = 0; t < CH; ++t) { const float z = bf2f(*(const LAS unsigned short*)(Xq + t * LD64 + lane * 2)); const float f = lb + (1.0f - lb) * fsigmoid(z); kk[t] = 1.0f - f; run += __logf(fmaxf(f, 1e-20f)); bcum[t] = run; }
    const float blast = bcum[CH - 1];
    LDS_WAIT();
    if (!M3) {
#pragma unroll
        for (int t = 0; t < CH; ++t) *(LAS unsigned short*)(Xq + t * LD64 + lane * 2) = f2b(kk[t] * expc(blast - bcum[t]));
        Dbase[((size_t)bh * NCH + n) * 64 + lane] = expc(blast);
        LDS_WAIT();
        glin_m1(Xq, Xv, Sg, lane);
    } else {
#pragma unroll
        for (int t = 0; t < CH; ++t) { const float q = fsilu(bf2f(*(const LAS unsigned short*)(Xk + t * LD64 + lane * 2)));
            *(LAS unsigned short*)(Xq + t * LD64 + lane * 2) = f2b(q * expc(bcum[t]));
            *(LAS unsigned short*)(Xk + t * LD64 + lane * 2) = f2b(kk[t] * expc(-bcum[t])); }
        LDS_WAIT();
        f32x16 o[2];
        glin_m3(Xq, Xk, Xv, Xa, n > 0 ? Sg - 4096 : nullptr, lane, o);
        const int t = lane & 31, hh = lane >> 5; float ss = 0.f;
#pragma unroll
        for (int et = 0; et < 2; ++et)
#pragma unroll
            for (int i = 0; i < 16; ++i) ss += o[et][i] * o[et][i];
        ss += __shfl_xor(ss, 32);
        const float rn = __builtin_amdgcn_rsqf(ss * (1.0f / 64.0f) + EPS);
        const float* ng = F.in[I_HG_NORM] + L * 256 + h * 64;
#pragma unroll
        for (int et = 0; et < 2; ++et) {
#pragma unroll
            for (int g = 0; g < 4; ++g) { const int e0 = 32 * et + 8 * g + 4 * hh;
                const u32x2 og = *(const u32x2*)(ur + (size_t)t * UW + 768 + e0); const f32x4 gg = *(const f32x4*)(ng + e0);
                o[et][4 * g] *= rn * gg[0] * fsilu(bflo(og.x)); o[et][4 * g + 1] *= rn * gg[1] * fsilu(bfhi(og.x));
                o[et][4 * g + 2] *= rn * gg[2] * fsilu(bflo(og.y)); o[et][4 * g + 3] *= rn * gg[3] * fsilu(bfhi(og.y)); }
            st_T_g<false>(bo + row0 * 1024 + 256 + h * 64, 1024, 0, 32 * et, o[et], lane); }
    }
    LDS_WAIT();
}
template <bool M3>
__device__ __forceinline__ void ret_chunk(Frame& F, int L, int bh, int n, LAS unsigned char* W, bf16* Sbase) {
    const bf16* u = (const bf16*)(F.ws + WS_U); bf16* bo = (bf16*)(F.ws + WS_BO); const float* rope = (const float*)(F.ws + WS_ROPE);
    int lane = F.lane; asm volatile("" : "+v"(lane));
    const int b = bh >> 2, h = bh & 3; const int tpos0 = n * CH; const size_t row0 = (size_t)b * S + (size_t)tpos0;
    const bf16* ur = u + row0 * UW + U_RT + h * 64;
    bf16* Sg = Sbase + ((size_t)bh * NCH + n) * 4096;
    LAS unsigned char* Xq = W; LAS unsigned char* Xk = W + 4608; LAS unsigned char* Xv = W + 9216; LAS unsigned char* Xa = W + 13824;
    const float lg2 = __log2f(1.0f - exp2f(-5.0f - (float)h));
    copy_tok64(Xv, ur + 512, lane);
#pragma unroll
    for (int p = 0; p < 2; ++p) { const int idx = lane + 64 * p, t = idx >> 2, jc = idx & 3;
        f32x4 c0, c1, s0, s1;
        { const float* rp = rope + ((size_t)(tpos0 + t) * 32 + jc * 8) * 2; const f32x4 a = *(const f32x4*)rp, bq = *(const f32x4*)(rp + 4), c = *(const f32x4*)(rp + 8), d = *(const f32x4*)(rp + 12);
          c0 = (f32x4){a[0], a[2], bq[0], bq[2]}; s0 = (f32x4){a[1], a[3], bq[1], bq[3]}; c1 = (f32x4){c[0], c[2], d[0], d[2]}; s1 = (f32x4){c[1], c[3], d[1], d[3]}; }
        { const u32x4 w1 = *(const u32x4*)(ur + (size_t)t * UW + 256 + jc * 8), w2 = *(const u32x4*)(ur + (size_t)t * UW + 256 + 32 + jc * 8);
          f32x4 a0, a1, b0, b1; unpack8(w1, a0, a1); unpack8(w2, b0, b1);
          const float sc = 0.125f * exp2f(lg2 * (M3 ? -(float)(t + 1) : (float)(CH - 1 - t)));
          const f32x4 lo0 = (a0 * c0 - b0 * s0) * sc, lo1 = (a1 * c1 - b1 * s1) * sc, hi0 = (a0 * s0 + b0 * c0) * sc, hi1 = (a1 * s1 + b1 * c1) * sc;
          LAS unsigned char* dst = M3 ? Xk : Xq;
          *(LAS u32x4*)(dst + t * LD64 + jc * 16) = pack8(lo0, lo1); *(LAS u32x4*)(dst + t * LD64 + 64 + jc * 16) = pack8(hi0, hi1); }
        if (M3) { const u32x4 w1 = *(const u32x4*)(ur + (size_t)t * UW + jc * 8), w2 = *(const u32x4*)(ur + (size_t)t * UW + 32 + jc * 8);
          f32x4 a0, a1, b0, b1; unpack8(w1, a0, a1); unpack8(w2, b0, b1);
          const float sc = exp2f(lg2 * (float)(t + 1));
          const f32x4 lo0 = (a0 * c0 - b0 * s0) * sc, lo1 = (a1 * c1 - b1 * s1) * sc, hi0 = (a0 * s0 + b0 * c0) * sc, hi1 = (a1 * s1 + b1 * c1) * sc;
          *(LAS u32x4*)(Xq + t * LD64 + jc * 16) = pack8(lo0, lo1); *(LAS u32x4*)(Xq + t * LD64 + 64 + jc * 16) = pack8(hi0, hi1); }
    }
    LDS_WAIT();
    if (!M3) glin_m1(Xq, Xv, Sg, lane);
    else {
        f32x16 o[2];
        glin_m3(Xq, Xk, Xv, Xa, n > 0 ? Sg - 4096 : nullptr, lane, o);
        const int t = lane & 31, hh = lane >> 5; float sm = 0.f;
#pragma unroll
        for (int et = 0; et < 2; ++et)
#pragma unroll
            for (int i = 0; i < 16; ++i) sm += o[et][i];
        sm += __shfl_xor(sm, 32);
        const float mean = sm * (1.0f / 64.0f); float sv = 0.f;
#pragma unroll
        for (int et = 0; et < 2; ++et)
#pragma unroll
            for (int i = 0; i < 16; ++i) { const float dl = o[et][i] - mean; sv += dl * dl; }
        sv += __shfl_xor(sv, 32);
        const float rn = __builtin_amdgcn_rsqf(sv * (1.0f / 64.0f) + 1e-5f);
        const float* ng = F.in[I_RT_G] + L * 256 + h * 64; const float* nb = F.in[I_RT_B] + L * 256 + h * 64;
#pragma unroll
        for (int et = 0; et < 2; ++et) {
#pragma unroll
            for (int g = 0; g < 4; ++g) { const int e0 = 32 * et + 8 * g + 4 * hh;
                const u32x2 og = *(const u32x2*)(ur + (size_t)t * UW + 768 + e0); const f32x4 gg = *(const f32x4*)(ng + e0), bb = *(const f32x4*)(nb + e0);
                o[et][4 * g] = ((o[et][4 * g] - mean) * rn * gg[0] + bb[0]) * fsilu(bflo(og.x)); o[et][4 * g + 1] = ((o[et][4 * g + 1] - mean) * rn * gg[1] + bb[1]) * fsilu(bfhi(og.x));
                o[et][4 * g + 2] = ((o[et][4 * g + 2] - mean) * rn * gg[2] + bb[2]) * fsilu(bflo(og.y)); o[et][4 * g + 3] = ((o[et][4 * g + 3] - mean) * rn * gg[3] + bb[3]) * fsilu(bfhi(og.y)); }
            st_T_g<false>(bo + row0 * 1024 + 512 + h * 64, 1024, 0, 32 * et, o[et], lane); }
    }
    LDS_WAIT();
}
__device__ __forceinline__ void glin_scan_task(const bf16* Sbase, bf16* Sout, const float* Dbase, float dscal, int bh, int half, int tl  ) {
    const bf16* p = Sbase + (size_t)bh * NCH * 4096 + half * 2048 + tl * 8; bf16* po = Sout + (size_t)bh * NCH * 4096 + half * 2048 + tl * 8;
    const int d0 = (tl & 7) * 8;
    float st[8];
#pragma unroll
    for (int x = 0; x < 8; ++x) st[x] = 0.f;
    for (int n0 = 0; n0 < NCH; n0 += 8) {
        u32x4 kv[8]; f32x4 da[8], db[8];
#pragma unroll
        for (int j = 0; j < 8; ++j) { kv[j] = *(const u32x4*)(p + (size_t)(n0 + j) * 4096);
            if (Dbase) { da[j] = *(const f32x4*)(Dbase + ((size_t)bh * NCH + n0 + j) * 64 + d0); db[j] = *(const f32x4*)(Dbase + ((size_t)bh * NCH + n0 + j) * 64 + d0 + 4); } else { da[j] = (f32x4){dscal, dscal, dscal, dscal}; db[j] = da[j]; } }
#pragma unroll
        for (int j = 0; j < 8; ++j) { f32x4 a, b; unpack8(kv[j], a, b);
#pragma unroll
            for (int x = 0; x < 4; ++x) { st[x] = st[x] * da[j][x] + a[x]; st[4 + x] = st[4 + x] * db[j][x] + b[x]; }
            *(u32x4*)(po + (size_t)(n0 + j) * 4096) = pack8((f32x4){st[0], st[1], st[2], st[3]}, (f32x4){st[4], st[5], st[6], st[7]}); }
    }
}

constexpr int RW_R0 = 0, RW_R1 = 4608, RW_R2 = 9216, RW_R3 = 13824, RW_R4 = 16384, RW_R5 = 18944, RW_LW = 0, RW_AG = 8704, LDLW = 272;
__device__ __forceinline__ void ld_shift8(const bf16* urow, bool has_prev, const float* mu8, f32x4& lo, f32x4& hi) {
    const u32x4 w1 = *(const u32x4*)urow; f32x4 a0, a1; unpack8(w1, a0, a1);
    f32x4 p0 = {0.f, 0.f, 0.f, 0.f}, p1 = {0.f, 0.f, 0.f, 0.f};
    if (has_prev) { const u32x4 w0 = *(const u32x4*)(urow - UW); unpack8(w0, p0, p1); }
    const f32x4 m0 = *(const f32x4*)mu8, m1 = *(const f32x4*)(mu8 + 4);
    lo = a0 + m0 * (p0 - a0); hi = a1 + m1 * (p1 - a1);
}
__device__ __forceinline__ float ftanh(float x) { return 1.0f - 2.0f * __builtin_amdgcn_rcpf(1.0f + __builtin_amdgcn_exp2f(2.8853900817779268f * x)); }
#ifndef RW_LIMIT
#define RW_LIMIT 100
#endif
#define RW_CUT(k) do { if (RW_LIMIT <= (k)) return; } while (0)
template <int SI> struct SubstStep {
    static __device__ __forceinline__ void run(float (&Tr)[CH], const LAS unsigned char* AT, int r32, int& ofs) {
        float a0 = (r32 == SI) ? 1.0f : 0.f, a1 = 0.f;
#pragma unroll
        for (int q = 0; q < 4; ++q) { if (8 * q + 7 > SI) { const u32x4 w = *(const LAS u32x4*)(AT + ofs + SI * LD32 + q * 16); f32x4 lo, hi; unpack8(w, lo, hi);
#pragma unroll
            for (int x = 0; x < 4; ++x) { if (8 * q + x > SI) a0 += Tr[8 * q + x] * lo[x]; if (8 * q + 4 + x > SI) a1 += Tr[8 * q + 4 + x] * hi[x]; } } }
        const float a = a0 + a1;
        Tr[SI] = a;
        asm volatile("" : "+v"(ofs) : "v"(a));
        SubstStep<SI - 1>::run(Tr, AT, r32, ofs);
    }
};
template <> struct SubstStep<-1> { static __device__ __forceinline__ void run(float (&)[CH], const LAS unsigned char*, int, int&) {} };
template <bool M3>
__device__ __forceinline__ void rwkv_chunk(Frame& F, int L, int bh, int n, LAS unsigned char* W) {
    const bf16* u = (const bf16*)(F.ws + WS_U); bf16* bo = (bf16*)(F.ws + WS_BO);
    int lane = F.lane; asm volatile("" : "+v"(lane));
    const int b = bh >> 2, h = bh & 3, r32 = lane & 31, hh = lane >> 5; const size_t row0 = (size_t)b * S + (size_t)n * CH;
    const bf16* ur = u + row0 * UW + U_RW;
    const float* mu = F.in[I_MU] + L * 1024;
    const bf16* upT = (const bf16*)(F.ws + WS_RWUP + (size_t)L * 131072);
    bf16* Mg = (bf16*)(F.ws + WS_RWM) + ((size_t)bh * NCH + n) * 4096;
    bf16* Ng = (bf16*)(F.ws + WS_RWN) + ((size_t)bh * NCH + n) * 4096;
    bf16* Tg = (bf16*)((unsigned char*)F.out + DO_T) + ((size_t)bh * NCH + n) * 1024;
    LAS unsigned char* R0 = W + RW_R0; LAS unsigned char* R1 = W + RW_R1; LAS unsigned char* R2 = W + RW_R2; LAS unsigned char* R3 = W + RW_R3; LAS unsigned char* R4 = W + RW_R4;
    LAS float* R5 = (LAS float*)(W + RW_R5);
#pragma unroll
    for (int i = 0; i < 8; ++i) { const int idx = lane + 64 * i, t = idx >> 4, part = (idx >> 3) & 1, ch = idx & 7, col = 768 + part * 64 + ch * 8;
        f32x4 lo, hi; ld_shift8(ur + (size_t)t * UW + col, (n * CH + t) > 0, mu + col, lo, hi);
        if (part == 0) {
#pragma unroll
            for (int j = 0; j < 4; ++j) { lo[j] = ftanh(lo[j]); hi[j] = ftanh(hi[j]); } }
        *(LAS u32x4*)(W + part * 4608 + t * LD64 + ch * 16) = pack8(lo, hi); }
    RW_CUT(0);
    LDS_WAIT();
    { f32x16 zw[2], za[2];
#pragma unroll
      for (int ct = 0; ct < 2; ++ct) { zw[ct] = zero16(); za[ct] = zero16();
#pragma unroll
        for (int ks = 0; ks < 4; ++ks) { zw[ct] = mma32(frag_g(upT + (size_t)(h * 64 + 32 * ct) * 64, 64, 0, 16 * ks, lane), frag_rm(W, LD64, 0, 16 * ks, lane), zw[ct]);
            za[ct] = mma32(frag_g(upT + 256 * 64 + (size_t)(h * 64 + 32 * ct) * 64, 64, 0, 16 * ks, lane), frag_rm(W + 4608, LD64, 0, 16 * ks, lane), za[ct]); } }
      const float* w0 = F.in[I_W0] + L * 256 + h * 64; const float* a0 = F.in[I_A0] + L * 256 + h * 64;
#pragma unroll
      for (int ct = 0; ct < 2; ++ct)
#pragma unroll
        for (int g = 0; g < 4; ++g) { const int c0 = 32 * ct + 8 * g + 4 * hh; const f32x4 wv = *(const f32x4*)(w0 + c0), av = *(const f32x4*)(a0 + c0);
            f32x4 lw, ag;
#pragma unroll
            for (int x = 0; x < 4; ++x) { lw[x] = -0.6065306597126334f * fsigmoid(zw[ct][4 * g + x] + wv[x]); ag[x] = fsigmoid(za[ct][4 * g + x] + av[x]); }
            *(LAS f32x4*)(W + RW_LW + r32 * LDLW + c0 * 4) = lw;
            u32x2 pk; pk.x = cvt_pk_bf16(ag[0], ag[1]); pk.y = cvt_pk_bf16(ag[2], ag[3]); *(LAS u32x2*)(W + RW_AG + r32 * LD64 + c0 * 2) = pk; } }
    RW_CUT(1);
    LDS_WAIT();
    { float run = 0.f;
#pragma unroll
      for (int t = 0; t < CH; ++t) { LAS float* p = (LAS float*)(W + RW_LW + t * LDLW) + lane; run += *p; *p = run; } }
    RW_CUT(2);
    LDS_WAIT();
    const int c0 = 8 * (lane & 7), tl = lane >> 3;
    u32x4 E1p[4], E2p[4], AGp[4];
#pragma unroll
    for (int p = 0; p < 4; ++p) { const int t = 8 * p + tl;
        const f32x4 ca = *(const LAS f32x4*)(W + RW_LW + t * LDLW + c0 * 4), cb = *(const LAS f32x4*)(W + RW_LW + t * LDLW + c0 * 4 + 16);
        f32x4 ea = {0.f, 0.f, 0.f, 0.f}, eb = {0.f, 0.f, 0.f, 0.f};
        if (t > 0) { ea = *(const LAS f32x4*)(W + RW_LW + (t - 1) * LDLW + c0 * 4); eb = *(const LAS f32x4*)(W + RW_LW + (t - 1) * LDLW + c0 * 4 + 16); }
        AGp[p] = *(const LAS u32x4*)(W + RW_AG + t * LD64 + c0 * 2);
        f32x4 x1a, x1b, x2a, x2b;
#pragma unroll
        for (int x = 0; x < 4; ++x) { x1a[x] = __expf(ea[x]); x1b[x] = __expf(eb[x]); x2a[x] = __expf(-ca[x]); x2b[x] = __expf(-cb[x]); }
        E1p[p] = pack8(x1a, x1b); E2p[p] = pack8(x2a, x2b); }
    float pcl[8];
    { const f32x4 la = *(const LAS f32x4*)(W + RW_LW + 31 * LDLW + c0 * 4), lb2 = *(const LAS f32x4*)(W + RW_LW + 31 * LDLW + c0 * 4 + 16);
#pragma unroll
      for (int x = 0; x < 4; ++x) { pcl[x] = __expf(la[x]); pcl[4 + x] = __expf(lb2[x]); } }
    RW_CUT(3);
    LDS_WAIT();
    const float* kkw = F.in[I_KK] + L * 256 + h * 64 + c0; const float* kaw = F.in[I_KA] + L * 256 + h * 64 + c0; const float* rkw = F.in[I_RK] + L * 256 + h * 64 + c0;
    u32x4 Ap[4];
    if (!M3 && tl == 0) { *(LAS f32x4*)(R5 + c0) = (f32x4){pcl[0], pcl[1], pcl[2], pcl[3]}; *(LAS f32x4*)(R5 + c0 + 4) = (f32x4){pcl[4], pcl[5], pcl[6], pcl[7]}; }
#pragma unroll
    for (int p = 0; p < 4; ++p) { const int t = 8 * p + tl; const bool hp = (n * CH + t) > 0; const bf16* ut = ur + (size_t)t * UW + h * 64 + c0;
        f32x4 k0, k1, r0 = {0.f, 0.f, 0.f, 0.f}, r1 = {0.f, 0.f, 0.f, 0.f};
        ld_shift8(ut + 256, hp, mu + 256 + h * 64 + c0, k0, k1);
        if (M3) ld_shift8(ut, hp, mu + h * 64 + c0, r0, r1);
        f32x4 ag0, ag1; unpack8(AGp[p], ag0, ag1);
        float E1[8], E2[8]; { f32x4 a, bq; unpack8(E1p[p], a, bq); f32x4 c, d; unpack8(E2p[p], c, d);
#pragma unroll
            for (int x = 0; x < 4; ++x) { E1[x] = a[x]; E1[4 + x] = bq[x]; E2[x] = c[x]; E2[4 + x] = d[x]; } }
        const f32x4 kw0 = *(const f32x4*)kkw, kw1 = *(const f32x4*)(kkw + 4), ka0 = *(const f32x4*)kaw, ka1 = *(const f32x4*)(kaw + 4);
        f32x4 q0 = k0 * kw0, q1 = k1 * kw1;
        float n2 = (q0[0] * q0[0] + q0[1] * q0[1]) + (q0[2] * q0[2] + q0[3] * q0[3]) + (q1[0] * q1[0] + q1[1] * q1[1]) + (q1[2] * q1[2] + q1[3] * q1[3]);
        n2 += __shfl_xor(n2, 1); n2 += __shfl_xor(n2, 2); n2 += __shfl_xor(n2, 4);
        const float rn = __builtin_amdgcn_rsqf(fmaxf(n2, 1e-24f)); q0 = q0 * rn; q1 = q1 * rn;
        f32x4 kp0, kp1, at0, at1, bt0, bt1, kt0, kt1;
#pragma unroll
        for (int x = 0; x < 4; ++x) { kp0[x] = k0[x] * (1.0f + (ag0[x] - 1.0f) * ka0[x]); kp1[x] = k1[x] * (1.0f + (ag1[x] - 1.0f) * ka1[x]);
            at0[x] = -q0[x] * E1[x]; at1[x] = -q1[x] * E1[4 + x]; bt0[x] = q0[x] * ag0[x] * E2[x]; bt1[x] = q1[x] * ag1[x] * E2[4 + x];
            kt0[x] = kp0[x] * E2[x]; kt1[x] = kp1[x] * E2[4 + x]; }
        *(LAS u32x4*)(R1 + t * LD64 + c0 * 2) = pack8(bt0, bt1); *(LAS u32x4*)(R2 + t * LD64 + c0 * 2) = pack8(kt0, kt1);
        if (!M3) *(LAS u32x4*)(R0 + t * LD64 + c0 * 2) = pack8(at0, at1);
        else { Ap[p] = pack8(at0, at1);
            const f32x4 rk0 = *(const f32x4*)rkw, rk1 = *(const f32x4*)(rkw + 4);
            f32x4 rt0, rt1; float bs = 0.f;
#pragma unroll
            for (int x = 0; x < 4; ++x) { rt0[x] = r0[x] * __builtin_amdgcn_rcpf(E2[x]); rt1[x] = r1[x] * __builtin_amdgcn_rcpf(E2[4 + x]); bs += r0[x] * kp0[x] * rk0[x] + r1[x] * kp1[x] * rk1[x]; }
            bs += __shfl_xor(bs, 1); bs += __shfl_xor(bs, 2); bs += __shfl_xor(bs, 4);
            if ((lane & 7) == 0) R5[t] = bs;
            *(LAS u32x4*)(R0 + t * LD64 + c0 * 2) = pack8(rt0, rt1); } }
    RW_CUT(4);
    LDS_WAIT();
    const bf16* S0 = n > 0 ? (const bf16*)((unsigned char*)F.out + DO_RWS) + ((size_t)bh * NCH + n - 1) * 4096 : nullptr;
    f32x16 yacc[2], g2acc;
    if (M3) {
#pragma unroll
        for (int vt = 0; vt < 2; ++vt) { yacc[vt] = zero16();
            if (S0) {
#pragma unroll
                for (int ks = 0; ks < 4; ++ks) yacc[vt] = mma32(frag_g(S0, 64, 32 * vt, 16 * ks, lane), frag_rm(R0, LD64, 0, 16 * ks, lane), yacc[vt]); } }
        f32x16 g1 = zero16(); g2acc = zero16();
#pragma unroll
        for (int ks = 0; ks < 4; ++ks) { const bf16x8 rf = frag_rm(R0, LD64, 0, 16 * ks, lane); g1 = mma32(frag_rm(R1, LD64, 0, 16 * ks, lane), rf, g1); g2acc = mma32(frag_rm(R2, LD64, 0, 16 * ks, lane), rf, g2acc); }
#pragma unroll
        for (int i = 0; i < 16; ++i) { const int sidx = (i & 3) + 8 * (i >> 2) + 4 * hh; if (sidx > r32) { g1[i] = 0.f; g2acc[i] = 0.f; } }
        st_T(R4, LD32, 0, 0, g1, lane);
        LDS_WAIT();
#pragma unroll
        for (int p = 0; p < 4; ++p) *(LAS u32x4*)(R0 + (8 * p + tl) * LD64 + c0 * 2) = Ap[p];
        LDS_WAIT();
    }
    RW_CUT(5);
    { f32x16 ab = zero16(), ak = zero16();
#pragma unroll
      for (int ks = 0; ks < 4; ++ks) { const bf16x8 af = frag_rm(R0, LD64, 0, 16 * ks, lane); if (!M3) ab = mma32(af, frag_rm(R1, LD64, 0, 16 * ks, lane), ab); ak = mma32(frag_rm(R2, LD64, 0, 16 * ks, lane), af, ak); }
#pragma unroll
      for (int i = 0; i < 16; ++i) { const int ridx = (i & 3) + 8 * (i >> 2) + 4 * hh;
          if (!(ridx > r32)) ab[i] = 0.f;
          if (!(ridx < r32)) ak[i] = 0.f; }
      if (!M3) st_T(R3, LD32, 0, 0, ab, lane);
      st_T(M3 ? R2 : R4, LD32, 0, 0, ak, lane); }
    LAS unsigned char* X1 = M3 ? R2 : R4;
    RW_CUT(6);
    LDS_WAIT();
    if (!M3) {
      float Tr[CH];
      int sofs = 0; asm volatile("" : "+v"(sofs)); SubstStep<CH - 1>::run(Tr, R3, r32, sofs);
      if (hh == 0) {
#pragma unroll
          for (int q = 0; q < 4; ++q) { f32x4 lo = {Tr[8 * q], Tr[8 * q + 1], Tr[8 * q + 2], Tr[8 * q + 3]}, hi = {Tr[8 * q + 4], Tr[8 * q + 5], Tr[8 * q + 6], Tr[8 * q + 7]};
              const u32x4 w = pack8(lo, hi); *(LAS u32x4*)(R3 + r32 * LD32 + q * 16) = w; *(u32x4*)(Tg + r32 * 32 + q * 8) = w; } }
    } else if (hh == 0) {
#pragma unroll
        for (int q = 0; q < 4; ++q) *(LAS u32x4*)(R3 + r32 * LD32 + q * 16) = *(const u32x4*)(Tg + r32 * 32 + q * 8);
    }
    RW_CUT(7);
    LDS_WAIT();
    { f32x16 y = zero16(), ah[2];
#pragma unroll
      for (int ks = 0; ks < 2; ++ks) y = mma32(frag_tr(X1, LD32, 16 * ks, 0, lane), frag_rm(R3, LD32, 0, 16 * ks, lane), y);
#pragma unroll
      for (int ct = 0; ct < 2; ++ct) { ah[ct] = zero16();
#pragma unroll
        for (int ks = 0; ks < 2; ++ks) ah[ct] = mma32(frag_tr(R0, LD64, 16 * ks, 32 * ct, lane), frag_rm(R3, LD32, 0, 16 * ks, lane), ah[ct]); }
      st_T(X1, LD32, 0, 0, y, lane);
      st_T(R0, LD64, 0, 0, ah[0], lane); st_T(R0, LD64, 0, 32, ah[1], lane); }
    RW_CUT(8);
    LDS_WAIT();
    if (!M3) {
        { f32x16 z[2];
#pragma unroll
          for (int dt = 0; dt < 2; ++dt) {
#pragma unroll
            for (int g = 0; g < 4; ++g) { const u32x2 w = *(const LAS u32x2*)(R2 + r32 * LD64 + (32 * dt + 8 * g + 4 * hh) * 2); z[dt][4 * g] = bflo(w.x); z[dt][4 * g + 1] = bfhi(w.x); z[dt][4 * g + 2] = bflo(w.y); z[dt][4 * g + 3] = bfhi(w.y); }
#pragma unroll
            for (int ks = 0; ks < 2; ++ks) z[dt] = mma32(frag_tr(R1, LD64, 16 * ks, 32 * dt, lane), frag_tr(X1, LD32, 16 * ks, 0, lane), z[dt]); }
          st_T(R2, LD64, 0, 0, z[0], lane); st_T(R2, LD64, 0, 32, z[1], lane); }
#pragma unroll
        for (int d1t = 0; d1t < 2; ++d1t) { const float pc1 = R5[32 * d1t + r32];
#pragma unroll
            for (int d2t = 0; d2t < 2; ++d2t) { f32x16 m = zero16();
#pragma unroll
                for (int ks = 0; ks < 2; ++ks) m = mma32(frag_tr(R0, LD64, 16 * ks, 32 * d2t, lane), frag_tr(R1, LD64, 16 * ks, 32 * d1t, lane), m);
#pragma unroll
                for (int i = 0; i < 16; ++i) { const int d2 = 32 * d2t + (i & 3) + 8 * (i >> 2) + 4 * hh; m[i] = pc1 * (m[i] + ((d2 == 32 * d1t + r32) ? 1.0f : 0.f)); }
                st_T_g<false>(Mg, 64, 32 * d1t, 32 * d2t, m, lane); } }
        LDS_WAIT();
#pragma unroll
        for (int p = 0; p < 4; ++p) { const int t = 8 * p + tl; f32x4 v0, v1; ld_shift8(ur + (size_t)t * UW + h * 64 + c0 + 512, (n * CH + t) > 0, mu + 512 + h * 64 + c0, v0, v1); *(LAS u32x4*)(R1 + t * LD64 + c0 * 2) = pack8(v0, v1); }
        LDS_WAIT();
#pragma unroll
        for (int dt = 0; dt < 2; ++dt)
#pragma unroll
            for (int vt = 0; vt < 2; ++vt) { f32x16 nn = zero16();
#pragma unroll
                for (int ks = 0; ks < 2; ++ks) nn = mma32(frag_tr(R2, LD64, 16 * ks, 32 * dt, lane), frag_tr(R1, LD64, 16 * ks, 32 * vt, lane), nn);
#pragma unroll
                for (int g = 0; g < 4; ++g) { const f32x4 pv = *(const LAS f32x4*)(R5 + 32 * dt + 8 * g + 4 * hh);
#pragma unroll
                    for (int x = 0; x < 4; ++x) nn[4 * g + x] *= pv[x]; }
                st_T_g<false>(Ng, 64, 32 * vt, 32 * dt, nn, lane); }
    } else {
        { f32x16 rh[2];
#pragma unroll
          for (int dt = 0; dt < 2; ++dt) { rh[dt] = zero16();
#pragma unroll
            for (int ks = 0; ks < 2; ++ks) rh[dt] = mma32(frag_tr(R0, LD64, 16 * ks, 32 * dt, lane), frag_rm(R4, LD32, 0, 16 * ks, lane), rh[dt]); }
          st_T(R1, LD64, 0, 0, rh[0], lane); st_T(R1, LD64, 0, 32, rh[1], lane); }
        { f32x16 gh = g2acc;
#pragma unroll
          for (int ks = 0; ks < 2; ++ks) gh = mma32(frag_tr(X1, LD32, 16 * ks, 0, lane), frag_rm(R4, LD32, 0, 16 * ks, lane), gh);
          LDS_WAIT();
          st_T(R3, LD32, 0, 0, gh, lane); }
        LDS_WAIT();
        if (S0) {
#pragma unroll
            for (int vt = 0; vt < 2; ++vt)
#pragma unroll
                for (int ks = 0; ks < 4; ++ks) yacc[vt] = mma32(frag_g(S0, 64, 32 * vt, 16 * ks, lane), frag_rm(R1, LD64, 0, 16 * ks, lane), yacc[vt]); }
        LDS_WAIT();
#pragma unroll
        for (int p = 0; p < 4; ++p) { const int t = 8 * p + tl; f32x4 v0, v1; ld_shift8(ur + (size_t)t * UW + h * 64 + c0 + 512, (n * CH + t) > 0, mu + 512 + h * 64 + c0, v0, v1); *(LAS u32x4*)(R0 + t * LD64 + c0 * 2) = pack8(v0, v1); }
#pragma unroll
        for (int i = 0; i < 8; ++i) { const int idx = lane + 64 * i, t = idx >> 4, ch = idx & 15, col = 896 + ch * 8;
            f32x4 lo, hi; ld_shift8(ur + (size_t)t * UW + col, (n * CH + t) > 0, mu + col, lo, hi);
#pragma unroll
            for (int j = 0; j < 4; ++j) { lo[j] = fsigmoid(lo[j]); hi[j] = fsigmoid(hi[j]); }
            *(LAS u32x4*)(R1 + t * LDLW + ch * 16) = pack8(lo, hi); }
        LDS_WAIT();
        f32x16 gacc[2];
#pragma unroll
        for (int vt = 0; vt < 2; ++vt) {
#pragma unroll
            for (int ks = 0; ks < 2; ++ks) yacc[vt] = mma32(frag_tr(R0, LD64, 16 * ks, 32 * vt, lane), frag_rm(R3, LD32, 0, 16 * ks, lane), yacc[vt]);
            gacc[vt] = zero16();
#pragma unroll
            for (int ks = 0; ks < 8; ++ks) gacc[vt] = mma32(frag_g(upT + 2 * 256 * 64 + (size_t)(h * 64 + 32 * vt) * 128, 128, 0, 16 * ks, lane), frag_rm(R1, LDLW, 0, 16 * ks, lane), gacc[vt]); }
        float sm = 0.f;
#pragma unroll
        for (int vt = 0; vt < 2; ++vt)
#pragma unroll
            for (int i = 0; i < 16; ++i) sm += yacc[vt][i];
        sm += __shfl_xor(sm, 32);
        const float mean = sm * (1.0f / 64.0f); float sv = 0.f;
#pragma unroll
        for (int vt = 0; vt < 2; ++vt)
#pragma unroll
            for (int i = 0; i < 16; ++i) { const float dl = yacc[vt][i] - mean; sv += dl * dl; }
        sv += __shfl_xor(sv, 32);
        const float rstd = __builtin_amdgcn_rsqf(sv * (1.0f / 64.0f) + 64e-5f);
        const float bon = R5[r32];
        const float* ng = F.in[I_RW_G] + L * 256 + h * 64; const float* nb = F.in[I_RW_B] + L * 256 + h * 64;
#pragma unroll
        for (int vt = 0; vt < 2; ++vt) {
#pragma unroll
            for (int g = 0; g < 4; ++g) { const int v0i = 32 * vt + 8 * g + 4 * hh;
                const u32x2 vw = *(const LAS u32x2*)(R0 + r32 * LD64 + v0i * 2); const f32x4 gg = *(const f32x4*)(ng + v0i), bb = *(const f32x4*)(nb + v0i);
                const float vv[4] = {bflo(vw.x), bfhi(vw.x), bflo(vw.y), bfhi(vw.y)};
#pragma unroll
                for (int x = 0; x < 4; ++x) yacc[vt][4 * g + x] = ((yacc[vt][4 * g + x] - mean) * rstd * gg[x] + bb[x] + bon * vv[x]) * gacc[vt][4 * g + x]; }
            st_T_g<false>(bo + row0 * 1024 + 768 + h * 64, 1024, 0, 32 * vt, yacc[vt], lane); }
    }
    LDS_WAIT();
}
constexpr int RW_SLOT = 12288, RW_D = 3;
__device__ __forceinline__ void rwkv_scan_task(Frame& F, int bh, int vh) {
    const int lane = F.lane, r32 = lane & 31, hh = lane >> 5;
    const char* Mb = (const char*)(F.ws + WS_RWM) + (size_t)bh * NCH * 8192; const char* Nb = (const char*)(F.ws + WS_RWN) + (size_t)bh * NCH * 8192 + (size_t)vh * 32 * 128;
    LAS unsigned char* ring = F.lds;
    const int irow = lane >> 3, icg = (lane & 7) ^ (irow & 7);
#define RW_ISSUE(nn) do { const int _n = (nn) < NCH ? (nn) : NCH - 1; LAS unsigned char* _sl = ring + (_n & 7) * RW_SLOT; const char* _m = Mb + (size_t)_n * 8192 + irow * 128 + icg * 16; const char* _q = Nb + (size_t)_n * 8192 + irow * 128 + icg * 16; \
        _Pragma("unroll") for (int q = 0; q < 8; ++q) __builtin_amdgcn_global_load_lds((const unsigned*)(_m + q * 1024), (LAS unsigned*)(_sl + q * 1024), 16, 0, 0); \
        _Pragma("unroll") for (int q = 0; q < 4; ++q) __builtin_amdgcn_global_load_lds((const unsigned*)(_q + q * 1024), (LAS unsigned*)(_sl + 8192 + q * 1024), 16, 0, 0); } while (0)
    f32x16 st[2] = {zero16(), zero16()};
#pragma unroll
    for (int k = 0; k < RW_D; ++k) RW_ISSUE(k);
    asm volatile("s_waitcnt vmcnt(0)" ::: "memory");
    const int sw = r32 & 7;
    for (int n = 0; n < NCH; ++n) {
        RW_ISSUE(n + RW_D);
        asm volatile("s_waitcnt vmcnt(48)" ::: "memory");
        const LAS unsigned char* sl = ring + (n & 7) * RW_SLOT;
        bf16x8 bfr[2][2];
#pragma unroll
        for (int dt = 0; dt < 2; ++dt)
#pragma unroll
            for (int s2 = 0; s2 < 2; ++s2) { union { bf16x8 v; unsigned w[4]; } pf;
#pragma unroll
                for (int j = 0; j < 4; ++j) pf.w[j] = cvt_pk_bf16(st[dt][8 * s2 + 2 * j], st[dt][8 * s2 + 2 * j + 1]);
                bfr[dt][s2] = pf.v; }
        f32x16 nw[2];
#pragma unroll
        for (int d1t = 0; d1t < 2; ++d1t) {
#pragma unroll
            for (int g = 0; g < 4; ++g) { const u32x2 w = *(const LAS u32x2*)(sl + 8192 + r32 * 128 + (((4 * d1t + g) ^ sw) * 16) + hh * 8);
                nw[d1t][4 * g] = bflo(w.x); nw[d1t][4 * g + 1] = bfhi(w.x); nw[d1t][4 * g + 2] = bflo(w.y); nw[d1t][4 * g + 3] = bfhi(w.y); }
#pragma unroll
            for (int dt = 0; dt < 2; ++dt)
#pragma unroll
                for (int s2 = 0; s2 < 2; ++s2) { const int cg = 4 * dt + 2 * s2; union { bf16x8 v; u32x2 d[2]; } mf;
                    mf.d[0] = *(const LAS u32x2*)(sl + (32 * d1t + r32) * 128 + ((cg ^ sw) * 16) + hh * 8); mf.d[1] = *(const LAS u32x2*)(sl + (32 * d1t + r32) * 128 + (((cg + 1) ^ sw) * 16) + hh * 8);
                    nw[d1t] = mma32(mf.v, bfr[dt][s2], nw[d1t]); } }
#pragma unroll
        for (int d1t = 0; d1t < 2; ++d1t) { st[d1t] = nw[d1t];
            st_T_g<false>((bf16*)((unsigned char*)F.out + DO_RWS) + ((size_t)bh * NCH + n) * 4096, 64, vh * 32, 32 * d1t, nw[d1t], lane); }
    }
    asm volatile("s_waitcnt vmcnt(0)" ::: "memory");
#undef RW_ISSUE
}

constexpr int NS_KROW = 144, NS_VROW = 144;
constexpr int NS_KB = 64 * NS_KROW, NS_VB = 64 * NS_VROW;
constexpr int NS_K0 = 0, NS_V0 = 2 * NS_KB, NS_IMP = NS_V0 + 2 * NS_VB, NS_SEL = NS_IMP + 64 * 128 * 4, NS_END = NS_SEL + 64 * 4 * 4;
constexpr int NS_OUT = NS_END, NS_END2 = NS_OUT + 8 * 8192;
static_assert(NS_END2 <= MISC_OFF, "nsa lds");
struct NsaRow { float m, l; f32x16 o[2]; };
__device__ __forceinline__ void ns_load(const bf16* kb, const bf16* vb, size_t stride, int tid, u32x4& kr, u32x4& vr) {
    const int key = tid >> 3, ch = tid & 7; kr = *(const u32x4*)(kb + (size_t)key * stride + ch * 8); vr = *(const u32x4*)(vb + (size_t)key * stride + ch * 8);
}
__device__ __forceinline__ void ns_store(LAS unsigned char* Kb, LAS unsigned char* Vb, int tid, const u32x4& kr, const u32x4& vr) {
    const int key = tid >> 3, ch = tid & 7;
    *(LAS u32x4*)(Kb + key * NS_KROW + ch * 16) = kr;
    *(LAS u32x4*)(Vb + key * NS_VROW + ch * 16) = vr;
}
__device__ __forceinline__ void ns_qk(LAS unsigned char* Kb, const bf16x8 (&qf)[4], int r, int h2, f32x16 (&sacc)[2]) {
#pragma unroll
    for (int sub = 0; sub < 2; ++sub) { f32x16 a;
#pragma unroll
        for (int i = 0; i < 16; ++i) a[i] = 0.f;
#pragma unroll
        for (int kk = 0; kk < 4; ++kk) { const bf16x8 kf = *(const LAS bf16x8*)(Kb + (32 * sub + r) * NS_KROW + (8 * h2 + 16 * kk) * 2); a = __builtin_amdgcn_mfma_f32_32x32x16_bf16(kf, qf[kk], a, 0, 0, 0); }
        sacc[sub] = a; }
}
enum { NS_CMP = 0, NS_SEL_ = 1, NS_WIN = 2 };
template <int MODE> __device__ __forceinline__ bool ns_valid(int key, int t, bool blk_on) {
    if (MODE == NS_CMP) return 16 * key + 31 <= t;
    if (MODE == NS_SEL_) return blk_on && key <= t;
    return key <= t && key + 511 >= t;
}
template <int MODE>
__device__ __forceinline__ void ns_branch(Frame& F, const bf16* kbase, const bf16* vbase, size_t stride, int tile_lo, int tile_hi, const bf16x8 (&qf)[4], int t, int r, int h2,
                                          const unsigned (&selw)[4], NsaRow& R) {
    LAS unsigned char* L = F.lds;
    R.m = -1e30f; R.l = 0.f;
#pragma unroll
    for (int e = 0; e < 2; ++e)
#pragma unroll
        for (int i = 0; i < 16; ++i) R.o[e][i] = 0.f;
    if (tile_hi <= tile_lo) return;
    u32x4 kr, vr;
    ns_load(kbase + (size_t)tile_lo * 64 * stride, vbase + (size_t)tile_lo * 64 * stride, stride, F.tid, kr, vr);
    __syncthreads();
    ns_store(L + NS_K0, L + NS_V0, F.tid, kr, vr);
    __syncthreads();
    for (int ti = tile_lo; ti < tile_hi; ++ti) {
        const int buf = (ti - tile_lo) & 1;
        if (ti + 1 < tile_hi) ns_load(kbase + (size_t)(ti + 1) * 64 * stride, vbase + (size_t)(ti + 1) * 64 * stride, stride, F.tid, kr, vr);
        LAS unsigned char* Kb = L + NS_K0 + buf * NS_KB; LAS unsigned char* Vb = L + NS_V0 + buf * NS_VB;
        bool blk_on = true;
        if (MODE == NS_SEL_) blk_on = (selw[ti >> 5] >> (ti & 31)) & 1u;
        bool any;
        if (MODE == NS_CMP) any = 16 * (ti * 64) + 31 <= t; else if (MODE == NS_SEL_) any = blk_on && ti * 64 <= t; else any = (ti * 64 <= t) && (ti * 64 + 63 + 511 >= t);
        if (__ballot(any) != 0ull) {
            f32x16 sacc[2];
            ns_qk(Kb, qf, r, h2, sacc);
            bool full;
            { const int tmin = t - (r & 7), tmax = tmin + 7;
              if (MODE == NS_CMP) full = 16 * (ti * 64 + 63) + 31 <= tmin; else if (MODE == NS_SEL_) full = ti * 64 + 63 <= tmin; else full = (ti * 64 + 63 <= tmin) && (ti * 64 + 511 >= tmax); }
            float sc, rs = 0.f;
            if (full) {
                const bool rowon = (MODE != NS_SEL_) || blk_on;
                float m0 = sacc[0][0], m1 = sacc[1][0];
#pragma unroll
                for (int i = 1; i < 16; ++i) { m0 = fmaxf(m0, sacc[0][i]); m1 = fmaxf(m1, sacc[1][i]); }
                float mt = rowon ? fmaxf(m0, m1) : -1e30f;
                mt = fmaxf(mt, __shfl_xor(mt, 32));
                const float mn = fmaxf(R.m, mt); sc = __expf(R.m - mn);
                const float nb = -1.44269504f * (rowon ? mn : 1e30f);
#pragma unroll
                for (int sub = 0; sub < 2; ++sub)
#pragma unroll
                    for (int i = 0; i < 16; ++i) { const float p = __builtin_amdgcn_exp2f(__builtin_fmaf(sacc[sub][i], 1.44269504f, nb)); sacc[sub][i] = p; rs += p; }
                rs += __shfl_xor(rs, 32);
                R.l = R.l * sc + rs; R.m = mn;
            } else {
            float mt = -1e30f;
#pragma unroll
            for (int sub = 0; sub < 2; ++sub)
#pragma unroll
                for (int i = 0; i < 16; ++i) { const int key = ti * 64 + 32 * sub + (i & 3) + 8 * (i >> 2) + 4 * h2; const float sv = ns_valid<MODE>(key, t, blk_on) ? sacc[sub][i] : -1e30f; sacc[sub][i] = sv; mt = fmaxf(mt, sv); }
            mt = fmaxf(mt, __shfl_xor(mt, 32));
            const float mn = fmaxf(R.m, mt); sc = __expf(R.m - mn);
#pragma unroll
            for (int sub = 0; sub < 2; ++sub)
#pragma unroll
                for (int i = 0; i < 16; ++i) { const float sv = sacc[sub][i]; const float p = sv > -1e29f ? __expf(sv - mn) : 0.f; sacc[sub][i] = p; rs += p; }
            rs += __shfl_xor(rs, 32);
            R.l = R.l * sc + rs; R.m = mn;
            }
            if (__ballot(sc != 1.0f) != 0ull) {
#pragma unroll
                for (int e = 0; e < 2; ++e)
#pragma unroll
                    for (int i = 0; i < 16; ++i) R.o[e][i] *= sc; }
#pragma unroll
            for (int sub = 0; sub < 2; ++sub)
#pragma unroll
                for (int s2 = 0; s2 < 2; ++s2) {
                    union { bf16x8 v; unsigned w[4]; } pf;
#pragma unroll
                    for (int j = 0; j < 4; ++j) pf.w[j] = cvt_pk_bf16(sacc[sub][8 * s2 + 2 * j], sacc[sub][8 * s2 + 2 * j + 1]);
#pragma unroll
                    for (int e = 0; e < 2; ++e) {
                        const LAS unsigned char* vp = Vb + (32 * sub + 16 * s2 + 4 * h2 + ((F.lane & 15) >> 2)) * NS_VROW + (32 * e + 16 * ((F.lane >> 4) & 1) + 4 * (F.lane & 3)) * 2;
                        const s16x4 va = __builtin_amdgcn_ds_read_tr16_b64_v4i16((LAS s16x4*)vp), vb = __builtin_amdgcn_ds_read_tr16_b64_v4i16((LAS s16x4*)(vp + 8 * NS_VROW));
                        const bf16x8 vf = {va[0], va[1], va[2], va[3], vb[0], vb[1], vb[2], vb[3]};
                        R.o[e] = __builtin_amdgcn_mfma_f32_32x32x16_bf16(vf, pf.v, R.o[e], 0, 0, 0);
                    }
                }
        }
        if (ti + 1 < tile_hi) ns_store(L + NS_K0 + (buf ^ 1) * NS_KB, L + NS_V0 + (buf ^ 1) * NS_VB, F.tid, kr, vr);
        __syncthreads();
    }
}
__device__ __forceinline__ void ns_importance(Frame& F, const bf16* kbase, int ntiles, const bf16x8 (&qf)[4], int t, int r, int h2, float m, float inv_l) {
    LAS unsigned char* L = F.lds; LAS float* imp = (LAS float*)(L + NS_IMP);
    const int qrow = F.wave * 8 + (r & 7);
    u32x4 kr, vr;
    ns_load(kbase, kbase, 64, F.tid, kr, vr);
    __syncthreads();
    ns_store(L + NS_K0, L + NS_V0, F.tid, kr, vr);
    __syncthreads();
    for (int ti = 0; ti < ntiles; ++ti) {
        const int buf = ti & 1;
        if (ti + 1 < ntiles) ns_load(kbase + (size_t)(ti + 1) * 64 * 64, kbase + (size_t)(ti + 1) * 64 * 64, 64, F.tid, kr, vr);
        LAS unsigned char* Kb = L + NS_K0 + buf * NS_KB;
        f32x16 sacc[2];
        ns_qk(Kb, qf, r, h2, sacc);
#pragma unroll
        for (int sub = 0; sub < 2; ++sub)
#pragma unroll
            for (int g = 0; g < 4; ++g) {
                float p[4];
#pragma unroll
                for (int x = 0; x < 4; ++x) { const int key = ti * 64 + 32 * sub + x + 8 * g + 4 * h2; p[x] = (16 * key + 31 <= t) ? __expf(sacc[sub][4 * g + x] - m) * inv_l : 0.f; }
                float G = (p[0] + p[1]) + (p[2] + p[3]), E = p[3];
                G += __shfl_xor(G, 8); G += __shfl_xor(G, 16); E += __shfl_xor(E, 8); E += __shfl_xor(E, 16);
                const int jj = ti * 16 + 8 * sub + 2 * g + h2;
                if (r < 8) { atomicAdd((float*)(imp + qrow * 128 + jj), G); if (jj + 1 < 128) atomicAdd((float*)(imp + qrow * 128 + jj + 1), E); }
            }
        if (ti + 1 < ntiles) ns_store(L + NS_K0 + (buf ^ 1) * NS_KB, L + NS_V0 + (buf ^ 1) * NS_VB, F.tid, kr, vr);
        __syncthreads();
    }
}
__device__ __forceinline__ void nsa_unit(Frame& F0, int b, int c) {
    Frame F = F0; asm volatile("" : "+v"(F.tid)); F.lane = F.tid & 63;
    const bf16* u = (const bf16*)(F.ws + WS_U); bf16* bo = (bf16*)(F.ws + WS_BO);
    const bf16* kcmp = (const bf16*)(F.ws + WS_KCMP) + (size_t)b * 512 * 64; const bf16* vcmp = (const bf16*)(F.ws + WS_VCMP) + (size_t)b * 512 * 64;
    LAS unsigned char* L = F.lds; LAS float* imp = (LAS float*)(L + NS_IMP); LAS unsigned* selL = (LAS unsigned*)(L + NS_SEL);
    int lane = F.lane; asm volatile("" : "+v"(lane));
    const int r = lane & 31, h2 = lane >> 5, head = r >> 3, ql = r & 7;
    const int t = 64 * c + 8 * F.wave + ql; const size_t row = (size_t)b * S + t;
    const bf16* ub = u + (size_t)b * S * UW;
    bf16x8 qf[4];
#pragma unroll
    for (int kk = 0; kk < 4; ++kk) { const u32x4 w = *(const u32x4*)(u + row * UW + U_NSA + head * 64 + 8 * h2 + 16 * kk); f32x4 a, bb; unpack8(w, a, bb);
        union { bf16x8 v; u32x4 q; } cv; cv.q = pack8(a * 0.125f, bb * 0.125f); qf[kk] = cv.v; }
    const float g_cmp = fsigmoid(ldu(u, row, U_NSA + 640 + head)), g_sel = fsigmoid(ldu(u, row, U_NSA + 644 + head)), g_win = fsigmoid(ldu(u, row, U_NSA + 648 + head));
    unsigned selw[4] = {0xffffffffu, 0xffffffffu, 0xffffffffu, 0xffffffffu};
    NsaRow R;
    const int ncmp_tiles = (4 * c + 3 + 63) >> 6;
    ns_branch<NS_CMP>(F, kcmp, vcmp, 64, 0, ncmp_tiles, qf, t, r, h2, selw, R);
    LAS f32x4* stash = (LAS f32x4*)(L + NS_OUT + F.wave * 8192) + lane;
    { const float inv = R.l > 0.f ? 1.0f / R.l : 0.f; const float gs = g_cmp * inv;
#pragma unroll
      for (int e = 0; e < 2; ++e)
#pragma unroll
        for (int g = 0; g < 4; ++g) stash[(e * 4 + g) * 64] = (f32x4){R.o[e][4 * g] * gs, R.o[e][4 * g + 1] * gs, R.o[e][4 * g + 2] * gs, R.o[e][4 * g + 3] * gs};
      if (c >= 15) {
        for (int i = F.tid; i < 64 * 128; i += NTHR) imp[i] = 0.f;
        __syncthreads();
        ns_importance(F, kcmp, ncmp_tiles, qf, t, r, h2, R.m, inv);
        for (int q8 = 0; q8 < 8; ++q8) { const int qrow = F.wave * 8 + q8;
            float sc0, sc1;
            { const int j0 = lane, j1 = lane + 64;
              const bool f0 = (j0 == 0) || (j0 == c) || (j0 == c - 1), f1 = (j1 == c) || (j1 == c - 1);
              sc0 = f0 ? 1e30f : (j0 <= c ? imp[qrow * 128 + j0] : -1e30f); sc1 = f1 ? 1e30f : (j1 <= c ? imp[qrow * 128 + j1] : -1e30f); }
            unsigned long long lo = 0ull, hi = 0ull;
            for (int it = 0; it < 16; ++it) {
                const float best = wave_max(fmaxf(sc0, sc1));
                const unsigned long long m0 = __ballot(sc0 == best), m1 = __ballot(sc1 == best);
                int idx; if (m0) idx = __builtin_ctzll(m0); else idx = 64 + __builtin_ctzll(m1);
                if (idx < 64) { lo |= 1ull << idx; if (lane == idx) sc0 = -3e38f; } else { hi |= 1ull << (idx - 64); if (lane == idx - 64) sc1 = -3e38f; }
            }
            if (lane == 0) { selL[qrow * 4 + 0] = (unsigned)lo; selL[qrow * 4 + 1] = (unsigned)(lo >> 32); selL[qrow * 4 + 2] = (unsigned)hi; selL[qrow * 4 + 3] = (unsigned)(hi >> 32); }
        }
        LDS_WAIT();
#pragma unroll
        for (int j = 0; j < 4; ++j) selw[j] = selL[(F.wave * 8 + ql) * 4 + j];
      }
    }
    ns_branch<NS_SEL_>(F, ub + U_NSA + 384, ub + U_NSA + 448, UW, 0, c + 1, qf, t, r, h2, selw, R);
    { const float gs = g_sel / R.l;
#pragma unroll
      for (int e = 0; e < 2; ++e)
#pragma unroll
        for (int g = 0; g < 4; ++g) { f32x4 a = stash[(e * 4 + g) * 64]; a += (f32x4){R.o[e][4 * g] * gs, R.o[e][4 * g + 1] * gs, R.o[e][4 * g + 2] * gs, R.o[e][4 * g + 3] * gs}; stash[(e * 4 + g) * 64] = a; } }
    ns_branch<NS_WIN>(F, ub + U_NSA + 512, ub + U_NSA + 576, UW, c >= 8 ? c - 8 : 0, c + 1, qf, t, r, h2, selw, R);
    f32x16 out[2];
    { const float gs = g_win / R.l;
#pragma unroll
      for (int e = 0; e < 2; ++e)
#pragma unroll
        for (int g = 0; g < 4; ++g) { const f32x4 a = stash[(e * 4 + g) * 64];
#pragma unroll
            for (int x = 0; x < 4; ++x) out[e][4 * g + x] = a[x] + R.o[e][4 * g + x] * gs; } }
#pragma unroll
    for (int e = 0; e < 2; ++e) st_T_row(bo + row * 1024 + head * 64, 32 * e, out[e], lane);
}

__device__ __forceinline__ void cmp2_item(Frame& F, int L, int item) {
    int lane = F.lane; asm volatile("" : "+v"(lane));
    const int kv = item & 1, it = (item >> 1) & 15, b = item >> 5, r32 = lane & 31, hh = lane >> 5;
    const bf16* w2T = (const bf16*)(F.ws + WS_CW2 + (size_t)L * 65536) + kv * 64 * 128;
    const bf16* hid = (const bf16*)(F.ws + WS_CMPH) + ((size_t)(b * 512 + 32 * it)) * 256 + kv * 128;
    bf16* outp = (bf16*)(F.ws + (kv ? WS_VCMP : WS_KCMP)) + ((size_t)(b * 512 + 32 * it + r32)) * 64;
    const bool live = (32 * it + r32) < NCMP;
#pragma unroll
    for (int et = 0; et < 2; ++et) { f32x16 acc = zero16();
#pragma unroll
        for (int ks = 0; ks < 8; ++ks) acc = mma32(frag_g(w2T, 128, 32 * et, 16 * ks, lane), frag_g(hid, 256, 0, 16 * ks, lane), acc);
#pragma unroll
        for (int g = 0; g < 4; ++g) { u32x2 w; w.x = live ? cvt_pk_bf16(acc[4 * g], acc[4 * g + 1]) : 0u; w.y = live ? cvt_pk_bf16(acc[4 * g + 2], acc[4 * g + 3]) : 0u;
            *(u32x2*)(outp + 32 * et + 8 * g + 4 * hh) = w; } }
}
#ifdef SK_RWM1
#define RWM1(x)
#else
#define RWM1(x) x
#endif
#ifdef SK_RWM3
#define RWM3(x)
#else
#define RWM3(x) x
#endif
#ifdef SK_RWSC
#define RWSC(x)
#else
#define RWSC(x) x
#endif
__device__ __forceinline__ void phase_m1(Frame& F0, int L, bf16* hgS, bf16* rtS) {
    Frame F = F0; asm volatile("" : "+v"(F.tid)); F.lane = F.tid & 63;
    if (F.bx < 32) { LAS float* c1l = (LAS float*)(F.lds + RSTD_OFF + 1024);
      if (F.tid < 256) { const float* cp = (const float*)(F.ws + WS_CW2 + (size_t)L * 65536 + 32768) + (F.tid >> 7) * 32 * 128 + (F.tid & 127); float a = 0.f;
          for (int jq = 0; jq < 32; ++jq) a += cp[jq * 128];
          c1l[F.tid] = a; }
      __syncthreads(); }
    { CmpSched Sd{(const char*)(F.ws + WS_U), (const char*)(F.ws + WS_CW1 + (size_t)L * MiB), F.bx};
      EpiCmp E{(bf16*)(F.ws + WS_CMPH)};
      pg8::gemm_phase<EpiCmp, CmpSched, true>(F.lds + RING_OFF, Sd, E, (unsigned)(UW * 2), 128u); }
    LAS unsigned char* W = F.lds + F.wave * WREG;
    const int gw = F.bx * NWAVES + F.wave, NGW = F.G * NWAVES;
    for (int it = gw; it < 3 * 32 * NCH; it += NGW) { const int type = it % 3, q = it / 3, bh = q / NCH, n = q % NCH;
        if (type == 0) hgrn_chunk<false>(F, L, bh, n, W, hgS, (float*)(F.ws + WS_HGD)); else if (type == 1) ret_chunk<false>(F, L, bh, n, W, rtS); else { RWM1(rwkv_chunk<false>(F, L, bh, n, W)); } }
}
__device__ __forceinline__ void phase_scan(Frame& F0, int L, bf16* hgS, bf16* rtS) {
    Frame F = F0; asm volatile("" : "+v"(F.tid)); F.lane = F.tid & 63;
    if (F.tid < 256) {
        if (F.bx < 64) glin_scan_task(hgS, (bf16*)((unsigned char*)F.out + DO_HGS), (const float*)(F.ws + WS_HGD), 0.f, F.bx >> 1, F.bx & 1, F.tid);
        else if (F.bx < 128) { const int k = F.bx - 64, h = (k >> 1) & 3; const float g = 1.0f - exp2f(-5.0f - (float)h); glin_scan_task(rtS, (bf16*)((unsigned char*)F.out + DO_RTS), nullptr, exp2f(32.0f * __log2f(g)), k >> 1, k & 1, F.tid); }
    } else if (F.wave == 4) { if (F.bx < 64) { RWSC(rwkv_scan_task(F, F.bx >> 1, F.bx & 1)); } }
    else { for (int item = F.bx * 3 + (F.wave - 5); item < 256; item += F.G * 3) cmp2_item(F, L, item); }
}
__device__ __forceinline__ void phase_m3(Frame& F0, int L, bf16* hgS, bf16* rtS) {
    Frame F = F0; asm volatile("" : "+v"(F.tid)); F.lane = F.tid & 63;
    LAS unsigned char* W = F.lds + F.wave * WREG;
    const int gw = F.bx * NWAVES + F.wave, NGW = F.G * NWAVES;
    for (int it = gw; it < REP_ITEMS * 3 * 32 * NCH; it += NGW) { const int type = it % 3, q = (it / 3) % (32 * NCH), bh = q / NCH, n = q % NCH;
        if (type == 0) hgrn_chunk<true>(F, L, bh, n, W, (bf16*)((unsigned char*)F.out + DO_HGS), nullptr); else if (type == 1) ret_chunk<true>(F, L, bh, n, W, (bf16*)((unsigned char*)F.out + DO_RTS)); else { RWM3(rwkv_chunk<true>(F, L, bh, n, W)); } }
    __syncthreads();
#ifndef SK_NSA
    for (int p = F.bx; p < REP_NSA * 512; p += F.G) { const int b = (p >> 6) & 7, cc = p & 63; nsa_unit(F, b, 127 - cc); nsa_unit(F, b, cc); }
#endif
}

__device__ __forceinline__ void phase_pconv(Frame& F0, int L) {
    Frame F = F0; asm volatile("" : "+v"(F.tid)); F.lane = F.tid & 63;
    const float* p = F.in[I_P] + (size_t)L * T * PLE; bf16* pbf = (bf16*)(F.ws + WS_PB);
    for (int r = F.bx * NWAVES + F.wave; r < T; r += F.G * NWAVES) { const f32x4 v = *((const f32x4*)(p + (size_t)r * PLE) + F.lane); u32x2 w; w.x = cvt_pk_bf16(v[0], v[1]); w.y = cvt_pk_bf16(v[2], v[3]); *((u32x2*)(pbf + (size_t)r * PLE) + F.lane) = w; }
}
__device__ __forceinline__ void phase_final(Frame& F0, const float* ssf, const bf16* hb) {
    Frame F = F0; asm volatile("" : "+v"(F.tid)); F.lane = F.tid & 63;
    const float* g = F.in[I_NORM_FINAL]; const int gw = F.bx * NWAVES + F.wave, NGW = F.G * NWAVES;
    for (int r = gw; r < T; r += NGW) { const float rs = __builtin_amdgcn_rsqf(ss_row(ssf, r) * (1.0f / D) + EPS); const u32x4* hr = (const u32x4*)(hb + (size_t)r * D) + F.lane; f32x4* orow = (f32x4*)(F.out + (size_t)r * D);
#pragma unroll
        for (int j = 0; j < 2; ++j) { f32x4 a, b; unpack8(hr[64 * j], a, b); const f32x4 g0 = *((const f32x4*)g + 2 * (F.lane + 64 * j)), g1 = *((const f32x4*)g + 2 * (F.lane + 64 * j) + 1);
            orow[2 * (F.lane + 64 * j)] = a * rs * g0; orow[2 * (F.lane + 64 * j) + 1] = b * rs * g1; } }
}

constexpr int PH_PER_LAYER = 9, N_PHASES = 1 + NL * PH_PER_LAYER + 1;
__global__ void __launch_bounds__(NTHR, 2) mega_fwd(Args args) {
    extern __shared__ __attribute__((aligned(16))) unsigned char lds_raw[];
    Frame F; F.lds = (LAS unsigned char*)lds_raw; F.tid = threadIdx.x; F.lane = F.tid & 63; F.wave = __builtin_amdgcn_readfirstlane(F.tid >> 6); F.G = gridDim.x; F.bx = blockIdx.x;
    F.in = args.in; F.out = args.out; F.ws = args.ws;
    volatile LAS unsigned* MISC = (volatile LAS unsigned*)(F.lds + MISC_OFF);
    if (F.tid < 32) MISC[F.tid] = 0u;
    __syncthreads();
    unsigned* ctl = (unsigned*)(F.ws + WS_CTL);
    XcdBarrier bar; bar.bar = ctl + CW_BAR; bar.x = 0; bar.st = nullptr;
    if (MK_N_LAUNCHES == 1) bar = xcd_barrier_post(ctl + CW_BAR, MISC + 8);
    const int lo = args.ph_lo, hi = args.ph_hi;
#define IN(k) (lo <= (k) && (k) < hi)
#define REPS(k) (((k) == REP_PHASE || (k) == REP_PHASE + 9) ? 2 : 1)
#define SEAM(k) do { if (IN(k) && IN((k) + 1)) xcd_barrier(bar); } while (0)
    float* ssb = F.out;
    LAS unsigned char* ring = F.lds + RING_OFF;

    #ifndef SK_PRO
    for (int rep = 0; rep < ((REP_PHASE == 0) ? 2 : 1); ++rep) if (IN(0)) { if (rep) xcd_barrier(bar); phase_prologue(F); }
#endif
    SEAM(0);

    for (int L = 0; L < NL; ++L) {
        asm volatile("" : "+v"(F.tid)); F.lane = F.tid & 63;
        const int pb = 1 + L * PH_PER_LAYER;
        unsigned char* wl = F.ws + WS_W + (size_t)L * WL_STRIDE;
        bf16* hb_cur = (bf16*)(F.ws + ((L & 1) ? WS_HBB : WS_HBA)); bf16* hb_oth = (bf16*)(F.ws + ((L & 1) ? WS_HBA : WS_HBB));
        const float* ss_mix = ssb + (size_t)(3 * L) * T * 16; float* ss_ffn = ssb + (size_t)(3 * L + 1) * T * 16; float* ss_ple = ssb + (size_t)(3 * L + 2) * T * 16; float* ss_next = (L == NL - 1) ? (float*)(F.ws + WS_SSF) : ssb + (size_t)(3 * L + 3) * T * 16;
#ifndef SK_G1
        for (int rep = 0; rep < REPS(pb + 0); ++rep) if (IN(pb + 0)) { PlainSched Sd{(const char*)hb_cur, (const char*)(wl + WL_IN), D * 2, D * 2, D / 64, T / 256, UW / 256, F.G, F.bx};
            EpiScaleBf16 E{(bf16*)(F.ws + WS_U), UW, ss_mix}; pg8::gemm_phase(ring, Sd, E); }
#endif
        SEAM(pb + 0);
        bf16* hgS = hb_oth; bf16* rtS = hb_oth + (size_t)32 * NCH * 4096;
        for (int rep = 0; rep < REPS(pb + 1); ++rep) if (IN(pb + 1)) { if (rep) xcd_barrier(bar); phase_m1(F, L, hgS, rtS); }
        SEAM(pb + 1);
#ifndef EXP_NOSCAN
        for (int rep = 0; rep < REPS(pb + 2); ++rep) if (IN(pb + 2)) { if (rep) xcd_barrier(bar); phase_scan(F, L, hgS, rtS); }
#endif
        SEAM(pb + 2);
        if (IN(pb + 3)) phase_m3(F, L, hgS, rtS);
        SEAM(pb + 3);
#ifndef SK_G2
        for (int rep = 0; rep < REPS(pb + 4); ++rep) if (IN(pb + 4)) { PairSched Sd{(const char*)hb_cur, (const char*)(wl + WL_G), D * 2, D * 2, D / 64, (size_t)D * D * 2,
                                        (const char*)(F.ws + WS_BO), (const char*)(wl + WL_B), 1024 * 2, MW * 2, MW / 64, (size_t)MW * 2, (size_t)D * MW * 2, 4, T / 256, D / 256, F.G, F.bx};
            u32x4* scr = (u32x4*)(F.ws + WS_SCR + (size_t)F.bx * 262144);
            EpiMerge E{scr, scr + 8192, (bf16*)(F.ws + WS_MERGED), ss_mix, F.in[I_BGATE] + (size_t)L * 4 * D, 4}; pg8::gemm_phase(ring, Sd, E); }
#endif
        SEAM(pb + 4);
#ifndef SK_G3
        if (IN(pb + 5)) phase_pconv(F, L);
        if (IN(pb + 5)) { PlainSched Sd{(const char*)(F.ws + WS_MERGED), (const char*)(wl + WL_OUT), D * 2, D * 2, D / 64, T / 256, D / 256, F.G, F.bx};
            EpiResidual E{(L == 0) ? F.in[I_X] : nullptr, hb_cur, ss_ffn}; pg8::gemm_phase(ring, Sd, E); }
#endif
        SEAM(pb + 5);
#ifndef SK_G4
        for (int rep = 0; rep < REPS(pb + 6); ++rep) if (IN(pb + 6)) { PlainSched Sd{(const char*)hb_cur, (const char*)(wl + WL_FF), D * 2, D * 2, D / 64, T / 256, (2 * DFF) / 256, F.G, F.bx};
            EpiSwiGLU E{(bf16*)(F.ws + WS_FFH), ss_ffn}; pg8::gemm_phase(ring, Sd, E); }
#endif
        SEAM(pb + 6);
#ifndef SK_G5
        if (IN(pb + 7)) { PlainSched Sd{(const char*)(F.ws + WS_FFH), (const char*)(wl + WL_DN), DFF * 2, DFF * 2, DFF / 64, T / 256, D / 256, F.G, F.bx};
            EpiResidual E{nullptr, hb_cur, ss_ple}; pg8::gemm_phase(ring, Sd, E); }
#endif
        SEAM(pb + 7);
#ifndef SK_G6
        if (IN(pb + 8)) { PairSched Sd{(const char*)hb_cur, (const char*)(wl + WL_PG), D * 2, D * 2, D / 64, 0,
                                        (const char*)(F.ws + WS_PB), (const char*)(wl + WL_PP), PLE * 2, PLE * 2, PLE / 64, 0, 0, 1, T / 256, D / 256, F.G, F.bx};
            u32x4* scr = (u32x4*)(F.ws + WS_SCR + (size_t)F.bx * 262144);
            EpiPle E{scr, hb_cur, hb_oth, ss_ple, ss_next}; pg8::gemm_phase(ring, Sd, E); }
#endif
        SEAM(pb + 8);
    }
#ifndef SK_FIN
    if (IN(N_PHASES - 1)) phase_final(F, (const float*)(F.ws + WS_SSF), (const bf16*)(F.ws + ((NL & 1) ? WS_HBB : WS_HBA)));
#endif
#undef IN
#undef SEAM
}

extern "C" void kernel_launch(void* const* d_in, const int* in_sizes, int n_in, void* d_out, int out_size, void* d_ws, size_t ws_size, hipStream_t stream) {
    static int grid = 0;
    if (grid == 0) {
        if (n_in != 37 || in_sizes[0] != T * D || out_size != T * D || ws_size < WS_END) { fprintf(stderr, "kernel_launch: unexpected shapes (n_in %d, ws %zu)\n", n_in, ws_size); grid = -1; return; }
        int dev = 0, cus = 0, per_cu = 0;
        if (hipGetDevice(&dev) != hipSuccess || hipDeviceGetAttribute(&cus, hipDeviceAttributeMultiprocessorCount, dev) != hipSuccess) { grid = -1; return; }
        if (hipFuncSetAttribute((const void*)mega_fwd, hipFuncAttributeMaxDynamicSharedMemorySize, LDS_BYTES) != hipSuccess) { fprintf(stderr, "kernel_launch: hipFuncSetAttribute failed\n"); grid = -1; return; }
        if (hipOccupancyMaxActiveBlocksPerMultiprocessor(&per_cu, (const void*)mega_fwd, NTHR, LDS_BYTES) != hipSuccess || per_cu < 1) { fprintf(stderr, "kernel_launch: occupancy query says %d\n", per_cu); }
        (void)hipGetLastError();
        grid = cus;
    }
    if (grid < 0) return;
    hipMemsetAsync((char*)d_ws + WS_CTL, 0, CTL_BYTES, stream);
    Args a{};
    for (int i = 0; i < 37; ++i) a.in[i] = (const float*)d_in[i];
    a.out = (float*)d_out; a.ws = (unsigned char*)d_ws;
    if (MK_N_LAUNCHES == 1) { a.ph_lo = 0; a.ph_hi = N_PHASES; hipLaunchKernelGGL(mega_fwd, dim3(grid), dim3(NTHR), LDS_BYTES, stream, a); }
    else for (int p = 0; p < N_PHASES; ++p) { a.ph_lo = p; a.ph_hi = p + 1; hipLaunchKernelGGL(mega_fwd, dim3(grid), dim3(NTHR), LDS_BYTES, stream, a); }
}
```

```cpp
#include <hip/hip_runtime.h>
#include <cstdio>
#include <cstdint>

#ifndef REP_ITEMS
#define REP_ITEMS 1
#endif
#ifndef REP_NSA
#define REP_NSA 1
#endif
#ifndef REP_PHASE
#define REP_PHASE (-1)
#ifndef NSA_CA
#define NSA_CA 95
#endif
#ifndef STAG_G2
#define STAG_G2 0
#endif
#endif
#ifndef MK_N_LAUNCHES
#define MK_N_LAUNCHES 1
#endif

#define LAS __attribute__((address_space(3)))
#define GAS __attribute__((address_space(1)))
typedef unsigned short bf16;
typedef short bf16x8 __attribute__((ext_vector_type(8)));
typedef float f32x4 __attribute__((ext_vector_type(4)));
typedef float f32x16 __attribute__((ext_vector_type(16)));
typedef unsigned u32x4 __attribute__((ext_vector_type(4)));
typedef unsigned u32x2 __attribute__((ext_vector_type(2)));
typedef short s16x4 __attribute__((ext_vector_type(4)));

constexpr int D = 1024, NB = 8, S = 8192, T = NB * S, NL = 2;
constexpr int NH = 4, HD = 64, MW = 256, DFF = 2816, PLE = 256;
constexpr int DIN = 3724, UW = 3840;
constexpr int U_NSA = 0, U_HG = 768, U_RT = 1792, U_RW = 2816;
constexpr int NCMP = 511, NSEL = 128;
constexpr float EPS = 1e-6f;

constexpr size_t MiB = 1u << 20;
constexpr size_t WS_CTL = 0, CTL_BYTES = 4 * MiB;
constexpr size_t WS_W = 4 * MiB;
constexpr size_t WL_IN = 0, WL_G = 8 * MiB, WL_B = 16 * MiB, WL_OUT = 18 * MiB, WL_FF = 20 * MiB, WL_DN = 31 * MiB, WL_PG = 37 * MiB, WL_PP = 39 * MiB, WL_STRIDE = 40 * MiB;
constexpr size_t WS_MISC = 84 * MiB;
constexpr size_t WS_ROPE = WS_MISC, WS_KCMP = WS_MISC + 2 * MiB, WS_VCMP = WS_MISC + 2 * MiB + 512 * 1024, WS_RWUP = WS_MISC + 3 * MiB;
constexpr size_t WS_HBA = 88 * MiB, WS_HBB = 216 * MiB;
constexpr size_t WS_BO = 344 * MiB;
constexpr size_t WS_U = 472 * MiB;
constexpr size_t WS_MERGED = WS_U, WS_SCR = WS_U + 416 * MiB;
constexpr size_t WS_FFH = WS_U;
constexpr size_t WS_PB = WS_U + 352 * MiB;
constexpr size_t WS_RWN = 952 * MiB;
constexpr size_t WS_HGD = 1016 * MiB;
constexpr size_t WS_RWM = WS_BO;
constexpr size_t WS_CMPH = 1018 * MiB;
constexpr size_t WS_CW1 = 1020 * MiB;
constexpr size_t WS_CW2 = 1022 * MiB;
constexpr size_t WS_SSF = 1016 * MiB;
constexpr size_t DO_T = 28 * MiB, DO_HGS = 44 * MiB, DO_RTS = 108 * MiB, DO_RWS = 172 * MiB;
constexpr size_t WS_END = 1024 * MiB;
constexpr int CH = 32, NCH = S / CH;
constexpr int CW_BAR = 4096;
constexpr int CW_NSA = 12288;
constexpr int CW_C1 = 16384;
constexpr int NSS = 7;

#define LDS_WAIT() asm volatile("s_waitcnt lgkmcnt(0)" ::: "memory")
#define VM_WAIT() asm volatile("s_waitcnt vmcnt(0)" ::: "memory")
typedef __bf16 hbf16x2 __attribute__((ext_vector_type(2)));
typedef float f32x2v __attribute__((ext_vector_type(2)));
__device__ __forceinline__ unsigned cvt_pk_bf16(float lo, float hi) { const f32x2v v = {lo, hi}; const hbf16x2 b = __builtin_convertvector(v, hbf16x2); return __builtin_bit_cast(unsigned, b); }
__device__ __forceinline__ float bf2f(unsigned short b) { return __builtin_bit_cast(float, ((unsigned)b) << 16); }
__device__ __forceinline__ float bflo(unsigned w) { return __builtin_bit_cast(float, w << 16); }
__device__ __forceinline__ float bfhi(unsigned w) { return __builtin_bit_cast(float, w & 0xffff0000u); }
__device__ __forceinline__ float fsigmoid(float z) { return __builtin_amdgcn_rcpf(1.0f + __builtin_amdgcn_exp2f(-1.44269504f * z)); }
__device__ __forceinline__ float fsilu(float z) { return z * fsigmoid(z); }
__device__ __forceinline__ float wave_sum(float v) {
#pragma unroll
    for (int o = 1; o < 64; o <<= 1) v += __shfl_xor(v, o);
    return v;
}
__device__ __forceinline__ float wave_max(float v) {
#pragma unroll
    for (int o = 1; o < 64; o <<= 1) v = fmaxf(v, __shfl_xor(v, o));
    return v;
}

#define XB_TMO      128
#define XB_XCNT(j)  (256  + 64 * (j))
#define XB_XSUB(j)  (1280 + 64 * (j))
#define XB_XGEN(j)  (2304 + 64 * (j))
#define XB_TOP      3328
#define XB_TOPGEN   3392
#define XCD_BAR_WORDS 3456
#define XB_SPIN_CAP (1u << 24)
__device__ __forceinline__ unsigned xb_ld(unsigned* p)              { return __hip_atomic_load(p, __ATOMIC_RELAXED, __HIP_MEMORY_SCOPE_AGENT); }
__device__ __forceinline__ unsigned xb_add(unsigned* p, unsigned v) { return __hip_atomic_fetch_add(p, v, __ATOMIC_RELAXED, __HIP_MEMORY_SCOPE_AGENT); }
__device__ __forceinline__ unsigned xb_xcc_id() { return (unsigned)__builtin_amdgcn_s_getreg((3 << 11) | 20) & 0xFu; }
#define XB_SPIN(cond, bar) do { unsigned _sp = 0; while (cond) { __builtin_amdgcn_s_sleep(1); \
    if ((++_sp & 255u) == 0u) { if (xb_ld(&(bar)[XB_TMO])) break; if (_sp > XB_SPIN_CAP) { atomicAdd(&(bar)[XB_TMO], 1u); break; } } } } while (0)
struct XcdBarrier { unsigned* bar; unsigned x; volatile LAS unsigned* st; };
__device__ __forceinline__ XcdBarrier xcd_barrier_post(unsigned* bar, volatile LAS unsigned* st) {
    XcdBarrier b; b.bar = bar; b.x = xb_xcc_id(); b.st = st;
    if (threadIdx.x == 0) (void)xb_add(&bar[XB_XCNT(b.x)], 1u);
    return b;
}
__device__ __forceinline__ void xcd_barrier_complete(unsigned* bar, unsigned x, unsigned& nloc, unsigned& nx) {
    const unsigned G = gridDim.x * gridDim.y * gridDim.z;
    unsigned sum, cnt, mine, sp = 0u;
    for (;;) {
        sum = 0u; cnt = 0u; mine = 0u;
#pragma unroll
        for (unsigned j = 0; j < 16; ++j) { const unsigned c = xb_ld(&bar[XB_XCNT(j)]); sum += c; cnt += (c > 0u) ? 1u : 0u; mine = (j == x) ? c : mine; }
        if (sum == G) break;
        __builtin_amdgcn_s_sleep(1);
        if ((++sp & 255u) == 0u) { if (xb_ld(&bar[XB_TMO])) break; if (sp > XB_SPIN_CAP) { atomicAdd(&bar[XB_TMO], 1u); break; } }
    }
    nloc = mine > 0u ? mine : 1u; nx = cnt > 0u ? cnt : 1u;
}
__device__ __forceinline__ void xcd_barrier(const XcdBarrier& b) {
    asm volatile("s_waitcnt vmcnt(0)" ::: "memory");
    __syncthreads();
    if (threadIdx.x == 0) {
        unsigned* bar = b.bar;
        __builtin_amdgcn_s_waitcnt(0);
        unsigned nloc = b.st[0], nx = b.st[1];
        if (nloc == 0u) { xcd_barrier_complete(bar, b.x, nloc, nx); b.st[0] = nloc; b.st[1] = nx; }
        const unsigned old = xb_add(&bar[XB_XSUB(b.x)], 1u);
        const unsigned gen = old / nloc;
        if (old + 1u == (gen + 1u) * nloc) {
            __builtin_amdgcn_fence(__ATOMIC_RELEASE, "agent");
            asm volatile("s_waitcnt vmcnt(0)" ::: "memory");
            const unsigned og = xb_add(&bar[XB_TOP], 1u);
            const unsigned tg = og / nx;
            if (og + 1u == (tg + 1u) * nx) xb_add(&bar[XB_TOPGEN], 1u);
            else XB_SPIN(xb_ld(&bar[XB_TOPGEN]) == tg, bar);
            __builtin_amdgcn_fence(__ATOMIC_ACQUIRE, "agent");
            xb_add(&bar[XB_XGEN(b.x)], 1u);
            asm volatile("s_waitcnt vmcnt(0)" ::: "memory");
        } else {
            XB_SPIN(xb_ld(&bar[XB_XGEN(b.x)]) == gen, bar);
            __builtin_amdgcn_fence(__ATOMIC_ACQUIRE, "agent");
            asm volatile("s_waitcnt vmcnt(0)" ::: "memory");
        }
    }
    __syncthreads();
}

namespace pg8 {
constexpr int BM = 256, BK = 64, HALF = 128, HTB = HALF * BK * 2, STAGE_BYTES = 8 * HTB, NXCD = 8, WGM = 8;
__host__ __device__ __forceinline__ int lds_byte(int r, int c) { const int st = (r >> 4) * 2 + (c >> 5), rr = r & 15, cc = c & 31, ob = rr * 64 + cc * 2; return st * 1024 + (ob ^ (((ob >> 9) & 1) << 5)); }
__host__ __device__ __forceinline__ void stage_rc(int b, int& R, int& C) { const int st = b / 1024, sb = b % 1024, swz = sb ^ (((sb >> 9) & 1) << 5); R = (st >> 1) * 16 + swz / 64; C = (st & 1) * 32 + (swz % 64) / 2; }
__host__ __device__ __forceinline__ int perm32(int rho) { const int n = rho >> 4, i = rho & 15; return 8 * (i >> 2) + 4 * n + (i & 3); }

struct GU { const char* A; const char* B; unsigned lda, ldb; int nt; int pm, pn, kind, mi; };

__device__ __forceinline__ bool tile_of(int L, int nM, int nN, int& pm, int& pn) {
    const int nwg = nM * nN; if (L >= nwg) return false;
    int wgid = L; { const int q = nwg / NXCD, r = nwg % NXCD, xcd = wgid % NXCD, off = wgid / NXCD; wgid = (xcd < r ? xcd * (q + 1) : r * (q + 1) + (xcd - r) * q) + off; }
    const int nig = WGM * nN, gid = wgid / nig, fm = gid * WGM, gsz = (nM - fm) < WGM ? (nM - fm) : WGM;
    pm = fm + ((wgid % nig) % gsz); pn = (wgid % nig) / gsz; return true;
}

template <class Epi, class Sched, bool AX = false>
__device__ __forceinline__ void gemm_phase(LAS unsigned char* lds, const Sched& S, const Epi& E, unsigned ax_kstep = 0, unsigned ax_half = 0) {
    int tid = threadIdx.x; asm volatile("" : "+v"(tid));
    const int wid = __builtin_amdgcn_readfirstlane(tid >> 6), lane = tid & 63, wr = wid >> 2, wc = wid & 3, fr = lane & 15, fq = lane >> 4;
    unsigned RA[2], RB[2], C2[2];
#pragma unroll
    for (int i = 0; i < 2; ++i) { int R, C; stage_rc(tid * 16 + i * 8192, R, C); RA[i] = (unsigned)R; RB[i] = (unsigned)((R & ~31) + perm32(R & 31)); C2[i] = (unsigned)C * 2u; }
    const size_t kstep = (size_t)(BK * 2);
    const size_t kstepA = AX ? (size_t)ax_kstep : kstep;
#define PG8_HSA(ld) (AX ? (size_t)ax_half : (size_t)HALF * (ld))
    const unsigned ldsw = (unsigned)wid * 1024u;
    const int aoff = lds_byte(wr * 64 + fr, fq * 8), boff = lds_byte(wc * 32 + fr, fq * 8);
#define PG8_SA(b, h) (((b) * 2 + (h)) * HTB)
#define PG8_SB(b, h) ((4 + (b) * 2 + (h)) * HTB)
#define PG8_STAGE(bufoff, gbase, ld, RR) do { _Pragma("unroll") for (int _i = 0; _i < 2; ++_i) \
        __builtin_amdgcn_global_load_lds((const unsigned*)((const char*)(gbase) + (RR[_i] * (ld) + C2[_i])), (LAS unsigned*)(lds + (bufoff) + ldsw + _i * 8192), 16, 0, 0); } while (0)
#define PG8_LDA(dst, b, h) do { _Pragma("unroll") for (int m = 0; m < 4; ++m) _Pragma("unroll") for (int k = 0; k < 2; ++k) dst[m][k] = *(const LAS bf16x8*)(lds + PG8_SA(b, h) + aoff + m * 2048 + k * 1024); } while (0)
#define PG8_LDB(dst, b, h) do { _Pragma("unroll") for (int n = 0; n < 2; ++n) _Pragma("unroll") for (int k = 0; k < 2; ++k) dst[n][k] = *(const LAS bf16x8*)(lds + PG8_SB(b, h) + boff + n * 2048 + k * 1024); } while (0)
#define PG8_MMA(ai, bj, At, Bt) do { __builtin_amdgcn_s_setprio(1); _Pragma("unroll") for (int m = 0; m < 4; ++m) _Pragma("unroll") for (int n = 0; n < 2; ++n) _Pragma("unroll") for (int k = 0; k < 2; ++k) \
        acc[ai][bj][m][n] = __builtin_amdgcn_mfma_f32_16x16x32_bf16(Bt[n][k], At[m][k], acc[ai][bj][m][n], 0, 0, 0); __builtin_amdgcn_s_setprio(0); } while (0)
#define PG8_WAIT_V(n) asm volatile("s_waitcnt vmcnt(" #n ")" ::: "memory")
#define PG8_WAIT_L(n) asm volatile("s_waitcnt lgkmcnt(" #n ")" ::: "memory")
#define PG8_BAR __builtin_amdgcn_s_barrier()
#define PG8_SCHED __builtin_amdgcn_sched_barrier(0)
    GU cur, nxt; int ui = 0;
    if (!S.next(0, cur)) return;
    f32x4 acc[2][2][4][2];
#pragma unroll
    for (int a = 0; a < 2; ++a)
#pragma unroll
        for (int b = 0; b < 2; ++b)
#pragma unroll
            for (int m = 0; m < 4; ++m)
#pragma unroll
                for (int n = 0; n < 2; ++n) acc[a][b][m][n] = (f32x4){0.f, 0.f, 0.f, 0.f};
    bf16x8 At[4][2], B0[2][2], B1[2][2];
    const char* cA = cur.A; const char* cB = cur.B; unsigned clda = cur.lda, cldb = cur.ldb;
    PG8_STAGE(PG8_SB(0, 0), cB, cldb, RB); PG8_STAGE(PG8_SB(0, 1), cB + (size_t)HALF * cldb, cldb, RB); PG8_STAGE(PG8_SA(0, 0), cA, clda, RA); PG8_STAGE(PG8_SA(0, 1), cA + PG8_HSA(clda), clda, RA);
    if (wr == 1) PG8_BAR;
    PG8_WAIT_V(2); PG8_BAR;
    PG8_STAGE(PG8_SB(1, 0), cB + kstep, cldb, RB); PG8_STAGE(PG8_SA(1, 0), cA + kstepA, clda, RA); PG8_STAGE(PG8_SB(1, 1), cB + (size_t)HALF * cldb + kstep, cldb, RB);
    PG8_WAIT_V(6); PG8_BAR;
    for (;;) {
        const bool has_next = S.next(ui + 1, nxt);
        const char* nA = has_next ? nxt.A : cA; const char* nB = has_next ? nxt.B : cB;
        const unsigned nlda = has_next ? nxt.lda : clda, nldb = has_next ? nxt.ldb : cldb;
        const int nt = cur.nt;
        for (int t = 0; t < nt; t += 2) {
            const bool last = (t == nt - 2);
            const char* a1 = cA + (size_t)(t + 1) * kstepA;
            const char* a2 = last ? nA : cA + (size_t)(t + 2) * kstepA; const char* b2 = last ? nB : cB + (size_t)(t + 2) * kstep;
            const unsigned lda2 = last ? nlda : clda, ldb2 = last ? nldb : cldb;
            const char* a3 = a2 + kstepA; const char* b3 = b2 + kstep;
            PG8_LDB(B0, 0, 0); PG8_LDB(B1, 0, 1); PG8_SCHED; PG8_LDA(At, 0, 0); PG8_STAGE(PG8_SA(1, 1), a1 + PG8_HSA(clda), clda, RA);
            PG8_WAIT_V(8); PG8_WAIT_L(0); PG8_BAR; PG8_MMA(0, 0, At, B0); PG8_MMA(0, 1, At, B1); PG8_BAR; PG8_SCHED;
            PG8_LDA(At, 0, 1); PG8_STAGE(PG8_SB(0, 0), b2, ldb2, RB); PG8_STAGE(PG8_SB(0, 1), b2 + (size_t)HALF * ldb2, ldb2, RB); PG8_STAGE(PG8_SA(0, 0), a2, lda2, RA);
            PG8_WAIT_V(8); PG8_WAIT_L(0); PG8_BAR; PG8_MMA(1, 0, At, B0); PG8_MMA(1, 1, At, B1); PG8_BAR; PG8_SCHED;
            PG8_LDB(B0, 1, 0); PG8_LDB(B1, 1, 1); PG8_SCHED; PG8_LDA(At, 1, 0); PG8_STAGE(PG8_SA(0, 1), a2 + PG8_HSA(lda2), lda2, RA);
            PG8_WAIT_V(8); PG8_WAIT_L(0); PG8_BAR; PG8_MMA(0, 0, At, B0); PG8_MMA(0, 1, At, B1); PG8_BAR; PG8_SCHED;
            PG8_LDA(At, 1, 1); PG8_STAGE(PG8_SB(1, 0), b3, ldb2, RB); PG8_STAGE(PG8_SB(1, 1), b3 + (size_t)HALF * ldb2, ldb2, RB); PG8_STAGE(PG8_SA(1, 0), a3, lda2, RA);
            PG8_WAIT_V(8); PG8_WAIT_L(0); PG8_BAR; PG8_MMA(1, 0, At, B0); PG8_MMA(1, 1, At, B1); PG8_BAR; PG8_SCHED;
        }
        if (wr == 0) PG8_BAR;
        E(acc, cur, wr, wc, fr, fq);
        if (!has_next) break;
#pragma unroll
        for (int a = 0; a < 2; ++a)
#pragma unroll
            for (int b = 0; b < 2; ++b)
#pragma unroll
                for (int m = 0; m < 4; ++m)
#pragma unroll
                    for (int n = 0; n < 2; ++n) acc[a][b][m][n] = (f32x4){0.f, 0.f, 0.f, 0.f};
        cur = nxt; cA = nA; cB = nB; clda = nlda; cldb = nldb; ++ui;
        if (wr == 1) PG8_BAR;
    }
    PG8_WAIT_V(0);
    PG8_BAR;
#undef PG8_SA
#undef PG8_HSA
#undef PG8_SB
#undef PG8_STAGE
#undef PG8_LDA
#undef PG8_LDB
#undef PG8_MMA
#undef PG8_WAIT_V
#undef PG8_WAIT_L
#undef PG8_BAR
#undef PG8_SCHED
}
}
using pg8::GU;

struct PlainSched {
    const char* A; const char* B; unsigned lda, ldb; int nt, nM, nN, G, c;
    __device__ __forceinline__ bool next(int i, GU& u) const {
        int pm, pn; if (!pg8::tile_of(i * G + c, nM, nN, pm, pn)) return false;
        u.A = A + (size_t)pm * 256 * lda; u.B = B + (size_t)pn * 256 * ldb; u.lda = lda; u.ldb = ldb; u.nt = nt; u.pm = pm; u.pn = pn; u.kind = 0; u.mi = 0; return true;
    }
};
struct PairSched {
    const char* A1; const char* B1; unsigned lda1, ldb1; int nt1; size_t b1_mstride;
    const char* A2; const char* B2; unsigned lda2, ldb2; int nt2; size_t a2_mstride, b2_mstride;
    int nm, nM, nN, G, c;
    __device__ __forceinline__ bool next(int i, GU& u) const {
        const int per = 2 * nm, ti = i / per, sub = i - ti * per, m = sub >> 1, kind = sub & 1;
        int pm, pn; if (!pg8::tile_of(ti * G + c, nM, nN, pm, pn)) return false;
        u.pm = pm; u.pn = pn; u.kind = kind; u.mi = m;
        if (kind == 0) { u.A = A2 + (size_t)m * a2_mstride + (size_t)pm * 256 * lda2; u.B = B2 + (size_t)m * b2_mstride + (size_t)pn * 256 * ldb2; u.lda = lda2; u.ldb = ldb2; u.nt = nt2; }
        else { u.A = A1 + (size_t)pm * 256 * lda1; u.B = B1 + (size_t)m * b1_mstride + (size_t)pn * 256 * ldb1; u.lda = lda1; u.ldb = ldb1; u.nt = nt1; }
        return true;
    }
};

constexpr int RSTD_OFF = 131072;
__device__ __forceinline__ float ss_row(const float* ssp, int row) {
    const f32x4* p = (const f32x4*)(ssp + (size_t)row * 16); const f32x4 a = p[0], b = p[1], c = p[2], d = p[3];
    return (((a[0] + a[1]) + (a[2] + a[3])) + ((b[0] + b[1]) + (b[2] + b[3]))) + (((c[0] + c[1]) + (c[2] + c[3])) + ((d[0] + d[1]) + (d[2] + d[3])));
}
__device__ __forceinline__ void rstd_table(const float* ssp, int pm) {
    extern __shared__ __attribute__((aligned(16))) unsigned char lds_tab_raw[];
    LAS float* tab = (LAS float*)((LAS unsigned char*)lds_tab_raw + RSTD_OFF);
    const int t = threadIdx.x; if (t < 256) tab[t] = __builtin_amdgcn_rsqf(ss_row(ssp, pm * 256 + t) * (1.0f / D) + EPS);
    asm volatile("s_waitcnt lgkmcnt(0)" ::: "memory"); __builtin_amdgcn_s_barrier(); asm volatile("" ::: "memory");
}
__device__ __forceinline__ float rstd_tab(int lr) { extern __shared__ __attribute__((aligned(16))) unsigned char lds_tab_raw[]; return ((const LAS float*)((LAS unsigned char*)lds_tab_raw + RSTD_OFF))[lr]; }
__device__ __forceinline__ u32x4 pack8(const f32x4& a, const f32x4& b) { u32x4 w; w.x = cvt_pk_bf16(a[0], a[1]); w.y = cvt_pk_bf16(a[2], a[3]); w.z = cvt_pk_bf16(b[0], b[1]); w.w = cvt_pk_bf16(b[2], b[3]); return w; }
__device__ __forceinline__ void unpack8(const u32x4& w, f32x4& a, f32x4& b) { a = (f32x4){bflo(w.x), bfhi(w.x), bflo(w.y), bfhi(w.y)}; b = (f32x4){bflo(w.z), bfhi(w.z), bflo(w.w), bfhi(w.w)}; }

struct CmpSched {
    const char* U; const char* B; int c;
    __device__ __forceinline__ bool next(int i, GU& u) const {
        if (i > 0 || c >= 32) return false;
        const int b = c >> 2, q = c & 3;
        u.A = U + ((size_t)(b * S + 2048 * q) * UW + U_NSA + 256) * 2; u.B = B; u.lda = 16 * UW * 2; u.ldb = 4096; u.nt = 32; u.pm = b; u.pn = q; u.kind = 0; u.mi = 0; return true;
    }
};
struct EpiCmp {
    bf16* H;
    __device__ __forceinline__ void operator()(const f32x4 (&acc)[2][2][4][2], const GU& u, int wr, int wc, int fr, int fq) const {
        const int col = wc * 32 + 8 * fq;
        extern __shared__ __attribute__((aligned(16))) unsigned char lds_c1_raw[]; const LAS float* c1 = (const LAS float*)((LAS unsigned char*)lds_c1_raw + RSTD_OFF + 1024);
#pragma unroll
        for (int kv = 0; kv < 2; ++kv) { const f32x4 b0 = *(const LAS f32x4*)(c1 + kv * 128 + col), b1 = *(const LAS f32x4*)(c1 + kv * 128 + col + 4);
#pragma unroll
            for (int m = 0; m < 4; ++m) { const int i = u.pn * 128 + wr * 64 + m * 16 + fr; f32x4 v0, v1;
#pragma unroll
                for (int j = 0; j < 4; ++j) { v0[j] = fsilu(acc[kv][kv][m][0][j] + b0[j]); v1[j] = fsilu(acc[kv][kv][m][1][j] + b1[j]); }
                *(u32x4*)(H + ((size_t)(u.pm * 512 + i)) * 256 + kv * 128 + col) = pack8(v0, v1); } }
    }
};
struct EpiScaleBf16 {
    bf16* O; int ldo; const float* ss;
    __device__ __forceinline__ void operator()(const f32x4 (&acc)[2][2][4][2], const GU& u, int wr, int wc, int fr, int fq) const {
        rstd_table(ss, u.pm);
        const int row0 = u.pm * 256 + wr * 64 + fr, col0 = u.pn * 256 + wc * 32 + 8 * fq;
#pragma unroll
        for (int ai = 0; ai < 2; ++ai)
#pragma unroll
            for (int m = 0; m < 4; ++m) { const int r = row0 + ai * 128 + m * 16; const float rs = rstd_tab(wr * 64 + fr + ai * 128 + m * 16); bf16* rowp = O + (size_t)r * ldo + col0;
#pragma unroll
                for (int bj = 0; bj < 2; ++bj) *(u32x4*)(rowp + bj * 128) = pack8(acc[ai][bj][m][0] * rs, acc[ai][bj][m][1] * rs); }
    }
};
struct EpiSwiGLU {
    bf16* O; const float* ss;
    __device__ __forceinline__ void operator()(const f32x4 (&acc)[2][2][4][2], const GU& u, int wr, int wc, int fr, int fq) const {
        rstd_table(ss, u.pm);
        const int row0 = u.pm * 256 + wr * 64 + fr, col0 = u.pn * 128 + wc * 32 + 8 * fq;
#pragma unroll
        for (int ai = 0; ai < 2; ++ai)
#pragma unroll
            for (int m = 0; m < 4; ++m) { const int r = row0 + ai * 128 + m * 16; const float rs = rstd_tab(wr * 64 + fr + ai * 128 + m * 16);
                f32x4 v[2];
#pragma unroll
                for (int n = 0; n < 2; ++n)
#pragma unroll
                    for (int j = 0; j < 4; ++j) { const float g = acc[ai][0][m][n][j] * rs, up = acc[ai][1][m][n][j] * rs; v[n][j] = fsilu(g) * up; }
                *(u32x4*)(O + (size_t)r * DFF + col0) = pack8(v[0], v[1]); }
    }
};
struct EpiResidual {
    const float* Hin32; bf16* HB; float* ss_out;
    __device__ __forceinline__ void operator()(const f32x4 (&acc)[2][2][4][2], const GU& u, int wr, int wc, int fr, int fq) const {
        const int row0 = u.pm * 256 + wr * 64 + fr, col0 = u.pn * 256 + wc * 32 + 8 * fq;
#pragma unroll
        for (int hf = 0; hf < 2; ++hf) { const int ai = hf;
            u32x4 hv[8];
            if (!Hin32) {
#pragma unroll
                for (int q = 0; q < 8; ++q) { const int m = q >> 1, bj = q & 1; hv[q] = *(const u32x4*)(HB + (size_t)(row0 + ai * 128 + m * 16) * D + col0 + bj * 128); } }
#pragma unroll
            for (int m = 0; m < 4; ++m) { const int r = row0 + ai * 128 + m * 16; float s2 = 0.f;
#pragma unroll
                for (int bj = 0; bj < 2; ++bj) { const size_t o = (size_t)r * D + col0 + bj * 128;
                    f32x4 h0, h1;
                    if (Hin32) { h0 = *(const f32x4*)(Hin32 + o); h1 = *(const f32x4*)(Hin32 + o + 4); } else unpack8(hv[m * 2 + bj], h0, h1);
                    h0 += acc[ai][bj][m][0]; h1 += acc[ai][bj][m][1];
                    *(u32x4*)(HB + o) = pack8(h0, h1);
                    s2 += (h0[0] * h0[0] + h0[1] * h0[1]) + (h0[2] * h0[2] + h0[3] * h0[3]) + (h1[0] * h1[0] + h1[1] * h1[1]) + (h1[2] * h1[2] + h1[3] * h1[3]); }
                s2 += __shfl_xor(s2, 16); s2 += __shfl_xor(s2, 32);
                if (fq == 0) ss_out[(size_t)r * 16 + u.pn * 4 + wc] = s2; }
            asm volatile("" ::: "memory"); }
    }
};
#define SCR(p, ai, m, bj) (*(u32x4*)((char*)(p) + (size_t)((((ai) * 4 + (m)) * 2 + (bj)) * 8192) + (size_t)toff))
struct EpiMerge {
    u32x4* scrP; u32x4* scrM; bf16* M; const float* ss; const float* bias;
    int nm;
    __device__ __forceinline__ void operator()(const f32x4 (&acc)[2][2][4][2], const GU& u, int wr, int wc, int fr, int fq) const {
        unsigned toff = threadIdx.x * 16u; asm volatile("" : "+v"(toff));
        if (u.kind == 0) {
#pragma unroll
            for (int ai = 0; ai < 2; ++ai)
#pragma unroll
                for (int m = 0; m < 4; ++m)
#pragma unroll
                    for (int bj = 0; bj < 2; ++bj) SCR(scrP, ai, m, bj) = pack8(acc[ai][bj][m][0], acc[ai][bj][m][1]);
            return;
        }
        const int row0 = u.pm * 256 + wr * 64 + fr, col0 = u.pn * 256 + wc * 32 + 8 * fq;
        if (u.mi == 0) rstd_table(ss, u.pm);
        const float* bp = bias + (size_t)u.mi * D + col0;
#pragma unroll
        for (int hf = 0; hf < 2; ++hf) { const int ai = hf;
            u32x4 pv[8];
#pragma unroll
            for (int q = 0; q < 8; ++q) pv[q] = SCR(scrP, ai, q >> 1, q & 1);
#pragma unroll
            for (int q = 0; q < 8; ++q) { const int m = q >> 1, bj = q & 1; const float rs = rstd_tab(wr * 64 + fr + ai * 128 + m * 16);
                const f32x4 b0 = *(const f32x4*)(bp + bj * 128), b1 = *(const f32x4*)(bp + bj * 128 + 4); f32x4 p0, p1; unpack8(pv[q], p0, p1);
#pragma unroll
                for (int j = 0; j < 4; ++j) { p0[j] *= fsigmoid(acc[ai][bj][m][0][j] * rs + b0[j]); p1[j] *= fsigmoid(acc[ai][bj][m][1][j] * rs + b1[j]); }
                pv[q] = pack8(p0, p1); }
            asm volatile("" ::: "memory");
            if (u.mi > 0) { u32x4 mv[8];
#pragma unroll
                for (int q = 0; q < 8; ++q) mv[q] = SCR(scrM, ai, q >> 1, q & 1);
#pragma unroll
                for (int q = 0; q < 8; ++q) { f32x4 a0, a1, q0, q1; unpack8(pv[q], a0, a1); unpack8(mv[q], q0, q1); pv[q] = pack8(a0 + q0, a1 + q1); } }
#pragma unroll
            for (int q = 0; q < 8; ++q) { const int m = q >> 1, bj = q & 1;
                if (u.mi == nm - 1) *(u32x4*)(M + (size_t)(row0 + ai * 128 + m * 16) * D + col0 + bj * 128) = pv[q]; else SCR(scrM, ai, m, bj) = pv[q]; }
            asm volatile("" ::: "memory"); }
    }
};
struct EpiPle {
    u32x4* scrP; const bf16* Hcur; bf16* HBout; const float* ss; float* ss_out;
    __device__ __forceinline__ void operator()(const f32x4 (&acc)[2][2][4][2], const GU& u, int wr, int wc, int fr, int fq) const {
        unsigned toff = threadIdx.x * 16u; asm volatile("" : "+v"(toff));
        if (u.kind == 0) {
#pragma unroll
            for (int ai = 0; ai < 2; ++ai)
#pragma unroll
                for (int m = 0; m < 4; ++m)
#pragma unroll
                    for (int bj = 0; bj < 2; ++bj) SCR(scrP, ai, m, bj) = pack8(acc[ai][bj][m][0], acc[ai][bj][m][1]);
            return;
        }
        rstd_table(ss, u.pm);
        const int row0 = u.pm * 256 + wr * 64 + fr, col0 = u.pn * 256 + wc * 32 + 8 * fq;
#pragma unroll
        for (int qt = 0; qt < 4; ++qt) { const int ai = qt >> 1, m0 = (qt & 1) * 2;
            u32x4 pv[4], hv[4];
#pragma unroll
            for (int q = 0; q < 4; ++q) { const int m = m0 + (q >> 1), bj = q & 1; pv[q] = SCR(scrP, ai, m, bj); hv[q] = *(const u32x4*)(Hcur + (size_t)(row0 + ai * 128 + m * 16) * D + col0 + bj * 128); }
#pragma unroll
            for (int mm = 0; mm < 2; ++mm) { const int m = m0 + mm; const int r = row0 + ai * 128 + m * 16; const float rs = rstd_tab(wr * 64 + fr + ai * 128 + m * 16); float s2 = 0.f;
#pragma unroll
                for (int bj = 0; bj < 2; ++bj) { const int q = mm * 2 + bj; f32x4 h0, h1, p0, p1; unpack8(hv[q], h0, h1); unpack8(pv[q], p0, p1);
#pragma unroll
                    for (int j = 0; j < 4; ++j) { h0[j] += fsigmoid(acc[ai][bj][m][0][j] * rs) * p0[j]; h1[j] += fsigmoid(acc[ai][bj][m][1][j] * rs) * p1[j]; }
                    *(u32x4*)(HBout + (size_t)r * D + col0 + bj * 128) = pack8(h0, h1);
                    s2 += (h0[0] * h0[0] + h0[1] * h0[1]) + (h0[2] * h0[2] + h0[3] * h0[3]) + (h1[0] * h1[0] + h1[1] * h1[1]) + (h1[2] * h1[2] + h1[3] * h1[3]); }
                s2 += __shfl_xor(s2, 16); s2 += __shfl_xor(s2, 32);
                if (fq == 0) ss_out[(size_t)r * 16 + u.pn * 4 + wc] = s2; }
            asm volatile("" ::: "memory"); }
    }
};

constexpr int NWAVES = 8, NTHR = 512;
constexpr int RING_OFF = 0, RING_BYTES = 131072, WREG = 19456, MISC_OFF = 8 * WREG;
constexpr int LDS_BYTES = MISC_OFF + 256;
static_assert(MISC_OFF + 128 <= LDS_BYTES, "lds");
struct Args { const float* in[37]; float* out; unsigned char* ws; int ph_lo, ph_hi; };
struct Frame {
    LAS unsigned char* lds; int tid, lane, wave, G, bx;
    const float* const* in; float* out; unsigned char* ws;
};
enum { I_X = 0, I_P, I_NORM_MIX, I_W_IN, I_POS_K, I_POS_V, I_CK1, I_CK2, I_CV1, I_CV2, I_LB, I_HG_NORM, I_RT_G, I_RT_B, I_MU, I_W0, I_WUP, I_A0, I_AUP, I_GUP, I_KK, I_KA, I_RK,
       I_RW_G, I_RW_B, I_WBR, I_WGATE, I_BGATE, I_WOUT, I_NORM_FFN, I_FFG, I_FFU, I_FFD, I_NORM_PLE, I_PLEG, I_PLEP, I_NORM_FINAL };

template <class ColMap>
__device__ __forceinline__ void transpose_item(const float* W, int ldw, int K, const float* scale, bf16* WT, LAS float* scr, int item, int nblk, int lane, const ColMap& cm) {
    const int kb = item / nblk, nb = item % nblk, k0 = 64 * kb, n0 = 32 * nb;
    const int sc = cm(n0 + (lane & 31));
    float tv[32];
#pragma unroll
    for (int i = 0; i < 32; ++i) { const int kk = 2 * i + (lane >> 5); tv[i] = (sc >= 0) ? W[(size_t)(k0 + kk) * ldw + sc] : 0.f; }
    if (scale) {
#pragma unroll
        for (int i = 0; i < 32; ++i) tv[i] *= scale[k0 + 2 * i + (lane >> 5)]; }
#pragma unroll
    for (int i = 0; i < 32; ++i) scr[(2 * i + (lane >> 5)) * 33 + (lane & 31)] = tv[i];
    LDS_WAIT();
    const int c = lane & 7;
#pragma unroll
    for (int j = 0; j < 4; ++j) { const int n = (lane >> 3) + 8 * j; const LAS float* s = scr + (8 * c) * 33 + n;
        u32x4 o; o.x = cvt_pk_bf16(s[0 * 33], s[1 * 33]); o.y = cvt_pk_bf16(s[2 * 33], s[3 * 33]); o.z = cvt_pk_bf16(s[4 * 33], s[5 * 33]); o.w = cvt_pk_bf16(s[6 * 33], s[7 * 33]);
        *(u32x4*)(WT + (size_t)(n0 + n) * K + k0 + 8 * c) = o; }
    LDS_WAIT();
}
struct CmIdent { __device__ __forceinline__ int operator()(int n) const { return n; } };
struct CmWin { __device__ __forceinline__ int operator()(int n) const { return n < 652 ? n : (n < 768 ? -1 : n - 116); } };
struct CmFF { __device__ __forceinline__ int operator()(int n) const { return (n >> 8) * 128 + (n & 127); } };

__device__ __forceinline__ void phase_prologue(Frame& F0) {
    Frame F = F0; asm volatile("" : "+v"(F.tid)); F.lane = F.tid & 63;
    LAS float* scr = (LAS float*)(F.lds + F.wave * WREG);
    const int gw = F.bx * NWAVES + F.wave, NGW = F.G * NWAVES;
    int dbase = 0;
#define DEAL(var, n) for (int _n = (n), var = (int)((unsigned)(gw + NGW - (dbase % NGW)) % (unsigned)NGW), _once = ((dbase += _n), 0); var < _n; var += NGW)
    for (int L = 0; L < NL; ++L) {
        unsigned char* wl = F.ws + WS_W + (size_t)L * WL_STRIDE;
        const float* g_mix = F.in[I_NORM_MIX] + L * D; const float* g_ffn = F.in[I_NORM_FFN] + L * D; const float* g_ple = F.in[I_NORM_PLE] + L * D;
        { const int nblk = UW / 32, items = (D / 64) * nblk; const float* W = F.in[I_W_IN] + (size_t)L * D * DIN;
          DEAL(it, items) transpose_item(W, DIN, D, g_mix, (bf16*)(wl + WL_IN), scr, it, nblk, F.lane, CmWin()); }
        for (int m = 0; m < 4; ++m) { const int nblk = D / 32, items = (D / 64) * nblk; const float* W = F.in[I_WGATE] + ((size_t)L * 4 + m) * D * D;
          DEAL(it, items) transpose_item(W, D, D, g_mix, (bf16*)(wl + WL_G) + (size_t)m * D * D, scr, it, nblk, F.lane, CmIdent()); }
        for (int m = 0; m < 4; ++m) { const int nblk = D / 32, items = (MW / 64) * nblk; const float* W = F.in[I_WBR] + ((size_t)L * 4 + m) * MW * D;
          DEAL(it, items) transpose_item(W, D, MW, nullptr, (bf16*)(wl + WL_B) + (size_t)m * D * MW, scr, it, nblk, F.lane, CmIdent()); }
        { const int nblk = D / 32, items = (D / 64) * nblk; const float* W = F.in[I_WOUT] + (size_t)L * D * D;
          DEAL(it, items) transpose_item(W, D, D, nullptr, (bf16*)(wl + WL_OUT), scr, it, nblk, F.lane, CmIdent()); }
        { const int nblk = (2 * DFF) / 32, items = (D / 64) * nblk; const float* Wg = F.in[I_FFG] + (size_t)L * D * DFF; const float* Wu = F.in[I_FFU] + (size_t)L * D * DFF;
          DEAL(it, items) { const int nb = it % nblk; const bool up = ((nb * 32) & 128) != 0; transpose_item(up ? Wu : Wg, DFF, D, g_ffn, (bf16*)(wl + WL_FF), scr, it, nblk, F.lane, CmFF()); } }
        { const int nblk = D / 32, items = (DFF / 64) * nblk; const float* W = F.in[I_FFD] + (size_t)L * DFF * D;
          DEAL(it, items) transpose_item(W, D, DFF, nullptr, (bf16*)(wl + WL_DN), scr, it, nblk, F.lane, CmIdent()); }
        { const int nblk = D / 32, items = (D / 64) * nblk; const float* W = F.in[I_PLEG] + (size_t)L * D * D;
          DEAL(it, items) transpose_item(W, D, D, g_ple, (bf16*)(wl + WL_PG), scr, it, nblk, F.lane, CmIdent()); }
        { const int nblk = D / 32, items = (PLE / 64) * nblk; const float* W = F.in[I_PLEP] + (size_t)L * PLE * D;
          DEAL(it, items) transpose_item(W, D, PLE, nullptr, (bf16*)(wl + WL_PP), scr, it, nblk, F.lane, CmIdent()); }
    }
    for (int L = 0; L < NL; ++L) for (int kv = 0; kv < 2; ++kv) {
        const float* w1 = F.in[kv ? I_CV1 : I_CK1] + (size_t)L * 2048 * 128; const float* w2 = F.in[kv ? I_CV2 : I_CK2] + (size_t)L * 128 * 64;
        bf16* w1T = (bf16*)(F.ws + WS_CW1 + (size_t)L * MiB) + (size_t)kv * 128 * 2048; bf16* w2T = (bf16*)(F.ws + WS_CW2 + (size_t)L * 65536) + kv * 64 * 128;
        DEAL(it, 128) transpose_item(w1, 128, 2048, nullptr, w1T, scr, it, 4, F.lane, CmIdent());
        DEAL(it, 4) transpose_item(w2, 64, 128, nullptr, w2T, scr, it, 2, F.lane, CmIdent());
        DEAL(tk, 64) { const int hf = tk & 1, jq = tk >> 1; const float* pos = F.in[kv ? I_POS_V : I_POS_K] + (size_t)L * 2048; float a = 0.f;
#pragma unroll 8
            for (int j = 64 * jq; j < 64 * jq + 64; ++j) a += pos[j] * w1[(size_t)j * 128 + hf * 64 + F.lane];
            ((float*)(F.ws + WS_CW2 + (size_t)L * 65536 + 32768))[(kv * 32 + jq) * 128 + hf * 64 + F.lane] = a; } }
#undef DEAL
    { const float* x = F.in[I_X]; bf16* hb = (bf16*)(F.ws + WS_HBA); float* ss0 = F.out;
      for (int r = gw; r < T; r += NGW) { const f32x4* xr = (const f32x4*)(x + (size_t)r * D) + F.lane; float s = 0.f;
#pragma unroll
        for (int j = 0; j < 4; ++j) { const f32x4 v = xr[64 * j]; s += (v[0] * v[0] + v[1] * v[1]) + (v[2] * v[2] + v[3] * v[3]);
            u32x2 w; w.x = cvt_pk_bf16(v[0], v[1]); w.y = cvt_pk_bf16(v[2], v[3]); *((u32x2*)(hb + (size_t)r * D) + F.lane + 64 * j) = w; }
        s = wave_sum(s); if (F.lane < 16) ss0[(size_t)r * 16 + F.lane] = (F.lane == 0) ? s : 0.f; } }
    for (int L = 0; L < NL; ++L) { bf16* base = (bf16*)(F.ws + WS_RWUP + (size_t)L * 131072);
        for (int it = gw; it < 8; it += NGW) transpose_item(F.in[I_WUP] + (size_t)L * 64 * 256, 256, 64, nullptr, base, scr, it, 8, F.lane, CmIdent());
        for (int it = gw; it < 8; it += NGW) transpose_item(F.in[I_AUP] + (size_t)L * 64 * 256, 256, 64, nullptr, base + 256 * 64, scr, it, 8, F.lane, CmIdent());
        for (int it = gw; it < 16; it += NGW) transpose_item(F.in[I_GUP] + (size_t)L * 128 * 256, 256, 128, nullptr, base + 2 * 256 * 64, scr, it, 8, F.lane, CmIdent()); }
    { float* rope = (float*)(F.ws + WS_ROPE); const int gt = F.bx * NTHR + F.tid, NT_ = F.G * NTHR;
      for (int i = gt; i < S * 32; i += NT_) { const int pos = i >> 5, j = i & 31; const float inv = exp2f(-(float)(2 * j) * (13.287712379549449f / 64.0f));
        const float a = (float)pos * inv;
        rope[2 * i] = cosf(a); rope[2 * i + 1] = sinf(a); } }
}

__device__ __forceinline__ float ldu(const bf16* u, size_t row, int col) { return bf2f(u[row * UW + col]); }

__device__ __forceinline__ bf16x8 frag_rm(const LAS unsigned char* X, int ld, int r0, int k0, int lane) { return *(const LAS bf16x8*)(X + (r0 + (lane & 31)) * ld + (k0 + 8 * (lane >> 5)) * 2); }
__device__ __forceinline__ bf16x8 frag_tr(const LAS unsigned char* X, int ld, int k0, int c0, int lane) {
    const LAS unsigned char* p = X + (k0 + 8 * (lane >> 5) + ((lane & 15) >> 2)) * ld + (c0 + 16 * ((lane >> 4) & 1) + 4 * (lane & 3)) * 2;
    const s16x4 a = __builtin_amdgcn_ds_read_tr16_b64_v4i16((LAS s16x4*)p), b = __builtin_amdgcn_ds_read_tr16_b64_v4i16((LAS s16x4*)(p + 4 * ld));
    return (bf16x8){a[0], a[1], a[2], a[3], b[0], b[1], b[2], b[3]};
}
__device__ __forceinline__ bf16x8 frag_g(const bf16* X, int ld, int r0, int k0, int lane) { return *(const bf16x8*)(X + (size_t)(r0 + (lane & 31)) * ld + k0 + 8 * (lane >> 5)); }
__device__ __forceinline__ f32x16 mma32(const bf16x8& a, const bf16x8& b, const f32x16& c) { return __builtin_amdgcn_mfma_f32_32x32x16_bf16(a, b, c, 0, 0, 0); }
__device__ __forceinline__ f32x16 zero16() { f32x16 z;
#pragma unroll
    for (int i = 0; i < 16; ++i) z[i] = 0.f;
    return z; }
__device__ __forceinline__ void st_T(LAS unsigned char* X, int ld, int j0, int i0, const f32x16& acc, int lane) {
#pragma unroll
    for (int g = 0; g < 4; ++g) { u32x2 w; w.x = cvt_pk_bf16(acc[4 * g], acc[4 * g + 1]); w.y = cvt_pk_bf16(acc[4 * g + 2], acc[4 * g + 3]);
        *(LAS u32x2*)(X + (j0 + (lane & 31)) * ld + (i0 + 8 * g + 4 * (lane >> 5)) * 2) = w; }
}
__device__ __forceinline__ void st_wt16(bf16* p, const u32x4& w) { __hip_atomic_store((unsigned long long*)p, ((unsigned long long)w.y << 32) | (unsigned long long)w.x, __ATOMIC_RELAXED, __HIP_MEMORY_SCOPE_AGENT); __hip_atomic_store((unsigned long long*)p + 1, ((unsigned long long)w.w << 32) | (unsigned long long)w.z, __ATOMIC_RELAXED, __HIP_MEMORY_SCOPE_AGENT); }
template <bool WT>
__device__ __forceinline__ void st_T_g(bf16* X, int ld, int j0, int i0, const f32x16& acc, int lane) {
    const int hh = lane >> 5; u32x2 w[4];
#pragma unroll
    for (int g = 0; g < 4; ++g) { w[g].x = cvt_pk_bf16(acc[4 * g], acc[4 * g + 1]); w[g].y = cvt_pk_bf16(acc[4 * g + 2], acc[4 * g + 3]); }
#pragma unroll
    for (int k = 0; k < 2; ++k) { const u32x2 snd = hh ? w[k] : w[2 + k]; u32x2 rcv; rcv.x = __shfl_xor(snd.x, 32); rcv.y = __shfl_xor(snd.y, 32);
        const u32x2 own = hh ? w[2 + k] : w[k]; u32x4 v; if (hh) { v.x = rcv.x; v.y = rcv.y; v.z = own.x; v.w = own.y; } else { v.x = own.x; v.y = own.y; v.z = rcv.x; v.w = rcv.y; }
        bf16* p = X + (size_t)(j0 + (lane & 31)) * ld + i0 + 8 * (2 * hh + k);
        if (WT) st_wt16(p, v); else *(u32x4*)p = v; }
}
__device__ __forceinline__ void st_T_row(bf16* rowp, int i0, const f32x16& acc, int lane) {
    const int hh = lane >> 5; u32x2 w[4];
#pragma unroll
    for (int g = 0; g < 4; ++g) { w[g].x = cvt_pk_bf16(acc[4 * g], acc[4 * g + 1]); w[g].y = cvt_pk_bf16(acc[4 * g + 2], acc[4 * g + 3]); }
#pragma unroll
    for (int k = 0; k < 2; ++k) { const u32x2 snd = hh ? w[k] : w[2 + k]; u32x2 rcv; rcv.x = __shfl_xor(snd.x, 32); rcv.y = __shfl_xor(snd.y, 32);
        const u32x2 own = hh ? w[2 + k] : w[k]; u32x4 v; if (hh) { v.x = rcv.x; v.y = rcv.y; v.z = own.x; v.w = own.y; } else { v.x = own.x; v.y = own.y; v.z = rcv.x; v.w = rcv.y; }
        *(u32x4*)(rowp + i0 + 8 * (2 * hh + k)) = v; }
}
constexpr int LD64 = 144, LD32 = 80;
__device__ __forceinline__ float expc(float x) { return __expf(fminf(fmaxf(x, -80.f), 80.f)); }
__device__ __forceinline__ unsigned short f2b(float x) { return (unsigned short)(cvt_pk_bf16(x, 0.f) & 0xffffu); }
__device__ __forceinline__ void copy_tok64(LAS unsigned char* X, const bf16* src, int lane) {
#pragma unroll
    for (int p = 0; p < 4; ++p) { const int t = 8 * p + (lane >> 3), ch = lane & 7; *(LAS u32x4*)(X + t * LD64 + ch * 16) = *(const u32x4*)(src + (size_t)t * UW + ch * 8); }
}
__device__ __forceinline__ void glin_m1(const LAS unsigned char* Kh, const LAS unsigned char* Vv, bf16* Sg, int lane, bool cst = false) {
#pragma unroll
    for (int dt = 0; dt < 2; ++dt)
#pragma unroll
        for (int et = 0; et < 2; ++et) { f32x16 acc = zero16();
#pragma unroll
            for (int ks = 0; ks < 2; ++ks) acc = mma32(frag_tr(Kh, LD64, 16 * ks, 32 * dt, lane), frag_tr(Vv, LD64, 16 * ks, 32 * et, lane), acc);
            if (cst) {
#pragma unroll
            for (int i = 0; i < 16; ++i) acc[i] = 0.01f * (float)(1 + ((lane + i) & 7)); }
            st_T_g<false>(Sg, 64, 32 * et, 32 * dt, acc, lane); }
}
__device__ __forceinline__ void glin_m3(const LAS unsigned char* Qt, const LAS unsigned char* Kt, const LAS unsigned char* Vv, LAS unsigned char* Xa, const bf16* S0, int lane, f32x16 (&o)[2]) {
    { f32x16 acc = zero16();
#pragma unroll
      for (int ks = 0; ks < 4; ++ks) acc = mma32(frag_rm(Kt, LD64, 0, 16 * ks, lane), frag_rm(Qt, LD64, 0, 16 * ks, lane), acc);
      const int t = lane & 31;
#pragma unroll
      for (int i = 0; i < 16; ++i) { const int sidx = (i & 3) + 8 * (i >> 2) + 4 * (lane >> 5); if (sidx > t) acc[i] = 0.f; }
      st_T(Xa, LD32, 0, 0, acc, lane); }
    LDS_WAIT();
#pragma unroll
    for (int et = 0; et < 2; ++et) { f32x16 acc = zero16();
        if (S0) {
#pragma unroll
            for (int ks = 0; ks < 4; ++ks) acc = mma32(frag_g(S0, 64, 32 * et, 16 * ks, lane), frag_rm(Qt, LD64, 0, 16 * ks, lane), acc); }
#pragma unroll
        for (int ks = 0; ks < 2; ++ks) acc = mma32(frag_tr(Vv, LD64, 16 * ks, 32 * et, lane), frag_rm(Xa, LD32, 0, 16 * ks, lane), acc);
        o[et] = acc; }
}
template <bool M3>
__device__ __forceinline__ void hgrn_chunk(Frame& F, int L, int bh, int n, LAS unsigned char* W, bf16* Sbase, float* Dbase) {
    const bf16* u = (const bf16*)(F.ws + WS_U); bf16* bo = (bf16*)(F.ws + WS_BO);
    int lane = F.lane; asm volatile("" : "+v"(lane));
    const int b = bh >> 2, h = bh & 3; const size_t row0 = (size_t)b * S + (size_t)n * CH;
    const bf16* ur = u + row0 * UW + U_HG + h * 64;
    bf16* Sg = Sbase + ((size_t)bh * NCH + n) * 4096;
    LAS unsigned char* Xq = W; LAS unsigned char* Xk = W + 4608; LAS unsigned char* Xv = W + 9216; LAS unsigned char* Xa = W + 13824;
    const float* lbl = F.in[I_LB]; const int ch = h * 64 + lane;
    float lb = 0.f; if (L > 0) { const float l0 = lbl[ch], l1 = lbl[256 + ch]; const float mx = fmaxf(l0, l1); const float e0 = __expf(l0 - mx), e1 = __expf(l1 - mx); lb = e1 / (e0 + e1); }
    copy_tok64(Xq, ur + 256, lane); if (M3) copy_tok64(Xk, ur, lane);
    copy_tok64(Xv, ur + 512, lane);
    LDS_WAIT();
    float bcum[CH], kk[CH]; float run = 0.f;
#pragma unroll
    for (int t = 0; t < CH; ++t) { const float z = bf2f(*(const LAS unsigned short*)(Xq + t * LD64 + lane * 2)); const float f = lb + (1.0f - lb) * fsigmoid(z); kk[t] = 1.0f - f; run += __logf(fmaxf(f, 1e-20f)); bcum[t] = run; }
    const float blast = bcum[CH - 1];
    LDS_WAIT();
    if (!M3) {
#pragma unroll
        for (int t = 0; t < CH; ++t) *(LAS unsigned short*)(Xq + t * LD64 + lane * 2) = f2b(kk[t] * expc(blast - bcum[t]));
        Dbase[((size_t)bh * NCH + n) * 64 + lane] = expc(blast);
        LDS_WAIT();
        glin_m1(Xq, Xv, Sg, lane);
    } else {
#pragma unroll
        for (int t = 0; t < CH; ++t) { const float q = fsilu(bf2f(*(const LAS unsigned short*)(Xk + t * LD64 + lane * 2)));
            *(LAS unsigned short*)(Xq + t * LD64 + lane * 2) = f2b(q * expc(bcum[t]));
            *(LAS unsigned short*)(Xk + t * LD64 + lane * 2) = f2b(kk[t] * expc(-bcum[t])); }
        LDS_WAIT();
        f32x16 o[2];
        glin_m3(Xq, Xk, Xv, Xa, n > 0 ? Sg - 4096 : nullptr, lane, o);
        const int t = lane & 31, hh = lane >> 5; float ss = 0.f;
#pragma unroll
        for (int et = 0; et < 2; ++et)
#pragma unroll
            for (int i = 0; i < 16; ++i) ss += o[et][i] * o[et][i];
        ss += __shfl_xor(ss, 32);
        const float rn = __builtin_amdgcn_rsqf(ss * (1.0f / 64.0f) + EPS);
        const float* ng = F.in[I_HG_NORM] + L * 256 + h * 64;
#pragma unroll
        for (int et = 0; et < 2; ++et) {
#pragma unroll
            for (int g = 0; g < 4; ++g) { const int e0 = 32 * et + 8 * g + 4 * hh;
                const u32x2 og = *(const u32x2*)(ur + (size_t)t * UW + 768 + e0); const f32x4 gg = *(const f32x4*)(ng + e0);
                o[et][4 * g] *= rn * gg[0] * fsilu(bflo(og.x)); o[et][4 * g + 1] *= rn * gg[1] * fsilu(bfhi(og.x));
                o[et][4 * g + 2] *= rn * gg[2] * fsilu(bflo(og.y)); o[et][4 * g + 3] *= rn * gg[3] * fsilu(bfhi(og.y)); }
            st_T_g<false>(bo + row0 * 1024 + 256 + h * 64, 1024, 0, 32 * et, o[et], lane); }
    }
    LDS_WAIT();
}
template <bool M3>
__device__ __forceinline__ void ret_chunk(Frame& F, int L, int bh, int n, LAS unsigned char* W, bf16* Sbase) {
    const bf16* u = (const bf16*)(F.ws + WS_U); bf16* bo = (bf16*)(F.ws + WS_BO); const float* rope = (const float*)(F.ws + WS_ROPE);
    int lane = F.lane; asm volatile("" : "+v"(lane));
    const int b = bh >> 2, h = bh & 3; const int tpos0 = n * CH; const size_t row0 = (size_t)b * S + (size_t)tpos0;
    const bf16* ur = u + row0 * UW + U_RT + h * 64;
    bf16* Sg = Sbase + ((size_t)bh * NCH + n) * 4096;
    LAS unsigned char* Xq = W; LAS unsigned char* Xk = W + 4608; LAS unsigned char* Xv = W + 9216; LAS unsigned char* Xa = W + 13824;
    const float lg2 = __log2f(1.0f - exp2f(-5.0f - (float)h));
    copy_tok64(Xv, ur + 512, lane);
#pragma unroll
    for (int p = 0; p < 2; ++p) { const int idx = lane + 64 * p, t = idx >> 2, jc = idx & 3;
        f32x4 c0, c1, s0, s1;
        { const float* rp = rope + ((size_t)(tpos0 + t) * 32 + jc * 8) * 2; const f32x4 a = *(const f32x4*)rp, bq = *(const f32x4*)(rp + 4), c = *(const f32x4*)(rp + 8), d = *(const f32x4*)(rp + 12);
          c0 = (f32x4){a[0], a[2], bq[0], bq[2]}; s0 = (f32x4){a[1], a[3], bq[1], bq[3]}; c1 = (f32x4){c[0], c[2], d[0], d[2]}; s1 = (f32x4){c[1], c[3], d[1], d[3]}; }
        { const u32x4 w1 = *(const u32x4*)(ur + (size_t)t * UW + 256 + jc * 8), w2 = *(const u32x4*)(ur + (size_t)t * UW + 256 + 32 + jc * 8);
          f32x4 a0, a1, b0, b1; unpack8(w1, a0, a1); unpack8(w2, b0, b1);
          const float sc = 0.125f * exp2f(lg2 * (M3 ? -(float)(t + 1) : (float)(CH - 1 - t)));
          const f32x4 lo0 = (a0 * c0 - b0 * s0) * sc, lo1 = (a1 * c1 - b1 * s1) * sc, hi0 = (a0 * s0 + b0 * c0) * sc, hi1 = (a1 * s1 + b1 * c1) * sc;
          LAS unsigned char* dst = M3 ? Xk : Xq;
          *(LAS u32x4*)(dst + t * LD64 + jc * 16) = pack8(lo0, lo1); *(LAS u32x4*)(dst + t * LD64 + 64 + jc * 16) = pack8(hi0, hi1); }
        if (M3) { const u32x4 w1 = *(const u32x4*)(ur + (size_t)t * UW + jc * 8), w2 = *(const u32x4*)(ur + (size_t)t * UW + 32 + jc * 8);
          f32x4 a0, a1, b0, b1; unpack8(w1, a0, a1); unpack8(w2, b0, b1);
          const float sc = exp2f(lg2 * (float)(t + 1));
          const f32x4 lo0 = (a0 * c0 - b0 * s0) * sc, lo1 = (a1 * c1 - b1 * s1) * sc, hi0 = (a0 * s0 + b0 * c0) * sc, hi1 = (a1 * s1 + b1 * c1) * sc;
          *(LAS u32x4*)(Xq + t * LD64 + jc * 16) = pack8(lo0, lo1); *(LAS u32x4*)(Xq + t * LD64 + 64 + jc * 16) = pack8(hi0, hi1); }
    }
    LDS_WAIT();
    if (!M3) glin_m1(Xq, Xv, Sg, lane);
    else {
        f32x16 o[2];
        glin_m3(Xq, Xk, Xv, Xa, n > 0 ? Sg - 4096 : nullptr, lane, o);
        const int t = lane & 31, hh = lane >> 5; float sm = 0.f;
#pragma unroll
        for (int et = 0; et < 2; ++et)
#pragma unroll
            for (int i = 0; i < 16; ++i) sm += o[et][i];
        sm += __shfl_xor(sm, 32);
        const float mean = sm * (1.0f / 64.0f); float sv = 0.f;
#pragma unroll
        for (int et = 0; et < 2; ++et)
#pragma unroll
            for (int i = 0; i < 16; ++i) { const float dl = o[et][i] - mean; sv += dl * dl; }
        sv += __shfl_xor(sv, 32);
        const float rn = __builtin_amdgcn_rsqf(sv * (1.0f / 64.0f) + 1e-5f);
        const float* ng = F.in[I_RT_G] + L * 256 + h * 64; const float* nb = F.in[I_RT_B] + L * 256 + h * 64;
#pragma unroll
        for (int et = 0; et < 2; ++et) {
#pragma unroll
            for (int g = 0; g < 4; ++g) { const int e0 = 32 * et + 8 * g + 4 * hh;
                const u32x2 og = *(const u32x2*)(ur + (size_t)t * UW + 768 + e0); const f32x4 gg = *(const f32x4*)(ng + e0), bb = *(const f32x4*)(nb + e0);
                o[et][4 * g] = ((o[et][4 * g] - mean) * rn * gg[0] + bb[0]) * fsilu(bflo(og.x)); o[et][4 * g + 1] = ((o[et][4 * g + 1] - mean) * rn * gg[1] + bb[1]) * fsilu(bfhi(og.x));
                o[et][4 * g + 2] = ((o[et][4 * g + 2] - mean) * rn * gg[2] + bb[2]) * fsilu(bflo(og.y)); o[et][4 * g + 3] = ((o[et][4 * g + 3] - mean) * rn * gg[3] + bb[3]) * fsilu(bfhi(og.y)); }
            st_T_g<false>(bo + row0 * 1024 + 512 + h * 64, 1024, 0, 32 * et, o[et], lane); }
    }
    LDS_WAIT();
}
__device__ __forceinline__ void glin_scan_task(const bf16* Sbase, bf16* Sout, const float* Dbase, float dscal, int bh, int half, int tl  ) {
    const bf16* p = Sbase + (size_t)bh * NCH * 4096 + half * 2048 + tl * 8; bf16* po = Sout + (size_t)bh * NCH * 4096 + half * 2048 + tl * 8;
    const int d0 = (tl & 7) * 8;
    float st[8];
#pragma unroll
    for (int x = 0; x < 8; ++x) st[x] = 0.f;
    for (int n0 = 0; n0 < NCH; n0 += 8) {
        u32x4 kv[8]; f32x4 da[8], db[8];
#pragma unroll
        for (int j = 0; j < 8; ++j) { kv[j] = *(const u32x4*)(p + (size_t)(n0 + j) * 4096);
            if (Dbase) { da[j] = *(const f32x4*)(Dbase + ((size_t)bh * NCH + n0 + j) * 64 + d0); db[j] = *(const f32x4*)(Dbase + ((size_t)bh * NCH + n0 + j) * 64 + d0 + 4); } else { da[j] = (f32x4){dscal, dscal, dscal, dscal}; db[j] = da[j]; } }
#pragma unroll
        for (int j = 0; j < 8; ++j) { f32x4 a, b; unpack8(kv[j], a, b);
#pragma unroll
            for (int x = 0; x < 4; ++x) { st[x] = st[x] * da[j][x] + a[x]; st[4 + x] = st[4 + x] * db[j][x] + b[x]; }
            *(u32x4*)(po + (size_t)(n0 + j) * 4096) = pack8((f32x4){st[0], st[1], st[2], st[3]}, (f32x4){st[4], st[5], st[6], st[7]}); }
    }
}

constexpr int RW_R0 = 0, RW_R1 = 4608, RW_R2 = 9216, RW_R3 = 13824, RW_R4 = 16384, RW_R5 = 18944, RW_LW = 0, RW_AG = 8704, LDLW = 272;
__device__ __forceinline__ void ld_shift8(const bf16* urow, bool has_prev, const float* mu8, f32x4& lo, f32x4& hi) {
    const u32x4 w1 = *(const u32x4*)urow; f32x4 a0, a1; unpack8(w1, a0, a1);
    f32x4 p0 = {0.f, 0.f, 0.f, 0.f}, p1 = {0.f, 0.f, 0.f, 0.f};
    if (has_prev) { const u32x4 w0 = *(const u32x4*)(urow - UW); unpack8(w0, p0, p1); }
    const f32x4 m0 = *(const f32x4*)mu8, m1 = *(const f32x4*)(mu8 + 4);
    lo = a0 + m0 * (p0 - a0); hi = a1 + m1 * (p1 - a1);
}
__device__ __forceinline__ float ftanh(float x) { return 1.0f - 2.0f * __builtin_amdgcn_rcpf(1.0f + __builtin_amdgcn_exp2f(2.8853900817779268f * x)); }
#ifndef RW_LIMIT
#define RW_LIMIT 100
#endif
#define RW_CUT(k) do { if (RW_LIMIT <= (k)) return; } while (0)
template <int SI> struct SubstStep {
    static __device__ __forceinline__ void run(float (&Tr)[CH], const LAS unsigned char* AT, int r32, int& ofs) {
        float a0 = (r32 == SI) ? 1.0f : 0.f, a1 = 0.f;
#pragma unroll
        for (int q = 0; q < 4; ++q) { if (8 * q + 7 > SI) { const u32x4 w = *(const LAS u32x4*)(AT + ofs + SI * LD32 + q * 16); f32x4 lo, hi; unpack8(w, lo, hi);
#pragma unroll
            for (int x = 0; x < 4; ++x) { if (8 * q + x > SI) a0 += Tr[8 * q + x] * lo[x]; if (8 * q + 4 + x > SI) a1 += Tr[8 * q + 4 + x] * hi[x]; } } }
        const float a = a0 + a1;
        Tr[SI] = a;
        asm volatile("" : "+v"(ofs) : "v"(a));
        SubstStep<SI - 1>::run(Tr, AT, r32, ofs);
    }
};
template <> struct SubstStep<-1> { static __device__ __forceinline__ void run(float (&)[CH], const LAS unsigned char*, int, int&) {} };
template <bool M3>
__device__ __forceinline__ void rwkv_chunk(Frame& F, int L, int bh, int n, LAS unsigned char* W) {
    const bf16* u = (const bf16*)(F.ws + WS_U); bf16* bo = (bf16*)(F.ws + WS_BO);
    int lane = F.lane; asm volatile("" : "+v"(lane));
    const int b = bh >> 2, h = bh & 3, r32 = lane & 31, hh = lane >> 5; const size_t row0 = (size_t)b * S + (size_t)n * CH;
    const bf16* ur = u + row0 * UW + U_RW;
    const float* mu = F.in[I_MU] + L * 1024;
    const bf16* upT = (const bf16*)(F.ws + WS_RWUP + (size_t)L * 131072);
    bf16* Mg = (bf16*)(F.ws + WS_RWM) + ((size_t)bh * NCH + n) * 4096;
    bf16* Ng = (bf16*)(F.ws + WS_RWN) + ((size_t)bh * NCH + n) * 4096;
    bf16* Tg = (bf16*)((unsigned char*)F.out + DO_T) + ((size_t)bh * NCH + n) * 1024;
    LAS unsigned char* R0 = W + RW_R0; LAS unsigned char* R1 = W + RW_R1; LAS unsigned char* R2 = W + RW_R2; LAS unsigned char* R3 = W + RW_R3; LAS unsigned char* R4 = W + RW_R4;
    LAS float* R5 = (LAS float*)(W + RW_R5);
#pragma unroll
    for (int i = 0; i < 8; ++i) { const int idx = lane + 64 * i, t = idx >> 4, part = (idx >> 3) & 1, ch = idx & 7, col = 768 + part * 64 + ch * 8;
        f32x4 lo, hi; ld_shift8(ur + (size_t)t * UW + col, (n * CH + t) > 0, mu + col, lo, hi);
        if (part == 0) {
#pragma unroll
            for (int j = 0; j < 4; ++j) { lo[j] = ftanh(lo[j]); hi[j] = ftanh(hi[j]); } }
        *(LAS u32x4*)(W + part * 4608 + t * LD64 + ch * 16) = pack8(lo, hi); }
    RW_CUT(0);
    LDS_WAIT();
    { f32x16 zw[2], za[2];
#pragma unroll
      for (int ct = 0; ct < 2; ++ct) { zw[ct] = zero16(); za[ct] = zero16();
#pragma unroll
        for (int ks = 0; ks < 4; ++ks) { zw[ct] = mma32(frag_g(upT + (size_t)(h * 64 + 32 * ct) * 64, 64, 0, 16 * ks, lane), frag_rm(W, LD64, 0, 16 * ks, lane), zw[ct]);
            za[ct] = mma32(frag_g(upT + 256 * 64 + (size_t)(h * 64 + 32 * ct) * 64, 64, 0, 16 * ks, lane), frag_rm(W + 4608, LD64, 0, 16 * ks, lane), za[ct]); } }
      const float* w0 = F.in[I_W0] + L * 256 + h * 64; const float* a0 = F.in[I_A0] + L * 256 + h * 64;
#pragma unroll
      for (int ct = 0; ct < 2; ++ct)
#pragma unroll
        for (int g = 0; g < 4; ++g) { const int c0 = 32 * ct + 8 * g + 4 * hh; const f32x4 wv = *(const f32x4*)(w0 + c0), av = *(const f32x4*)(a0 + c0);
            f32x4 lw, ag;
#pragma unroll
            for (int x = 0; x < 4; ++x) { lw[x] = -0.6065306597126334f * fsigmoid(zw[ct][4 * g + x] + wv[x]); ag[x] = fsigmoid(za[ct][4 * g + x] + av[x]); }
            *(LAS f32x4*)(W + RW_LW + r32 * LDLW + c0 * 4) = lw;
            u32x2 pk; pk.x = cvt_pk_bf16(ag[0], ag[1]); pk.y = cvt_pk_bf16(ag[2], ag[3]); *(LAS u32x2*)(W + RW_AG + r32 * LD64 + c0 * 2) = pk; } }
    RW_CUT(1);
    LDS_WAIT();
    { float run = 0.f;
#pragma unroll
      for (int t = 0; t < CH; ++t) { LAS float* p = (LAS float*)(W + RW_LW + t * LDLW) + lane; run += *p; *p = run; } }
    RW_CUT(2);
    LDS_WAIT();
    const int c0 = 8 * (lane & 7), tl = lane >> 3;
    u32x4 E1p[4], E2p[4], AGp[4];
#pragma unroll
    for (int p = 0; p < 4; ++p) { const int t = 8 * p + tl;
        const f32x4 ca = *(const LAS f32x4*)(W + RW_LW + t * LDLW + c0 * 4), cb = *(const LAS f32x4*)(W + RW_LW + t * LDLW + c0 * 4 + 16);
        f32x4 ea = {0.f, 0.f, 0.f, 0.f}, eb = {0.f, 0.f, 0.f, 0.f};
        if (t > 0) { ea = *(const LAS f32x4*)(W + RW_LW + (t - 1) * LDLW + c0 * 4); eb = *(const LAS f32x4*)(W + RW_LW + (t - 1) * LDLW + c0 * 4 + 16); }
        AGp[p] = *(const LAS u32x4*)(W + RW_AG + t * LD64 + c0 * 2);
        f32x4 x1a, x1b, x2a, x2b;
#pragma unroll
        for (int x = 0; x < 4; ++x) { x1a[x] = __expf(ea[x]); x1b[x] = __expf(eb[x]); x2a[x] = __expf(-ca[x]); x2b[x] = __expf(-cb[x]); }
        E1p[p] = pack8(x1a, x1b); E2p[p] = pack8(x2a, x2b); }
    float pcl[8];
    { const f32x4 la = *(const LAS f32x4*)(W + RW_LW + 31 * LDLW + c0 * 4), lb2 = *(const LAS f32x4*)(W + RW_LW + 31 * LDLW + c0 * 4 + 16);
#pragma unroll
      for (int x = 0; x < 4; ++x) { pcl[x] = __expf(la[x]); pcl[4 + x] = __expf(lb2[x]); } }
    RW_CUT(3);
    LDS_WAIT();
    const float* kkw = F.in[I_KK] + L * 256 + h * 64 + c0; const float* kaw = F.in[I_KA] + L * 256 + h * 64 + c0; const float* rkw = F.in[I_RK] + L * 256 + h * 64 + c0;
    u32x4 Ap[4];
    if (!M3 && tl == 0) { *(LAS f32x4*)(R5 + c0) = (f32x4){pcl[0], pcl[1], pcl[2], pcl[3]}; *(LAS f32x4*)(R5 + c0 + 4) = (f32x4){pcl[4], pcl[5], pcl[6], pcl[7]}; }
#pragma unroll
    for (int p = 0; p < 4; ++p) { const int t = 8 * p + tl; const bool hp = (n * CH + t) > 0; const bf16* ut = ur + (size_t)t * UW + h * 64 + c0;
        f32x4 k0, k1, r0 = {0.f, 0.f, 0.f, 0.f}, r1 = {0.f, 0.f, 0.f, 0.f};
        ld_shift8(ut + 256, hp, mu + 256 + h * 64 + c0, k0, k1);
        if (M3) ld_shift8(ut, hp, mu + h * 64 + c0, r0, r1);
        f32x4 ag0, ag1; unpack8(AGp[p], ag0, ag1);
        float E1[8], E2[8]; { f32x4 a, bq; unpack8(E1p[p], a, bq); f32x4 c, d; unpack8(E2p[p], c, d);
#pragma unroll
            for (int x = 0; x < 4; ++x) { E1[x] = a[x]; E1[4 + x] = bq[x]; E2[x] = c[x]; E2[4 + x] = d[x]; } }
        const f32x4 kw0 = *(const f32x4*)kkw, kw1 = *(const f32x4*)(kkw + 4), ka0 = *(const f32x4*)kaw, ka1 = *(const f32x4*)(kaw + 4);
        f32x4 q0 = k0 * kw0, q1 = k1 * kw1;
        float n2 = (q0[0] * q0[0] + q0[1] * q0[1]) + (q0[2] * q0[2] + q0[3] * q0[3]) + (q1[0] * q1[0] + q1[1] * q1[1]) + (q1[2] * q1[2] + q1[3] * q1[3]);
        n2 += __shfl_xor(n2, 1); n2 += __shfl_xor(n2, 2); n2 += __shfl_xor(n2, 4);
        const float rn = __builtin_amdgcn_rsqf(fmaxf(n2, 1e-24f)); q0 = q0 * rn; q1 = q1 * rn;
        f32x4 kp0, kp1, at0, at1, bt0, bt1, kt0, kt1;
#pragma unroll
        for (int x = 0; x < 4; ++x) { kp0[x] = k0[x] * (1.0f + (ag0[x] - 1.0f) * ka0[x]); kp1[x] = k1[x] * (1.0f + (ag1[x] - 1.0f) * ka1[x]);
            at0[x] = -q0[x] * E1[x]; at1[x] = -q1[x] * E1[4 + x]; bt0[x] = q0[x] * ag0[x] * E2[x]; bt1[x] = q1[x] * ag1[x] * E2[4 + x];
            kt0[x] = kp0[x] * E2[x]; kt1[x] = kp1[x] * E2[4 + x]; }
        *(LAS u32x4*)(R1 + t * LD64 + c0 * 2) = pack8(bt0, bt1); *(LAS u32x4*)(R2 + t * LD64 + c0 * 2) = pack8(kt0, kt1);
        if (!M3) *(LAS u32x4*)(R0 + t * LD64 + c0 * 2) = pack8(at0, at1);
        else { Ap[p] = pack8(at0, at1);
            const f32x4 rk0 = *(const f32x4*)rkw, rk1 = *(const f32x4*)(rkw + 4);
            f32x4 rt0, rt1; float bs = 0.f;
#pragma unroll
            for (int x = 0; x < 4; ++x) { rt0[x] = r0[x] * __builtin_amdgcn_rcpf(E2[x]); rt1[x] = r1[x] * __builtin_amdgcn_rcpf(E2[4 + x]); bs += r0[x] * kp0[x] * rk0[x] + r1[x] * kp1[x] * rk1[x]; }
            bs += __shfl_xor(bs, 1); bs += __shfl_xor(bs, 2); bs += __shfl_xor(bs, 4);
            if ((lane & 7) == 0) R5[t] = bs;
            *(LAS u32x4*)(R0 + t * LD64 + c0 * 2) = pack8(rt0, rt1); } }
    RW_CUT(4);
    LDS_WAIT();
    const bf16* S0 = n > 0 ? (const bf16*)((unsigned char*)F.out + DO_RWS) + ((size_t)bh * NCH + n - 1) * 4096 : nullptr;
    f32x16 yacc[2], g2acc;
    if (M3) {
#pragma unroll
        for (int vt = 0; vt < 2; ++vt) { yacc[vt] = zero16();
            if (S0) {
#pragma unroll
                for (int ks = 0; ks < 4; ++ks) yacc[vt] = mma32(frag_g(S0, 64, 32 * vt, 16 * ks, lane), frag_rm(R0, LD64, 0, 16 * ks, lane), yacc[vt]); } }
        f32x16 g1 = zero16(); g2acc = zero16();
#pragma unroll
        for (int ks = 0; ks < 4; ++ks) { const bf16x8 rf = frag_rm(R0, LD64, 0, 16 * ks, lane); g1 = mma32(frag_rm(R1, LD64, 0, 16 * ks, lane), rf, g1); g2acc = mma32(frag_rm(R2, LD64, 0, 16 * ks, lane), rf, g2acc); }
#pragma unroll
        for (int i = 0; i < 16; ++i) { const int sidx = (i & 3) + 8 * (i >> 2) + 4 * hh; if (sidx > r32) { g1[i] = 0.f; g2acc[i] = 0.f; } }
        st_T(R4, LD32, 0, 0, g1, lane);
        LDS_WAIT();
#pragma unroll
        for (int p = 0; p < 4; ++p) *(LAS u32x4*)(R0 + (8 * p + tl) * LD64 + c0 * 2) = Ap[p];
        LDS_WAIT();
    }
    RW_CUT(5);
    { f32x16 ab = zero16(), ak = zero16();
#pragma unroll
      for (int ks = 0; ks < 4; ++ks) { const bf16x8 af = frag_rm(R0, LD64, 0, 16 * ks, lane); if (!M3) ab = mma32(af, frag_rm(R1, LD64, 0, 16 * ks, lane), ab); ak = mma32(frag_rm(R2, LD64, 0, 16 * ks, lane), af, ak); }
#pragma unroll
      for (int i = 0; i < 16; ++i) { const int ridx = (i & 3) + 8 * (i >> 2) + 4 * hh;
          if (!(ridx > r32)) ab[i] = 0.f;
          if (!(ridx < r32)) ak[i] = 0.f; }
      if (!M3) st_T(R3, LD32, 0, 0, ab, lane);
      st_T(M3 ? R2 : R4, LD32, 0, 0, ak, lane); }
    LAS unsigned char* X1 = M3 ? R2 : R4;
    RW_CUT(6);
    LDS_WAIT();
    if (!M3) {
      float Tr[CH];
      int sofs = 0; asm volatile("" : "+v"(sofs)); SubstStep<CH - 1>::run(Tr, R3, r32, sofs);
      if (hh == 0) {
#pragma unroll
          for (int q = 0; q < 4; ++q) { f32x4 lo = {Tr[8 * q], Tr[8 * q + 1], Tr[8 * q + 2], Tr[8 * q + 3]}, hi = {Tr[8 * q + 4], Tr[8 * q + 5], Tr[8 * q + 6], Tr[8 * q + 7]};
              const u32x4 w = pack8(lo, hi); *(LAS u32x4*)(R3 + r32 * LD32 + q * 16) = w; *(u32x4*)(Tg + r32 * 32 + q * 8) = w; } }
    } else if (hh == 0) {
#pragma unroll
        for (int q = 0; q < 4; ++q) *(LAS u32x4*)(R3 + r32 * LD32 + q * 16) = *(const u32x4*)(Tg + r32 * 32 + q * 8);
    }
    RW_CUT(7);
    LDS_WAIT();
    { f32x16 y = zero16(), ah[2];
#pragma unroll
      for (int ks = 0; ks < 2; ++ks) y = mma32(frag_tr(X1, LD32, 16 * ks, 0, lane), frag_rm(R3, LD32, 0, 16 * ks, lane), y);
#pragma unroll
      for (int ct = 0; ct < 2; ++ct) { ah[ct] = zero16();
#pragma unroll
        for (int ks = 0; ks < 2; ++ks) ah[ct] = mma32(frag_tr(R0, LD64, 16 * ks, 32 * ct, lane), frag_rm(R3, LD32, 0, 16 * ks, lane), ah[ct]); }
      st_T(X1, LD32, 0, 0, y, lane);
      st_T(R0, LD64, 0, 0, ah[0], lane); st_T(R0, LD64, 0, 32, ah[1], lane); }
    RW_CUT(8);
    LDS_WAIT();
    if (!M3) {
        { f32x16 z[2];
#pragma unroll
          for (int dt = 0; dt < 2; ++dt) {
#pragma unroll
            for (int g = 0; g < 4; ++g) { const u32x2 w = *(const LAS u32x2*)(R2 + r32 * LD64 + (32 * dt + 8 * g + 4 * hh) * 2); z[dt][4 * g] = bflo(w.x); z[dt][4 * g + 1] = bfhi(w.x); z[dt][4 * g + 2] = bflo(w.y); z[dt][4 * g + 3] = bfhi(w.y); }
#pragma unroll
            for (int ks = 0; ks < 2; ++ks) z[dt] = mma32(frag_tr(R1, LD64, 16 * ks, 32 * dt, lane), frag_tr(X1, LD32, 16 * ks, 0, lane), z[dt]); }
          st_T(R2, LD64, 0, 0, z[0], lane); st_T(R2, LD64, 0, 32, z[1], lane); }
#pragma unroll
        for (int d1t = 0; d1t < 2; ++d1t) { const float pc1 = R5[32 * d1t + r32];
#pragma unroll
            for (int d2t = 0; d2t < 2; ++d2t) { f32x16 m = zero16();
#pragma unroll
                for (int ks = 0; ks < 2; ++ks) m = mma32(frag_tr(R0, LD64, 16 * ks, 32 * d2t, lane), frag_tr(R1, LD64, 16 * ks, 32 * d1t, lane), m);
#pragma unroll
                for (int i = 0; i < 16; ++i) { const int d2 = 32 * d2t + (i & 3) + 8 * (i >> 2) + 4 * hh; m[i] = pc1 * (m[i] + ((d2 == 32 * d1t + r32) ? 1.0f : 0.f)); }
                st_T_g<false>(Mg, 64, 32 * d1t, 32 * d2t, m, lane); } }
        LDS_WAIT();
#pragma unroll
        for (int p = 0; p < 4; ++p) { const int t = 8 * p + tl; f32x4 v0, v1; ld_shift8(ur + (size_t)t * UW + h * 64 + c0 + 512, (n * CH + t) > 0, mu + 512 + h * 64 + c0, v0, v1); *(LAS u32x4*)(R1 + t * LD64 + c0 * 2) = pack8(v0, v1); }
        LDS_WAIT();
#pragma unroll
        for (int dt = 0; dt < 2; ++dt)
#pragma unroll
            for (int vt = 0; vt < 2; ++vt) { f32x16 nn = zero16();
#pragma unroll
                for (int ks = 0; ks < 2; ++ks) nn = mma32(frag_tr(R2, LD64, 16 * ks, 32 * dt, lane), frag_tr(R1, LD64, 16 * ks, 32 * vt, lane), nn);
#pragma unroll
                for (int g = 0; g < 4; ++g) { const f32x4 pv = *(const LAS f32x4*)(R5 + 32 * dt + 8 * g + 4 * hh);
#pragma unroll
                    for (int x = 0; x < 4; ++x) nn[4 * g + x] *= pv[x]; }
                st_T_g<false>(Ng, 64, 32 * vt, 32 * dt, nn, lane); }
    } else {
        { f32x16 rh[2];
#pragma unroll
          for (int dt = 0; dt < 2; ++dt) { rh[dt] = zero16();
#pragma unroll
            for (int ks = 0; ks < 2; ++ks) rh[dt] = mma32(frag_tr(R0, LD64, 16 * ks, 32 * dt, lane), frag_rm(R4, LD32, 0, 16 * ks, lane), rh[dt]); }
          st_T(R1, LD64, 0, 0, rh[0], lane); st_T(R1, LD64, 0, 32, rh[1], lane); }
        { f32x16 gh = g2acc;
#pragma unroll
          for (int ks = 0; ks < 2; ++ks) gh = mma32(frag_tr(X1, LD32, 16 * ks, 0, lane), frag_rm(R4, LD32, 0, 16 * ks, lane), gh);
          LDS_WAIT();
          st_T(R3, LD32, 0, 0, gh, lane); }
        LDS_WAIT();
        if (S0) {
#pragma unroll
            for (int vt = 0; vt < 2; ++vt)
#pragma unroll
                for (int ks = 0; ks < 4; ++ks) yacc[vt] = mma32(frag_g(S0, 64, 32 * vt, 16 * ks, lane), frag_rm(R1, LD64, 0, 16 * ks, lane), yacc[vt]); }
        LDS_WAIT();
#pragma unroll
        for (int p = 0; p < 4; ++p) { const int t = 8 * p + tl; f32x4 v0, v1; ld_shift8(ur + (size_t)t * UW + h * 64 + c0 + 512, (n * CH + t) > 0, mu + 512 + h * 64 + c0, v0, v1); *(LAS u32x4*)(R0 + t * LD64 + c0 * 2) = pack8(v0, v1); }
#pragma unroll
        for (int i = 0; i < 8; ++i) { const int idx = lane + 64 * i, t = idx >> 4, ch = idx & 15, col = 896 + ch * 8;
            f32x4 lo, hi; ld_shift8(ur + (size_t)t * UW + col, (n * CH + t) > 0, mu + col, lo, hi);
#pragma unroll
            for (int j = 0; j < 4; ++j) { lo[j] = fsigmoid(lo[j]); hi[j] = fsigmoid(hi[j]); }
            *(LAS u32x4*)(R1 + t * LDLW + ch * 16) = pack8(lo, hi); }
        LDS_WAIT();
        f32x16 gacc[2];
#pragma unroll
        for (int vt = 0; vt < 2; ++vt) {
#pragma unroll
            for (int ks = 0; ks < 2; ++ks) yacc[vt] = mma32(frag_tr(R0, LD64, 16 * ks, 32 * vt, lane), frag_rm(R3, LD32, 0, 16 * ks, lane), yacc[vt]);
            gacc[vt] = zero16();
#pragma unroll
            for (int ks = 0; ks < 8; ++ks) gacc[vt] = mma32(frag_g(upT + 2 * 256 * 64 + (size_t)(h * 64 + 32 * vt) * 128, 128, 0, 16 * ks, lane), frag_rm(R1, LDLW, 0, 16 * ks, lane), gacc[vt]); }
        float sm = 0.f;
#pragma unroll
        for (int vt = 0; vt < 2; ++vt)
#pragma unroll
            for (int i = 0; i < 16; ++i) sm += yacc[vt][i];
        sm += __shfl_xor(sm, 32);
        const float mean = sm * (1.0f / 64.0f); float sv = 0.f;
#pragma unroll
        for (int vt = 0; vt < 2; ++vt)
#pragma unroll
            for (int i = 0; i < 16; ++i) { const float dl = yacc[vt][i] - mean; sv += dl * dl; }
        sv += __shfl_xor(sv, 32);
        const float rstd = __builtin_amdgcn_rsqf(sv * (1.0f / 64.0f) + 64e-5f);
        const float bon = R5[r32];
        const float* ng = F.in[I_RW_G] + L * 256 + h * 64; const float* nb = F.in[I_RW_B] + L * 256 + h * 64;
#pragma unroll
        for (int vt = 0; vt < 2; ++vt) {
#pragma unroll
            for (int g = 0; g < 4; ++g) { const int v0i = 32 * vt + 8 * g + 4 * hh;
                const u32x2 vw = *(const LAS u32x2*)(R0 + r32 * LD64 + v0i * 2); const f32x4 gg = *(const f32x4*)(ng + v0i), bb = *(const f32x4*)(nb + v0i);
                const float vv[4] = {bflo(vw.x), bfhi(vw.x), bflo(vw.y), bfhi(vw.y)};
#pragma unroll
                for (int x = 0; x < 4; ++x) yacc[vt][4 * g + x] = ((yacc[vt][4 * g + x] - mean) * rstd * gg[x] + bb[x] + bon * vv[x]) * gacc[vt][4 * g + x]; }
            st_T_g<false>(bo + row0 * 1024 + 768 + h * 64, 1024, 0, 32 * vt, yacc[vt], lane); }
    }
    LDS_WAIT();
}
constexpr int RW_SLOT = 12288, RW_D = 3;
__device__ __forceinline__ void rwkv_scan_task(Frame& F, int bh, int vh) {
    const int lane = F.lane, r32 = lane & 31, hh = lane >> 5;
    const char* Mb = (const char*)(F.ws + WS_RWM) + (size_t)bh * NCH * 8192; const char* Nb = (const char*)(F.ws + WS_RWN) + (size_t)bh * NCH * 8192 + (size_t)vh * 32 * 128;
    LAS unsigned char* ring = F.lds;
    const int irow = lane >> 3, icg = (lane & 7) ^ (irow & 7);
#define RW_ISSUE(nn) do { const int _n = (nn) < NCH ? (nn) : NCH - 1; LAS unsigned char* _sl = ring + (_n & 7) * RW_SLOT; const char* _m = Mb + (size_t)_n * 8192 + irow * 128 + icg * 16; const char* _q = Nb + (size_t)_n * 8192 + irow * 128 + icg * 16; \
        _Pragma("unroll") for (int q = 0; q < 8; ++q) __builtin_amdgcn_global_load_lds((const unsigned*)(_m + q * 1024), (LAS unsigned*)(_sl + q * 1024), 16, 0, 0); \
        _Pragma("unroll") for (int q = 0; q < 4; ++q) __builtin_amdgcn_global_load_lds((const unsigned*)(_q + q * 1024), (LAS unsigned*)(_sl + 8192 + q * 1024), 16, 0, 0); } while (0)
    f32x16 st[2] = {zero16(), zero16()};
#pragma unroll
    for (int k = 0; k < RW_D; ++k) RW_ISSUE(k);
    asm volatile("s_waitcnt vmcnt(0)" ::: "memory");
    const int sw = r32 & 7;
    for (int n = 0; n < NCH; ++n) {
        RW_ISSUE(n + RW_D);
        asm volatile("s_waitcnt vmcnt(48)" ::: "memory");
        const LAS unsigned char* sl = ring + (n & 7) * RW_SLOT;
        bf16x8 bfr[2][2];
#pragma unroll
        for (int dt = 0; dt < 2; ++dt)
#pragma unroll
            for (int s2 = 0; s2 < 2; ++s2) { union { bf16x8 v; unsigned w[4]; } pf;
#pragma unroll
                for (int j = 0; j < 4; ++j) pf.w[j] = cvt_pk_bf16(st[dt][8 * s2 + 2 * j], st[dt][8 * s2 + 2 * j + 1]);
                bfr[dt][s2] = pf.v; }
        f32x16 nw[2];
#pragma unroll
        for (int d1t = 0; d1t < 2; ++d1t) {
#pragma unroll
            for (int g = 0; g < 4; ++g) { const u32x2 w = *(const LAS u32x2*)(sl + 8192 + r32 * 128 + (((4 * d1t + g) ^ sw) * 16) + hh * 8);
                nw[d1t][4 * g] = bflo(w.x); nw[d1t][4 * g + 1] = bfhi(w.x); nw[d1t][4 * g + 2] = bflo(w.y); nw[d1t][4 * g + 3] = bfhi(w.y); }
#pragma unroll
            for (int dt = 0; dt < 2; ++dt)
#pragma unroll
                for (int s2 = 0; s2 < 2; ++s2) { const int cg = 4 * dt + 2 * s2; union { bf16x8 v; u32x2 d[2]; } mf;
                    mf.d[0] = *(const LAS u32x2*)(sl + (32 * d1t + r32) * 128 + ((cg ^ sw) * 16) + hh * 8); mf.d[1] = *(const LAS u32x2*)(sl + (32 * d1t + r32) * 128 + (((cg + 1) ^ sw) * 16) + hh * 8);
                    nw[d1t] = mma32(mf.v, bfr[dt][s2], nw[d1t]); } }
#pragma unroll
        for (int d1t = 0; d1t < 2; ++d1t) { st[d1t] = nw[d1t];
            st_T_g<false>((bf16*)((unsigned char*)F.out + DO_RWS) + ((size_t)bh * NCH + n) * 4096, 64, vh * 32, 32 * d1t, nw[d1t], lane); }
    }
    asm volatile("s_waitcnt vmcnt(0)" ::: "memory");
#undef RW_ISSUE
}

constexpr int NS_KROW = 144, NS_VROW = 144;
constexpr int NS_KB = 64 * NS_KROW, NS_VB = 64 * NS_VROW;
constexpr int NS_K0 = 0, NS_V0 = 2 * NS_KB, NS_IMP = NS_V0 + 2 * NS_VB, NS_SEL = NS_IMP + 64 * 128 * 4, NS_END = NS_SEL + 64 * 4 * 4;
constexpr int NS_OUT = NS_END, NS_END2 = NS_OUT + 8 * 8192;
static_assert(NS_END2 <= MISC_OFF, "nsa lds");
struct NsaRow { float m, l; f32x16 o[2]; };
__device__ __forceinline__ void ns_load(const bf16* kb, const bf16* vb, size_t stride, int tid, u32x4& kr, u32x4& vr) {
    const int key = tid >> 3, ch = tid & 7; kr = *(const u32x4*)(kb + (size_t)key * stride + ch * 8); vr = *(const u32x4*)(vb + (size_t)key * stride + ch * 8);
}
__device__ __forceinline__ void ns_store(LAS unsigned char* Kb, LAS unsigned char* Vb, int tid, const u32x4& kr, const u32x4& vr) {
    const int key = tid >> 3, ch = tid & 7;
    *(LAS u32x4*)(Kb + key * NS_KROW + ch * 16) = kr;
    *(LAS u32x4*)(Vb + key * NS_VROW + ch * 16) = vr;
}
__device__ __forceinline__ void ns_qk(LAS unsigned char* Kb, const bf16x8 (&qf)[4], int r, int h2, f32x16 (&sacc)[2]) {
#pragma unroll
    for (int sub = 0; sub < 2; ++sub) { f32x16 a;
#pragma unroll
        for (int i = 0; i < 16; ++i) a[i] = 0.f;
#pragma unroll
        for (int kk = 0; kk < 4; ++kk) { const bf16x8 kf = *(const LAS bf16x8*)(Kb + (32 * sub + r) * NS_KROW + (8 * h2 + 16 * kk) * 2); a = __builtin_amdgcn_mfma_f32_32x32x16_bf16(kf, qf[kk], a, 0, 0, 0); }
        sacc[sub] = a; }
}
enum { NS_CMP = 0, NS_SEL_ = 1, NS_WIN = 2 };
template <int MODE> __device__ __forceinline__ bool ns_valid(int key, int t, bool blk_on) {
    if (MODE == NS_CMP) return 16 * key + 31 <= t;
    if (MODE == NS_SEL_) return blk_on && key <= t;
    return key <= t && key + 511 >= t;
}
template <int MODE>
__device__ __forceinline__ void ns_branch(Frame& F, const bf16* kbase, const bf16* vbase, size_t stride, int tile_lo, int tile_hi, const bf16x8 (&qf)[4], int t, int r, int h2,
                                          const unsigned (&selw)[4], NsaRow& R) {
    LAS unsigned char* L = F.lds;
    R.m = -1e30f; R.l = 0.f;
#pragma unroll
    for (int e = 0; e < 2; ++e)
#pragma unroll
        for (int i = 0; i < 16; ++i) R.o[e][i] = 0.f;
    if (tile_hi <= tile_lo) return;
    u32x4 kr, vr;
    ns_load(kbase + (size_t)tile_lo * 64 * stride, vbase + (size_t)tile_lo * 64 * stride, stride, F.tid, kr, vr);
    __syncthreads();
    ns_store(L + NS_K0, L + NS_V0, F.tid, kr, vr);
    __syncthreads();
    for (int ti = tile_lo; ti < tile_hi; ++ti) {
        const int buf = (ti - tile_lo) & 1;
        if (ti + 1 < tile_hi) ns_load(kbase + (size_t)(ti + 1) * 64 * stride, vbase + (size_t)(ti + 1) * 64 * stride, stride, F.tid, kr, vr);
        LAS unsigned char* Kb = L + NS_K0 + buf * NS_KB; LAS unsigned char* Vb = L + NS_V0 + buf * NS_VB;
        bool blk_on = true;
        if (MODE == NS_SEL_) blk_on = (selw[ti >> 5] >> (ti & 31)) & 1u;
        bool any;
        if (MODE == NS_CMP) any = 16 * (ti * 64) + 31 <= t; else if (MODE == NS_SEL_) any = blk_on && ti * 64 <= t; else any = (ti * 64 <= t) && (ti * 64 + 63 + 511 >= t);
        if (__ballot(any) != 0ull) {
            f32x16 sacc[2];
            ns_qk(Kb, qf, r, h2, sacc);
            bool full;
            { const int tmin = t - (r & 7), tmax = tmin + 7;
              if (MODE == NS_CMP) full = 16 * (ti * 64 + 63) + 31 <= tmin; else if (MODE == NS_SEL_) full = ti * 64 + 63 <= tmin; else full = (ti * 64 + 63 <= tmin) && (ti * 64 + 511 >= tmax); }
            float sc, rs = 0.f;
            if (full) {
                const bool rowon = (MODE != NS_SEL_) || blk_on;
                float m0 = sacc[0][0], m1 = sacc[1][0];
#pragma unroll
                for (int i = 1; i < 16; ++i) { m0 = fmaxf(m0, sacc[0][i]); m1 = fmaxf(m1, sacc[1][i]); }
                float mt = rowon ? fmaxf(m0, m1) : -1e30f;
                mt = fmaxf(mt, __shfl_xor(mt, 32));
                const float mn = fmaxf(R.m, mt); sc = __expf(R.m - mn);
                const float nb = -1.44269504f * (rowon ? mn : 1e30f);
#pragma unroll
                for (int sub = 0; sub < 2; ++sub)
#pragma unroll
                    for (int i = 0; i < 16; ++i) { const float p = __builtin_amdgcn_exp2f(__builtin_fmaf(sacc[sub][i], 1.44269504f, nb)); sacc[sub][i] = p; rs += p; }
                rs += __shfl_xor(rs, 32);
                R.l = R.l * sc + rs; R.m = mn;
            } else {
            float mt = -1e30f;
#pragma unroll
            for (int sub = 0; sub < 2; ++sub)
#pragma unroll
                for (int i = 0; i < 16; ++i) { const int key = ti * 64 + 32 * sub + (i & 3) + 8 * (i >> 2) + 4 * h2; const float sv = ns_valid<MODE>(key, t, blk_on) ? sacc[sub][i] : -1e30f; sacc[sub][i] = sv; mt = fmaxf(mt, sv); }
            mt = fmaxf(mt, __shfl_xor(mt, 32));
            const float mn = fmaxf(R.m, mt); sc = __expf(R.m - mn);
#pragma unroll
            for (int sub = 0; sub < 2; ++sub)
#pragma unroll
                for (int i = 0; i < 16; ++i) { const float sv = sacc[sub][i]; const float p = sv > -1e29f ? __expf(sv - mn) : 0.f; sacc[sub][i] = p; rs += p; }
            rs += __shfl_xor(rs, 32);
            R.l = R.l * sc + rs; R.m = mn;
            }
            if (__ballot(sc != 1.0f) != 0ull) {
#pragma unroll
                for (int e = 0; e < 2; ++e)
#pragma unroll
                    for (int i = 0; i < 16; ++i) R.o[e][i] *= sc; }
#pragma unroll
            for (int sub = 0; sub < 2; ++sub)
#pragma unroll
                for (int s2 = 0; s2 < 2; ++s2) {
                    union { bf16x8 v; unsigned w[4]; } pf;
#pragma unroll
                    for (int j = 0; j < 4; ++j) pf.w[j] = cvt_pk_bf16(sacc[sub][8 * s2 + 2 * j], sacc[sub][8 * s2 + 2 * j + 1]);
#pragma unroll
                    for (int e = 0; e < 2; ++e) {
                        const LAS unsigned char* vp = Vb + (32 * sub + 16 * s2 + 4 * h2 + ((F.lane & 15) >> 2)) * NS_VROW + (32 * e + 16 * ((F.lane >> 4) & 1) + 4 * (F.lane & 3)) * 2;
                        const s16x4 va = __builtin_amdgcn_ds_read_tr16_b64_v4i16((LAS s16x4*)vp), vb = __builtin_amdgcn_ds_read_tr16_b64_v4i16((LAS s16x4*)(vp + 8 * NS_VROW));
                        const bf16x8 vf = {va[0], va[1], va[2], va[3], vb[0], vb[1], vb[2], vb[3]};
                        R.o[e] = __builtin_amdgcn_mfma_f32_32x32x16_bf16(vf, pf.v, R.o[e], 0, 0, 0);
                    }
                }
        }
        if (ti + 1 < tile_hi) ns_store(L + NS_K0 + (buf ^ 1) * NS_KB, L + NS_V0 + (buf ^ 1) * NS_VB, F.tid, kr, vr);
        __syncthreads();
    }
}
__device__ __forceinline__ void ns_importance(Frame& F, const bf16* kbase, int ntiles, const bf16x8 (&qf)[4], int t, int r, int h2, float m, float inv_l) {
    LAS unsigned char* L = F.lds; LAS float* imp = (LAS float*)(L + NS_IMP);
    const int qrow = F.wave * 8 + (r & 7);
    u32x4 kr, vr;
    ns_load(kbase, kbase, 64, F.tid, kr, vr);
    __syncthreads();
    ns_store(L + NS_K0, L + NS_V0, F.tid, kr, vr);
    __syncthreads();
    for (int ti = 0; ti < ntiles; ++ti) {
        const int buf = ti & 1;
        if (ti + 1 < ntiles) ns_load(kbase + (size_t)(ti + 1) * 64 * 64, kbase + (size_t)(ti + 1) * 64 * 64, 64, F.tid, kr, vr);
        LAS unsigned char* Kb = L + NS_K0 + buf * NS_KB;
        f32x16 sacc[2];
        ns_qk(Kb, qf, r, h2, sacc);
#pragma unroll
        for (int sub = 0; sub < 2; ++sub)
#pragma unroll
            for (int g = 0; g < 4; ++g) {
                float p[4];
#pragma unroll
                for (int x = 0; x < 4; ++x) { const int key = ti * 64 + 32 * sub + x + 8 * g + 4 * h2; p[x] = (16 * key + 31 <= t) ? __expf(sacc[sub][4 * g + x] - m) * inv_l : 0.f; }
                float G = (p[0] + p[1]) + (p[2] + p[3]), E = p[3];
                G += __shfl_xor(G, 8); G += __shfl_xor(G, 16); E += __shfl_xor(E, 8); E += __shfl_xor(E, 16);
                const int jj = ti * 16 + 8 * sub + 2 * g + h2;
                if (r < 8) { atomicAdd((float*)(imp + qrow * 128 + jj), G); if (jj + 1 < 128) atomicAdd((float*)(imp + qrow * 128 + jj + 1), E); }
            }
        if (ti + 1 < ntiles) ns_store(L + NS_K0 + (buf ^ 1) * NS_KB, L + NS_V0 + (buf ^ 1) * NS_VB, F.tid, kr, vr);
        __syncthreads();
    }
}
__device__ __forceinline__ void nsa_unit(Frame& F0, int b, int c) {
    Frame F = F0; asm volatile("" : "+v"(F.tid)); F.lane = F.tid & 63;
    const bf16* u = (const bf16*)(F.ws + WS_U); bf16* bo = (bf16*)(F.ws + WS_BO);
    const bf16* kcmp = (const bf16*)(F.ws + WS_KCMP) + (size_t)b * 512 * 64; const bf16* vcmp = (const bf16*)(F.ws + WS_VCMP) + (size_t)b * 512 * 64;
    LAS unsigned char* L = F.lds; LAS float* imp = (LAS float*)(L + NS_IMP); LAS unsigned* selL = (LAS unsigned*)(L + NS_SEL);
    int lane = F.lane; asm volatile("" : "+v"(lane));
    const int r = lane & 31, h2 = lane >> 5, head = r >> 3, ql = r & 7;
    const int t = 64 * c + 8 * F.wave + ql; const size_t row = (size_t)b * S + t;
    const bf16* ub = u + (size_t)b * S * UW;
    bf16x8 qf[4];
#pragma unroll
    for (int kk = 0; kk < 4; ++kk) { const u32x4 w = *(const u32x4*)(u + row * UW + U_NSA + head * 64 + 8 * h2 + 16 * kk); f32x4 a, bb; unpack8(w, a, bb);
        union { bf16x8 v; u32x4 q; } cv; cv.q = pack8(a * 0.125f, bb * 0.125f); qf[kk] = cv.v; }
    const float g_cmp = fsigmoid(ldu(u, row, U_NSA + 640 + head)), g_sel = fsigmoid(ldu(u, row, U_NSA + 644 + head)), g_win = fsigmoid(ldu(u, row, U_NSA + 648 + head));
    unsigned selw[4] = {0xffffffffu, 0xffffffffu, 0xffffffffu, 0xffffffffu};
    NsaRow R;
    const int ncmp_tiles = (4 * c + 3 + 63) >> 6;
    ns_branch<NS_CMP>(F, kcmp, vcmp, 64, 0, ncmp_tiles, qf, t, r, h2, selw, R);
    LAS f32x4* stash = (LAS f32x4*)(L + NS_OUT + F.wave * 8192) + lane;
    { const float inv = R.l > 0.f ? 1.0f / R.l : 0.f; const float gs = g_cmp * inv;
#pragma unroll
      for (int e = 0; e < 2; ++e)
#pragma unroll
        for (int g = 0; g < 4; ++g) stash[(e * 4 + g) * 64] = (f32x4){R.o[e][4 * g] * gs, R.o[e][4 * g + 1] * gs, R.o[e][4 * g + 2] * gs, R.o[e][4 * g + 3] * gs};
      if (c >= 15) {
        for (int i = F.tid; i < 64 * 128; i += NTHR) imp[i] = 0.f;
        __syncthreads();
        ns_importance(F, kcmp, ncmp_tiles, qf, t, r, h2, R.m, inv);
        for (int q8 = 0; q8 < 8; ++q8) { const int qrow = F.wave * 8 + q8;
            float sc0, sc1;
            { const int j0 = lane, j1 = lane + 64;
              const bool f0 = (j0 == 0) || (j0 == c) || (j0 == c - 1), f1 = (j1 == c) || (j1 == c - 1);
              sc0 = f0 ? 1e30f : (j0 <= c ? imp[qrow * 128 + j0] : -1e30f); sc1 = f1 ? 1e30f : (j1 <= c ? imp[qrow * 128 + j1] : -1e30f); }
            unsigned long long lo = 0ull, hi = 0ull;
            for (int it = 0; it < 16; ++it) {
                const float best = wave_max(fmaxf(sc0, sc1));
                const unsigned long long m0 = __ballot(sc0 == best), m1 = __ballot(sc1 == best);
                int idx; if (m0) idx = __builtin_ctzll(m0); else idx = 64 + __builtin_ctzll(m1);
                if (idx < 64) { lo |= 1ull << idx; if (lane == idx) sc0 = -3e38f; } else { hi |= 1ull << (idx - 64); if (lane == idx - 64) sc1 = -3e38f; }
            }
            if (lane == 0) { selL[qrow * 4 + 0] = (unsigned)lo; selL[qrow * 4 + 1] = (unsigned)(lo >> 32); selL[qrow * 4 + 2] = (unsigned)hi; selL[qrow * 4 + 3] = (unsigned)(hi >> 32); }
        }
        LDS_WAIT();
#pragma unroll
        for (int j = 0; j < 4; ++j) selw[j] = selL[(F.wave * 8 + ql) * 4 + j];
      }
    }
    ns_branch<NS_SEL_>(F, ub + U_NSA + 384, ub + U_NSA + 448, UW, 0, c + 1, qf, t, r, h2, selw, R);
    { const float gs = g_sel / R.l;
#pragma unroll
      for (int e = 0; e < 2; ++e)
#pragma unroll
        for (int g = 0; g < 4; ++g) { f32x4 a = stash[(e * 4 + g) * 64]; a += (f32x4){R.o[e][4 * g] * gs, R.o[e][4 * g + 1] * gs, R.o[e][4 * g + 2] * gs, R.o[e][4 * g + 3] * gs}; stash[(e * 4 + g) * 64] = a; } }
    ns_branch<NS_WIN>(F, ub + U_NSA + 512, ub + U_NSA + 576, UW, c >= 8 ? c - 8 : 0, c + 1, qf, t, r, h2, selw, R);
    f32x16 out[2];
    { const float gs = g_win / R.l;
#pragma unroll
      for (int e = 0; e < 2; ++e)
#pragma unroll
        for (int g = 0; g < 4; ++g) { const f32x4 a = stash[(e * 4 + g) * 64];
#pragma unroll
            for (int x = 0; x < 4; ++x) out[e][4 * g + x] = a[x] + R.o[e][4 * g + x] * gs; } }
#pragma unroll
    for (int e = 0; e < 2; ++e) st_T_row(bo + row * 1024 + head * 64, 32 * e, out[e], lane);
}

__device__ __forceinline__ int nsa_grab(Frame& F, unsigned* ctr) {
    volatile LAS unsigned* MISC = (volatile LAS unsigned*)(F.lds + MISC_OFF);
    __syncthreads();
    if (F.tid == 0) MISC[16] = xb_add(ctr, 1u);
    __syncthreads();
    return (int)MISC[16];
}
__device__ __forceinline__ void cmp2_item(Frame& F, int L, int item) {
    int lane = F.lane; asm volatile("" : "+v"(lane));
    const int kv = item & 1, it = (item >> 1) & 15, b = item >> 5, r32 = lane & 31, hh = lane >> 5;
    const bf16* w2T = (const bf16*)(F.ws + WS_CW2 + (size_t)L * 65536) + kv * 64 * 128;
    const bf16* hid = (const bf16*)(F.ws + WS_CMPH) + ((size_t)(b * 512 + 32 * it)) * 256 + kv * 128;
    bf16* outp = (bf16*)(F.ws + (kv ? WS_VCMP : WS_KCMP)) + ((size_t)(b * 512 + 32 * it + r32)) * 64;
    const bool live = (32 * it + r32) < NCMP;
#pragma unroll
    for (int et = 0; et < 2; ++et) { f32x16 acc = zero16();
#pragma unroll
        for (int ks = 0; ks < 8; ++ks) acc = mma32(frag_g(w2T, 128, 32 * et, 16 * ks, lane), frag_g(hid, 256, 0, 16 * ks, lane), acc);
#pragma unroll
        for (int g = 0; g < 4; ++g) { u32x2 w; w.x = live ? cvt_pk_bf16(acc[4 * g], acc[4 * g + 1]) : 0u; w.y = live ? cvt_pk_bf16(acc[4 * g + 2], acc[4 * g + 3]) : 0u;
            *(u32x2*)(outp + 32 * et + 8 * g + 4 * hh) = w; } }
}
#ifdef SK_RWM1
#define RWM1(x)
#else
#define RWM1(x) x
#endif
#ifdef SK_RWM3
#define RWM3(x)
#else
#define RWM3(x) x
#endif
#ifdef SK_RWSC
#define RWSC(x)
#else
#define RWSC(x) x
#endif
__device__ __forceinline__ void phase_m1(Frame& F0, int L, bf16* hgS, bf16* rtS) {
    Frame F = F0; asm volatile("" : "+v"(F.tid)); F.lane = F.tid & 63;
    if (F.bx < 32) { LAS float* c1l = (LAS float*)(F.lds + RSTD_OFF + 1024);
      if (F.tid < 256) { const float* cp = (const float*)(F.ws + WS_CW2 + (size_t)L * 65536 + 32768) + (F.tid >> 7) * 32 * 128 + (F.tid & 127); float a = 0.f;
          for (int jq = 0; jq < 32; ++jq) a += cp[jq * 128];
          c1l[F.tid] = a; }
      __syncthreads(); }
    { CmpSched Sd{(const char*)(F.ws + WS_U), (const char*)(F.ws + WS_CW1 + (size_t)L * MiB), F.bx};
      EpiCmp E{(bf16*)(F.ws + WS_CMPH)};
      pg8::gemm_phase<EpiCmp, CmpSched, true>(F.lds + RING_OFF, Sd, E, (unsigned)(UW * 2), 128u); }
    if (F.bx < 32) { const int b = F.bx >> 2, q = F.bx & 3; cmp2_item(F, L, (F.wave & 1) | ((4 * q + (F.wave >> 1)) << 1) | (b << 5)); }
    LAS unsigned char* W = F.lds + F.wave * WREG;
    const int gw = F.bx * NWAVES + F.wave, NGW = F.G * NWAVES;
    for (int it = gw; it < 3 * 32 * NCH; it += NGW) { const int type = it % 3, q = it / 3, bh = q / NCH, n = q % NCH;
        if (type == 0) hgrn_chunk<false>(F, L, bh, n, W, hgS, (float*)(F.ws + WS_HGD)); else if (type == 1) ret_chunk<false>(F, L, bh, n, W, rtS); else { RWM1(rwkv_chunk<false>(F, L, bh, n, W)); } }
}
__device__ __forceinline__ void phase_scan(Frame& F0, int L, bf16* hgS, bf16* rtS) {
    Frame F = F0; asm volatile("" : "+v"(F.tid)); F.lane = F.tid & 63;
    if (F.tid < 256) {
        if (F.bx < 64) glin_scan_task(hgS, (bf16*)((unsigned char*)F.out + DO_HGS), (const float*)(F.ws + WS_HGD), 0.f, F.bx >> 1, F.bx & 1, F.tid);
        else if (F.bx < 128) { const int k = F.bx - 64, h = (k >> 1) & 3; const float g = 1.0f - exp2f(-5.0f - (float)h); glin_scan_task(rtS, (bf16*)((unsigned char*)F.out + DO_RTS), nullptr, exp2f(32.0f * __log2f(g)), k >> 1, k & 1, F.tid); }
    } else if (F.wave == 4) { if (F.bx < 64) { RWSC(rwkv_scan_task(F, F.bx >> 1, F.bx & 1)); } }
    if (F.bx >= 64) { unsigned* ctr = (unsigned*)(F.ws + WS_CTL) + CW_NSA + L * 64;
        for (;;) { const int k = nsa_grab(F, ctr); if (k >= 4 * (NSA_CA + 1)) break; nsa_unit(F, 4 + (k & 3), NSA_CA - (k >> 2)); } }
}
__device__ __forceinline__ void phase_m3(Frame& F0, int L, bf16* hgS, bf16* rtS) {
    Frame F = F0; asm volatile("" : "+v"(F.tid)); F.lane = F.tid & 63;
    LAS unsigned char* W = F.lds + F.wave * WREG;
    const int gw = F.bx * NWAVES + F.wave, NGW = F.G * NWAVES;
    for (int it = gw; it < REP_ITEMS * 3 * 32 * NCH; it += NGW) { const int type = it % 3, q = (it / 3) % (32 * NCH), bh = q / NCH, n = q % NCH;
        if (type == 0) hgrn_chunk<true>(F, L, bh, n, W, (bf16*)((unsigned char*)F.out + DO_HGS), nullptr); else if (type == 1) ret_chunk<true>(F, L, bh, n, W, (bf16*)((unsigned char*)F.out + DO_RTS)); else { RWM3(rwkv_chunk<true>(F, L, bh, n, W)); } }
    __syncthreads();
#ifndef SK_NSA
    { unsigned* ctr = (unsigned*)(F.ws + WS_CTL) + CW_NSA + L * 64 + 16;
      const int nbig = 8 * (127 - NSA_CA), ntot = nbig + 4 * (NSA_CA + 1);
      for (;;) { const int k = nsa_grab(F, ctr); if (k >= ntot) break;
          if (k < nbig) nsa_unit(F, k & 7, 127 - (k >> 3)); else { const int k2 = k - nbig; nsa_unit(F, k2 & 3, NSA_CA - (k2 >> 2)); } } }
#endif
}

__device__ __forceinline__ void phase_pconv(Frame& F0, int L) {
    Frame F = F0; asm volatile("" : "+v"(F.tid)); F.lane = F.tid & 63;
    const float* p = F.in[I_P] + (size_t)L * T * PLE; bf16* pbf = (bf16*)(F.ws + WS_PB);
    for (int r = F.bx * NWAVES + F.wave; r < T; r += F.G * NWAVES) { const f32x4 v = *((const f32x4*)(p + (size_t)r * PLE) + F.lane); u32x2 w; w.x = cvt_pk_bf16(v[0], v[1]); w.y = cvt_pk_bf16(v[2], v[3]); *((u32x2*)(pbf + (size_t)r * PLE) + F.lane) = w; }
}
__device__ __forceinline__ void phase_final(Frame& F0, const float* ssf, const bf16* hb) {
    Frame F = F0; asm volatile("" : "+v"(F.tid)); F.lane = F.tid & 63;
    const float* g = F.in[I_NORM_FINAL]; const int gw = F.bx * NWAVES + F.wave, NGW = F.G * NWAVES;
    for (int r = gw; r < T; r += NGW) { const float rs = __builtin_amdgcn_rsqf(ss_row(ssf, r) * (1.0f / D) + EPS); const u32x4* hr = (const u32x4*)(hb + (size_t)r * D) + F.lane; f32x4* orow = (f32x4*)(F.out + (size_t)r * D);
#pragma unroll
        for (int j = 0; j < 2; ++j) { f32x4 a, b; unpack8(hr[64 * j], a, b); const f32x4 g0 = *((const f32x4*)g + 2 * (F.lane + 64 * j)), g1 = *((const f32x4*)g + 2 * (F.lane + 64 * j) + 1);
            orow[2 * (F.lane + 64 * j)] = a * rs * g0; orow[2 * (F.lane + 64 * j) + 1] = b * rs * g1; } }
}

constexpr int PH_PER_LAYER = 9, N_PHASES = 1 + NL * PH_PER_LAYER + 1;
__global__ void __launch_bounds__(NTHR, 2) mega_fwd(Args args) {
    extern __shared__ __attribute__((aligned(16))) unsigned char lds_raw[];
    Frame F; F.lds = (LAS unsigned char*)lds_raw; F.tid = threadIdx.x; F.lane = F.tid & 63; F.wave = __builtin_amdgcn_readfirstlane(F.tid >> 6); F.G = gridDim.x; F.bx = blockIdx.x;
    F.in = args.in; F.out = args.out; F.ws = args.ws;
    volatile LAS unsigned* MISC = (volatile LAS unsigned*)(F.lds + MISC_OFF);
    if (F.tid < 32) MISC[F.tid] = 0u;
    __syncthreads();
    unsigned* ctl = (unsigned*)(F.ws + WS_CTL);
    XcdBarrier bar; bar.bar = ctl + CW_BAR; bar.x = 0; bar.st = nullptr;
    if (MK_N_LAUNCHES == 1) bar = xcd_barrier_post(ctl + CW_BAR, MISC + 8);
    const int lo = args.ph_lo, hi = args.ph_hi;
#define IN(k) (lo <= (k) && (k) < hi)
#define REPS(k) (((k) == REP_PHASE || (k) == REP_PHASE + 9) ? 2 : 1)
#define SEAM(k) do { if (IN(k) && IN((k) + 1)) xcd_barrier(bar); } while (0)
    float* ssb = F.out;
    LAS unsigned char* ring = F.lds + RING_OFF;

    #ifndef SK_PRO
    for (int rep = 0; rep < ((REP_PHASE == 0) ? 2 : 1); ++rep) if (IN(0)) { if (rep) xcd_barrier(bar); phase_prologue(F); }
#endif
    SEAM(0);

    for (int L = 0; L < NL; ++L) {
        asm volatile("" : "+v"(F.tid)); F.lane = F.tid & 63;
        const int pb = 1 + L * PH_PER_LAYER;
        unsigned char* wl = F.ws + WS_W + (size_t)L * WL_STRIDE;
        bf16* hb_cur = (bf16*)(F.ws + ((L & 1) ? WS_HBB : WS_HBA)); bf16* hb_oth = (bf16*)(F.ws + ((L & 1) ? WS_HBA : WS_HBB));
        const float* ss_mix = ssb + (size_t)(3 * L) * T * 16; float* ss_ffn = ssb + (size_t)(3 * L + 1) * T * 16; float* ss_ple = ssb + (size_t)(3 * L + 2) * T * 16; float* ss_next = (L == NL - 1) ? (float*)(F.ws + WS_SSF) : ssb + (size_t)(3 * L + 3) * T * 16;
#ifndef SK_G1
        for (int rep = 0; rep < REPS(pb + 0); ++rep) if (IN(pb + 0)) { PlainSched Sd{(const char*)hb_cur, (const char*)(wl + WL_IN), D * 2, D * 2, D / 64, T / 256, UW / 256, F.G, F.bx};
            EpiScaleBf16 E{(bf16*)(F.ws + WS_U), UW, ss_mix}; pg8::gemm_phase(ring, Sd, E); }
#endif
        SEAM(pb + 0);
        bf16* hgS = hb_oth; bf16* rtS = hb_oth + (size_t)32 * NCH * 4096;
        for (int rep = 0; rep < REPS(pb + 1); ++rep) if (IN(pb + 1)) { if (rep) xcd_barrier(bar); phase_m1(F, L, hgS, rtS); }
        SEAM(pb + 1);
#ifndef EXP_NOSCAN
        for (int rep = 0; rep < REPS(pb + 2); ++rep) if (IN(pb + 2)) { if (rep) xcd_barrier(bar); phase_scan(F, L, hgS, rtS); }
#endif
        SEAM(pb + 2);
        if (IN(pb + 3)) phase_m3(F, L, hgS, rtS);
        SEAM(pb + 3);
#ifndef SK_G2
        for (int rep = 0; rep < REPS(pb + 4); ++rep) if (IN(pb + 4)) { if (STAG_G2 > 0 && ((F.bx >> 3) & 1)) { const unsigned long long t0 = __builtin_amdgcn_s_memrealtime(); while (__builtin_amdgcn_s_memrealtime() - t0 < (unsigned long long)STAG_G2) __builtin_amdgcn_s_sleep(16); }
            PairSched Sd{(const char*)hb_cur, (const char*)(wl + WL_G), D * 2, D * 2, D / 64, (size_t)D * D * 2,
                                        (const char*)(F.ws + WS_BO), (const char*)(wl + WL_B), 1024 * 2, MW * 2, MW / 64, (size_t)MW * 2, (size_t)D * MW * 2, 4, T / 256, D / 256, F.G, F.bx};
            u32x4* scr = (u32x4*)(F.ws + WS_SCR + (size_t)F.bx * 262144);
            EpiMerge E{scr, scr + 8192, (bf16*)(F.ws + WS_MERGED), ss_mix, F.in[I_BGATE] + (size_t)L * 4 * D, 4}; pg8::gemm_phase(ring, Sd, E); }
#endif
        SEAM(pb + 4);
#ifndef SK_G3
        if (IN(pb + 5)) phase_pconv(F, L);
        if (IN(pb + 5)) { PlainSched Sd{(const char*)(F.ws + WS_MERGED), (const char*)(wl + WL_OUT), D * 2, D * 2, D / 64, T / 256, D / 256, F.G, F.bx};
            EpiResidual E{(L == 0) ? F.in[I_X] : nullptr, hb_cur, ss_ffn}; pg8::gemm_phase(ring, Sd, E); }
#endif
        SEAM(pb + 5);
#ifndef SK_G4
        for (int rep = 0; rep < REPS(pb + 6); ++rep) if (IN(pb + 6)) { PlainSched Sd{(const char*)hb_cur, (const char*)(wl + WL_FF), D * 2, D * 2, D / 64, T / 256, (2 * DFF) / 256, F.G, F.bx};
            EpiSwiGLU E{(bf16*)(F.ws + WS_FFH), ss_ffn}; pg8::gemm_phase(ring, Sd, E); }
#endif
        SEAM(pb + 6);
#ifndef SK_G5
        if (IN(pb + 7)) { PlainSched Sd{(const char*)(F.ws + WS_FFH), (const char*)(wl + WL_DN), DFF * 2, DFF * 2, DFF / 64, T / 256, D / 256, F.G, F.bx};
            EpiResidual E{nullptr, hb_cur, ss_ple}; pg8::gemm_phase(ring, Sd, E); }
#endif
        SEAM(pb + 7);
#ifndef SK_G6
        if (IN(pb + 8)) { PairSched Sd{(const char*)hb_cur, (const char*)(wl + WL_PG), D * 2, D * 2, D / 64, 0,
                                        (const char*)(F.ws + WS_PB), (const char*)(wl + WL_PP), PLE * 2, PLE * 2, PLE / 64, 0, 0, 1, T / 256, D / 256, F.G, F.bx};
            u32x4* scr = (u32x4*)(F.ws + WS_SCR + (size_t)F.bx * 262144);
            EpiPle E{scr, hb_cur, hb_oth, ss_ple, ss_next}; pg8::gemm_phase(ring, Sd, E); }
#endif
        SEAM(pb + 8);
    }
#ifndef SK_FIN
    if (IN(N_PHASES - 1)) phase_final(F, (const float*)(F.ws + WS_SSF), (const bf16*)(F.ws + ((NL & 1) ? WS_HBB : WS_HBA)));
#endif
#undef IN
#undef SEAM
}

extern "C" void kernel_launch(void* const* d_in, const int* in_sizes, int n_in, void* d_out, int out_size, void* d_ws, size_t ws_size, hipStream_t stream) {
    static int grid = 0;
    if (grid == 0) {
        if (n_in != 37 || in_sizes[0] != T * D || out_size != T * D || ws_size < WS_END) { fprintf(stderr, "kernel_launch: unexpected shapes (n_in %d, ws %zu)\n", n_in, ws_size); grid = -1; return; }
        int dev = 0, cus = 0, per_cu = 0;
        if (hipGetDevice(&dev) != hipSuccess || hipDeviceGetAttribute(&cus, hipDeviceAttributeMultiprocessorCount, dev) != hipSuccess) { grid = -1; return; }
        if (hipFuncSetAttribute((const void*)mega_fwd, hipFuncAttributeMaxDynamicSharedMemorySize, LDS_BYTES) != hipSuccess) { fprintf(stderr, "kernel_launch: hipFuncSetAttribute failed\n"); grid = -1; return; }
        if (hipOccupancyMaxActiveBlocksPerMultiprocessor(&per_cu, (const void*)mega_fwd, NTHR, LDS_BYTES) != hipSuccess || per_cu < 1) { fprintf(stderr, "kernel_launch: occupancy query says %d\n", per_cu); }
        (void)hipGetLastError();
        grid = cus;
    }
    if (grid < 0) return;
    hipMemsetAsync((char*)d_ws + WS_CTL, 0, CTL_BYTES, stream);
    Args a{};
    for (int i = 0; i < 37; ++i) a.in[i] = (const float*)d_in[i];
    a.out = (float*)d_out; a.ws = (unsigned char*)d_ws;
    if (MK_N_LAUNCHES == 1) { a.ph_lo = 0; a.ph_hi = N_PHASES; hipLaunchKernelGGL(mega_fwd, dim3(grid), dim3(NTHR), LDS_BYTES, stream, a); }
    else for (int p = 0; p < N_PHASES; ++p) { a.ph_lo = p; a.ph_hi = p + 1; hipLaunchKernelGGL(mega_fwd, dim3(grid), dim3(NTHR), LDS_BYTES, stream, a); }
}
```
